# Optimizing an MI355X kernel written in HIP

```python
import jax, jax.numpy as jnp
from jax import lax
import numpy as np

D_MODEL = 1024
BATCH = 2
SEQ = 8192
DEPTH = 2

N_META = 16
CHUNK = 64
PAD = CHUNK - N_META
D_FF = 2816
EPS = 1e-6
N_MIXERS = 2
N_RET = (DEPTH + 1) // 2
N_GLA = DEPTH // 2

RET_HEADS = 4
RET_DK = D_MODEL // RET_HEADS
RET_DV = 2 * D_MODEL // RET_HEADS
RET_IN = 2 * D_MODEL + 4 * D_MODEL
ROPE_BASE = 10000.0

GLA_HEADS = 4
GLA_DK = D_MODEL // 2 // GLA_HEADS
GLA_DV = D_MODEL // GLA_HEADS
GLA_RANK = 16
GLA_TAU = 16.0
GLA_HK = GLA_HEADS * GLA_DK
GLA_HV = GLA_HEADS * GLA_DV
GLA_IN = 2 * GLA_HK + 2 * GLA_HV + GLA_RANK

kernel_name = "hybrid_retnet_gla_macaron_meta"


def rmsnorm(x, g):
    xf = x.astype(jnp.float32)
    y = xf * lax.rsqrt(jnp.mean(xf * xf, axis=-1, keepdims=True) + EPS)
    return (y * g).astype(x.dtype)


def swiglu(x, w_in, w_out):
    gate, up = jnp.split(x @ w_in, 2, axis=-1)
    return (jax.nn.silu(gate) * up) @ w_out


def to_chunks(t):
    b, T, h, d = t.shape
    n = (T + PAD) // CHUNK
    t = jnp.pad(t, ((0, 0), (PAD, 0), (0, 0), (0, 0)))
    return t.reshape(b, n, CHUNK, h, d).transpose(1, 0, 3, 2, 4)


def from_chunks(t):
    n, b, h, c, d = t.shape
    return t.transpose(1, 0, 3, 2, 4).reshape(b, n * c, h, d)[:, PAD:]


def rotary(t, pos):
    half = t.shape[-1] // 2
    inv = 1.0 / (ROPE_BASE ** jnp.linspace(0.0, 1.0, half, dtype=jnp.float32))
    ang = pos.astype(jnp.float32)[:, None] * inv[None, :]
    cos = jnp.cos(ang)[None, :, None, :].astype(t.dtype)
    sin = jnp.sin(ang)[None, :, None, :].astype(t.dtype)
    t1, t2 = t[..., :half], t[..., half:]
    return jnp.concatenate([t1 * cos - t2 * sin, t1 * sin + t2 * cos], axis=-1)


def retention(h, w_in, head_norm, w_out):
    b, T, _ = h.shape
    q, k, v, g = jnp.split(h @ w_in, [D_MODEL, 2 * D_MODEL, 4 * D_MODEL], axis=-1)
    pos = jnp.arange(T)
    q = rotary(q.reshape(b, T, RET_HEADS, RET_DK), pos)
    k = rotary(k.reshape(b, T, RET_HEADS, RET_DK), pos) * (RET_DK ** -0.5)
    v = v.reshape(b, T, RET_HEADS, RET_DV)

    log_gamma = jnp.log1p(-2.0 ** (-5.0 - jnp.arange(RET_HEADS, dtype=jnp.float32)))
    idx = jnp.arange(CHUNK, dtype=jnp.float32)
    rel = idx[:, None] - idx[None, :]
    decay_intra = jnp.where(rel >= 0, jnp.exp(log_gamma[:, None, None] * jnp.maximum(rel, 0.0)), 0.0)
    decay_q = jnp.exp(log_gamma[:, None] * (idx + 1.0))[..., None]
    decay_k = jnp.exp(log_gamma[:, None] * (CHUNK - 1.0 - idx))[..., None]
    decay_chunk = jnp.exp(log_gamma * CHUNK)[:, None, None]

    def step(S, inp):
        qi, ki, vi = inp
        scores = jnp.einsum('bhid,bhjd->bhij', qi, ki) * decay_intra
        o = (jnp.einsum('bhij,bhjv->bhiv', scores, vi)
             + jnp.einsum('bhid,bhdv->bhiv', qi * decay_q, S))
        S = S * decay_chunk + jnp.einsum('bhjd,bhjv->bhdv', ki * decay_k, vi)
        return S, o

    S0 = jnp.zeros((b, RET_HEADS, RET_DK, RET_DV), jnp.float32)
    _, o = lax.scan(step, S0, (to_chunks(q), to_chunks(k), to_chunks(v)))
    o = rmsnorm(from_chunks(o), head_norm)
    o = o.reshape(b, T, RET_HEADS * RET_DV) * jax.nn.silu(g)
    return o @ w_out


def gla(h, w_in, w_gate, b_gate, head_norm, w_out):
    b, T, _ = h.shape
    q, k, v, g, z = jnp.split(h @ w_in, [GLA_HK, 2 * GLA_HK, 2 * GLA_HK + GLA_HV, 2 * GLA_HK + 2 * GLA_HV], axis=-1)
    q = q.reshape(b, T, GLA_HEADS, GLA_DK) * (GLA_DK ** -0.5)
    k = k.reshape(b, T, GLA_HEADS, GLA_DK)
    v = v.reshape(b, T, GLA_HEADS, GLA_DV)
    log_a = jax.nn.log_sigmoid((z @ w_gate + b_gate).astype(jnp.float32)) / GLA_TAU
    log_a = log_a.reshape(b, T, GLA_HEADS, GLA_DK)
    causal = jnp.tril(jnp.ones((CHUNK, CHUNK), dtype=bool))[:, :, None]

    def step(S, inp):
        qi, ki, vi, ai = inp
        bcum = jnp.cumsum(ai, axis=2)
        diff = bcum[:, :, :, None, :] - bcum[:, :, None, :, :]
        dec = jnp.exp(jnp.where(causal, diff, -jnp.inf))
        scores = jnp.einsum('bhid,bhijd,bhjd->bhij', qi, dec, ki)
        o = (jnp.einsum('bhij,bhjv->bhiv', scores, vi)
             + jnp.einsum('bhid,bhdv->bhiv', qi * jnp.exp(bcum), S))
        btot = bcum[:, :, -1:, :]
        S = (S * jnp.exp(btot)[:, :, 0, :, None]
             + jnp.einsum('bhjd,bhjv->bhdv', ki * jnp.exp(btot - bcum), vi))
        return S, o

    S0 = jnp.zeros((b, GLA_HEADS, GLA_DK, GLA_DV), jnp.float32)
    _, o = lax.scan(step, S0, (to_chunks(q), to_chunks(k), to_chunks(v), to_chunks(log_a)))
    o = rmsnorm(from_chunks(o), head_norm)
    o = o.reshape(b, T, GLA_HV) * jax.nn.silu(g)
    return o @ w_out


def setup_inputs(seed: int = 0) -> dict:
    key = jax.random.key(seed)
    ks = jax.random.split(key, 20)
    nrm = lambda k, shape, fan_in: jax.random.normal(k, shape, jnp.float32) * (fan_in ** -0.5)
    gain = lambda k, shape: 1.0 + 0.01 * jax.random.normal(k, shape, jnp.float32)
    return {
        "x": jax.random.normal(ks[0], (BATCH, SEQ, D_MODEL), jnp.float32),
        "meta_tokens": jax.random.normal(ks[1], (N_META, D_MODEL), jnp.float32),
        "norm_ffn1": gain(ks[2], (DEPTH, D_MODEL)),
        "ffn1_w_in": nrm(ks[3], (DEPTH, D_MODEL, 2 * D_FF), D_MODEL),
        "ffn1_w_out": nrm(ks[4], (DEPTH, D_FF, D_MODEL), D_FF),
        "norm_mix": gain(ks[5], (DEPTH, D_MODEL)),
        "norm_ffn2": gain(ks[6], (DEPTH, D_MODEL)),
        "ffn2_w_in": nrm(ks[7], (DEPTH, D_MODEL, 2 * D_FF), D_MODEL),
        "ffn2_w_out": nrm(ks[8], (DEPTH, D_FF, D_MODEL), D_FF),
        "ret_w_in": nrm(ks[9], (N_RET, D_MODEL, RET_IN), D_MODEL),
        "ret_head_norm": gain(ks[10], (N_RET, RET_HEADS, RET_DV)),
        "ret_w_out": nrm(ks[11], (N_RET, RET_HEADS * RET_DV, D_MODEL), RET_HEADS * RET_DV),
        "gla_w_in": nrm(ks[12], (N_GLA, D_MODEL, GLA_IN), D_MODEL),
        "gla_w_gate": nrm(ks[13], (N_GLA, GLA_RANK, GLA_HK), GLA_RANK),
        "gla_b_gate": 0.1 * jax.random.normal(ks[14], (N_GLA, GLA_HK), jnp.float32),
        "gla_head_norm": gain(ks[15], (N_GLA, GLA_HEADS, GLA_DV)),
        "gla_w_out": nrm(ks[16], (N_GLA, GLA_HV, D_MODEL), GLA_HV),
        "final_norm": gain(ks[17], (D_MODEL,)),
    }


def reference(x, meta_tokens, norm_ffn1, ffn1_w_in, ffn1_w_out, norm_mix, norm_ffn2,
              ffn2_w_in, ffn2_w_out, ret_w_in, ret_head_norm, ret_w_out,
              gla_w_in, gla_w_gate, gla_b_gate, gla_head_norm, gla_w_out, final_norm):
    b = x.shape[0]
    meta = jnp.broadcast_to(meta_tokens[None].astype(x.dtype), (b, N_META, D_MODEL))
    h = jnp.concatenate([meta, x], axis=1)
    for i in range(DEPTH):
        j = i // N_MIXERS
        h = h + 0.5 * swiglu(rmsnorm(h, norm_ffn1[i]), ffn1_w_in[i], ffn1_w_out[i])
        hn = rmsnorm(h, norm_mix[i])
        if i % N_MIXERS == 0:
            mix = retention(hn, ret_w_in[j], ret_head_norm[j], ret_w_out[j])
        else:
            mix = gla(hn, gla_w_in[j], gla_w_gate[j], gla_b_gate[j], gla_head_norm[j], gla_w_out[j])
        h = h + mix
        h = h + 0.5 * swiglu(rmsnorm(h, norm_ffn2[i]), ffn2_w_in[i], ffn2_w_out[i])
    h = rmsnorm(h, final_norm)
    return h[:, N_META:]
```

```cpp
#include <hip/hip_runtime.h>
#include <cstdint>
#include <cstdio>
#include <cmath>
namespace nv {
constexpr int D = 1024, NB = 2, SEQ = 8192, NMETA = 16, TT = SEQ + NMETA, DFF = 2816;
constexpr int RET_DK = 256, RET_DV = 512, RET_IN = 6144;
constexpr int GLA_DK = 128, GLA_DV = 256, GLA_HK = 512, GLA_HV = 1024, GLA_IN = 3088;
constexpr int ROWS = NB * TT;

__global__ __launch_bounds__(256) void gemm(const float* __restrict__ A, int lda, const float* __restrict__ rs, const float* __restrict__ cg,
                                            const float* __restrict__ W, int ldw, float* C, int ldc, int R, int N, int K, float alpha, float beta) {
    __shared__ float As[16][68];
    __shared__ float Ws[16][68];
    const int tid = threadIdx.x, tx = tid & 15, ty = tid >> 4;
    const int r0 = blockIdx.y * 64, c0 = blockIdx.x * 64;
    float acc[4][4] = {};
    const int ar = r0 + (tid >> 2), ak = (tid & 3) * 4;
    const int wk = tid >> 4, wc = c0 + (tid & 15) * 4;
    const float rsv = (rs && ar < R) ? rs[ar] : 1.f;
    for (int k0 = 0; k0 < K; k0 += 16) {
        float4 a = make_float4(0.f, 0.f, 0.f, 0.f);
        if (ar < R) a = *(const float4*)(A + (size_t)ar * lda + k0 + ak);
        if (cg) { const float4 g = *(const float4*)(cg + k0 + ak); a.x *= g.x; a.y *= g.y; a.z *= g.z; a.w *= g.w; }
        a.x *= rsv; a.y *= rsv; a.z *= rsv; a.w *= rsv;
        As[ak + 0][tid >> 2] = a.x; As[ak + 1][tid >> 2] = a.y; As[ak + 2][tid >> 2] = a.z; As[ak + 3][tid >> 2] = a.w;
        float4 w = make_float4(0.f, 0.f, 0.f, 0.f);
        if (wc < N) w = *(const float4*)(W + (size_t)(k0 + wk) * ldw + wc);
        *(float4*)&Ws[wk][(tid & 15) * 4] = w;
        __syncthreads();
#pragma unroll
        for (int k = 0; k < 16; ++k) {
            const float4 av = *(const float4*)&As[k][ty * 4];
            const float4 wv = *(const float4*)&Ws[k][tx * 4];
            const float aa[4] = {av.x, av.y, av.z, av.w}, ww[4] = {wv.x, wv.y, wv.z, wv.w};
#pragma unroll
            for (int i = 0; i < 4; ++i)
#pragma unroll
                for (int j = 0; j < 4; ++j) acc[i][j] += aa[i] * ww[j];
        }
        __syncthreads();
    }
#pragma unroll
    for (int i = 0; i < 4; ++i) {
        const int r = r0 + ty * 4 + i; if (r >= R) continue;
        const int c = c0 + tx * 4; if (c >= N) continue;
        float* cp = C + (size_t)r * ldc + c;
        float4 o;
        if (beta != 0.f) { const float4 old = *(const float4*)cp; o.x = beta * old.x + alpha * acc[i][0]; o.y = beta * old.y + alpha * acc[i][1]; o.z = beta * old.z + alpha * acc[i][2]; o.w = beta * old.w + alpha * acc[i][3]; }
        else { o.x = alpha * acc[i][0]; o.y = alpha * acc[i][1]; o.z = alpha * acc[i][2]; o.w = alpha * acc[i][3]; }
        *(float4*)cp = o;
    }
}

__global__ void build_h(const float* __restrict__ x, const float* __restrict__ meta, float* H) {
    const size_t i = (size_t)blockIdx.x * blockDim.x + threadIdx.x;
    if (i >= (size_t)ROWS * D) return;
    const int d = (int)(i % D); const size_t row = i / D; const int b = (int)(row / TT), s = (int)(row % TT);
    H[i] = s < NMETA ? meta[s * D + d] : x[((size_t)b * SEQ + (s - NMETA)) * D + d];
}
__global__ __launch_bounds__(256) void rstd(const float* __restrict__ X, int ld, int n, float* rs) {
    __shared__ float red[256];
    const float* xr = X + (size_t)blockIdx.x * ld; float s = 0.f;
    for (int i = threadIdx.x; i < n; i += 256) { const float v = xr[i]; s += v * v; }
    red[threadIdx.x] = s; __syncthreads();
    for (int o = 128; o > 0; o >>= 1) { if (threadIdx.x < o) red[threadIdx.x] += red[threadIdx.x + o]; __syncthreads(); }
    if (threadIdx.x == 0) rs[blockIdx.x] = 1.0f / sqrtf(red[0] / (float)n + 1e-6f);
}
__device__ __forceinline__ float silu(float v) { return v / (1.f + expf(-v)); }
__global__ void swiglu(float* hid, int R) {
    const size_t i = (size_t)blockIdx.x * blockDim.x + threadIdx.x;
    if (i >= (size_t)R * DFF) return;
    const size_t r = i / DFF; const int j = (int)(i % DFF);
    float* p = hid + r * (2 * DFF);
    p[j] = silu(p[j]) * p[DFF + j];
}
__global__ void ret_rotary(float* q, float* k) {
    const int i = blockIdx.x * blockDim.x + threadIdx.x;
    if (i >= TT * 128) return;
    const int s = i / 128, c = i % 128;
    const float inv = 1.0f / powf(10000.0f, (float)c / 127.0f);
    const float ang = (float)s * inv; const float cs = cosf(ang), sn = sinf(ang);
    float* qp = q + (size_t)s * 256; float* kp = k + (size_t)s * 256;
    const float q1 = qp[c], q2 = qp[c + 128]; qp[c] = q1 * cs - q2 * sn; qp[c + 128] = q1 * sn + q2 * cs;
    const float k1 = kp[c], k2 = kp[c + 128]; kp[c] = (k1 * cs - k2 * sn) * 0.0625f; kp[c + 128] = (k1 * sn + k2 * cs) * 0.0625f;
}
__global__ void gla_prep(const float* __restrict__ z, const float* __restrict__ wg, const float* __restrict__ bg, int col0, float* alpha, float* q) {
    const int i = blockIdx.x * blockDim.x + threadIdx.x;
    if (i >= TT * 128) return;
    const int t = i / 128, d = i % 128;
    float a = bg[col0 + d];
    for (int r = 0; r < 16; ++r) a += z[(size_t)t * 16 + r] * wg[r * GLA_HK + col0 + d];
    const float ls = fminf(a, 0.f) - log1pf(expf(-fabsf(a)));
    alpha[i] = expf(ls * (1.0f / 16.0f));
    q[i] *= 0.08838834764831845f;
}
template <int DK> __global__ __launch_bounds__(256) void recur(const float* __restrict__ q, const float* __restrict__ k, const float* __restrict__ v, int ldv,
                                                               const float* __restrict__ alpha, float gamma, float* o, int ldo, int T) {
    constexpr int NJ = DK / 16;
    const int tid = threadIdx.x, w = tid >> 4, dg = tid & 15, col = blockIdx.x * 16 + w;
    float S[NJ];
#pragma unroll
    for (int j = 0; j < NJ; ++j) S[j] = 0.f;
#pragma unroll 2
    for (int t = 0; t < T; ++t) {
        const float* qp = q + (size_t)t * DK + dg * NJ; const float* kp = k + (size_t)t * DK + dg * NJ;
        const float vv = v[(size_t)t * ldv + col];
        float acc = 0.f;
#pragma unroll
        for (int j = 0; j < NJ; ++j) {
            const float a = alpha ? alpha[(size_t)t * DK + dg * NJ + j] : gamma;
            S[j] = a * S[j] + kp[j] * vv; acc += qp[j] * S[j];
        }
        acc += __shfl_xor(acc, 1); acc += __shfl_xor(acc, 2); acc += __shfl_xor(acc, 4); acc += __shfl_xor(acc, 8);
        if (dg == 0) o[(size_t)t * ldo + col] = acc;
    }
}
__global__ __launch_bounds__(256) void norm_gate(const float* __restrict__ o, const float* __restrict__ g, const float* __restrict__ hn, int dv, float* y, int ldy, int col0) {
    __shared__ float red[256];
    const int t = blockIdx.x; const float* orow = o + (size_t)t * dv; float s = 0.f;
    for (int i = threadIdx.x; i < dv; i += 256) s += orow[i] * orow[i];
    red[threadIdx.x] = s; __syncthreads();
    for (int of = 128; of > 0; of >>= 1) { if (threadIdx.x < of) red[threadIdx.x] += red[threadIdx.x + of]; __syncthreads(); }
    const float r = 1.0f / sqrtf(red[0] / (float)dv + 1e-6f);
    for (int i = threadIdx.x; i < dv; i += 256) y[(size_t)t * ldy + col0 + i] = orow[i] * r * hn[i] * silu(g[(size_t)t * dv + i]);
}
__global__ __launch_bounds__(256) void final_norm(const float* __restrict__ H, const float* __restrict__ gn, float* out) {
    __shared__ float red[256];
    const int row = blockIdx.x, b = row / SEQ, t = row % SEQ;
    const float* hr = H + ((size_t)b * TT + NMETA + t) * D; float s = 0.f;
    for (int i = threadIdx.x; i < D; i += 256) s += hr[i] * hr[i];
    red[threadIdx.x] = s; __syncthreads();
    for (int of = 128; of > 0; of >>= 1) { if (threadIdx.x < of) red[threadIdx.x] += red[threadIdx.x + of]; __syncthreads(); }
    const float r = 1.0f / sqrtf(red[0] / (float)D + 1e-6f);
    for (int i = threadIdx.x; i < D; i += 256) out[(size_t)row * D + i] = hr[i] * r * gn[i];
}

struct Ws {
    static constexpr size_t MiB = 1u << 20;
    static constexpr size_t H = 0, RS = 65 * MiB, BIG = 66 * MiB;
    static constexpr size_t Q = BIG, K = BIG + 9 * MiB, V = BIG + 18 * MiB, G = BIG + 35 * MiB, O = BIG + 52 * MiB, Y = BIG + 69 * MiB, Z = BIG + 134 * MiB, AL = BIG + 135 * MiB;
};

static void launch_gemm(hipStream_t st, const float* A, int lda, const float* rs, const float* cg, const float* W, int ldw, float* C, int ldc, int R, int N, int K, float alpha, float beta) {
    dim3 grid((N + 63) / 64, (R + 63) / 64);
    hipLaunchKernelGGL(gemm, grid, dim3(256), 0, st, A, lda, rs, cg, W, ldw, C, ldc, R, N, K, alpha, beta);
}
static void ffn(hipStream_t st, char* ws, const float* ng, const float* w_in, const float* w_out) {
    float* H = (float*)(ws + Ws::H); float* RS = (float*)(ws + Ws::RS); float* HID = (float*)(ws + Ws::BIG);
    hipLaunchKernelGGL(rstd, dim3(ROWS), dim3(256), 0, st, H, D, D, RS);
    constexpr int SL = ROWS / 8;
    for (int s = 0; s < 8; ++s) {
        float* Hs = H + (size_t)s * SL * D;
        launch_gemm(st, Hs, D, RS + s * SL, ng, w_in, 2 * DFF, HID, 2 * DFF, SL, 2 * DFF, D, 1.f, 0.f);
        hipLaunchKernelGGL(swiglu, dim3((SL * DFF + 255) / 256), dim3(256), 0, st, HID, SL);
        launch_gemm(st, HID, 2 * DFF, nullptr, nullptr, w_out, D, Hs, D, SL, D, DFF, 0.5f, 1.f);
    }
}
static void forward(hipStream_t st, void* const* d_in, float* out, char* ws, int upto_layer = 2) {
    const float* x = (const float*)d_in[0]; const float* meta = (const float*)d_in[1];
    const float* norm_ffn1 = (const float*)d_in[2]; const float* ffn1_w_in = (const float*)d_in[3]; const float* ffn1_w_out = (const float*)d_in[4];
    const float* norm_mix = (const float*)d_in[5]; const float* norm_ffn2 = (const float*)d_in[6];
    const float* ffn2_w_in = (const float*)d_in[7]; const float* ffn2_w_out = (const float*)d_in[8];
    const float* ret_w_in = (const float*)d_in[9]; const float* ret_hn = (const float*)d_in[10]; const float* ret_w_out = (const float*)d_in[11];
    const float* gla_w_in = (const float*)d_in[12]; const float* gla_wg = (const float*)d_in[13]; const float* gla_bg = (const float*)d_in[14];
    const float* gla_hn = (const float*)d_in[15]; const float* gla_w_out = (const float*)d_in[16]; const float* fin = (const float*)d_in[17];
    float* H = (float*)(ws + Ws::H); float* RS = (float*)(ws + Ws::RS);
    float* Q = (float*)(ws + Ws::Q); float* K = (float*)(ws + Ws::K); float* V = (float*)(ws + Ws::V); float* G = (float*)(ws + Ws::G);
    float* O = (float*)(ws + Ws::O); float* Y = (float*)(ws + Ws::Y); float* Z = (float*)(ws + Ws::Z); float* AL = (float*)(ws + Ws::AL);
    hipLaunchKernelGGL(build_h, dim3((unsigned)(((size_t)ROWS * D + 255) / 256)), dim3(256), 0, st, x, meta, H);
    for (int i = 0; i < upto_layer; ++i) {
        ffn(st, ws, norm_ffn1 + i * D, ffn1_w_in + (size_t)i * D * 2 * DFF, ffn1_w_out + (size_t)i * DFF * D);
        hipLaunchKernelGGL(rstd, dim3(ROWS), dim3(256), 0, st, H, D, D, RS);
        const float* ng = norm_mix + i * D;
        for (int b = 0; b < NB; ++b) {
            float* Hb = H + (size_t)b * TT * D; const float* rsb = RS + b * TT;
            if (i == 0) {
                for (int h = 0; h < 4; ++h) {
                    launch_gemm(st, Hb, D, rsb, ng, ret_w_in + h * 256, RET_IN, Q, 256, TT, 256, D, 1.f, 0.f);
                    launch_gemm(st, Hb, D, rsb, ng, ret_w_in + 1024 + h * 256, RET_IN, K, 256, TT, 256, D, 1.f, 0.f);
                    launch_gemm(st, Hb, D, rsb, ng, ret_w_in + 2048 + h * 512, RET_IN, V, 512, TT, 512, D, 1.f, 0.f);
                    launch_gemm(st, Hb, D, rsb, ng, ret_w_in + 4096 + h * 512, RET_IN, G, 512, TT, 512, D, 1.f, 0.f);
                    hipLaunchKernelGGL(ret_rotary, dim3((TT * 128 + 255) / 256), dim3(256), 0, st, Q, K);
                    const float gamma = 1.0f - exp2f(-5.0f - (float)h);
                    hipLaunchKernelGGL(recur<256>, dim3(512 / 16), dim3(256), 0, st, Q, K, V, 512, (const float*)nullptr, gamma, O, 512, TT);
                    hipLaunchKernelGGL(norm_gate, dim3(TT), dim3(256), 0, st, O, G, ret_hn + h * 512, 512, Y, 2048, h * 512);
                }
                launch_gemm(st, Y, 2048, nullptr, nullptr, ret_w_out, D, Hb, D, TT, D, 2048, 1.f, 1.f);
            } else {
                launch_gemm(st, Hb, D, rsb, ng, gla_w_in + 3072, GLA_IN, Z, 16, TT, 16, D, 1.f, 0.f);
                for (int h = 0; h < 4; ++h) {
                    launch_gemm(st, Hb, D, rsb, ng, gla_w_in + h * 128, GLA_IN, Q, 128, TT, 128, D, 1.f, 0.f);
                    launch_gemm(st, Hb, D, rsb, ng, gla_w_in + 512 + h * 128, GLA_IN, K, 128, TT, 128, D, 1.f, 0.f);
                    launch_gemm(st, Hb, D, rsb, ng, gla_w_in + 1024 + h * 256, GLA_IN, V, 256, TT, 256, D, 1.f, 0.f);
                    launch_gemm(st, Hb, D, rsb, ng, gla_w_in + 2048 + h * 256, GLA_IN, G, 256, TT, 256, D, 1.f, 0.f);
                    hipLaunchKernelGGL(gla_prep, dim3((TT * 128 + 255) / 256), dim3(256), 0, st, Z, gla_wg, gla_bg, h * 128, AL, Q);
                    hipLaunchKernelGGL(recur<128>, dim3(256 / 16), dim3(256), 0, st, Q, K, V, 256, (const float*)AL, 0.f, O, 256, TT);
                    hipLaunchKernelGGL(norm_gate, dim3(TT), dim3(256), 0, st, O, G, gla_hn + h * 256, 256, Y, 1024, h * 256);
                }
                launch_gemm(st, Y, 1024, nullptr, nullptr, gla_w_out, D, Hb, D, TT, D, 1024, 1.f, 1.f);
            }
        }
        ffn(st, ws, norm_ffn2 + i * D, ffn2_w_in + (size_t)i * D * 2 * DFF, ffn2_w_out + (size_t)i * DFF * D);
    }
    if (out) hipLaunchKernelGGL(final_norm, dim3(NB * SEQ), dim3(256), 0, st, H, fin, out);
}
}
extern "C" void kernel_launch(void* const* d_in, const int* in_sizes, int n_in, void* d_out, int out_size, void* d_ws, size_t ws_size, hipStream_t stream) {
    (void)in_sizes; (void)n_in; (void)out_size; (void)ws_size;
    nv::forward(stream, d_in, (float*)d_out, (char*)d_ws);
}
```

```cpp
#include <hip/hip_runtime.h>
#include <cstdint>
#include <cstdio>
#include <cmath>
#define MK_MODE 0
namespace mk {
#define LAS __attribute__((address_space(3)))
#define GAS __attribute__((address_space(1)))
typedef unsigned short bf16_t;
typedef short bf16x8 __attribute__((ext_vector_type(8)));
typedef short s16x4 __attribute__((ext_vector_type(4)));
typedef float f32x4 __attribute__((ext_vector_type(4)));
typedef float f32x2 __attribute__((ext_vector_type(2)));
typedef unsigned u32x4 __attribute__((ext_vector_type(4)));
typedef unsigned u32x2 __attribute__((ext_vector_type(2)));

constexpr int M = 16384, D = 1024, DFF = 2816, SEQ = 8192, NMETA = 16;
constexpr int NWAVES = 8, NTHREADS = 512;
constexpr size_t MiB = 1u << 20;
constexpr size_t WS_CTL = 0, CTL_ZERO_BYTES = 1 * MiB;
constexpr size_t CTL_OSS_RET = 256 * 1024, CTL_OSS_GLA = 512 * 1024, CTL_MOSS = 768 * 1024;
constexpr size_t WS_HB = 1 * MiB, WS_SS = 33 * MiB, WS_META = 34 * MiB, WS_WMIX = 35 * MiB;
constexpr size_t META_HM = 0, META_RAW = 64 * 1024, META_MO = 448 * 1024;
constexpr size_t WS_WFFN_A = 52 * MiB, WS_ACT = 69 * MiB, WS_WFFN_B = 157 * MiB;
constexpr size_t WS_QH = 52 * MiB, WS_KH = 84 * MiB, WS_VT = 116 * MiB, WS_O = 180 * MiB;
constexpr size_t WS_BC = 69 * MiB, WS_QH2 = 101 * MiB, WS_KH2 = 117 * MiB, WS_VT2 = 133 * MiB, WS_O2 = 174 * MiB;
constexpr size_t WS_NEED = 256 * MiB;
constexpr size_t WM_RET_IN = 0, WM_RET_OUT = 12 * MiB;
constexpr size_t WM_GLA_IN = 0, WM_GLA_G = 4 * MiB, WM_GLA_OUT = 6 * MiB, WM_GLA_Z = 8 * MiB;
constexpr size_t WF_IN = 0, WF_OUT = 11 * MiB;
constexpr int CW_BAR = 4096;

constexpr int LDS_BYTES = 163840;
constexpr int LDS_MISC = LDS_BYTES - 256;

__constant__ float L2G[4] = {-0.04580368961312478f, -0.02272007650008353f, -0.011315313227834133f, -0.005646563141142062f};
__constant__ float ROPE_INV[128] = {
  1.000000000e+00f, 9.300450087e-01f, 8.649836779e-01f, 8.044736385e-01f,
  7.481966019e-01f, 6.958565116e-01f, 6.471778154e-01f, 6.019044518e-01f,
  5.597981811e-01f, 5.206375122e-01f, 4.842162728e-01f, 4.503428936e-01f,
  4.188391268e-01f, 3.895392120e-01f, 3.622889817e-01f, 3.369450271e-01f,
  3.133740425e-01f, 2.914519310e-01f, 2.710633874e-01f, 2.521011233e-01f,
  2.344653904e-01f, 2.180633694e-01f, 2.028087080e-01f, 1.886212230e-01f,
  1.754262149e-01f, 1.631542742e-01f, 1.517407894e-01f, 1.411257535e-01f,
  1.312533021e-01f, 1.220714748e-01f, 1.135319397e-01f, 1.055898219e-01f,
  9.820328653e-02f, 9.133346379e-02f, 8.494423330e-02f, 7.900195569e-02f,
  7.347535342e-02f, 6.833537668e-02f, 6.355497986e-02f, 5.910899118e-02f,
  5.497401953e-02f, 5.112830922e-02f, 4.755162448e-02f, 4.422515258e-02f,
  4.113136977e-02f, 3.825402260e-02f, 3.557796404e-02f, 3.308910504e-02f,
  3.077435680e-02f, 2.862153389e-02f, 2.661931701e-02f, 2.475716174e-02f,
  2.302526683e-02f, 2.141453326e-02f, 1.991648041e-02f, 1.852322184e-02f,
  1.722742990e-02f, 1.602228358e-02f, 1.490144618e-02f, 1.385901403e-02f,
  1.288950257e-02f, 1.198781747e-02f, 1.114920899e-02f, 1.036926545e-02f,
  9.643883444e-03f, 8.969245479e-03f, 8.341802284e-03f, 7.758250926e-03f,
  7.215522230e-03f, 6.710760761e-03f, 6.241309457e-03f, 5.804697983e-03f,
  5.398627371e-03f, 5.020966288e-03f, 4.669724498e-03f, 4.343053792e-03f,
  4.039235413e-03f, 3.756670747e-03f, 3.493872471e-03f, 3.249458736e-03f,
  3.022142686e-03f, 2.810728736e-03f, 2.614103956e-03f, 2.431234345e-03f,
  2.261157380e-03f, 2.102978062e-03f, 1.955864020e-03f, 1.819041790e-03f,
  1.691789716e-03f, 1.573440502e-03f, 1.463370281e-03f, 1.361000235e-03f,
  1.265791478e-03f, 1.177242957e-03f, 1.094888896e-03f, 1.018295996e-03f,
  9.470609948e-04f, 8.808093844e-04f, 8.191923262e-04f, 7.618857198e-04f,
  7.085879333e-04f, 6.590186385e-04f, 6.129170069e-04f, 5.700403708e-04f,
  5.301629426e-04f, 4.930753494e-04f, 4.585822753e-04f, 4.265021416e-04f,
  3.966661752e-04f, 3.689173318e-04f, 3.431097430e-04f, 3.191074939e-04f,
  2.967843320e-04f, 2.760227653e-04f, 2.567135962e-04f, 2.387551940e-04f,
  2.220530587e-04f, 2.065193403e-04f, 1.920722716e-04f, 1.786358480e-04f,
  1.661392889e-04f, 1.545170089e-04f, 1.437077590e-04f, 1.336546848e-04f,
  1.243048755e-04f, 1.156091312e-04f, 1.075216787e-04f, 9.999999747e-05f,
};

#define LDS_WAIT() asm volatile("s_waitcnt lgkmcnt(0)" ::: "memory")
#define VM_WAIT() asm volatile("s_waitcnt vmcnt(0)" ::: "memory")
#define RLX_AGENT __ATOMIC_RELAXED, __HIP_MEMORY_SCOPE_AGENT

__device__ __forceinline__ unsigned cvt_pk_bf16(float lo, float hi) { unsigned r; asm volatile("v_cvt_pk_bf16_f32 %0, %1, %2" : "=v"(r) : "v"(lo), "v"(hi)); return r; }
__device__ __forceinline__ float bf_lo(unsigned w) { return __uint_as_float(w << 16); }
__device__ __forceinline__ float bf_hi(unsigned w) { return __uint_as_float(w & 0xffff0000u); }
__device__ __forceinline__ unsigned short f2bf(float f) { return (unsigned short)(cvt_pk_bf16(f, 0.f) & 0xffffu); }
__device__ __forceinline__ float fsilu(float v) { return v * __builtin_amdgcn_rcpf(1.0f + __expf(-v)); }
__device__ __forceinline__ float wave_sum(float v) {
#pragma unroll
    for (int o = 1; o < 64; o <<= 1) v += __shfl_xor(v, o);
    return v;
}
__device__ __forceinline__ float row_rstd(const float* SS, int row) {
    const f32x4* p = (const f32x4*)(SS + (size_t)row * 16);
    const f32x4 a = p[0], b = p[1], c = p[2], d = p[3];
    const float s = ((a.x + a.y) + (a.z + a.w)) + ((b.x + b.y) + (b.z + b.w)) + ((c.x + c.y) + (c.z + c.w)) + ((d.x + d.y) + (d.z + d.w));
    return 1.0f / sqrtf(s * (1.0f / 1024.0f) + 1e-6f);
}

#define XB_TMO      128
#define XB_XCNT(j)  (256  + 64 * (j))
#define XB_XSUB(j)  (1280 + 64 * (j))
#define XB_XGEN(j)  (2304 + 64 * (j))
#define XB_TOP      3328
#define XB_TOPGEN   3392
#define XCD_BAR_WORDS 3456
#define XB_SPIN_CAP (1u << 18)
__device__ __forceinline__ unsigned xb_ld(unsigned* p)              { return __hip_atomic_load(p, __ATOMIC_RELAXED, __HIP_MEMORY_SCOPE_AGENT); }
__device__ __forceinline__ unsigned xb_add(unsigned* p, unsigned v) { return __hip_atomic_fetch_add(p, v, __ATOMIC_RELAXED, __HIP_MEMORY_SCOPE_AGENT); }
__device__ __forceinline__ unsigned xb_xcc_id() { return (unsigned)__builtin_amdgcn_s_getreg((3 << 11) | 20) & 0xFu; }
#define XB_SPIN(cond, bar) do { unsigned _sp = 0; while (cond) { __builtin_amdgcn_s_sleep(1); \
    if ((++_sp & 255u) == 0u) { if (xb_ld(&(bar)[XB_TMO])) break; if (_sp > XB_SPIN_CAP) { atomicAdd(&(bar)[XB_TMO], 1u); break; } } } } while (0)
struct XcdBarrier { unsigned* bar; unsigned x; volatile LAS unsigned* st; };
__device__ __forceinline__ XcdBarrier xcd_barrier_post(unsigned* bar, volatile LAS unsigned* st) {
    XcdBarrier b; b.bar = bar; b.x = xb_xcc_id(); b.st = st;
    if (threadIdx.x == 0) (void)xb_add(&bar[XB_XCNT(b.x)], 1u);
    return b;
}
__device__ __forceinline__ void xcd_barrier_complete(unsigned* bar, unsigned x, unsigned& nloc, unsigned& nx) {
    const unsigned G = gridDim.x * gridDim.y * gridDim.z;
    unsigned sum, cnt, mine, sp = 0u;
    for (;;) {
        sum = 0u; cnt = 0u; mine = 0u;
#pragma unroll
        for (unsigned j = 0; j < 16; ++j) { const unsigned c = xb_ld(&bar[XB_XCNT(j)]); sum += c; cnt += (c > 0u) ? 1u : 0u; mine = (j == x) ? c : mine; }
        if (sum == G) break;
        __builtin_amdgcn_s_sleep(1);
        if ((++sp & 255u) == 0u) { if (xb_ld(&bar[XB_TMO])) break; if (sp > XB_SPIN_CAP) { atomicAdd(&bar[XB_TMO], 1u); break; } }
    }
    nloc = mine > 0u ? mine : 1u; nx = cnt > 0u ? cnt : 1u;
}
__device__ __forceinline__ void xcd_barrier(const XcdBarrier& b) {
    asm volatile("s_waitcnt vmcnt(0)" ::: "memory");
    __syncthreads();
    if (threadIdx.x == 0) {
        unsigned* bar = b.bar;
        __builtin_amdgcn_s_waitcnt(0);
        unsigned nloc = b.st[0], nx = b.st[1];
        if (nloc == 0u) { xcd_barrier_complete(bar, b.x, nloc, nx); b.st[0] = nloc; b.st[1] = nx; }
        const unsigned old = xb_add(&bar[XB_XSUB(b.x)], 1u);
        const unsigned gen = old / nloc;
        if (old + 1u == (gen + 1u) * nloc) {
            __builtin_amdgcn_fence(__ATOMIC_RELEASE, "agent");
            asm volatile("s_waitcnt vmcnt(0)" ::: "memory");
            const unsigned og = xb_add(&bar[XB_TOP], 1u);
            const unsigned tg = og / nx;
            if (og + 1u == (tg + 1u) * nx) xb_add(&bar[XB_TOPGEN], 1u);
            else XB_SPIN(xb_ld(&bar[XB_TOPGEN]) == tg, bar);
            __builtin_amdgcn_fence(__ATOMIC_ACQUIRE, "agent");
            xb_add(&bar[XB_XGEN(b.x)], 1u);
            asm volatile("s_waitcnt vmcnt(0)" ::: "memory");
        } else {
            XB_SPIN(xb_ld(&bar[XB_XGEN(b.x)]) == gen, bar);
            __builtin_amdgcn_fence(__ATOMIC_ACQUIRE, "agent");
            asm volatile("s_waitcnt vmcnt(0)" ::: "memory");
        }
    }
    __syncthreads();
}

namespace pg8 {
constexpr int BM = 256, BK = 64, HALF = 128, HTB = HALF * BK * 2, STAGE_BYTES = 8 * HTB, NXCD = 8, WGM = 8;
__host__ __device__ __forceinline__ int lds_byte(int r, int c) { const int st = (r >> 4) * 2 + (c >> 5), rr = r & 15, cc = c & 31, ob = rr * 64 + cc * 2; return st * 1024 + (ob ^ (((ob >> 9) & 1) << 5)); }
__host__ __device__ __forceinline__ void stage_rc(int b, int& R, int& C) { const int st = b / 1024, sb = b % 1024, swz = sb ^ (((sb >> 9) & 1) << 5); R = (st >> 1) * 16 + swz / 64; C = (st & 1) * 32 + (swz % 64) / 2; }
__host__ __device__ __forceinline__ int perm32(int rho) { const int n = rho >> 4, i = rho & 15; return 8 * (i >> 2) + 4 * n + (i & 3); }
struct Unit { int pm, pn; };
struct Order {
    int nM, nN, nwg, G, c;
    __device__ void init(int nM_, int nN_, int G_, int c_) { nM = nM_; nN = nN_; nwg = nM * nN; G = G_; c = c_; }
    __device__ bool next(int i, Unit& u) const {
        const long L = (long)i * G + c; if (L >= nwg) return false;
        int wgid = (int)L; { const int q = nwg / NXCD, r = nwg % NXCD, xcd = wgid % NXCD, off = wgid / NXCD; wgid = (xcd < r ? xcd * (q + 1) : r * (q + 1) + (xcd - r) * q) + off; }
        const int nig = WGM * nN, gid = wgid / nig, fm = gid * WGM, gsz = (nM - fm) < WGM ? (nM - fm) : WGM;
        u.pm = fm + ((wgid % nig) % gsz); u.pn = (wgid % nig) / gsz; return true;
    }
};
template <class Epi, class Ptr>
__device__ __forceinline__ void gemm_phase(LAS unsigned char* lds, const int K, const Order& S, const Ptr& P, const Epi& E) {
    const int tid = threadIdx.x, wid = __builtin_amdgcn_readfirstlane(tid >> 6), lane = tid & 63, wr = wid >> 2, wc = wid & 3, fr = lane & 15, fq = lane >> 4;
    const int nt = K / BK;
    unsigned voffA[2], voffB[2];
#pragma unroll
    for (int i = 0; i < 2; ++i) { int R, C; stage_rc(tid * 16 + i * 8192, R, C); const int Rb = (R & ~31) + perm32(R & 31);
        voffA[i] = (unsigned)(R * K + C) * 2u; voffB[i] = (unsigned)(Rb * K + C) * 2u; }
    const size_t kstep = (size_t)(BK * 2);
    const size_t hstep = (size_t)HALF * K * 2;
    const unsigned ldsw = (unsigned)wid * 1024u;
    const int aoff = lds_byte(wr * 64 + fr, fq * 8), boff = lds_byte(wc * 32 + fr, fq * 8);
#define PG8_SA(b, h) (((b) * 2 + (h)) * HTB)
#define PG8_SB(b, h) ((4 + (b) * 2 + (h)) * HTB)
#define PG8_STAGE(bufoff, gbase, voff) do { _Pragma("unroll") for (int _i = 0; _i < 2; ++_i) \
        __builtin_amdgcn_global_load_lds((const unsigned*)((const char*)(gbase) + (voff)[_i]), (LAS unsigned*)(lds + (bufoff) + ldsw + _i * 8192), 16, 0, 0); } while (0)
#define PG8_LDA(dst, b, h) do { _Pragma("unroll") for (int m = 0; m < 4; ++m) _Pragma("unroll") for (int k = 0; k < 2; ++k) dst[m][k] = *(const LAS bf16x8*)(lds + PG8_SA(b, h) + aoff + m * 2048 + k * 1024); } while (0)
#define PG8_LDB(dst, b, h) do { _Pragma("unroll") for (int n = 0; n < 2; ++n) _Pragma("unroll") for (int k = 0; k < 2; ++k) dst[n][k] = *(const LAS bf16x8*)(lds + PG8_SB(b, h) + boff + n * 2048 + k * 1024); } while (0)
#define PG8_MMA(ai, bj, At, Bt) do { __builtin_amdgcn_s_setprio(1); _Pragma("unroll") for (int m = 0; m < 4; ++m) _Pragma("unroll") for (int n = 0; n < 2; ++n) _Pragma("unroll") for (int k = 0; k < 2; ++k) \
        acc[ai][bj][m][n] = __builtin_amdgcn_mfma_f32_16x16x32_bf16(Bt[n][k], At[m][k], acc[ai][bj][m][n], 0, 0, 0); __builtin_amdgcn_s_setprio(0); } while (0)
#define PG8_WAIT_V(n) asm volatile("s_waitcnt vmcnt(" #n ")" ::: "memory")
#define PG8_WAIT_L(n) asm volatile("s_waitcnt lgkmcnt(" #n ")" ::: "memory")
#define PG8_BAR __builtin_amdgcn_s_barrier()
#define PG8_SCHED __builtin_amdgcn_sched_barrier(0)
    Unit cur, nxt; int ui = 0;
    if (!S.next(0, cur)) return;
    f32x4 acc[2][2][4][2];
#pragma unroll
    for (int a = 0; a < 2; ++a)
#pragma unroll
        for (int b = 0; b < 2; ++b)
#pragma unroll
            for (int m = 0; m < 4; ++m)
#pragma unroll
                for (int n = 0; n < 2; ++n) acc[a][b][m][n] = (f32x4){0.f, 0.f, 0.f, 0.f};
    bf16x8 At[4][2], B0[2][2], B1[2][2];
    const char* cA; const char* cB; P.ptrs(cur, cA, cB);
    PG8_STAGE(PG8_SB(0, 0), cB, voffB); PG8_STAGE(PG8_SB(0, 1), cB + hstep, voffB); PG8_STAGE(PG8_SA(0, 0), cA, voffA); PG8_STAGE(PG8_SA(0, 1), cA + hstep, voffA);
    if (wr == 1) PG8_BAR;
    PG8_WAIT_V(2); PG8_BAR;
    PG8_STAGE(PG8_SB(1, 0), cB + kstep, voffB); PG8_STAGE(PG8_SA(1, 0), cA + kstep, voffA); PG8_STAGE(PG8_SB(1, 1), cB + hstep + kstep, voffB);
    PG8_WAIT_V(6); PG8_BAR;
    for (;;) {
        const bool has_next = S.next(ui + 1, nxt);
        const char* nA = cA; const char* nB = cB; if (has_next) P.ptrs(nxt, nA, nB);
        for (int t = 0; t < nt; t += 2) {
            const bool last = (t == nt - 2);
            const char* a1 = cA + (size_t)(t + 1) * kstep;
            const char* a2 = last ? nA : cA + (size_t)(t + 2) * kstep; const char* b2 = last ? nB : cB + (size_t)(t + 2) * kstep;
            const char* a3 = a2 + kstep; const char* b3 = b2 + kstep;
            PG8_LDB(B0, 0, 0); PG8_LDB(B1, 0, 1); PG8_SCHED; PG8_LDA(At, 0, 0); PG8_STAGE(PG8_SA(1, 1), a1 + hstep, voffA);
            PG8_WAIT_V(8); PG8_WAIT_L(0); PG8_BAR; PG8_MMA(0, 0, At, B0); PG8_MMA(0, 1, At, B1); PG8_BAR; PG8_SCHED;
            PG8_LDA(At, 0, 1); PG8_STAGE(PG8_SB(0, 0), b2, voffB); PG8_STAGE(PG8_SB(0, 1), b2 + hstep, voffB); PG8_STAGE(PG8_SA(0, 0), a2, voffA);
            PG8_WAIT_V(8); PG8_WAIT_L(0); PG8_BAR; PG8_MMA(1, 0, At, B0); PG8_MMA(1, 1, At, B1); PG8_BAR; PG8_SCHED;
            PG8_LDB(B0, 1, 0); PG8_LDB(B1, 1, 1); PG8_SCHED; PG8_LDA(At, 1, 0); PG8_STAGE(PG8_SA(0, 1), a2 + hstep, voffA);
            PG8_WAIT_V(8); PG8_WAIT_L(0); PG8_BAR; PG8_MMA(0, 0, At, B0); PG8_MMA(0, 1, At, B1); PG8_BAR; PG8_SCHED;
            PG8_LDA(At, 1, 1); PG8_STAGE(PG8_SB(1, 0), b3, voffB); PG8_STAGE(PG8_SB(1, 1), b3 + hstep, voffB); PG8_STAGE(PG8_SA(1, 0), a3, voffA);
            PG8_WAIT_V(8); PG8_WAIT_L(0); PG8_BAR; PG8_MMA(1, 0, At, B0); PG8_MMA(1, 1, At, B1); PG8_BAR; PG8_SCHED;
        }
        if (wr == 0) PG8_BAR;
        E(acc, cur, wr, wc, fr, fq);
        if (!has_next) break;
#pragma unroll
        for (int a = 0; a < 2; ++a)
#pragma unroll
            for (int b = 0; b < 2; ++b)
#pragma unroll
                for (int m = 0; m < 4; ++m)
#pragma unroll
                    for (int n = 0; n < 2; ++n) acc[a][b][m][n] = (f32x4){0.f, 0.f, 0.f, 0.f};
        cur = nxt; cA = nA; cB = nB; ++ui;
        if (wr == 1) PG8_BAR;
    }
    PG8_WAIT_V(0);
    PG8_BAR;
#undef PG8_SA
#undef PG8_SB
#undef PG8_STAGE
#undef PG8_LDA
#undef PG8_LDB
#undef PG8_MMA
#undef PG8_WAIT_V
#undef PG8_WAIT_L
#undef PG8_BAR
#undef PG8_SCHED
}
}
struct Frame {
    LAS unsigned char* lds;
    int tid, lane, wave, vcu, G;
    unsigned char* ws;
    const float* in[18];
    float* out;
};
#define WSP(T, off) ((T*)(F.ws + (off)))

__device__ __forceinline__ void conv_item(const float* W, int ldn, int srccol0, int k0, const float* gain, bf16_t* WT, int K, int dstrow0, LAS float* scr, int lane) {
#pragma unroll 8
    for (int i = 0; i < 32; ++i) { const int kk = 2 * i + (lane >> 5); float v = W[(size_t)(k0 + kk) * ldn + srccol0 + (lane & 31)]; if (gain) v *= gain[k0 + kk]; scr[kk * 33 + (lane & 31)] = v; }
    LDS_WAIT(); asm volatile("" ::: "memory");
    const int c = lane & 7;
#pragma unroll
    for (int j = 0; j < 4; ++j) { const int n = (lane >> 3) + 8 * j; const LAS float* s = scr + (8 * c) * 33 + n;
        u32x4 o; o.x = cvt_pk_bf16(s[0 * 33], s[1 * 33]); o.y = cvt_pk_bf16(s[2 * 33], s[3 * 33]); o.z = cvt_pk_bf16(s[4 * 33], s[5 * 33]); o.w = cvt_pk_bf16(s[6 * 33], s[7 * 33]);
        *(u32x4*)(WT + (size_t)(dstrow0 + n) * K + k0 + 8 * c) = o; }
    LDS_WAIT(); asm volatile("" ::: "memory");
}
struct ConvJob { const float* W; int ldn, K, N, col0, kind; const float* gain; bf16_t* WT; };
__device__ __forceinline__ int conv_items(const ConvJob& J) { return (J.K / 64) * (J.N / 32); }
__device__ __forceinline__ void conv_run(const ConvJob& J, int item, LAS float* scr, int lane) {
    const int nblk = J.N / 32, kb = item / nblk, nb = item % nblk; const int n0 = 32 * nb;
    int src;
    if (J.kind == 0) src = J.col0 + n0; else { const int u = n0 >> 8, j = n0 & 255; src = (j < 128) ? u * 128 + j : 2816 + u * 128 + (j - 128); }
    conv_item(J.W, J.ldn, src, 64 * kb, J.gain, J.WT, J.K, n0, scr, lane);
}
__device__ __forceinline__ void conv_jobs(Frame& F, const ConvJob* jobs, int njobs, int gw, int ngw) {
    LAS float* scr = (LAS float*)(F.lds + F.wave * 16384);
    int base = 0;
    for (int j = 0; j < njobs; ++j) { const int n = conv_items(jobs[j]);
        int first = (gw - base % ngw + ngw) % ngw;
        for (int it = first; it < n; it += ngw) conv_run(jobs[j], it, scr, F.lane);
        base += n; }
}
__device__ __forceinline__ ConvJob job_ffn_in(Frame& F, int layer, int which  , size_t slot) {
    ConvJob J; J.W = F.in[which ? 7 : 3] + (size_t)layer * D * 2 * DFF; J.ldn = 2 * DFF; J.K = D; J.N = 2 * DFF; J.col0 = 0; J.kind = 1; J.gain = F.in[which ? 6 : 2] + layer * D; J.WT = WSP(bf16_t, slot + WF_IN); return J; }
__device__ __forceinline__ ConvJob job_ffn_out(Frame& F, int layer, int which, size_t slot) {
    ConvJob J; J.W = F.in[which ? 8 : 4] + (size_t)layer * DFF * D; J.ldn = D; J.K = DFF; J.N = D; J.col0 = 0; J.kind = 0; J.gain = nullptr; J.WT = WSP(bf16_t, slot + WF_OUT); return J; }

struct EpiSwiglu {
    const float* SS; bf16_t* ACT;
    __device__ __forceinline__ void operator()(const f32x4 (&acc)[2][2][4][2], const pg8::Unit& u, int wr, int wc, int fr, int fq) const {
#pragma unroll
        for (int ai = 0; ai < 2; ++ai)
#pragma unroll
            for (int m = 0; m < 4; ++m) {
                const int row = u.pm * 256 + ai * 128 + wr * 64 + m * 16 + fr; const float rs = row_rstd(SS, row);
                float v[8];
#pragma unroll
                for (int n = 0; n < 2; ++n)
#pragma unroll
                    for (int j = 0; j < 4; ++j) { const float g = acc[ai][0][m][n][j] * rs, up = acc[ai][1][m][n][j] * rs; v[4 * n + j] = fsilu(g) * up; }
                u32x4 w; w.x = cvt_pk_bf16(v[0], v[1]); w.y = cvt_pk_bf16(v[2], v[3]); w.z = cvt_pk_bf16(v[4], v[5]); w.w = cvt_pk_bf16(v[6], v[7]);
                *(u32x4*)(ACT + (size_t)row * DFF + u.pn * 128 + wc * 32 + 8 * fq) = w;
            }
    }
};
struct EpiResid {
    const float* base; float* H; bf16_t* HB; float* SS; float alpha;
    __device__ __forceinline__ void operator()(const f32x4 (&acc)[2][2][4][2], const pg8::Unit& u, int wr, int wc, int fr, int fq) const {
#pragma unroll
        for (int ai = 0; ai < 2; ++ai)
#pragma unroll
            for (int m = 0; m < 4; ++m) {
                const int row = u.pm * 256 + ai * 128 + wr * 64 + m * 16 + fr; float ss = 0.f;
#pragma unroll
                for (int bj = 0; bj < 2; ++bj) {
                    const size_t off = (size_t)row * D + u.pn * 256 + bj * 128 + wc * 32 + 8 * fq;
                    const f32x4 b0 = *(const f32x4*)(base + off), b1 = *(const f32x4*)(base + off + 4);
                    const f32x4 v0 = b0 + acc[ai][bj][m][0] * alpha, v1 = b1 + acc[ai][bj][m][1] * alpha;
                    *(f32x4*)(H + off) = v0; *(f32x4*)(H + off + 4) = v1;
                    u32x4 w; w.x = cvt_pk_bf16(v0[0], v0[1]); w.y = cvt_pk_bf16(v0[2], v0[3]); w.z = cvt_pk_bf16(v1[0], v1[1]); w.w = cvt_pk_bf16(v1[2], v1[3]);
                    *(u32x4*)(HB + off) = w;
                    ss += (v0[0] * v0[0] + v0[1] * v0[1]) + (v0[2] * v0[2] + v0[3] * v0[3]) + (v1[0] * v1[0] + v1[1] * v1[1]) + (v1[2] * v1[2] + v1[3] * v1[3]);
                }
                ss += __shfl_xor(ss, 16); ss += __shfl_xor(ss, 32);
                if (fq == 0) SS[(size_t)row * 16 + u.pn * 4 + wc] = ss;
            }
    }
};
struct EpiRetIn {
    const float* SS; bf16_t* QH; bf16_t* KH; bf16_t* VT;
    __device__ __forceinline__ void operator()(const f32x4 (&acc)[2][2][4][2], const pg8::Unit& u, int wr, int wc, int fr, int fq) const {
        if (u.pn < 8) {
            const bool isq = u.pn < 4; const int head = u.pn & 3; bf16_t* dst = isq ? QH : KH;
            const float l2g = isq ? L2G[head] : -L2G[head], sc = isq ? 1.0f : 0.0625f;
            float inv[8];
#pragma unroll
            for (int e = 0; e < 8; ++e) inv[e] = ROPE_INV[wc * 32 + 8 * fq + e];
#pragma unroll
            for (int ai = 0; ai < 2; ++ai)
#pragma unroll
                for (int m = 0; m < 4; ++m) {
                    const int row = u.pm * 256 + ai * 128 + wr * 64 + m * 16 + fr; const float rs = row_rstd(SS, row);
                    const int b = row >> 13, t = row & 8191; const float pos = (float)(t + NMETA);
                    const float dec = __builtin_amdgcn_exp2f((float)((t & 63) + 1) * l2g) * sc * rs;
                    float o1[8], o2[8];
#pragma unroll
                    for (int n = 0; n < 2; ++n)
#pragma unroll
                        for (int j = 0; j < 4; ++j) { const int e = 4 * n + j;
                            const float rev = (pos * inv[e]) * 0.15915494309189535f; const float frc = rev - floorf(rev);
                            const float sn = __builtin_amdgcn_sinf(frc), cs = __builtin_amdgcn_cosf(frc);
                            const float t1 = acc[ai][0][m][n][j], t2 = acc[ai][1][m][n][j];
                            o1[e] = (t1 * cs - t2 * sn) * dec; o2[e] = (t1 * sn + t2 * cs) * dec; }
                    bf16_t* p = dst + ((size_t)(b * 4 + head) * SEQ + t) * 256 + wc * 32 + 8 * fq;
                    u32x4 w; w.x = cvt_pk_bf16(o1[0], o1[1]); w.y = cvt_pk_bf16(o1[2], o1[3]); w.z = cvt_pk_bf16(o1[4], o1[5]); w.w = cvt_pk_bf16(o1[6], o1[7]);
                    *(u32x4*)p = w;
                    w.x = cvt_pk_bf16(o2[0], o2[1]); w.y = cvt_pk_bf16(o2[2], o2[3]); w.z = cvt_pk_bf16(o2[4], o2[5]); w.w = cvt_pk_bf16(o2[6], o2[7]);
                    *(u32x4*)(p + 128) = w;
                }
        } else {
            float rs[2][8];
#pragma unroll
            for (int bj = 0; bj < 2; ++bj)
#pragma unroll
                for (int e = 0; e < 8; ++e) rs[bj][e] = row_rstd(SS, u.pm * 256 + bj * 128 + wc * 32 + 8 * fq + e);
            const int b = u.pm >> 5, t0 = (u.pm & 31) * 256;
#pragma unroll
            for (int ai = 0; ai < 2; ++ai)
#pragma unroll
                for (int m = 0; m < 4; ++m) {
                    const int vc = (u.pn - 8) * 256 + ai * 128 + wr * 64 + m * 16 + fr; const int head = vc >> 9, dvi = vc & 511;
                    bf16_t* p = VT + ((size_t)(b * 4 + head) * 512 + dvi) * SEQ + t0 + wc * 32 + 8 * fq;
#pragma unroll
                    for (int bj = 0; bj < 2; ++bj) {
                        const f32x4 v0 = acc[ai][bj][m][0], v1 = acc[ai][bj][m][1];
                        u32x4 w; w.x = cvt_pk_bf16(v0[0] * rs[bj][0], v0[1] * rs[bj][1]); w.y = cvt_pk_bf16(v0[2] * rs[bj][2], v0[3] * rs[bj][3]);
                        w.z = cvt_pk_bf16(v1[0] * rs[bj][4], v1[1] * rs[bj][5]); w.w = cvt_pk_bf16(v1[2] * rs[bj][6], v1[3] * rs[bj][7]);
                        *(u32x4*)(p + bj * 128) = w;
                    }
                }
        }
    }
};
template <int DV, int LDO> struct EpiGate {
    const float* SS; const float* OSS; bf16_t* O;
    __device__ __forceinline__ void operator()(const f32x4 (&acc)[2][2][4][2], const pg8::Unit& u, int wr, int wc, int fr, int fq) const {
#pragma unroll
        for (int ai = 0; ai < 2; ++ai)
#pragma unroll
            for (int m = 0; m < 4; ++m) {
                const int row = u.pm * 256 + ai * 128 + wr * 64 + m * 16 + fr; const float rs = row_rstd(SS, row);
#pragma unroll
                for (int bj = 0; bj < 2; ++bj) {
                    const int col = u.pn * 256 + bj * 128 + wc * 32 + 8 * fq; const int head = col / DV;
                    const float ro = 1.0f / sqrtf(OSS[(size_t)row * 4 + head] * (1.0f / (float)DV) + 1e-6f);
                    bf16_t* p = O + (size_t)row * LDO + col; const u32x4 ov = *(const u32x4*)p;
                    const f32x4 g0 = acc[ai][bj][m][0] * rs, g1 = acc[ai][bj][m][1] * rs;
                    u32x4 w;
                    w.x = cvt_pk_bf16(bf_lo(ov.x) * ro * fsilu(g0[0]), bf_hi(ov.x) * ro * fsilu(g0[1]));
                    w.y = cvt_pk_bf16(bf_lo(ov.y) * ro * fsilu(g0[2]), bf_hi(ov.y) * ro * fsilu(g0[3]));
                    w.z = cvt_pk_bf16(bf_lo(ov.z) * ro * fsilu(g1[0]), bf_hi(ov.z) * ro * fsilu(g1[1]));
                    w.w = cvt_pk_bf16(bf_lo(ov.w) * ro * fsilu(g1[2]), bf_hi(ov.w) * ro * fsilu(g1[3]));
                    *(u32x4*)p = w;
                }
            }
    }
};
struct EpiGlaIn {
    const float* SS; const float* BC; bf16_t* QH; bf16_t* KH; bf16_t* VT;
    __device__ __forceinline__ void operator()(const f32x4 (&acc)[2][2][4][2], const pg8::Unit& u, int wr, int wc, int fr, int fq) const {
        if (u.pn < 4) {
            const bool isq = u.pn < 2; bf16_t* dst = isq ? QH : KH;
#pragma unroll
            for (int ai = 0; ai < 2; ++ai)
#pragma unroll
                for (int m = 0; m < 4; ++m) {
                    const int row = u.pm * 256 + ai * 128 + wr * 64 + m * 16 + fr; const float rs = row_rstd(SS, row) * (isq ? 0.08838834764831845f : 1.0f);
                    const int b = row >> 13, t = row & 8191;
#pragma unroll
                    for (int bj = 0; bj < 2; ++bj) {
                        const int cq = (u.pn & 1) * 256 + bj * 128 + wc * 32 + 8 * fq; const int head = cq >> 7, d = cq & 127;
                        const f32x4 c0 = *(const f32x4*)(BC + (size_t)row * 512 + cq), c1 = *(const f32x4*)(BC + (size_t)row * 512 + cq + 4);
                        float v[8];
#pragma unroll
                        for (int j = 0; j < 4; ++j) { v[j] = acc[ai][bj][m][0][j] * rs * __expf(isq ? c0[j] : -c0[j]); v[4 + j] = acc[ai][bj][m][1][j] * rs * __expf(isq ? c1[j] : -c1[j]); }
                        u32x4 w; w.x = cvt_pk_bf16(v[0], v[1]); w.y = cvt_pk_bf16(v[2], v[3]); w.z = cvt_pk_bf16(v[4], v[5]); w.w = cvt_pk_bf16(v[6], v[7]);
                        *(u32x4*)(dst + ((size_t)(b * 4 + head) * SEQ + t) * 128 + d) = w;
                    }
                }
        } else {
            float rs[2][8];
#pragma unroll
            for (int bj = 0; bj < 2; ++bj)
#pragma unroll
                for (int e = 0; e < 8; ++e) rs[bj][e] = row_rstd(SS, u.pm * 256 + bj * 128 + wc * 32 + 8 * fq + e);
            const int b = u.pm >> 5, t0 = (u.pm & 31) * 256; const int head = u.pn - 4;
#pragma unroll
            for (int ai = 0; ai < 2; ++ai)
#pragma unroll
                for (int m = 0; m < 4; ++m) {
                    const int dvi = ai * 128 + wr * 64 + m * 16 + fr;
                    bf16_t* p = VT + ((size_t)(b * 4 + head) * 256 + dvi) * SEQ + t0 + wc * 32 + 8 * fq;
#pragma unroll
                    for (int bj = 0; bj < 2; ++bj) {
                        const f32x4 v0 = acc[ai][bj][m][0], v1 = acc[ai][bj][m][1];
                        u32x4 w; w.x = cvt_pk_bf16(v0[0] * rs[bj][0], v0[1] * rs[bj][1]); w.y = cvt_pk_bf16(v0[2] * rs[bj][2], v0[3] * rs[bj][3]);
                        w.z = cvt_pk_bf16(v1[0] * rs[bj][4], v1[1] * rs[bj][5]); w.w = cvt_pk_bf16(v1[2] * rs[bj][6], v1[3] * rs[bj][7]);
                        *(u32x4*)(p + bj * 128) = w;
                    }
                }
        }
    }
};
struct PtrNormal { const char* A; const char* B; size_t tstep;
    __device__ __forceinline__ void ptrs(const pg8::Unit& u, const char*& cA, const char*& cB) const { cA = A + (size_t)u.pm * tstep; cB = B + (size_t)u.pn * tstep; } };
struct PtrSwapFrom { const char* A; const char* B; size_t tstep; int pn_swap;
    __device__ __forceinline__ void ptrs(const pg8::Unit& u, const char*& cA, const char*& cB) const {
        const char* a = A + (size_t)u.pm * tstep; const char* b = B + (size_t)u.pn * tstep;
        if (u.pn >= pn_swap) { cA = b; cB = a; } else { cA = a; cB = b; } } };

constexpr int MA_RS_OFF = 98304, MA_RED_OFF = 100352;
template <int MODE> __device__ __forceinline__ void meta_tiles(Frame& F, const bf16_t* Bt, int N, int K, float* out, int ldo, float alpha) {
    const int lane = F.lane, g = lane >> 4, r16 = lane & 15, pitch = K + 8;
    const LAS bf16_t* A = (const LAS bf16_t*)F.lds; const LAS float* rsA = (const LAS float*)(F.lds + MA_RS_OFF); LAS f32x4* red = (LAS f32x4*)(F.lds + MA_RED_OFF);
    const int ksteps = K / 32, per = ksteps / 8;
    for (int tile = blockIdx.x; tile < N / 16; tile += F.G) {
        f32x4 acc = (f32x4){0.f, 0.f, 0.f, 0.f};
        const bf16_t* bp = Bt + (size_t)(tile * 16 + r16) * K + 8 * g;
        for (int ks = F.wave * per; ks < (F.wave + 1) * per; ++ks) {
            const bf16x8 a = *(const LAS bf16x8*)(A + r16 * pitch + ks * 32 + 8 * g);
            const bf16x8 b = *(const bf16x8*)(bp + ks * 32);
            acc = __builtin_amdgcn_mfma_f32_16x16x32_bf16(a, b, acc, 0, 0, 0);
        }
        red[F.wave * 64 + lane] = acc;
        __syncthreads();
        if (F.wave == 0) {
            f32x4 s = red[lane];
#pragma unroll
            for (int w = 1; w < 8; ++w) s += red[w * 64 + lane];
#pragma unroll
            for (int j = 0; j < 4; ++j) { const int r = 4 * g + j; float* o = out + (size_t)r * ldo + tile * 16 + r16;
                if (MODE == 0) *o = s[j] * rsA[r]; else *o = *o + alpha * s[j]; }
        }
        __syncthreads();
    }
}
__device__ __forceinline__ bool meta_has_tiles(Frame& F, int N) { return (int)blockIdx.x < N / 16; }
__device__ __forceinline__ void meta_prep_h(Frame& F) {
    const float* HM = WSP(float, WS_META + META_HM); LAS bf16_t* A = (LAS bf16_t*)F.lds; LAS float* rsA = (LAS float*)(F.lds + MA_RS_OFF);
    for (int r = F.wave; r < 16; r += 8) { float s = 0.f;
        for (int k = F.lane; k < D; k += 64) { const float v = HM[r * D + k]; s += v * v; A[r * (D + 8) + k] = f2bf(v); }
        s = wave_sum(s); if (F.lane == 0) rsA[r] = 1.0f / sqrtf(s * (1.0f / 1024.0f) + 1e-6f); }
    __syncthreads();
}
__device__ __forceinline__ void meta_prep_act(Frame& F) {
    const float* RAW = WSP(float, WS_META + META_RAW); LAS bf16_t* A = (LAS bf16_t*)F.lds; LAS float* rsA = (LAS float*)(F.lds + MA_RS_OFF);
    for (int i = F.tid; i < 16 * DFF; i += NTHREADS) { const int r = i / DFF, k = i % DFF, u = k >> 7, j = k & 127;
        const float g = RAW[r * 5632 + u * 256 + j], up = RAW[r * 5632 + u * 256 + 128 + j]; A[r * (DFF + 8) + k] = f2bf(fsilu(g) * up); }
    if (F.tid < 16) rsA[F.tid] = 1.f;
    __syncthreads();
}
__device__ __forceinline__ void meta_prep_y(Frame& F) {
    const float* RAW = WSP(float, WS_META + META_RAW); const float* MO = WSP(float, WS_META + META_MO); const float* MOSS = WSP(float, WS_CTL + CTL_MOSS);
    LAS bf16_t* A = (LAS bf16_t*)F.lds; LAS float* rsA = (LAS float*)(F.lds + MA_RS_OFF);
    for (int i = F.tid; i < 16 * 2048; i += NTHREADS) { const int r = i >> 11, k = i & 2047, head = k >> 9;
        const float ro = 1.0f / sqrtf(MOSS[r * 4 + head] * (1.0f / 512.0f) + 1e-6f);
        A[r * (2048 + 8) + k] = f2bf(MO[r * 2048 + k] * ro * fsilu(RAW[r * 6144 + 4096 + k])); }
    if (F.tid < 16) rsA[F.tid] = 1.f;
    __syncthreads();
}
__device__ __forceinline__ void z_phase(Frame& F, const bf16_t* HB, const float* SS, const bf16_t* WZ, const float* wg, const float* bg, float* BC) {
    LAS float* zpart = (LAS float*)F.lds;
    LAS float* zs = (LAS float*)(F.lds + 8192);
    const int lane = F.lane, g = lane >> 4, r16 = lane & 15;
    for (int cidx = blockIdx.x; cidx < M / 64; cidx += F.G) {
        const int row0 = cidx * 64;
        { const int tile = F.wave & 3, kh = F.wave >> 2; f32x4 acc = (f32x4){0.f, 0.f, 0.f, 0.f};
          const bf16_t* ap = HB + (size_t)(row0 + tile * 16 + r16) * D + 8 * g; const bf16_t* bp = WZ + (size_t)r16 * D + 8 * g;
#pragma unroll 4
          for (int ks = kh * 16; ks < kh * 16 + 16; ++ks) {
              const bf16x8 a = *(const bf16x8*)(ap + ks * 32), b = *(const bf16x8*)(bp + ks * 32);
              acc = __builtin_amdgcn_mfma_f32_16x16x32_bf16(a, b, acc, 0, 0, 0);
          }
#pragma unroll
          for (int j = 0; j < 4; ++j) zpart[(kh * 64 + tile * 16 + 4 * g + j) * 16 + r16] = acc[j]; }
        __syncthreads();
        for (int i = F.tid; i < 64 * 16; i += NTHREADS) { const int t = i >> 4; zs[i] = (zpart[i] + zpart[1024 + i]) * row_rstd(SS, row0 + t); }
        __syncthreads();
        { const int c = F.tid; float w[16];
#pragma unroll
          for (int r = 0; r < 16; ++r) w[r] = wg[r * 512 + c];
          const float bias = bg[c]; float cum = 0.f;
          for (int t = 0; t < 64; ++t) { float a = bias;
#pragma unroll
              for (int r = 0; r < 16; ++r) a += zs[t * 16 + r] * w[r];
              const float ls = fminf(a, 0.f) - __logf(1.0f + __expf(-fabsf(a)));
              cum += ls * 0.0625f; BC[(size_t)(row0 + t) * 512 + c] = cum; } }
        __syncthreads();
    }
}

typedef short v4i16_t __attribute__((ext_vector_type(4)));
__device__ __forceinline__ s16x4 ds_tr(unsigned addr) { return __builtin_bit_cast(s16x4, __builtin_amdgcn_ds_read_tr16_b64_v4i16((LAS v4i16_t*)addr)); }
template <int DK, int DV, bool GLA>
__device__ __forceinline__ void s2_phase(Frame& F, const bf16_t* QH, const bf16_t* KH, const bf16_t* VT, bf16_t* O, float* OSS, const float* BC, int ldraw) {
    constexpr int NS = DV / 16, ROWB = DK * 2, TILEB = 64 * ROWB, NI = TILEB / 1024 / 8, NT = DK / 128, LDO = 4 * DV;
    constexpr int LQ = 0, LK = 2 * TILEB, LV = 4 * TILEB, LP = LV + 4096, LS = LP + 8192, LDEC = LS + 2 * 16 * ROWB;
    static_assert(LDEC + DK * 4 <= LDS_MISC, "S2 LDS map");
    const int unit = blockIdx.x; if (unit >= 8 * NS) return;
    const int bh = unit & 7, s = unit >> 3, b = bh >> 2, h = bh & 3;
    const int lane = F.lane, g = lane >> 4, r16 = lane & 15, w = F.wave;
    LAS unsigned char* L = F.lds; const unsigned Lb = (unsigned)(uintptr_t)L;
    const float* RAW = WSP(float, WS_META + META_RAW);
    for (int i = F.tid * 16; i < TILEB; i += NTHREADS * 16) { *(LAS u32x4*)(L + LQ + i) = (u32x4){0, 0, 0, 0}; *(LAS u32x4*)(L + LK + i) = (u32x4){0, 0, 0, 0}; }
    for (int i = F.tid * 16; i < 2048; i += NTHREADS * 16) *(LAS u32x4*)(L + LV + i) = (u32x4){0, 0, 0, 0};
    for (int i = F.tid * 16; i < 16 * ROWB; i += NTHREADS * 16) *(LAS u32x4*)(L + LS + i) = (u32x4){0, 0, 0, 0};
    __syncthreads();
    if (!GLA) {
        for (int idx = F.tid; idx < 16 * 128; idx += NTHREADS) { const int j = idx >> 7, c = idx & 127, row = 48 + j;
            const float* rq = RAW + (size_t)j * ldraw + h * 256; const float* rk = rq + 1024;
            const float rev = ((float)j * ROPE_INV[c]) * 0.15915494309189535f; const float frc = rev - floorf(rev);
            const float sn = __builtin_amdgcn_sinf(frc), cs = __builtin_amdgcn_cosf(frc);
            const float dq = __builtin_amdgcn_exp2f((float)(row + 1) * L2G[h]), dk = 0.0625f * __builtin_amdgcn_exp2f(-(float)(row + 1) * L2G[h]);
            const float q1 = rq[c], q2 = rq[c + 128], k1 = rk[c], k2 = rk[c + 128];
            const int a1 = row * ROWB + ((((c >> 3)) ^ (row & 15)) << 4) + (c & 7) * 2, a2 = row * ROWB + ((((c + 128) >> 3) ^ (row & 15)) << 4) + (c & 7) * 2;
            *(LAS bf16_t*)(L + LQ + a1) = f2bf((q1 * cs - q2 * sn) * dq); *(LAS bf16_t*)(L + LQ + a2) = f2bf((q1 * sn + q2 * cs) * dq);
            *(LAS bf16_t*)(L + LK + a1) = f2bf((k1 * cs - k2 * sn) * dk); *(LAS bf16_t*)(L + LK + a2) = f2bf((k1 * sn + k2 * cs) * dk); }
        if (F.tid < 256) { const int j = F.tid >> 4, wv = F.tid & 15, tok = 48 + j;
            *(LAS bf16_t*)(L + LV + wv * 128 + (((tok >> 3) ^ ((wv >> 1) & 7)) << 4) + (tok & 7) * 2) = f2bf(RAW[(size_t)j * ldraw + 2048 + h * 512 + 16 * s + wv]); }
    } else {
        if (F.tid < 128) { const int d = F.tid; const float* wgp = F.in[13] + h * 128 + d; const float bias = F.in[14][h * 128 + d]; float cum = 0.f;
            for (int j = 0; j < 16; ++j) { float a = bias;
                for (int r = 0; r < 16; ++r) a += RAW[(size_t)j * ldraw + 3072 + r] * wgp[r * 512];
                cum += (fminf(a, 0.f) - __logf(1.0f + __expf(-fabsf(a)))) * 0.0625f;
                const int row = 48 + j;
                *(LAS bf16_t*)(L + LK + row * ROWB + (((d >> 3) ^ (row & 15)) << 4) + (d & 7) * 2) = f2bf(RAW[(size_t)j * ldraw + 512 + h * 128 + d] * __expf(-cum)); }
            *(LAS float*)(L + LDEC + d * 4) = __expf(cum); }
        if (F.tid >= 256) { const int j = (F.tid - 256) >> 4, wv = F.tid & 15, tok = 48 + j;
            *(LAS bf16_t*)(L + LV + wv * 128 + (((tok >> 3) ^ ((wv >> 1) & 7)) << 4) + (tok & 7) * 2) = f2bf(RAW[(size_t)j * ldraw + 1024 + h * 256 + 16 * s + wv]); }
    }
    f32x4 S[NT];
#pragma unroll
    for (int tt = 0; tt < NT; ++tt) S[tt] = (f32x4){0.f, 0.f, 0.f, 0.f};
    const float g64 = GLA ? 1.0f : __builtin_amdgcn_exp2f(64.0f * L2G[h]);
    const char* Qg = (const char*)(QH + (size_t)bh * SEQ * DK); const char* Kg = (const char*)(KH + (size_t)bh * SEQ * DK);
    const char* Vg = (const char*)(VT + ((size_t)bh * DV + 16 * s) * SEQ);
    __syncthreads();
    for (int c = 0; c <= 128; ++c) {
        const int buf = c & 1;
        if (c < 128) {
            const char* qc = Qg + (size_t)c * TILEB; const char* kc = Kg + (size_t)c * TILEB;
#pragma unroll
            for (int i = 0; i < NI; ++i) { const int piece = w * NI + i, off = piece * 1024 + lane * 16, row = off / ROWB, p = (off % ROWB) >> 4; const int so = row * ROWB + ((p ^ (row & 15)) << 4);
                __builtin_amdgcn_global_load_lds((const unsigned*)(qc + so), (LAS unsigned*)(L + LQ + (buf ^ 1) * TILEB + piece * 1024), 16, 0, 0);
                __builtin_amdgcn_global_load_lds((const unsigned*)(kc + so), (LAS unsigned*)(L + LK + (buf ^ 1) * TILEB + piece * 1024), 16, 0, 0); }
            if (w < 2) { const int off = w * 1024 + lane * 16, wv = off >> 7, p = (off & 127) >> 4;
                __builtin_amdgcn_global_load_lds((const unsigned*)(Vg + (size_t)wv * SEQ * 2 + (size_t)c * 128 + ((p ^ ((wv >> 1) & 7)) << 4)), (LAS unsigned*)(L + LV + (buf ^ 1) * 2048 + w * 1024), 16, 0, 0); }
        }
        if (GLA && c >= 1 && F.tid < DK) *(LAS float*)(L + LDEC + F.tid * 4) = __expf(BC[(size_t)(b * SEQ + (c - 1) * 64 + 63) * 512 + h * 128 + F.tid]);
        { const int ti = w >> 1, tj0 = 2 * (w & 1); f32x4 pt0 = (f32x4){0.f, 0.f, 0.f, 0.f}, pt1 = pt0;
          const int qrow = 16 * ti + r16, kr0 = 16 * tj0 + r16, kr1 = kr0 + 16;
          const LAS unsigned char* qb = L + LQ + buf * TILEB + qrow * ROWB; const LAS unsigned char* kb0 = L + LK + buf * TILEB + kr0 * ROWB; const LAS unsigned char* kb1 = L + LK + buf * TILEB + kr1 * ROWB;
#pragma unroll
          for (int ks = 0; ks < DK / 32; ++ks) { const int ch = ((4 * ks + g) ^ r16) << 4;
              const bf16x8 qf = *(const LAS bf16x8*)(qb + ch), k0 = *(const LAS bf16x8*)(kb0 + ch), k1 = *(const LAS bf16x8*)(kb1 + ch);
              pt0 = __builtin_amdgcn_mfma_f32_16x16x32_bf16(k0, qf, pt0, 0, 0, 0); pt1 = __builtin_amdgcn_mfma_f32_16x16x32_bf16(k1, qf, pt1, 0, 0, 0); }
          const int i = qrow;
#pragma unroll
          for (int tjj = 0; tjj < 2; ++tjj) { const f32x4 pt = tjj ? pt1 : pt0; const int tj = tj0 + tjj, j0 = 16 * tj + 4 * g;
              const float v0 = (j0 + 0 <= i) ? pt[0] : 0.f, v1 = (j0 + 1 <= i) ? pt[1] : 0.f, v2 = (j0 + 2 <= i) ? pt[2] : 0.f, v3 = (j0 + 3 <= i) ? pt[3] : 0.f;
              u32x2 pk; pk.x = cvt_pk_bf16(v0, v1); pk.y = cvt_pk_bf16(v2, v3);
              *(LAS u32x2*)(L + LP + i * 128 + (((2 * tj + (g >> 1)) ^ ((i >> 1) & 7)) << 4) + (g & 1) * 8) = pk; } }
        __syncthreads();
        if (w < 4) { const int irow = 16 * w + r16; f32x4 ot = (f32x4){0.f, 0.f, 0.f, 0.f};
#pragma unroll
            for (int ks = 0; ks < 2; ++ks) {
                const bf16x8 va = *(const LAS bf16x8*)(L + LV + buf * 2048 + r16 * 128 + (((4 * ks + g) ^ ((r16 >> 1) & 7)) << 4));
                const bf16x8 pb = *(const LAS bf16x8*)(L + LP + irow * 128 + (((4 * ks + g) ^ ((irow >> 1) & 7)) << 4));
                ot = __builtin_amdgcn_mfma_f32_16x16x32_bf16(va, pb, ot, 0, 0, 0); }
#pragma unroll
            for (int ks = 0; ks < DK / 32; ++ks) { const int ch = ((4 * ks + g) ^ r16) << 4;
                const bf16x8 sa = *(const LAS bf16x8*)(L + LS + buf * 16 * ROWB + r16 * ROWB + ch);
                const bf16x8 qb = *(const LAS bf16x8*)(L + LQ + buf * TILEB + irow * ROWB + ch);
                ot = __builtin_amdgcn_mfma_f32_16x16x32_bf16(sa, qb, ot, 0, 0, 0); }
            float ss = (ot[0] * ot[0] + ot[1] * ot[1]) + (ot[2] * ot[2] + ot[3] * ot[3]);
            ss += __shfl_xor(ss, 16); ss += __shfl_xor(ss, 32);
            if (c >= 1) { const size_t grow = (size_t)b * SEQ + (c - 1) * 64 + irow;
                u32x2 pk; pk.x = cvt_pk_bf16(ot[0], ot[1]); pk.y = cvt_pk_bf16(ot[2], ot[3]);
                *(u32x2*)(O + grow * LDO + h * DV + 16 * s + 4 * g) = pk;
                if (g == 0) atomicAdd(OSS + grow * 4 + h, ss);
            } else if (!GLA && b == 0 && irow >= 48) { float* MO = WSP(float, WS_META + META_MO); float* MOSS = WSP(float, WS_CTL + CTL_MOSS);
                *(f32x4*)(MO + (size_t)(irow - 48) * 2048 + h * 512 + 16 * s + 4 * g) = ot;
                if (g == 0) atomicAdd(MOSS + (irow - 48) * 4 + h, ss); } }
        {
#pragma unroll
          for (int ks = 0; ks < 2; ++ks) {
              const bf16x8 vb = *(const LAS bf16x8*)(L + LV + buf * 2048 + r16 * 128 + (((4 * ks + g) ^ ((r16 >> 1) & 7)) << 4));
#pragma unroll
              for (int tt = 0; tt < NT; ++tt) { const int d0 = 16 * (w + 8 * tt), dcol = d0 + 4 * (r16 & 3), chunk = dcol >> 3, sub = (dcol & 7) * 2;
                  const int r1 = 32 * ks + 8 * g + (r16 >> 2), r2 = r1 + 4;
                  const s16x4 lo = ds_tr(Lb + LK + buf * TILEB + r1 * ROWB + ((chunk ^ (r1 & 15)) << 4) + sub);
                  const s16x4 hi = ds_tr(Lb + LK + buf * TILEB + r2 * ROWB + ((chunk ^ (r2 & 15)) << 4) + sub);
                  const bf16x8 ka = (bf16x8){lo[0], lo[1], lo[2], lo[3], hi[0], hi[1], hi[2], hi[3]};
                  S[tt] = __builtin_amdgcn_mfma_f32_16x16x32_bf16(ka, vb, S[tt], 0, 0, 0); } }
#pragma unroll
          for (int tt = 0; tt < NT; ++tt) { const int tile = w + 8 * tt;
              if (GLA) { const f32x4 dc = *(const LAS f32x4*)(L + LDEC + (16 * tile + 4 * g) * 4); S[tt] = S[tt] * dc; } else S[tt] = S[tt] * g64;
              u32x2 pk; pk.x = cvt_pk_bf16(S[tt][0], S[tt][1]); pk.y = cvt_pk_bf16(S[tt][2], S[tt][3]);
              *(LAS u32x2*)(L + LS + (buf ^ 1) * 16 * ROWB + r16 * ROWB + (((2 * tile + (g >> 1)) ^ r16) << 4) + (g & 1) * 8) = pk; } }
        __syncthreads();
    }
}

__device__ __forceinline__ void final_phase(Frame& F, const float* SS, const float* gain) {
    const int gw = F.vcu * NWAVES + F.wave, NGW = F.G * NWAVES;
    f32x4 gv[4];
#pragma unroll
    for (int j = 0; j < 4; ++j) gv[j] = *(const f32x4*)(gain + 4 * F.lane + 256 * j);
    for (int m = gw; m < M; m += NGW) { float* row = F.out + (size_t)m * D; const float rs = row_rstd(SS, m);
#pragma unroll
        for (int j = 0; j < 4; ++j) { f32x4 v = *(const f32x4*)(row + 4 * F.lane + 256 * j); v = v * rs * gv[j]; *(f32x4*)(row + 4 * F.lane + 256 * j) = v; } }
}
__device__ __forceinline__ void p0_rows(Frame& F) {
    const int gw = F.vcu * NWAVES + F.wave, NGW = F.G * NWAVES; const float* x = F.in[0]; bf16_t* HB = WSP(bf16_t, WS_HB); float* SS = WSP(float, WS_SS);
    for (int m = gw; m < M; m += NGW) { const float* xr = x + (size_t)m * D; float s = 0.f;
#pragma unroll
        for (int j = 0; j < 4; ++j) { const f32x4 v = *(const f32x4*)(xr + 4 * F.lane + 256 * j); s += (v[0] * v[0] + v[1] * v[1]) + (v[2] * v[2] + v[3] * v[3]);
            u32x2 pk; pk.x = cvt_pk_bf16(v[0], v[1]); pk.y = cvt_pk_bf16(v[2], v[3]); *(u32x2*)(HB + (size_t)m * D + 4 * F.lane + 256 * j) = pk; }
        s = wave_sum(s);
        if (F.lane < 16) SS[(size_t)m * 16 + F.lane] = F.lane == 0 ? s : 0.f; }
    if (blockIdx.x == 0) { float* HM = WSP(float, WS_META + META_HM); for (int i = F.tid; i < 16 * D; i += NTHREADS) HM[i] = F.in[1][i]; }
}

struct Args { const float* in[18]; float* out; unsigned char* ws; int ph_lo, ph_hi; };
constexpr int N_PHASES = 19;
__global__ void __launch_bounds__(NTHREADS, 2) fwd(Args args) {
    extern __shared__ __attribute__((aligned(16))) unsigned char lds_raw[];
    Frame F;
    F.lds = (LAS unsigned char*)lds_raw;
    F.tid = threadIdx.x; F.lane = F.tid & 63; F.wave = __builtin_amdgcn_readfirstlane(F.tid >> 6);
    F.G = gridDim.x; { const int bx = blockIdx.x; F.vcu = (F.G % 8 == 0) ? (bx % 8) * (F.G / 8) + bx / 8 : bx; }
    F.ws = args.ws; F.out = args.out;
#pragma unroll
    for (int i = 0; i < 18; ++i) F.in[i] = args.in[i];
    volatile LAS unsigned* MISC = (volatile LAS unsigned*)(F.lds + LDS_MISC);
    if (F.tid < 64) MISC[F.tid] = 0u;
    __syncthreads();
    XcdBarrier bar = xcd_barrier_post(WSP(unsigned, WS_CTL) + CW_BAR, MISC + 8);
    const int lo = args.ph_lo, hi = args.ph_hi;
#define IN(k) (lo <= (k) && (k) < hi)
#define SEAM(k) do { if (IN(k) && IN((k) + 1)) xcd_barrier(bar); } while (0)
    bf16_t* HB = WSP(bf16_t, WS_HB); float* SS = WSP(float, WS_SS); float* H = F.out;
    bf16_t* ACT = WSP(bf16_t, WS_ACT);
    const int gw = F.vcu * NWAVES + F.wave, NGW = F.G * NWAVES;
    float* RAW = WSP(float, WS_META + META_RAW); float* HM = WSP(float, WS_META + META_HM);

#define FFN_IN(slot, do_meta) do { \
        if ((do_meta) && meta_has_tiles(F, 2 * DFF)) { meta_prep_h(F); meta_tiles<0>(F, WSP(bf16_t, (slot) + WF_IN), 2 * DFF, D, RAW, 2 * DFF, 1.f); } \
        pg8::Order S_; S_.init(M / 256, 22, F.G, (int)blockIdx.x); PtrNormal P_{(const char*)HB, (const char*)WSP(bf16_t, (slot) + WF_IN), (size_t)256 * D * 2}; \
        EpiSwiglu E_{SS, ACT}; pg8::gemm_phase(F.lds, D, S_, P_, E_); } while (0)
#define FFN_OUT(slot, do_meta, basep) do { \
        if ((do_meta) && meta_has_tiles(F, D)) { meta_prep_act(F); meta_tiles<1>(F, WSP(bf16_t, (slot) + WF_OUT), D, DFF, HM, D, 0.5f); } \
        pg8::Order S_; S_.init(M / 256, 4, F.G, (int)blockIdx.x); PtrNormal P_{(const char*)ACT, (const char*)WSP(bf16_t, (slot) + WF_OUT), (size_t)256 * DFF * 2}; \
        EpiResid E_{(basep), H, HB, SS, 0.5f}; pg8::gemm_phase(F.lds, DFF, S_, P_, E_); } while (0)

    if (IN(0)) {
        ConvJob jobs[4]; jobs[0] = job_ffn_in(F, 0, 0, WS_WFFN_A); jobs[1] = job_ffn_out(F, 0, 0, WS_WFFN_A);
        jobs[2].W = F.in[9]; jobs[2].ldn = 6144; jobs[2].K = D; jobs[2].N = 6144; jobs[2].col0 = 0; jobs[2].kind = 0; jobs[2].gain = F.in[5]; jobs[2].WT = WSP(bf16_t, WS_WMIX + WM_RET_IN);
        jobs[3].W = F.in[11]; jobs[3].ldn = D; jobs[3].K = 2048; jobs[3].N = D; jobs[3].col0 = 0; jobs[3].kind = 0; jobs[3].gain = F.in[10]; jobs[3].WT = WSP(bf16_t, WS_WMIX + WM_RET_OUT);
        conv_jobs(F, jobs, 4, gw, NGW);
        p0_rows(F);
    }
    SEAM(0);
    if (IN(1)) FFN_IN(WS_WFFN_A, true);
    SEAM(1);
    if (IN(2)) FFN_OUT(WS_WFFN_A, true, F.in[0]);
    SEAM(2);
    if (IN(3)) {
        if (meta_has_tiles(F, 6144)) { meta_prep_h(F); meta_tiles<0>(F, WSP(bf16_t, WS_WMIX + WM_RET_IN), 6144, D, RAW, 6144, 1.f); }
        pg8::Order S_; S_.init(M / 256, 16, F.G, (int)blockIdx.x);
        PtrSwapFrom P_{(const char*)HB, (const char*)WSP(bf16_t, WS_WMIX + WM_RET_IN), (size_t)256 * D * 2, 8};
        EpiRetIn E_{SS, WSP(bf16_t, WS_QH), WSP(bf16_t, WS_KH), WSP(bf16_t, WS_VT)}; pg8::gemm_phase(F.lds, D, S_, P_, E_);
    }
    SEAM(3);
    if (IN(4)) s2_phase<256, 512, false>(F, WSP(bf16_t, WS_QH), WSP(bf16_t, WS_KH), WSP(bf16_t, WS_VT), WSP(bf16_t, WS_O), WSP(float, WS_CTL + CTL_OSS_RET), nullptr, 6144);
    SEAM(4);
    if (IN(5)) {
        ConvJob jobs[2]; jobs[0] = job_ffn_in(F, 0, 1, WS_WFFN_A); jobs[1] = job_ffn_out(F, 0, 1, WS_WFFN_A); conv_jobs(F, jobs, 2, gw, NGW);
        __syncthreads();
        pg8::Order S_; S_.init(M / 256, 8, F.G, (int)blockIdx.x); PtrNormal P_{(const char*)HB, (const char*)(WSP(bf16_t, WS_WMIX + WM_RET_IN) + (size_t)4096 * D), (size_t)256 * D * 2};
        EpiGate<512, 2048> E_{SS, WSP(float, WS_CTL + CTL_OSS_RET), WSP(bf16_t, WS_O)}; pg8::gemm_phase(F.lds, D, S_, P_, E_);
    }
    SEAM(5);
    if (IN(6)) {
        if (meta_has_tiles(F, D)) { meta_prep_y(F); meta_tiles<1>(F, WSP(bf16_t, WS_WMIX + WM_RET_OUT), D, 2048, HM, D, 1.0f); }
        pg8::Order S_; S_.init(M / 256, 4, F.G, (int)blockIdx.x); PtrNormal P_{(const char*)WSP(bf16_t, WS_O), (const char*)WSP(bf16_t, WS_WMIX + WM_RET_OUT), (size_t)256 * 2048 * 2};
        EpiResid E_{H, H, HB, SS, 1.0f}; pg8::gemm_phase(F.lds, 2048, S_, P_, E_);
    }
    SEAM(6);
    if (IN(7)) {
        ConvJob jobs[4]; jobs[0] = job_ffn_in(F, 1, 0, WS_WFFN_B); jobs[1] = job_ffn_out(F, 1, 0, WS_WFFN_B);
        jobs[2].W = F.in[12]; jobs[2].ldn = 3088; jobs[2].K = D; jobs[2].N = 3072; jobs[2].col0 = 0; jobs[2].kind = 0; jobs[2].gain = F.in[5] + D; jobs[2].WT = WSP(bf16_t, WS_WMIX + WM_GLA_IN);
        jobs[3].W = F.in[16]; jobs[3].ldn = D; jobs[3].K = D; jobs[3].N = D; jobs[3].col0 = 0; jobs[3].kind = 0; jobs[3].gain = F.in[15]; jobs[3].WT = WSP(bf16_t, WS_WMIX + WM_GLA_OUT);
        conv_jobs(F, jobs, 4, gw, NGW);
        if (blockIdx.x == F.G - 1) { bf16_t* WZ = WSP(bf16_t, WS_WMIX + WM_GLA_Z); const float* W = F.in[12]; const float* gn = F.in[5] + D;
            for (int i = F.tid; i < 16 * D; i += NTHREADS) { const int k = i >> 4, r = i & 15; WZ[r * D + k] = f2bf(W[(size_t)k * 3088 + 3072 + r] * gn[k]); } }
        __syncthreads();
        FFN_IN(WS_WFFN_A, true);
    }
    SEAM(7);
    if (IN(8)) FFN_OUT(WS_WFFN_A, true, H);
    SEAM(8);
    if (IN(9)) {
        ConvJob jobs[2]; jobs[0] = job_ffn_in(F, 1, 1, WS_WFFN_A); jobs[1] = job_ffn_out(F, 1, 1, WS_WFFN_A); conv_jobs(F, jobs, 2, gw, NGW);
        __syncthreads();
        FFN_IN(WS_WFFN_B, true);
    }
    SEAM(9);
    if (IN(10)) FFN_OUT(WS_WFFN_B, true, H);
    SEAM(10);
    if (IN(11)) {
        if (meta_has_tiles(F, 2048)) { meta_prep_h(F); meta_tiles<0>(F, WSP(bf16_t, WS_WMIX + WM_GLA_IN), 2048, D, RAW, 3088, 1.f);
            if (blockIdx.x == 0) {   }
        }
        if (blockIdx.x == 0) { meta_tiles<0>(F, WSP(bf16_t, WS_WMIX + WM_GLA_Z), 16, D, RAW + 3072, 3088, 1.f); }
        __syncthreads();
        z_phase(F, HB, SS, WSP(bf16_t, WS_WMIX + WM_GLA_Z), F.in[13], F.in[14], WSP(float, WS_BC));
    }
    SEAM(11);
    if (IN(12)) {
        pg8::Order S_; S_.init(M / 256, 8, F.G, (int)blockIdx.x);
        PtrSwapFrom P_{(const char*)HB, (const char*)WSP(bf16_t, WS_WMIX + WM_GLA_IN), (size_t)256 * D * 2, 4};
        EpiGlaIn E_{SS, WSP(float, WS_BC), WSP(bf16_t, WS_QH2), WSP(bf16_t, WS_KH2), WSP(bf16_t, WS_VT2)}; pg8::gemm_phase(F.lds, D, S_, P_, E_);
    }
    SEAM(12);
    if (IN(13)) s2_phase<128, 256, true>(F, WSP(bf16_t, WS_QH2), WSP(bf16_t, WS_KH2), WSP(bf16_t, WS_VT2), WSP(bf16_t, WS_O2), WSP(float, WS_CTL + CTL_OSS_GLA), WSP(float, WS_BC), 3088);
    SEAM(13);
    if (IN(14)) {
        pg8::Order S_; S_.init(M / 256, 4, F.G, (int)blockIdx.x); PtrNormal P_{(const char*)HB, (const char*)WSP(bf16_t, WS_WMIX + WM_GLA_G), (size_t)256 * D * 2};
        EpiGate<256, 1024> E_{SS, WSP(float, WS_CTL + CTL_OSS_GLA), WSP(bf16_t, WS_O2)}; pg8::gemm_phase(F.lds, D, S_, P_, E_);
    }
    SEAM(14);
    if (IN(15)) {
        pg8::Order S_; S_.init(M / 256, 4, F.G, (int)blockIdx.x); PtrNormal P_{(const char*)WSP(bf16_t, WS_O2), (const char*)WSP(bf16_t, WS_WMIX + WM_GLA_OUT), (size_t)256 * D * 2};
        EpiResid E_{H, H, HB, SS, 1.0f}; pg8::gemm_phase(F.lds, D, S_, P_, E_);
    }
    SEAM(15);
    if (IN(16)) FFN_IN(WS_WFFN_A, false);
    SEAM(16);
    if (IN(17)) FFN_OUT(WS_WFFN_A, false, H);
    SEAM(17);
    if (IN(18)) final_phase(F, SS, F.in[17]);
#undef IN
#undef SEAM
#undef FFN_IN
#undef FFN_OUT
}
}
#ifndef MK_MODE
#define MK_MODE 0
#endif
#if MK_MODE == 2
namespace dbg {
__global__ void adapt(const float* Hreal, const float* HMtmp, float* Hn) {
    const size_t i = (size_t)blockIdx.x * blockDim.x + threadIdx.x;
    if (i >= (size_t)nv::ROWS * nv::D) return;
    const int d = (int)(i % nv::D); const size_t row = i / nv::D; const int b = (int)(row / nv::TT), s = (int)(row % nv::TT);
    Hn[i] = s < nv::NMETA ? HMtmp[s * nv::D + d] : Hreal[((size_t)b * nv::SEQ + (s - nv::NMETA)) * nv::D + d];
}
}
#endif
extern "C" void kernel_launch(void* const* d_in, const int* in_sizes, int n_in, void* d_out, int out_size, void* d_ws, size_t ws_size, hipStream_t stream) {
    static int grid = 0;
    if (grid == 0) {
        if (n_in != 18 || out_size != mk::M * mk::D || ws_size < mk::WS_NEED) { fprintf(stderr, "kernel_launch: unexpected sizes n_in %d out %d ws %zu\n", n_in, out_size, ws_size); grid = -1; return; }
        int dev = 0, cus = 0, per_cu = 0;
        if (hipGetDevice(&dev) != hipSuccess || hipDeviceGetAttribute(&cus, hipDeviceAttributeMultiprocessorCount, dev) != hipSuccess) { grid = -1; return; }
        if (hipFuncSetAttribute((const void*)mk::fwd, hipFuncAttributeMaxDynamicSharedMemorySize, mk::LDS_BYTES) != hipSuccess) { fprintf(stderr, "kernel_launch: hipFuncSetAttribute failed\n"); grid = -1; return; }
        if (hipOccupancyMaxActiveBlocksPerMultiprocessor(&per_cu, (const void*)mk::fwd, mk::NTHREADS, mk::LDS_BYTES) != hipSuccess || per_cu < 1) { fprintf(stderr, "kernel_launch: occupancy query says %d\n", per_cu); per_cu = 1; }
        (void)hipGetLastError();
        grid = cus;
        if (grid != 256) fprintf(stderr, "kernel_launch: %d CUs (built for 256)\n", grid);
    }
    if (grid < 0) return;
    (void)hipMemsetAsync((char*)d_ws + mk::WS_CTL, 0, mk::CTL_ZERO_BYTES, stream);
    mk::Args a{};
    for (int i = 0; i < 18; ++i) a.in[i] = (const float*)d_in[i];
    a.out = (float*)d_out; a.ws = (unsigned char*)d_ws;
#if MK_MODE == 0
    a.ph_lo = 0; a.ph_hi = mk::N_PHASES;
    hipLaunchKernelGGL(mk::fwd, dim3(grid), dim3(mk::NTHREADS), mk::LDS_BYTES, stream, a);
#elif MK_MODE == 1
    for (int p = 0; p < mk::N_PHASES; ++p) { a.ph_lo = p; a.ph_hi = p + 1; hipLaunchKernelGGL(mk::fwd, dim3(grid), dim3(mk::NTHREADS), mk::LDS_BYTES, stream, a); }
#else
    for (int p = 0; p < MK_CUT; ++p) { a.ph_lo = p; a.ph_hi = p + 1; hipLaunchKernelGGL(mk::fwd, dim3(grid), dim3(mk::NTHREADS), mk::LDS_BYTES, stream, a); }
    {
        float* tmp = (float*)((char*)d_ws + 250 * mk::MiB);
        (void)hipMemcpyAsync(tmp, (char*)d_ws + mk::WS_META + mk::META_HM, 16 * 1024 * 4, hipMemcpyDeviceToDevice, stream);
        hipLaunchKernelGGL(dbg::adapt, dim3((unsigned)(((size_t)nv::ROWS * nv::D + 255) / 256)), dim3(256), 0, stream, (const float*)d_out, (const float*)tmp, (float*)d_ws);
        nv::forward(stream, d_in, (float*)d_out, (char*)d_ws, MK_STAGE);
    }
#endif
}
```

```cpp
#include <hip/hip_runtime.h>
#include <cstdint>
#include <cstdio>
#include <cmath>
#define MK_MODE 0
namespace mk {
#define LAS __attribute__((address_space(3)))
#define GAS __attribute__((address_space(1)))
typedef unsigned short bf16_t;
typedef short bf16x8 __attribute__((ext_vector_type(8)));
typedef short s16x4 __attribute__((ext_vector_type(4)));
typedef float f32x4 __attribute__((ext_vector_type(4)));
typedef float f32x2 __attribute__((ext_vector_type(2)));
typedef unsigned u32x4 __attribute__((ext_vector_type(4)));
typedef unsigned u32x2 __attribute__((ext_vector_type(2)));

constexpr int M = 16384, D = 1024, DFF = 2816, SEQ = 8192, NMETA = 16;
constexpr int NWAVES = 8, NTHREADS = 512;
constexpr size_t MiB = 1u << 20;
constexpr size_t WS_CTL = 0, CTL_ZERO_BYTES = 1 * MiB;
constexpr size_t CTL_OSS_RET = 256 * 1024, CTL_OSS_GLA = 512 * 1024, CTL_MOSS = 768 * 1024;
constexpr size_t WS_HB = 1 * MiB, WS_SS = 33 * MiB, WS_META = 34 * MiB, WS_WMIX = 35 * MiB;
constexpr size_t META_HM = 0, META_RAW = 64 * 1024, META_MO = 448 * 1024;
constexpr size_t WS_WFFN_A = 52 * MiB, WS_ACT = 69 * MiB, WS_WFFN_B = 157 * MiB, WS_WFFN_C = 244 * MiB;
constexpr size_t WS_QH = 52 * MiB, WS_KH = 84 * MiB, WS_VT = 116 * MiB, WS_O = 180 * MiB;
constexpr size_t WS_BC = 69 * MiB, WS_QH2 = 101 * MiB, WS_KH2 = 117 * MiB, WS_VT2 = 133 * MiB, WS_O2 = 174 * MiB;
constexpr size_t WS_NEED = 256 * MiB;
constexpr size_t WM_RET_IN = 0, WM_RET_OUT = 12 * MiB;
constexpr size_t WM_GLA_IN = 0, WM_GLA_G = 4 * MiB, WM_GLA_OUT = 6 * MiB, WM_GLA_Z = 8 * MiB;
constexpr size_t WF_IN = 0, WF_OUT = 11 * MiB;
constexpr int CW_BAR = 4096;

constexpr int LDS_BYTES = 163840;
constexpr int LDS_MISC = LDS_BYTES - 256;

__constant__ float L2G[4] = {-0.04580368961312478f, -0.02272007650008353f, -0.011315313227834133f, -0.005646563141142062f};
__constant__ float ROPE_INV[128] = {
  1.000000000e+00f, 9.300450087e-01f, 8.649836779e-01f, 8.044736385e-01f,
  7.481966019e-01f, 6.958565116e-01f, 6.471778154e-01f, 6.019044518e-01f,
  5.597981811e-01f, 5.206375122e-01f, 4.842162728e-01f, 4.503428936e-01f,
  4.188391268e-01f, 3.895392120e-01f, 3.622889817e-01f, 3.369450271e-01f,
  3.133740425e-01f, 2.914519310e-01f, 2.710633874e-01f, 2.521011233e-01f,
  2.344653904e-01f, 2.180633694e-01f, 2.028087080e-01f, 1.886212230e-01f,
  1.754262149e-01f, 1.631542742e-01f, 1.517407894e-01f, 1.411257535e-01f,
  1.312533021e-01f, 1.220714748e-01f, 1.135319397e-01f, 1.055898219e-01f,
  9.820328653e-02f, 9.133346379e-02f, 8.494423330e-02f, 7.900195569e-02f,
  7.347535342e-02f, 6.833537668e-02f, 6.355497986e-02f, 5.910899118e-02f,
  5.497401953e-02f, 5.112830922e-02f, 4.755162448e-02f, 4.422515258e-02f,
  4.113136977e-02f, 3.825402260e-02f, 3.557796404e-02f, 3.308910504e-02f,
  3.077435680e-02f, 2.862153389e-02f, 2.661931701e-02f, 2.475716174e-02f,
  2.302526683e-02f, 2.141453326e-02f, 1.991648041e-02f, 1.852322184e-02f,
  1.722742990e-02f, 1.602228358e-02f, 1.490144618e-02f, 1.385901403e-02f,
  1.288950257e-02f, 1.198781747e-02f, 1.114920899e-02f, 1.036926545e-02f,
  9.643883444e-03f, 8.969245479e-03f, 8.341802284e-03f, 7.758250926e-03f,
  7.215522230e-03f, 6.710760761e-03f, 6.241309457e-03f, 5.804697983e-03f,
  5.398627371e-03f, 5.020966288e-03f, 4.669724498e-03f, 4.343053792e-03f,
  4.039235413e-03f, 3.756670747e-03f, 3.493872471e-03f, 3.249458736e-03f,
  3.022142686e-03f, 2.810728736e-03f, 2.614103956e-03f, 2.431234345e-03f,
  2.261157380e-03f, 2.102978062e-03f, 1.955864020e-03f, 1.819041790e-03f,
  1.691789716e-03f, 1.573440502e-03f, 1.463370281e-03f, 1.361000235e-03f,
  1.265791478e-03f, 1.177242957e-03f, 1.094888896e-03f, 1.018295996e-03f,
  9.470609948e-04f, 8.808093844e-04f, 8.191923262e-04f, 7.618857198e-04f,
  7.085879333e-04f, 6.590186385e-04f, 6.129170069e-04f, 5.700403708e-04f,
  5.301629426e-04f, 4.930753494e-04f, 4.585822753e-04f, 4.265021416e-04f,
  3.966661752e-04f, 3.689173318e-04f, 3.431097430e-04f, 3.191074939e-04f,
  2.967843320e-04f, 2.760227653e-04f, 2.567135962e-04f, 2.387551940e-04f,
  2.220530587e-04f, 2.065193403e-04f, 1.920722716e-04f, 1.786358480e-04f,
  1.661392889e-04f, 1.545170089e-04f, 1.437077590e-04f, 1.336546848e-04f,
  1.243048755e-04f, 1.156091312e-04f, 1.075216787e-04f, 9.999999747e-05f,
};

#define LDS_WAIT() asm volatile("s_waitcnt lgkmcnt(0)" ::: "memory")
#define VM_WAIT() asm volatile("s_waitcnt vmcnt(0)" ::: "memory")
#define RLX_AGENT __ATOMIC_RELAXED, __HIP_MEMORY_SCOPE_AGENT

__device__ __forceinline__ unsigned cvt_pk_bf16(float lo, float hi) { unsigned r; asm volatile("v_cvt_pk_bf16_f32 %0, %1, %2" : "=v"(r) : "v"(lo), "v"(hi)); return r; }
__device__ __forceinline__ float bf_lo(unsigned w) { return __uint_as_float(w << 16); }
__device__ __forceinline__ float bf_hi(unsigned w) { return __uint_as_float(w & 0xffff0000u); }
__device__ __forceinline__ unsigned short f2bf(float f) { return (unsigned short)(cvt_pk_bf16(f, 0.f) & 0xffffu); }
__device__ __forceinline__ float fsilu(float v) { return v * __builtin_amdgcn_rcpf(1.0f + __expf(-v)); }
__device__ __forceinline__ float wave_sum(float v) {
#pragma unroll
    for (int o = 1; o < 64; o <<= 1) v += __shfl_xor(v, o);
    return v;
}
__device__ __forceinline__ float row_rstd(const float* SS, int row) {
    const f32x4* p = (const f32x4*)(SS + (size_t)row * 16);
    const f32x4 a = p[0], b = p[1], c = p[2], d = p[3];
    const float s = ((a.x + a.y) + (a.z + a.w)) + ((b.x + b.y) + (b.z + b.w)) + ((c.x + c.y) + (c.z + c.w)) + ((d.x + d.y) + (d.z + d.w));
    return 1.0f / sqrtf(s * (1.0f / 1024.0f) + 1e-6f);
}

#define XB_TMO      128
#define XB_XCNT(j)  (256  + 64 * (j))
#define XB_XSUB(j)  (1280 + 64 * (j))
#define XB_XGEN(j)  (2304 + 64 * (j))
#define XB_TOP      3328
#define XB_TOPGEN   3392
#define XCD_BAR_WORDS 3456
#define XB_SPIN_CAP (1u << 18)
__device__ __forceinline__ unsigned xb_ld(unsigned* p)              { return __hip_atomic_load(p, __ATOMIC_RELAXED, __HIP_MEMORY_SCOPE_AGENT); }
__device__ __forceinline__ unsigned xb_add(unsigned* p, unsigned v) { return __hip_atomic_fetch_add(p, v, __ATOMIC_RELAXED, __HIP_MEMORY_SCOPE_AGENT); }
__device__ __forceinline__ unsigned xb_xcc_id() { return (unsigned)__builtin_amdgcn_s_getreg((3 << 11) | 20) & 0xFu; }
#define XB_SPIN(cond, bar) do { unsigned _sp = 0; while (cond) { __builtin_amdgcn_s_sleep(1); \
    if ((++_sp & 255u) == 0u) { if (xb_ld(&(bar)[XB_TMO])) break; if (_sp > XB_SPIN_CAP) { atomicAdd(&(bar)[XB_TMO], 1u); break; } } } } while (0)
struct XcdBarrier { unsigned* bar; unsigned x; volatile LAS unsigned* st; };
__device__ __forceinline__ XcdBarrier xcd_barrier_post(unsigned* bar, volatile LAS unsigned* st) {
    XcdBarrier b; b.bar = bar; b.x = xb_xcc_id(); b.st = st;
    if (threadIdx.x == 0) { const unsigned rank = xb_add(&bar[XB_XCNT(b.x)], 1u); st[2] = rank; st[3] = b.x; }
    return b;
}
__device__ __forceinline__ void xcd_barrier_complete(unsigned* bar, unsigned x, unsigned& nloc, unsigned& nx) {
    const unsigned G = gridDim.x * gridDim.y * gridDim.z;
    unsigned sum, cnt, mine, sp = 0u;
    for (;;) {
        sum = 0u; cnt = 0u; mine = 0u;
#pragma unroll
        for (unsigned j = 0; j < 16; ++j) { const unsigned c = xb_ld(&bar[XB_XCNT(j)]); sum += c; cnt += (c > 0u) ? 1u : 0u; mine = (j == x) ? c : mine; }
        if (sum == G) break;
        __builtin_amdgcn_s_sleep(1);
        if ((++sp & 255u) == 0u) { if (xb_ld(&bar[XB_TMO])) break; if (sp > XB_SPIN_CAP) { atomicAdd(&bar[XB_TMO], 1u); break; } }
    }
    nloc = mine > 0u ? mine : 1u; nx = cnt > 0u ? cnt : 1u;
}
__device__ __forceinline__ void xcd_barrier(const XcdBarrier& b) {
    asm volatile("s_waitcnt vmcnt(0)" ::: "memory");
    __syncthreads();
    if (threadIdx.x == 0) {
        unsigned* bar = b.bar;
        __builtin_amdgcn_s_waitcnt(0);
        unsigned nloc = b.st[0], nx = b.st[1];
        if (nloc == 0u) { xcd_barrier_complete(bar, b.x, nloc, nx); b.st[0] = nloc; b.st[1] = nx; }
        const unsigned old = xb_add(&bar[XB_XSUB(b.x)], 1u);
        const unsigned gen = old / nloc;
        if (old + 1u == (gen + 1u) * nloc) {
            __builtin_amdgcn_fence(__ATOMIC_RELEASE, "agent");
            asm volatile("s_waitcnt vmcnt(0)" ::: "memory");
            const unsigned og = xb_add(&bar[XB_TOP], 1u);
            const unsigned tg = og / nx;
            if (og + 1u == (tg + 1u) * nx) xb_add(&bar[XB_TOPGEN], 1u);
            else XB_SPIN(xb_ld(&bar[XB_TOPGEN]) == tg, bar);
            __builtin_amdgcn_fence(__ATOMIC_ACQUIRE, "agent");
            xb_add(&bar[XB_XGEN(b.x)], 1u);
            asm volatile("s_waitcnt vmcnt(0)" ::: "memory");
        } else {
            XB_SPIN(xb_ld(&bar[XB_XGEN(b.x)]) == gen, bar);
            __builtin_amdgcn_fence(__ATOMIC_ACQUIRE, "agent");
            asm volatile("s_waitcnt vmcnt(0)" ::: "memory");
        }
    }
    __syncthreads();
}

namespace pg8 {
constexpr int BM = 256, BK = 64, HALF = 128, HTB = HALF * BK * 2, STAGE_BYTES = 8 * HTB, NXCD = 8, WGM = 8;
__host__ __device__ __forceinline__ int lds_byte(int r, int c) { const int st = (r >> 4) * 2 + (c >> 5), rr = r & 15, cc = c & 31, ob = rr * 64 + cc * 2; return st * 1024 + (ob ^ (((ob >> 9) & 1) << 5)); }
__host__ __device__ __forceinline__ void stage_rc(int b, int& R, int& C) { const int st = b / 1024, sb = b % 1024, swz = sb ^ (((sb >> 9) & 1) << 5); R = (st >> 1) * 16 + swz / 64; C = (st & 1) * 32 + (swz % 64) / 2; }
__host__ __device__ __forceinline__ int perm32(int rho) { const int n = rho >> 4, i = rho & 15; return 8 * (i >> 2) + 4 * n + (i & 3); }
struct Unit { int pm, pn; };
struct Order {
    int nM, nN, nwg, G, c;
    __device__ void init(int nM_, int nN_, int G_, int c_) { nM = nM_; nN = nN_; nwg = nM * nN; G = G_; c = c_; }
    __device__ bool next(int i, Unit& u) const {
        const long L = (long)i * G + c; if (L >= nwg) return false;
        int wgid = (int)L; { const int q = nwg / NXCD, r = nwg % NXCD, xcd = wgid % NXCD, off = wgid / NXCD; wgid = (xcd < r ? xcd * (q + 1) : r * (q + 1) + (xcd - r) * q) + off; }
        const int nig = WGM * nN, gid = wgid / nig, fm = gid * WGM, gsz = (nM - fm) < WGM ? (nM - fm) : WGM;
        u.pm = fm + ((wgid % nig) % gsz); u.pn = (wgid % nig) / gsz; return true;
    }
};
template <class Epi, class Ptr>
__device__ __forceinline__ void gemm_phase(LAS unsigned char* lds, const int K, const Order& S, const Ptr& P, const Epi& E) {
    const int tid = threadIdx.x, wid = __builtin_amdgcn_readfirstlane(tid >> 6), lane = tid & 63, wr = wid >> 2, wc = wid & 3, fr = lane & 15, fq = lane >> 4;
    const int nt = K / BK;
    unsigned voffA[2], voffB[2];
#pragma unroll
    for (int i = 0; i < 2; ++i) { int R, C; stage_rc(tid * 16 + i * 8192, R, C); const int Rb = (R & ~31) + perm32(R & 31);
        voffA[i] = (unsigned)(R * K + C) * 2u; voffB[i] = (unsigned)(Rb * K + C) * 2u; }
    const size_t kstep = (size_t)(BK * 2);
    const size_t hstep = (size_t)HALF * K * 2;
    const unsigned ldsw = (unsigned)wid * 1024u;
    const int aoff = lds_byte(wr * 64 + fr, fq * 8), boff = lds_byte(wc * 32 + fr, fq * 8);
#define PG8_SA(b, h) (((b) * 2 + (h)) * HTB)
#define PG8_SB(b, h) ((4 + (b) * 2 + (h)) * HTB)
#define PG8_STAGE(bufoff, gbase, voff) do { _Pragma("unroll") for (int _i = 0; _i < 2; ++_i) \
        __builtin_amdgcn_global_load_lds((const unsigned*)((const char*)(gbase) + (voff)[_i]), (LAS unsigned*)(lds + (bufoff) + ldsw + _i * 8192), 16, 0, 0); } while (0)
#define PG8_LDA(dst, b, h) do { _Pragma("unroll") for (int m = 0; m < 4; ++m) _Pragma("unroll") for (int k = 0; k < 2; ++k) dst[m][k] = *(const LAS bf16x8*)(lds + PG8_SA(b, h) + aoff + m * 2048 + k * 1024); } while (0)
#define PG8_LDB(dst, b, h) do { _Pragma("unroll") for (int n = 0; n < 2; ++n) _Pragma("unroll") for (int k = 0; k < 2; ++k) dst[n][k] = *(const LAS bf16x8*)(lds + PG8_SB(b, h) + boff + n * 2048 + k * 1024); } while (0)
#define PG8_MMA(ai, bj, At, Bt) do { __builtin_amdgcn_s_setprio(1); _Pragma("unroll") for (int m = 0; m < 4; ++m) _Pragma("unroll") for (int n = 0; n < 2; ++n) _Pragma("unroll") for (int k = 0; k < 2; ++k) \
        acc[ai][bj][m][n] = __builtin_amdgcn_mfma_f32_16x16x32_bf16(Bt[n][k], At[m][k], acc[ai][bj][m][n], 0, 0, 0); __builtin_amdgcn_s_setprio(0); } while (0)
#define PG8_WAIT_V(n) asm volatile("s_waitcnt vmcnt(" #n ")" ::: "memory")
#define PG8_WAIT_L(n) asm volatile("s_waitcnt lgkmcnt(" #n ")" ::: "memory")
#define PG8_BAR __builtin_amdgcn_s_barrier()
#define PG8_SCHED __builtin_amdgcn_sched_barrier(0)
    Unit cur, nxt; int ui = 0;
    if (!S.next(0, cur)) return;
    f32x4 acc[2][2][4][2];
#pragma unroll
    for (int a = 0; a < 2; ++a)
#pragma unroll
        for (int b = 0; b < 2; ++b)
#pragma unroll
            for (int m = 0; m < 4; ++m)
#pragma unroll
                for (int n = 0; n < 2; ++n) acc[a][b][m][n] = (f32x4){0.f, 0.f, 0.f, 0.f};
    bf16x8 At[4][2], B0[2][2], B1[2][2];
    const char* cA; const char* cB; P.ptrs(cur, cA, cB);
    PG8_STAGE(PG8_SB(0, 0), cB, voffB); PG8_STAGE(PG8_SB(0, 1), cB + hstep, voffB); PG8_STAGE(PG8_SA(0, 0), cA, voffA); PG8_STAGE(PG8_SA(0, 1), cA + hstep, voffA);
    if (wr == 1) PG8_BAR;
    PG8_WAIT_V(2); PG8_BAR;
    PG8_STAGE(PG8_SB(1, 0), cB + kstep, voffB); PG8_STAGE(PG8_SA(1, 0), cA + kstep, voffA); PG8_STAGE(PG8_SB(1, 1), cB + hstep + kstep, voffB);
    PG8_WAIT_V(6); PG8_BAR;
    for (;;) {
        const bool has_next = S.next(ui + 1, nxt);
        const char* nA = cA; const char* nB = cB; if (has_next) P.ptrs(nxt, nA, nB);
        for (int t = 0; t < nt; t += 2) {
            const bool last = (t == nt - 2);
            const char* a1 = cA + (size_t)(t + 1) * kstep;
            const char* a2 = last ? nA : cA + (size_t)(t + 2) * kstep; const char* b2 = last ? nB : cB + (size_t)(t + 2) * kstep;
            const char* a3 = a2 + kstep; const char* b3 = b2 + kstep;
            PG8_LDB(B0, 0, 0); PG8_LDB(B1, 0, 1); PG8_SCHED; PG8_LDA(At, 0, 0); PG8_STAGE(PG8_SA(1, 1), a1 + hstep, voffA);
            PG8_WAIT_V(8); PG8_WAIT_L(0); PG8_BAR; PG8_MMA(0, 0, At, B0); PG8_MMA(0, 1, At, B1); PG8_BAR; PG8_SCHED;
            PG8_LDA(At, 0, 1); PG8_STAGE(PG8_SB(0, 0), b2, voffB); PG8_STAGE(PG8_SB(0, 1), b2 + hstep, voffB); PG8_STAGE(PG8_SA(0, 0), a2, voffA);
            PG8_WAIT_V(8); PG8_WAIT_L(0); PG8_BAR; PG8_MMA(1, 0, At, B0); PG8_MMA(1, 1, At, B1); PG8_BAR; PG8_SCHED;
            PG8_LDB(B0, 1, 0); PG8_LDB(B1, 1, 1); PG8_SCHED; PG8_LDA(At, 1, 0); PG8_STAGE(PG8_SA(0, 1), a2 + hstep, voffA);
            PG8_WAIT_V(8); PG8_WAIT_L(0); PG8_BAR; PG8_MMA(0, 0, At, B0); PG8_MMA(0, 1, At, B1); PG8_BAR; PG8_SCHED;
            PG8_LDA(At, 1, 1); PG8_STAGE(PG8_SB(1, 0), b3, voffB); PG8_STAGE(PG8_SB(1, 1), b3 + hstep, voffB); PG8_STAGE(PG8_SA(1, 0), a3, voffA);
            PG8_WAIT_V(8); PG8_WAIT_L(0); PG8_BAR; PG8_MMA(1, 0, At, B0); PG8_MMA(1, 1, At, B1); PG8_BAR; PG8_SCHED;
        }
        if (wr == 0) PG8_BAR;
        E(acc, cur, wr, wc, fr, fq);
        if (!has_next) break;
#pragma unroll
        for (int a = 0; a < 2; ++a)
#pragma unroll
            for (int b = 0; b < 2; ++b)
#pragma unroll
                for (int m = 0; m < 4; ++m)
#pragma unroll
                    for (int n = 0; n < 2; ++n) acc[a][b][m][n] = (f32x4){0.f, 0.f, 0.f, 0.f};
        cur = nxt; cA = nA; cB = nB; ++ui;
        if (wr == 1) PG8_BAR;
    }
    PG8_WAIT_V(0);
    PG8_BAR;
#undef PG8_SA
#undef PG8_SB
#undef PG8_STAGE
#undef PG8_LDA
#undef PG8_LDB
#undef PG8_MMA
#undef PG8_WAIT_V
#undef PG8_WAIT_L
#undef PG8_BAR
#undef PG8_SCHED
}
}
struct Frame {
    LAS unsigned char* lds;
    int tid, lane, wave, vcu, G, vb;
    unsigned char* ws;
    const float* in[18];
    float* out;
};
#define WSP(T, off) ((T*)(F.ws + (off)))

__device__ __forceinline__ void conv_item(const float* W, int ldn, int srccol0, int k0, const float* gain, bf16_t* WT, int K, int dstrow0, LAS float* scr, int lane) {
    float v[32];
    const float* wp = W + (size_t)(k0 + (lane >> 5)) * ldn + srccol0 + (lane & 31);
#pragma unroll
    for (int i = 0; i < 32; ++i) v[i] = wp[(size_t)(2 * i) * ldn];
    const int c = lane & 7;
    float gn[8];
#pragma unroll
    for (int e = 0; e < 8; ++e) gn[e] = gain ? gain[k0 + 8 * c + e] : 1.0f;
#pragma unroll
    for (int i = 0; i < 32; ++i) scr[(2 * i + (lane >> 5)) * 33 + (lane & 31)] = v[i];
    LDS_WAIT(); asm volatile("" ::: "memory");
#pragma unroll
    for (int j = 0; j < 4; ++j) { const int n = (lane >> 3) + 8 * j; const LAS float* s = scr + (8 * c) * 33 + n;
        u32x4 o; o.x = cvt_pk_bf16(s[0 * 33] * gn[0], s[1 * 33] * gn[1]); o.y = cvt_pk_bf16(s[2 * 33] * gn[2], s[3 * 33] * gn[3]);
        o.z = cvt_pk_bf16(s[4 * 33] * gn[4], s[5 * 33] * gn[5]); o.w = cvt_pk_bf16(s[6 * 33] * gn[6], s[7 * 33] * gn[7]);
        *(u32x4*)(WT + (size_t)(dstrow0 + n) * K + k0 + 8 * c) = o; }
    LDS_WAIT(); asm volatile("" ::: "memory");
}
struct ConvJob { const float* W; int ldn, K, N, col0, kind; const float* gain; bf16_t* WT; };
__device__ __forceinline__ int conv_items(const ConvJob& J) { return (J.K / 64) * (J.N / 32); }
__device__ __forceinline__ void conv_run(const ConvJob& J, int item, LAS float* scr, int lane) {
    const int nblk = J.N / 32, kb = item / nblk, nb = item % nblk; const int n0 = 32 * nb;
    int src;
    if (J.kind == 0) src = J.col0 + n0; else { const int u = n0 >> 8, j = n0 & 255; src = (j < 128) ? u * 128 + j : 2816 + u * 128 + (j - 128); }
    conv_item(J.W, J.ldn, src, 64 * kb, J.gain, J.WT, J.K, n0, scr, lane);
}
__device__ __forceinline__ int conv_job(Frame& F, const ConvJob& J, int base, int gw, int ngw) {
    LAS float* scr = (LAS float*)(F.lds + F.wave * 16384);
    const int n = conv_items(J);
    const int first = (gw - base % ngw + ngw) % ngw;
    for (int it = first; it < n; it += ngw) conv_run(J, it, scr, F.lane);
    return base + n;
}
__device__ __forceinline__ ConvJob job_ffn_in(Frame& F, int layer, int which  , size_t dst) {
    ConvJob J; J.W = F.in[which ? 7 : 3] + (size_t)layer * D * 2 * DFF; J.ldn = 2 * DFF; J.K = D; J.N = 2 * DFF; J.col0 = 0; J.kind = 1; J.gain = F.in[which ? 6 : 2] + layer * D; J.WT = WSP(bf16_t, dst); return J; }
__device__ __forceinline__ ConvJob job_ffn_out(Frame& F, int layer, int which, size_t dst) {
    ConvJob J; J.W = F.in[which ? 8 : 4] + (size_t)layer * DFF * D; J.ldn = D; J.K = DFF; J.N = D; J.col0 = 0; J.kind = 0; J.gain = nullptr; J.WT = WSP(bf16_t, dst); return J; }

struct EpiSwiglu {
    const float* SS; bf16_t* ACT;
    __device__ __forceinline__ void operator()(const f32x4 (&acc)[2][2][4][2], const pg8::Unit& u, int wr, int wc, int fr, int fq) const {
#pragma unroll
        for (int ai = 0; ai < 2; ++ai)
#pragma unroll
            for (int m = 0; m < 4; ++m) {
                const int row = u.pm * 256 + ai * 128 + wr * 64 + m * 16 + fr; const float rs = row_rstd(SS, row);
                float v[8];
#pragma unroll
                for (int n = 0; n < 2; ++n)
#pragma unroll
                    for (int j = 0; j < 4; ++j) { const float g = acc[ai][0][m][n][j] * rs, up = acc[ai][1][m][n][j] * rs; v[4 * n + j] = fsilu(g) * up; }
                u32x4 w; w.x = cvt_pk_bf16(v[0], v[1]); w.y = cvt_pk_bf16(v[2], v[3]); w.z = cvt_pk_bf16(v[4], v[5]); w.w = cvt_pk_bf16(v[6], v[7]);
                *(u32x4*)(ACT + (size_t)row * DFF + u.pn * 128 + wc * 32 + 8 * fq) = w;
            }
    }
};
struct EpiResid {
    const float* base; float* H; bf16_t* HB; float* SS; float alpha;
    __device__ __forceinline__ void operator()(const f32x4 (&acc)[2][2][4][2], const pg8::Unit& u, int wr, int wc, int fr, int fq) const {
#pragma unroll
        for (int ai = 0; ai < 2; ++ai)
#pragma unroll
            for (int m = 0; m < 4; ++m) {
                const int row = u.pm * 256 + ai * 128 + wr * 64 + m * 16 + fr; float ss = 0.f;
#pragma unroll
                for (int bj = 0; bj < 2; ++bj) {
                    const size_t off = (size_t)row * D + u.pn * 256 + bj * 128 + wc * 32 + 8 * fq;
                    const f32x4 b0 = *(const f32x4*)(base + off), b1 = *(const f32x4*)(base + off + 4);
                    const f32x4 v0 = b0 + acc[ai][bj][m][0] * alpha, v1 = b1 + acc[ai][bj][m][1] * alpha;
                    *(f32x4*)(H + off) = v0; *(f32x4*)(H + off + 4) = v1;
                    u32x4 w; w.x = cvt_pk_bf16(v0[0], v0[1]); w.y = cvt_pk_bf16(v0[2], v0[3]); w.z = cvt_pk_bf16(v1[0], v1[1]); w.w = cvt_pk_bf16(v1[2], v1[3]);
                    *(u32x4*)(HB + off) = w;
                    ss += (v0[0] * v0[0] + v0[1] * v0[1]) + (v0[2] * v0[2] + v0[3] * v0[3]) + (v1[0] * v1[0] + v1[1] * v1[1]) + (v1[2] * v1[2] + v1[3] * v1[3]);
                }
                ss += __shfl_xor(ss, 16); ss += __shfl_xor(ss, 32);
                if (fq == 0) SS[(size_t)row * 16 + u.pn * 4 + wc] = ss;
            }
    }
};
struct EpiRetIn {
    const float* SS; bf16_t* QH; bf16_t* KH; bf16_t* VT;
    __device__ __forceinline__ void operator()(const f32x4 (&acc)[2][2][4][2], const pg8::Unit& u, int wr, int wc, int fr, int fq) const {
        if (u.pn < 8) {
            const bool isq = u.pn < 4; const int head = u.pn & 3; bf16_t* dst = isq ? QH : KH;
            const float l2g = isq ? L2G[head] : -L2G[head], sc = isq ? 1.0f : 0.0625f;
            float inv[8];
#pragma unroll
            for (int e = 0; e < 8; ++e) inv[e] = ROPE_INV[wc * 32 + 8 * fq + e];
#pragma unroll
            for (int ai = 0; ai < 2; ++ai)
#pragma unroll
                for (int m = 0; m < 4; ++m) {
                    const int row = u.pm * 256 + ai * 128 + wr * 64 + m * 16 + fr; const float rs = row_rstd(SS, row);
                    const int b = row >> 13, t = row & 8191; const float pos = (float)(t + NMETA);
                    const float dec = __builtin_amdgcn_exp2f((float)((t & 31) + 1) * l2g) * sc * rs;
                    float o1[8], o2[8];
#pragma unroll
                    for (int n = 0; n < 2; ++n)
#pragma unroll
                        for (int j = 0; j < 4; ++j) { const int e = 4 * n + j;
                            const float rev = (pos * inv[e]) * 0.15915494309189535f; const float frc = rev - floorf(rev);
                            const float sn = __builtin_amdgcn_sinf(frc), cs = __builtin_amdgcn_cosf(frc);
                            const float t1 = acc[ai][0][m][n][j], t2 = acc[ai][1][m][n][j];
                            o1[e] = (t1 * cs - t2 * sn) * dec; o2[e] = (t1 * sn + t2 * cs) * dec; }
                    bf16_t* p = dst + ((size_t)(b * 4 + head) * SEQ + t) * 256 + wc * 32 + 8 * fq;
                    u32x4 w; w.x = cvt_pk_bf16(o1[0], o1[1]); w.y = cvt_pk_bf16(o1[2], o1[3]); w.z = cvt_pk_bf16(o1[4], o1[5]); w.w = cvt_pk_bf16(o1[6], o1[7]);
                    *(u32x4*)p = w;
                    w.x = cvt_pk_bf16(o2[0], o2[1]); w.y = cvt_pk_bf16(o2[2], o2[3]); w.z = cvt_pk_bf16(o2[4], o2[5]); w.w = cvt_pk_bf16(o2[6], o2[7]);
                    *(u32x4*)(p + 128) = w;
                }
        } else {
            float rs[2][8];
#pragma unroll
            for (int bj = 0; bj < 2; ++bj)
#pragma unroll
                for (int e = 0; e < 8; ++e) rs[bj][e] = row_rstd(SS, u.pm * 256 + bj * 128 + wc * 32 + 8 * fq + e);
            const int b = u.pm >> 5, t0 = (u.pm & 31) * 256;
#pragma unroll
            for (int ai = 0; ai < 2; ++ai)
#pragma unroll
                for (int m = 0; m < 4; ++m) {
                    const int vc = (u.pn - 8) * 256 + ai * 128 + wr * 64 + m * 16 + fr; const int head = vc >> 9, dvi = vc & 511;
                    bf16_t* p = VT + ((size_t)(b * 4 + head) * 512 + dvi) * SEQ + t0 + wc * 32 + 8 * fq;
#pragma unroll
                    for (int bj = 0; bj < 2; ++bj) {
                        const f32x4 v0 = acc[ai][bj][m][0], v1 = acc[ai][bj][m][1];
                        u32x4 w; w.x = cvt_pk_bf16(v0[0] * rs[bj][0], v0[1] * rs[bj][1]); w.y = cvt_pk_bf16(v0[2] * rs[bj][2], v0[3] * rs[bj][3]);
                        w.z = cvt_pk_bf16(v1[0] * rs[bj][4], v1[1] * rs[bj][5]); w.w = cvt_pk_bf16(v1[2] * rs[bj][6], v1[3] * rs[bj][7]);
                        *(u32x4*)(p + bj * 128) = w;
                    }
                }
        }
    }
};
template <int DV, int LDO> struct EpiGate {
    const float* SS; const bf16_t* O; bf16_t* Y; LAS float* RO;
    __device__ __forceinline__ void operator()(const f32x4 (&acc)[2][2][4][2], const pg8::Unit& u, int wr, int wc, int fr, int fq) const {
        const int wid = wr * 4 + wc, lane = fq * 16 + fr; const int head = (u.pn * 256) / DV;
        {   const bf16_t* ob = O + (size_t)(u.pm * 256 + wid * 32) * LDO + head * DV;
#pragma unroll
            for (int i0 = 0; i0 < 32; i0 += 8) { float sv[8];
#pragma unroll
                for (int i = 0; i < 8; ++i) { float s;
                    if (DV == 512) { const u32x4 v = *(const u32x4*)(ob + (size_t)(i0 + i) * LDO + lane * 8);
                        const float a0 = bf_lo(v.x), a1 = bf_hi(v.x), a2 = bf_lo(v.y), a3 = bf_hi(v.y), a4 = bf_lo(v.z), a5 = bf_hi(v.z), a6 = bf_lo(v.w), a7 = bf_hi(v.w);
                        s = ((a0 * a0 + a1 * a1) + (a2 * a2 + a3 * a3)) + ((a4 * a4 + a5 * a5) + (a6 * a6 + a7 * a7)); }
                    else { const u32x2 v = *(const u32x2*)(ob + (size_t)(i0 + i) * LDO + lane * 4);
                        const float a0 = bf_lo(v.x), a1 = bf_hi(v.x), a2 = bf_lo(v.y), a3 = bf_hi(v.y); s = (a0 * a0 + a1 * a1) + (a2 * a2 + a3 * a3); }
                    sv[i] = s; }
#pragma unroll
                for (int i = 0; i < 8; ++i) { const float t = wave_sum(sv[i]); if (lane == 0) RO[wid * 32 + i0 + i] = 1.0f / sqrtf(t * (1.0f / (float)DV) + 1e-6f); } }
            LDS_WAIT(); __builtin_amdgcn_s_barrier(); asm volatile("" ::: "memory"); }
#pragma unroll
        for (int ai = 0; ai < 2; ++ai)
#pragma unroll
            for (int m = 0; m < 4; ++m) {
                const int rl = ai * 128 + wr * 64 + m * 16 + fr, row = u.pm * 256 + rl; const float rs = row_rstd(SS, row); const float ro = RO[rl];
#pragma unroll
                for (int bj = 0; bj < 2; ++bj) {
                    const int col = u.pn * 256 + bj * 128 + wc * 32 + 8 * fq;
                    const u32x4 ov = *(const u32x4*)(O + (size_t)row * LDO + col);
                    const f32x4 g0 = acc[ai][bj][m][0] * rs, g1 = acc[ai][bj][m][1] * rs;
                    u32x4 w;
                    w.x = cvt_pk_bf16(bf_lo(ov.x) * ro * fsilu(g0[0]), bf_hi(ov.x) * ro * fsilu(g0[1]));
                    w.y = cvt_pk_bf16(bf_lo(ov.y) * ro * fsilu(g0[2]), bf_hi(ov.y) * ro * fsilu(g0[3]));
                    w.z = cvt_pk_bf16(bf_lo(ov.z) * ro * fsilu(g1[0]), bf_hi(ov.z) * ro * fsilu(g1[1]));
                    w.w = cvt_pk_bf16(bf_lo(ov.w) * ro * fsilu(g1[2]), bf_hi(ov.w) * ro * fsilu(g1[3]));
                    *(u32x4*)(Y + (size_t)row * LDO + col) = w;
                }
            }
        asm volatile("" ::: "memory"); __builtin_amdgcn_s_barrier(); asm volatile("" ::: "memory");
    }
};
struct EpiGlaIn {
    const float* SS; const float* BC; bf16_t* QH; bf16_t* KH; bf16_t* VT;
    __device__ __forceinline__ void operator()(const f32x4 (&acc)[2][2][4][2], const pg8::Unit& u, int wr, int wc, int fr, int fq) const {
        if (u.pn < 4) {
            const bool isq = u.pn < 2; bf16_t* dst = isq ? QH : KH;
#pragma unroll
            for (int ai = 0; ai < 2; ++ai)
#pragma unroll
                for (int m = 0; m < 4; ++m) {
                    const int row = u.pm * 256 + ai * 128 + wr * 64 + m * 16 + fr; const float rs = row_rstd(SS, row) * (isq ? 0.08838834764831845f : 1.0f);
                    const int b = row >> 13, t = row & 8191;
#pragma unroll
                    for (int bj = 0; bj < 2; ++bj) {
                        const int cq = (u.pn & 1) * 256 + bj * 128 + wc * 32 + 8 * fq; const int head = cq >> 7, d = cq & 127;
                        const f32x4 c0 = *(const f32x4*)(BC + (size_t)row * 512 + cq), c1 = *(const f32x4*)(BC + (size_t)row * 512 + cq + 4);
                        float v[8];
#pragma unroll
                        for (int j = 0; j < 4; ++j) { v[j] = acc[ai][bj][m][0][j] * rs * __expf(isq ? c0[j] : -c0[j]); v[4 + j] = acc[ai][bj][m][1][j] * rs * __expf(isq ? c1[j] : -c1[j]); }
                        u32x4 w; w.x = cvt_pk_bf16(v[0], v[1]); w.y = cvt_pk_bf16(v[2], v[3]); w.z = cvt_pk_bf16(v[4], v[5]); w.w = cvt_pk_bf16(v[6], v[7]);
                        *(u32x4*)(dst + ((size_t)(b * 4 + head) * SEQ + t) * 128 + d) = w;
                    }
                }
        } else {
            float rs[2][8];
#pragma unroll
            for (int bj = 0; bj < 2; ++bj)
#pragma unroll
                for (int e = 0; e < 8; ++e) rs[bj][e] = row_rstd(SS, u.pm * 256 + bj * 128 + wc * 32 + 8 * fq + e);
            const int b = u.pm >> 5, t0 = (u.pm & 31) * 256; const int head = u.pn - 4;
#pragma unroll
            for (int ai = 0; ai < 2; ++ai)
#pragma unroll
                for (int m = 0; m < 4; ++m) {
                    const int dvi = ai * 128 + wr * 64 + m * 16 + fr;
                    bf16_t* p = VT + ((size_t)(b * 4 + head) * 256 + dvi) * SEQ + t0 + wc * 32 + 8 * fq;
#pragma unroll
                    for (int bj = 0; bj < 2; ++bj) {
                        const f32x4 v0 = acc[ai][bj][m][0], v1 = acc[ai][bj][m][1];
                        u32x4 w; w.x = cvt_pk_bf16(v0[0] * rs[bj][0], v0[1] * rs[bj][1]); w.y = cvt_pk_bf16(v0[2] * rs[bj][2], v0[3] * rs[bj][3]);
                        w.z = cvt_pk_bf16(v1[0] * rs[bj][4], v1[1] * rs[bj][5]); w.w = cvt_pk_bf16(v1[2] * rs[bj][6], v1[3] * rs[bj][7]);
                        *(u32x4*)(p + bj * 128) = w;
                    }
                }
        }
    }
};
struct PtrNormal { const char* A; const char* B; size_t tstep;
    __device__ __forceinline__ void ptrs(const pg8::Unit& u, const char*& cA, const char*& cB) const { cA = A + (size_t)u.pm * tstep; cB = B + (size_t)u.pn * tstep; } };
struct PtrSwapFrom { const char* A; const char* B; size_t tstep; int pn_swap;
    __device__ __forceinline__ void ptrs(const pg8::Unit& u, const char*& cA, const char*& cB) const {
        const char* a = A + (size_t)u.pm * tstep; const char* b = B + (size_t)u.pn * tstep;
        if (u.pn >= pn_swap) { cA = b; cB = a; } else { cA = a; cB = b; } } };

constexpr int MA_RS_OFF = 98304, MA_RED_OFF = 100352;
template <int MODE> __device__ __forceinline__ void meta_tiles(Frame& F, const bf16_t* Bt, int N, int K, float* out, int ldo, float alpha, int b0, int nb) {
    const int lane = F.lane, g = lane >> 4, r16 = lane & 15, pitch = K + 8;
    const LAS bf16_t* A = (const LAS bf16_t*)F.lds; const LAS float* rsA = (const LAS float*)(F.lds + MA_RS_OFF); LAS f32x4* red = (LAS f32x4*)(F.lds + MA_RED_OFF);
    const int ksteps = K / 32, per = ksteps / 8;
    for (int tile = F.vb - b0; tile < N / 16; tile += nb) {
        f32x4 acc = (f32x4){0.f, 0.f, 0.f, 0.f};
        const bf16_t* bp = Bt + (size_t)(tile * 16 + r16) * K + 8 * g;
        for (int ks = F.wave * per; ks < (F.wave + 1) * per; ++ks) {
            const bf16x8 a = *(const LAS bf16x8*)(A + r16 * pitch + ks * 32 + 8 * g);
            const bf16x8 b = *(const bf16x8*)(bp + ks * 32);
            acc = __builtin_amdgcn_mfma_f32_16x16x32_bf16(a, b, acc, 0, 0, 0);
        }
        red[F.wave * 64 + lane] = acc;
        __syncthreads();
        if (F.wave == 0) {
            f32x4 s = red[lane];
#pragma unroll
            for (int w = 1; w < 8; ++w) s += red[w * 64 + lane];
#pragma unroll
            for (int j = 0; j < 4; ++j) { const int r = 4 * g + j; float* o = out + (size_t)r * ldo + tile * 16 + r16;
                if (MODE == 0) *o = s[j] * rsA[r]; else *o = *o + alpha * s[j]; }
        }
        __syncthreads();
    }
}
__device__ __forceinline__ bool meta_has_tiles(Frame& F, int N, int b0, int nb) { const int r = F.vb - b0; return r >= 0 && r < nb && r < N / 16; }
__device__ __forceinline__ void meta_prep_h(Frame& F) {
    const float* HM = WSP(float, WS_META + META_HM); LAS bf16_t* A = (LAS bf16_t*)F.lds; LAS float* rsA = (LAS float*)(F.lds + MA_RS_OFF);
    for (int r = F.wave; r < 16; r += 8) { float s = 0.f;
        for (int k = F.lane; k < D; k += 64) { const float v = HM[r * D + k]; s += v * v; A[r * (D + 8) + k] = f2bf(v); }
        s = wave_sum(s); if (F.lane == 0) rsA[r] = 1.0f / sqrtf(s * (1.0f / 1024.0f) + 1e-6f); }
    __syncthreads();
}
__device__ __forceinline__ void meta_prep_act(Frame& F) {
    const float* RAW = WSP(float, WS_META + META_RAW); LAS bf16_t* A = (LAS bf16_t*)F.lds; LAS float* rsA = (LAS float*)(F.lds + MA_RS_OFF);
    for (int i = F.tid; i < 16 * DFF; i += NTHREADS) { const int r = i / DFF, k = i % DFF, u = k >> 7, j = k & 127;
        const float g = RAW[r * 5632 + u * 256 + j], up = RAW[r * 5632 + u * 256 + 128 + j]; A[r * (DFF + 8) + k] = f2bf(fsilu(g) * up); }
    if (F.tid < 16) rsA[F.tid] = 1.f;
    __syncthreads();
}
__device__ __forceinline__ void meta_prep_y(Frame& F) {
    const float* RAW = WSP(float, WS_META + META_RAW); const float* MO = WSP(float, WS_META + META_MO);
    LAS bf16_t* A = (LAS bf16_t*)F.lds; LAS float* rsA = (LAS float*)(F.lds + MA_RS_OFF); LAS float* mro = (LAS float*)(F.lds + MA_RED_OFF);
    for (int p = F.wave; p < 64; p += 8) { const int r = p >> 2, head = p & 3; float sacc = 0.f;
        for (int k = F.lane; k < 512; k += 64) { const float v = MO[r * 2048 + head * 512 + k]; sacc += v * v; }
        sacc = wave_sum(sacc); if (F.lane == 0) mro[p] = 1.0f / sqrtf(sacc * (1.0f / 512.0f) + 1e-6f); }
    __syncthreads();
    for (int i = F.tid; i < 16 * 2048; i += NTHREADS) { const int r = i >> 11, k = i & 2047, head = k >> 9;
        A[r * (2048 + 8) + k] = f2bf(MO[r * 2048 + k] * mro[r * 4 + head] * fsilu(RAW[r * 6144 + 4096 + k])); }
    if (F.tid < 16) rsA[F.tid] = 1.f;
    __syncthreads();
}
__device__ __forceinline__ void z_phase(Frame& F, const bf16_t* HB, const float* SS, const bf16_t* WZ, const float* wg, const float* bg, float* BC) {
    LAS float* zpart = (LAS float*)F.lds;
    LAS float* zs = (LAS float*)(F.lds + 8192);
    const int lane = F.lane, g = lane >> 4, r16 = lane & 15;
    for (int cidx = blockIdx.x; cidx < M / 64; cidx += F.G) {
        const int row0 = cidx * 64;
        { const int tile = F.wave & 3, kh = F.wave >> 2; f32x4 acc = (f32x4){0.f, 0.f, 0.f, 0.f};
          const bf16_t* ap = HB + (size_t)(row0 + tile * 16 + r16) * D + 8 * g; const bf16_t* bp = WZ + (size_t)r16 * D + 8 * g;
#pragma unroll 4
          for (int ks = kh * 16; ks < kh * 16 + 16; ++ks) {
              const bf16x8 a = *(const bf16x8*)(ap + ks * 32), b = *(const bf16x8*)(bp + ks * 32);
              acc = __builtin_amdgcn_mfma_f32_16x16x32_bf16(a, b, acc, 0, 0, 0);
          }
#pragma unroll
          for (int j = 0; j < 4; ++j) zpart[(kh * 64 + tile * 16 + 4 * g + j) * 16 + r16] = acc[j]; }
        __syncthreads();
        for (int i = F.tid; i < 64 * 16; i += NTHREADS) { const int t = i >> 4; zs[i] = (zpart[i] + zpart[1024 + i]) * row_rstd(SS, row0 + t); }
        __syncthreads();
        { const int c = F.tid; float w[16];
#pragma unroll
          for (int r = 0; r < 16; ++r) w[r] = wg[r * 512 + c];
          const float bias = bg[c]; float cum = 0.f;
          for (int t = 0; t < 64; ++t) { float a = bias; if (t == 32) cum = 0.f;
#pragma unroll
              for (int r = 0; r < 16; ++r) a += zs[t * 16 + r] * w[r];
              const float ls = fminf(a, 0.f) - __logf(1.0f + __expf(-fabsf(a)));
              cum += ls * 0.0625f; BC[(size_t)(row0 + t) * 512 + c] = cum; } }
        __syncthreads();
    }
}

typedef short v4i16_t __attribute__((ext_vector_type(4)));
__device__ __forceinline__ s16x4 ds_tr_asm(unsigned addr) { s16x4 r; asm volatile("ds_read_b64_tr_b16 %0, %1" : "=v"(r) : "v"(addr) : "memory"); return r; }
__device__ __forceinline__ s16x4 ds_tr(const LAS unsigned char* p) { return __builtin_bit_cast(s16x4, __builtin_amdgcn_ds_read_tr16_b64_v4i16((LAS v4i16_t*)p)); }
template <int DK, int DV, bool GLA>
__device__ __forceinline__ void s2_phase(Frame& F, const bf16_t* QH, const bf16_t* KH, const bf16_t* VT, bf16_t* O, float* OSS, const float* BC, int ldraw) {
    constexpr int NS = DV / 16, ROWB = DK * 2, TILEB = 64 * ROWB, NI = TILEB / 1024 / 8, NT = DK / 128, LDO = 4 * DV;
    constexpr int LQ = 0, LK = 2 * TILEB, LV = 4 * TILEB, LP = LV + 4096, LS = LP + 8192, LDEC = LS + 2 * 16 * ROWB;
    static_assert(LDEC + 2 * DK * 4 <= LDS_MISC, "S2 LDS map");
    const int unit = blockIdx.x; if (unit >= 8 * NS) return;
    const int bh = unit & 7, s = unit >> 3, b = bh >> 2, h = bh & 3;
    const int lane = F.lane, g = lane >> 4, r16 = lane & 15, w = F.wave;
    LAS unsigned char* L = F.lds; const unsigned Lb = (unsigned)(uintptr_t)L;
    const float* RAW = WSP(float, WS_META + META_RAW);
    for (int i = F.tid * 16; i < TILEB; i += NTHREADS * 16) { *(LAS u32x4*)(L + LQ + i) = (u32x4){0, 0, 0, 0}; *(LAS u32x4*)(L + LK + i) = (u32x4){0, 0, 0, 0}; }
    for (int i = F.tid * 16; i < 2048; i += NTHREADS * 16) *(LAS u32x4*)(L + LV + i) = (u32x4){0, 0, 0, 0};
    for (int i = F.tid * 16; i < 16 * ROWB; i += NTHREADS * 16) *(LAS u32x4*)(L + LS + i) = (u32x4){0, 0, 0, 0};
    __syncthreads();
    if (!GLA) {
        for (int idx = F.tid; idx < 16 * 128; idx += NTHREADS) { const int j = idx >> 7, c = idx & 127, row = 48 + j;
            const float* rq = RAW + (size_t)j * ldraw + h * 256; const float* rk = rq + 1024;
            const float rev = ((float)j * ROPE_INV[c]) * 0.15915494309189535f; const float frc = rev - floorf(rev);
            const float sn = __builtin_amdgcn_sinf(frc), cs = __builtin_amdgcn_cosf(frc);
            const float dq = __builtin_amdgcn_exp2f((float)(row + 1) * L2G[h]), dk = 0.0625f * __builtin_amdgcn_exp2f(-(float)(row + 1) * L2G[h]);
            const float q1 = rq[c], q2 = rq[c + 128], k1 = rk[c], k2 = rk[c + 128];
            const int a1 = row * ROWB + ((((c >> 3)) ^ (row & 15)) << 4) + (c & 7) * 2, a2 = row * ROWB + ((((c + 128) >> 3) ^ (row & 15)) << 4) + (c & 7) * 2;
            *(LAS bf16_t*)(L + LQ + a1) = f2bf((q1 * cs - q2 * sn) * dq); *(LAS bf16_t*)(L + LQ + a2) = f2bf((q1 * sn + q2 * cs) * dq);
            *(LAS bf16_t*)(L + LK + a1) = f2bf((k1 * cs - k2 * sn) * dk); *(LAS bf16_t*)(L + LK + a2) = f2bf((k1 * sn + k2 * cs) * dk); }
        if (F.tid < 256) { const int j = F.tid >> 4, wv = F.tid & 15, tok = 48 + j;
            *(LAS bf16_t*)(L + LV + wv * 128 + (((tok >> 3) ^ ((wv >> 1) & 7)) << 4) + (tok & 7) * 2) = f2bf(RAW[(size_t)j * ldraw + 2048 + h * 512 + 16 * s + wv]); }
    } else {
        if (F.tid < 128) { const int d = F.tid; const float* wgp = F.in[13] + h * 128 + d; const float bias = F.in[14][h * 128 + d]; float cum = 0.f;
            for (int j = 0; j < 16; ++j) { float a = bias;
                for (int r = 0; r < 16; ++r) a += RAW[(size_t)j * ldraw + 3072 + r] * wgp[r * 512];
                cum += (fminf(a, 0.f) - __logf(1.0f + __expf(-fabsf(a)))) * 0.0625f;
                const int row = 48 + j;
                *(LAS bf16_t*)(L + LK + row * ROWB + (((d >> 3) ^ (row & 15)) << 4) + (d & 7) * 2) = f2bf(RAW[(size_t)j * ldraw + 512 + h * 128 + d] * __expf(-cum)); }
            *(LAS float*)(L + LDEC + d * 4) = __expf(cum); }
        if (F.tid >= 256) { const int j = (F.tid - 256) >> 4, wv = F.tid & 15, tok = 48 + j;
            *(LAS bf16_t*)(L + LV + wv * 128 + (((tok >> 3) ^ ((wv >> 1) & 7)) << 4) + (tok & 7) * 2) = f2bf(RAW[(size_t)j * ldraw + 1024 + h * 256 + 16 * s + wv]); }
    }
    f32x4 S[NT];
#pragma unroll
    for (int tt = 0; tt < NT; ++tt) S[tt] = (f32x4){0.f, 0.f, 0.f, 0.f};
    const float g64 = GLA ? 1.0f : __builtin_amdgcn_exp2f(64.0f * L2G[h]);
    const char* Qg = (const char*)(QH + (size_t)bh * SEQ * DK); const char* Kg = (const char*)(KH + (size_t)bh * SEQ * DK);
    const char* Vg = (const char*)(VT + ((size_t)bh * DV + 16 * s) * SEQ);
    __syncthreads();
    for (int c = 0; c <= 128; ++c) {
        const int buf = c & 1;
        if (c < 128) {
            const char* qc = Qg + (size_t)c * TILEB; const char* kc = Kg + (size_t)c * TILEB;
#pragma unroll
            for (int i = 0; i < NI; ++i) { const int piece = w * NI + i, off = piece * 1024 + lane * 16, row = off / ROWB, p = (off % ROWB) >> 4; const int so = row * ROWB + ((p ^ (row & 15)) << 4);
                __builtin_amdgcn_global_load_lds((const unsigned*)(qc + so), (LAS unsigned*)(L + LQ + (buf ^ 1) * TILEB + piece * 1024), 16, 0, 0);
                __builtin_amdgcn_global_load_lds((const unsigned*)(kc + so), (LAS unsigned*)(L + LK + (buf ^ 1) * TILEB + piece * 1024), 16, 0, 0); }
            if (w < 2) { const int off = w * 1024 + lane * 16, wv = off >> 7, p = (off & 127) >> 4;
                __builtin_amdgcn_global_load_lds((const unsigned*)(Vg + (size_t)wv * SEQ * 2 + (size_t)c * 128 + ((p ^ ((wv >> 1) & 7)) << 4)), (LAS unsigned*)(L + LV + (buf ^ 1) * 2048 + w * 1024), 16, 0, 0); }
        }
        { const int ti = w >> 1, tj0 = 2 * (w & 1); f32x4 pt0 = (f32x4){0.f, 0.f, 0.f, 0.f}, pt1 = pt0;
          const int qrow = 16 * ti + r16, kr0 = 16 * tj0 + r16, kr1 = kr0 + 16;
          const LAS unsigned char* qb = L + LQ + buf * TILEB + qrow * ROWB; const LAS unsigned char* kb0 = L + LK + buf * TILEB + kr0 * ROWB; const LAS unsigned char* kb1 = L + LK + buf * TILEB + kr1 * ROWB;
#pragma unroll
          for (int ks = 0; ks < DK / 32; ++ks) { const int ch = ((4 * ks + g) ^ r16) << 4;
              const bf16x8 qf = *(const LAS bf16x8*)(qb + ch), k0 = *(const LAS bf16x8*)(kb0 + ch), k1 = *(const LAS bf16x8*)(kb1 + ch);
              pt0 = __builtin_amdgcn_mfma_f32_16x16x32_bf16(k0, qf, pt0, 0, 0, 0); pt1 = __builtin_amdgcn_mfma_f32_16x16x32_bf16(k1, qf, pt1, 0, 0, 0); }
          const int i = qrow;
#pragma unroll
          for (int tjj = 0; tjj < 2; ++tjj) { const f32x4 pt = tjj ? pt1 : pt0; const int tj = tj0 + tjj, j0 = 16 * tj + 4 * g;
              const float v0 = (j0 + 0 <= i) ? pt[0] : 0.f, v1 = (j0 + 1 <= i) ? pt[1] : 0.f, v2 = (j0 + 2 <= i) ? pt[2] : 0.f, v3 = (j0 + 3 <= i) ? pt[3] : 0.f;
              u32x2 pk; pk.x = cvt_pk_bf16(v0, v1); pk.y = cvt_pk_bf16(v2, v3);
              *(LAS u32x2*)(L + LP + i * 128 + (((2 * tj + (g >> 1)) ^ ((i >> 1) & 7)) << 4) + (g & 1) * 8) = pk; } }
        LDS_WAIT(); __builtin_amdgcn_s_barrier(); asm volatile("" ::: "memory");
        if (w < 4) { const int irow = 16 * w + r16; f32x4 ot = (f32x4){0.f, 0.f, 0.f, 0.f};
#pragma unroll
            for (int ks = 0; ks < 2; ++ks) {
                const bf16x8 va = *(const LAS bf16x8*)(L + LV + buf * 2048 + r16 * 128 + (((4 * ks + g) ^ ((r16 >> 1) & 7)) << 4));
                const bf16x8 pb = *(const LAS bf16x8*)(L + LP + irow * 128 + (((4 * ks + g) ^ ((irow >> 1) & 7)) << 4));
                ot = __builtin_amdgcn_mfma_f32_16x16x32_bf16(va, pb, ot, 0, 0, 0); }
#pragma unroll
            for (int ks = 0; ks < DK / 32; ++ks) { const int ch = ((4 * ks + g) ^ r16) << 4;
                const bf16x8 sa = *(const LAS bf16x8*)(L + LS + buf * 16 * ROWB + r16 * ROWB + ch);
                const bf16x8 qb = *(const LAS bf16x8*)(L + LQ + buf * TILEB + irow * ROWB + ch);
                ot = __builtin_amdgcn_mfma_f32_16x16x32_bf16(sa, qb, ot, 0, 0, 0); }
            float ss = (ot[0] * ot[0] + ot[1] * ot[1]) + (ot[2] * ot[2] + ot[3] * ot[3]);
            ss += __shfl_xor(ss, 16); ss += __shfl_xor(ss, 32);
            if (c >= 1) { const size_t grow = (size_t)b * SEQ + (c - 1) * 64 + irow;
                u32x2 pk; pk.x = cvt_pk_bf16(ot[0], ot[1]); pk.y = cvt_pk_bf16(ot[2], ot[3]);
                *(u32x2*)(O + grow * LDO + h * DV + 16 * s + 4 * g) = pk;
                if (g == 0) atomicAdd(OSS + grow * 4 + h, ss);
            } else if (!GLA && b == 0 && irow >= 48) { float* MO = WSP(float, WS_META + META_MO); float* MOSS = WSP(float, WS_CTL + CTL_MOSS);
                *(f32x4*)(MO + (size_t)(irow - 48) * 2048 + h * 512 + 16 * s + 4 * g) = ot;
                if (g == 0) atomicAdd(MOSS + (irow - 48) * 4 + h, ss); } }
        {
#pragma unroll
          for (int ks = 0; ks < 2; ++ks) {
              const bf16x8 vb = *(const LAS bf16x8*)(L + LV + buf * 2048 + r16 * 128 + (((4 * ks + g) ^ ((r16 >> 1) & 7)) << 4));
#pragma unroll
              for (int tt = 0; tt < NT; ++tt) { const int d0 = 16 * (w + 8 * tt), dcol = d0 + 4 * (r16 & 3), chunk = dcol >> 3, sub = (dcol & 7) * 2;
                  const int r1 = 32 * ks + 8 * g + (r16 >> 2), r2 = r1 + 4;
                  const s16x4 lo = ds_tr(L + LK + buf * TILEB + r1 * ROWB + ((chunk ^ (r1 & 15)) << 4) + sub);
                  const s16x4 hi = ds_tr(L + LK + buf * TILEB + r2 * ROWB + ((chunk ^ (r2 & 15)) << 4) + sub);
                  const bf16x8 ka = (bf16x8){lo[0], lo[1], lo[2], lo[3], hi[0], hi[1], hi[2], hi[3]};
                  S[tt] = __builtin_amdgcn_mfma_f32_16x16x32_bf16(ka, vb, S[tt], 0, 0, 0); } }
#pragma unroll
          for (int tt = 0; tt < NT; ++tt) { const int tile = w + 8 * tt;
              if (GLA) { const f32x4 dc = *(const LAS f32x4*)(L + LDEC + buf * DK * 4 + (16 * tile + 4 * g) * 4); S[tt] = S[tt] * dc; } else S[tt] = S[tt] * g64;
              u32x2 pk; pk.x = cvt_pk_bf16(S[tt][0], S[tt][1]); pk.y = cvt_pk_bf16(S[tt][2], S[tt][3]);
              *(LAS u32x2*)(L + LS + (buf ^ 1) * 16 * ROWB + r16 * ROWB + (((2 * tile + (g >> 1)) ^ r16) << 4) + (g & 1) * 8) = pk; } }
        if (GLA && c < 128 && F.tid < DK) *(LAS float*)(L + LDEC + (buf ^ 1) * DK * 4 + F.tid * 4) = __expf(BC[(size_t)(b * SEQ + c * 64 + 63) * 512 + h * 128 + F.tid]);
        __syncthreads();
    }
}

__device__ __forceinline__ bf16x8 gload16(const void* p) { bf16x8 r; asm volatile("global_load_dwordx4 %0, %1, off" : "=v"(r) : "v"(p) : "memory"); return r; }
__device__ __forceinline__ void glds_touch(const void* gsrc, unsigned lds_dst) { unsigned keep; asm volatile("s_mov_b32 %0, m0\n\ts_mov_b32 m0, %2\n\ts_nop 0\n\tglobal_load_lds_dword %1, off\n\ts_mov_b32 m0, %0" : "=&s"(keep) : "v"(gsrc), "s"(lds_dst) : "memory"); }
#define S2_WAITV(n) asm volatile("s_waitcnt vmcnt(" #n ")" ::: "memory")
template <int DK, int DV, bool GLA>
__device__ __forceinline__ void s2v2_phase(Frame& F, const bf16_t* QH, const bf16_t* KH, const bf16_t* VT, bf16_t* O, float* OSS, const float* BC, int ldraw) {
    constexpr int NS = DV / 16, ROWB = DK * 2, TILEB = 64 * ROWB, NI = TILEB / 1024 / 8, NT = DK / 128, LDO = 4 * DV, KS = DK / 32;
    constexpr int LK = 0, LV = 3 * TILEB, LDEC = LV + 3 * 2048, LP = LDEC + 3 * 1024, LS = LP + 8192, LOT = LS + 2 * 16 * ROWB, LQM = LOT + 4096, LEND = LQM + 16 * ROWB;
    static_assert(LEND <= LDS_MISC, "S2 LDS map");
    const int unit = blockIdx.x; if (unit >= 8 * NS) return;
    const int bh = unit & 7, s = unit >> 3, b = bh >> 2, h = bh & 3;
    const int lane = F.lane, g = lane >> 4, r16 = lane & 15, w = F.wave, ti = w >> 1, hf = w & 1;
    LAS unsigned char* L = F.lds; const unsigned Lb = (unsigned)(uintptr_t)L;
    const float* RAW = WSP(float, WS_META + META_RAW);
    const char* Qg = (const char*)(QH + (size_t)bh * SEQ * DK); const char* Kg = (const char*)(KH + (size_t)bh * SEQ * DK);
    const char* Vg = (const char*)(VT + ((size_t)bh * DV + 16 * s) * SEQ);
    const char* qlane = Qg + (size_t)(16 * ti + r16) * ROWB + g * 16;
    bf16x8 q0[KS], q1[KS], q2[KS];
#define S2_ISSUE(c_, QSET) do { const int rc_ = (c_) - 1, st_ = (c_) % 3; const char* kc_ = Kg + (size_t)rc_ * TILEB; \
        _Pragma("unroll") for (int i_ = 0; i_ < NI; ++i_) { const int piece_ = w * NI + i_, off_ = piece_ * 1024 + lane * 16, row_ = off_ / ROWB, p_ = (off_ % ROWB) >> 4; \
            __builtin_amdgcn_global_load_lds((const unsigned*)(kc_ + row_ * ROWB + ((p_ ^ (row_ & 15)) << 4)), (LAS unsigned*)(L + LK + st_ * TILEB + piece_ * 1024), 16, 0, 0); } \
        if (w < 2) { const int off_ = w * 1024 + lane * 16, wv_ = off_ >> 7, p_ = (off_ & 127) >> 4; \
            __builtin_amdgcn_global_load_lds((const unsigned*)(Vg + (size_t)wv_ * SEQ * 2 + (size_t)rc_ * 128 + ((p_ ^ ((wv_ >> 1) & 7)) << 4)), (LAS unsigned*)(L + LV + st_ * 2048 + w * 1024), 16, 0, 0); } \
        if (GLA && w == 2) __builtin_amdgcn_global_load_lds((const unsigned*)((const char*)(BC + (size_t)(b * SEQ + rc_ * 64 + 63) * 512 + h * 128) + lane * 16), (LAS unsigned*)(L + LDEC + st_ * 1024), 16, 0, 0); \
        _Pragma("unroll") for (int k_ = 0; k_ < KS; ++k_) QSET[k_] = gload16(qlane + (size_t)rc_ * TILEB + k_ * 64); } while (0)
#define S2_WAIT_PREV() do { if (w < 2 || (GLA && w == 2)) { if (NI + KS + 1 == 13) S2_WAITV(13); else S2_WAITV(7); } else { if (NI + KS == 12) S2_WAITV(12); else S2_WAITV(6); } } while (0)
    static_assert((NI + KS == 12) || (NI + KS == 6), "S2 wait immediates");
    for (int i = F.tid * 16; i < TILEB; i += NTHREADS * 16) *(LAS u32x4*)(L + LK + i) = (u32x4){0, 0, 0, 0};
    for (int i = F.tid * 16; i < 2048; i += NTHREADS * 16) *(LAS u32x4*)(L + LV + i) = (u32x4){0, 0, 0, 0};
    for (int i = F.tid * 16; i < 16 * ROWB; i += NTHREADS * 16) { *(LAS u32x4*)(L + LS + i) = (u32x4){0, 0, 0, 0}; *(LAS u32x4*)(L + LQM + i) = (u32x4){0, 0, 0, 0}; }
    __syncthreads();
    if (!GLA) {
        for (int idx = F.tid; idx < 16 * 128; idx += NTHREADS) { const int j = idx >> 7, c = idx & 127, row = 48 + j;
            const float* rq = RAW + (size_t)j * ldraw + h * 256; const float* rk = rq + 1024;
            const float rev = ((float)j * ROPE_INV[c]) * 0.15915494309189535f; const float frc = rev - floorf(rev);
            const float sn = __builtin_amdgcn_sinf(frc), cs = __builtin_amdgcn_cosf(frc);
            const float dq = __builtin_amdgcn_exp2f((float)(row + 1) * L2G[h]), dk = 0.0625f * __builtin_amdgcn_exp2f(-(float)(row + 1) * L2G[h]);
            const float q1v = rq[c], q2v = rq[c + 128], k1 = rk[c], k2 = rk[c + 128];
            const int a1 = row * ROWB + ((((c >> 3)) ^ (row & 15)) << 4) + (c & 7) * 2, a2 = row * ROWB + ((((c + 128) >> 3) ^ (row & 15)) << 4) + (c & 7) * 2;
            *(LAS bf16_t*)(L + LQM + j * ROWB + c * 2) = f2bf((q1v * cs - q2v * sn) * dq); *(LAS bf16_t*)(L + LQM + j * ROWB + (c + 128) * 2) = f2bf((q1v * sn + q2v * cs) * dq);
            *(LAS bf16_t*)(L + LK + a1) = f2bf((k1 * cs - k2 * sn) * dk); *(LAS bf16_t*)(L + LK + a2) = f2bf((k1 * sn + k2 * cs) * dk); }
        if (F.tid < 256) { const int j = F.tid >> 4, wv = F.tid & 15, tok = 48 + j;
            *(LAS bf16_t*)(L + LV + wv * 128 + (((tok >> 3) ^ ((wv >> 1) & 7)) << 4) + (tok & 7) * 2) = f2bf(RAW[(size_t)j * ldraw + 2048 + h * 512 + 16 * s + wv]); }
    } else {
        if (F.tid < 128) { const int d = F.tid; const float* wgp = F.in[13] + h * 128 + d; const float bias = F.in[14][h * 128 + d]; float cum = 0.f;
            for (int j = 0; j < 16; ++j) { float a = bias;
                for (int r = 0; r < 16; ++r) a += RAW[(size_t)j * ldraw + 3072 + r] * wgp[r * 512];
                cum += (fminf(a, 0.f) - __logf(1.0f + __expf(-fabsf(a)))) * 0.0625f;
                const int row = 48 + j;
                *(LAS bf16_t*)(L + LK + row * ROWB + (((d >> 3) ^ (row & 15)) << 4) + (d & 7) * 2) = f2bf(RAW[(size_t)j * ldraw + 512 + h * 128 + d] * __expf(-cum)); }
            *(LAS float*)(L + LDEC + d * 4) = cum; }
        if (F.tid >= 256) { const int j = (F.tid - 256) >> 4, wv = F.tid & 15, tok = 48 + j;
            *(LAS bf16_t*)(L + LV + wv * 128 + (((tok >> 3) ^ ((wv >> 1) & 7)) << 4) + (tok & 7) * 2) = f2bf(RAW[(size_t)j * ldraw + 1024 + h * 256 + 16 * s + wv]); }
    }
    f32x4 S[NT];
#pragma unroll
    for (int tt = 0; tt < NT; ++tt) S[tt] = (f32x4){0.f, 0.f, 0.f, 0.f};
    const float g64 = GLA ? 1.0f : __builtin_amdgcn_exp2f(64.0f * L2G[h]);
    __syncthreads();
#pragma unroll
    for (int k = 0; k < KS; ++k) { q0[k] = *(const LAS bf16x8*)(L + LQM + (ti == 3 ? r16 : 0) * ROWB + (4 * k + g) * 16); if (ti != 3) q0[k] = (bf16x8){0, 0, 0, 0, 0, 0, 0, 0}; q1[k] = q0[k]; q2[k] = q0[k]; }
    LDS_WAIT();
    S2_ISSUE(1, q1);
    f32x4 ot_prev = (f32x4){0.f, 0.f, 0.f, 0.f}; float ss_prev = 0.f;
#define S2_STEP(c_, QC, QN2) do { const int c = (c_), st = c % 3, sb = c & 1; \
          \
        if (hf == 0 && c >= 1) { const f32x4 part = *(const LAS f32x4*)(L + LOT + ti * 1024 + lane * 16); const f32x4 ot = ot_prev + part; const int irow = 16 * ti + r16; \
            if (c >= 2) { const size_t grow = (size_t)b * SEQ + (c - 2) * 64 + irow; u32x2 pk; pk.x = cvt_pk_bf16(ot[0], ot[1]); pk.y = cvt_pk_bf16(ot[2], ot[3]); \
                *(u32x2*)(O + grow * LDO + h * DV + 16 * s + 4 * g) = pk; } \
            else if (!GLA && b == 0 && irow >= 48) { float* MO = WSP(float, WS_META + META_MO); \
                *(f32x4*)(MO + (size_t)(irow - 48) * 2048 + h * 512 + 16 * s + 4 * g) = ot; } } \
        if (c + 2 <= 128) S2_ISSUE(c + 2, QN2); \
          \
        { const int tj0 = 2 * hf; f32x4 pt0 = (f32x4){0.f, 0.f, 0.f, 0.f}, pt1 = pt0; \
          const LAS unsigned char* kb0 = L + LK + st * TILEB + (16 * tj0 + r16) * ROWB; const LAS unsigned char* kb1 = kb0 + 16 * ROWB; \
          _Pragma("unroll") for (int ks = 0; ks < KS; ++ks) { const int ch = ((4 * ks + g) ^ r16) << 4; \
              const bf16x8 k0 = *(const LAS bf16x8*)(kb0 + ch), k1 = *(const LAS bf16x8*)(kb1 + ch); \
              pt0 = __builtin_amdgcn_mfma_f32_16x16x32_bf16(k0, QC[ks], pt0, 0, 0, 0); pt1 = __builtin_amdgcn_mfma_f32_16x16x32_bf16(k1, QC[ks], pt1, 0, 0, 0); } \
          const int i = 16 * ti + r16; \
          _Pragma("unroll") for (int tjj = 0; tjj < 2; ++tjj) { const f32x4 pt = tjj ? pt1 : pt0; const int tj = tj0 + tjj, j0 = 16 * tj + 4 * g; \
              const float v0 = (j0 + 0 <= i) ? pt[0] : 0.f, v1 = (j0 + 1 <= i) ? pt[1] : 0.f, v2 = (j0 + 2 <= i) ? pt[2] : 0.f, v3 = (j0 + 3 <= i) ? pt[3] : 0.f; \
              u32x2 pk; pk.x = cvt_pk_bf16(v0, v1); pk.y = cvt_pk_bf16(v2, v3); \
              *(LAS u32x2*)(L + LP + i * 128 + (((2 * tj + (g >> 1)) ^ ((i >> 1) & 7)) << 4) + (g & 1) * 8) = pk; } } \
        LDS_WAIT(); __builtin_amdgcn_s_barrier(); asm volatile("" ::: "memory"); \
          \
        { const int irow = 16 * ti + r16; f32x4 ot = (f32x4){0.f, 0.f, 0.f, 0.f}; \
          if (hf == 0) { _Pragma("unroll") for (int ks = 0; ks < 2; ++ks) { \
                const bf16x8 va = *(const LAS bf16x8*)(L + LV + st * 2048 + r16 * 128 + (((4 * ks + g) ^ ((r16 >> 1) & 7)) << 4)); \
                const bf16x8 pb = *(const LAS bf16x8*)(L + LP + irow * 128 + (((4 * ks + g) ^ ((irow >> 1) & 7)) << 4)); \
                ot = __builtin_amdgcn_mfma_f32_16x16x32_bf16(va, pb, ot, 0, 0, 0); } } \
          if (hf == 0) { _Pragma("unroll") for (int kk = 0; kk < KS / 2; ++kk) { \
              const bf16x8 sa = *(const LAS bf16x8*)(L + LS + sb * 16 * ROWB + r16 * ROWB + (((4 * kk + g) ^ r16) << 4)); \
              ot = __builtin_amdgcn_mfma_f32_16x16x32_bf16(sa, QC[kk], ot, 0, 0, 0); } } \
          else { _Pragma("unroll") for (int kk = KS / 2; kk < KS; ++kk) { \
              const bf16x8 sa = *(const LAS bf16x8*)(L + LS + sb * 16 * ROWB + r16 * ROWB + (((4 * kk + g) ^ r16) << 4)); \
              ot = __builtin_amdgcn_mfma_f32_16x16x32_bf16(sa, QC[kk], ot, 0, 0, 0); } } \
          if (hf == 1) *(LAS f32x4*)(L + LOT + ti * 1024 + lane * 16) = ot; else ot_prev = ot; } \
          \
        { s16x4 klo[2][NT], khi[2][NT]; bf16x8 vbb[2]; \
          _Pragma("unroll") for (int ks = 0; ks < 2; ++ks) { \
              vbb[ks] = *(const LAS bf16x8*)(L + LV + st * 2048 + r16 * 128 + (((4 * ks + g) ^ ((r16 >> 1) & 7)) << 4)); \
              _Pragma("unroll") for (int tt = 0; tt < NT; ++tt) { const int d0 = 16 * (w + 8 * tt), dcol = d0 + 4 * (r16 & 3), chunk = dcol >> 3, sub = (dcol & 7) * 2; \
                  const int r1 = 32 * ks + 8 * g + (r16 >> 2), r2 = r1 + 4; \
                  klo[ks][tt] = ds_tr_asm(Lb + LK + st * TILEB + r1 * ROWB + ((chunk ^ (r1 & 15)) << 4) + sub); \
                  khi[ks][tt] = ds_tr_asm(Lb + LK + st * TILEB + r2 * ROWB + ((chunk ^ (r2 & 15)) << 4) + sub); } } \
          asm volatile("s_waitcnt lgkmcnt(0)" ::: "memory"); __builtin_amdgcn_sched_barrier(0); \
          _Pragma("unroll") for (int ks = 0; ks < 2; ++ks) _Pragma("unroll") for (int tt = 0; tt < NT; ++tt) { \
                  const s16x4 lo = klo[ks][tt], hi = khi[ks][tt]; \
                  const bf16x8 ka = (bf16x8){lo[0], lo[1], lo[2], lo[3], hi[0], hi[1], hi[2], hi[3]}; \
                  S[tt] = __builtin_amdgcn_mfma_f32_16x16x32_bf16(ka, vbb[ks], S[tt], 0, 0, 0); } \
          _Pragma("unroll") for (int tt = 0; tt < NT; ++tt) { const int tile = w + 8 * tt; \
              if (GLA) { const f32x4 dl = *(const LAS f32x4*)(L + LDEC + st * 1024 + (16 * tile + 4 * g) * 4); \
                  S[tt][0] *= __expf(dl[0]); S[tt][1] *= __expf(dl[1]); S[tt][2] *= __expf(dl[2]); S[tt][3] *= __expf(dl[3]); } else S[tt] = S[tt] * g64; \
              u32x2 pk; pk.x = cvt_pk_bf16(S[tt][0], S[tt][1]); pk.y = cvt_pk_bf16(S[tt][2], S[tt][3]); \
              *(LAS u32x2*)(L + LS + (sb ^ 1) * 16 * ROWB + r16 * ROWB + (((2 * tile + (g >> 1)) ^ r16) << 4) + (g & 1) * 8) = pk; } } \
          \
        if (c + 2 <= 128) S2_WAIT_PREV(); else S2_WAITV(0); \
        LDS_WAIT(); __builtin_amdgcn_s_barrier(); asm volatile("" ::: "memory"); __builtin_amdgcn_sched_barrier(0); \
    } while (0)
#define S2_PIN(Q) do { _Pragma("unroll") for (int k_ = 0; k_ < KS; ++k_) asm volatile("" : "+v"(Q[k_])); } while (0)
    for (int c3 = 0; c3 < 129; c3 += 3) {
        S2_STEP(c3, q0, q2);     S2_PIN(q1);
        S2_STEP(c3 + 1, q1, q0); S2_PIN(q2);
        S2_STEP(c3 + 2, q2, q1); S2_PIN(q0);
    }
    if (hf == 0) { const f32x4 part = *(const LAS f32x4*)(L + LOT + ti * 1024 + lane * 16); const f32x4 ot = ot_prev + part; const int irow = 16 * ti + r16;
        const size_t grow = (size_t)b * SEQ + 127 * 64 + irow; u32x2 pk; pk.x = cvt_pk_bf16(ot[0], ot[1]); pk.y = cvt_pk_bf16(ot[2], ot[3]);
        *(u32x2*)(O + grow * LDO + h * DV + 16 * s + 4 * g) = pk; }
#undef S2_ISSUE
#undef S2_WAIT_PREV
#undef S2_STEP
#undef S2_PIN
}

template <int DK, int DV, bool GLA>
__device__ __forceinline__ void s2v3_phase(Frame& F, const bf16_t* QH, const bf16_t* KH, const bf16_t* VT, bf16_t* O, const float* BC, int ldraw) {
    constexpr int NS = DV / 16, ROWB = DK * 2, TILEB = 64 * ROWB, NIL = TILEB / 1024 / 4, NTU = DK / 64, LDO = 4 * DV, KS = DK / 32;
    constexpr int LK = 0, LV = 3 * TILEB, LDEC = LV + 3 * 2048, LP = LDEC + 3 * 1024, LS = LP + 8192, LOT = LS + 2 * 16 * ROWB, LQM = LOT + 4096, LEND = LQM + 16 * ROWB;
    static_assert(LEND <= LDS_MISC, "S2 LDS map");
    static_assert((NIL + KS == 16) || (NIL + KS == 8), "S2 wait immediates");
    const int unit = blockIdx.x; if (unit >= 8 * NS) return;
    const int bh = unit & 7, s = unit >> 3, b = bh >> 2, h = bh & 3;
    const int lane = F.lane, g = lane >> 4, r16 = lane & 15, w = F.wave, ti = w >> 1, hf = w & 1;
    LAS unsigned char* L = F.lds; const unsigned Lb = (unsigned)(uintptr_t)L;
    const float* RAW = WSP(float, WS_META + META_RAW);
    const char* Qg = (const char*)(QH + (size_t)bh * SEQ * DK); const char* Kg = (const char*)(KH + (size_t)bh * SEQ * DK);
    const char* Vg = (const char*)(VT + ((size_t)bh * DV + 16 * s) * SEQ);
    const char* qlane = Qg + (size_t)(16 * ti + r16) * ROWB + g * 16;
    bf16x8 q0[KS], q1[KS], q2[KS];
#define S3_ISSUE(c_, ST_, QSET) do { unsigned lzi_ = 0; asm volatile("" : "+v"(lzi_)); const int rc_ = (c_) - 1; constexpr int st_ = (ST_); const char* kc_ = Kg + (size_t)rc_ * TILEB + lzi_; \
        _Pragma("unroll") for (int i_ = 0; i_ < NIL; ++i_) { const int piece_ = ti * NIL + i_, off_ = piece_ * 1024 + lane * 16, row_ = off_ / ROWB, p_ = (off_ % ROWB) >> 4; \
            __builtin_amdgcn_global_load_lds((const unsigned*)(kc_ + row_ * ROWB + ((p_ ^ (row_ & 15)) << 4)), (LAS unsigned*)(L + LK + st_ * TILEB + piece_ * 1024), 16, 0, 0); } \
        if (ti < 2) { const int off_ = ti * 1024 + lane * 16, wv_ = off_ >> 7, p_ = (off_ & 127) >> 4; \
            __builtin_amdgcn_global_load_lds((const unsigned*)(Vg + (size_t)wv_ * SEQ * 2 + (size_t)rc_ * 128 + ((p_ ^ ((wv_ >> 1) & 7)) << 4)), (LAS unsigned*)(L + LV + st_ * 2048 + ti * 1024), 16, 0, 0); } \
        if (GLA && ti == 2) __builtin_amdgcn_global_load_lds((const unsigned*)((const char*)(BC + (size_t)(b * SEQ + rc_ * 64 + 63) * 512 + h * 128) + lane * 16), (LAS unsigned*)(L + LDEC + st_ * 1024), 16, 0, 0); \
        _Pragma("unroll") for (int k_ = 0; k_ < KS; ++k_) QSET[k_] = gload16(qlane + (size_t)rc_ * TILEB + k_ * 64); } while (0)
#define S3_WAIT_PREV() do { if (ti < 2 || (GLA && ti == 2)) { if (NIL + KS == 16) S2_WAITV(17); else S2_WAITV(9); } else { if (NIL + KS == 16) S2_WAITV(16); else S2_WAITV(8); } } while (0)
    for (int i = F.tid * 16; i < TILEB; i += NTHREADS * 16) *(LAS u32x4*)(L + LK + i) = (u32x4){0, 0, 0, 0};
    for (int i = F.tid * 16; i < 2048; i += NTHREADS * 16) *(LAS u32x4*)(L + LV + i) = (u32x4){0, 0, 0, 0};
    for (int i = F.tid * 16; i < 16 * ROWB; i += NTHREADS * 16) { *(LAS u32x4*)(L + LS + i) = (u32x4){0, 0, 0, 0}; *(LAS u32x4*)(L + LQM + i) = (u32x4){0, 0, 0, 0}; }
    __syncthreads();
    if (!GLA) {
        for (int idx = F.tid; idx < 16 * 128; idx += NTHREADS) { const int j = idx >> 7, c = idx & 127, row = 48 + j;
            const float* rq = RAW + (size_t)j * ldraw + h * 256; const float* rk = rq + 1024;
            const float rev = ((float)j * ROPE_INV[c]) * 0.15915494309189535f; const float frc = rev - floorf(rev);
            const float sn = __builtin_amdgcn_sinf(frc), cs = __builtin_amdgcn_cosf(frc);
            const float dq = __builtin_amdgcn_exp2f((float)(row + 1) * L2G[h]), dk = 0.0625f * __builtin_amdgcn_exp2f(-(float)(row + 1) * L2G[h]);
            const float q1v = rq[c], q2v = rq[c + 128], k1 = rk[c], k2 = rk[c + 128];
            const int a1 = row * ROWB + ((((c >> 3)) ^ (row & 15)) << 4) + (c & 7) * 2, a2 = row * ROWB + ((((c + 128) >> 3) ^ (row & 15)) << 4) + (c & 7) * 2;
            *(LAS bf16_t*)(L + LQM + j * ROWB + c * 2) = f2bf((q1v * cs - q2v * sn) * dq); *(LAS bf16_t*)(L + LQM + j * ROWB + (c + 128) * 2) = f2bf((q1v * sn + q2v * cs) * dq);
            *(LAS bf16_t*)(L + LK + a1) = f2bf((k1 * cs - k2 * sn) * dk); *(LAS bf16_t*)(L + LK + a2) = f2bf((k1 * sn + k2 * cs) * dk); }
        if (F.tid < 256) { const int j = F.tid >> 4, wv = F.tid & 15, tok = 48 + j;
            *(LAS bf16_t*)(L + LV + wv * 128 + (((tok >> 3) ^ ((wv >> 1) & 7)) << 4) + (tok & 7) * 2) = f2bf(RAW[(size_t)j * ldraw + 2048 + h * 512 + 16 * s + wv]); }
    } else {
        if (F.tid < 128) { const int d = F.tid; const float* wgp = F.in[13] + h * 128 + d; const float bias = F.in[14][h * 128 + d]; float cum = 0.f;
            for (int j = 0; j < 16; ++j) { float a = bias;
                for (int r = 0; r < 16; ++r) a += RAW[(size_t)j * ldraw + 3072 + r] * wgp[r * 512];
                cum += (fminf(a, 0.f) - __logf(1.0f + __expf(-fabsf(a)))) * 0.0625f;
                const int row = 48 + j;
                *(LAS bf16_t*)(L + LK + row * ROWB + (((d >> 3) ^ (row & 15)) << 4) + (d & 7) * 2) = f2bf(RAW[(size_t)j * ldraw + 512 + h * 128 + d] * __expf(-cum)); }
            *(LAS float*)(L + LDEC + d * 4) = cum; }
        if (F.tid >= 256) { const int j = (F.tid - 256) >> 4, wv = F.tid & 15, tok = 48 + j;
            *(LAS bf16_t*)(L + LV + wv * 128 + (((tok >> 3) ^ ((wv >> 1) & 7)) << 4) + (tok & 7) * 2) = f2bf(RAW[(size_t)j * ldraw + 1024 + h * 256 + 16 * s + wv]); }
    }
    f32x4 S[NTU];
#pragma unroll
    for (int tt = 0; tt < NTU; ++tt) S[tt] = (f32x4){0.f, 0.f, 0.f, 0.f};
    const float g64 = GLA ? 1.0f : __builtin_amdgcn_exp2f(64.0f * L2G[h]);
    __syncthreads();
#pragma unroll
    for (int k = 0; k < KS; ++k) { q0[k] = *(const LAS bf16x8*)(L + LQM + (ti == 3 ? r16 : 0) * ROWB + (4 * k + g) * 16); if (ti != 3) q0[k] = (bf16x8){0, 0, 0, 0, 0, 0, 0, 0}; asm volatile("" : "=v"(q1[k])); asm volatile("" : "=v"(q2[k])); }
    LDS_WAIT();
    if (hf) S3_ISSUE(1, 1, q1);
    f32x4 ot_prev = (f32x4){0.f, 0.f, 0.f, 0.f};
#define S3_STEP(c_, ST, QC, QN2) do { const int c = (c_), sb = c & 1; constexpr int st = (ST); \
        unsigned lz_ = 0; asm volatile("" : "+v"(lz_)); LAS unsigned char* const Lz = L + lz_; const unsigned Lbz = Lb + lz_;   \
        if (hf == 0) { \
              \
            if (c >= 1) { const f32x4 part = *(const LAS f32x4*)(Lz + LOT + ti * 1024 + lane * 16); const f32x4 ot = ot_prev + part; const int irow = 16 * ti + r16; \
                if (c >= 2) { const size_t grow = (size_t)b * SEQ + (c - 2) * 64 + irow; u32x2 pk; pk.x = cvt_pk_bf16(ot[0], ot[1]); pk.y = cvt_pk_bf16(ot[2], ot[3]); \
                    *(u32x2*)(O + grow * LDO + h * DV + 16 * s + 4 * g) = pk; } \
                else if (!GLA && b == 0 && irow >= 48) { float* MO = WSP(float, WS_META + META_MO); *(f32x4*)(MO + (size_t)(irow - 48) * 2048 + h * 512 + 16 * s + 4 * g) = ot; } } \
              \
            { bf16x8 vbb[2]; \
              _Pragma("unroll") for (int ks = 0; ks < 2; ++ks) vbb[ks] = *(const LAS bf16x8*)(Lz + LV + st * 2048 + r16 * 128 + (((4 * ks + g) ^ ((r16 >> 1) & 7)) << 4)); \
              _Pragma("unroll") for (int tt = 0; tt < NTU; ++tt) { const int tile = ti + 4 * tt, d0 = 16 * tile, dcol = d0 + 4 * (r16 & 3), chunk = dcol >> 3, sub = (dcol & 7) * 2; \
                  s16x4 klo[2], khi[2]; \
                  _Pragma("unroll") for (int ks = 0; ks < 2; ++ks) { const int r1 = 32 * ks + 8 * g + (r16 >> 2), r2 = r1 + 4; \
                      klo[ks] = ds_tr_asm(Lbz + LK + st * TILEB + r1 * ROWB + ((chunk ^ (r1 & 15)) << 4) + sub); \
                      khi[ks] = ds_tr_asm(Lbz + LK + st * TILEB + r2 * ROWB + ((chunk ^ (r2 & 15)) << 4) + sub); } \
                  asm volatile("s_waitcnt lgkmcnt(0)" ::: "memory"); __builtin_amdgcn_sched_barrier(0); \
                  _Pragma("unroll") for (int ks = 0; ks < 2; ++ks) { const s16x4 lo = klo[ks], hi = khi[ks]; \
                      const bf16x8 ka = (bf16x8){lo[0], lo[1], lo[2], lo[3], hi[0], hi[1], hi[2], hi[3]}; \
                      S[tt] = __builtin_amdgcn_mfma_f32_16x16x32_bf16(ka, vbb[ks], S[tt], 0, 0, 0); } \
                  if (GLA) { const f32x4 dl = *(const LAS f32x4*)(Lz + LDEC + st * 1024 + (16 * tile + 4 * g) * 4); \
                      S[tt][0] *= __expf(dl[0]); S[tt][1] *= __expf(dl[1]); S[tt][2] *= __expf(dl[2]); S[tt][3] *= __expf(dl[3]); } else S[tt] = S[tt] * g64; \
                  u32x2 pk; pk.x = cvt_pk_bf16(S[tt][0], S[tt][1]); pk.y = cvt_pk_bf16(S[tt][2], S[tt][3]); \
                  *(LAS u32x2*)(Lz + LS + (sb ^ 1) * 16 * ROWB + r16 * ROWB + (((2 * tile + (g >> 1)) ^ r16) << 4) + (g & 1) * 8) = pk; } } \
        } else { \
            if (c + 2 <= 128) S3_ISSUE(c + 2, (ST + 2) % 3, QN2); \
              \
            { const LAS unsigned char* kb = Lz + LK + st * TILEB + r16 * ROWB; const int i = 16 * ti + r16; \
              _Pragma("unroll") for (int th = 0; th < 2; ++th) { f32x4 pa = (f32x4){0.f, 0.f, 0.f, 0.f}, pb = pa; \
                  if (2 * th <= ti) { \
                      _Pragma("unroll") for (int ks = 0; ks < KS; ++ks) { const int ch = ((4 * ks + g) ^ r16) << 4; \
                          const bf16x8 ka = *(const LAS bf16x8*)(kb + (2 * th) * 16 * ROWB + ch), kc2 = *(const LAS bf16x8*)(kb + (2 * th + 1) * 16 * ROWB + ch); \
                          pa = __builtin_amdgcn_mfma_f32_16x16x32_bf16(ka, QC[ks], pa, 0, 0, 0); pb = __builtin_amdgcn_mfma_f32_16x16x32_bf16(kc2, QC[ks], pb, 0, 0, 0); \
                          if (ks & 1) __builtin_amdgcn_sched_barrier(0); } } \
                  _Pragma("unroll") for (int tq = 0; tq < 2; ++tq) { const int tj = 2 * th + tq, j0 = 16 * tj + 4 * g; const f32x4 pt = tq ? pb : pa; \
                      const float v0 = (j0 + 0 <= i) ? pt[0] : 0.f, v1 = (j0 + 1 <= i) ? pt[1] : 0.f, v2 = (j0 + 2 <= i) ? pt[2] : 0.f, v3 = (j0 + 3 <= i) ? pt[3] : 0.f; \
                      u32x2 pk; pk.x = cvt_pk_bf16(v0, v1); pk.y = cvt_pk_bf16(v2, v3); \
                      *(LAS u32x2*)(Lz + LP + i * 128 + (((2 * tj + (g >> 1)) ^ ((i >> 1) & 7)) << 4) + (g & 1) * 8) = pk; } } } \
        } \
        LDS_WAIT(); __builtin_amdgcn_s_barrier(); asm volatile("" ::: "memory"); \
        if (hf == 0) {   \
            const int irow = 16 * ti + r16; f32x4 ot = (f32x4){0.f, 0.f, 0.f, 0.f}; \
            _Pragma("unroll") for (int ks = 0; ks < 2; ++ks) { \
                const bf16x8 va = *(const LAS bf16x8*)(Lz + LV + st * 2048 + r16 * 128 + (((4 * ks + g) ^ ((r16 >> 1) & 7)) << 4)); \
                const bf16x8 pb = *(const LAS bf16x8*)(Lz + LP + irow * 128 + (((4 * ks + g) ^ ((irow >> 1) & 7)) << 4)); \
                ot = __builtin_amdgcn_mfma_f32_16x16x32_bf16(va, pb, ot, 0, 0, 0); } \
            ot_prev = ot; \
        } else {   \
            f32x4 oa = (f32x4){0.f, 0.f, 0.f, 0.f}, ob = oa; \
            _Pragma("unroll") for (int ks = 0; ks < KS; ks += 2) { \
                const bf16x8 sa = *(const LAS bf16x8*)(Lz + LS + sb * 16 * ROWB + r16 * ROWB + (((4 * ks + g) ^ r16) << 4)); \
                const bf16x8 sc = *(const LAS bf16x8*)(Lz + LS + sb * 16 * ROWB + r16 * ROWB + (((4 * (ks + 1) + g) ^ r16) << 4)); \
                oa = __builtin_amdgcn_mfma_f32_16x16x32_bf16(sa, QC[ks], oa, 0, 0, 0); ob = __builtin_amdgcn_mfma_f32_16x16x32_bf16(sc, QC[ks + 1], ob, 0, 0, 0); __builtin_amdgcn_sched_barrier(0); } \
            *(LAS f32x4*)(Lz + LOT + ti * 1024 + lane * 16) = oa + ob; \
            if (c + 2 <= 128) S3_WAIT_PREV(); else S2_WAITV(0); \
        } \
        LDS_WAIT(); __builtin_amdgcn_s_barrier(); asm volatile("" ::: "memory"); __builtin_amdgcn_sched_barrier(0); \
    } while (0)
#define S3_PIN(Q) do { _Pragma("unroll") for (int k_ = 0; k_ < KS; ++k_) asm volatile("" : "+v"(Q[k_])); } while (0)
    for (int c3 = 0; c3 < 129; c3 += 3) {
        S3_STEP(c3, 0, q0, q2);     S3_PIN(q1);
        S3_STEP(c3 + 1, 1, q1, q0); S3_PIN(q2);
        S3_STEP(c3 + 2, 2, q2, q1); S3_PIN(q0);
    }
    if (hf == 0) { const f32x4 part = *(const LAS f32x4*)(L + LOT + ti * 1024 + lane * 16); const f32x4 ot = ot_prev + part; const int irow = 16 * ti + r16;
        const size_t grow = (size_t)b * SEQ + 127 * 64 + irow; u32x2 pk; pk.x = cvt_pk_bf16(ot[0], ot[1]); pk.y = cvt_pk_bf16(ot[2], ot[3]);
        *(u32x2*)(O + grow * LDO + h * DV + 16 * s + 4 * g) = pk; }
#undef S3_ISSUE
#undef S3_WAIT_PREV
#undef S3_STEP
#undef S3_PIN
}

template <int DK, int DV, bool GLA>
__device__ __forceinline__ void s2v4_phase(Frame& F, const int unit, const bf16_t* QH, const bf16_t* KH, const bf16_t* VT, bf16_t* O, const float* BC, int ldraw) {
    constexpr int NS = DV / 16, ROWB = DK * 2, TILEB = 32 * ROWB, NIL = TILEB / 1024 / 4, NTU = DK / 64, LDO = 4 * DV, KS = DK / 32, NSTEP = 257;
    constexpr int LK = 0, LQ = 3 * TILEB, LV = 6 * TILEB, LDEC = LV + 3 * 1024, LP = LDEC + 3 * 1024, LS = LP + 2048, LOT = LS + 2 * 16 * ROWB, LEND = LOT + 4096;
    static_assert(LEND + 256 <= LDS_MISC, "S2 LDS map");
    static_assert(NIL == 4 || NIL == 2, "S2 wait immediates");
    if (unit >= 8 * NS) return;
    const int bh = unit & 7, s = unit >> 3, b = bh >> 2, h = bh & 3;
    const int lane = F.lane, g = lane >> 4, r16 = lane & 15, w = F.wave, li = w >> 1, hf = w & 1, qi = li >> 1, kj = li & 1;
    LAS unsigned char* L = F.lds; const unsigned Lb = (unsigned)(uintptr_t)L;
    const float* RAW = WSP(float, WS_META + META_RAW);
    const char* Qg = (const char*)(QH + (size_t)bh * SEQ * DK); const char* Kg = (const char*)(KH + (size_t)bh * SEQ * DK);
    const char* Vg = (const char*)(VT + ((size_t)bh * DV + 16 * s) * SEQ);
#define S4_ISSUE(c_, st_) do { const int rc_ = (c_) - 1; const char* kc_ = Kg + (size_t)rc_ * TILEB; const char* qc_ = Qg + (size_t)rc_ * TILEB; \
        _Pragma("unroll") for (int i_ = 0; i_ < NIL; ++i_) { const int piece_ = li * NIL + i_, off_ = piece_ * 1024 + lane * 16, row_ = off_ / ROWB, p_ = (off_ % ROWB) >> 4; const int so_ = row_ * ROWB + ((p_ ^ (row_ & 15)) << 4); \
            __builtin_amdgcn_global_load_lds((const unsigned*)(kc_ + so_), (LAS unsigned*)(L + LK + (st_) * TILEB + piece_ * 1024), 16, 0, 0); \
            __builtin_amdgcn_global_load_lds((const unsigned*)(qc_ + so_), (LAS unsigned*)(L + LQ + (st_) * TILEB + piece_ * 1024), 16, 0, 0); } \
        if (li == 0) { const int wv_ = lane >> 2, p_ = lane & 3; \
            __builtin_amdgcn_global_load_lds((const unsigned*)(Vg + (size_t)wv_ * SEQ * 2 + (size_t)rc_ * 64 + ((p_ ^ ((wv_ >> 2) & 3)) << 4)), (LAS unsigned*)(L + LV + (st_) * 1024), 16, 0, 0); } \
        if (GLA && li == 1) __builtin_amdgcn_global_load_lds((const unsigned*)((const char*)(BC + (size_t)(b * SEQ + rc_ * 32 + 31) * 512 + h * 128) + lane * 16), (LAS unsigned*)(L + LDEC + (st_) * 1024), 16, 0, 0); } while (0)
#define S4_WAIT_PREV() do { if (li == 0 || (GLA && li == 1)) { if (NIL == 4) S2_WAITV(9); else S2_WAITV(5); } else { if (NIL == 4) S2_WAITV(8); else S2_WAITV(4); } } while (0)
    for (int i = F.tid * 16; i < TILEB; i += NTHREADS * 16) { *(LAS u32x4*)(L + LK + i) = (u32x4){0, 0, 0, 0}; *(LAS u32x4*)(L + LQ + i) = (u32x4){0, 0, 0, 0}; }
    for (int i = F.tid * 16; i < 1024; i += NTHREADS * 16) *(LAS u32x4*)(L + LV + i) = (u32x4){0, 0, 0, 0};
    for (int i = F.tid * 16; i < 16 * ROWB; i += NTHREADS * 16) *(LAS u32x4*)(L + LS + i) = (u32x4){0, 0, 0, 0};
    __syncthreads();
    if (!GLA) {
        for (int idx = F.tid; idx < 16 * 128; idx += NTHREADS) { const int j = idx >> 7, c = idx & 127, row = 16 + j;
            const float* rq = RAW + (size_t)j * ldraw + h * 256; const float* rk = rq + 1024;
            const float rev = ((float)j * ROPE_INV[c]) * 0.15915494309189535f; const float frc = rev - floorf(rev);
            const float sn = __builtin_amdgcn_sinf(frc), cs = __builtin_amdgcn_cosf(frc);
            const float dq = __builtin_amdgcn_exp2f((float)(row + 1) * L2G[h]), dk = 0.0625f * __builtin_amdgcn_exp2f(-(float)(row + 1) * L2G[h]);
            const float q1v = rq[c], q2v = rq[c + 128], k1 = rk[c], k2 = rk[c + 128];
            const int a1 = row * ROWB + ((((c >> 3)) ^ (row & 15)) << 4) + (c & 7) * 2, a2 = row * ROWB + ((((c + 128) >> 3) ^ (row & 15)) << 4) + (c & 7) * 2;
            *(LAS bf16_t*)(L + LQ + a1) = f2bf((q1v * cs - q2v * sn) * dq); *(LAS bf16_t*)(L + LQ + a2) = f2bf((q1v * sn + q2v * cs) * dq);
            *(LAS bf16_t*)(L + LK + a1) = f2bf((k1 * cs - k2 * sn) * dk); *(LAS bf16_t*)(L + LK + a2) = f2bf((k1 * sn + k2 * cs) * dk); }
        if (F.tid < 256) { const int j = F.tid >> 4, wv = F.tid & 15, tok = 16 + j;
            *(LAS bf16_t*)(L + LV + wv * 64 + (((tok >> 3) ^ ((wv >> 2) & 3)) << 4) + (tok & 7) * 2) = f2bf(RAW[(size_t)j * ldraw + 2048 + h * 512 + 16 * s + wv]); }
    } else {
        if (F.tid < 128) { const int d = F.tid; const float* wgp = F.in[13] + h * 128 + d; const float bias = F.in[14][h * 128 + d]; float cum = 0.f;
            for (int j = 0; j < 16; ++j) { float a = bias;
                for (int r = 0; r < 16; ++r) a += RAW[(size_t)j * ldraw + 3072 + r] * wgp[r * 512];
                cum += (fminf(a, 0.f) - __logf(1.0f + __expf(-fabsf(a)))) * 0.0625f;
                const int row = 16 + j;
                *(LAS bf16_t*)(L + LK + row * ROWB + (((d >> 3) ^ (row & 15)) << 4) + (d & 7) * 2) = f2bf(RAW[(size_t)j * ldraw + 512 + h * 128 + d] * __expf(-cum)); }
            *(LAS float*)(L + LDEC + d * 4) = cum; }
        if (F.tid >= 256) { const int j = (F.tid - 256) >> 4, wv = F.tid & 15, tok = 16 + j;
            *(LAS bf16_t*)(L + LV + wv * 64 + (((tok >> 3) ^ ((wv >> 2) & 3)) << 4) + (tok & 7) * 2) = f2bf(RAW[(size_t)j * ldraw + 1024 + h * 256 + 16 * s + wv]); }
    }
    f32x4 S[NTU];
#pragma unroll
    for (int tt = 0; tt < NTU; ++tt) S[tt] = (f32x4){0.f, 0.f, 0.f, 0.f};
    const float g32 = GLA ? 1.0f : __builtin_amdgcn_exp2f(32.0f * L2G[h]);
    __syncthreads();
    if (hf) S4_ISSUE(1, 1);
    f32x4 ot_prev = (f32x4){0.f, 0.f, 0.f, 0.f};
    int st = 0;
#if defined(PROBE2)
    unsigned long long pacc = 0ull, pt0 = 0ull; const unsigned long long ptot0 = __builtin_amdgcn_s_memtime();
#define P2T(q, stmt) do { if (PROBE2 == (q) && !GLA) { stmt; } } while (0)
#else
#define P2T(q, stmt) do {} while (0)
#endif
    for (int c = 0; c < NSTEP; ++c) {
        P2T(2, if (hf == 1) pt0 = __builtin_amdgcn_s_memtime()); P2T(3, if (hf == 0) pt0 = __builtin_amdgcn_s_memtime());
        const int sb = c & 1, st2 = (st == 0) ? 2 : st - 1;
        unsigned lz_ = 0; asm volatile("" : "+v"(lz_)); LAS unsigned char* const Lz = L + lz_; const unsigned Lbz = Lb + lz_;
        if (hf == 0) {
            if (li == 3) { constexpr int PFD = 8, LPT = TILEB / 128, LPB = 2 * LPT / NS; const int rcp = c + PFD - 1;
                if (rcp < 256) { const char* pa_ = nullptr;
                    if (lane < LPB) { const int ln = s * LPB + lane; pa_ = (ln < LPT) ? Kg + (size_t)rcp * TILEB + ln * 128 : Qg + (size_t)rcp * TILEB + (ln - LPT) * 128; }
                    else if (lane >= 16 && lane < 32) pa_ = Vg + (size_t)(lane - 16) * SEQ * 2 + (size_t)rcp * 64;
                    else if (GLA && lane == 32 && s == 0) pa_ = (const char*)(BC + (size_t)(b * SEQ + rcp * 32 + 31) * 512 + h * 128);
                    if (pa_) glds_touch(pa_, (unsigned)__builtin_amdgcn_readfirstlane((int)(Lb + LEND))); } }
            if (li < 2 && c >= 1) { const f32x4 pa = *(const LAS f32x4*)(Lz + LOT + (li * 2) * 1024 + lane * 16), pb = *(const LAS f32x4*)(Lz + LOT + (li * 2 + 1) * 1024 + lane * 16);
                const f32x4 ot = ot_prev + (pa + pb); const int irow = 16 * li + r16;
                if (c >= 2) { const size_t grow = (size_t)b * SEQ + (size_t)(c - 2) * 32 + irow; u32x2 pk; pk.x = cvt_pk_bf16(ot[0], ot[1]); pk.y = cvt_pk_bf16(ot[2], ot[3]);
                    *(u32x2*)(O + grow * LDO + h * DV + 16 * s + 4 * g) = pk; }
                else if (!GLA && b == 0 && irow >= 16) { float* MO = WSP(float, WS_META + META_MO); *(f32x4*)(MO + (size_t)(irow - 16) * 2048 + h * 512 + 16 * s + 4 * g) = ot; } }
            { s16x4 klo[NTU], khi[NTU];
              const bf16x8 vb = *(const LAS bf16x8*)(Lz + LV + st * 1024 + r16 * 64 + ((g ^ ((r16 >> 2) & 3)) << 4));
#pragma unroll
              for (int tt = 0; tt < NTU; ++tt) { const int tile = li + 4 * tt, d0 = 16 * tile, dcol = d0 + 4 * (r16 & 3), chunk = dcol >> 3, sub = (dcol & 7) * 2;
                  const int r1 = 8 * g + (r16 >> 2), r2 = r1 + 4;
                  klo[tt] = ds_tr_asm(Lbz + LK + st * TILEB + r1 * ROWB + ((chunk ^ (r1 & 15)) << 4) + sub);
                  khi[tt] = ds_tr_asm(Lbz + LK + st * TILEB + r2 * ROWB + ((chunk ^ (r2 & 15)) << 4) + sub); }
              asm volatile("s_waitcnt lgkmcnt(0)" ::: "memory"); __builtin_amdgcn_sched_barrier(0);
#pragma unroll
              for (int tt = 0; tt < NTU; ++tt) {
                  const bf16x8 ka = (bf16x8){klo[tt][0], klo[tt][1], klo[tt][2], klo[tt][3], khi[tt][0], khi[tt][1], khi[tt][2], khi[tt][3]};
                  S[tt] = __builtin_amdgcn_mfma_f32_16x16x32_bf16(ka, vb, S[tt], 0, 0, 0); }
#pragma unroll
              for (int tt = 0; tt < NTU; ++tt) { const int tile = li + 4 * tt;
                  if (GLA) { const f32x4 dl = *(const LAS f32x4*)(Lz + LDEC + st * 1024 + (16 * tile + 4 * g) * 4);
                      S[tt][0] *= __expf(dl[0]); S[tt][1] *= __expf(dl[1]); S[tt][2] *= __expf(dl[2]); S[tt][3] *= __expf(dl[3]); } else S[tt] = S[tt] * g32;
                  u32x2 pk; pk.x = cvt_pk_bf16(S[tt][0], S[tt][1]); pk.y = cvt_pk_bf16(S[tt][2], S[tt][3]);
                  *(LAS u32x2*)(Lz + LS + (sb ^ 1) * 16 * ROWB + r16 * ROWB + (((2 * tile + (g >> 1)) ^ r16) << 4) + (g & 1) * 8) = pk; } }
        } else {
            if (c + 2 < NSTEP) S4_ISSUE(c + 2, st2);
            { f32x4 pa = (f32x4){0.f, 0.f, 0.f, 0.f}, pb = pa;
              if (kj <= qi) { const LAS unsigned char* kb = Lz + LK + st * TILEB + (16 * kj + r16) * ROWB; const LAS unsigned char* qb = Lz + LQ + st * TILEB + (16 * qi + r16) * ROWB;
#pragma unroll
                  for (int ks = 0; ks < KS; ks += 2) { const int ch0 = ((4 * ks + g) ^ r16) << 4, ch1 = ((4 * (ks + 1) + g) ^ r16) << 4;
                      const bf16x8 k0 = *(const LAS bf16x8*)(kb + ch0), q0 = *(const LAS bf16x8*)(qb + ch0), k1 = *(const LAS bf16x8*)(kb + ch1), q1 = *(const LAS bf16x8*)(qb + ch1);
                      pa = __builtin_amdgcn_mfma_f32_16x16x32_bf16(k0, q0, pa, 0, 0, 0); pb = __builtin_amdgcn_mfma_f32_16x16x32_bf16(k1, q1, pb, 0, 0, 0); } }
              const f32x4 pt = pa + pb; const int i = 16 * qi + r16, j0 = 16 * kj + 4 * g;
              const float v0 = (j0 + 0 <= i) ? pt[0] : 0.f, v1 = (j0 + 1 <= i) ? pt[1] : 0.f, v2 = (j0 + 2 <= i) ? pt[2] : 0.f, v3 = (j0 + 3 <= i) ? pt[3] : 0.f;
              u32x2 pk; pk.x = cvt_pk_bf16(v0, v1); pk.y = cvt_pk_bf16(v2, v3);
              *(LAS u32x2*)(Lz + LP + i * 64 + (((2 * kj + (g >> 1)) ^ ((i >> 2) & 3)) << 4) + (g & 1) * 8) = pk; }
        }
        LDS_WAIT();
        P2T(2, if (hf == 1) pacc += __builtin_amdgcn_s_memtime() - pt0); P2T(3, if (hf == 0) pacc += __builtin_amdgcn_s_memtime() - pt0);
        P2T(5, pt0 = __builtin_amdgcn_s_memtime());
        __builtin_amdgcn_s_barrier(); asm volatile("" ::: "memory"); __builtin_amdgcn_sched_barrier(0);
        P2T(5, pacc += __builtin_amdgcn_s_memtime() - pt0);
        P2T(4, if (hf == 1) pt0 = __builtin_amdgcn_s_memtime());
        if (hf == 0) {
            if (li < 2) { const int irow = 16 * li + r16;
                const bf16x8 va = *(const LAS bf16x8*)(Lz + LV + st * 1024 + r16 * 64 + ((g ^ ((r16 >> 2) & 3)) << 4));
                const bf16x8 pb = *(const LAS bf16x8*)(Lz + LP + irow * 64 + ((g ^ ((irow >> 2) & 3)) << 4));
                ot_prev = __builtin_amdgcn_mfma_f32_16x16x32_bf16(va, pb, (f32x4){0.f, 0.f, 0.f, 0.f}, 0, 0, 0); }
        } else {
            f32x4 oa = (f32x4){0.f, 0.f, 0.f, 0.f}, ob = oa;
            const LAS unsigned char* sp = Lz + LS + sb * 16 * ROWB + r16 * ROWB; const LAS unsigned char* qb = Lz + LQ + st * TILEB + (16 * qi + r16) * ROWB;
#pragma unroll
            for (int kk = 0; kk < KS / 2; kk += 2) { const int ks = kj * (KS / 2) + kk; const int ch0 = ((4 * ks + g) ^ r16) << 4, ch1 = ((4 * (ks + 1) + g) ^ r16) << 4;
                const bf16x8 s0 = *(const LAS bf16x8*)(sp + ch0), q0 = *(const LAS bf16x8*)(qb + ch0), s1 = *(const LAS bf16x8*)(sp + ch1), q1 = *(const LAS bf16x8*)(qb + ch1);
                oa = __builtin_amdgcn_mfma_f32_16x16x32_bf16(s0, q0, oa, 0, 0, 0); ob = __builtin_amdgcn_mfma_f32_16x16x32_bf16(s1, q1, ob, 0, 0, 0); }
            *(LAS f32x4*)(Lz + LOT + (qi * 2 + kj) * 1024 + lane * 16) = oa + ob;
            P2T(4, pacc += __builtin_amdgcn_s_memtime() - pt0); P2T(1, pt0 = __builtin_amdgcn_s_memtime());
            if (c + 2 < NSTEP) S4_WAIT_PREV(); else S2_WAITV(0);
            P2T(1, pacc += __builtin_amdgcn_s_memtime() - pt0);
        }
        LDS_WAIT(); __builtin_amdgcn_s_barrier(); asm volatile("" ::: "memory"); __builtin_amdgcn_sched_barrier(0);
        st = (st == 2) ? 0 : st + 1;
    }
#if defined(PROBE2)
    if (!GLA && unit == 0) { if (PROBE2 == 0) pacc = __builtin_amdgcn_s_memtime() - ptot0; const int pw = (PROBE2 == 3 || PROBE2 == 5 || PROBE2 == 0) ? 0 : 1; if (w == pw && lane == 0) { volatile LAS unsigned* MI = (volatile LAS unsigned*)(F.lds + LDS_MISC); MI[20] = (unsigned)pacc; MI[21] = (unsigned)(pacc >> 32); } }
#endif
    if (hf == 0 && li < 2) { const f32x4 pa = *(const LAS f32x4*)(L + LOT + (li * 2) * 1024 + lane * 16), pb = *(const LAS f32x4*)(L + LOT + (li * 2 + 1) * 1024 + lane * 16);
        const f32x4 ot = ot_prev + (pa + pb); const int irow = 16 * li + r16;
        const size_t grow = (size_t)b * SEQ + (size_t)(NSTEP - 2) * 32 + irow; u32x2 pk; pk.x = cvt_pk_bf16(ot[0], ot[1]); pk.y = cvt_pk_bf16(ot[2], ot[3]);
        *(u32x2*)(O + grow * LDO + h * DV + 16 * s + 4 * g) = pk; }
#undef S4_ISSUE
#undef S4_WAIT_PREV
}

template <int DK, int DV, bool GLA>
__device__ __forceinline__ void s2v5_phase(Frame& F, const int unit, const bf16_t* QH, const bf16_t* KH, const bf16_t* VT, bf16_t* O, const float* BC, int ldraw) {
    constexpr int NS = DV / 16, ROWB = DK * 2, TILEB = 32 * ROWB, NIL = TILEB / 1024 / 4, NTU = DK / 64, LDO = 4 * DV, KS = DK / 32, NSTEP = 257;
    constexpr int LK = 0, LQ = 2 * TILEB, LV = 4 * TILEB, LDEC = LV + 2 * 1024, LP = LDEC + 2 * 1024, LS = LP + 2048, LOT = LS + 2 * 16 * ROWB, LEND = LOT + 4096;
    static_assert(LEND <= LDS_MISC, "S2 LDS map");
    if (unit >= 8 * NS) return;
    const int bh = unit & 7, s = unit >> 3, b = bh >> 2, h = bh & 3;
    const int lane = F.lane, g = lane >> 4, r16 = lane & 15, w = F.wave, li = w & 3, hf = w >> 2, qi = li >> 1, kj = li & 1;
    LAS unsigned char* L = F.lds; const unsigned Lb = (unsigned)(uintptr_t)L;
    const float* RAW = WSP(float, WS_META + META_RAW);
    const char* Qg = (const char*)(QH + (size_t)bh * SEQ * DK); const char* Kg = (const char*)(KH + (size_t)bh * SEQ * DK);
    const char* Vg = (const char*)(VT + ((size_t)bh * DV + 16 * s) * SEQ);
    u32x4 ra[2 * NIL + 1], rb[2 * NIL + 1];
#pragma unroll
    for (int i = 0; i < 2 * NIL + 1; ++i) { ra[i] = (u32x4){0, 0, 0, 0}; rb[i] = ra[i]; }
#define S5_LOAD(c_, R) do { const int rc_ = ((c_) - 1 < 255) ? (c_) - 1 : 255;     const char* kc_ = Kg + (size_t)rc_ * TILEB; const char* qc_ = Qg + (size_t)rc_ * TILEB; \
        _Pragma("unroll") for (int i_ = 0; i_ < NIL; ++i_) { const int piece_ = li * NIL + i_, off_ = piece_ * 1024 + lane * 16, row_ = off_ / ROWB, p_ = (off_ % ROWB) >> 4; const int so_ = row_ * ROWB + ((p_ ^ (row_ & 15)) << 4); \
            R[i_] = *(const u32x4*)(kc_ + so_); R[NIL + i_] = *(const u32x4*)(qc_ + so_); } \
        if (li == 0) { const int wv_ = lane >> 2, p_ = lane & 3; R[2 * NIL] = *(const u32x4*)(Vg + (size_t)wv_ * SEQ * 2 + (size_t)rc_ * 64 + ((p_ ^ ((wv_ >> 2) & 3)) << 4)); } \
        if (GLA && li == 1) R[2 * NIL] = *(const u32x4*)((const char*)(BC + (size_t)(b * SEQ + rc_ * 32 + 31) * 512 + h * 128) + lane * 16); } while (0)
#define S5_WRITE(st_, R) do { \
        _Pragma("unroll") for (int i_ = 0; i_ < NIL; ++i_) { const int piece_ = li * NIL + i_; \
            *(LAS u32x4*)(L + LK + (st_) * TILEB + piece_ * 1024 + lane * 16) = R[i_]; *(LAS u32x4*)(L + LQ + (st_) * TILEB + piece_ * 1024 + lane * 16) = R[NIL + i_]; } \
        if (li == 0) *(LAS u32x4*)(L + LV + (st_) * 1024 + lane * 16) = R[2 * NIL]; \
        if (GLA && li == 1) *(LAS u32x4*)(L + LDEC + (st_) * 1024 + lane * 16) = R[2 * NIL]; } while (0)
    for (int i = F.tid * 16; i < TILEB; i += NTHREADS * 16) { *(LAS u32x4*)(L + LK + i) = (u32x4){0, 0, 0, 0}; *(LAS u32x4*)(L + LQ + i) = (u32x4){0, 0, 0, 0}; }
    for (int i = F.tid * 16; i < 1024; i += NTHREADS * 16) *(LAS u32x4*)(L + LV + i) = (u32x4){0, 0, 0, 0};
    for (int i = F.tid * 16; i < 16 * ROWB; i += NTHREADS * 16) *(LAS u32x4*)(L + LS + i) = (u32x4){0, 0, 0, 0};
    __syncthreads();
    if (!GLA) {
        for (int idx = F.tid; idx < 16 * 128; idx += NTHREADS) { const int j = idx >> 7, c = idx & 127, row = 16 + j;
            const float* rq = RAW + (size_t)j * ldraw + h * 256; const float* rk = rq + 1024;
            const float rev = ((float)j * ROPE_INV[c]) * 0.15915494309189535f; const float frc = rev - floorf(rev);
            const float sn = __builtin_amdgcn_sinf(frc), cs = __builtin_amdgcn_cosf(frc);
            const float dq = __builtin_amdgcn_exp2f((float)(row + 1) * L2G[h]), dk = 0.0625f * __builtin_amdgcn_exp2f(-(float)(row + 1) * L2G[h]);
            const float q1v = rq[c], q2v = rq[c + 128], k1 = rk[c], k2 = rk[c + 128];
            const int a1 = row * ROWB + ((((c >> 3)) ^ (row & 15)) << 4) + (c & 7) * 2, a2 = row * ROWB + ((((c + 128) >> 3) ^ (row & 15)) << 4) + (c & 7) * 2;
            *(LAS bf16_t*)(L + LQ + a1) = f2bf((q1v * cs - q2v * sn) * dq); *(LAS bf16_t*)(L + LQ + a2) = f2bf((q1v * sn + q2v * cs) * dq);
            *(LAS bf16_t*)(L + LK + a1) = f2bf((k1 * cs - k2 * sn) * dk); *(LAS bf16_t*)(L + LK + a2) = f2bf((k1 * sn + k2 * cs) * dk); }
        if (F.tid < 256) { const int j = F.tid >> 4, wv = F.tid & 15, tok = 16 + j;
            *(LAS bf16_t*)(L + LV + wv * 64 + (((tok >> 3) ^ ((wv >> 2) & 3)) << 4) + (tok & 7) * 2) = f2bf(RAW[(size_t)j * ldraw + 2048 + h * 512 + 16 * s + wv]); }
    } else {
        if (F.tid < 128) { const int d = F.tid; const float* wgp = F.in[13] + h * 128 + d; const float bias = F.in[14][h * 128 + d]; float cum = 0.f;
            for (int j = 0; j < 16; ++j) { float a = bias;
                for (int r = 0; r < 16; ++r) a += RAW[(size_t)j * ldraw + 3072 + r] * wgp[r * 512];
                cum += (fminf(a, 0.f) - __logf(1.0f + __expf(-fabsf(a)))) * 0.0625f;
                const int row = 16 + j;
                *(LAS bf16_t*)(L + LK + row * ROWB + (((d >> 3) ^ (row & 15)) << 4) + (d & 7) * 2) = f2bf(RAW[(size_t)j * ldraw + 512 + h * 128 + d] * __expf(-cum)); }
            *(LAS float*)(L + LDEC + d * 4) = cum; }
        if (F.tid >= 256) { const int j = (F.tid - 256) >> 4, wv = F.tid & 15, tok = 16 + j;
            *(LAS bf16_t*)(L + LV + wv * 64 + (((tok >> 3) ^ ((wv >> 2) & 3)) << 4) + (tok & 7) * 2) = f2bf(RAW[(size_t)j * ldraw + 1024 + h * 256 + 16 * s + wv]); }
    }
    f32x4 S[NTU];
#pragma unroll
    for (int tt = 0; tt < NTU; ++tt) S[tt] = (f32x4){0.f, 0.f, 0.f, 0.f};
    const float g32 = GLA ? 1.0f : __builtin_amdgcn_exp2f(32.0f * L2G[h]);
    __syncthreads();
    if (hf) S5_LOAD(1, rb);
    f32x4 ot_prev = (f32x4){0.f, 0.f, 0.f, 0.f};
#define S5_ODD(c_, ST, RL, RW) do { const int c = (c_); constexpr int st = (ST), sb = (ST); P3T(1, pt0 = __builtin_amdgcn_s_memtime()); \
        LAS unsigned char* const Lz = L; \
        S5_LOAD(c + 2, RL); P3T(1, pacc += __builtin_amdgcn_s_memtime() - pt0); P3T(2, pt0 = __builtin_amdgcn_s_memtime()); \
        { f32x4 pa = (f32x4){0.f, 0.f, 0.f, 0.f}, pb = pa; \
          if (kj <= qi) { const LAS unsigned char* kb = Lz + LK + st * TILEB + (16 * kj + r16) * ROWB; const LAS unsigned char* qb = Lz + LQ + st * TILEB + (16 * qi + r16) * ROWB; \
              _Pragma("unroll") for (int ks = 0; ks < KS; ks += 2) { const int ch0 = ((4 * ks + g) ^ r16) << 4, ch1 = ((4 * (ks + 1) + g) ^ r16) << 4; \
                  const bf16x8 k0 = *(const LAS bf16x8*)(kb + ch0), q0 = *(const LAS bf16x8*)(qb + ch0), k1 = *(const LAS bf16x8*)(kb + ch1), q1 = *(const LAS bf16x8*)(qb + ch1); \
                  pa = __builtin_amdgcn_mfma_f32_16x16x32_bf16(k0, q0, pa, 0, 0, 0); pb = __builtin_amdgcn_mfma_f32_16x16x32_bf16(k1, q1, pb, 0, 0, 0); } } \
          const f32x4 pt = pa + pb; const int i = 16 * qi + r16, j0 = 16 * kj + 4 * g; \
          const float v0 = (j0 + 0 <= i) ? pt[0] : 0.f, v1 = (j0 + 1 <= i) ? pt[1] : 0.f, v2 = (j0 + 2 <= i) ? pt[2] : 0.f, v3 = (j0 + 3 <= i) ? pt[3] : 0.f; \
          u32x2 pk; pk.x = cvt_pk_bf16(v0, v1); pk.y = cvt_pk_bf16(v2, v3); \
          *(LAS u32x2*)(Lz + LP + i * 64 + (((2 * kj + (g >> 1)) ^ ((i >> 2) & 3)) << 4) + (g & 1) * 8) = pk; } \
        LDS_WAIT(); P3T(2, pacc += __builtin_amdgcn_s_memtime() - pt0); P3T(3, pt0 = __builtin_amdgcn_s_memtime()); __builtin_amdgcn_s_barrier(); asm volatile("" ::: "memory"); P3T(3, pacc += __builtin_amdgcn_s_memtime() - pt0); P3T(4, pt0 = __builtin_amdgcn_s_memtime()); \
        { f32x4 oa = (f32x4){0.f, 0.f, 0.f, 0.f}, ob = oa; \
          const LAS unsigned char* sp = Lz + LS + sb * 16 * ROWB + r16 * ROWB; const LAS unsigned char* qb = Lz + LQ + st * TILEB + (16 * qi + r16) * ROWB; \
          _Pragma("unroll") for (int kk = 0; kk < KS / 2; kk += 2) { const int ks = kj * (KS / 2) + kk; const int ch0 = ((4 * ks + g) ^ r16) << 4, ch1 = ((4 * (ks + 1) + g) ^ r16) << 4; \
              const bf16x8 s0 = *(const LAS bf16x8*)(sp + ch0), q0 = *(const LAS bf16x8*)(qb + ch0), s1 = *(const LAS bf16x8*)(sp + ch1), q1 = *(const LAS bf16x8*)(qb + ch1); \
              oa = __builtin_amdgcn_mfma_f32_16x16x32_bf16(s0, q0, oa, 0, 0, 0); ob = __builtin_amdgcn_mfma_f32_16x16x32_bf16(s1, q1, ob, 0, 0, 0); } \
          *(LAS f32x4*)(Lz + LOT + (qi * 2 + kj) * 1024 + lane * 16) = oa + ob; } \
        P3T(4, pacc += __builtin_amdgcn_s_memtime() - pt0); P3T(5, pt0 = __builtin_amdgcn_s_memtime()); S5_WRITE(st ^ 1, RW); \
        LDS_WAIT(); P3T(5, pacc += __builtin_amdgcn_s_memtime() - pt0); P3T(6, pt0 = __builtin_amdgcn_s_memtime()); __builtin_amdgcn_s_barrier(); asm volatile("" ::: "memory"); P3T(6, pacc += __builtin_amdgcn_s_memtime() - pt0); \
    } while (0)
#define S5_EVEN(c_, ST) do { const int c = (c_); constexpr int st = (ST), sb = (ST); \
        LAS unsigned char* const Lz = L; const unsigned Lbz = Lb; \
        if (li < 2 && c >= 1) { const f32x4 pa = *(const LAS f32x4*)(Lz + LOT + (li * 2) * 1024 + lane * 16), pb = *(const LAS f32x4*)(Lz + LOT + (li * 2 + 1) * 1024 + lane * 16); \
            const f32x4 ot = ot_prev + (pa + pb); const int irow = 16 * li + r16; \
            if (c >= 2) { const size_t grow = (size_t)b * SEQ + (size_t)(c - 2) * 32 + irow; u32x2 pk; pk.x = cvt_pk_bf16(ot[0], ot[1]); pk.y = cvt_pk_bf16(ot[2], ot[3]); \
                *(u32x2*)(O + grow * LDO + h * DV + 16 * s + 4 * g) = pk; } \
            else if (!GLA && b == 0 && irow >= 16) { float* MO = WSP(float, WS_META + META_MO); *(f32x4*)(MO + (size_t)(irow - 16) * 2048 + h * 512 + 16 * s + 4 * g) = ot; } } \
        { s16x4 klo[NTU], khi[NTU]; \
          const bf16x8 vb = *(const LAS bf16x8*)(Lz + LV + st * 1024 + r16 * 64 + ((g ^ ((r16 >> 2) & 3)) << 4)); \
          _Pragma("unroll") for (int tt = 0; tt < NTU; ++tt) { const int tile = li + 4 * tt, d0 = 16 * tile, dcol = d0 + 4 * (r16 & 3), chunk = dcol >> 3, sub = (dcol & 7) * 2; \
              const int r1 = 8 * g + (r16 >> 2), r2 = r1 + 4; \
              klo[tt] = ds_tr_asm(Lbz + LK + st * TILEB + r1 * ROWB + ((chunk ^ (r1 & 15)) << 4) + sub); \
              khi[tt] = ds_tr_asm(Lbz + LK + st * TILEB + r2 * ROWB + ((chunk ^ (r2 & 15)) << 4) + sub); } \
          asm volatile("s_waitcnt lgkmcnt(0)" ::: "memory"); __builtin_amdgcn_sched_barrier(0); \
          _Pragma("unroll") for (int tt = 0; tt < NTU; ++tt) { \
              const bf16x8 ka = (bf16x8){klo[tt][0], klo[tt][1], klo[tt][2], klo[tt][3], khi[tt][0], khi[tt][1], khi[tt][2], khi[tt][3]}; \
              S[tt] = __builtin_amdgcn_mfma_f32_16x16x32_bf16(ka, vb, S[tt], 0, 0, 0); } \
          _Pragma("unroll") for (int tt = 0; tt < NTU; ++tt) { const int tile = li + 4 * tt; \
              if (GLA) { const f32x4 dl = *(const LAS f32x4*)(Lz + LDEC + st * 1024 + (16 * tile + 4 * g) * 4); \
                  S[tt][0] *= __expf(dl[0]); S[tt][1] *= __expf(dl[1]); S[tt][2] *= __expf(dl[2]); S[tt][3] *= __expf(dl[3]); } else S[tt] = S[tt] * g32; \
              u32x2 pk; pk.x = cvt_pk_bf16(S[tt][0], S[tt][1]); pk.y = cvt_pk_bf16(S[tt][2], S[tt][3]); \
              *(LAS u32x2*)(Lz + LS + (sb ^ 1) * 16 * ROWB + r16 * ROWB + (((2 * tile + (g >> 1)) ^ r16) << 4) + (g & 1) * 8) = pk; } } \
        LDS_WAIT(); __builtin_amdgcn_s_barrier(); asm volatile("" ::: "memory"); \
        if (li < 2) { const int irow = 16 * li + r16; \
            const bf16x8 va = *(const LAS bf16x8*)(Lz + LV + st * 1024 + r16 * 64 + ((g ^ ((r16 >> 2) & 3)) << 4)); \
            const bf16x8 pb = *(const LAS bf16x8*)(Lz + LP + irow * 64 + ((g ^ ((irow >> 2) & 3)) << 4)); \
            ot_prev = __builtin_amdgcn_mfma_f32_16x16x32_bf16(va, pb, (f32x4){0.f, 0.f, 0.f, 0.f}, 0, 0, 0); } \
        LDS_WAIT(); __builtin_amdgcn_s_barrier(); asm volatile("" ::: "memory"); \
    } while (0)
#if defined(PROBE3)
    unsigned long long pacc = 0ull, pt0 = 0ull;
#define P3T(q, stmt) do { if (PROBE3 == (q) && !GLA) { stmt; } } while (0)
#else
#define P3T(q, stmt) do {} while (0)
#endif
    if (hf) {
        for (int c2 = 0; c2 < 256; c2 += 2) { S5_ODD(c2, 0, ra, rb); S5_ODD(c2 + 1, 1, rb, ra); }
        S5_ODD(256, 0, ra, rb);
#if defined(PROBE3)
        if (!GLA && unit == 0 && w == 5 && lane == 0) { volatile LAS unsigned* MI = (volatile LAS unsigned*)(F.lds + LDS_MISC); MI[20] = (unsigned)pacc; MI[21] = (unsigned)(pacc >> 32); }
#endif
    } else {
        for (int c2 = 0; c2 < 256; c2 += 2) { S5_EVEN(c2, 0); S5_EVEN(c2 + 1, 1); }
        S5_EVEN(256, 0);
        if (li < 2) { const f32x4 pa = *(const LAS f32x4*)(L + LOT + (li * 2) * 1024 + lane * 16), pb = *(const LAS f32x4*)(L + LOT + (li * 2 + 1) * 1024 + lane * 16);
            const f32x4 ot = ot_prev + (pa + pb); const int irow = 16 * li + r16;
            const size_t grow = (size_t)b * SEQ + (size_t)(NSTEP - 2) * 32 + irow; u32x2 pk; pk.x = cvt_pk_bf16(ot[0], ot[1]); pk.y = cvt_pk_bf16(ot[2], ot[3]);
            *(u32x2*)(O + grow * LDO + h * DV + 16 * s + 4 * g) = pk; }
    }
#undef S5_ODD
#undef S5_EVEN
#undef S5_LOAD
#undef S5_WRITE
}

__device__ __forceinline__ void final_phase(Frame& F, const float* SS, const float* gain) {
    const int gw = F.vcu * NWAVES + F.wave, NGW = F.G * NWAVES;
    f32x4 gv[4];
#pragma unroll
    for (int j = 0; j < 4; ++j) gv[j] = *(const f32x4*)(gain + 4 * F.lane + 256 * j);
    for (int m = gw; m < M; m += NGW) { float* row = F.out + (size_t)m * D; const float rs = row_rstd(SS, m);
#pragma unroll
        for (int j = 0; j < 4; ++j) { f32x4 v = *(const f32x4*)(row + 4 * F.lane + 256 * j); v = v * rs * gv[j]; *(f32x4*)(row + 4 * F.lane + 256 * j) = v; } }
}
__device__ __forceinline__ void p0_rows(Frame& F) {
    const int gw = F.vcu * NWAVES + F.wave, NGW = F.G * NWAVES; const float* x = F.in[0]; bf16_t* HB = WSP(bf16_t, WS_HB); float* SS = WSP(float, WS_SS);
    for (int m = gw; m < M; m += 2 * NGW) { const int m2 = m + NGW;
        f32x4 va[4], vb[4];
#pragma unroll
        for (int j = 0; j < 4; ++j) { va[j] = *(const f32x4*)(x + (size_t)m * D + 4 * F.lane + 256 * j); vb[j] = *(const f32x4*)(x + (size_t)m2 * D + 4 * F.lane + 256 * j); }
        float s = 0.f, s2 = 0.f;
#pragma unroll
        for (int j = 0; j < 4; ++j) { const f32x4 v = va[j], u = vb[j]; s += (v[0] * v[0] + v[1] * v[1]) + (v[2] * v[2] + v[3] * v[3]); s2 += (u[0] * u[0] + u[1] * u[1]) + (u[2] * u[2] + u[3] * u[3]);
            u32x2 pk; pk.x = cvt_pk_bf16(v[0], v[1]); pk.y = cvt_pk_bf16(v[2], v[3]); *(u32x2*)(HB + (size_t)m * D + 4 * F.lane + 256 * j) = pk;
            pk.x = cvt_pk_bf16(u[0], u[1]); pk.y = cvt_pk_bf16(u[2], u[3]); *(u32x2*)(HB + (size_t)m2 * D + 4 * F.lane + 256 * j) = pk; }
        s = wave_sum(s); s2 = wave_sum(s2);
        if (F.lane < 16) { SS[(size_t)m * 16 + F.lane] = F.lane == 0 ? s : 0.f; SS[(size_t)m2 * 16 + F.lane] = F.lane == 0 ? s2 : 0.f; } }
    if (blockIdx.x == 0) { float* HM = WSP(float, WS_META + META_HM); for (int i = F.tid; i < 16 * D; i += NTHREADS) HM[i] = F.in[1][i]; }
}

#ifndef S2FN
#define S2FN s2v5_phase
#endif
struct Args { const float* in[18]; float* out; unsigned char* ws; int ph_lo, ph_hi; };
constexpr int N_PHASES = 19;
__global__ void __launch_bounds__(NTHREADS, 2) fwd(Args args) {
    extern __shared__ __attribute__((aligned(16))) unsigned char lds_raw[];
    Frame F;
    F.lds = (LAS unsigned char*)lds_raw;
    F.tid = threadIdx.x; F.lane = F.tid & 63; F.wave = __builtin_amdgcn_readfirstlane(F.tid >> 6);
    F.G = gridDim.x; { const int bx = blockIdx.x; F.vcu = (F.G % 8 == 0) ? (bx % 8) * (F.G / 8) + bx / 8 : bx; }
    F.ws = args.ws; F.out = args.out;
#pragma unroll
    for (int i = 0; i < 18; ++i) F.in[i] = args.in[i];
    volatile LAS unsigned* MISC = (volatile LAS unsigned*)(F.lds + LDS_MISC);
    if (F.tid < 64) MISC[F.tid] = 0u;
    __syncthreads();
    XcdBarrier bar = xcd_barrier_post(WSP(unsigned, WS_CTL) + CW_BAR, MISC + 8);
    const int lo = args.ph_lo, hi = args.ph_hi;
    __syncthreads();
    F.vb = (int)blockIdx.x;
    int vblk = (int)blockIdx.x;
#define IN(k) (lo <= (k) && (k) < hi)
#if defined(PROBE_PHASE)
    unsigned long long t_prev = __builtin_amdgcn_s_memrealtime(), t_probe = 0ull;
#define SEAM(k) do { if (IN(k) && IN((k) + 1)) xcd_barrier(bar); { const unsigned long long t_now = __builtin_amdgcn_s_memrealtime(); if ((k) == PROBE_PHASE) t_probe = t_now - t_prev; t_prev = t_now; } } while (0)
#else
#define SEAM(k) do { if (IN(k) && IN((k) + 1)) xcd_barrier(bar); } while (0)
#endif
    bf16_t* HB = WSP(bf16_t, WS_HB); float* SS = WSP(float, WS_SS); float* H = F.out;
    bf16_t* ACT = WSP(bf16_t, WS_ACT);
    const int gw = F.vcu * NWAVES + F.wave, NGW = F.G * NWAVES;
    float* RAW = WSP(float, WS_META + META_RAW); float* HM = WSP(float, WS_META + META_HM);

#define FFN_IN(win, do_meta) do { \
        if ((do_meta) && meta_has_tiles(F, 2 * DFF, 128, 128)) { meta_prep_h(F); meta_tiles<0>(F, WSP(bf16_t, (win)), 2 * DFF, D, RAW, 2 * DFF, 1.f, 128, 128); } \
        pg8::Order S_; S_.init(M / 256, 22, F.G, vblk); PtrNormal P_{(const char*)HB, (const char*)WSP(bf16_t, (win)), (size_t)256 * D * 2}; \
        EpiSwiglu E_{SS, ACT}; pg8::gemm_phase(F.lds, D, S_, P_, E_); } while (0)
#define FFN_OUT(wout, do_meta, basep) do { \
        if ((do_meta) && meta_has_tiles(F, D, 0, 256)) { meta_prep_act(F); meta_tiles<1>(F, WSP(bf16_t, (wout)), D, DFF, HM, D, 0.5f, 0, 256); } \
        pg8::Order S_; S_.init(M / 256, 4, F.G, vblk); PtrNormal P_{(const char*)ACT, (const char*)WSP(bf16_t, (wout)), (size_t)256 * DFF * 2}; \
        EpiResid E_{(basep), H, HB, SS, 0.5f}; pg8::gemm_phase(F.lds, DFF, S_, P_, E_); } while (0)

#define slack (vblk >= 128)
#define sgw ((vblk - 128) * NWAVES + F.wave)
    const int SNGW = 128 * NWAVES;
    if (IN(0)) {
        int cb = conv_job(F, job_ffn_in(F, 0, 0, WS_WFFN_A + WF_IN), 0, gw, NGW); cb = conv_job(F, job_ffn_out(F, 0, 0, WS_WFFN_A + WF_OUT), cb, gw, NGW);
        p0_rows(F);
    }
    SEAM(0);
    if (lo == 0 && hi == N_PHASES && F.G == 256) {
        const unsigned* barw = WSP(unsigned, WS_CTL) + CW_BAR; bool ok = true;
#pragma unroll
        for (int j = 0; j < 8; ++j) ok = ok && (__hip_atomic_load(barw + XB_XCNT(j), __ATOMIC_RELAXED, __HIP_MEMORY_SCOPE_AGENT) == 32u);
        const unsigned rank = MISC[10], xcc = MISC[11];
        if (ok && rank < 32u && xcc < 8u) vblk = (int)(rank * 8u + xcc);
    }
    F.vb = vblk;
    if (IN(1)) {
        if (slack) { ConvJob J;
            J.W = F.in[9]; J.ldn = 6144; J.K = D; J.N = 6144; J.col0 = 0; J.kind = 0; J.gain = F.in[5]; J.WT = WSP(bf16_t, WS_WMIX + WM_RET_IN);
            int cb = conv_job(F, J, 0, sgw, SNGW);
            J.W = F.in[11]; J.ldn = D; J.K = 2048; J.N = D; J.col0 = 0; J.kind = 0; J.gain = F.in[10]; J.WT = WSP(bf16_t, WS_WMIX + WM_RET_OUT);
            cb = conv_job(F, J, cb, sgw, SNGW);
            cb = conv_job(F, job_ffn_in(F, 0, 1, WS_WFFN_C), cb, sgw, SNGW); __syncthreads(); }
        FFN_IN(WS_WFFN_A + WF_IN, true);
    }
    SEAM(1);
    if (IN(2)) FFN_OUT(WS_WFFN_A + WF_OUT, true, F.in[0]);
    SEAM(2);
    if (IN(3)) {
        if (meta_has_tiles(F, 6144, 0, 256)) { meta_prep_h(F); meta_tiles<0>(F, WSP(bf16_t, WS_WMIX + WM_RET_IN), 6144, D, RAW, 6144, 1.f, 0, 256); }
        pg8::Order S_; S_.init(M / 256, 16, F.G, vblk);
        PtrSwapFrom P_{(const char*)HB, (const char*)WSP(bf16_t, WS_WMIX + WM_RET_IN), (size_t)256 * D * 2, 8};
        EpiRetIn E_{SS, WSP(bf16_t, WS_QH), WSP(bf16_t, WS_KH), WSP(bf16_t, WS_VT)}; pg8::gemm_phase(F.lds, D, S_, P_, E_);
    }
    SEAM(3);
    if (IN(4)) S2FN<256, 512, false>(F, vblk, WSP(bf16_t, WS_QH), WSP(bf16_t, WS_KH), WSP(bf16_t, WS_VT), WSP(bf16_t, WS_O), nullptr, 6144);
    SEAM(4);
    if (IN(5)) {
        (void)conv_job(F, job_ffn_out(F, 0, 1, WS_WFFN_A + WF_OUT), 0, gw, NGW);
        __syncthreads();
        pg8::Order S_; S_.init(M / 256, 8, F.G, vblk); PtrNormal P_{(const char*)HB, (const char*)(WSP(bf16_t, WS_WMIX + WM_RET_IN) + (size_t)4096 * D), (size_t)256 * D * 2};
        EpiGate<512, 2048> E_{SS, WSP(bf16_t, WS_O), WSP(bf16_t, WS_VT), (LAS float*)(F.lds + 132096)}; pg8::gemm_phase(F.lds, D, S_, P_, E_);
    }
    SEAM(5);
    if (IN(6)) {
        if (meta_has_tiles(F, D, 0, 256)) { meta_prep_y(F); meta_tiles<1>(F, WSP(bf16_t, WS_WMIX + WM_RET_OUT), D, 2048, HM, D, 1.0f, 0, 256); }
        pg8::Order S_; S_.init(M / 256, 4, F.G, vblk); PtrNormal P_{(const char*)WSP(bf16_t, WS_VT), (const char*)WSP(bf16_t, WS_WMIX + WM_RET_OUT), (size_t)256 * 2048 * 2};
        EpiResid E_{H, H, HB, SS, 1.0f}; pg8::gemm_phase(F.lds, 2048, S_, P_, E_);
    }
    SEAM(6);
    if (IN(7)) {
        if (slack) { int cb = conv_job(F, job_ffn_in(F, 1, 0, WS_WFFN_B + WF_IN), 0, sgw, SNGW); cb = conv_job(F, job_ffn_out(F, 1, 0, WS_WFFN_B + WF_OUT), cb, sgw, SNGW);
            ConvJob J;
            J.W = F.in[12]; J.ldn = 3088; J.K = D; J.N = 3072; J.col0 = 0; J.kind = 0; J.gain = F.in[5] + D; J.WT = WSP(bf16_t, WS_WMIX + WM_GLA_IN);
            cb = conv_job(F, J, cb, sgw, SNGW);
            J.W = F.in[16]; J.ldn = D; J.K = D; J.N = D; J.col0 = 0; J.kind = 0; J.gain = F.in[15]; J.WT = WSP(bf16_t, WS_WMIX + WM_GLA_OUT);
            cb = conv_job(F, J, cb, sgw, SNGW);
            if (vblk == F.G - 1) { bf16_t* WZ = WSP(bf16_t, WS_WMIX + WM_GLA_Z); const float* W = F.in[12]; const float* gn = F.in[5] + D;
                for (int i = F.tid; i < 16 * D; i += NTHREADS) { const int k = i >> 4, r = i & 15; WZ[r * D + k] = f2bf(W[(size_t)k * 3088 + 3072 + r] * gn[k]); } }
            __syncthreads(); }
        FFN_IN(WS_WFFN_C, true);
    }
    SEAM(7);
    if (IN(8)) FFN_OUT(WS_WFFN_A + WF_OUT, true, H);
    SEAM(8);
    if (IN(9)) {
        if (slack) { int cb = conv_job(F, job_ffn_in(F, 1, 1, WS_WFFN_A + WF_IN), 0, sgw, SNGW); cb = conv_job(F, job_ffn_out(F, 1, 1, WS_WFFN_A + WF_OUT), cb, sgw, SNGW); __syncthreads(); }
        FFN_IN(WS_WFFN_B + WF_IN, true);
    }
    SEAM(9);
    if (IN(10)) FFN_OUT(WS_WFFN_B + WF_OUT, true, H);
    SEAM(10);
    if (IN(11)) {
        if (meta_has_tiles(F, 2048, 0, 256)) { meta_prep_h(F); meta_tiles<0>(F, WSP(bf16_t, WS_WMIX + WM_GLA_IN), 2048, D, RAW, 3088, 1.f, 0, 256); }
        if (F.vb == 0) meta_tiles<0>(F, WSP(bf16_t, WS_WMIX + WM_GLA_Z), 16, D, RAW + 3072, 3088, 1.f, 0, 256);
        __syncthreads();
        z_phase(F, HB, SS, WSP(bf16_t, WS_WMIX + WM_GLA_Z), F.in[13], F.in[14], WSP(float, WS_BC));
    }
    SEAM(11);
    if (IN(12)) {
        pg8::Order S_; S_.init(M / 256, 8, F.G, vblk);
        PtrSwapFrom P_{(const char*)HB, (const char*)WSP(bf16_t, WS_WMIX + WM_GLA_IN), (size_t)256 * D * 2, 4};
        EpiGlaIn E_{SS, WSP(float, WS_BC), WSP(bf16_t, WS_QH2), WSP(bf16_t, WS_KH2), WSP(bf16_t, WS_VT2)}; pg8::gemm_phase(F.lds, D, S_, P_, E_);
    }
    SEAM(12);
    if (IN(13)) S2FN<128, 256, true>(F, vblk, WSP(bf16_t, WS_QH2), WSP(bf16_t, WS_KH2), WSP(bf16_t, WS_VT2), WSP(bf16_t, WS_O2), WSP(float, WS_BC), 3088);
    SEAM(13);
    if (IN(14)) {
        pg8::Order S_; S_.init(M / 256, 4, F.G, vblk); PtrNormal P_{(const char*)HB, (const char*)WSP(bf16_t, WS_WMIX + WM_GLA_G), (size_t)256 * D * 2};
        EpiGate<256, 1024> E_{SS, WSP(bf16_t, WS_O2), WSP(bf16_t, WS_VT2), (LAS float*)(F.lds + 132096)}; pg8::gemm_phase(F.lds, D, S_, P_, E_);
    }
    SEAM(14);
    if (IN(15)) {
        pg8::Order S_; S_.init(M / 256, 4, F.G, vblk); PtrNormal P_{(const char*)WSP(bf16_t, WS_VT2), (const char*)WSP(bf16_t, WS_WMIX + WM_GLA_OUT), (size_t)256 * D * 2};
        EpiResid E_{H, H, HB, SS, 1.0f}; pg8::gemm_phase(F.lds, D, S_, P_, E_);
    }
    SEAM(15);
    if (IN(16)) FFN_IN(WS_WFFN_A + WF_IN, false);
    SEAM(16);
    if (IN(17)) FFN_OUT(WS_WFFN_A + WF_OUT, false, H);
    SEAM(17);
    if (IN(18)) final_phase(F, SS, F.in[17]);
#if defined(PROBE2) || defined(PROBE3)
    __syncthreads();
    if (vblk == 0 && F.tid == 0) { const unsigned long long cyc = ((unsigned long long)MISC[21] << 32) | MISC[20]; const unsigned long long t0 = __builtin_amdgcn_s_memtime(); while (__builtin_amdgcn_s_memtime() - t0 < 4ull * cyc) __builtin_amdgcn_s_sleep(16); }
#endif
#if defined(PROBE_PHASE)
    { const unsigned long long t_now = __builtin_amdgcn_s_memrealtime(); if (18 == PROBE_PHASE) t_probe = t_now - t_prev;
      if (blockIdx.x == 0 && F.tid == 0) { const unsigned long long t_end = t_now + (unsigned long long)PROBE_MULT * t_probe; while (__builtin_amdgcn_s_memrealtime() < t_end) __builtin_amdgcn_s_sleep(16); } }
#endif
#undef slack
#undef sgw
#undef IN
#undef SEAM
#undef FFN_IN
#undef FFN_OUT
}
}
#ifndef MK_MODE
#define MK_MODE 0
#endif
#if MK_MODE == 2
namespace dbg {
__global__ void adapt(const float* Hreal, const float* HMtmp, float* Hn) {
    const size_t i = (size_t)blockIdx.x * blockDim.x + threadIdx.x;
    if (i >= (size_t)nv::ROWS * nv::D) return;
    const int d = (int)(i % nv::D); const size_t row = i / nv::D; const int b = (int)(row / nv::TT), s = (int)(row % nv::TT);
    Hn[i] = s < nv::NMETA ? HMtmp[s * nv::D + d] : Hreal[((size_t)b * nv::SEQ + (s - nv::NMETA)) * nv::D + d];
}
}
#endif
extern "C" void kernel_launch(void* const* d_in, const int* in_sizes, int n_in, void* d_out, int out_size, void* d_ws, size_t ws_size, hipStream_t stream) {
    static int grid = 0;
    if (grid == 0) {
        if (n_in != 18 || out_size != mk::M * mk::D || ws_size < mk::WS_NEED) { fprintf(stderr, "kernel_launch: unexpected sizes n_in %d out %d ws %zu\n", n_in, out_size, ws_size); grid = -1; return; }
        int dev = 0, cus = 0, per_cu = 0;
        if (hipGetDevice(&dev) != hipSuccess || hipDeviceGetAttribute(&cus, hipDeviceAttributeMultiprocessorCount, dev) != hipSuccess) { grid = -1; return; }
        if (hipFuncSetAttribute((const void*)mk::fwd, hipFuncAttributeMaxDynamicSharedMemorySize, mk::LDS_BYTES) != hipSuccess) { fprintf(stderr, "kernel_launch: hipFuncSetAttribute failed\n"); grid = -1; return; }
        if (hipOccupancyMaxActiveBlocksPerMultiprocessor(&per_cu, (const void*)mk::fwd, mk::NTHREADS, mk::LDS_BYTES) != hipSuccess || per_cu < 1) { fprintf(stderr, "kernel_launch: occupancy query says %d\n", per_cu); per_cu = 1; }
        (void)hipGetLastError();
        grid = cus;
        if (grid != 256) fprintf(stderr, "kernel_launch: %d CUs (built for 256)\n", grid);
    }
    if (grid < 0) return;
    (void)hipMemsetAsync((char*)d_ws + mk::WS_CTL, 0, mk::CTL_ZERO_BYTES, stream);
    mk::Args a{};
    for (int i = 0; i < 18; ++i) a.in[i] = (const float*)d_in[i];
    a.out = (float*)d_out; a.ws = (unsigned char*)d_ws;
#if MK_MODE == 0
    a.ph_lo = 0; a.ph_hi = mk::N_PHASES;
    hipLaunchKernelGGL(mk::fwd, dim3(grid), dim3(mk::NTHREADS), mk::LDS_BYTES, stream, a);
#elif MK_MODE == 1
    for (int p = 0; p < mk::N_PHASES; ++p) { a.ph_lo = p; a.ph_hi = p + 1; hipLaunchKernelGGL(mk::fwd, dim3(grid), dim3(mk::NTHREADS), mk::LDS_BYTES, stream, a); }
#else
    for (int p = 0; p < MK_CUT; ++p) { a.ph_lo = p; a.ph_hi = p + 1; hipLaunchKernelGGL(mk::fwd, dim3(grid), dim3(mk::NTHREADS), mk::LDS_BYTES, stream, a); }
    {
        float* tmp = (float*)((char*)d_ws + 250 * mk::MiB);
        (void)hipMemcpyAsync(tmp, (char*)d_ws + mk::WS_META + mk::META_HM, 16 * 1024 * 4, hipMemcpyDeviceToDevice, stream);
        hipLaunchKernelGGL(dbg::adapt, dim3((unsigned)(((size_t)nv::ROWS * nv::D + 255) / 256)), dim3(256), 0, stream, (const float*)d_out, (const float*)tmp, (float*)d_ws);
        nv::forward(stream, d_in, (float*)d_out, (char*)d_ws, MK_STAGE);
    }
#endif
}
```

```cpp
#include <hip/hip_runtime.h>
#include <cstdint>
#include <cstdio>
#include <cmath>
#define MK_MODE 0
namespace mk {
#define LAS __attribute__((address_space(3)))
#define GAS __attribute__((address_space(1)))
typedef unsigned short bf16_t;
typedef short bf16x8 __attribute__((ext_vector_type(8)));
typedef short s16x4 __attribute__((ext_vector_type(4)));
typedef float f32x4 __attribute__((ext_vector_type(4)));
typedef float f32x2 __attribute__((ext_vector_type(2)));
typedef unsigned u32x4 __attribute__((ext_vector_type(4)));
typedef unsigned u32x2 __attribute__((ext_vector_type(2)));

constexpr int M = 16384, D = 1024, DFF = 2816, SEQ = 8192, NMETA = 16;
constexpr int NWAVES = 8, NTHREADS = 512;
constexpr size_t MiB = 1u << 20;
constexpr size_t WS_CTL = 0, CTL_ZERO_BYTES = 1 * MiB;
constexpr size_t CTL_OSS_RET = 256 * 1024, CTL_OSS_GLA = 512 * 1024, CTL_MOSS = 768 * 1024;
constexpr size_t WS_HB = 1 * MiB, WS_SS = 33 * MiB, WS_META = 34 * MiB, WS_WMIX = 35 * MiB;
constexpr size_t META_HM = 0, META_RAW = 64 * 1024, META_MO = 448 * 1024;
constexpr size_t WS_WFFN_A = 52 * MiB, WS_ACT = 69 * MiB, WS_WFFN_B = 157 * MiB, WS_WFFN_C = 244 * MiB;
constexpr size_t WS_QH = 52 * MiB, WS_KH = 84 * MiB, WS_VT = 116 * MiB, WS_O = 180 * MiB;
constexpr size_t WS_BC = 69 * MiB, WS_QH2 = 101 * MiB, WS_KH2 = 117 * MiB, WS_VT2 = 133 * MiB, WS_O2 = 174 * MiB;
constexpr size_t WS_NEED = 256 * MiB;
constexpr size_t WM_RET_IN = 0, WM_RET_OUT = 12 * MiB;
constexpr size_t WM_GLA_IN = 0, WM_GLA_G = 4 * MiB, WM_GLA_OUT = 6 * MiB, WM_GLA_Z = 8 * MiB;
constexpr size_t WF_IN = 0, WF_OUT = 11 * MiB;
constexpr int CW_BAR = 4096;

constexpr int LDS_BYTES = 163840;
constexpr int LDS_MISC = LDS_BYTES - 256;

__constant__ float L2G[4] = {-0.04580368961312478f, -0.02272007650008353f, -0.011315313227834133f, -0.005646563141142062f};
__constant__ float ROPE_INV[128] = {
  1.000000000e+00f, 9.300450087e-01f, 8.649836779e-01f, 8.044736385e-01f,
  7.481966019e-01f, 6.958565116e-01f, 6.471778154e-01f, 6.019044518e-01f,
  5.597981811e-01f, 5.206375122e-01f, 4.842162728e-01f, 4.503428936e-01f,
  4.188391268e-01f, 3.895392120e-01f, 3.622889817e-01f, 3.369450271e-01f,
  3.133740425e-01f, 2.914519310e-01f, 2.710633874e-01f, 2.521011233e-01f,
  2.344653904e-01f, 2.180633694e-01f, 2.028087080e-01f, 1.886212230e-01f,
  1.754262149e-01f, 1.631542742e-01f, 1.517407894e-01f, 1.411257535e-01f,
  1.312533021e-01f, 1.220714748e-01f, 1.135319397e-01f, 1.055898219e-01f,
  9.820328653e-02f, 9.133346379e-02f, 8.494423330e-02f, 7.900195569e-02f,
  7.347535342e-02f, 6.833537668e-02f, 6.355497986e-02f, 5.910899118e-02f,
  5.497401953e-02f, 5.112830922e-02f, 4.755162448e-02f, 4.422515258e-02f,
  4.113136977e-02f, 3.825402260e-02f, 3.557796404e-02f, 3.308910504e-02f,
  3.077435680e-02f, 2.862153389e-02f, 2.661931701e-02f, 2.475716174e-02f,
  2.302526683e-02f, 2.141453326e-02f, 1.991648041e-02f, 1.852322184e-02f,
  1.722742990e-02f, 1.602228358e-02f, 1.490144618e-02f, 1.385901403e-02f,
  1.288950257e-02f, 1.198781747e-02f, 1.114920899e-02f, 1.036926545e-02f,
  9.643883444e-03f, 8.969245479e-03f, 8.341802284e-03f, 7.758250926e-03f,
  7.215522230e-03f, 6.710760761e-03f, 6.241309457e-03f, 5.804697983e-03f,
  5.398627371e-03f, 5.020966288e-03f, 4.669724498e-03f, 4.343053792e-03f,
  4.039235413e-03f, 3.756670747e-03f, 3.493872471e-03f, 3.249458736e-03f,
  3.022142686e-03f, 2.810728736e-03f, 2.614103956e-03f, 2.431234345e-03f,
  2.261157380e-03f, 2.102978062e-03f, 1.955864020e-03f, 1.819041790e-03f,
  1.691789716e-03f, 1.573440502e-03f, 1.463370281e-03f, 1.361000235e-03f,
  1.265791478e-03f, 1.177242957e-03f, 1.094888896e-03f, 1.018295996e-03f,
  9.470609948e-04f, 8.808093844e-04f, 8.191923262e-04f, 7.618857198e-04f,
  7.085879333e-04f, 6.590186385e-04f, 6.129170069e-04f, 5.700403708e-04f,
  5.301629426e-04f, 4.930753494e-04f, 4.585822753e-04f, 4.265021416e-04f,
  3.966661752e-04f, 3.689173318e-04f, 3.431097430e-04f, 3.191074939e-04f,
  2.967843320e-04f, 2.760227653e-04f, 2.567135962e-04f, 2.387551940e-04f,
  2.220530587e-04f, 2.065193403e-04f, 1.920722716e-04f, 1.786358480e-04f,
  1.661392889e-04f, 1.545170089e-04f, 1.437077590e-04f, 1.336546848e-04f,
  1.243048755e-04f, 1.156091312e-04f, 1.075216787e-04f, 9.999999747e-05f,
};

#define LDS_WAIT() asm volatile("s_waitcnt lgkmcnt(0)" ::: "memory")
#define VM_WAIT() asm volatile("s_waitcnt vmcnt(0)" ::: "memory")
#define RLX_AGENT __ATOMIC_RELAXED, __HIP_MEMORY_SCOPE_AGENT

__device__ __forceinline__ unsigned cvt_pk_bf16(float lo, float hi) { unsigned r; asm volatile("v_cvt_pk_bf16_f32 %0, %1, %2" : "=v"(r) : "v"(lo), "v"(hi)); return r; }
__device__ __forceinline__ float bf_lo(unsigned w) { return __uint_as_float(w << 16); }
__device__ __forceinline__ float bf_hi(unsigned w) { return __uint_as_float(w & 0xffff0000u); }
__device__ __forceinline__ unsigned short f2bf(float f) { return (unsigned short)(cvt_pk_bf16(f, 0.f) & 0xffffu); }
__device__ __forceinline__ float fsilu(float v) { return v * __builtin_amdgcn_rcpf(1.0f + __expf(-v)); }
__device__ __forceinline__ float wave_sum(float v) {
#pragma unroll
    for (int o = 1; o < 64; o <<= 1) v += __shfl_xor(v, o);
    return v;
}
__device__ __forceinline__ float row_rstd(const float* SS, int row) {
    const f32x4* p = (const f32x4*)(SS + (size_t)row * 16);
    const f32x4 a = p[0], b = p[1], c = p[2], d = p[3];
    const float s = ((a.x + a.y) + (a.z + a.w)) + ((b.x + b.y) + (b.z + b.w)) + ((c.x + c.y) + (c.z + c.w)) + ((d.x + d.y) + (d.z + d.w));
    return 1.0f / sqrtf(s * (1.0f / 1024.0f) + 1e-6f);
}

#define XB_TMO      128
#define XB_XCNT(j)  (256  + 64 * (j))
#define XB_XSUB(j)  (1280 + 64 * (j))
#define XB_XGEN(j)  (2304 + 64 * (j))
#define XB_TOP      3328
#define XB_TOPGEN   3392
#define XCD_BAR_WORDS 3456
#define XB_SPIN_CAP (1u << 18)
__device__ __forceinline__ unsigned xb_ld(unsigned* p)              { return __hip_atomic_load(p, __ATOMIC_RELAXED, __HIP_MEMORY_SCOPE_AGENT); }
__device__ __forceinline__ unsigned xb_add(unsigned* p, unsigned v) { return __hip_atomic_fetch_add(p, v, __ATOMIC_RELAXED, __HIP_MEMORY_SCOPE_AGENT); }
__device__ __forceinline__ unsigned xb_xcc_id() { return (unsigned)__builtin_amdgcn_s_getreg((3 << 11) | 20) & 0xFu; }
#define XB_SPIN(cond, bar) do { unsigned _sp = 0; while (cond) { __builtin_amdgcn_s_sleep(1); \
    if ((++_sp & 255u) == 0u) { if (xb_ld(&(bar)[XB_TMO])) break; if (_sp > XB_SPIN_CAP) { atomicAdd(&(bar)[XB_TMO], 1u); break; } } } } while (0)
struct XcdBarrier { unsigned* bar; unsigned x; volatile LAS unsigned* st; };
__device__ __forceinline__ XcdBarrier xcd_barrier_post(unsigned* bar, volatile LAS unsigned* st) {
    XcdBarrier b; b.bar = bar; b.x = xb_xcc_id(); b.st = st;
    if (threadIdx.x == 0) { const unsigned rank = xb_add(&bar[XB_XCNT(b.x)], 1u); st[2] = rank; st[3] = b.x; }
    return b;
}
__device__ __forceinline__ void xcd_barrier_complete(unsigned* bar, unsigned x, unsigned& nloc, unsigned& nx) {
    const unsigned G = gridDim.x * gridDim.y * gridDim.z;
    unsigned sum, cnt, mine, sp = 0u;
    for (;;) {
        sum = 0u; cnt = 0u; mine = 0u;
#pragma unroll
        for (unsigned j = 0; j < 16; ++j) { const unsigned c = xb_ld(&bar[XB_XCNT(j)]); sum += c; cnt += (c > 0u) ? 1u : 0u; mine = (j == x) ? c : mine; }
        if (sum == G) break;
        __builtin_amdgcn_s_sleep(1);
        if ((++sp & 255u) == 0u) { if (xb_ld(&bar[XB_TMO])) break; if (sp > XB_SPIN_CAP) { atomicAdd(&bar[XB_TMO], 1u); break; } }
    }
    nloc = mine > 0u ? mine : 1u; nx = cnt > 0u ? cnt : 1u;
}
__device__ __forceinline__ void xcd_barrier(const XcdBarrier& b) {
    asm volatile("s_waitcnt vmcnt(0)" ::: "memory");
    __syncthreads();
    if (threadIdx.x == 0) {
        unsigned* bar = b.bar;
        __builtin_amdgcn_s_waitcnt(0);
        unsigned nloc = b.st[0], nx = b.st[1];
        if (nloc == 0u) { xcd_barrier_complete(bar, b.x, nloc, nx); b.st[0] = nloc; b.st[1] = nx; }
        const unsigned old = xb_add(&bar[XB_XSUB(b.x)], 1u);
        const unsigned gen = old / nloc;
        if (old + 1u == (gen + 1u) * nloc) {
            __builtin_amdgcn_fence(__ATOMIC_RELEASE, "agent");
            asm volatile("s_waitcnt vmcnt(0)" ::: "memory");
            const unsigned og = xb_add(&bar[XB_TOP], 1u);
            const unsigned tg = og / nx;
            if (og + 1u == (tg + 1u) * nx) xb_add(&bar[XB_TOPGEN], 1u);
            else XB_SPIN(xb_ld(&bar[XB_TOPGEN]) == tg, bar);
            __builtin_amdgcn_fence(__ATOMIC_ACQUIRE, "agent");
            xb_add(&bar[XB_XGEN(b.x)], 1u);
            asm volatile("s_waitcnt vmcnt(0)" ::: "memory");
        } else {
            XB_SPIN(xb_ld(&bar[XB_XGEN(b.x)]) == gen, bar);
            __builtin_amdgcn_fence(__ATOMIC_ACQUIRE, "agent");
            asm volatile("s_waitcnt vmcnt(0)" ::: "memory");
        }
    }
    __syncthreads();
}

namespace pg8 {
constexpr int BM = 256, BK = 64, HALF = 128, HTB = HALF * BK * 2, STAGE_BYTES = 8 * HTB, NXCD = 8, WGM = 8;
__host__ __device__ __forceinline__ int lds_byte(int r, int c) { const int st = (r >> 4) * 2 + (c >> 5), rr = r & 15, cc = c & 31, ob = rr * 64 + cc * 2; return st * 1024 + (ob ^ (((ob >> 9) & 1) << 5)); }
__host__ __device__ __forceinline__ void stage_rc(int b, int& R, int& C) { const int st = b / 1024, sb = b % 1024, swz = sb ^ (((sb >> 9) & 1) << 5); R = (st >> 1) * 16 + swz / 64; C = (st & 1) * 32 + (swz % 64) / 2; }
__host__ __device__ __forceinline__ int perm32(int rho) { const int n = rho >> 4, i = rho & 15; return 8 * (i >> 2) + 4 * n + (i & 3); }
struct Unit { int pm, pn; };
struct Order {
    int nM, nN, nwg, G, c;
    __device__ void init(int nM_, int nN_, int G_, int c_) { nM = nM_; nN = nN_; nwg = nM * nN; G = G_; c = c_; }
    __device__ bool next(int i, Unit& u) const {
        const long L = (long)i * G + c; if (L >= nwg) return false;
        int wgid = (int)L; { const int q = nwg / NXCD, r = nwg % NXCD, xcd = wgid % NXCD, off = wgid / NXCD; wgid = (xcd < r ? xcd * (q + 1) : r * (q + 1) + (xcd - r) * q) + off; }
        const int nig = WGM * nN, gid = wgid / nig, fm = gid * WGM, gsz = (nM - fm) < WGM ? (nM - fm) : WGM;
        u.pm = fm + ((wgid % nig) % gsz); u.pn = (wgid % nig) / gsz; return true;
    }
};
template <class Epi, class Ptr>
__device__ __forceinline__ void gemm_phase(LAS unsigned char* lds, const int K, const Order& S, const Ptr& P, const Epi& E) {
    const int tid = threadIdx.x, wid = __builtin_amdgcn_readfirstlane(tid >> 6), lane = tid & 63, wr = wid >> 2, wc = wid & 3, fr = lane & 15, fq = lane >> 4;
    const int nt = K / BK;
    unsigned voffA[2], voffB[2];
#pragma unroll
    for (int i = 0; i < 2; ++i) { int R, C; stage_rc(tid * 16 + i * 8192, R, C); const int Rb = (R & ~31) + perm32(R & 31);
        voffA[i] = (unsigned)(R * K + C) * 2u; voffB[i] = (unsigned)(Rb * K + C) * 2u; }
    const size_t kstep = (size_t)(BK * 2);
    const size_t hstep = (size_t)HALF * K * 2;
    const unsigned ldsw = (unsigned)wid * 1024u;
    const int aoff = lds_byte(wr * 64 + fr, fq * 8), boff = lds_byte(wc * 32 + fr, fq * 8);
#define PG8_SA(b, h) (((b) * 2 + (h)) * HTB)
#define PG8_SB(b, h) ((4 + (b) * 2 + (h)) * HTB)
#define PG8_STAGE(bufoff, gbase, voff) do { _Pragma("unroll") for (int _i = 0; _i < 2; ++_i) \
        __builtin_amdgcn_global_load_lds((const unsigned*)((const char*)(gbase) + (voff)[_i]), (LAS unsigned*)(lds + (bufoff) + ldsw + _i * 8192), 16, 0, 0); } while (0)
#define PG8_LDA(dst, b, h) do { _Pragma("unroll") for (int m = 0; m < 4; ++m) _Pragma("unroll") for (int k = 0; k < 2; ++k) dst[m][k] = *(const LAS bf16x8*)(lds + PG8_SA(b, h) + aoff + m * 2048 + k * 1024); } while (0)
#define PG8_LDB(dst, b, h) do { _Pragma("unroll") for (int n = 0; n < 2; ++n) _Pragma("unroll") for (int k = 0; k < 2; ++k) dst[n][k] = *(const LAS bf16x8*)(lds + PG8_SB(b, h) + boff + n * 2048 + k * 1024); } while (0)
#define PG8_MMA(ai, bj, At, Bt) do { __builtin_amdgcn_s_setprio(1); _Pragma("unroll") for (int m = 0; m < 4; ++m) _Pragma("unroll") for (int n = 0; n < 2; ++n) _Pragma("unroll") for (int k = 0; k < 2; ++k) \
        acc[ai][bj][m][n] = __builtin_amdgcn_mfma_f32_16x16x32_bf16(Bt[n][k], At[m][k], acc[ai][bj][m][n], 0, 0, 0); __builtin_amdgcn_s_setprio(0); } while (0)
#define PG8_WAIT_V(n) asm volatile("s_waitcnt vmcnt(" #n ")" ::: "memory")
#define PG8_WAIT_L(n) asm volatile("s_waitcnt lgkmcnt(" #n ")" ::: "memory")
#define PG8_BAR __builtin_amdgcn_s_barrier()
#define PG8_SCHED __builtin_amdgcn_sched_barrier(0)
    Unit cur, nxt; int ui = 0;
    if (!S.next(0, cur)) return;
    f32x4 acc[2][2][4][2];
#pragma unroll
    for (int a = 0; a < 2; ++a)
#pragma unroll
        for (int b = 0; b < 2; ++b)
#pragma unroll
            for (int m = 0; m < 4; ++m)
#pragma unroll
                for (int n = 0; n < 2; ++n) acc[a][b][m][n] = (f32x4){0.f, 0.f, 0.f, 0.f};
    bf16x8 At[4][2], B0[2][2], B1[2][2];
    const char* cA; const char* cB; P.ptrs(cur, cA, cB);
    PG8_STAGE(PG8_SB(0, 0), cB, voffB); PG8_STAGE(PG8_SB(0, 1), cB + hstep, voffB); PG8_STAGE(PG8_SA(0, 0), cA, voffA); PG8_STAGE(PG8_SA(0, 1), cA + hstep, voffA);
    if (wr == 1) PG8_BAR;
    PG8_WAIT_V(2); PG8_BAR;
    PG8_STAGE(PG8_SB(1, 0), cB + kstep, voffB); PG8_STAGE(PG8_SA(1, 0), cA + kstep, voffA); PG8_STAGE(PG8_SB(1, 1), cB + hstep + kstep, voffB);
    PG8_WAIT_V(6); PG8_BAR;
    for (;;) {
        const bool has_next = S.next(ui + 1, nxt);
        const char* nA = cA; const char* nB = cB; if (has_next) P.ptrs(nxt, nA, nB);
        for (int t = 0; t < nt; t += 2) {
            const bool last = (t == nt - 2);
            const char* a1 = cA + (size_t)(t + 1) * kstep;
            const char* a2 = last ? nA : cA + (size_t)(t + 2) * kstep; const char* b2 = last ? nB : cB + (size_t)(t + 2) * kstep;
            const char* a3 = a2 + kstep; const char* b3 = b2 + kstep;
            PG8_LDB(B0, 0, 0); PG8_LDB(B1, 0, 1); PG8_SCHED; PG8_LDA(At, 0, 0); PG8_STAGE(PG8_SA(1, 1), a1 + hstep, voffA);
            PG8_WAIT_V(8); PG8_WAIT_L(0); PG8_BAR; PG8_MMA(0, 0, At, B0); PG8_MMA(0, 1, At, B1); PG8_BAR; PG8_SCHED;
            PG8_LDA(At, 0, 1); PG8_STAGE(PG8_SB(0, 0), b2, voffB); PG8_STAGE(PG8_SB(0, 1), b2 + hstep, voffB); PG8_STAGE(PG8_SA(0, 0), a2, voffA);
            PG8_WAIT_V(8); PG8_WAIT_L(0); PG8_BAR; PG8_MMA(1, 0, At, B0); PG8_MMA(1, 1, At, B1); PG8_BAR; PG8_SCHED;
            PG8_LDB(B0, 1, 0); PG8_LDB(B1, 1, 1); PG8_SCHED; PG8_LDA(At, 1, 0); PG8_STAGE(PG8_SA(0, 1), a2 + hstep, voffA);
            PG8_WAIT_V(8); PG8_WAIT_L(0); PG8_BAR; PG8_MMA(0, 0, At, B0); PG8_MMA(0, 1, At, B1); PG8_BAR; PG8_SCHED;
            PG8_LDA(At, 1, 1); PG8_STAGE(PG8_SB(1, 0), b3, voffB); PG8_STAGE(PG8_SB(1, 1), b3 + hstep, voffB); PG8_STAGE(PG8_SA(1, 0), a3, voffA);
            PG8_WAIT_V(8); PG8_WAIT_L(0); PG8_BAR; PG8_MMA(1, 0, At, B0); PG8_MMA(1, 1, At, B1); PG8_BAR; PG8_SCHED;
        }
        if (wr == 0) PG8_BAR;
        E(acc, cur, wr, wc, fr, fq);
        if (!has_next) break;
#pragma unroll
        for (int a = 0; a < 2; ++a)
#pragma unroll
            for (int b = 0; b < 2; ++b)
#pragma unroll
                for (int m = 0; m < 4; ++m)
#pragma unroll
                    for (int n = 0; n < 2; ++n) acc[a][b][m][n] = (f32x4){0.f, 0.f, 0.f, 0.f};
        cur = nxt; cA = nA; cB = nB; ++ui;
        if (wr == 1) PG8_BAR;
    }
    PG8_WAIT_V(0);
    PG8_BAR;
#undef PG8_SA
#undef PG8_SB
#undef PG8_STAGE
#undef PG8_LDA
#undef PG8_LDB
#undef PG8_MMA
#undef PG8_WAIT_V
#undef PG8_WAIT_L
#undef PG8_BAR
#undef PG8_SCHED
}
}
struct Frame {
    LAS unsigned char* lds;
    int tid, lane, wave, vcu, G, vb;
    unsigned char* ws;
    const float* in[18];
    float* out;
};
#define WSP(T, off) ((T*)(F.ws + (off)))

__device__ __forceinline__ void conv_item(const float* W, int ldn, int srccol0, int k0, const float* gain, bf16_t* WT, int K, int dstrow0, LAS float* scr, int lane) {
    float v[32];
    const float* wp = W + (size_t)(k0 + (lane >> 5)) * ldn + srccol0 + (lane & 31);
#pragma unroll
    for (int i = 0; i < 32; ++i) v[i] = wp[(size_t)(2 * i) * ldn];
    const int c = lane & 7;
    float gn[8];
#pragma unroll
    for (int e = 0; e < 8; ++e) gn[e] = gain ? gain[k0 + 8 * c + e] : 1.0f;
#pragma unroll
    for (int i = 0; i < 32; ++i) scr[(2 * i + (lane >> 5)) * 33 + (lane & 31)] = v[i];
    LDS_WAIT(); asm volatile("" ::: "memory");
#pragma unroll
    for (int j = 0; j < 4; ++j) { const int n = (lane >> 3) + 8 * j; const LAS float* s = scr + (8 * c) * 33 + n;
        u32x4 o; o.x = cvt_pk_bf16(s[0 * 33] * gn[0], s[1 * 33] * gn[1]); o.y = cvt_pk_bf16(s[2 * 33] * gn[2], s[3 * 33] * gn[3]);
        o.z = cvt_pk_bf16(s[4 * 33] * gn[4], s[5 * 33] * gn[5]); o.w = cvt_pk_bf16(s[6 * 33] * gn[6], s[7 * 33] * gn[7]);
        *(u32x4*)(WT + (size_t)(dstrow0 + n) * K + k0 + 8 * c) = o; }
    LDS_WAIT(); asm volatile("" ::: "memory");
}
struct ConvJob { const float* W; int ldn, K, N, col0, kind; const float* gain; bf16_t* WT; };
__device__ __forceinline__ int conv_items(const ConvJob& J) { return (J.K / 64) * (J.N / 32); }
__device__ __forceinline__ void conv_run(const ConvJob& J, int item, LAS float* scr, int lane) {
    const int nblk = J.N / 32, kb = item / nblk, nb = item % nblk; const int n0 = 32 * nb;
    int src;
    if (J.kind == 0) src = J.col0 + n0; else { const int u = n0 >> 8, j = n0 & 255; src = (j < 128) ? u * 128 + j : 2816 + u * 128 + (j - 128); }
    conv_item(J.W, J.ldn, src, 64 * kb, J.gain, J.WT, J.K, n0, scr, lane);
}
__device__ __forceinline__ int conv_job(Frame& F, const ConvJob& J, int base, int gw, int ngw) {
    LAS float* scr = (LAS float*)(F.lds + F.wave * 16384);
    const int n = conv_items(J);
    const int first = (gw - base % ngw + ngw) % ngw;
    for (int it = first; it < n; it += ngw) conv_run(J, it, scr, F.lane);
    return base + n;
}
__device__ __forceinline__ ConvJob job_ffn_in(Frame& F, int layer, int which  , size_t dst) {
    ConvJob J; J.W = F.in[which ? 7 : 3] + (size_t)layer * D * 2 * DFF; J.ldn = 2 * DFF; J.K = D; J.N = 2 * DFF; J.col0 = 0; J.kind = 1; J.gain = F.in[which ? 6 : 2] + layer * D; J.WT = WSP(bf16_t, dst); return J; }
__device__ __forceinline__ ConvJob job_ffn_out(Frame& F, int layer, int which, size_t dst) {
    ConvJob J; J.W = F.in[which ? 8 : 4] + (size_t)layer * DFF * D; J.ldn = D; J.K = DFF; J.N = D; J.col0 = 0; J.kind = 0; J.gain = nullptr; J.WT = WSP(bf16_t, dst); return J; }

struct EpiSwiglu {
    const float* SS; bf16_t* ACT;
    __device__ __forceinline__ void operator()(const f32x4 (&acc)[2][2][4][2], const pg8::Unit& u, int wr, int wc, int fr, int fq) const {
#pragma unroll
        for (int ai = 0; ai < 2; ++ai)
#pragma unroll
            for (int m = 0; m < 4; ++m) {
                const int row = u.pm * 256 + ai * 128 + wr * 64 + m * 16 + fr; const float rs = row_rstd(SS, row);
                float v[8];
#pragma unroll
                for (int n = 0; n < 2; ++n)
#pragma unroll
                    for (int j = 0; j < 4; ++j) { const float g = acc[ai][0][m][n][j] * rs, up = acc[ai][1][m][n][j] * rs; v[4 * n + j] = fsilu(g) * up; }
                u32x4 w; w.x = cvt_pk_bf16(v[0], v[1]); w.y = cvt_pk_bf16(v[2], v[3]); w.z = cvt_pk_bf16(v[4], v[5]); w.w = cvt_pk_bf16(v[6], v[7]);
                *(u32x4*)(ACT + (size_t)row * DFF + u.pn * 128 + wc * 32 + 8 * fq) = w;
            }
    }
};
template <bool BASE_F32> struct EpiResid {
    const float* xbase; bf16_t* HB; float* SS; float alpha;
    __device__ __forceinline__ void operator()(const f32x4 (&acc)[2][2][4][2], const pg8::Unit& u, int wr, int wc, int fr, int fq) const {
#pragma unroll
        for (int ai = 0; ai < 2; ++ai)
#pragma unroll
            for (int m = 0; m < 4; ++m) {
                const int row = u.pm * 256 + ai * 128 + wr * 64 + m * 16 + fr; float ss = 0.f;
#pragma unroll
                for (int bj = 0; bj < 2; ++bj) {
                    const size_t off = (size_t)row * D + u.pn * 256 + bj * 128 + wc * 32 + 8 * fq;
                    f32x4 b0, b1;
                    if (BASE_F32) { b0 = *(const f32x4*)(xbase + off); b1 = *(const f32x4*)(xbase + off + 4); }
                    else { const u32x4 hv = *(const u32x4*)(HB + off); b0 = (f32x4){bf_lo(hv.x), bf_hi(hv.x), bf_lo(hv.y), bf_hi(hv.y)}; b1 = (f32x4){bf_lo(hv.z), bf_hi(hv.z), bf_lo(hv.w), bf_hi(hv.w)}; }
                    const f32x4 v0 = b0 + acc[ai][bj][m][0] * alpha, v1 = b1 + acc[ai][bj][m][1] * alpha;
                    u32x4 w; w.x = cvt_pk_bf16(v0[0], v0[1]); w.y = cvt_pk_bf16(v0[2], v0[3]); w.z = cvt_pk_bf16(v1[0], v1[1]); w.w = cvt_pk_bf16(v1[2], v1[3]);
                    *(u32x4*)(HB + off) = w;
                    ss += (v0[0] * v0[0] + v0[1] * v0[1]) + (v0[2] * v0[2] + v0[3] * v0[3]) + (v1[0] * v1[0] + v1[1] * v1[1]) + (v1[2] * v1[2] + v1[3] * v1[3]);
                }
                ss += __shfl_xor(ss, 16); ss += __shfl_xor(ss, 32);
                if (fq == 0) SS[(size_t)row * 16 + u.pn * 4 + wc] = ss;
            }
    }
};
struct EpiRetIn {
    const float* SS; bf16_t* QH; bf16_t* KH; bf16_t* VT;
    __device__ __forceinline__ void operator()(const f32x4 (&acc)[2][2][4][2], const pg8::Unit& u, int wr, int wc, int fr, int fq) const {
        if (u.pn < 8) {
            const bool isq = u.pn < 4; const int head = u.pn & 3; bf16_t* dst = isq ? QH : KH;
            const float l2g = isq ? L2G[head] : -L2G[head], sc = isq ? 1.0f : 0.0625f;
            float inv[8];
#pragma unroll
            for (int e = 0; e < 8; ++e) inv[e] = ROPE_INV[wc * 32 + 8 * fq + e];
#pragma unroll
            for (int ai = 0; ai < 2; ++ai)
#pragma unroll
                for (int m = 0; m < 4; ++m) {
                    const int row = u.pm * 256 + ai * 128 + wr * 64 + m * 16 + fr; const float rs = row_rstd(SS, row);
                    const int b = row >> 13, t = row & 8191; const float pos = (float)(t + NMETA);
                    const float dec = __builtin_amdgcn_exp2f((float)((t & 31) + 1) * l2g) * sc * rs;
                    float o1[8], o2[8];
#pragma unroll
                    for (int n = 0; n < 2; ++n)
#pragma unroll
                        for (int j = 0; j < 4; ++j) { const int e = 4 * n + j;
                            const float rev = (pos * inv[e]) * 0.15915494309189535f; const float frc = rev - floorf(rev);
                            const float sn = __builtin_amdgcn_sinf(frc), cs = __builtin_amdgcn_cosf(frc);
                            const float t1 = acc[ai][0][m][n][j], t2 = acc[ai][1][m][n][j];
                            o1[e] = (t1 * cs - t2 * sn) * dec; o2[e] = (t1 * sn + t2 * cs) * dec; }
                    bf16_t* p = dst + ((size_t)(b * 4 + head) * SEQ + t) * 256 + wc * 32 + 8 * fq;
                    u32x4 w; w.x = cvt_pk_bf16(o1[0], o1[1]); w.y = cvt_pk_bf16(o1[2], o1[3]); w.z = cvt_pk_bf16(o1[4], o1[5]); w.w = cvt_pk_bf16(o1[6], o1[7]);
                    *(u32x4*)p = w;
                    w.x = cvt_pk_bf16(o2[0], o2[1]); w.y = cvt_pk_bf16(o2[2], o2[3]); w.z = cvt_pk_bf16(o2[4], o2[5]); w.w = cvt_pk_bf16(o2[6], o2[7]);
                    *(u32x4*)(p + 128) = w;
                }
        } else {
            float rs[2][8];
#pragma unroll
            for (int bj = 0; bj < 2; ++bj)
#pragma unroll
                for (int e = 0; e < 8; ++e) rs[bj][e] = row_rstd(SS, u.pm * 256 + bj * 128 + wc * 32 + 8 * fq + e);
            const int b = u.pm >> 5, t0 = (u.pm & 31) * 256;
#pragma unroll
            for (int ai = 0; ai < 2; ++ai)
#pragma unroll
                for (int m = 0; m < 4; ++m) {
                    const int vc = (u.pn - 8) * 256 + ai * 128 + wr * 64 + m * 16 + fr; const int head = vc >> 9, dvi = vc & 511;
                    bf16_t* p = VT + ((size_t)(b * 4 + head) * 512 + dvi) * SEQ + t0 + wc * 32 + 8 * fq;
#pragma unroll
                    for (int bj = 0; bj < 2; ++bj) {
                        const f32x4 v0 = acc[ai][bj][m][0], v1 = acc[ai][bj][m][1];
                        u32x4 w; w.x = cvt_pk_bf16(v0[0] * rs[bj][0], v0[1] * rs[bj][1]); w.y = cvt_pk_bf16(v0[2] * rs[bj][2], v0[3] * rs[bj][3]);
                        w.z = cvt_pk_bf16(v1[0] * rs[bj][4], v1[1] * rs[bj][5]); w.w = cvt_pk_bf16(v1[2] * rs[bj][6], v1[3] * rs[bj][7]);
                        *(u32x4*)(p + bj * 128) = w;
                    }
                }
        }
    }
};
template <int DV, int LDO> struct EpiGate {
    const float* SS; const bf16_t* O; bf16_t* Y; LAS float* RO;
    __device__ __forceinline__ void operator()(const f32x4 (&acc)[2][2][4][2], const pg8::Unit& u, int wr, int wc, int fr, int fq) const {
        const int wid = wr * 4 + wc, lane = fq * 16 + fr; const int head = (u.pn * 256) / DV;
        {   const bf16_t* ob = O + (size_t)(u.pm * 256 + wid * 32) * LDO + head * DV;
#pragma unroll
            for (int i0 = 0; i0 < 32; i0 += 8) { float sv[8];
#pragma unroll
                for (int i = 0; i < 8; ++i) { float s;
                    if (DV == 512) { const u32x4 v = *(const u32x4*)(ob + (size_t)(i0 + i) * LDO + lane * 8);
                        const float a0 = bf_lo(v.x), a1 = bf_hi(v.x), a2 = bf_lo(v.y), a3 = bf_hi(v.y), a4 = bf_lo(v.z), a5 = bf_hi(v.z), a6 = bf_lo(v.w), a7 = bf_hi(v.w);
                        s = ((a0 * a0 + a1 * a1) + (a2 * a2 + a3 * a3)) + ((a4 * a4 + a5 * a5) + (a6 * a6 + a7 * a7)); }
                    else { const u32x2 v = *(const u32x2*)(ob + (size_t)(i0 + i) * LDO + lane * 4);
                        const float a0 = bf_lo(v.x), a1 = bf_hi(v.x), a2 = bf_lo(v.y), a3 = bf_hi(v.y); s = (a0 * a0 + a1 * a1) + (a2 * a2 + a3 * a3); }
                    sv[i] = s; }
#pragma unroll
                for (int i = 0; i < 8; ++i) { const float t = wave_sum(sv[i]); if (lane == 0) RO[wid * 32 + i0 + i] = 1.0f / sqrtf(t * (1.0f / (float)DV) + 1e-6f); } }
            LDS_WAIT(); __builtin_amdgcn_s_barrier(); asm volatile("" ::: "memory"); }
#pragma unroll
        for (int ai = 0; ai < 2; ++ai)
#pragma unroll
            for (int m = 0; m < 4; ++m) {
                const int rl = ai * 128 + wr * 64 + m * 16 + fr, row = u.pm * 256 + rl; const float rs = row_rstd(SS, row); const float ro = RO[rl];
#pragma unroll
                for (int bj = 0; bj < 2; ++bj) {
                    const int col = u.pn * 256 + bj * 128 + wc * 32 + 8 * fq;
                    const u32x4 ov = *(const u32x4*)(O + (size_t)row * LDO + col);
                    const f32x4 g0 = acc[ai][bj][m][0] * rs, g1 = acc[ai][bj][m][1] * rs;
                    u32x4 w;
                    w.x = cvt_pk_bf16(bf_lo(ov.x) * ro * fsilu(g0[0]), bf_hi(ov.x) * ro * fsilu(g0[1]));
                    w.y = cvt_pk_bf16(bf_lo(ov.y) * ro * fsilu(g0[2]), bf_hi(ov.y) * ro * fsilu(g0[3]));
                    w.z = cvt_pk_bf16(bf_lo(ov.z) * ro * fsilu(g1[0]), bf_hi(ov.z) * ro * fsilu(g1[1]));
                    w.w = cvt_pk_bf16(bf_lo(ov.w) * ro * fsilu(g1[2]), bf_hi(ov.w) * ro * fsilu(g1[3]));
                    *(u32x4*)(Y + (size_t)row * LDO + col) = w;
                }
            }
        asm volatile("" ::: "memory"); __builtin_amdgcn_s_barrier(); asm volatile("" ::: "memory");
    }
};
struct EpiGlaIn {
    const float* SS; const float* BC; bf16_t* QH; bf16_t* KH; bf16_t* VT;
    __device__ __forceinline__ void operator()(const f32x4 (&acc)[2][2][4][2], const pg8::Unit& u, int wr, int wc, int fr, int fq) const {
        if (u.pn < 4) {
            const bool isq = u.pn < 2; bf16_t* dst = isq ? QH : KH;
#pragma unroll
            for (int ai = 0; ai < 2; ++ai)
#pragma unroll
                for (int m = 0; m < 4; ++m) {
                    const int row = u.pm * 256 + ai * 128 + wr * 64 + m * 16 + fr; const float rs = row_rstd(SS, row) * (isq ? 0.08838834764831845f : 1.0f);
                    const int b = row >> 13, t = row & 8191;
#pragma unroll
                    for (int bj = 0; bj < 2; ++bj) {
                        const int cq = (u.pn & 1) * 256 + bj * 128 + wc * 32 + 8 * fq; const int head = cq >> 7, d = cq & 127;
                        const f32x4 c0 = *(const f32x4*)(BC + (size_t)row * 512 + cq), c1 = *(const f32x4*)(BC + (size_t)row * 512 + cq + 4);
                        float v[8];
#pragma unroll
                        for (int j = 0; j < 4; ++j) { v[j] = acc[ai][bj][m][0][j] * rs * __expf(isq ? c0[j] : -c0[j]); v[4 + j] = acc[ai][bj][m][1][j] * rs * __expf(isq ? c1[j] : -c1[j]); }
                        u32x4 w; w.x = cvt_pk_bf16(v[0], v[1]); w.y = cvt_pk_bf16(v[2], v[3]); w.z = cvt_pk_bf16(v[4], v[5]); w.w = cvt_pk_bf16(v[6], v[7]);
                        *(u32x4*)(dst + ((size_t)(b * 4 + head) * SEQ + t) * 128 + d) = w;
                    }
                }
        } else {
            float rs[2][8];
#pragma unroll
            for (int bj = 0; bj < 2; ++bj)
#pragma unroll
                for (int e = 0; e < 8; ++e) rs[bj][e] = row_rstd(SS, u.pm * 256 + bj * 128 + wc * 32 + 8 * fq + e);
            const int b = u.pm >> 5, t0 = (u.pm & 31) * 256; const int head = u.pn - 4;
#pragma unroll
            for (int ai = 0; ai < 2; ++ai)
#pragma unroll
                for (int m = 0; m < 4; ++m) {
                    const int dvi = ai * 128 + wr * 64 + m * 16 + fr;
                    bf16_t* p = VT + ((size_t)(b * 4 + head) * 256 + dvi) * SEQ + t0 + wc * 32 + 8 * fq;
#pragma unroll
                    for (int bj = 0; bj < 2; ++bj) {
                        const f32x4 v0 = acc[ai][bj][m][0], v1 = acc[ai][bj][m][1];
                        u32x4 w; w.x = cvt_pk_bf16(v0[0] * rs[bj][0], v0[1] * rs[bj][1]); w.y = cvt_pk_bf16(v0[2] * rs[bj][2], v0[3] * rs[bj][3]);
                        w.z = cvt_pk_bf16(v1[0] * rs[bj][4], v1[1] * rs[bj][5]); w.w = cvt_pk_bf16(v1[2] * rs[bj][6], v1[3] * rs[bj][7]);
                        *(u32x4*)(p + bj * 128) = w;
                    }
                }
        }
    }
};
struct PtrNormal { const char* A; const char* B; size_t tstep;
    __device__ __forceinline__ void ptrs(const pg8::Unit& u, const char*& cA, const char*& cB) const { cA = A + (size_t)u.pm * tstep; cB = B + (size_t)u.pn * tstep; } };
struct PtrSwapFrom { const char* A; const char* B; size_t tstep; int pn_swap;
    __device__ __forceinline__ void ptrs(const pg8::Unit& u, const char*& cA, const char*& cB) const {
        const char* a = A + (size_t)u.pm * tstep; const char* b = B + (size_t)u.pn * tstep;
        if (u.pn >= pn_swap) { cA = b; cB = a; } else { cA = a; cB = b; } } };

constexpr int MA_RS_OFF = 98304, MA_RED_OFF = 100352;
template <int MODE> __device__ __forceinline__ void meta_tiles(Frame& F, const bf16_t* Bt, int N, int K, float* out, int ldo, float alpha, int b0, int nb) {
    const int lane = F.lane, g = lane >> 4, r16 = lane & 15, pitch = K + 8;
    const LAS bf16_t* A = (const LAS bf16_t*)F.lds; const LAS float* rsA = (const LAS float*)(F.lds + MA_RS_OFF); LAS f32x4* red = (LAS f32x4*)(F.lds + MA_RED_OFF);
    const int ksteps = K / 32, per = ksteps / 8;
    for (int tile = F.vb - b0; tile < N / 16; tile += nb) {
        f32x4 acc = (f32x4){0.f, 0.f, 0.f, 0.f};
        const bf16_t* bp = Bt + (size_t)(tile * 16 + r16) * K + 8 * g;
        for (int ks = F.wave * per; ks < (F.wave + 1) * per; ++ks) {
            const bf16x8 a = *(const LAS bf16x8*)(A + r16 * pitch + ks * 32 + 8 * g);
            const bf16x8 b = *(const bf16x8*)(bp + ks * 32);
            acc = __builtin_amdgcn_mfma_f32_16x16x32_bf16(a, b, acc, 0, 0, 0);
        }
        red[F.wave * 64 + lane] = acc;
        __syncthreads();
        if (F.wave == 0) {
            f32x4 s = red[lane];
#pragma unroll
            for (int w = 1; w < 8; ++w) s += red[w * 64 + lane];
#pragma unroll
            for (int j = 0; j < 4; ++j) { const int r = 4 * g + j; float* o = out + (size_t)r * ldo + tile * 16 + r16;
                if (MODE == 0) *o = s[j] * rsA[r]; else *o = *o + alpha * s[j]; }
        }
        __syncthreads();
    }
}
__device__ __forceinline__ bool meta_has_tiles(Frame& F, int N, int b0, int nb) { const int r = F.vb - b0; return r >= 0 && r < nb && r < N / 16; }
__device__ __forceinline__ void meta_prep_h(Frame& F) {
    const float* HM = WSP(float, WS_META + META_HM); LAS bf16_t* A = (LAS bf16_t*)F.lds; LAS float* rsA = (LAS float*)(F.lds + MA_RS_OFF);
    for (int r = F.wave; r < 16; r += 8) { float s = 0.f;
        for (int k = F.lane; k < D; k += 64) { const float v = HM[r * D + k]; s += v * v; A[r * (D + 8) + k] = f2bf(v); }
        s = wave_sum(s); if (F.lane == 0) rsA[r] = 1.0f / sqrtf(s * (1.0f / 1024.0f) + 1e-6f); }
    __syncthreads();
}
__device__ __forceinline__ void meta_prep_act(Frame& F) {
    const float* RAW = WSP(float, WS_META + META_RAW); LAS bf16_t* A = (LAS bf16_t*)F.lds; LAS float* rsA = (LAS float*)(F.lds + MA_RS_OFF);
    for (int i = F.tid; i < 16 * DFF; i += NTHREADS) { const int r = i / DFF, k = i % DFF, u = k >> 7, j = k & 127;
        const float g = RAW[r * 5632 + u * 256 + j], up = RAW[r * 5632 + u * 256 + 128 + j]; A[r * (DFF + 8) + k] = f2bf(fsilu(g) * up); }
    if (F.tid < 16) rsA[F.tid] = 1.f;
    __syncthreads();
}
__device__ __forceinline__ void meta_prep_y(Frame& F) {
    const float* RAW = WSP(float, WS_META + META_RAW); const float* MO = WSP(float, WS_META + META_MO);
    LAS bf16_t* A = (LAS bf16_t*)F.lds; LAS float* rsA = (LAS float*)(F.lds + MA_RS_OFF); LAS float* mro = (LAS float*)(F.lds + MA_RED_OFF);
    for (int p = F.wave; p < 64; p += 8) { const int r = p >> 2, head = p & 3; float sacc = 0.f;
        for (int k = F.lane; k < 512; k += 64) { const float v = MO[r * 2048 + head * 512 + k]; sacc += v * v; }
        sacc = wave_sum(sacc); if (F.lane == 0) mro[p] = 1.0f / sqrtf(sacc * (1.0f / 512.0f) + 1e-6f); }
    __syncthreads();
    for (int i = F.tid; i < 16 * 2048; i += NTHREADS) { const int r = i >> 11, k = i & 2047, head = k >> 9;
        A[r * (2048 + 8) + k] = f2bf(MO[r * 2048 + k] * mro[r * 4 + head] * fsilu(RAW[r * 6144 + 4096 + k])); }
    if (F.tid < 16) rsA[F.tid] = 1.f;
    __syncthreads();
}
__device__ __forceinline__ void z_phase(Frame& F, const bf16_t* HB, const float* SS, const bf16_t* WZ, const float* wg, const float* bg, float* BC) {
    LAS float* zpart = (LAS float*)F.lds;
    LAS float* zs = (LAS float*)(F.lds + 8192);
    const int lane = F.lane, g = lane >> 4, r16 = lane & 15;
    for (int cidx = blockIdx.x; cidx < M / 64; cidx += F.G) {
        const int row0 = cidx * 64;
        { const int tile = F.wave & 3, kh = F.wave >> 2; f32x4 acc = (f32x4){0.f, 0.f, 0.f, 0.f};
          const bf16_t* ap = HB + (size_t)(row0 + tile * 16 + r16) * D + 8 * g; const bf16_t* bp = WZ + (size_t)r16 * D + 8 * g;
#pragma unroll 4
          for (int ks = kh * 16; ks < kh * 16 + 16; ++ks) {
              const bf16x8 a = *(const bf16x8*)(ap + ks * 32), b = *(const bf16x8*)(bp + ks * 32);
              acc = __builtin_amdgcn_mfma_f32_16x16x32_bf16(a, b, acc, 0, 0, 0);
          }
#pragma unroll
          for (int j = 0; j < 4; ++j) zpart[(kh * 64 + tile * 16 + 4 * g + j) * 16 + r16] = acc[j]; }
        __syncthreads();
        for (int i = F.tid; i < 64 * 16; i += NTHREADS) { const int t = i >> 4; zs[i] = (zpart[i] + zpart[1024 + i]) * row_rstd(SS, row0 + t); }
        __syncthreads();
        { const int c = F.tid; float w[16];
#pragma unroll
          for (int r = 0; r < 16; ++r) w[r] = wg[r * 512 + c];
          const float bias = bg[c]; float cum = 0.f;
          for (int t = 0; t < 64; ++t) { float a = bias; if (t == 32) cum = 0.f;
#pragma unroll
              for (int r = 0; r < 16; ++r) a += zs[t * 16 + r] * w[r];
              const float ls = fminf(a, 0.f) - __logf(1.0f + __expf(-fabsf(a)));
              cum += ls * 0.0625f; BC[(size_t)(row0 + t) * 512 + c] = cum; } }
        __syncthreads();
    }
}

typedef short v4i16_t __attribute__((ext_vector_type(4)));
__device__ __forceinline__ s16x4 ds_tr_asm(unsigned addr) { s16x4 r; asm volatile("ds_read_b64_tr_b16 %0, %1" : "=v"(r) : "v"(addr) : "memory"); return r; }
__device__ __forceinline__ s16x4 ds_tr(const LAS unsigned char* p) { return __builtin_bit_cast(s16x4, __builtin_amdgcn_ds_read_tr16_b64_v4i16((LAS v4i16_t*)p)); }
template <int DK, int DV, bool GLA>
__device__ __forceinline__ void s2_phase(Frame& F, const bf16_t* QH, const bf16_t* KH, const bf16_t* VT, bf16_t* O, float* OSS, const float* BC, int ldraw) {
    constexpr int NS = DV / 16, ROWB = DK * 2, TILEB = 64 * ROWB, NI = TILEB / 1024 / 8, NT = DK / 128, LDO = 4 * DV;
    constexpr int LQ = 0, LK = 2 * TILEB, LV = 4 * TILEB, LP = LV + 4096, LS = LP + 8192, LDEC = LS + 2 * 16 * ROWB;
    static_assert(LDEC + 2 * DK * 4 <= LDS_MISC, "S2 LDS map");
    const int unit = blockIdx.x; if (unit >= 8 * NS) return;
    const int bh = unit & 7, s = unit >> 3, b = bh >> 2, h = bh & 3;
    const int lane = F.lane, g = lane >> 4, r16 = lane & 15, w = F.wave;
    LAS unsigned char* L = F.lds; const unsigned Lb = (unsigned)(uintptr_t)L;
    const float* RAW = WSP(float, WS_META + META_RAW);
    for (int i = F.tid * 16; i < TILEB; i += NTHREADS * 16) { *(LAS u32x4*)(L + LQ + i) = (u32x4){0, 0, 0, 0}; *(LAS u32x4*)(L + LK + i) = (u32x4){0, 0, 0, 0}; }
    for (int i = F.tid * 16; i < 2048; i += NTHREADS * 16) *(LAS u32x4*)(L + LV + i) = (u32x4){0, 0, 0, 0};
    for (int i = F.tid * 16; i < 16 * ROWB; i += NTHREADS * 16) *(LAS u32x4*)(L + LS + i) = (u32x4){0, 0, 0, 0};
    __syncthreads();
    if (!GLA) {
        for (int idx = F.tid; idx < 16 * 128; idx += NTHREADS) { const int j = idx >> 7, c = idx & 127, row = 48 + j;
            const float* rq = RAW + (size_t)j * ldraw + h * 256; const float* rk = rq + 1024;
            const float rev = ((float)j * ROPE_INV[c]) * 0.15915494309189535f; const float frc = rev - floorf(rev);
            const float sn = __builtin_amdgcn_sinf(frc), cs = __builtin_amdgcn_cosf(frc);
            const float dq = __builtin_amdgcn_exp2f((float)(row + 1) * L2G[h]), dk = 0.0625f * __builtin_amdgcn_exp2f(-(float)(row + 1) * L2G[h]);
            const float q1 = rq[c], q2 = rq[c + 128], k1 = rk[c], k2 = rk[c + 128];
            const int a1 = row * ROWB + ((((c >> 3)) ^ (row & 15)) << 4) + (c & 7) * 2, a2 = row * ROWB + ((((c + 128) >> 3) ^ (row & 15)) << 4) + (c & 7) * 2;
            *(LAS bf16_t*)(L + LQ + a1) = f2bf((q1 * cs - q2 * sn) * dq); *(LAS bf16_t*)(L + LQ + a2) = f2bf((q1 * sn + q2 * cs) * dq);
            *(LAS bf16_t*)(L + LK + a1) = f2bf((k1 * cs - k2 * sn) * dk); *(LAS bf16_t*)(L + LK + a2) = f2bf((k1 * sn + k2 * cs) * dk); }
        if (F.tid < 256) { const int j = F.tid >> 4, wv = F.tid & 15, tok = 48 + j;
            *(LAS bf16_t*)(L + LV + wv * 128 + (((tok >> 3) ^ ((wv >> 1) & 7)) << 4) + (tok & 7) * 2) = f2bf(RAW[(size_t)j * ldraw + 2048 + h * 512 + 16 * s + wv]); }
    } else {
        if (F.tid < 128) { const int d = F.tid; const float* wgp = F.in[13] + h * 128 + d; const float bias = F.in[14][h * 128 + d]; float cum = 0.f;
            for (int j = 0; j < 16; ++j) { float a = bias;
                for (int r = 0; r < 16; ++r) a += RAW[(size_t)j * ldraw + 3072 + r] * wgp[r * 512];
                cum += (fminf(a, 0.f) - __logf(1.0f + __expf(-fabsf(a)))) * 0.0625f;
                const int row = 48 + j;
                *(LAS bf16_t*)(L + LK + row * ROWB + (((d >> 3) ^ (row & 15)) << 4) + (d & 7) * 2) = f2bf(RAW[(size_t)j * ldraw + 512 + h * 128 + d] * __expf(-cum)); }
            *(LAS float*)(L + LDEC + d * 4) = __expf(cum); }
        if (F.tid >= 256) { const int j = (F.tid - 256) >> 4, wv = F.tid & 15, tok = 48 + j;
            *(LAS bf16_t*)(L + LV + wv * 128 + (((tok >> 3) ^ ((wv >> 1) & 7)) << 4) + (tok & 7) * 2) = f2bf(RAW[(size_t)j * ldraw + 1024 + h * 256 + 16 * s + wv]); }
    }
    f32x4 S[NT];
#pragma unroll
    for (int tt = 0; tt < NT; ++tt) S[tt] = (f32x4){0.f, 0.f, 0.f, 0.f};
    const float g64 = GLA ? 1.0f : __builtin_amdgcn_exp2f(64.0f * L2G[h]);
    const char* Qg = (const char*)(QH + (size_t)bh * SEQ * DK); const char* Kg = (const char*)(KH + (size_t)bh * SEQ * DK);
    const char* Vg = (const char*)(VT + ((size_t)bh * DV + 16 * s) * SEQ);
    __syncthreads();
    for (int c = 0; c <= 128; ++c) {
        const int buf = c & 1;
        if (c < 128) {
            const char* qc = Qg + (size_t)c * TILEB; const char* kc = Kg + (size_t)c * TILEB;
#pragma unroll
            for (int i = 0; i < NI; ++i) { const int piece = w * NI + i, off = piece * 1024 + lane * 16, row = off / ROWB, p = (off % ROWB) >> 4; const int so = row * ROWB + ((p ^ (row & 15)) << 4);
                __builtin_amdgcn_global_load_lds((const unsigned*)(qc + so), (LAS unsigned*)(L + LQ + (buf ^ 1) * TILEB + piece * 1024), 16, 0, 0);
                __builtin_amdgcn_global_load_lds((const unsigned*)(kc + so), (LAS unsigned*)(L + LK + (buf ^ 1) * TILEB + piece * 1024), 16, 0, 0); }
            if (w < 2) { const int off = w * 1024 + lane * 16, wv = off >> 7, p = (off & 127) >> 4;
                __builtin_amdgcn_global_load_lds((const unsigned*)(Vg + (size_t)wv * SEQ * 2 + (size_t)c * 128 + ((p ^ ((wv >> 1) & 7)) << 4)), (LAS unsigned*)(L + LV + (buf ^ 1) * 2048 + w * 1024), 16, 0, 0); }
        }
        { const int ti = w >> 1, tj0 = 2 * (w & 1); f32x4 pt0 = (f32x4){0.f, 0.f, 0.f, 0.f}, pt1 = pt0;
          const int qrow = 16 * ti + r16, kr0 = 16 * tj0 + r16, kr1 = kr0 + 16;
          const LAS unsigned char* qb = L + LQ + buf * TILEB + qrow * ROWB; const LAS unsigned char* kb0 = L + LK + buf * TILEB + kr0 * ROWB; const LAS unsigned char* kb1 = L + LK + buf * TILEB + kr1 * ROWB;
#pragma unroll
          for (int ks = 0; ks < DK / 32; ++ks) { const int ch = ((4 * ks + g) ^ r16) << 4;
              const bf16x8 qf = *(const LAS bf16x8*)(qb + ch), k0 = *(const LAS bf16x8*)(kb0 + ch), k1 = *(const LAS bf16x8*)(kb1 + ch);
              pt0 = __builtin_amdgcn_mfma_f32_16x16x32_bf16(k0, qf, pt0, 0, 0, 0); pt1 = __builtin_amdgcn_mfma_f32_16x16x32_bf16(k1, qf, pt1, 0, 0, 0); }
          const int i = qrow;
#pragma unroll
          for (int tjj = 0; tjj < 2; ++tjj) { const f32x4 pt = tjj ? pt1 : pt0; const int tj = tj0 + tjj, j0 = 16 * tj + 4 * g;
              const float v0 = (j0 + 0 <= i) ? pt[0] : 0.f, v1 = (j0 + 1 <= i) ? pt[1] : 0.f, v2 = (j0 + 2 <= i) ? pt[2] : 0.f, v3 = (j0 + 3 <= i) ? pt[3] : 0.f;
              u32x2 pk; pk.x = cvt_pk_bf16(v0, v1); pk.y = cvt_pk_bf16(v2, v3);
              *(LAS u32x2*)(L + LP + i * 128 + (((2 * tj + (g >> 1)) ^ ((i >> 1) & 7)) << 4) + (g & 1) * 8) = pk; } }
        LDS_WAIT(); __builtin_amdgcn_s_barrier(); asm volatile("" ::: "memory");
        if (w < 4) { const int irow = 16 * w + r16; f32x4 ot = (f32x4){0.f, 0.f, 0.f, 0.f};
#pragma unroll
            for (int ks = 0; ks < 2; ++ks) {
                const bf16x8 va = *(const LAS bf16x8*)(L + LV + buf * 2048 + r16 * 128 + (((4 * ks + g) ^ ((r16 >> 1) & 7)) << 4));
                const bf16x8 pb = *(const LAS bf16x8*)(L + LP + irow * 128 + (((4 * ks + g) ^ ((irow >> 1) & 7)) << 4));
                ot = __builtin_amdgcn_mfma_f32_16x16x32_bf16(va, pb, ot, 0, 0, 0); }
#pragma unroll
            for (int ks = 0; ks < DK / 32; ++ks) { const int ch = ((4 * ks + g) ^ r16) << 4;
                const bf16x8 sa = *(const LAS bf16x8*)(L + LS + buf * 16 * ROWB + r16 * ROWB + ch);
                const bf16x8 qb = *(const LAS bf16x8*)(L + LQ + buf * TILEB + irow * ROWB + ch);
                ot = __builtin_amdgcn_mfma_f32_16x16x32_bf16(sa, qb, ot, 0, 0, 0); }
            float ss = (ot[0] * ot[0] + ot[1] * ot[1]) + (ot[2] * ot[2] + ot[3] * ot[3]);
            ss += __shfl_xor(ss, 16); ss += __shfl_xor(ss, 32);
            if (c >= 1) { const size_t grow = (size_t)b * SEQ + (c - 1) * 64 + irow;
                u32x2 pk; pk.x = cvt_pk_bf16(ot[0], ot[1]); pk.y = cvt_pk_bf16(ot[2], ot[3]);
                *(u32x2*)(O + grow * LDO + h * DV + 16 * s + 4 * g) = pk;
                if (g == 0) atomicAdd(OSS + grow * 4 + h, ss);
            } else if (!GLA && b == 0 && irow >= 48) { float* MO = WSP(float, WS_META + META_MO); float* MOSS = WSP(float, WS_CTL + CTL_MOSS);
                *(f32x4*)(MO + (size_t)(irow - 48) * 2048 + h * 512 + 16 * s + 4 * g) = ot;
                if (g == 0) atomicAdd(MOSS + (irow - 48) * 4 + h, ss); } }
        {
#pragma unroll
          for (int ks = 0; ks < 2; ++ks) {
              const bf16x8 vb = *(const LAS bf16x8*)(L + LV + buf * 2048 + r16 * 128 + (((4 * ks + g) ^ ((r16 >> 1) & 7)) << 4));
#pragma unroll
              for (int tt = 0; tt < NT; ++tt) { const int d0 = 16 * (w + 8 * tt), dcol = d0 + 4 * (r16 & 3), chunk = dcol >> 3, sub = (dcol & 7) * 2;
                  const int r1 = 32 * ks + 8 * g + (r16 >> 2), r2 = r1 + 4;
                  const s16x4 lo = ds_tr(L + LK + buf * TILEB + r1 * ROWB + ((chunk ^ (r1 & 15)) << 4) + sub);
                  const s16x4 hi = ds_tr(L + LK + buf * TILEB + r2 * ROWB + ((chunk ^ (r2 & 15)) << 4) + sub);
                  const bf16x8 ka = (bf16x8){lo[0], lo[1], lo[2], lo[3], hi[0], hi[1], hi[2], hi[3]};
                  S[tt] = __builtin_amdgcn_mfma_f32_16x16x32_bf16(ka, vb, S[tt], 0, 0, 0); } }
#pragma unroll
          for (int tt = 0; tt < NT; ++tt) { const int tile = w + 8 * tt;
              if (GLA) { const f32x4 dc = *(const LAS f32x4*)(L + LDEC + buf * DK * 4 + (16 * tile + 4 * g) * 4); S[tt] = S[tt] * dc; } else S[tt] = S[tt] * g64;
              u32x2 pk; pk.x = cvt_pk_bf16(S[tt][0], S[tt][1]); pk.y = cvt_pk_bf16(S[tt][2], S[tt][3]);
              *(LAS u32x2*)(L + LS + (buf ^ 1) * 16 * ROWB + r16 * ROWB + (((2 * tile + (g >> 1)) ^ r16) << 4) + (g & 1) * 8) = pk; } }
        if (GLA && c < 128 && F.tid < DK) *(LAS float*)(L + LDEC + (buf ^ 1) * DK * 4 + F.tid * 4) = __expf(BC[(size_t)(b * SEQ + c * 64 + 63) * 512 + h * 128 + F.tid]);
        __syncthreads();
    }
}

__device__ __forceinline__ bf16x8 gload16(const void* p) { bf16x8 r; asm volatile("global_load_dwordx4 %0, %1, off" : "=v"(r) : "v"(p) : "memory"); return r; }
__device__ __forceinline__ void glds_touch(const void* gsrc, unsigned lds_dst) { unsigned keep; asm volatile("s_mov_b32 %0, m0\n\ts_mov_b32 m0, %2\n\ts_nop 0\n\tglobal_load_lds_dword %1, off\n\ts_mov_b32 m0, %0" : "=&s"(keep) : "v"(gsrc), "s"(lds_dst) : "memory"); }
#define S2_WAITV(n) asm volatile("s_waitcnt vmcnt(" #n ")" ::: "memory")
template <int DK, int DV, bool GLA>
__device__ __forceinline__ void s2v2_phase(Frame& F, const bf16_t* QH, const bf16_t* KH, const bf16_t* VT, bf16_t* O, float* OSS, const float* BC, int ldraw) {
    constexpr int NS = DV / 16, ROWB = DK * 2, TILEB = 64 * ROWB, NI = TILEB / 1024 / 8, NT = DK / 128, LDO = 4 * DV, KS = DK / 32;
    constexpr int LK = 0, LV = 3 * TILEB, LDEC = LV + 3 * 2048, LP = LDEC + 3 * 1024, LS = LP + 8192, LOT = LS + 2 * 16 * ROWB, LQM = LOT + 4096, LEND = LQM + 16 * ROWB;
    static_assert(LEND <= LDS_MISC, "S2 LDS map");
    const int unit = blockIdx.x; if (unit >= 8 * NS) return;
    const int bh = unit & 7, s = unit >> 3, b = bh >> 2, h = bh & 3;
    const int lane = F.lane, g = lane >> 4, r16 = lane & 15, w = F.wave, ti = w >> 1, hf = w & 1;
    LAS unsigned char* L = F.lds; const unsigned Lb = (unsigned)(uintptr_t)L;
    const float* RAW = WSP(float, WS_META + META_RAW);
    const char* Qg = (const char*)(QH + (size_t)bh * SEQ * DK); const char* Kg = (const char*)(KH + (size_t)bh * SEQ * DK);
    const char* Vg = (const char*)(VT + ((size_t)bh * DV + 16 * s) * SEQ);
    const char* qlane = Qg + (size_t)(16 * ti + r16) * ROWB + g * 16;
    bf16x8 q0[KS], q1[KS], q2[KS];
#define S2_ISSUE(c_, QSET) do { const int rc_ = (c_) - 1, st_ = (c_) % 3; const char* kc_ = Kg + (size_t)rc_ * TILEB; \
        _Pragma("unroll") for (int i_ = 0; i_ < NI; ++i_) { const int piece_ = w * NI + i_, off_ = piece_ * 1024 + lane * 16, row_ = off_ / ROWB, p_ = (off_ % ROWB) >> 4; \
            __builtin_amdgcn_global_load_lds((const unsigned*)(kc_ + row_ * ROWB + ((p_ ^ (row_ & 15)) << 4)), (LAS unsigned*)(L + LK + st_ * TILEB + piece_ * 1024), 16, 0, 0); } \
        if (w < 2) { const int off_ = w * 1024 + lane * 16, wv_ = off_ >> 7, p_ = (off_ & 127) >> 4; \
            __builtin_amdgcn_global_load_lds((const unsigned*)(Vg + (size_t)wv_ * SEQ * 2 + (size_t)rc_ * 128 + ((p_ ^ ((wv_ >> 1) & 7)) << 4)), (LAS unsigned*)(L + LV + st_ * 2048 + w * 1024), 16, 0, 0); } \
        if (GLA && w == 2) __builtin_amdgcn_global_load_lds((const unsigned*)((const char*)(BC + (size_t)(b * SEQ + rc_ * 64 + 63) * 512 + h * 128) + lane * 16), (LAS unsigned*)(L + LDEC + st_ * 1024), 16, 0, 0); \
        _Pragma("unroll") for (int k_ = 0; k_ < KS; ++k_) QSET[k_] = gload16(qlane + (size_t)rc_ * TILEB + k_ * 64); } while (0)
#define S2_WAIT_PREV() do { if (w < 2 || (GLA && w == 2)) { if (NI + KS + 1 == 13) S2_WAITV(13); else S2_WAITV(7); } else { if (NI + KS == 12) S2_WAITV(12); else S2_WAITV(6); } } while (0)
    static_assert((NI + KS == 12) || (NI + KS == 6), "S2 wait immediates");
    for (int i = F.tid * 16; i < TILEB; i += NTHREADS * 16) *(LAS u32x4*)(L + LK + i) = (u32x4){0, 0, 0, 0};
    for (int i = F.tid * 16; i < 2048; i += NTHREADS * 16) *(LAS u32x4*)(L + LV + i) = (u32x4){0, 0, 0, 0};
    for (int i = F.tid * 16; i < 16 * ROWB; i += NTHREADS * 16) { *(LAS u32x4*)(L + LS + i) = (u32x4){0, 0, 0, 0}; *(LAS u32x4*)(L + LQM + i) = (u32x4){0, 0, 0, 0}; }
    __syncthreads();
    if (!GLA) {
        for (int idx = F.tid; idx < 16 * 128; idx += NTHREADS) { const int j = idx >> 7, c = idx & 127, row = 48 + j;
            const float* rq = RAW + (size_t)j * ldraw + h * 256; const float* rk = rq + 1024;
            const float rev = ((float)j * ROPE_INV[c]) * 0.15915494309189535f; const float frc = rev - floorf(rev);
            const float sn = __builtin_amdgcn_sinf(frc), cs = __builtin_amdgcn_cosf(frc);
            const float dq = __builtin_amdgcn_exp2f((float)(row + 1) * L2G[h]), dk = 0.0625f * __builtin_amdgcn_exp2f(-(float)(row + 1) * L2G[h]);
            const float q1v = rq[c], q2v = rq[c + 128], k1 = rk[c], k2 = rk[c + 128];
            const int a1 = row * ROWB + ((((c >> 3)) ^ (row & 15)) << 4) + (c & 7) * 2, a2 = row * ROWB + ((((c + 128) >> 3) ^ (row & 15)) << 4) + (c & 7) * 2;
            *(LAS bf16_t*)(L + LQM + j * ROWB + c * 2) = f2bf((q1v * cs - q2v * sn) * dq); *(LAS bf16_t*)(L + LQM + j * ROWB + (c + 128) * 2) = f2bf((q1v * sn + q2v * cs) * dq);
            *(LAS bf16_t*)(L + LK + a1) = f2bf((k1 * cs - k2 * sn) * dk); *(LAS bf16_t*)(L + LK + a2) = f2bf((k1 * sn + k2 * cs) * dk); }
        if (F.tid < 256) { const int j = F.tid >> 4, wv = F.tid & 15, tok = 48 + j;
            *(LAS bf16_t*)(L + LV + wv * 128 + (((tok >> 3) ^ ((wv >> 1) & 7)) << 4) + (tok & 7) * 2) = f2bf(RAW[(size_t)j * ldraw + 2048 + h * 512 + 16 * s + wv]); }
    } else {
        if (F.tid < 128) { const int d = F.tid; const float* wgp = F.in[13] + h * 128 + d; const float bias = F.in[14][h * 128 + d]; float cum = 0.f;
            for (int j = 0; j < 16; ++j) { float a = bias;
                for (int r = 0; r < 16; ++r) a += RAW[(size_t)j * ldraw + 3072 + r] * wgp[r * 512];
                cum += (fminf(a, 0.f) - __logf(1.0f + __expf(-fabsf(a)))) * 0.0625f;
                const int row = 48 + j;
                *(LAS bf16_t*)(L + LK + row * ROWB + (((d >> 3) ^ (row & 15)) << 4) + (d & 7) * 2) = f2bf(RAW[(size_t)j * ldraw + 512 + h * 128 + d] * __expf(-cum)); }
            *(LAS float*)(L + LDEC + d * 4) = cum; }
        if (F.tid >= 256) { const int j = (F.tid - 256) >> 4, wv = F.tid & 15, tok = 48 + j;
            *(LAS bf16_t*)(L + LV + wv * 128 + (((tok >> 3) ^ ((wv >> 1) & 7)) << 4) + (tok & 7) * 2) = f2bf(RAW[(size_t)j * ldraw + 1024 + h * 256 + 16 * s + wv]); }
    }
    f32x4 S[NT];
#pragma unroll
    for (int tt = 0; tt < NT; ++tt) S[tt] = (f32x4){0.f, 0.f, 0.f, 0.f};
    const float g64 = GLA ? 1.0f : __builtin_amdgcn_exp2f(64.0f * L2G[h]);
    __syncthreads();
#pragma unroll
    for (int k = 0; k < KS; ++k) { q0[k] = *(const LAS bf16x8*)(L + LQM + (ti == 3 ? r16 : 0) * ROWB + (4 * k + g) * 16); if (ti != 3) q0[k] = (bf16x8){0, 0, 0, 0, 0, 0, 0, 0}; q1[k] = q0[k]; q2[k] = q0[k]; }
    LDS_WAIT();
    S2_ISSUE(1, q1);
    f32x4 ot_prev = (f32x4){0.f, 0.f, 0.f, 0.f}; float ss_prev = 0.f;
#define S2_STEP(c_, QC, QN2) do { const int c = (c_), st = c % 3, sb = c & 1; \
          \
        if (hf == 0 && c >= 1) { const f32x4 part = *(const LAS f32x4*)(L + LOT + ti * 1024 + lane * 16); const f32x4 ot = ot_prev + part; const int irow = 16 * ti + r16; \
            if (c >= 2) { const size_t grow = (size_t)b * SEQ + (c - 2) * 64 + irow; u32x2 pk; pk.x = cvt_pk_bf16(ot[0], ot[1]); pk.y = cvt_pk_bf16(ot[2], ot[3]); \
                *(u32x2*)(O + grow * LDO + h * DV + 16 * s + 4 * g) = pk; } \
            else if (!GLA && b == 0 && irow >= 48) { float* MO = WSP(float, WS_META + META_MO); \
                *(f32x4*)(MO + (size_t)(irow - 48) * 2048 + h * 512 + 16 * s + 4 * g) = ot; } } \
        if (c + 2 <= 128) S2_ISSUE(c + 2, QN2); \
          \
        { const int tj0 = 2 * hf; f32x4 pt0 = (f32x4){0.f, 0.f, 0.f, 0.f}, pt1 = pt0; \
          const LAS unsigned char* kb0 = L + LK + st * TILEB + (16 * tj0 + r16) * ROWB; const LAS unsigned char* kb1 = kb0 + 16 * ROWB; \
          _Pragma("unroll") for (int ks = 0; ks < KS; ++ks) { const int ch = ((4 * ks + g) ^ r16) << 4; \
              const bf16x8 k0 = *(const LAS bf16x8*)(kb0 + ch), k1 = *(const LAS bf16x8*)(kb1 + ch); \
              pt0 = __builtin_amdgcn_mfma_f32_16x16x32_bf16(k0, QC[ks], pt0, 0, 0, 0); pt1 = __builtin_amdgcn_mfma_f32_16x16x32_bf16(k1, QC[ks], pt1, 0, 0, 0); } \
          const int i = 16 * ti + r16; \
          _Pragma("unroll") for (int tjj = 0; tjj < 2; ++tjj) { const f32x4 pt = tjj ? pt1 : pt0; const int tj = tj0 + tjj, j0 = 16 * tj + 4 * g; \
              const float v0 = (j0 + 0 <= i) ? pt[0] : 0.f, v1 = (j0 + 1 <= i) ? pt[1] : 0.f, v2 = (j0 + 2 <= i) ? pt[2] : 0.f, v3 = (j0 + 3 <= i) ? pt[3] : 0.f; \
              u32x2 pk; pk.x = cvt_pk_bf16(v0, v1); pk.y = cvt_pk_bf16(v2, v3); \
              *(LAS u32x2*)(L + LP + i * 128 + (((2 * tj + (g >> 1)) ^ ((i >> 1) & 7)) << 4) + (g & 1) * 8) = pk; } } \
        LDS_WAIT(); __builtin_amdgcn_s_barrier(); asm volatile("" ::: "memory"); \
          \
        { const int irow = 16 * ti + r16; f32x4 ot = (f32x4){0.f, 0.f, 0.f, 0.f}; \
          if (hf == 0) { _Pragma("unroll") for (int ks = 0; ks < 2; ++ks) { \
                const bf16x8 va = *(const LAS bf16x8*)(L + LV + st * 2048 + r16 * 128 + (((4 * ks + g) ^ ((r16 >> 1) & 7)) << 4)); \
                const bf16x8 pb = *(const LAS bf16x8*)(L + LP + irow * 128 + (((4 * ks + g) ^ ((irow >> 1) & 7)) << 4)); \
                ot = __builtin_amdgcn_mfma_f32_16x16x32_bf16(va, pb, ot, 0, 0, 0); } } \
          if (hf == 0) { _Pragma("unroll") for (int kk = 0; kk < KS / 2; ++kk) { \
              const bf16x8 sa = *(const LAS bf16x8*)(L + LS + sb * 16 * ROWB + r16 * ROWB + (((4 * kk + g) ^ r16) << 4)); \
              ot = __builtin_amdgcn_mfma_f32_16x16x32_bf16(sa, QC[kk], ot, 0, 0, 0); } } \
          else { _Pragma("unroll") for (int kk = KS / 2; kk < KS; ++kk) { \
              const bf16x8 sa = *(const LAS bf16x8*)(L + LS + sb * 16 * ROWB + r16 * ROWB + (((4 * kk + g) ^ r16) << 4)); \
              ot = __builtin_amdgcn_mfma_f32_16x16x32_bf16(sa, QC[kk], ot, 0, 0, 0); } } \
          if (hf == 1) *(LAS f32x4*)(L + LOT + ti * 1024 + lane * 16) = ot; else ot_prev = ot; } \
          \
        { s16x4 klo[2][NT], khi[2][NT]; bf16x8 vbb[2]; \
          _Pragma("unroll") for (int ks = 0; ks < 2; ++ks) { \
              vbb[ks] = *(const LAS bf16x8*)(L + LV + st * 2048 + r16 * 128 + (((4 * ks + g) ^ ((r16 >> 1) & 7)) << 4)); \
              _Pragma("unroll") for (int tt = 0; tt < NT; ++tt) { const int d0 = 16 * (w + 8 * tt), dcol = d0 + 4 * (r16 & 3), chunk = dcol >> 3, sub = (dcol & 7) * 2; \
                  const int r1 = 32 * ks + 8 * g + (r16 >> 2), r2 = r1 + 4; \
                  klo[ks][tt] = ds_tr_asm(Lb + LK + st * TILEB + r1 * ROWB + ((chunk ^ (r1 & 15)) << 4) + sub); \
                  khi[ks][tt] = ds_tr_asm(Lb + LK + st * TILEB + r2 * ROWB + ((chunk ^ (r2 & 15)) << 4) + sub); } } \
          asm volatile("s_waitcnt lgkmcnt(0)" ::: "memory"); __builtin_amdgcn_sched_barrier(0); \
          _Pragma("unroll") for (int ks = 0; ks < 2; ++ks) _Pragma("unroll") for (int tt = 0; tt < NT; ++tt) { \
                  const s16x4 lo = klo[ks][tt], hi = khi[ks][tt]; \
                  const bf16x8 ka = (bf16x8){lo[0], lo[1], lo[2], lo[3], hi[0], hi[1], hi[2], hi[3]}; \
                  S[tt] = __builtin_amdgcn_mfma_f32_16x16x32_bf16(ka, vbb[ks], S[tt], 0, 0, 0); } \
          _Pragma("unroll") for (int tt = 0; tt < NT; ++tt) { const int tile = w + 8 * tt; \
              if (GLA) { const f32x4 dl = *(const LAS f32x4*)(L + LDEC + st * 1024 + (16 * tile + 4 * g) * 4); \
                  S[tt][0] *= __expf(dl[0]); S[tt][1] *= __expf(dl[1]); S[tt][2] *= __expf(dl[2]); S[tt][3] *= __expf(dl[3]); } else S[tt] = S[tt] * g64; \
              u32x2 pk; pk.x = cvt_pk_bf16(S[tt][0], S[tt][1]); pk.y = cvt_pk_bf16(S[tt][2], S[tt][3]); \
              *(LAS u32x2*)(L + LS + (sb ^ 1) * 16 * ROWB + r16 * ROWB + (((2 * tile + (g >> 1)) ^ r16) << 4) + (g & 1) * 8) = pk; } } \
          \
        if (c + 2 <= 128) S2_WAIT_PREV(); else S2_WAITV(0); \
        LDS_WAIT(); __builtin_amdgcn_s_barrier(); asm volatile("" ::: "memory"); __builtin_amdgcn_sched_barrier(0); \
    } while (0)
#define S2_PIN(Q) do { _Pragma("unroll") for (int k_ = 0; k_ < KS; ++k_) asm volatile("" : "+v"(Q[k_])); } while (0)
    for (int c3 = 0; c3 < 129; c3 += 3) {
        S2_STEP(c3, q0, q2);     S2_PIN(q1);
        S2_STEP(c3 + 1, q1, q0); S2_PIN(q2);
        S2_STEP(c3 + 2, q2, q1); S2_PIN(q0);
    }
    if (hf == 0) { const f32x4 part = *(const LAS f32x4*)(L + LOT + ti * 1024 + lane * 16); const f32x4 ot = ot_prev + part; const int irow = 16 * ti + r16;
        const size_t grow = (size_t)b * SEQ + 127 * 64 + irow; u32x2 pk; pk.x = cvt_pk_bf16(ot[0], ot[1]); pk.y = cvt_pk_bf16(ot[2], ot[3]);
        *(u32x2*)(O + grow * LDO + h * DV + 16 * s + 4 * g) = pk; }
#undef S2_ISSUE
#undef S2_WAIT_PREV
#undef S2_STEP
#undef S2_PIN
}

template <int DK, int DV, bool GLA>
__device__ __forceinline__ void s2v3_phase(Frame& F, const bf16_t* QH, const bf16_t* KH, const bf16_t* VT, bf16_t* O, const float* BC, int ldraw) {
    constexpr int NS = DV / 16, ROWB = DK * 2, TILEB = 64 * ROWB, NIL = TILEB / 1024 / 4, NTU = DK / 64, LDO = 4 * DV, KS = DK / 32;
    constexpr int LK = 0, LV = 3 * TILEB, LDEC = LV + 3 * 2048, LP = LDEC + 3 * 1024, LS = LP + 8192, LOT = LS + 2 * 16 * ROWB, LQM = LOT + 4096, LEND = LQM + 16 * ROWB;
    static_assert(LEND <= LDS_MISC, "S2 LDS map");
    static_assert((NIL + KS == 16) || (NIL + KS == 8), "S2 wait immediates");
    const int unit = blockIdx.x; if (unit >= 8 * NS) return;
    const int bh = unit & 7, s = unit >> 3, b = bh >> 2, h = bh & 3;
    const int lane = F.lane, g = lane >> 4, r16 = lane & 15, w = F.wave, ti = w >> 1, hf = w & 1;
    LAS unsigned char* L = F.lds; const unsigned Lb = (unsigned)(uintptr_t)L;
    const float* RAW = WSP(float, WS_META + META_RAW);
    const char* Qg = (const char*)(QH + (size_t)bh * SEQ * DK); const char* Kg = (const char*)(KH + (size_t)bh * SEQ * DK);
    const char* Vg = (const char*)(VT + ((size_t)bh * DV + 16 * s) * SEQ);
    const char* qlane = Qg + (size_t)(16 * ti + r16) * ROWB + g * 16;
    bf16x8 q0[KS], q1[KS], q2[KS];
#define S3_ISSUE(c_, ST_, QSET) do { unsigned lzi_ = 0; asm volatile("" : "+v"(lzi_)); const int rc_ = (c_) - 1; constexpr int st_ = (ST_); const char* kc_ = Kg + (size_t)rc_ * TILEB + lzi_; \
        _Pragma("unroll") for (int i_ = 0; i_ < NIL; ++i_) { const int piece_ = ti * NIL + i_, off_ = piece_ * 1024 + lane * 16, row_ = off_ / ROWB, p_ = (off_ % ROWB) >> 4; \
            __builtin_amdgcn_global_load_lds((const unsigned*)(kc_ + row_ * ROWB + ((p_ ^ (row_ & 15)) << 4)), (LAS unsigned*)(L + LK + st_ * TILEB + piece_ * 1024), 16, 0, 0); } \
        if (ti < 2) { const int off_ = ti * 1024 + lane * 16, wv_ = off_ >> 7, p_ = (off_ & 127) >> 4; \
            __builtin_amdgcn_global_load_lds((const unsigned*)(Vg + (size_t)wv_ * SEQ * 2 + (size_t)rc_ * 128 + ((p_ ^ ((wv_ >> 1) & 7)) << 4)), (LAS unsigned*)(L + LV + st_ * 2048 + ti * 1024), 16, 0, 0); } \
        if (GLA && ti == 2) __builtin_amdgcn_global_load_lds((const unsigned*)((const char*)(BC + (size_t)(b * SEQ + rc_ * 64 + 63) * 512 + h * 128) + lane * 16), (LAS unsigned*)(L + LDEC + st_ * 1024), 16, 0, 0); \
        _Pragma("unroll") for (int k_ = 0; k_ < KS; ++k_) QSET[k_] = gload16(qlane + (size_t)rc_ * TILEB + k_ * 64); } while (0)
#define S3_WAIT_PREV() do { if (ti < 2 || (GLA && ti == 2)) { if (NIL + KS == 16) S2_WAITV(17); else S2_WAITV(9); } else { if (NIL + KS == 16) S2_WAITV(16); else S2_WAITV(8); } } while (0)
    for (int i = F.tid * 16; i < TILEB; i += NTHREADS * 16) *(LAS u32x4*)(L + LK + i) = (u32x4){0, 0, 0, 0};
    for (int i = F.tid * 16; i < 2048; i += NTHREADS * 16) *(LAS u32x4*)(L + LV + i) = (u32x4){0, 0, 0, 0};
    for (int i = F.tid * 16; i < 16 * ROWB; i += NTHREADS * 16) { *(LAS u32x4*)(L + LS + i) = (u32x4){0, 0, 0, 0}; *(LAS u32x4*)(L + LQM + i) = (u32x4){0, 0, 0, 0}; }
    __syncthreads();
    if (!GLA) {
        for (int idx = F.tid; idx < 16 * 128; idx += NTHREADS) { const int j = idx >> 7, c = idx & 127, row = 48 + j;
            const float* rq = RAW + (size_t)j * ldraw + h * 256; const float* rk = rq + 1024;
            const float rev = ((float)j * ROPE_INV[c]) * 0.15915494309189535f; const float frc = rev - floorf(rev);
            const float sn = __builtin_amdgcn_sinf(frc), cs = __builtin_amdgcn_cosf(frc);
            const float dq = __builtin_amdgcn_exp2f((float)(row + 1) * L2G[h]), dk = 0.0625f * __builtin_amdgcn_exp2f(-(float)(row + 1) * L2G[h]);
            const float q1v = rq[c], q2v = rq[c + 128], k1 = rk[c], k2 = rk[c + 128];
            const int a1 = row * ROWB + ((((c >> 3)) ^ (row & 15)) << 4) + (c & 7) * 2, a2 = row * ROWB + ((((c + 128) >> 3) ^ (row & 15)) << 4) + (c & 7) * 2;
            *(LAS bf16_t*)(L + LQM + j * ROWB + c * 2) = f2bf((q1v * cs - q2v * sn) * dq); *(LAS bf16_t*)(L + LQM + j * ROWB + (c + 128) * 2) = f2bf((q1v * sn + q2v * cs) * dq);
            *(LAS bf16_t*)(L + LK + a1) = f2bf((k1 * cs - k2 * sn) * dk); *(LAS bf16_t*)(L + LK + a2) = f2bf((k1 * sn + k2 * cs) * dk); }
        if (F.tid < 256) { const int j = F.tid >> 4, wv = F.tid & 15, tok = 48 + j;
            *(LAS bf16_t*)(L + LV + wv * 128 + (((tok >> 3) ^ ((wv >> 1) & 7)) << 4) + (tok & 7) * 2) = f2bf(RAW[(size_t)j * ldraw + 2048 + h * 512 + 16 * s + wv]); }
    } else {
        if (F.tid < 128) { const int d = F.tid; const float* wgp = F.in[13] + h * 128 + d; const float bias = F.in[14][h * 128 + d]; float cum = 0.f;
            for (int j = 0; j < 16; ++j) { float a = bias;
                for (int r = 0; r < 16; ++r) a += RAW[(size_t)j * ldraw + 3072 + r] * wgp[r * 512];
                cum += (fminf(a, 0.f) - __logf(1.0f + __expf(-fabsf(a)))) * 0.0625f;
                const int row = 48 + j;
                *(LAS bf16_t*)(L + LK + row * ROWB + (((d >> 3) ^ (row & 15)) << 4) + (d & 7) * 2) = f2bf(RAW[(size_t)j * ldraw + 512 + h * 128 + d] * __expf(-cum)); }
            *(LAS float*)(L + LDEC + d * 4) = cum; }
        if (F.tid >= 256) { const int j = (F.tid - 256) >> 4, wv = F.tid & 15, tok = 48 + j;
            *(LAS bf16_t*)(L + LV + wv * 128 + (((tok >> 3) ^ ((wv >> 1) & 7)) << 4) + (tok & 7) * 2) = f2bf(RAW[(size_t)j * ldraw + 1024 + h * 256 + 16 * s + wv]); }
    }
    f32x4 S[NTU];
#pragma unroll
    for (int tt = 0; tt < NTU; ++tt) S[tt] = (f32x4){0.f, 0.f, 0.f, 0.f};
    const float g64 = GLA ? 1.0f : __builtin_amdgcn_exp2f(64.0f * L2G[h]);
    __syncthreads();
#pragma unroll
    for (int k = 0; k < KS; ++k) { q0[k] = *(const LAS bf16x8*)(L + LQM + (ti == 3 ? r16 : 0) * ROWB + (4 * k + g) * 16); if (ti != 3) q0[k] = (bf16x8){0, 0, 0, 0, 0, 0, 0, 0}; asm volatile("" : "=v"(q1[k])); asm volatile("" : "=v"(q2[k])); }
    LDS_WAIT();
    if (hf) S3_ISSUE(1, 1, q1);
    f32x4 ot_prev = (f32x4){0.f, 0.f, 0.f, 0.f};
#define S3_STEP(c_, ST, QC, QN2) do { const int c = (c_), sb = c & 1; constexpr int st = (ST); \
        unsigned lz_ = 0; asm volatile("" : "+v"(lz_)); LAS unsigned char* const Lz = L + lz_; const unsigned Lbz = Lb + lz_;   \
        if (hf == 0) { \
              \
            if (c >= 1) { const f32x4 part = *(const LAS f32x4*)(Lz + LOT + ti * 1024 + lane * 16); const f32x4 ot = ot_prev + part; const int irow = 16 * ti + r16; \
                if (c >= 2) { const size_t grow = (size_t)b * SEQ + (c - 2) * 64 + irow; u32x2 pk; pk.x = cvt_pk_bf16(ot[0], ot[1]); pk.y = cvt_pk_bf16(ot[2], ot[3]); \
                    *(u32x2*)(O + grow * LDO + h * DV + 16 * s + 4 * g) = pk; } \
                else if (!GLA && b == 0 && irow >= 48) { float* MO = WSP(float, WS_META + META_MO); *(f32x4*)(MO + (size_t)(irow - 48) * 2048 + h * 512 + 16 * s + 4 * g) = ot; } } \
              \
            { bf16x8 vbb[2]; \
              _Pragma("unroll") for (int ks = 0; ks < 2; ++ks) vbb[ks] = *(const LAS bf16x8*)(Lz + LV + st * 2048 + r16 * 128 + (((4 * ks + g) ^ ((r16 >> 1) & 7)) << 4)); \
              _Pragma("unroll") for (int tt = 0; tt < NTU; ++tt) { const int tile = ti + 4 * tt, d0 = 16 * tile, dcol = d0 + 4 * (r16 & 3), chunk = dcol >> 3, sub = (dcol & 7) * 2; \
                  s16x4 klo[2], khi[2]; \
                  _Pragma("unroll") for (int ks = 0; ks < 2; ++ks) { const int r1 = 32 * ks + 8 * g + (r16 >> 2), r2 = r1 + 4; \
                      klo[ks] = ds_tr_asm(Lbz + LK + st * TILEB + r1 * ROWB + ((chunk ^ (r1 & 15)) << 4) + sub); \
                      khi[ks] = ds_tr_asm(Lbz + LK + st * TILEB + r2 * ROWB + ((chunk ^ (r2 & 15)) << 4) + sub); } \
                  asm volatile("s_waitcnt lgkmcnt(0)" ::: "memory"); __builtin_amdgcn_sched_barrier(0); \
                  _Pragma("unroll") for (int ks = 0; ks < 2; ++ks) { const s16x4 lo = klo[ks], hi = khi[ks]; \
                      const bf16x8 ka = (bf16x8){lo[0], lo[1], lo[2], lo[3], hi[0], hi[1], hi[2], hi[3]}; \
                      S[tt] = __builtin_amdgcn_mfma_f32_16x16x32_bf16(ka, vbb[ks], S[tt], 0, 0, 0); } \
                  if (GLA) { const f32x4 dl = *(const LAS f32x4*)(Lz + LDEC + st * 1024 + (16 * tile + 4 * g) * 4); \
                      S[tt][0] *= __expf(dl[0]); S[tt][1] *= __expf(dl[1]); S[tt][2] *= __expf(dl[2]); S[tt][3] *= __expf(dl[3]); } else S[tt] = S[tt] * g64; \
                  u32x2 pk; pk.x = cvt_pk_bf16(S[tt][0], S[tt][1]); pk.y = cvt_pk_bf16(S[tt][2], S[tt][3]); \
                  *(LAS u32x2*)(Lz + LS + (sb ^ 1) * 16 * ROWB + r16 * ROWB + (((2 * tile + (g >> 1)) ^ r16) << 4) + (g & 1) * 8) = pk; } } \
        } else { \
            if (c + 2 <= 128) S3_ISSUE(c + 2, (ST + 2) % 3, QN2); \
              \
            { const LAS unsigned char* kb = Lz + LK + st * TILEB + r16 * ROWB; const int i = 16 * ti + r16; \
              _Pragma("unroll") for (int th = 0; th < 2; ++th) { f32x4 pa = (f32x4){0.f, 0.f, 0.f, 0.f}, pb = pa; \
                  if (2 * th <= ti) { \
                      _Pragma("unroll") for (int ks = 0; ks < KS; ++ks) { const int ch = ((4 * ks + g) ^ r16) << 4; \
                          const bf16x8 ka = *(const LAS bf16x8*)(kb + (2 * th) * 16 * ROWB + ch), kc2 = *(const LAS bf16x8*)(kb + (2 * th + 1) * 16 * ROWB + ch); \
                          pa = __builtin_amdgcn_mfma_f32_16x16x32_bf16(ka, QC[ks], pa, 0, 0, 0); pb = __builtin_amdgcn_mfma_f32_16x16x32_bf16(kc2, QC[ks], pb, 0, 0, 0); \
                          if (ks & 1) __builtin_amdgcn_sched_barrier(0); } } \
                  _Pragma("unroll") for (int tq = 0; tq < 2; ++tq) { const int tj = 2 * th + tq, j0 = 16 * tj + 4 * g; const f32x4 pt = tq ? pb : pa; \
                      const float v0 = (j0 + 0 <= i) ? pt[0] : 0.f, v1 = (j0 + 1 <= i) ? pt[1] : 0.f, v2 = (j0 + 2 <= i) ? pt[2] : 0.f, v3 = (j0 + 3 <= i) ? pt[3] : 0.f; \
                      u32x2 pk; pk.x = cvt_pk_bf16(v0, v1); pk.y = cvt_pk_bf16(v2, v3); \
                      *(LAS u32x2*)(Lz + LP + i * 128 + (((2 * tj + (g >> 1)) ^ ((i >> 1) & 7)) << 4) + (g & 1) * 8) = pk; } } } \
        } \
        LDS_WAIT(); __builtin_amdgcn_s_barrier(); asm volatile("" ::: "memory"); \
        if (hf == 0) {   \
            const int irow = 16 * ti + r16; f32x4 ot = (f32x4){0.f, 0.f, 0.f, 0.f}; \
            _Pragma("unroll") for (int ks = 0; ks < 2; ++ks) { \
                const bf16x8 va = *(const LAS bf16x8*)(Lz + LV + st * 2048 + r16 * 128 + (((4 * ks + g) ^ ((r16 >> 1) & 7)) << 4)); \
                const bf16x8 pb = *(const LAS bf16x8*)(Lz + LP + irow * 128 + (((4 * ks + g) ^ ((irow >> 1) & 7)) << 4)); \
                ot = __builtin_amdgcn_mfma_f32_16x16x32_bf16(va, pb, ot, 0, 0, 0); } \
            ot_prev = ot; \
        } else {   \
            f32x4 oa = (f32x4){0.f, 0.f, 0.f, 0.f}, ob = oa; \
            _Pragma("unroll") for (int ks = 0; ks < KS; ks += 2) { \
                const bf16x8 sa = *(const LAS bf16x8*)(Lz + LS + sb * 16 * ROWB + r16 * ROWB + (((4 * ks + g) ^ r16) << 4)); \
                const bf16x8 sc = *(const LAS bf16x8*)(Lz + LS + sb * 16 * ROWB + r16 * ROWB + (((4 * (ks + 1) + g) ^ r16) << 4)); \
                oa = __builtin_amdgcn_mfma_f32_16x16x32_bf16(sa, QC[ks], oa, 0, 0, 0); ob = __builtin_amdgcn_mfma_f32_16x16x32_bf16(sc, QC[ks + 1], ob, 0, 0, 0); __builtin_amdgcn_sched_barrier(0); } \
            *(LAS f32x4*)(Lz + LOT + ti * 1024 + lane * 16) = oa + ob; \
            if (c + 2 <= 128) S3_WAIT_PREV(); else S2_WAITV(0); \
        } \
        LDS_WAIT(); __builtin_amdgcn_s_barrier(); asm volatile("" ::: "memory"); __builtin_amdgcn_sched_barrier(0); \
    } while (0)
#define S3_PIN(Q) do { _Pragma("unroll") for (int k_ = 0; k_ < KS; ++k_) asm volatile("" : "+v"(Q[k_])); } while (0)
    for (int c3 = 0; c3 < 129; c3 += 3) {
        S3_STEP(c3, 0, q0, q2);     S3_PIN(q1);
        S3_STEP(c3 + 1, 1, q1, q0); S3_PIN(q2);
        S3_STEP(c3 + 2, 2, q2, q1); S3_PIN(q0);
    }
    if (hf == 0) { const f32x4 part = *(const LAS f32x4*)(L + LOT + ti * 1024 + lane * 16); const f32x4 ot = ot_prev + part; const int irow = 16 * ti + r16;
        const size_t grow = (size_t)b * SEQ + 127 * 64 + irow; u32x2 pk; pk.x = cvt_pk_bf16(ot[0], ot[1]); pk.y = cvt_pk_bf16(ot[2], ot[3]);
        *(u32x2*)(O + grow * LDO + h * DV + 16 * s + 4 * g) = pk; }
#undef S3_ISSUE
#undef S3_WAIT_PREV
#undef S3_STEP
#undef S3_PIN
}

template <int DK, int DV, bool GLA>
__device__ __forceinline__ void s2v4_phase(Frame& F, const int unit, const bf16_t* QH, const bf16_t* KH, const bf16_t* VT, bf16_t* O, const float* BC, int ldraw) {
    constexpr int NS = DV / 16, ROWB = DK * 2, TILEB = 32 * ROWB, NIL = TILEB / 1024 / 4, NTU = DK / 64, LDO = 4 * DV, KS = DK / 32, NSTEP = 257;
    constexpr int LK = 0, LQ = 3 * TILEB, LV = 6 * TILEB, LDEC = LV + 3 * 1024, LP = LDEC + 3 * 1024, LS = LP + 2048, LOT = LS + 2 * 16 * ROWB, LEND = LOT + 4096;
    static_assert(LEND + 256 <= LDS_MISC, "S2 LDS map");
    static_assert(NIL == 4 || NIL == 2, "S2 wait immediates");
    if (unit >= 8 * NS) return;
    const int bh = unit & 7, s = unit >> 3, b = bh >> 2, h = bh & 3;
    const int lane = F.lane, g = lane >> 4, r16 = lane & 15, w = F.wave, li = w >> 1, hf = w & 1, qi = li >> 1, kj = li & 1;
    LAS unsigned char* L = F.lds; const unsigned Lb = (unsigned)(uintptr_t)L;
    const float* RAW = WSP(float, WS_META + META_RAW);
    const char* Qg = (const char*)(QH + (size_t)bh * SEQ * DK); const char* Kg = (const char*)(KH + (size_t)bh * SEQ * DK);
    const char* Vg = (const char*)(VT + ((size_t)bh * DV + 16 * s) * SEQ);
#define S4_ISSUE(c_, st_) do { const int rc_ = (c_) - 1; const char* kc_ = Kg + (size_t)rc_ * TILEB; const char* qc_ = Qg + (size_t)rc_ * TILEB; \
        _Pragma("unroll") for (int i_ = 0; i_ < NIL; ++i_) { const int piece_ = li * NIL + i_, off_ = piece_ * 1024 + lane * 16, row_ = off_ / ROWB, p_ = (off_ % ROWB) >> 4; const int so_ = row_ * ROWB + ((p_ ^ (row_ & 15)) << 4); \
            __builtin_amdgcn_global_load_lds((const unsigned*)(kc_ + so_), (LAS unsigned*)(L + LK + (st_) * TILEB + piece_ * 1024), 16, 0, 0); \
            __builtin_amdgcn_global_load_lds((const unsigned*)(qc_ + so_), (LAS unsigned*)(L + LQ + (st_) * TILEB + piece_ * 1024), 16, 0, 0); } \
        if (li == 0) { const int wv_ = lane >> 2, p_ = lane & 3; \
            __builtin_amdgcn_global_load_lds((const unsigned*)(Vg + (size_t)wv_ * SEQ * 2 + (size_t)rc_ * 64 + ((p_ ^ ((wv_ >> 2) & 3)) << 4)), (LAS unsigned*)(L + LV + (st_) * 1024), 16, 0, 0); } \
        if (GLA && li == 1) __builtin_amdgcn_global_load_lds((const unsigned*)((const char*)(BC + (size_t)(b * SEQ + rc_ * 32 + 31) * 512 + h * 128) + lane * 16), (LAS unsigned*)(L + LDEC + (st_) * 1024), 16, 0, 0); } while (0)
#define S4_WAIT_PREV() do { if (li == 0 || (GLA && li == 1)) { if (NIL == 4) S2_WAITV(9); else S2_WAITV(5); } else { if (NIL == 4) S2_WAITV(8); else S2_WAITV(4); } } while (0)
    for (int i = F.tid * 16; i < TILEB; i += NTHREADS * 16) { *(LAS u32x4*)(L + LK + i) = (u32x4){0, 0, 0, 0}; *(LAS u32x4*)(L + LQ + i) = (u32x4){0, 0, 0, 0}; }
    for (int i = F.tid * 16; i < 1024; i += NTHREADS * 16) *(LAS u32x4*)(L + LV + i) = (u32x4){0, 0, 0, 0};
    for (int i = F.tid * 16; i < 16 * ROWB; i += NTHREADS * 16) *(LAS u32x4*)(L + LS + i) = (u32x4){0, 0, 0, 0};
    __syncthreads();
    if (!GLA) {
        for (int idx = F.tid; idx < 16 * 128; idx += NTHREADS) { const int j = idx >> 7, c = idx & 127, row = 16 + j;
            const float* rq = RAW + (size_t)j * ldraw + h * 256; const float* rk = rq + 1024;
            const float rev = ((float)j * ROPE_INV[c]) * 0.15915494309189535f; const float frc = rev - floorf(rev);
            const float sn = __builtin_amdgcn_sinf(frc), cs = __builtin_amdgcn_cosf(frc);
            const float dq = __builtin_amdgcn_exp2f((float)(row + 1) * L2G[h]), dk = 0.0625f * __builtin_amdgcn_exp2f(-(float)(row + 1) * L2G[h]);
            const float q1v = rq[c], q2v = rq[c + 128], k1 = rk[c], k2 = rk[c + 128];
            const int a1 = row * ROWB + ((((c >> 3)) ^ (row & 15)) << 4) + (c & 7) * 2, a2 = row * ROWB + ((((c + 128) >> 3) ^ (row & 15)) << 4) + (c & 7) * 2;
            *(LAS bf16_t*)(L + LQ + a1) = f2bf((q1v * cs - q2v * sn) * dq); *(LAS bf16_t*)(L + LQ + a2) = f2bf((q1v * sn + q2v * cs) * dq);
            *(LAS bf16_t*)(L + LK + a1) = f2bf((k1 * cs - k2 * sn) * dk); *(LAS bf16_t*)(L + LK + a2) = f2bf((k1 * sn + k2 * cs) * dk); }
        if (F.tid < 256) { const int j = F.tid >> 4, wv = F.tid & 15, tok = 16 + j;
            *(LAS bf16_t*)(L + LV + wv * 64 + (((tok >> 3) ^ ((wv >> 2) & 3)) << 4) + (tok & 7) * 2) = f2bf(RAW[(size_t)j * ldraw + 2048 + h * 512 + 16 * s + wv]); }
    } else {
        if (F.tid < 128) { const int d = F.tid; const float* wgp = F.in[13] + h * 128 + d; const float bias = F.in[14][h * 128 + d]; float cum = 0.f;
            for (int j = 0; j < 16; ++j) { float a = bias;
                for (int r = 0; r < 16; ++r) a += RAW[(size_t)j * ldraw + 3072 + r] * wgp[r * 512];
                cum += (fminf(a, 0.f) - __logf(1.0f + __expf(-fabsf(a)))) * 0.0625f;
                const int row = 16 + j;
                *(LAS bf16_t*)(L + LK + row * ROWB + (((d >> 3) ^ (row & 15)) << 4) + (d & 7) * 2) = f2bf(RAW[(size_t)j * ldraw + 512 + h * 128 + d] * __expf(-cum)); }
            *(LAS float*)(L + LDEC + d * 4) = cum; }
        if (F.tid >= 256) { const int j = (F.tid - 256) >> 4, wv = F.tid & 15, tok = 16 + j;
            *(LAS bf16_t*)(L + LV + wv * 64 + (((tok >> 3) ^ ((wv >> 2) & 3)) << 4) + (tok & 7) * 2) = f2bf(RAW[(size_t)j * ldraw + 1024 + h * 256 + 16 * s + wv]); }
    }
    f32x4 S[NTU];
#pragma unroll
    for (int tt = 0; tt < NTU; ++tt) S[tt] = (f32x4){0.f, 0.f, 0.f, 0.f};
    const float g32 = GLA ? 1.0f : __builtin_amdgcn_exp2f(32.0f * L2G[h]);
    __syncthreads();
    if (hf) S4_ISSUE(1, 1);
    f32x4 ot_prev = (f32x4){0.f, 0.f, 0.f, 0.f};
    int st = 0;
#if defined(PROBE2)
    unsigned long long pacc = 0ull, pt0 = 0ull; const unsigned long long ptot0 = __builtin_amdgcn_s_memtime();
#define P2T(q, stmt) do { if (PROBE2 == (q) && !GLA) { stmt; } } while (0)
#else
#define P2T(q, stmt) do {} while (0)
#endif
    for (int c = 0; c < NSTEP; ++c) {
        P2T(2, if (hf == 1) pt0 = __builtin_amdgcn_s_memtime()); P2T(3, if (hf == 0) pt0 = __builtin_amdgcn_s_memtime());
        const int sb = c & 1, st2 = (st == 0) ? 2 : st - 1;
        unsigned lz_ = 0; asm volatile("" : "+v"(lz_)); LAS unsigned char* const Lz = L + lz_; const unsigned Lbz = Lb + lz_;
        if (hf == 0) {
            if (li == 3) { constexpr int PFD = 8, LPT = TILEB / 128, LPB = 2 * LPT / NS; const int rcp = c + PFD - 1;
                if (rcp < 256) { const char* pa_ = nullptr;
                    if (lane < LPB) { const int ln = s * LPB + lane; pa_ = (ln < LPT) ? Kg + (size_t)rcp * TILEB + ln * 128 : Qg + (size_t)rcp * TILEB + (ln - LPT) * 128; }
                    else if (lane >= 16 && lane < 32) pa_ = Vg + (size_t)(lane - 16) * SEQ * 2 + (size_t)rcp * 64;
                    else if (GLA && lane == 32 && s == 0) pa_ = (const char*)(BC + (size_t)(b * SEQ + rcp * 32 + 31) * 512 + h * 128);
                    if (pa_) glds_touch(pa_, (unsigned)__builtin_amdgcn_readfirstlane((int)(Lb + LEND))); } }
            if (li < 2 && c >= 1) { const f32x4 pa = *(const LAS f32x4*)(Lz + LOT + (li * 2) * 1024 + lane * 16), pb = *(const LAS f32x4*)(Lz + LOT + (li * 2 + 1) * 1024 + lane * 16);
                const f32x4 ot = ot_prev + (pa + pb); const int irow = 16 * li + r16;
                if (c >= 2) { const size_t grow = (size_t)b * SEQ + (size_t)(c - 2) * 32 + irow; u32x2 pk; pk.x = cvt_pk_bf16(ot[0], ot[1]); pk.y = cvt_pk_bf16(ot[2], ot[3]);
                    *(u32x2*)(O + grow * LDO + h * DV + 16 * s + 4 * g) = pk; }
                else if (!GLA && b == 0 && irow >= 16) { float* MO = WSP(float, WS_META + META_MO); *(f32x4*)(MO + (size_t)(irow - 16) * 2048 + h * 512 + 16 * s + 4 * g) = ot; } }
            { s16x4 klo[NTU], khi[NTU];
              const bf16x8 vb = *(const LAS bf16x8*)(Lz + LV + st * 1024 + r16 * 64 + ((g ^ ((r16 >> 2) & 3)) << 4));
#pragma unroll
              for (int tt = 0; tt < NTU; ++tt) { const int tile = li + 4 * tt, d0 = 16 * tile, dcol = d0 + 4 * (r16 & 3), chunk = dcol >> 3, sub = (dcol & 7) * 2;
                  const int r1 = 8 * g + (r16 >> 2), r2 = r1 + 4;
                  klo[tt] = ds_tr_asm(Lbz + LK + st * TILEB + r1 * ROWB + ((chunk ^ (r1 & 15)) << 4) + sub);
                  khi[tt] = ds_tr_asm(Lbz + LK + st * TILEB + r2 * ROWB + ((chunk ^ (r2 & 15)) << 4) + sub); }
              asm volatile("s_waitcnt lgkmcnt(0)" ::: "memory"); __builtin_amdgcn_sched_barrier(0);
#pragma unroll
              for (int tt = 0; tt < NTU; ++tt) {
                  const bf16x8 ka = (bf16x8){klo[tt][0], klo[tt][1], klo[tt][2], klo[tt][3], khi[tt][0], khi[tt][1], khi[tt][2], khi[tt][3]};
                  S[tt] = __builtin_amdgcn_mfma_f32_16x16x32_bf16(ka, vb, S[tt], 0, 0, 0); }
#pragma unroll
              for (int tt = 0; tt < NTU; ++tt) { const int tile = li + 4 * tt;
                  if (GLA) { const f32x4 dl = *(const LAS f32x4*)(Lz + LDEC + st * 1024 + (16 * tile + 4 * g) * 4);
                      S[tt][0] *= __expf(dl[0]); S[tt][1] *= __expf(dl[1]); S[tt][2] *= __expf(dl[2]); S[tt][3] *= __expf(dl[3]); } else S[tt] = S[tt] * g32;
                  u32x2 pk; pk.x = cvt_pk_bf16(S[tt][0], S[tt][1]); pk.y = cvt_pk_bf16(S[tt][2], S[tt][3]);
                  *(LAS u32x2*)(Lz + LS + (sb ^ 1) * 16 * ROWB + r16 * ROWB + (((2 * tile + (g >> 1)) ^ r16) << 4) + (g & 1) * 8) = pk; } }
        } else {
            if (c + 2 < NSTEP) S4_ISSUE(c + 2, st2);
            { f32x4 pa = (f32x4){0.f, 0.f, 0.f, 0.f}, pb = pa;
              if (kj <= qi) { const LAS unsigned char* kb = Lz + LK + st * TILEB + (16 * kj + r16) * ROWB; const LAS unsigned char* qb = Lz + LQ + st * TILEB + (16 * qi + r16) * ROWB;
#pragma unroll
                  for (int ks = 0; ks < KS; ks += 2) { const int ch0 = ((4 * ks + g) ^ r16) << 4, ch1 = ((4 * (ks + 1) + g) ^ r16) << 4;
                      const bf16x8 k0 = *(const LAS bf16x8*)(kb + ch0), q0 = *(const LAS bf16x8*)(qb + ch0), k1 = *(const LAS bf16x8*)(kb + ch1), q1 = *(const LAS bf16x8*)(qb + ch1);
                      pa = __builtin_amdgcn_mfma_f32_16x16x32_bf16(k0, q0, pa, 0, 0, 0); pb = __builtin_amdgcn_mfma_f32_16x16x32_bf16(k1, q1, pb, 0, 0, 0); } }
              const f32x4 pt = pa + pb; const int i = 16 * qi + r16, j0 = 16 * kj + 4 * g;
              const float v0 = (j0 + 0 <= i) ? pt[0] : 0.f, v1 = (j0 + 1 <= i) ? pt[1] : 0.f, v2 = (j0 + 2 <= i) ? pt[2] : 0.f, v3 = (j0 + 3 <= i) ? pt[3] : 0.f;
              u32x2 pk; pk.x = cvt_pk_bf16(v0, v1); pk.y = cvt_pk_bf16(v2, v3);
              *(LAS u32x2*)(Lz + LP + i * 64 + (((2 * kj + (g >> 1)) ^ ((i >> 2) & 3)) << 4) + (g & 1) * 8) = pk; }
        }
        LDS_WAIT();
        P2T(2, if (hf == 1) pacc += __builtin_amdgcn_s_memtime() - pt0); P2T(3, if (hf == 0) pacc += __builtin_amdgcn_s_memtime() - pt0);
        P2T(5, pt0 = __builtin_amdgcn_s_memtime());
        __builtin_amdgcn_s_barrier(); asm volatile("" ::: "memory"); __builtin_amdgcn_sched_barrier(0);
        P2T(5, pacc += __builtin_amdgcn_s_memtime() - pt0);
        P2T(4, if (hf == 1) pt0 = __builtin_amdgcn_s_memtime());
        if (hf == 0) {
            if (li < 2) { const int irow = 16 * li + r16;
                const bf16x8 va = *(const LAS bf16x8*)(Lz + LV + st * 1024 + r16 * 64 + ((g ^ ((r16 >> 2) & 3)) << 4));
                const bf16x8 pb = *(const LAS bf16x8*)(Lz + LP + irow * 64 + ((g ^ ((irow >> 2) & 3)) << 4));
                ot_prev = __builtin_amdgcn_mfma_f32_16x16x32_bf16(va, pb, (f32x4){0.f, 0.f, 0.f, 0.f}, 0, 0, 0); }
        } else {
            f32x4 oa = (f32x4){0.f, 0.f, 0.f, 0.f}, ob = oa;
            const LAS unsigned char* sp = Lz + LS + sb * 16 * ROWB + r16 * ROWB; const LAS unsigned char* qb = Lz + LQ + st * TILEB + (16 * qi + r16) * ROWB;
#pragma unroll
            for (int kk = 0; kk < KS / 2; kk += 2) { const int ks = kj * (KS / 2) + kk; const int ch0 = ((4 * ks + g) ^ r16) << 4, ch1 = ((4 * (ks + 1) + g) ^ r16) << 4;
                const bf16x8 s0 = *(const LAS bf16x8*)(sp + ch0), q0 = *(const LAS bf16x8*)(qb + ch0), s1 = *(const LAS bf16x8*)(sp + ch1), q1 = *(const LAS bf16x8*)(qb + ch1);
                oa = __builtin_amdgcn_mfma_f32_16x16x32_bf16(s0, q0, oa, 0, 0, 0); ob = __builtin_amdgcn_mfma_f32_16x16x32_bf16(s1, q1, ob, 0, 0, 0); }
            *(LAS f32x4*)(Lz + LOT + (qi * 2 + kj) * 1024 + lane * 16) = oa + ob;
            P2T(4, pacc += __builtin_amdgcn_s_memtime() - pt0); P2T(1, pt0 = __builtin_amdgcn_s_memtime());
            if (c + 2 < NSTEP) S4_WAIT_PREV(); else S2_WAITV(0);
            P2T(1, pacc += __builtin_amdgcn_s_memtime() - pt0);
        }
        LDS_WAIT(); __builtin_amdgcn_s_barrier(); asm volatile("" ::: "memory"); __builtin_amdgcn_sched_barrier(0);
        st = (st == 2) ? 0 : st + 1;
    }
#if defined(PROBE2)
    if (!GLA && unit == 0) { if (PROBE2 == 0) pacc = __builtin_amdgcn_s_memtime() - ptot0; const int pw = (PROBE2 == 3 || PROBE2 == 5 || PROBE2 == 0) ? 0 : 1; if (w == pw && lane == 0) { volatile LAS unsigned* MI = (volatile LAS unsigned*)(F.lds + LDS_MISC); MI[20] = (unsigned)pacc; MI[21] = (unsigned)(pacc >> 32); } }
#endif
    if (hf == 0 && li < 2) { const f32x4 pa = *(const LAS f32x4*)(L + LOT + (li * 2) * 1024 + lane * 16), pb = *(const LAS f32x4*)(L + LOT + (li * 2 + 1) * 1024 + lane * 16);
        const f32x4 ot = ot_prev + (pa + pb); const int irow = 16 * li + r16;
        const size_t grow = (size_t)b * SEQ + (size_t)(NSTEP - 2) * 32 + irow; u32x2 pk; pk.x = cvt_pk_bf16(ot[0], ot[1]); pk.y = cvt_pk_bf16(ot[2], ot[3]);
        *(u32x2*)(O + grow * LDO + h * DV + 16 * s + 4 * g) = pk; }
#undef S4_ISSUE
#undef S4_WAIT_PREV
}

template <int DK, int DV, bool GLA>
__device__ __forceinline__ void s2v5_phase(Frame& F, const int unit, const bf16_t* QH, const bf16_t* KH, const bf16_t* VT, bf16_t* O, const float* BC, int ldraw) {
    constexpr int NS = DV / 16, ROWB = DK * 2, TILEB = 32 * ROWB, NIL = TILEB / 1024 / 4, NTU = DK / 64, LDO = 4 * DV, KS = DK / 32, NSTEP = 257;
    constexpr int LK = 0, LQ = 2 * TILEB, LV = 4 * TILEB, LDEC = LV + 2 * 1024, LP = LDEC + 2 * 1024, LS = LP + 2048, LOT = LS + 2 * 16 * ROWB, LEND = LOT + 4096;
    static_assert(LEND <= LDS_MISC, "S2 LDS map");
    if (unit >= 8 * NS) return;
    const int bh = unit & 7, s = unit >> 3, b = bh >> 2, h = bh & 3;
    const int lane = F.lane, g = lane >> 4, r16 = lane & 15, w = F.wave, li = w & 3, hf = w >> 2, qi = li >> 1, kj = li & 1;
    LAS unsigned char* L = F.lds; const unsigned Lb = (unsigned)(uintptr_t)L;
    const float* RAW = WSP(float, WS_META + META_RAW);
    const char* Qg = (const char*)(QH + (size_t)bh * SEQ * DK); const char* Kg = (const char*)(KH + (size_t)bh * SEQ * DK);
    const char* Vg = (const char*)(VT + ((size_t)bh * DV + 16 * s) * SEQ);
    u32x4 ra[2 * NIL + 1], rb[2 * NIL + 1];
#pragma unroll
    for (int i = 0; i < 2 * NIL + 1; ++i) { ra[i] = (u32x4){0, 0, 0, 0}; rb[i] = ra[i]; }
#define S5_LOAD(c_, R) do { const int rc_ = ((c_) - 1 < 255) ? (c_) - 1 : 255;     const char* kc_ = Kg + (size_t)rc_ * TILEB; const char* qc_ = Qg + (size_t)rc_ * TILEB; \
        _Pragma("unroll") for (int i_ = 0; i_ < NIL; ++i_) { const int piece_ = li * NIL + i_, off_ = piece_ * 1024 + lane * 16, row_ = off_ / ROWB, p_ = (off_ % ROWB) >> 4; const int so_ = row_ * ROWB + ((p_ ^ (row_ & 15)) << 4); \
            R[i_] = *(const u32x4*)(kc_ + so_); R[NIL + i_] = *(const u32x4*)(qc_ + so_); } \
        if (li == 0) { const int wv_ = lane >> 2, p_ = lane & 3; R[2 * NIL] = *(const u32x4*)(Vg + (size_t)wv_ * SEQ * 2 + (size_t)rc_ * 64 + ((p_ ^ ((wv_ >> 2) & 3)) << 4)); } \
        if (GLA && li == 1) R[2 * NIL] = *(const u32x4*)((const char*)(BC + (size_t)(b * SEQ + rc_ * 32 + 31) * 512 + h * 128) + lane * 16); } while (0)
#define S5_WRITE(st_, R) do { \
        _Pragma("unroll") for (int i_ = 0; i_ < NIL; ++i_) { const int piece_ = li * NIL + i_; \
            *(LAS u32x4*)(L + LK + (st_) * TILEB + piece_ * 1024 + lane * 16) = R[i_]; *(LAS u32x4*)(L + LQ + (st_) * TILEB + piece_ * 1024 + lane * 16) = R[NIL + i_]; } \
        if (li == 0) *(LAS u32x4*)(L + LV + (st_) * 1024 + lane * 16) = R[2 * NIL]; \
        if (GLA && li == 1) *(LAS u32x4*)(L + LDEC + (st_) * 1024 + lane * 16) = R[2 * NIL]; } while (0)
    for (int i = F.tid * 16; i < TILEB; i += NTHREADS * 16) { *(LAS u32x4*)(L + LK + i) = (u32x4){0, 0, 0, 0}; *(LAS u32x4*)(L + LQ + i) = (u32x4){0, 0, 0, 0}; }
    for (int i = F.tid * 16; i < 1024; i += NTHREADS * 16) *(LAS u32x4*)(L + LV + i) = (u32x4){0, 0, 0, 0};
    for (int i = F.tid * 16; i < 16 * ROWB; i += NTHREADS * 16) *(LAS u32x4*)(L + LS + i) = (u32x4){0, 0, 0, 0};
    __syncthreads();
    if (!GLA) {
        for (int idx = F.tid; idx < 16 * 128; idx += NTHREADS) { const int j = idx >> 7, c = idx & 127, row = 16 + j;
            const float* rq = RAW + (size_t)j * ldraw + h * 256; const float* rk = rq + 1024;
            const float rev = ((float)j * ROPE_INV[c]) * 0.15915494309189535f; const float frc = rev - floorf(rev);
            const float sn = __builtin_amdgcn_sinf(frc), cs = __builtin_amdgcn_cosf(frc);
            const float dq = __builtin_amdgcn_exp2f((float)(row + 1) * L2G[h]), dk = 0.0625f * __builtin_amdgcn_exp2f(-(float)(row + 1) * L2G[h]);
            const float q1v = rq[c], q2v = rq[c + 128], k1 = rk[c], k2 = rk[c + 128];
            const int a1 = row * ROWB + ((((c >> 3)) ^ (row & 15)) << 4) + (c & 7) * 2, a2 = row * ROWB + ((((c + 128) >> 3) ^ (row & 15)) << 4) + (c & 7) * 2;
            *(LAS bf16_t*)(L + LQ + a1) = f2bf((q1v * cs - q2v * sn) * dq); *(LAS bf16_t*)(L + LQ + a2) = f2bf((q1v * sn + q2v * cs) * dq);
            *(LAS bf16_t*)(L + LK + a1) = f2bf((k1 * cs - k2 * sn) * dk); *(LAS bf16_t*)(L + LK + a2) = f2bf((k1 * sn + k2 * cs) * dk); }
        if (F.tid < 256) { const int j = F.tid >> 4, wv = F.tid & 15, tok = 16 + j;
            *(LAS bf16_t*)(L + LV + wv * 64 + (((tok >> 3) ^ ((wv >> 2) & 3)) << 4) + (tok & 7) * 2) = f2bf(RAW[(size_t)j * ldraw + 2048 + h * 512 + 16 * s + wv]); }
    } else {
        if (F.tid < 128) { const int d = F.tid; const float* wgp = F.in[13] + h * 128 + d; const float bias = F.in[14][h * 128 + d]; float cum = 0.f;
            for (int j = 0; j < 16; ++j) { float a = bias;
                for (int r = 0; r < 16; ++r) a += RAW[(size_t)j * ldraw + 3072 + r] * wgp[r * 512];
                cum += (fminf(a, 0.f) - __logf(1.0f + __expf(-fabsf(a)))) * 0.0625f;
                const int row = 16 + j;
                *(LAS bf16_t*)(L + LK + row * ROWB + (((d >> 3) ^ (row & 15)) << 4) + (d & 7) * 2) = f2bf(RAW[(size_t)j * ldraw + 512 + h * 128 + d] * __expf(-cum)); }
            *(LAS float*)(L + LDEC + d * 4) = cum; }
        if (F.tid >= 256) { const int j = (F.tid - 256) >> 4, wv = F.tid & 15, tok = 16 + j;
            *(LAS bf16_t*)(L + LV + wv * 64 + (((tok >> 3) ^ ((wv >> 2) & 3)) << 4) + (tok & 7) * 2) = f2bf(RAW[(size_t)j * ldraw + 1024 + h * 256 + 16 * s + wv]); }
    }
    f32x4 S[NTU];
#pragma unroll
    for (int tt = 0; tt < NTU; ++tt) S[tt] = (f32x4){0.f, 0.f, 0.f, 0.f};
    const float g32 = GLA ? 1.0f : __builtin_amdgcn_exp2f(32.0f * L2G[h]);
    __syncthreads();
    if (hf) S5_LOAD(1, rb);
    f32x4 ot_prev = (f32x4){0.f, 0.f, 0.f, 0.f};
#define S5_ODD(c_, ST, RL, RW) do { const int c = (c_); constexpr int st = (ST), sb = (ST); P3T(1, pt0 = __builtin_amdgcn_s_memtime()); \
        LAS unsigned char* const Lz = L; \
        S5_LOAD(c + 2, RL); P3T(1, pacc += __builtin_amdgcn_s_memtime() - pt0); P3T(2, pt0 = __builtin_amdgcn_s_memtime()); \
        { f32x4 pa = (f32x4){0.f, 0.f, 0.f, 0.f}, pb = pa; \
          if (kj <= qi) { const LAS unsigned char* kb = Lz + LK + st * TILEB + (16 * kj + r16) * ROWB; const LAS unsigned char* qb = Lz + LQ + st * TILEB + (16 * qi + r16) * ROWB; \
              _Pragma("unroll") for (int ks = 0; ks < KS; ks += 2) { const int ch0 = ((4 * ks + g) ^ r16) << 4, ch1 = ((4 * (ks + 1) + g) ^ r16) << 4; \
                  const bf16x8 k0 = *(const LAS bf16x8*)(kb + ch0), q0 = *(const LAS bf16x8*)(qb + ch0), k1 = *(const LAS bf16x8*)(kb + ch1), q1 = *(const LAS bf16x8*)(qb + ch1); \
                  pa = __builtin_amdgcn_mfma_f32_16x16x32_bf16(k0, q0, pa, 0, 0, 0); pb = __builtin_amdgcn_mfma_f32_16x16x32_bf16(k1, q1, pb, 0, 0, 0); } } \
          const f32x4 pt = pa + pb; const int i = 16 * qi + r16, j0 = 16 * kj + 4 * g; \
          const float v0 = (j0 + 0 <= i) ? pt[0] : 0.f, v1 = (j0 + 1 <= i) ? pt[1] : 0.f, v2 = (j0 + 2 <= i) ? pt[2] : 0.f, v3 = (j0 + 3 <= i) ? pt[3] : 0.f; \
          u32x2 pk; pk.x = cvt_pk_bf16(v0, v1); pk.y = cvt_pk_bf16(v2, v3); \
          *(LAS u32x2*)(Lz + LP + i * 64 + (((2 * kj + (g >> 1)) ^ ((i >> 2) & 3)) << 4) + (g & 1) * 8) = pk; } \
        LDS_WAIT(); P3T(2, pacc += __builtin_amdgcn_s_memtime() - pt0); P3T(3, pt0 = __builtin_amdgcn_s_memtime()); __builtin_amdgcn_s_barrier(); asm volatile("" ::: "memory"); P3T(3, pacc += __builtin_amdgcn_s_memtime() - pt0); P3T(4, pt0 = __builtin_amdgcn_s_memtime()); \
        { f32x4 oa = (f32x4){0.f, 0.f, 0.f, 0.f}, ob = oa; \
          const LAS unsigned char* sp = Lz + LS + sb * 16 * ROWB + r16 * ROWB; const LAS unsigned char* qb = Lz + LQ + st * TILEB + (16 * qi + r16) * ROWB; \
          _Pragma("unroll") for (int kk = 0; kk < KS / 2; kk += 2) { const int ks = kj * (KS / 2) + kk; const int ch0 = ((4 * ks + g) ^ r16) << 4, ch1 = ((4 * (ks + 1) + g) ^ r16) << 4; \
              const bf16x8 s0 = *(const LAS bf16x8*)(sp + ch0), q0 = *(const LAS bf16x8*)(qb + ch0), s1 = *(const LAS bf16x8*)(sp + ch1), q1 = *(const LAS bf16x8*)(qb + ch1); \
              oa = __builtin_amdgcn_mfma_f32_16x16x32_bf16(s0, q0, oa, 0, 0, 0); ob = __builtin_amdgcn_mfma_f32_16x16x32_bf16(s1, q1, ob, 0, 0, 0); } \
          *(LAS f32x4*)(Lz + LOT + (qi * 2 + kj) * 1024 + lane * 16) = oa + ob; } \
        P3T(4, pacc += __builtin_amdgcn_s_memtime() - pt0); P3T(5, pt0 = __builtin_amdgcn_s_memtime()); S5_WRITE(st ^ 1, RW); \
        LDS_WAIT(); P3T(5, pacc += __builtin_amdgcn_s_memtime() - pt0); P3T(6, pt0 = __builtin_amdgcn_s_memtime()); __builtin_amdgcn_s_barrier(); asm volatile("" ::: "memory"); P3T(6, pacc += __builtin_amdgcn_s_memtime() - pt0); \
    } while (0)
#define S5_EVEN(c_, ST) do { const int c = (c_); constexpr int st = (ST), sb = (ST); \
        LAS unsigned char* const Lz = L; const unsigned Lbz = Lb; \
        if (li < 2 && c >= 1) { const f32x4 pa = *(const LAS f32x4*)(Lz + LOT + (li * 2) * 1024 + lane * 16), pb = *(const LAS f32x4*)(Lz + LOT + (li * 2 + 1) * 1024 + lane * 16); \
            const f32x4 ot = ot_prev + (pa + pb); const int irow = 16 * li + r16; \
            if (c >= 2) { const size_t grow = (size_t)b * SEQ + (size_t)(c - 2) * 32 + irow; u32x2 pk; pk.x = cvt_pk_bf16(ot[0], ot[1]); pk.y = cvt_pk_bf16(ot[2], ot[3]); \
                *(u32x2*)(O + grow * LDO + h * DV + 16 * s + 4 * g) = pk; } \
            else if (!GLA && b == 0 && irow >= 16) { float* MO = WSP(float, WS_META + META_MO); *(f32x4*)(MO + (size_t)(irow - 16) * 2048 + h * 512 + 16 * s + 4 * g) = ot; } } \
        { s16x4 klo[NTU], khi[NTU]; \
          const bf16x8 vb = *(const LAS bf16x8*)(Lz + LV + st * 1024 + r16 * 64 + ((g ^ ((r16 >> 2) & 3)) << 4)); \
          _Pragma("unroll") for (int tt = 0; tt < NTU; ++tt) { const int tile = li + 4 * tt, d0 = 16 * tile, dcol = d0 + 4 * (r16 & 3), chunk = dcol >> 3, sub = (dcol & 7) * 2; \
              const int r1 = 8 * g + (r16 >> 2), r2 = r1 + 4; \
              klo[tt] = ds_tr_asm(Lbz + LK + st * TILEB + r1 * ROWB + ((chunk ^ (r1 & 15)) << 4) + sub); \
              khi[tt] = ds_tr_asm(Lbz + LK + st * TILEB + r2 * ROWB + ((chunk ^ (r2 & 15)) << 4) + sub); } \
          asm volatile("s_waitcnt lgkmcnt(0)" ::: "memory"); __builtin_amdgcn_sched_barrier(0); \
          _Pragma("unroll") for (int tt = 0; tt < NTU; ++tt) { \
              const bf16x8 ka = (bf16x8){klo[tt][0], klo[tt][1], klo[tt][2], klo[tt][3], khi[tt][0], khi[tt][1], khi[tt][2], khi[tt][3]}; \
              S[tt] = __builtin_amdgcn_mfma_f32_16x16x32_bf16(ka, vb, S[tt], 0, 0, 0); } \
          _Pragma("unroll") for (int tt = 0; tt < NTU; ++tt) { const int tile = li + 4 * tt; \
              if (GLA) { const f32x4 dl = *(const LAS f32x4*)(Lz + LDEC + st * 1024 + (16 * tile + 4 * g) * 4); \
                  S[tt][0] *= __expf(dl[0]); S[tt][1] *= __expf(dl[1]); S[tt][2] *= __expf(dl[2]); S[tt][3] *= __expf(dl[3]); } else S[tt] = S[tt] * g32; \
              u32x2 pk; pk.x = cvt_pk_bf16(S[tt][0], S[tt][1]); pk.y = cvt_pk_bf16(S[tt][2], S[tt][3]); \
              *(LAS u32x2*)(Lz + LS + (sb ^ 1) * 16 * ROWB + r16 * ROWB + (((2 * tile + (g >> 1)) ^ r16) << 4) + (g & 1) * 8) = pk; } } \
        LDS_WAIT(); __builtin_amdgcn_s_barrier(); asm volatile("" ::: "memory"); \
        if (li < 2) { const int irow = 16 * li + r16; \
            const bf16x8 va = *(const LAS bf16x8*)(Lz + LV + st * 1024 + r16 * 64 + ((g ^ ((r16 >> 2) & 3)) << 4)); \
            const bf16x8 pb = *(const LAS bf16x8*)(Lz + LP + irow * 64 + ((g ^ ((irow >> 2) & 3)) << 4)); \
            ot_prev = __builtin_amdgcn_mfma_f32_16x16x32_bf16(va, pb, (f32x4){0.f, 0.f, 0.f, 0.f}, 0, 0, 0); } \
        LDS_WAIT(); __builtin_amdgcn_s_barrier(); asm volatile("" ::: "memory"); \
    } while (0)
#if defined(PROBE3)
    unsigned long long pacc = 0ull, pt0 = 0ull;
#define P3T(q, stmt) do { if (PROBE3 == (q) && !GLA) { stmt; } } while (0)
#else
#define P3T(q, stmt) do {} while (0)
#endif
    if (hf) {
        for (int c2 = 0; c2 < 256; c2 += 2) { S5_ODD(c2, 0, ra, rb); S5_ODD(c2 + 1, 1, rb, ra); }
        S5_ODD(256, 0, ra, rb);
#if defined(PROBE3)
        if (!GLA && unit == 0 && w == 5 && lane == 0) { volatile LAS unsigned* MI = (volatile LAS unsigned*)(F.lds + LDS_MISC); MI[20] = (unsigned)pacc; MI[21] = (unsigned)(pacc >> 32); }
#endif
    } else {
        for (int c2 = 0; c2 < 256; c2 += 2) { S5_EVEN(c2, 0); S5_EVEN(c2 + 1, 1); }
        S5_EVEN(256, 0);
        if (li < 2) { const f32x4 pa = *(const LAS f32x4*)(L + LOT + (li * 2) * 1024 + lane * 16), pb = *(const LAS f32x4*)(L + LOT + (li * 2 + 1) * 1024 + lane * 16);
            const f32x4 ot = ot_prev + (pa + pb); const int irow = 16 * li + r16;
            const size_t grow = (size_t)b * SEQ + (size_t)(NSTEP - 2) * 32 + irow; u32x2 pk; pk.x = cvt_pk_bf16(ot[0], ot[1]); pk.y = cvt_pk_bf16(ot[2], ot[3]);
            *(u32x2*)(O + grow * LDO + h * DV + 16 * s + 4 * g) = pk; }
    }
#undef S5_ODD
#undef S5_EVEN
#undef S5_LOAD
#undef S5_WRITE
}

__device__ __forceinline__ void final_phase(Frame& F, const float* SS, const float* gain) {
    const int gw = F.vcu * NWAVES + F.wave, NGW = F.G * NWAVES; const bf16_t* HB = WSP(bf16_t, WS_HB);
    f32x4 gv[4];
#pragma unroll
    for (int j = 0; j < 4; ++j) gv[j] = *(const f32x4*)(gain + 4 * F.lane + 256 * j);
    for (int m = gw; m < M; m += NGW) { float* row = F.out + (size_t)m * D; const float rs = row_rstd(SS, m);
#pragma unroll
        for (int j = 0; j < 4; ++j) { const u32x2 hv = *(const u32x2*)(HB + (size_t)m * D + 4 * F.lane + 256 * j);
            f32x4 v = (f32x4){bf_lo(hv.x), bf_hi(hv.x), bf_lo(hv.y), bf_hi(hv.y)}; v = v * rs * gv[j]; *(f32x4*)(row + 4 * F.lane + 256 * j) = v; } }
}
__device__ __forceinline__ void p0_rows(Frame& F) {
    const int gw = F.vcu * NWAVES + F.wave, NGW = F.G * NWAVES; const float* x = F.in[0]; bf16_t* HB = WSP(bf16_t, WS_HB); float* SS = WSP(float, WS_SS);
    for (int m = gw; m < M; m += 2 * NGW) { const int m2 = m + NGW;
        f32x4 va[4], vb[4];
#pragma unroll
        for (int j = 0; j < 4; ++j) { va[j] = *(const f32x4*)(x + (size_t)m * D + 4 * F.lane + 256 * j); vb[j] = *(const f32x4*)(x + (size_t)m2 * D + 4 * F.lane + 256 * j); }
        float s = 0.f, s2 = 0.f;
#pragma unroll
        for (int j = 0; j < 4; ++j) { const f32x4 v = va[j], u = vb[j]; s += (v[0] * v[0] + v[1] * v[1]) + (v[2] * v[2] + v[3] * v[3]); s2 += (u[0] * u[0] + u[1] * u[1]) + (u[2] * u[2] + u[3] * u[3]);
            u32x2 pk; pk.x = cvt_pk_bf16(v[0], v[1]); pk.y = cvt_pk_bf16(v[2], v[3]); *(u32x2*)(HB + (size_t)m * D + 4 * F.lane + 256 * j) = pk;
            pk.x = cvt_pk_bf16(u[0], u[1]); pk.y = cvt_pk_bf16(u[2], u[3]); *(u32x2*)(HB + (size_t)m2 * D + 4 * F.lane + 256 * j) = pk; }
        s = wave_sum(s); s2 = wave_sum(s2);
        if (F.lane < 16) { SS[(size_t)m * 16 + F.lane] = F.lane == 0 ? s : 0.f; SS[(size_t)m2 * 16 + F.lane] = F.lane == 0 ? s2 : 0.f; } }
    if (blockIdx.x == 0) { float* HM = WSP(float, WS_META + META_HM); for (int i = F.tid; i < 16 * D; i += NTHREADS) HM[i] = F.in[1][i]; }
}

#ifndef S2FN
#define S2FN s2v5_phase
#endif
struct Args { const float* in[18]; float* out; unsigned char* ws; int ph_lo, ph_hi; };
constexpr int N_PHASES = 19;
__global__ void __launch_bounds__(NTHREADS, 2) fwd(Args args) {
    extern __shared__ __attribute__((aligned(16))) unsigned char lds_raw[];
    Frame F;
    F.lds = (LAS unsigned char*)lds_raw;
    F.tid = threadIdx.x; F.lane = F.tid & 63; F.wave = __builtin_amdgcn_readfirstlane(F.tid >> 6);
    F.G = gridDim.x; { const int bx = blockIdx.x; F.vcu = (F.G % 8 == 0) ? (bx % 8) * (F.G / 8) + bx / 8 : bx; }
    F.ws = args.ws; F.out = args.out;
#pragma unroll
    for (int i = 0; i < 18; ++i) F.in[i] = args.in[i];
    volatile LAS unsigned* MISC = (volatile LAS unsigned*)(F.lds + LDS_MISC);
    if (F.tid < 64) MISC[F.tid] = 0u;
    __syncthreads();
    XcdBarrier bar = xcd_barrier_post(WSP(unsigned, WS_CTL) + CW_BAR, MISC + 8);
    const int lo = args.ph_lo, hi = args.ph_hi;
    __syncthreads();
    F.vb = (int)blockIdx.x;
    int vblk = (int)blockIdx.x;
#define IN(k) (lo <= (k) && (k) < hi)
#if defined(PROBE_PHASE)
    unsigned long long t_prev = __builtin_amdgcn_s_memrealtime(), t_probe = 0ull;
#define SEAM(k) do { if (IN(k) && IN((k) + 1)) xcd_barrier(bar); { const unsigned long long t_now = __builtin_amdgcn_s_memrealtime(); if ((k) == PROBE_PHASE) t_probe = t_now - t_prev; t_prev = t_now; } } while (0)
#else
#define SEAM(k) do { if (IN(k) && IN((k) + 1)) xcd_barrier(bar); } while (0)
#endif
    bf16_t* HB = WSP(bf16_t, WS_HB); float* SS = WSP(float, WS_SS); float* H = F.out;
    bf16_t* ACT = WSP(bf16_t, WS_ACT);
    const int gw = F.vcu * NWAVES + F.wave, NGW = F.G * NWAVES;
    float* RAW = WSP(float, WS_META + META_RAW); float* HM = WSP(float, WS_META + META_HM);

#define FFN_IN(win, do_meta) do { \
        if ((do_meta) && meta_has_tiles(F, 2 * DFF, 128, 128)) { meta_prep_h(F); meta_tiles<0>(F, WSP(bf16_t, (win)), 2 * DFF, D, RAW, 2 * DFF, 1.f, 128, 128); } \
        pg8::Order S_; S_.init(M / 256, 22, F.G, vblk); PtrNormal P_{(const char*)HB, (const char*)WSP(bf16_t, (win)), (size_t)256 * D * 2}; \
        EpiSwiglu E_{SS, ACT}; pg8::gemm_phase(F.lds, D, S_, P_, E_); } while (0)
#define FFN_OUT(wout, do_meta, F32B) do { \
        if ((do_meta) && meta_has_tiles(F, D, 0, 256)) { meta_prep_act(F); meta_tiles<1>(F, WSP(bf16_t, (wout)), D, DFF, HM, D, 0.5f, 0, 256); } \
        pg8::Order S_; S_.init(M / 256, 4, F.G, vblk); PtrNormal P_{(const char*)ACT, (const char*)WSP(bf16_t, (wout)), (size_t)256 * DFF * 2}; \
        EpiResid<F32B> E_{F.in[0], HB, SS, 0.5f}; pg8::gemm_phase(F.lds, DFF, S_, P_, E_); } while (0)

#define slack (vblk >= 128)
#define sgw ((vblk - 128) * NWAVES + F.wave)
    const int SNGW = 128 * NWAVES;
    if (IN(0)) {
        int cb = conv_job(F, job_ffn_in(F, 0, 0, WS_WFFN_A + WF_IN), 0, gw, NGW); cb = conv_job(F, job_ffn_out(F, 0, 0, WS_WFFN_A + WF_OUT), cb, gw, NGW);
        p0_rows(F);
    }
    SEAM(0);
    if (lo == 0 && hi == N_PHASES && F.G == 256) {
        const unsigned* barw = WSP(unsigned, WS_CTL) + CW_BAR; bool ok = true;
#pragma unroll
        for (int j = 0; j < 8; ++j) ok = ok && (__hip_atomic_load(barw + XB_XCNT(j), __ATOMIC_RELAXED, __HIP_MEMORY_SCOPE_AGENT) == 32u);
        const unsigned rank = MISC[10], xcc = MISC[11];
        if (ok && rank < 32u && xcc < 8u) vblk = (int)(rank * 8u + xcc);
    }
    F.vb = vblk;
    if (IN(1)) {
        if (slack) { ConvJob J;
            J.W = F.in[9]; J.ldn = 6144; J.K = D; J.N = 6144; J.col0 = 0; J.kind = 0; J.gain = F.in[5]; J.WT = WSP(bf16_t, WS_WMIX + WM_RET_IN);
            int cb = conv_job(F, J, 0, sgw, SNGW);
            J.W = F.in[11]; J.ldn = D; J.K = 2048; J.N = D; J.col0 = 0; J.kind = 0; J.gain = F.in[10]; J.WT = WSP(bf16_t, WS_WMIX + WM_RET_OUT);
            cb = conv_job(F, J, cb, sgw, SNGW);
            cb = conv_job(F, job_ffn_in(F, 0, 1, WS_WFFN_C), cb, sgw, SNGW); __syncthreads(); }
        FFN_IN(WS_WFFN_A + WF_IN, true);
    }
    SEAM(1);
    if (IN(2)) FFN_OUT(WS_WFFN_A + WF_OUT, true, true);
    SEAM(2);
    if (IN(3)) {
        if (meta_has_tiles(F, 6144, 0, 256)) { meta_prep_h(F); meta_tiles<0>(F, WSP(bf16_t, WS_WMIX + WM_RET_IN), 6144, D, RAW, 6144, 1.f, 0, 256); }
        pg8::Order S_; S_.init(M / 256, 16, F.G, vblk);
        PtrSwapFrom P_{(const char*)HB, (const char*)WSP(bf16_t, WS_WMIX + WM_RET_IN), (size_t)256 * D * 2, 8};
        EpiRetIn E_{SS, WSP(bf16_t, WS_QH), WSP(bf16_t, WS_KH), WSP(bf16_t, WS_VT)}; pg8::gemm_phase(F.lds, D, S_, P_, E_);
    }
    SEAM(3);
    if (IN(4)) S2FN<256, 512, false>(F, vblk, WSP(bf16_t, WS_QH), WSP(bf16_t, WS_KH), WSP(bf16_t, WS_VT), WSP(bf16_t, WS_O), nullptr, 6144);
    SEAM(4);
    if (IN(5)) {
        (void)conv_job(F, job_ffn_out(F, 0, 1, WS_WFFN_A + WF_OUT), 0, gw, NGW);
        __syncthreads();
        pg8::Order S_; S_.init(M / 256, 8, F.G, vblk); PtrNormal P_{(const char*)HB, (const char*)(WSP(bf16_t, WS_WMIX + WM_RET_IN) + (size_t)4096 * D), (size_t)256 * D * 2};
        EpiGate<512, 2048> E_{SS, WSP(bf16_t, WS_O), WSP(bf16_t, WS_VT), (LAS float*)(F.lds + 132096)}; pg8::gemm_phase(F.lds, D, S_, P_, E_);
    }
    SEAM(5);
    if (IN(6)) {
        if (meta_has_tiles(F, D, 0, 256)) { meta_prep_y(F); meta_tiles<1>(F, WSP(bf16_t, WS_WMIX + WM_RET_OUT), D, 2048, HM, D, 1.0f, 0, 256); }
        pg8::Order S_; S_.init(M / 256, 4, F.G, vblk); PtrNormal P_{(const char*)WSP(bf16_t, WS_VT), (const char*)WSP(bf16_t, WS_WMIX + WM_RET_OUT), (size_t)256 * 2048 * 2};
        EpiResid<false> E_{nullptr, HB, SS, 1.0f}; pg8::gemm_phase(F.lds, 2048, S_, P_, E_);
    }
    SEAM(6);
    if (IN(7)) {
        if (slack) { int cb = conv_job(F, job_ffn_in(F, 1, 0, WS_WFFN_B + WF_IN), 0, sgw, SNGW); cb = conv_job(F, job_ffn_out(F, 1, 0, WS_WFFN_B + WF_OUT), cb, sgw, SNGW);
            ConvJob J;
            J.W = F.in[12]; J.ldn = 3088; J.K = D; J.N = 3072; J.col0 = 0; J.kind = 0; J.gain = F.in[5] + D; J.WT = WSP(bf16_t, WS_WMIX + WM_GLA_IN);
            cb = conv_job(F, J, cb, sgw, SNGW);
            J.W = F.in[16]; J.ldn = D; J.K = D; J.N = D; J.col0 = 0; J.kind = 0; J.gain = F.in[15]; J.WT = WSP(bf16_t, WS_WMIX + WM_GLA_OUT);
            cb = conv_job(F, J, cb, sgw, SNGW);
            if (vblk == F.G - 1) { bf16_t* WZ = WSP(bf16_t, WS_WMIX + WM_GLA_Z); const float* W = F.in[12]; const float* gn = F.in[5] + D;
                for (int i = F.tid; i < 16 * D; i += NTHREADS) { const int k = i >> 4, r = i & 15; WZ[r * D + k] = f2bf(W[(size_t)k * 3088 + 3072 + r] * gn[k]); } }
            __syncthreads(); }
        FFN_IN(WS_WFFN_C, true);
    }
    SEAM(7);
    if (IN(8)) FFN_OUT(WS_WFFN_A + WF_OUT, true, false);
    SEAM(8);
    if (IN(9)) {
        if (slack) { int cb = conv_job(F, job_ffn_in(F, 1, 1, WS_WFFN_A + WF_IN), 0, sgw, SNGW); cb = conv_job(F, job_ffn_out(F, 1, 1, WS_WFFN_A + WF_OUT), cb, sgw, SNGW); __syncthreads(); }
        FFN_IN(WS_WFFN_B + WF_IN, true);
    }
    SEAM(9);
    if (IN(10)) FFN_OUT(WS_WFFN_B + WF_OUT, true, false);
    SEAM(10);
    if (IN(11)) {
        if (meta_has_tiles(F, 2048, 0, 256)) { meta_prep_h(F); meta_tiles<0>(F, WSP(bf16_t, WS_WMIX + WM_GLA_IN), 2048, D, RAW, 3088, 1.f, 0, 256); }
        if (F.vb == 0) meta_tiles<0>(F, WSP(bf16_t, WS_WMIX + WM_GLA_Z), 16, D, RAW + 3072, 3088, 1.f, 0, 256);
        __syncthreads();
        z_phase(F, HB, SS, WSP(bf16_t, WS_WMIX + WM_GLA_Z), F.in[13], F.in[14], WSP(float, WS_BC));
    }
    SEAM(11);
    if (IN(12)) {
        pg8::Order S_; S_.init(M / 256, 8, F.G, vblk);
        PtrSwapFrom P_{(const char*)HB, (const char*)WSP(bf16_t, WS_WMIX + WM_GLA_IN), (size_t)256 * D * 2, 4};
        EpiGlaIn E_{SS, WSP(float, WS_BC), WSP(bf16_t, WS_QH2), WSP(bf16_t, WS_KH2), WSP(bf16_t, WS_VT2)}; pg8::gemm_phase(F.lds, D, S_, P_, E_);
    }
    SEAM(12);
    if (IN(13)) S2FN<128, 256, true>(F, vblk, WSP(bf16_t, WS_QH2), WSP(bf16_t, WS_KH2), WSP(bf16_t, WS_VT2), WSP(bf16_t, WS_O2), WSP(float, WS_BC), 3088);
    SEAM(13);
    if (IN(14)) {
        pg8::Order S_; S_.init(M / 256, 4, F.G, vblk); PtrNormal P_{(const char*)HB, (const char*)WSP(bf16_t, WS_WMIX + WM_GLA_G), (size_t)256 * D * 2};
        EpiGate<256, 1024> E_{SS, WSP(bf16_t, WS_O2), WSP(bf16_t, WS_VT2), (LAS float*)(F.lds + 132096)}; pg8::gemm_phase(F.lds, D, S_, P_, E_);
    }
    SEAM(14);
    if (IN(15)) {
        pg8::Order S_; S_.init(M / 256, 4, F.G, vblk); PtrNormal P_{(const char*)WSP(bf16_t, WS_VT2), (const char*)WSP(bf16_t, WS_WMIX + WM_GLA_OUT), (size_t)256 * D * 2};
        EpiResid<false> E_{nullptr, HB, SS, 1.0f}; pg8::gemm_phase(F.lds, D, S_, P_, E_);
    }
    SEAM(15);
    if (IN(16)) FFN_IN(WS_WFFN_A + WF_IN, false);
    SEAM(16);
    if (IN(17)) FFN_OUT(WS_WFFN_A + WF_OUT, false, false);
    SEAM(17);
    if (IN(18)) final_phase(F, SS, F.in[17]);
#if defined(PROBE2) || defined(PROBE3)
    __syncthreads();
    if (vblk == 0 && F.tid == 0) { const unsigned long long cyc = ((unsigned long long)MISC[21] << 32) | MISC[20]; const unsigned long long t0 = __builtin_amdgcn_s_memtime(); while (__builtin_amdgcn_s_memtime() - t0 < 4ull * cyc) __builtin_amdgcn_s_sleep(16); }
#endif
#if defined(PROBE_PHASE)
    { const unsigned long long t_now = __builtin_amdgcn_s_memrealtime(); if (18 == PROBE_PHASE) t_probe = t_now - t_prev;
      if (blockIdx.x == 0 && F.tid == 0) { const unsigned long long t_end = t_now + (unsigned long long)PROBE_MULT * t_probe; while (__builtin_amdgcn_s_memrealtime() < t_end) __builtin_amdgcn_s_sleep(16); } }
#endif
#undef slack
#undef sgw
#undef IN
#undef SEAM
#undef FFN_IN
#undef FFN_OUT
}
}
#ifndef MK_MODE
#define MK_MODE 0
#endif
#if MK_MODE == 2
namespace dbg {
__global__ void adapt(const float* Hreal, const float* HMtmp, float* Hn) {
    const size_t i = (size_t)blockIdx.x * blockDim.x + threadIdx.x;
    if (i >= (size_t)nv::ROWS * nv::D) return;
    const int d = (int)(i % nv::D); const size_t row = i / nv::D; const int b = (int)(row / nv::TT), s = (int)(row % nv::TT);
    Hn[i] = s < nv::NMETA ? HMtmp[s * nv::D + d] : Hreal[((size_t)b * nv::SEQ + (s - nv::NMETA)) * nv::D + d];
}
}
#endif
extern "C" void kernel_launch(void* const* d_in, const int* in_sizes, int n_in, void* d_out, int out_size, void* d_ws, size_t ws_size, hipStream_t stream) {
    static int grid = 0;
    if (grid == 0) {
        if (n_in != 18 || out_size != mk::M * mk::D || ws_size < mk::WS_NEED) { fprintf(stderr, "kernel_launch: unexpected sizes n_in %d out %d ws %zu\n", n_in, out_size, ws_size); grid = -1; return; }
        int dev = 0, cus = 0, per_cu = 0;
        if (hipGetDevice(&dev) != hipSuccess || hipDeviceGetAttribute(&cus, hipDeviceAttributeMultiprocessorCount, dev) != hipSuccess) { grid = -1; return; }
        if (hipFuncSetAttribute((const void*)mk::fwd, hipFuncAttributeMaxDynamicSharedMemorySize, mk::LDS_BYTES) != hipSuccess) { fprintf(stderr, "kernel_launch: hipFuncSetAttribute failed\n"); grid = -1; return; }
        if (hipOccupancyMaxActiveBlocksPerMultiprocessor(&per_cu, (const void*)mk::fwd, mk::NTHREADS, mk::LDS_BYTES) != hipSuccess || per_cu < 1) { fprintf(stderr, "kernel_launch: occupancy query says %d\n", per_cu); per_cu = 1; }
        (void)hipGetLastError();
        grid = cus;
        if (grid != 256) fprintf(stderr, "kernel_launch: %d CUs (built for 256)\n", grid);
    }
    if (grid < 0) return;
    (void)hipMemsetAsync((char*)d_ws + mk::WS_CTL, 0, mk::CTL_ZERO_BYTES, stream);
    mk::Args a{};
    for (int i = 0; i < 18; ++i) a.in[i] = (const float*)d_in[i];
    a.out = (float*)d_out; a.ws = (unsigned char*)d_ws;
#if MK_MODE == 0
    a.ph_lo = 0; a.ph_hi = mk::N_PHASES;
    hipLaunchKernelGGL(mk::fwd, dim3(grid), dim3(mk::NTHREADS), mk::LDS_BYTES, stream, a);
#elif MK_MODE == 1
    for (int p = 0; p < mk::N_PHASES; ++p) { a.ph_lo = p; a.ph_hi = p + 1; hipLaunchKernelGGL(mk::fwd, dim3(grid), dim3(mk::NTHREADS), mk::LDS_BYTES, stream, a); }
#else
    for (int p = 0; p < MK_CUT; ++p) { a.ph_lo = p; a.ph_hi = p + 1; hipLaunchKernelGGL(mk::fwd, dim3(grid), dim3(mk::NTHREADS), mk::LDS_BYTES, stream, a); }
    {
        float* tmp = (float*)((char*)d_ws + 250 * mk::MiB);
        (void)hipMemcpyAsync(tmp, (char*)d_ws + mk::WS_META + mk::META_HM, 16 * 1024 * 4, hipMemcpyDeviceToDevice, stream);
        hipLaunchKernelGGL(dbg::adapt, dim3((unsigned)(((size_t)nv::ROWS * nv::D + 255) / 256)), dim3(256), 0, stream, (const float*)d_out, (const float*)tmp, (float*)d_ws);
        nv::forward(stream, d_in, (float*)d_out, (char*)d_ws, MK_STAGE);
    }
#endif
}
```

```cpp
#include <hip/hip_runtime.h>
#include <cstdint>
#include <cstdio>
#include <cmath>
#define MK_MODE 0
namespace mk {
#define LAS __attribute__((address_space(3)))
#define GAS __attribute__((address_space(1)))
typedef unsigned short bf16_t;
typedef short bf16x8 __attribute__((ext_vector_type(8)));
typedef short s16x4 __attribute__((ext_vector_type(4)));
typedef float f32x4 __attribute__((ext_vector_type(4)));
typedef float f32x2 __attribute__((ext_vector_type(2)));
typedef unsigned u32x4 __attribute__((ext_vector_type(4)));
typedef unsigned u32x2 __attribute__((ext_vector_type(2)));

constexpr int M = 16384, D = 1024, DFF = 2816, SEQ = 8192, NMETA = 16;
constexpr int NWAVES = 8, NTHREADS = 512;
constexpr size_t MiB = 1u << 20;
constexpr size_t WS_CTL = 0, CTL_ZERO_BYTES = 1 * MiB;
constexpr size_t CTL_OSS_RET = 256 * 1024, CTL_OSS_GLA = 512 * 1024, CTL_MOSS = 768 * 1024;
constexpr size_t WS_HB = 1 * MiB, WS_SS = 33 * MiB, WS_META = 34 * MiB, WS_WMIX = 35 * MiB;
constexpr size_t META_HM = 0, META_RAW = 64 * 1024, META_MO = 448 * 1024;
constexpr size_t WS_WFFN_A = 52 * MiB, WS_ACT = 69 * MiB, WS_WFFN_B = 157 * MiB, WS_WFFN_C = 244 * MiB;
constexpr size_t WS_QH = 52 * MiB, WS_KH = 84 * MiB, WS_VT = 116 * MiB, WS_O = 180 * MiB;
constexpr size_t WS_BC = 69 * MiB, WS_QH2 = 101 * MiB, WS_KH2 = 117 * MiB, WS_VT2 = 133 * MiB, WS_O2 = 174 * MiB;
constexpr size_t WS_NEED = 256 * MiB;
constexpr size_t WM_RET_IN = 0, WM_RET_OUT = 12 * MiB;
constexpr size_t WM_GLA_IN = 0, WM_GLA_G = 4 * MiB, WM_GLA_OUT = 6 * MiB, WM_GLA_Z = 8 * MiB;
constexpr size_t WF_IN = 0, WF_OUT = 11 * MiB;
constexpr int CW_BAR = 4096;

constexpr int LDS_BYTES = 163840;
constexpr int LDS_MISC = LDS_BYTES - 256;

__constant__ float L2G[4] = {-0.04580368961312478f, -0.02272007650008353f, -0.011315313227834133f, -0.005646563141142062f};
__constant__ float ROPE_INV[128] = {
  1.000000000e+00f, 9.300450087e-01f, 8.649836779e-01f, 8.044736385e-01f,
  7.481966019e-01f, 6.958565116e-01f, 6.471778154e-01f, 6.019044518e-01f,
  5.597981811e-01f, 5.206375122e-01f, 4.842162728e-01f, 4.503428936e-01f,
  4.188391268e-01f, 3.895392120e-01f, 3.622889817e-01f, 3.369450271e-01f,
  3.133740425e-01f, 2.914519310e-01f, 2.710633874e-01f, 2.521011233e-01f,
  2.344653904e-01f, 2.180633694e-01f, 2.028087080e-01f, 1.886212230e-01f,
  1.754262149e-01f, 1.631542742e-01f, 1.517407894e-01f, 1.411257535e-01f,
  1.312533021e-01f, 1.220714748e-01f, 1.135319397e-01f, 1.055898219e-01f,
  9.820328653e-02f, 9.133346379e-02f, 8.494423330e-02f, 7.900195569e-02f,
  7.347535342e-02f, 6.833537668e-02f, 6.355497986e-02f, 5.910899118e-02f,
  5.497401953e-02f, 5.112830922e-02f, 4.755162448e-02f, 4.422515258e-02f,
  4.113136977e-02f, 3.825402260e-02f, 3.557796404e-02f, 3.308910504e-02f,
  3.077435680e-02f, 2.862153389e-02f, 2.661931701e-02f, 2.475716174e-02f,
  2.302526683e-02f, 2.141453326e-02f, 1.991648041e-02f, 1.852322184e-02f,
  1.722742990e-02f, 1.602228358e-02f, 1.490144618e-02f, 1.385901403e-02f,
  1.288950257e-02f, 1.198781747e-02f, 1.114920899e-02f, 1.036926545e-02f,
  9.643883444e-03f, 8.969245479e-03f, 8.341802284e-03f, 7.758250926e-03f,
  7.215522230e-03f, 6.710760761e-03f, 6.241309457e-03f, 5.804697983e-03f,
  5.398627371e-03f, 5.020966288e-03f, 4.669724498e-03f, 4.343053792e-03f,
  4.039235413e-03f, 3.756670747e-03f, 3.493872471e-03f, 3.249458736e-03f,
  3.022142686e-03f, 2.810728736e-03f, 2.614103956e-03f, 2.431234345e-03f,
  2.261157380e-03f, 2.102978062e-03f, 1.955864020e-03f, 1.819041790e-03f,
  1.691789716e-03f, 1.573440502e-03f, 1.463370281e-03f, 1.361000235e-03f,
  1.265791478e-03f, 1.177242957e-03f, 1.094888896e-03f, 1.018295996e-03f,
  9.470609948e-04f, 8.808093844e-04f, 8.191923262e-04f, 7.618857198e-04f,
  7.085879333e-04f, 6.590186385e-04f, 6.129170069e-04f, 5.700403708e-04f,
  5.301629426e-04f, 4.930753494e-04f, 4.585822753e-04f, 4.265021416e-04f,
  3.966661752e-04f, 3.689173318e-04f, 3.431097430e-04f, 3.191074939e-04f,
  2.967843320e-04f, 2.760227653e-04f, 2.567135962e-04f, 2.387551940e-04f,
  2.220530587e-04f, 2.065193403e-04f, 1.920722716e-04f, 1.786358480e-04f,
  1.661392889e-04f, 1.545170089e-04f, 1.437077590e-04f, 1.336546848e-04f,
  1.243048755e-04f, 1.156091312e-04f, 1.075216787e-04f, 9.999999747e-05f,
};

#define LDS_WAIT() asm volatile("s_waitcnt lgkmcnt(0)" ::: "memory")
#define VM_WAIT() asm volatile("s_waitcnt vmcnt(0)" ::: "memory")
#define RLX_AGENT __ATOMIC_RELAXED, __HIP_MEMORY_SCOPE_AGENT

__device__ __forceinline__ unsigned cvt_pk_bf16(float lo, float hi) { unsigned r; asm volatile("v_cvt_pk_bf16_f32 %0, %1, %2" : "=v"(r) : "v"(lo), "v"(hi)); return r; }
__device__ __forceinline__ float bf_lo(unsigned w) { return __uint_as_float(w << 16); }
__device__ __forceinline__ float bf_hi(unsigned w) { return __uint_as_float(w & 0xffff0000u); }
__device__ __forceinline__ unsigned short f2bf(float f) { return (unsigned short)(cvt_pk_bf16(f, 0.f) & 0xffffu); }
__device__ __forceinline__ float fsilu(float v) { return v * __builtin_amdgcn_rcpf(1.0f + __expf(-v)); }
__device__ __forceinline__ float wave_sum(float v) {
#pragma unroll
    for (int o = 1; o < 64; o <<= 1) v += __shfl_xor(v, o);
    return v;
}
__device__ __forceinline__ float row_rstd(const float* SS, int row) {
    const f32x4* p = (const f32x4*)(SS + (size_t)row * 16);
    const f32x4 a = p[0], b = p[1], c = p[2], d = p[3];
    const float s = ((a.x + a.y) + (a.z + a.w)) + ((b.x + b.y) + (b.z + b.w)) + ((c.x + c.y) + (c.z + c.w)) + ((d.x + d.y) + (d.z + d.w));
    return 1.0f / sqrtf(s * (1.0f / 1024.0f) + 1e-6f);
}

#define XB_TMO      128
#define XB_XCNT(j)  (256  + 64 * (j))
#define XB_XSUB(j)  (1280 + 64 * (j))
#define XB_XGEN(j)  (2304 + 64 * (j))
#define XB_TOP      3328
#define XB_TOPGEN   3392
#define XCD_BAR_WORDS 3456
#define XB_SPIN_CAP (1u << 18)
__device__ __forceinline__ unsigned xb_ld(unsigned* p)              { return __hip_atomic_load(p, __ATOMIC_RELAXED, __HIP_MEMORY_SCOPE_AGENT); }
__device__ __forceinline__ unsigned xb_add(unsigned* p, unsigned v) { return __hip_atomic_fetch_add(p, v, __ATOMIC_RELAXED, __HIP_MEMORY_SCOPE_AGENT); }
__device__ __forceinline__ unsigned xb_xcc_id() { return (unsigned)__builtin_amdgcn_s_getreg((3 << 11) | 20) & 0xFu; }
#define XB_SPIN(cond, bar) do { unsigned _sp = 0; while (cond) { __builtin_amdgcn_s_sleep(1); \
    if ((++_sp & 255u) == 0u) { if (xb_ld(&(bar)[XB_TMO])) break; if (_sp > XB_SPIN_CAP) { atomicAdd(&(bar)[XB_TMO], 1u); break; } } } } while (0)
struct XcdBarrier { unsigned* bar; unsigned x; volatile LAS unsigned* st; };
__device__ __forceinline__ XcdBarrier xcd_barrier_post(unsigned* bar, volatile LAS unsigned* st) {
    XcdBarrier b; b.bar = bar; b.x = xb_xcc_id(); b.st = st;
    if (threadIdx.x == 0) { const unsigned rank = xb_add(&bar[XB_XCNT(b.x)], 1u); st[2] = rank; st[3] = b.x; }
    return b;
}
__device__ __forceinline__ void xcd_barrier_complete(unsigned* bar, unsigned x, unsigned& nloc, unsigned& nx) {
    const unsigned G = gridDim.x * gridDim.y * gridDim.z;
    unsigned sum, cnt, mine, sp = 0u;
    for (;;) {
        sum = 0u; cnt = 0u; mine = 0u;
#pragma unroll
        for (unsigned j = 0; j < 16; ++j) { const unsigned c = xb_ld(&bar[XB_XCNT(j)]); sum += c; cnt += (c > 0u) ? 1u : 0u; mine = (j == x) ? c : mine; }
        if (sum == G) break;
        __builtin_amdgcn_s_sleep(1);
        if ((++sp & 255u) == 0u) { if (xb_ld(&bar[XB_TMO])) break; if (sp > XB_SPIN_CAP) { atomicAdd(&bar[XB_TMO], 1u); break; } }
    }
    nloc = mine > 0u ? mine : 1u; nx = cnt > 0u ? cnt : 1u;
}
__device__ __forceinline__ void xcd_barrier(const XcdBarrier& b) {
    asm volatile("s_waitcnt vmcnt(0)" ::: "memory");
    __syncthreads();
    if (threadIdx.x == 0) {
        unsigned* bar = b.bar;
        __builtin_amdgcn_s_waitcnt(0);
        unsigned nloc = b.st[0], nx = b.st[1];
        if (nloc == 0u) { xcd_barrier_complete(bar, b.x, nloc, nx); b.st[0] = nloc; b.st[1] = nx; }
        const unsigned old = xb_add(&bar[XB_XSUB(b.x)], 1u);
        const unsigned gen = old / nloc;
        if (old + 1u == (gen + 1u) * nloc) {
            __builtin_amdgcn_fence(__ATOMIC_RELEASE, "agent");
            asm volatile("s_waitcnt vmcnt(0)" ::: "memory");
            const unsigned og = xb_add(&bar[XB_TOP], 1u);
            const unsigned tg = og / nx;
            if (og + 1u == (tg + 1u) * nx) xb_add(&bar[XB_TOPGEN], 1u);
            else XB_SPIN(xb_ld(&bar[XB_TOPGEN]) == tg, bar);
            __builtin_amdgcn_fence(__ATOMIC_ACQUIRE, "agent");
            xb_add(&bar[XB_XGEN(b.x)], 1u);
            asm volatile("s_waitcnt vmcnt(0)" ::: "memory");
        } else {
            XB_SPIN(xb_ld(&bar[XB_XGEN(b.x)]) == gen, bar);
            __builtin_amdgcn_fence(__ATOMIC_ACQUIRE, "agent");
            asm volatile("s_waitcnt vmcnt(0)" ::: "memory");
        }
    }
    __syncthreads();
}

namespace pg8 {
constexpr int BM = 256, BK = 64, HALF = 128, HTB = HALF * BK * 2, STAGE_BYTES = 8 * HTB, NXCD = 8, WGM = 8;
__host__ __device__ __forceinline__ int lds_byte(int r, int c) { const int st = (r >> 4) * 2 + (c >> 5), rr = r & 15, cc = c & 31, ob = rr * 64 + cc * 2; return st * 1024 + (ob ^ (((ob >> 9) & 1) << 5)); }
__host__ __device__ __forceinline__ void stage_rc(int b, int& R, int& C) { const int st = b / 1024, sb = b % 1024, swz = sb ^ (((sb >> 9) & 1) << 5); R = (st >> 1) * 16 + swz / 64; C = (st & 1) * 32 + (swz % 64) / 2; }
__host__ __device__ __forceinline__ int perm32(int rho) { const int n = rho >> 4, i = rho & 15; return 8 * (i >> 2) + 4 * n + (i & 3); }
struct Unit { int pm, pn; };
struct Order {
    int nM, nN, nwg, G, c;
    __device__ void init(int nM_, int nN_, int G_, int c_) { nM = nM_; nN = nN_; nwg = nM * nN; G = G_; c = c_; }
    __device__ bool next(int i, Unit& u) const {
        const long L = (long)i * G + c; if (L >= nwg) return false;
        int wgid = (int)L; { const int q = nwg / NXCD, r = nwg % NXCD, xcd = wgid % NXCD, off = wgid / NXCD; wgid = (xcd < r ? xcd * (q + 1) : r * (q + 1) + (xcd - r) * q) + off; }
        const int nig = WGM * nN, gid = wgid / nig, fm = gid * WGM, gsz = (nM - fm) < WGM ? (nM - fm) : WGM;
        u.pm = fm + ((wgid % nig) % gsz); u.pn = (wgid % nig) / gsz; return true;
    }
};
template <class Epi, class Ptr>
__device__ __forceinline__ void gemm_phase(LAS unsigned char* lds, const int K, const Order& S, const Ptr& P, const Epi& E) {
    const int tid = threadIdx.x, wid = __builtin_amdgcn_readfirstlane(tid >> 6), lane = tid & 63, wr = wid >> 2, wc = wid & 3, fr = lane & 15, fq = lane >> 4;
    const int nt = K / BK;
    unsigned voffA[2], voffB[2];
#pragma unroll
    for (int i = 0; i < 2; ++i) { int R, C; stage_rc(tid * 16 + i * 8192, R, C); const int Rb = (R & ~31) + perm32(R & 31);
        voffA[i] = (unsigned)(R * K + C) * 2u; voffB[i] = (unsigned)(Rb * K + C) * 2u; }
    const size_t kstep = (size_t)(BK * 2);
    const size_t hstep = (size_t)HALF * K * 2;
    const unsigned ldsw = (unsigned)wid * 1024u;
    const int aoff = lds_byte(wr * 64 + fr, fq * 8), boff = lds_byte(wc * 32 + fr, fq * 8);
#define PG8_SA(b, h) (((b) * 2 + (h)) * HTB)
#define PG8_SB(b, h) ((4 + (b) * 2 + (h)) * HTB)
#define PG8_STAGE(bufoff, gbase, voff) do { _Pragma("unroll") for (int _i = 0; _i < 2; ++_i) \
        __builtin_amdgcn_global_load_lds((const unsigned*)((const char*)(gbase) + (voff)[_i]), (LAS unsigned*)(lds + (bufoff) + ldsw + _i * 8192), 16, 0, 0); } while (0)
#define PG8_LDA(dst, b, h) do { _Pragma("unroll") for (int m = 0; m < 4; ++m) _Pragma("unroll") for (int k = 0; k < 2; ++k) dst[m][k] = *(const LAS bf16x8*)(lds + PG8_SA(b, h) + aoff + m * 2048 + k * 1024); } while (0)
#define PG8_LDB(dst, b, h) do { _Pragma("unroll") for (int n = 0; n < 2; ++n) _Pragma("unroll") for (int k = 0; k < 2; ++k) dst[n][k] = *(const LAS bf16x8*)(lds + PG8_SB(b, h) + boff + n * 2048 + k * 1024); } while (0)
#define PG8_MMA(ai, bj, At, Bt) do { __builtin_amdgcn_s_setprio(1); _Pragma("unroll") for (int m = 0; m < 4; ++m) _Pragma("unroll") for (int n = 0; n < 2; ++n) _Pragma("unroll") for (int k = 0; k < 2; ++k) \
        acc[ai][bj][m][n] = __builtin_amdgcn_mfma_f32_16x16x32_bf16(Bt[n][k], At[m][k], acc[ai][bj][m][n], 0, 0, 0); __builtin_amdgcn_s_setprio(0); } while (0)
#define PG8_WAIT_V(n) asm volatile("s_waitcnt vmcnt(" #n ")" ::: "memory")
#define PG8_WAIT_L(n) asm volatile("s_waitcnt lgkmcnt(" #n ")" ::: "memory")
#define PG8_BAR __builtin_amdgcn_s_barrier()
#define PG8_SCHED __builtin_amdgcn_sched_barrier(0)
    Unit cur, nxt; int ui = 0;
    if (!S.next(0, cur)) return;
    f32x4 acc[2][2][4][2];
#pragma unroll
    for (int a = 0; a < 2; ++a)
#pragma unroll
        for (int b = 0; b < 2; ++b)
#pragma unroll
            for (int m = 0; m < 4; ++m)
#pragma unroll
                for (int n = 0; n < 2; ++n) acc[a][b][m][n] = (f32x4){0.f, 0.f, 0.f, 0.f};
    bf16x8 At[4][2], B0[2][2], B1[2][2];
    const char* cA; const char* cB; P.ptrs(cur, cA, cB);
    PG8_STAGE(PG8_SB(0, 0), cB, voffB); PG8_STAGE(PG8_SB(0, 1), cB + hstep, voffB); PG8_STAGE(PG8_SA(0, 0), cA, voffA); PG8_STAGE(PG8_SA(0, 1), cA + hstep, voffA);
    if (wr == 1) PG8_BAR;
    PG8_WAIT_V(2); PG8_BAR;
    PG8_STAGE(PG8_SB(1, 0), cB + kstep, voffB); PG8_STAGE(PG8_SA(1, 0), cA + kstep, voffA); PG8_STAGE(PG8_SB(1, 1), cB + hstep + kstep, voffB);
    PG8_WAIT_V(6); PG8_BAR;
    for (;;) {
        const bool has_next = S.next(ui + 1, nxt);
        const char* nA = cA; const char* nB = cB; if (has_next) P.ptrs(nxt, nA, nB);
        for (int t = 0; t < nt; t += 2) {
            const bool last = (t == nt - 2);
            const char* a1 = cA + (size_t)(t + 1) * kstep;
            const char* a2 = last ? nA : cA + (size_t)(t + 2) * kstep; const char* b2 = last ? nB : cB + (size_t)(t + 2) * kstep;
            const char* a3 = a2 + kstep; const char* b3 = b2 + kstep;
            PG8_LDB(B0, 0, 0); PG8_LDB(B1, 0, 1); PG8_SCHED; PG8_LDA(At, 0, 0); PG8_STAGE(PG8_SA(1, 1), a1 + hstep, voffA);
            PG8_WAIT_V(8); PG8_WAIT_L(0); PG8_BAR; PG8_MMA(0, 0, At, B0); PG8_MMA(0, 1, At, B1); PG8_BAR; PG8_SCHED;
            PG8_LDA(At, 0, 1); PG8_STAGE(PG8_SB(0, 0), b2, voffB); PG8_STAGE(PG8_SB(0, 1), b2 + hstep, voffB); PG8_STAGE(PG8_SA(0, 0), a2, voffA);
            PG8_WAIT_V(8); PG8_WAIT_L(0); PG8_BAR; PG8_MMA(1, 0, At, B0); PG8_MMA(1, 1, At, B1); PG8_BAR; PG8_SCHED;
            PG8_LDB(B0, 1, 0); PG8_LDB(B1, 1, 1); PG8_SCHED; PG8_LDA(At, 1, 0); PG8_STAGE(PG8_SA(0, 1), a2 + hstep, voffA);
            PG8_WAIT_V(8); PG8_WAIT_L(0); PG8_BAR; PG8_MMA(0, 0, At, B0); PG8_MMA(0, 1, At, B1); PG8_BAR; PG8_SCHED;
            PG8_LDA(At, 1, 1); PG8_STAGE(PG8_SB(1, 0), b3, voffB); PG8_STAGE(PG8_SB(1, 1), b3 + hstep, voffB); PG8_STAGE(PG8_SA(1, 0), a3, voffA);
            PG8_WAIT_V(8); PG8_WAIT_L(0); PG8_BAR; PG8_MMA(1, 0, At, B0); PG8_MMA(1, 1, At, B1); PG8_BAR; PG8_SCHED;
        }
        if (wr == 0) PG8_BAR;
        E(acc, cur, wr, wc, fr, fq);
        if (!has_next) break;
#pragma unroll
        for (int a = 0; a < 2; ++a)
#pragma unroll
            for (int b = 0; b < 2; ++b)
#pragma unroll
                for (int m = 0; m < 4; ++m)
#pragma unroll
                    for (int n = 0; n < 2; ++n) acc[a][b][m][n] = (f32x4){0.f, 0.f, 0.f, 0.f};
        cur = nxt; cA = nA; cB = nB; ++ui;
        if (wr == 1) PG8_BAR;
    }
    PG8_WAIT_V(0);
    PG8_BAR;
#undef PG8_SA
#undef PG8_SB
#undef PG8_STAGE
#undef PG8_LDA
#undef PG8_LDB
#undef PG8_MMA
#undef PG8_WAIT_V
#undef PG8_WAIT_L
#undef PG8_BAR
#undef PG8_SCHED
}
}
struct Frame {
    LAS unsigned char* lds;
    int tid, lane, wave, vcu, G, vb;
    unsigned char* ws;
    const float* in[18];
    float* out;
};
#define WSP(T, off) ((T*)(F.ws + (off)))

__device__ __forceinline__ void conv_item(const float* W, int ldn, int srccol0, int k0, const float* gain, bf16_t* WT, int K, int dstrow0, LAS float* scr, int lane) {
    float v[32];
    const float* wp = W + (size_t)(k0 + (lane >> 5)) * ldn + srccol0 + (lane & 31);
#pragma unroll
    for (int i = 0; i < 32; ++i) v[i] = wp[(size_t)(2 * i) * ldn];
    const int c = lane & 7;
    float gn[8];
#pragma unroll
    for (int e = 0; e < 8; ++e) gn[e] = gain ? gain[k0 + 8 * c + e] : 1.0f;
#pragma unroll
    for (int i = 0; i < 32; ++i) scr[(2 * i + (lane >> 5)) * 33 + (lane & 31)] = v[i];
    LDS_WAIT(); asm volatile("" ::: "memory");
#pragma unroll
    for (int j = 0; j < 4; ++j) { const int n = (lane >> 3) + 8 * j; const LAS float* s = scr + (8 * c) * 33 + n;
        u32x4 o; o.x = cvt_pk_bf16(s[0 * 33] * gn[0], s[1 * 33] * gn[1]); o.y = cvt_pk_bf16(s[2 * 33] * gn[2], s[3 * 33] * gn[3]);
        o.z = cvt_pk_bf16(s[4 * 33] * gn[4], s[5 * 33] * gn[5]); o.w = cvt_pk_bf16(s[6 * 33] * gn[6], s[7 * 33] * gn[7]);
        *(u32x4*)(WT + (size_t)(dstrow0 + n) * K + k0 + 8 * c) = o; }
    LDS_WAIT(); asm volatile("" ::: "memory");
}
struct ConvJob { const float* W; int ldn, K, N, col0, kind; const float* gain; bf16_t* WT; };
__device__ __forceinline__ int conv_items(const ConvJob& J) { return (J.K / 64) * (J.N / 32); }
__device__ __forceinline__ void conv_run(const ConvJob& J, int item, LAS float* scr, int lane) {
    const int nblk = J.N / 32, kb = item / nblk, nb = item % nblk; const int n0 = 32 * nb;
    int src;
    if (J.kind == 0) src = J.col0 + n0; else { const int u = n0 >> 8, j = n0 & 255; src = (j < 128) ? u * 128 + j : 2816 + u * 128 + (j - 128); }
    conv_item(J.W, J.ldn, src, 64 * kb, J.gain, J.WT, J.K, n0, scr, lane);
}
__device__ __forceinline__ int conv_job(Frame& F, const ConvJob& J, int base, int gw, int ngw) {
    LAS float* scr = (LAS float*)(F.lds + F.wave * 16384);
    const int n = conv_items(J);
    const int first = (gw - base % ngw + ngw) % ngw;
    for (int it = first; it < n; it += ngw) conv_run(J, it, scr, F.lane);
    return base + n;
}
__device__ __forceinline__ ConvJob job_ffn_in(Frame& F, int layer, int which  , size_t dst) {
    ConvJob J; J.W = F.in[which ? 7 : 3] + (size_t)layer * D * 2 * DFF; J.ldn = 2 * DFF; J.K = D; J.N = 2 * DFF; J.col0 = 0; J.kind = 1; J.gain = F.in[which ? 6 : 2] + layer * D; J.WT = WSP(bf16_t, dst); return J; }
__device__ __forceinline__ ConvJob job_ffn_out(Frame& F, int layer, int which, size_t dst) {
    ConvJob J; J.W = F.in[which ? 8 : 4] + (size_t)layer * DFF * D; J.ldn = D; J.K = DFF; J.N = D; J.col0 = 0; J.kind = 0; J.gain = nullptr; J.WT = WSP(bf16_t, dst); return J; }

struct EpiSwiglu {
    const float* SS; bf16_t* ACT;
    __device__ __forceinline__ void operator()(const f32x4 (&acc)[2][2][4][2], const pg8::Unit& u, int wr, int wc, int fr, int fq) const {
#pragma unroll
        for (int ai = 0; ai < 2; ++ai)
#pragma unroll
            for (int m = 0; m < 4; ++m) {
                const int row = u.pm * 256 + ai * 128 + wr * 64 + m * 16 + fr; const float rs = row_rstd(SS, row);
                float v[8];
#pragma unroll
                for (int n = 0; n < 2; ++n)
#pragma unroll
                    for (int j = 0; j < 4; ++j) { const float g = acc[ai][0][m][n][j] * rs, up = acc[ai][1][m][n][j] * rs; v[4 * n + j] = fsilu(g) * up; }
                u32x4 w; w.x = cvt_pk_bf16(v[0], v[1]); w.y = cvt_pk_bf16(v[2], v[3]); w.z = cvt_pk_bf16(v[4], v[5]); w.w = cvt_pk_bf16(v[6], v[7]);
                *(u32x4*)(ACT + (size_t)row * DFF + u.pn * 128 + wc * 32 + 8 * fq) = w;
            }
    }
};
template <bool BASE_F32> struct EpiResid {
    const float* xbase; bf16_t* HB; float* SS; float alpha;
    __device__ __forceinline__ void operator()(const f32x4 (&acc)[2][2][4][2], const pg8::Unit& u, int wr, int wc, int fr, int fq) const {
#pragma unroll
        for (int ai = 0; ai < 2; ++ai)
#pragma unroll
            for (int m = 0; m < 4; ++m) {
                const int row = u.pm * 256 + ai * 128 + wr * 64 + m * 16 + fr; float ss = 0.f;
#pragma unroll
                for (int bj = 0; bj < 2; ++bj) {
                    const size_t off = (size_t)row * D + u.pn * 256 + bj * 128 + wc * 32 + 8 * fq;
                    f32x4 b0, b1;
                    if (BASE_F32) { b0 = *(const f32x4*)(xbase + off); b1 = *(const f32x4*)(xbase + off + 4); }
                    else { const u32x4 hv = *(const u32x4*)(HB + off); b0 = (f32x4){bf_lo(hv.x), bf_hi(hv.x), bf_lo(hv.y), bf_hi(hv.y)}; b1 = (f32x4){bf_lo(hv.z), bf_hi(hv.z), bf_lo(hv.w), bf_hi(hv.w)}; }
                    const f32x4 v0 = b0 + acc[ai][bj][m][0] * alpha, v1 = b1 + acc[ai][bj][m][1] * alpha;
                    u32x4 w; w.x = cvt_pk_bf16(v0[0], v0[1]); w.y = cvt_pk_bf16(v0[2], v0[3]); w.z = cvt_pk_bf16(v1[0], v1[1]); w.w = cvt_pk_bf16(v1[2], v1[3]);
                    *(u32x4*)(HB + off) = w;
                    ss += (v0[0] * v0[0] + v0[1] * v0[1]) + (v0[2] * v0[2] + v0[3] * v0[3]) + (v1[0] * v1[0] + v1[1] * v1[1]) + (v1[2] * v1[2] + v1[3] * v1[3]);
                }
                ss += __shfl_xor(ss, 16); ss += __shfl_xor(ss, 32);
                if (fq == 0) SS[(size_t)row * 16 + u.pn * 4 + wc] = ss;
            }
    }
};
struct EpiRetIn {
    const float* SS; bf16_t* QH; bf16_t* KH; bf16_t* VT;
    __device__ __forceinline__ void operator()(const f32x4 (&acc)[2][2][4][2], const pg8::Unit& u, int wr, int wc, int fr, int fq) const {
        if (u.pn < 8) {
            const bool isq = u.pn < 4; const int head = u.pn & 3; bf16_t* dst = isq ? QH : KH;
            const float l2g = isq ? L2G[head] : -L2G[head], sc = isq ? 1.0f : 0.0625f;
            float inv[8];
#pragma unroll
            for (int e = 0; e < 8; ++e) inv[e] = ROPE_INV[wc * 32 + 8 * fq + e];
#pragma unroll
            for (int ai = 0; ai < 2; ++ai)
#pragma unroll
                for (int m = 0; m < 4; ++m) {
                    const int row = u.pm * 256 + ai * 128 + wr * 64 + m * 16 + fr; const float rs = row_rstd(SS, row);
                    const int b = row >> 13, t = row & 8191; const float pos = (float)(t + NMETA);
                    const float dec = __builtin_amdgcn_exp2f((float)((t & 31) + 1) * l2g) * sc * rs;
                    float o1[8], o2[8];
#pragma unroll
                    for (int n = 0; n < 2; ++n)
#pragma unroll
                        for (int j = 0; j < 4; ++j) { const int e = 4 * n + j;
                            const float rev = (pos * inv[e]) * 0.15915494309189535f; const float frc = rev - floorf(rev);
                            const float sn = __builtin_amdgcn_sinf(frc), cs = __builtin_amdgcn_cosf(frc);
                            const float t1 = acc[ai][0][m][n][j], t2 = acc[ai][1][m][n][j];
                            o1[e] = (t1 * cs - t2 * sn) * dec; o2[e] = (t1 * sn + t2 * cs) * dec; }
                    bf16_t* p = dst + ((size_t)(b * 4 + head) * SEQ + t) * 256 + wc * 32 + 8 * fq;
                    u32x4 w; w.x = cvt_pk_bf16(o1[0], o1[1]); w.y = cvt_pk_bf16(o1[2], o1[3]); w.z = cvt_pk_bf16(o1[4], o1[5]); w.w = cvt_pk_bf16(o1[6], o1[7]);
                    *(u32x4*)p = w;
                    w.x = cvt_pk_bf16(o2[0], o2[1]); w.y = cvt_pk_bf16(o2[2], o2[3]); w.z = cvt_pk_bf16(o2[4], o2[5]); w.w = cvt_pk_bf16(o2[6], o2[7]);
                    *(u32x4*)(p + 128) = w;
                }
        } else {
            float rs[2][8];
#pragma unroll
            for (int bj = 0; bj < 2; ++bj)
#pragma unroll
                for (int e = 0; e < 8; ++e) rs[bj][e] = row_rstd(SS, u.pm * 256 + bj * 128 + wc * 32 + 8 * fq + e);
            const int b = u.pm >> 5, t0 = (u.pm & 31) * 256;
#pragma unroll
            for (int ai = 0; ai < 2; ++ai)
#pragma unroll
                for (int m = 0; m < 4; ++m) {
                    const int vc = (u.pn - 8) * 256 + ai * 128 + wr * 64 + m * 16 + fr; const int head = vc >> 9, dvi = vc & 511;
                    bf16_t* p = VT + ((size_t)(b * 4 + head) * 512 + dvi) * SEQ + t0 + wc * 32 + 8 * fq;
#pragma unroll
                    for (int bj = 0; bj < 2; ++bj) {
                        const f32x4 v0 = acc[ai][bj][m][0], v1 = acc[ai][bj][m][1];
                        u32x4 w; w.x = cvt_pk_bf16(v0[0] * rs[bj][0], v0[1] * rs[bj][1]); w.y = cvt_pk_bf16(v0[2] * rs[bj][2], v0[3] * rs[bj][3]);
                        w.z = cvt_pk_bf16(v1[0] * rs[bj][4], v1[1] * rs[bj][5]); w.w = cvt_pk_bf16(v1[2] * rs[bj][6], v1[3] * rs[bj][7]);
                        *(u32x4*)(p + bj * 128) = w;
                    }
                }
        }
    }
};
template <int DV, int LDO> struct EpiGate {
    const float* SS; const bf16_t* O; bf16_t* Y; LAS float* RO;
    __device__ __forceinline__ void operator()(const f32x4 (&acc)[2][2][4][2], const pg8::Unit& u, int wr, int wc, int fr, int fq) const {
        const int wid = wr * 4 + wc, lane = fq * 16 + fr; const int head = (u.pn * 256) / DV;
        {   const bf16_t* ob = O + (size_t)(u.pm * 256 + wid * 32) * LDO + head * DV;
#pragma unroll
            for (int i0 = 0; i0 < 32; i0 += 8) { float sv[8];
#pragma unroll
                for (int i = 0; i < 8; ++i) { float s;
                    if (DV == 512) { const u32x4 v = *(const u32x4*)(ob + (size_t)(i0 + i) * LDO + lane * 8);
                        const float a0 = bf_lo(v.x), a1 = bf_hi(v.x), a2 = bf_lo(v.y), a3 = bf_hi(v.y), a4 = bf_lo(v.z), a5 = bf_hi(v.z), a6 = bf_lo(v.w), a7 = bf_hi(v.w);
                        s = ((a0 * a0 + a1 * a1) + (a2 * a2 + a3 * a3)) + ((a4 * a4 + a5 * a5) + (a6 * a6 + a7 * a7)); }
                    else { const u32x2 v = *(const u32x2*)(ob + (size_t)(i0 + i) * LDO + lane * 4);
                        const float a0 = bf_lo(v.x), a1 = bf_hi(v.x), a2 = bf_lo(v.y), a3 = bf_hi(v.y); s = (a0 * a0 + a1 * a1) + (a2 * a2 + a3 * a3); }
                    sv[i] = s; }
#pragma unroll
                for (int i = 0; i < 8; ++i) { const float t = wave_sum(sv[i]); if (lane == 0) RO[wid * 32 + i0 + i] = 1.0f / sqrtf(t * (1.0f / (float)DV) + 1e-6f); } }
            LDS_WAIT(); __builtin_amdgcn_s_barrier(); asm volatile("" ::: "memory"); }
#pragma unroll
        for (int ai = 0; ai < 2; ++ai)
#pragma unroll
            for (int m = 0; m < 4; ++m) {
                const int rl = ai * 128 + wr * 64 + m * 16 + fr, row = u.pm * 256 + rl; const float rs = row_rstd(SS, row); const float ro = RO[rl];
#pragma unroll
                for (int bj = 0; bj < 2; ++bj) {
                    const int col = u.pn * 256 + bj * 128 + wc * 32 + 8 * fq;
                    const u32x4 ov = *(const u32x4*)(O + (size_t)row * LDO + col);
                    const f32x4 g0 = acc[ai][bj][m][0] * rs, g1 = acc[ai][bj][m][1] * rs;
                    u32x4 w;
                    w.x = cvt_pk_bf16(bf_lo(ov.x) * ro * fsilu(g0[0]), bf_hi(ov.x) * ro * fsilu(g0[1]));
                    w.y = cvt_pk_bf16(bf_lo(ov.y) * ro * fsilu(g0[2]), bf_hi(ov.y) * ro * fsilu(g0[3]));
                    w.z = cvt_pk_bf16(bf_lo(ov.z) * ro * fsilu(g1[0]), bf_hi(ov.z) * ro * fsilu(g1[1]));
                    w.w = cvt_pk_bf16(bf_lo(ov.w) * ro * fsilu(g1[2]), bf_hi(ov.w) * ro * fsilu(g1[3]));
                    *(u32x4*)(Y + (size_t)row * LDO + col) = w;
                }
            }
        asm volatile("" ::: "memory"); __builtin_amdgcn_s_barrier(); asm volatile("" ::: "memory");
    }
};
struct EpiGlaIn {
    const float* SS; const float* BC; bf16_t* QH; bf16_t* KH; bf16_t* VT;
    __device__ __forceinline__ void operator()(const f32x4 (&acc)[2][2][4][2], const pg8::Unit& u, int wr, int wc, int fr, int fq) const {
        if (u.pn < 4) {
            const bool isq = u.pn < 2; bf16_t* dst = isq ? QH : KH;
#pragma unroll
            for (int ai = 0; ai < 2; ++ai)
#pragma unroll
                for (int m = 0; m < 4; ++m) {
                    const int row = u.pm * 256 + ai * 128 + wr * 64 + m * 16 + fr; const float rs = row_rstd(SS, row) * (isq ? 0.08838834764831845f : 1.0f);
                    const int b = row >> 13, t = row & 8191;
#pragma unroll
                    for (int bj = 0; bj < 2; ++bj) {
                        const int cq = (u.pn & 1) * 256 + bj * 128 + wc * 32 + 8 * fq; const int head = cq >> 7, d = cq & 127;
                        const f32x4 c0 = *(const f32x4*)(BC + (size_t)row * 512 + cq), c1 = *(const f32x4*)(BC + (size_t)row * 512 + cq + 4);
                        float v[8];
#pragma unroll
                        for (int j = 0; j < 4; ++j) { v[j] = acc[ai][bj][m][0][j] * rs * __expf(isq ? c0[j] : -c0[j]); v[4 + j] = acc[ai][bj][m][1][j] * rs * __expf(isq ? c1[j] : -c1[j]); }
                        u32x4 w; w.x = cvt_pk_bf16(v[0], v[1]); w.y = cvt_pk_bf16(v[2], v[3]); w.z = cvt_pk_bf16(v[4], v[5]); w.w = cvt_pk_bf16(v[6], v[7]);
                        *(u32x4*)(dst + ((size_t)(b * 4 + head) * SEQ + t) * 128 + d) = w;
                    }
                }
        } else {
            float rs[2][8];
#pragma unroll
            for (int bj = 0; bj < 2; ++bj)
#pragma unroll
                for (int e = 0; e < 8; ++e) rs[bj][e] = row_rstd(SS, u.pm * 256 + bj * 128 + wc * 32 + 8 * fq + e);
            const int b = u.pm >> 5, t0 = (u.pm & 31) * 256; const int head = u.pn - 4;
#pragma unroll
            for (int ai = 0; ai < 2; ++ai)
#pragma unroll
                for (int m = 0; m < 4; ++m) {
                    const int dvi = ai * 128 + wr * 64 + m * 16 + fr;
                    bf16_t* p = VT + ((size_t)(b * 4 + head) * 256 + dvi) * SEQ + t0 + wc * 32 + 8 * fq;
#pragma unroll
                    for (int bj = 0; bj < 2; ++bj) {
                        const f32x4 v0 = acc[ai][bj][m][0], v1 = acc[ai][bj][m][1];
                        u32x4 w; w.x = cvt_pk_bf16(v0[0] * rs[bj][0], v0[1] * rs[bj][1]); w.y = cvt_pk_bf16(v0[2] * rs[bj][2], v0[3] * rs[bj][3]);
                        w.z = cvt_pk_bf16(v1[0] * rs[bj][4], v1[1] * rs[bj][5]); w.w = cvt_pk_bf16(v1[2] * rs[bj][6], v1[3] * rs[bj][7]);
                        *(u32x4*)(p + bj * 128) = w;
                    }
                }
        }
    }
};
struct PtrNormal { const char* A; const char* B; size_t tstep;
    __device__ __forceinline__ void ptrs(const pg8::Unit& u, const char*& cA, const char*& cB) const { cA = A + (size_t)u.pm * tstep; cB = B + (size_t)u.pn * tstep; } };
struct PtrSwapFrom { const char* A; const char* B; size_t tstep; int pn_swap;
    __device__ __forceinline__ void ptrs(const pg8::Unit& u, const char*& cA, const char*& cB) const {
        const char* a = A + (size_t)u.pm * tstep; const char* b = B + (size_t)u.pn * tstep;
        if (u.pn >= pn_swap) { cA = b; cB = a; } else { cA = a; cB = b; } } };

constexpr int MA_RS_OFF = 98304, MA_RED_OFF = 100352;
template <int MODE> __device__ __forceinline__ void meta_tiles(Frame& F, const bf16_t* Bt, int N, int K, float* out, int ldo, float alpha, int b0, int nb) {
    const int lane = F.lane, g = lane >> 4, r16 = lane & 15, pitch = K + 8;
    const LAS bf16_t* A = (const LAS bf16_t*)F.lds; const LAS float* rsA = (const LAS float*)(F.lds + MA_RS_OFF); LAS f32x4* red = (LAS f32x4*)(F.lds + MA_RED_OFF);
    const int ksteps = K / 32, per = ksteps / 8;
    for (int tile = F.vb - b0; tile < N / 16; tile += nb) {
        f32x4 acc = (f32x4){0.f, 0.f, 0.f, 0.f};
        const bf16_t* bp = Bt + (size_t)(tile * 16 + r16) * K + 8 * g;
        for (int ks = F.wave * per; ks < (F.wave + 1) * per; ++ks) {
            const bf16x8 a = *(const LAS bf16x8*)(A + r16 * pitch + ks * 32 + 8 * g);
            const bf16x8 b = *(const bf16x8*)(bp + ks * 32);
            acc = __builtin_amdgcn_mfma_f32_16x16x32_bf16(a, b, acc, 0, 0, 0);
        }
        red[F.wave * 64 + lane] = acc;
        __syncthreads();
        if (F.wave == 0) {
            f32x4 s = red[lane];
#pragma unroll
            for (int w = 1; w < 8; ++w) s += red[w * 64 + lane];
#pragma unroll
            for (int j = 0; j < 4; ++j) { const int r = 4 * g + j; float* o = out + (size_t)r * ldo + tile * 16 + r16;
                if (MODE == 0) *o = s[j] * rsA[r]; else *o = *o + alpha * s[j]; }
        }
        __syncthreads();
    }
}
__device__ __forceinline__ bool meta_has_tiles(Frame& F, int N, int b0, int nb) { const int r = F.vb - b0; return r >= 0 && r < nb && r < N / 16; }
__device__ __forceinline__ void meta_prep_h(Frame& F) {
    const float* HM = WSP(float, WS_META + META_HM); LAS bf16_t* A = (LAS bf16_t*)F.lds; LAS float* rsA = (LAS float*)(F.lds + MA_RS_OFF);
    for (int r = F.wave; r < 16; r += 8) { float s = 0.f;
        for (int k = F.lane; k < D; k += 64) { const float v = HM[r * D + k]; s += v * v; A[r * (D + 8) + k] = f2bf(v); }
        s = wave_sum(s); if (F.lane == 0) rsA[r] = 1.0f / sqrtf(s * (1.0f / 1024.0f) + 1e-6f); }
    __syncthreads();
}
__device__ __forceinline__ void meta_prep_act(Frame& F) {
    const float* RAW = WSP(float, WS_META + META_RAW); LAS bf16_t* A = (LAS bf16_t*)F.lds; LAS float* rsA = (LAS float*)(F.lds + MA_RS_OFF);
    for (int i = F.tid; i < 16 * DFF; i += NTHREADS) { const int r = i / DFF, k = i % DFF, u = k >> 7, j = k & 127;
        const float g = RAW[r * 5632 + u * 256 + j], up = RAW[r * 5632 + u * 256 + 128 + j]; A[r * (DFF + 8) + k] = f2bf(fsilu(g) * up); }
    if (F.tid < 16) rsA[F.tid] = 1.f;
    __syncthreads();
}
__device__ __forceinline__ void meta_prep_y(Frame& F) {
    const float* RAW = WSP(float, WS_META + META_RAW); const float* MO = WSP(float, WS_META + META_MO);
    LAS bf16_t* A = (LAS bf16_t*)F.lds; LAS float* rsA = (LAS float*)(F.lds + MA_RS_OFF); LAS float* mro = (LAS float*)(F.lds + MA_RED_OFF);
    for (int p = F.wave; p < 64; p += 8) { const int r = p >> 2, head = p & 3; float sacc = 0.f;
        for (int k = F.lane; k < 512; k += 64) { const float v = MO[r * 2048 + head * 512 + k]; sacc += v * v; }
        sacc = wave_sum(sacc); if (F.lane == 0) mro[p] = 1.0f / sqrtf(sacc * (1.0f / 512.0f) + 1e-6f); }
    __syncthreads();
    for (int i = F.tid; i < 16 * 2048; i += NTHREADS) { const int r = i >> 11, k = i & 2047, head = k >> 9;
        A[r * (2048 + 8) + k] = f2bf(MO[r * 2048 + k] * mro[r * 4 + head] * fsilu(RAW[r * 6144 + 4096 + k])); }
    if (F.tid < 16) rsA[F.tid] = 1.f;
    __syncthreads();
}

__device__ __forceinline__ void meta_tiles_ksplit(Frame& F, const bf16_t* Bt, int K, int KQ, float* out, float alpha) {
    const int lane = F.lane, g = lane >> 4, r16 = lane & 15, pitch = KQ + 8;
    const LAS bf16_t* A = (const LAS bf16_t*)F.lds; LAS f32x4* red = (LAS f32x4*)(F.lds + MA_RED_OFF);
    const int item = F.vb; if (item >= 256) return;
    const int tile = item >> 2, kq = item & 3, nks = KQ / 32;
    f32x4 acc = (f32x4){0.f, 0.f, 0.f, 0.f};
    const bf16_t* bp = Bt + (size_t)(tile * 16 + r16) * K + kq * KQ + 8 * g;
    for (int ks = F.wave; ks < nks; ks += 8) {
        const bf16x8 a = *(const LAS bf16x8*)(A + r16 * pitch + ks * 32 + 8 * g);
        const bf16x8 b = *(const bf16x8*)(bp + ks * 32);
        acc = __builtin_amdgcn_mfma_f32_16x16x32_bf16(a, b, acc, 0, 0, 0);
    }
    red[F.wave * 64 + lane] = acc;
    __syncthreads();
    if (F.wave == 0) { f32x4 sacc = red[lane];
#pragma unroll
        for (int w = 1; w < 8; ++w) sacc += red[w * 64 + lane];
#pragma unroll
        for (int j = 0; j < 4; ++j) atomicAdd(out + (size_t)(4 * g + j) * D + tile * 16 + r16, alpha * sacc[j]); }
    __syncthreads();
}
__device__ __forceinline__ void meta_prep_act_q(Frame& F) {
    const float* RAW = WSP(float, WS_META + META_RAW); LAS bf16_t* A = (LAS bf16_t*)F.lds; const int kq = F.vb & 3;
    for (int i = F.tid; i < 16 * 704; i += NTHREADS) { const int r = i / 704, kk = i % 704, k = kq * 704 + kk, u = k >> 7, j = k & 127;
        const float gt = RAW[r * 5632 + u * 256 + j], up = RAW[r * 5632 + u * 256 + 128 + j]; A[r * (704 + 8) + kk] = f2bf(fsilu(gt) * up); }
    __syncthreads();
}
__device__ __forceinline__ void meta_prep_y_q(Frame& F) {
    const float* RAW = WSP(float, WS_META + META_RAW); const float* MO = WSP(float, WS_META + META_MO);
    LAS bf16_t* A = (LAS bf16_t*)F.lds; LAS float* mro = (LAS float*)(F.lds + MA_RED_OFF); const int head = F.vb & 3;
    for (int r = F.wave; r < 16; r += 8) { float sacc = 0.f;
        for (int k = F.lane; k < 512; k += 64) { const float v = MO[r * 2048 + head * 512 + k]; sacc += v * v; }
        sacc = wave_sum(sacc); if (F.lane == 0) mro[r] = 1.0f / sqrtf(sacc * (1.0f / 512.0f) + 1e-6f); }
    __syncthreads();
    for (int i = F.tid; i < 16 * 512; i += NTHREADS) { const int r = i >> 9, kk = i & 511, k = head * 512 + kk;
        A[r * (512 + 8) + kk] = f2bf(MO[r * 2048 + k] * mro[r] * fsilu(RAW[r * 6144 + 4096 + k])); }
    __syncthreads();
}
__device__ __forceinline__ void z_phase(Frame& F, const bf16_t* HB, const float* SS, const bf16_t* WZ, const float* wg, const float* bg, float* BC) {
    LAS float* zpart = (LAS float*)F.lds;
    LAS float* zs = (LAS float*)(F.lds + 8192);
    const int lane = F.lane, g = lane >> 4, r16 = lane & 15;
    for (int cidx = blockIdx.x; cidx < M / 64; cidx += F.G) {
        const int row0 = cidx * 64;
        { const int tile = F.wave & 3, kh = F.wave >> 2; f32x4 acc = (f32x4){0.f, 0.f, 0.f, 0.f};
          const bf16_t* ap = HB + (size_t)(row0 + tile * 16 + r16) * D + 8 * g; const bf16_t* bp = WZ + (size_t)r16 * D + 8 * g;
#pragma unroll 4
          for (int ks = kh * 16; ks < kh * 16 + 16; ++ks) {
              const bf16x8 a = *(const bf16x8*)(ap + ks * 32), b = *(const bf16x8*)(bp + ks * 32);
              acc = __builtin_amdgcn_mfma_f32_16x16x32_bf16(a, b, acc, 0, 0, 0);
          }
#pragma unroll
          for (int j = 0; j < 4; ++j) zpart[(kh * 64 + tile * 16 + 4 * g + j) * 16 + r16] = acc[j]; }
        __syncthreads();
        for (int i = F.tid; i < 64 * 16; i += NTHREADS) { const int t = i >> 4; zs[i] = (zpart[i] + zpart[1024 + i]) * row_rstd(SS, row0 + t); }
        __syncthreads();
        { const int c = F.tid; float w[16];
#pragma unroll
          for (int r = 0; r < 16; ++r) w[r] = wg[r * 512 + c];
          const float bias = bg[c]; float cum = 0.f;
          for (int t = 0; t < 64; ++t) { float a = bias; if (t == 32) cum = 0.f;
#pragma unroll
              for (int r = 0; r < 16; ++r) a += zs[t * 16 + r] * w[r];
              const float ls = fminf(a, 0.f) - __logf(1.0f + __expf(-fabsf(a)));
              cum += ls * 0.0625f; BC[(size_t)(row0 + t) * 512 + c] = cum; } }
        __syncthreads();
    }
}

typedef short v4i16_t __attribute__((ext_vector_type(4)));
__device__ __forceinline__ s16x4 ds_tr_asm(unsigned addr) { s16x4 r; asm volatile("ds_read_b64_tr_b16 %0, %1" : "=v"(r) : "v"(addr) : "memory"); return r; }
__device__ __forceinline__ s16x4 ds_tr(const LAS unsigned char* p) { return __builtin_bit_cast(s16x4, __builtin_amdgcn_ds_read_tr16_b64_v4i16((LAS v4i16_t*)p)); }
template <int DK, int DV, bool GLA>
__device__ __forceinline__ void s2_phase(Frame& F, const bf16_t* QH, const bf16_t* KH, const bf16_t* VT, bf16_t* O, float* OSS, const float* BC, int ldraw) {
    constexpr int NS = DV / 16, ROWB = DK * 2, TILEB = 64 * ROWB, NI = TILEB / 1024 / 8, NT = DK / 128, LDO = 4 * DV;
    constexpr int LQ = 0, LK = 2 * TILEB, LV = 4 * TILEB, LP = LV + 4096, LS = LP + 8192, LDEC = LS + 2 * 16 * ROWB;
    static_assert(LDEC + 2 * DK * 4 <= LDS_MISC, "S2 LDS map");
    const int unit = blockIdx.x; if (unit >= 8 * NS) return;
    const int bh = unit & 7, s = unit >> 3, b = bh >> 2, h = bh & 3;
    const int lane = F.lane, g = lane >> 4, r16 = lane & 15, w = F.wave;
    LAS unsigned char* L = F.lds; const unsigned Lb = (unsigned)(uintptr_t)L;
    const float* RAW = WSP(float, WS_META + META_RAW);
    for (int i = F.tid * 16; i < TILEB; i += NTHREADS * 16) { *(LAS u32x4*)(L + LQ + i) = (u32x4){0, 0, 0, 0}; *(LAS u32x4*)(L + LK + i) = (u32x4){0, 0, 0, 0}; }
    for (int i = F.tid * 16; i < 2048; i += NTHREADS * 16) *(LAS u32x4*)(L + LV + i) = (u32x4){0, 0, 0, 0};
    for (int i = F.tid * 16; i < 16 * ROWB; i += NTHREADS * 16) *(LAS u32x4*)(L + LS + i) = (u32x4){0, 0, 0, 0};
    __syncthreads();
    if (!GLA) {
        for (int idx = F.tid; idx < 16 * 128; idx += NTHREADS) { const int j = idx >> 7, c = idx & 127, row = 48 + j;
            const float* rq = RAW + (size_t)j * ldraw + h * 256; const float* rk = rq + 1024;
            const float rev = ((float)j * ROPE_INV[c]) * 0.15915494309189535f; const float frc = rev - floorf(rev);
            const float sn = __builtin_amdgcn_sinf(frc), cs = __builtin_amdgcn_cosf(frc);
            const float dq = __builtin_amdgcn_exp2f((float)(row + 1) * L2G[h]), dk = 0.0625f * __builtin_amdgcn_exp2f(-(float)(row + 1) * L2G[h]);
            const float q1 = rq[c], q2 = rq[c + 128], k1 = rk[c], k2 = rk[c + 128];
            const int a1 = row * ROWB + ((((c >> 3)) ^ (row & 15)) << 4) + (c & 7) * 2, a2 = row * ROWB + ((((c + 128) >> 3) ^ (row & 15)) << 4) + (c & 7) * 2;
            *(LAS bf16_t*)(L + LQ + a1) = f2bf((q1 * cs - q2 * sn) * dq); *(LAS bf16_t*)(L + LQ + a2) = f2bf((q1 * sn + q2 * cs) * dq);
            *(LAS bf16_t*)(L + LK + a1) = f2bf((k1 * cs - k2 * sn) * dk); *(LAS bf16_t*)(L + LK + a2) = f2bf((k1 * sn + k2 * cs) * dk); }
        if (F.tid < 256) { const int j = F.tid >> 4, wv = F.tid & 15, tok = 48 + j;
            *(LAS bf16_t*)(L + LV + wv * 128 + (((tok >> 3) ^ ((wv >> 1) & 7)) << 4) + (tok & 7) * 2) = f2bf(RAW[(size_t)j * ldraw + 2048 + h * 512 + 16 * s + wv]); }
    } else {
        if (F.tid < 128) { const int d = F.tid; const float* wgp = F.in[13] + h * 128 + d; const float bias = F.in[14][h * 128 + d]; float cum = 0.f;
            for (int j = 0; j < 16; ++j) { float a = bias;
                for (int r = 0; r < 16; ++r) a += RAW[(size_t)j * ldraw + 3072 + r] * wgp[r * 512];
                cum += (fminf(a, 0.f) - __logf(1.0f + __expf(-fabsf(a)))) * 0.0625f;
                const int row = 48 + j;
                *(LAS bf16_t*)(L + LK + row * ROWB + (((d >> 3) ^ (row & 15)) << 4) + (d & 7) * 2) = f2bf(RAW[(size_t)j * ldraw + 512 + h * 128 + d] * __expf(-cum)); }
            *(LAS float*)(L + LDEC + d * 4) = __expf(cum); }
        if (F.tid >= 256) { const int j = (F.tid - 256) >> 4, wv = F.tid & 15, tok = 48 + j;
            *(LAS bf16_t*)(L + LV + wv * 128 + (((tok >> 3) ^ ((wv >> 1) & 7)) << 4) + (tok & 7) * 2) = f2bf(RAW[(size_t)j * ldraw + 1024 + h * 256 + 16 * s + wv]); }
    }
    f32x4 S[NT];
#pragma unroll
    for (int tt = 0; tt < NT; ++tt) S[tt] = (f32x4){0.f, 0.f, 0.f, 0.f};
    const float g64 = GLA ? 1.0f : __builtin_amdgcn_exp2f(64.0f * L2G[h]);
    const char* Qg = (const char*)(QH + (size_t)bh * SEQ * DK); const char* Kg = (const char*)(KH + (size_t)bh * SEQ * DK);
    const char* Vg = (const char*)(VT + ((size_t)bh * DV + 16 * s) * SEQ);
    __syncthreads();
    for (int c = 0; c <= 128; ++c) {
        const int buf = c & 1;
        if (c < 128) {
            const char* qc = Qg + (size_t)c * TILEB; const char* kc = Kg + (size_t)c * TILEB;
#pragma unroll
            for (int i = 0; i < NI; ++i) { const int piece = w * NI + i, off = piece * 1024 + lane * 16, row = off / ROWB, p = (off % ROWB) >> 4; const int so = row * ROWB + ((p ^ (row & 15)) << 4);
                __builtin_amdgcn_global_load_lds((const unsigned*)(qc + so), (LAS unsigned*)(L + LQ + (buf ^ 1) * TILEB + piece * 1024), 16, 0, 0);
                __builtin_amdgcn_global_load_lds((const unsigned*)(kc + so), (LAS unsigned*)(L + LK + (buf ^ 1) * TILEB + piece * 1024), 16, 0, 0); }
            if (w < 2) { const int off = w * 1024 + lane * 16, wv = off >> 7, p = (off & 127) >> 4;
                __builtin_amdgcn_global_load_lds((const unsigned*)(Vg + (size_t)wv * SEQ * 2 + (size_t)c * 128 + ((p ^ ((wv >> 1) & 7)) << 4)), (LAS unsigned*)(L + LV + (buf ^ 1) * 2048 + w * 1024), 16, 0, 0); }
        }
        { const int ti = w >> 1, tj0 = 2 * (w & 1); f32x4 pt0 = (f32x4){0.f, 0.f, 0.f, 0.f}, pt1 = pt0;
          const int qrow = 16 * ti + r16, kr0 = 16 * tj0 + r16, kr1 = kr0 + 16;
          const LAS unsigned char* qb = L + LQ + buf * TILEB + qrow * ROWB; const LAS unsigned char* kb0 = L + LK + buf * TILEB + kr0 * ROWB; const LAS unsigned char* kb1 = L + LK + buf * TILEB + kr1 * ROWB;
#pragma unroll
          for (int ks = 0; ks < DK / 32; ++ks) { const int ch = ((4 * ks + g) ^ r16) << 4;
              const bf16x8 qf = *(const LAS bf16x8*)(qb + ch), k0 = *(const LAS bf16x8*)(kb0 + ch), k1 = *(const LAS bf16x8*)(kb1 + ch);
              pt0 = __builtin_amdgcn_mfma_f32_16x16x32_bf16(k0, qf, pt0, 0, 0, 0); pt1 = __builtin_amdgcn_mfma_f32_16x16x32_bf16(k1, qf, pt1, 0, 0, 0); }
          const int i = qrow;
#pragma unroll
          for (int tjj = 0; tjj < 2; ++tjj) { const f32x4 pt = tjj ? pt1 : pt0; const int tj = tj0 + tjj, j0 = 16 * tj + 4 * g;
              const float v0 = (j0 + 0 <= i) ? pt[0] : 0.f, v1 = (j0 + 1 <= i) ? pt[1] : 0.f, v2 = (j0 + 2 <= i) ? pt[2] : 0.f, v3 = (j0 + 3 <= i) ? pt[3] : 0.f;
              u32x2 pk; pk.x = cvt_pk_bf16(v0, v1); pk.y = cvt_pk_bf16(v2, v3);
              *(LAS u32x2*)(L + LP + i * 128 + (((2 * tj + (g >> 1)) ^ ((i >> 1) & 7)) << 4) + (g & 1) * 8) = pk; } }
        LDS_WAIT(); __builtin_amdgcn_s_barrier(); asm volatile("" ::: "memory");
        if (w < 4) { const int irow = 16 * w + r16; f32x4 ot = (f32x4){0.f, 0.f, 0.f, 0.f};
#pragma unroll
            for (int ks = 0; ks < 2; ++ks) {
                const bf16x8 va = *(const LAS bf16x8*)(L + LV + buf * 2048 + r16 * 128 + (((4 * ks + g) ^ ((r16 >> 1) & 7)) << 4));
                const bf16x8 pb = *(const LAS bf16x8*)(L + LP + irow * 128 + (((4 * ks + g) ^ ((irow >> 1) & 7)) << 4));
                ot = __builtin_amdgcn_mfma_f32_16x16x32_bf16(va, pb, ot, 0, 0, 0); }
#pragma unroll
            for (int ks = 0; ks < DK / 32; ++ks) { const int ch = ((4 * ks + g) ^ r16) << 4;
                const bf16x8 sa = *(const LAS bf16x8*)(L + LS + buf * 16 * ROWB + r16 * ROWB + ch);
                const bf16x8 qb = *(const LAS bf16x8*)(L + LQ + buf * TILEB + irow * ROWB + ch);
                ot = __builtin_amdgcn_mfma_f32_16x16x32_bf16(sa, qb, ot, 0, 0, 0); }
            float ss = (ot[0] * ot[0] + ot[1] * ot[1]) + (ot[2] * ot[2] + ot[3] * ot[3]);
            ss += __shfl_xor(ss, 16); ss += __shfl_xor(ss, 32);
            if (c >= 1) { const size_t grow = (size_t)b * SEQ + (c - 1) * 64 + irow;
                u32x2 pk; pk.x = cvt_pk_bf16(ot[0], ot[1]); pk.y = cvt_pk_bf16(ot[2], ot[3]);
                *(u32x2*)(O + grow * LDO + h * DV + 16 * s + 4 * g) = pk;
                if (g == 0) atomicAdd(OSS + grow * 4 + h, ss);
            } else if (!GLA && b == 0 && irow >= 48) { float* MO = WSP(float, WS_META + META_MO); float* MOSS = WSP(float, WS_CTL + CTL_MOSS);
                *(f32x4*)(MO + (size_t)(irow - 48) * 2048 + h * 512 + 16 * s + 4 * g) = ot;
                if (g == 0) atomicAdd(MOSS + (irow - 48) * 4 + h, ss); } }
        {
#pragma unroll
          for (int ks = 0; ks < 2; ++ks) {
              const bf16x8 vb = *(const LAS bf16x8*)(L + LV + buf * 2048 + r16 * 128 + (((4 * ks + g) ^ ((r16 >> 1) & 7)) << 4));
#pragma unroll
              for (int tt = 0; tt < NT; ++tt) { const int d0 = 16 * (w + 8 * tt), dcol = d0 + 4 * (r16 & 3), chunk = dcol >> 3, sub = (dcol & 7) * 2;
                  const int r1 = 32 * ks + 8 * g + (r16 >> 2), r2 = r1 + 4;
                  const s16x4 lo = ds_tr(L + LK + buf * TILEB + r1 * ROWB + ((chunk ^ (r1 & 15)) << 4) + sub);
                  const s16x4 hi = ds_tr(L + LK + buf * TILEB + r2 * ROWB + ((chunk ^ (r2 & 15)) << 4) + sub);
                  const bf16x8 ka = (bf16x8){lo[0], lo[1], lo[2], lo[3], hi[0], hi[1], hi[2], hi[3]};
                  S[tt] = __builtin_amdgcn_mfma_f32_16x16x32_bf16(ka, vb, S[tt], 0, 0, 0); } }
#pragma unroll
          for (int tt = 0; tt < NT; ++tt) { const int tile = w + 8 * tt;
              if (GLA) { const f32x4 dc = *(const LAS f32x4*)(L + LDEC + buf * DK * 4 + (16 * tile + 4 * g) * 4); S[tt] = S[tt] * dc; } else S[tt] = S[tt] * g64;
              u32x2 pk; pk.x = cvt_pk_bf16(S[tt][0], S[tt][1]); pk.y = cvt_pk_bf16(S[tt][2], S[tt][3]);
              *(LAS u32x2*)(L + LS + (buf ^ 1) * 16 * ROWB + r16 * ROWB + (((2 * tile + (g >> 1)) ^ r16) << 4) + (g & 1) * 8) = pk; } }
        if (GLA && c < 128 && F.tid < DK) *(LAS float*)(L + LDEC + (buf ^ 1) * DK * 4 + F.tid * 4) = __expf(BC[(size_t)(b * SEQ + c * 64 + 63) * 512 + h * 128 + F.tid]);
        __syncthreads();
    }
}

__device__ __forceinline__ bf16x8 gload16(const void* p) { bf16x8 r; asm volatile("global_load_dwordx4 %0, %1, off" : "=v"(r) : "v"(p) : "memory"); return r; }
__device__ __forceinline__ void glds_touch(const void* gsrc, unsigned lds_dst) { unsigned keep; asm volatile("s_mov_b32 %0, m0\n\ts_mov_b32 m0, %2\n\ts_nop 0\n\tglobal_load_lds_dword %1, off\n\ts_mov_b32 m0, %0" : "=&s"(keep) : "v"(gsrc), "s"(lds_dst) : "memory"); }
#define S2_WAITV(n) asm volatile("s_waitcnt vmcnt(" #n ")" ::: "memory")
template <int DK, int DV, bool GLA>
__device__ __forceinline__ void s2v2_phase(Frame& F, const bf16_t* QH, const bf16_t* KH, const bf16_t* VT, bf16_t* O, float* OSS, const float* BC, int ldraw) {
    constexpr int NS = DV / 16, ROWB = DK * 2, TILEB = 64 * ROWB, NI = TILEB / 1024 / 8, NT = DK / 128, LDO = 4 * DV, KS = DK / 32;
    constexpr int LK = 0, LV = 3 * TILEB, LDEC = LV + 3 * 2048, LP = LDEC + 3 * 1024, LS = LP + 8192, LOT = LS + 2 * 16 * ROWB, LQM = LOT + 4096, LEND = LQM + 16 * ROWB;
    static_assert(LEND <= LDS_MISC, "S2 LDS map");
    const int unit = blockIdx.x; if (unit >= 8 * NS) return;
    const int bh = unit & 7, s = unit >> 3, b = bh >> 2, h = bh & 3;
    const int lane = F.lane, g = lane >> 4, r16 = lane & 15, w = F.wave, ti = w >> 1, hf = w & 1;
    LAS unsigned char* L = F.lds; const unsigned Lb = (unsigned)(uintptr_t)L;
    const float* RAW = WSP(float, WS_META + META_RAW);
    const char* Qg = (const char*)(QH + (size_t)bh * SEQ * DK); const char* Kg = (const char*)(KH + (size_t)bh * SEQ * DK);
    const char* Vg = (const char*)(VT + ((size_t)bh * DV + 16 * s) * SEQ);
    const char* qlane = Qg + (size_t)(16 * ti + r16) * ROWB + g * 16;
    bf16x8 q0[KS], q1[KS], q2[KS];
#define S2_ISSUE(c_, QSET) do { const int rc_ = (c_) - 1, st_ = (c_) % 3; const char* kc_ = Kg + (size_t)rc_ * TILEB; \
        _Pragma("unroll") for (int i_ = 0; i_ < NI; ++i_) { const int piece_ = w * NI + i_, off_ = piece_ * 1024 + lane * 16, row_ = off_ / ROWB, p_ = (off_ % ROWB) >> 4; \
            __builtin_amdgcn_global_load_lds((const unsigned*)(kc_ + row_ * ROWB + ((p_ ^ (row_ & 15)) << 4)), (LAS unsigned*)(L + LK + st_ * TILEB + piece_ * 1024), 16, 0, 0); } \
        if (w < 2) { const int off_ = w * 1024 + lane * 16, wv_ = off_ >> 7, p_ = (off_ & 127) >> 4; \
            __builtin_amdgcn_global_load_lds((const unsigned*)(Vg + (size_t)wv_ * SEQ * 2 + (size_t)rc_ * 128 + ((p_ ^ ((wv_ >> 1) & 7)) << 4)), (LAS unsigned*)(L + LV + st_ * 2048 + w * 1024), 16, 0, 0); } \
        if (GLA && w == 2) __builtin_amdgcn_global_load_lds((const unsigned*)((const char*)(BC + (size_t)(b * SEQ + rc_ * 64 + 63) * 512 + h * 128) + lane * 16), (LAS unsigned*)(L + LDEC + st_ * 1024), 16, 0, 0); \
        _Pragma("unroll") for (int k_ = 0; k_ < KS; ++k_) QSET[k_] = gload16(qlane + (size_t)rc_ * TILEB + k_ * 64); } while (0)
#define S2_WAIT_PREV() do { if (w < 2 || (GLA && w == 2)) { if (NI + KS + 1 == 13) S2_WAITV(13); else S2_WAITV(7); } else { if (NI + KS == 12) S2_WAITV(12); else S2_WAITV(6); } } while (0)
    static_assert((NI + KS == 12) || (NI + KS == 6), "S2 wait immediates");
    for (int i = F.tid * 16; i < TILEB; i += NTHREADS * 16) *(LAS u32x4*)(L + LK + i) = (u32x4){0, 0, 0, 0};
    for (int i = F.tid * 16; i < 2048; i += NTHREADS * 16) *(LAS u32x4*)(L + LV + i) = (u32x4){0, 0, 0, 0};
    for (int i = F.tid * 16; i < 16 * ROWB; i += NTHREADS * 16) { *(LAS u32x4*)(L + LS + i) = (u32x4){0, 0, 0, 0}; *(LAS u32x4*)(L + LQM + i) = (u32x4){0, 0, 0, 0}; }
    __syncthreads();
    if (!GLA) {
        for (int idx = F.tid; idx < 16 * 128; idx += NTHREADS) { const int j = idx >> 7, c = idx & 127, row = 48 + j;
            const float* rq = RAW + (size_t)j * ldraw + h * 256; const float* rk = rq + 1024;
            const float rev = ((float)j * ROPE_INV[c]) * 0.15915494309189535f; const float frc = rev - floorf(rev);
            const float sn = __builtin_amdgcn_sinf(frc), cs = __builtin_amdgcn_cosf(frc);
            const float dq = __builtin_amdgcn_exp2f((float)(row + 1) * L2G[h]), dk = 0.0625f * __builtin_amdgcn_exp2f(-(float)(row + 1) * L2G[h]);
            const float q1v = rq[c], q2v = rq[c + 128], k1 = rk[c], k2 = rk[c + 128];
            const int a1 = row * ROWB + ((((c >> 3)) ^ (row & 15)) << 4) + (c & 7) * 2, a2 = row * ROWB + ((((c + 128) >> 3) ^ (row & 15)) << 4) + (c & 7) * 2;
            *(LAS bf16_t*)(L + LQM + j * ROWB + c * 2) = f2bf((q1v * cs - q2v * sn) * dq); *(LAS bf16_t*)(L + LQM + j * ROWB + (c + 128) * 2) = f2bf((q1v * sn + q2v * cs) * dq);
            *(LAS bf16_t*)(L + LK + a1) = f2bf((k1 * cs - k2 * sn) * dk); *(LAS bf16_t*)(L + LK + a2) = f2bf((k1 * sn + k2 * cs) * dk); }
        if (F.tid < 256) { const int j = F.tid >> 4, wv = F.tid & 15, tok = 48 + j;
            *(LAS bf16_t*)(L + LV + wv * 128 + (((tok >> 3) ^ ((wv >> 1) & 7)) << 4) + (tok & 7) * 2) = f2bf(RAW[(size_t)j * ldraw + 2048 + h * 512 + 16 * s + wv]); }
    } else {
        if (F.tid < 128) { const int d = F.tid; const float* wgp = F.in[13] + h * 128 + d; const float bias = F.in[14][h * 128 + d]; float cum = 0.f;
            for (int j = 0; j < 16; ++j) { float a = bias;
                for (int r = 0; r < 16; ++r) a += RAW[(size_t)j * ldraw + 3072 + r] * wgp[r * 512];
                cum += (fminf(a, 0.f) - __logf(1.0f + __expf(-fabsf(a)))) * 0.0625f;
                const int row = 48 + j;
                *(LAS bf16_t*)(L + LK + row * ROWB + (((d >> 3) ^ (row & 15)) << 4) + (d & 7) * 2) = f2bf(RAW[(size_t)j * ldraw + 512 + h * 128 + d] * __expf(-cum)); }
            *(LAS float*)(L + LDEC + d * 4) = cum; }
        if (F.tid >= 256) { const int j = (F.tid - 256) >> 4, wv = F.tid & 15, tok = 48 + j;
            *(LAS bf16_t*)(L + LV + wv * 128 + (((tok >> 3) ^ ((wv >> 1) & 7)) << 4) + (tok & 7) * 2) = f2bf(RAW[(size_t)j * ldraw + 1024 + h * 256 + 16 * s + wv]); }
    }
    f32x4 S[NT];
#pragma unroll
    for (int tt = 0; tt < NT; ++tt) S[tt] = (f32x4){0.f, 0.f, 0.f, 0.f};
    const float g64 = GLA ? 1.0f : __builtin_amdgcn_exp2f(64.0f * L2G[h]);
    __syncthreads();
#pragma unroll
    for (int k = 0; k < KS; ++k) { q0[k] = *(const LAS bf16x8*)(L + LQM + (ti == 3 ? r16 : 0) * ROWB + (4 * k + g) * 16); if (ti != 3) q0[k] = (bf16x8){0, 0, 0, 0, 0, 0, 0, 0}; q1[k] = q0[k]; q2[k] = q0[k]; }
    LDS_WAIT();
    S2_ISSUE(1, q1);
    f32x4 ot_prev = (f32x4){0.f, 0.f, 0.f, 0.f}; float ss_prev = 0.f;
#define S2_STEP(c_, QC, QN2) do { const int c = (c_), st = c % 3, sb = c & 1; \
          \
        if (hf == 0 && c >= 1) { const f32x4 part = *(const LAS f32x4*)(L + LOT + ti * 1024 + lane * 16); const f32x4 ot = ot_prev + part; const int irow = 16 * ti + r16; \
            if (c >= 2) { const size_t grow = (size_t)b * SEQ + (c - 2) * 64 + irow; u32x2 pk; pk.x = cvt_pk_bf16(ot[0], ot[1]); pk.y = cvt_pk_bf16(ot[2], ot[3]); \
                *(u32x2*)(O + grow * LDO + h * DV + 16 * s + 4 * g) = pk; } \
            else if (!GLA && b == 0 && irow >= 48) { float* MO = WSP(float, WS_META + META_MO); \
                *(f32x4*)(MO + (size_t)(irow - 48) * 2048 + h * 512 + 16 * s + 4 * g) = ot; } } \
        if (c + 2 <= 128) S2_ISSUE(c + 2, QN2); \
          \
        { const int tj0 = 2 * hf; f32x4 pt0 = (f32x4){0.f, 0.f, 0.f, 0.f}, pt1 = pt0; \
          const LAS unsigned char* kb0 = L + LK + st * TILEB + (16 * tj0 + r16) * ROWB; const LAS unsigned char* kb1 = kb0 + 16 * ROWB; \
          _Pragma("unroll") for (int ks = 0; ks < KS; ++ks) { const int ch = ((4 * ks + g) ^ r16) << 4; \
              const bf16x8 k0 = *(const LAS bf16x8*)(kb0 + ch), k1 = *(const LAS bf16x8*)(kb1 + ch); \
              pt0 = __builtin_amdgcn_mfma_f32_16x16x32_bf16(k0, QC[ks], pt0, 0, 0, 0); pt1 = __builtin_amdgcn_mfma_f32_16x16x32_bf16(k1, QC[ks], pt1, 0, 0, 0); } \
          const int i = 16 * ti + r16; \
          _Pragma("unroll") for (int tjj = 0; tjj < 2; ++tjj) { const f32x4 pt = tjj ? pt1 : pt0; const int tj = tj0 + tjj, j0 = 16 * tj + 4 * g; \
              const float v0 = (j0 + 0 <= i) ? pt[0] : 0.f, v1 = (j0 + 1 <= i) ? pt[1] : 0.f, v2 = (j0 + 2 <= i) ? pt[2] : 0.f, v3 = (j0 + 3 <= i) ? pt[3] : 0.f; \
              u32x2 pk; pk.x = cvt_pk_bf16(v0, v1); pk.y = cvt_pk_bf16(v2, v3); \
              *(LAS u32x2*)(L + LP + i * 128 + (((2 * tj + (g >> 1)) ^ ((i >> 1) & 7)) << 4) + (g & 1) * 8) = pk; } } \
        LDS_WAIT(); __builtin_amdgcn_s_barrier(); asm volatile("" ::: "memory"); \
          \
        { const int irow = 16 * ti + r16; f32x4 ot = (f32x4){0.f, 0.f, 0.f, 0.f}; \
          if (hf == 0) { _Pragma("unroll") for (int ks = 0; ks < 2; ++ks) { \
                const bf16x8 va = *(const LAS bf16x8*)(L + LV + st * 2048 + r16 * 128 + (((4 * ks + g) ^ ((r16 >> 1) & 7)) << 4)); \
                const bf16x8 pb = *(const LAS bf16x8*)(L + LP + irow * 128 + (((4 * ks + g) ^ ((irow >> 1) & 7)) << 4)); \
                ot = __builtin_amdgcn_mfma_f32_16x16x32_bf16(va, pb, ot, 0, 0, 0); } } \
          if (hf == 0) { _Pragma("unroll") for (int kk = 0; kk < KS / 2; ++kk) { \
              const bf16x8 sa = *(const LAS bf16x8*)(L + LS + sb * 16 * ROWB + r16 * ROWB + (((4 * kk + g) ^ r16) << 4)); \
              ot = __builtin_amdgcn_mfma_f32_16x16x32_bf16(sa, QC[kk], ot, 0, 0, 0); } } \
          else { _Pragma("unroll") for (int kk = KS / 2; kk < KS; ++kk) { \
              const bf16x8 sa = *(const LAS bf16x8*)(L + LS + sb * 16 * ROWB + r16 * ROWB + (((4 * kk + g) ^ r16) << 4)); \
              ot = __builtin_amdgcn_mfma_f32_16x16x32_bf16(sa, QC[kk], ot, 0, 0, 0); } } \
          if (hf == 1) *(LAS f32x4*)(L + LOT + ti * 1024 + lane * 16) = ot; else ot_prev = ot; } \
          \
        { s16x4 klo[2][NT], khi[2][NT]; bf16x8 vbb[2]; \
          _Pragma("unroll") for (int ks = 0; ks < 2; ++ks) { \
              vbb[ks] = *(const LAS bf16x8*)(L + LV + st * 2048 + r16 * 128 + (((4 * ks + g) ^ ((r16 >> 1) & 7)) << 4)); \
              _Pragma("unroll") for (int tt = 0; tt < NT; ++tt) { const int d0 = 16 * (w + 8 * tt), dcol = d0 + 4 * (r16 & 3), chunk = dcol >> 3, sub = (dcol & 7) * 2; \
                  const int r1 = 32 * ks + 8 * g + (r16 >> 2), r2 = r1 + 4; \
                  klo[ks][tt] = ds_tr_asm(Lb + LK + st * TILEB + r1 * ROWB + ((chunk ^ (r1 & 15)) << 4) + sub); \
                  khi[ks][tt] = ds_tr_asm(Lb + LK + st * TILEB + r2 * ROWB + ((chunk ^ (r2 & 15)) << 4) + sub); } } \
          asm volatile("s_waitcnt lgkmcnt(0)" ::: "memory"); __builtin_amdgcn_sched_barrier(0); \
          _Pragma("unroll") for (int ks = 0; ks < 2; ++ks) _Pragma("unroll") for (int tt = 0; tt < NT; ++tt) { \
                  const s16x4 lo = klo[ks][tt], hi = khi[ks][tt]; \
                  const bf16x8 ka = (bf16x8){lo[0], lo[1], lo[2], lo[3], hi[0], hi[1], hi[2], hi[3]}; \
                  S[tt] = __builtin_amdgcn_mfma_f32_16x16x32_bf16(ka, vbb[ks], S[tt], 0, 0, 0); } \
          _Pragma("unroll") for (int tt = 0; tt < NT; ++tt) { const int tile = w + 8 * tt; \
              if (GLA) { const f32x4 dl = *(const LAS f32x4*)(L + LDEC + st * 1024 + (16 * tile + 4 * g) * 4); \
                  S[tt][0] *= __expf(dl[0]); S[tt][1] *= __expf(dl[1]); S[tt][2] *= __expf(dl[2]); S[tt][3] *= __expf(dl[3]); } else S[tt] = S[tt] * g64; \
              u32x2 pk; pk.x = cvt_pk_bf16(S[tt][0], S[tt][1]); pk.y = cvt_pk_bf16(S[tt][2], S[tt][3]); \
              *(LAS u32x2*)(L + LS + (sb ^ 1) * 16 * ROWB + r16 * ROWB + (((2 * tile + (g >> 1)) ^ r16) << 4) + (g & 1) * 8) = pk; } } \
          \
        if (c + 2 <= 128) S2_WAIT_PREV(); else S2_WAITV(0); \
        LDS_WAIT(); __builtin_amdgcn_s_barrier(); asm volatile("" ::: "memory"); __builtin_amdgcn_sched_barrier(0); \
    } while (0)
#define S2_PIN(Q) do { _Pragma("unroll") for (int k_ = 0; k_ < KS; ++k_) asm volatile("" : "+v"(Q[k_])); } while (0)
    for (int c3 = 0; c3 < 129; c3 += 3) {
        S2_STEP(c3, q0, q2);     S2_PIN(q1);
        S2_STEP(c3 + 1, q1, q0); S2_PIN(q2);
        S2_STEP(c3 + 2, q2, q1); S2_PIN(q0);
    }
    if (hf == 0) { const f32x4 part = *(const LAS f32x4*)(L + LOT + ti * 1024 + lane * 16); const f32x4 ot = ot_prev + part; const int irow = 16 * ti + r16;
        const size_t grow = (size_t)b * SEQ + 127 * 64 + irow; u32x2 pk; pk.x = cvt_pk_bf16(ot[0], ot[1]); pk.y = cvt_pk_bf16(ot[2], ot[3]);
        *(u32x2*)(O + grow * LDO + h * DV + 16 * s + 4 * g) = pk; }
#undef S2_ISSUE
#undef S2_WAIT_PREV
#undef S2_STEP
#undef S2_PIN
}

template <int DK, int DV, bool GLA>
__device__ __forceinline__ void s2v3_phase(Frame& F, const bf16_t* QH, const bf16_t* KH, const bf16_t* VT, bf16_t* O, const float* BC, int ldraw) {
    constexpr int NS = DV / 16, ROWB = DK * 2, TILEB = 64 * ROWB, NIL = TILEB / 1024 / 4, NTU = DK / 64, LDO = 4 * DV, KS = DK / 32;
    constexpr int LK = 0, LV = 3 * TILEB, LDEC = LV + 3 * 2048, LP = LDEC + 3 * 1024, LS = LP + 8192, LOT = LS + 2 * 16 * ROWB, LQM = LOT + 4096, LEND = LQM + 16 * ROWB;
    static_assert(LEND <= LDS_MISC, "S2 LDS map");
    static_assert((NIL + KS == 16) || (NIL + KS == 8), "S2 wait immediates");
    const int unit = blockIdx.x; if (unit >= 8 * NS) return;
    const int bh = unit & 7, s = unit >> 3, b = bh >> 2, h = bh & 3;
    const int lane = F.lane, g = lane >> 4, r16 = lane & 15, w = F.wave, ti = w >> 1, hf = w & 1;
    LAS unsigned char* L = F.lds; const unsigned Lb = (unsigned)(uintptr_t)L;
    const float* RAW = WSP(float, WS_META + META_RAW);
    const char* Qg = (const char*)(QH + (size_t)bh * SEQ * DK); const char* Kg = (const char*)(KH + (size_t)bh * SEQ * DK);
    const char* Vg = (const char*)(VT + ((size_t)bh * DV + 16 * s) * SEQ);
    const char* qlane = Qg + (size_t)(16 * ti + r16) * ROWB + g * 16;
    bf16x8 q0[KS], q1[KS], q2[KS];
#define S3_ISSUE(c_, ST_, QSET) do { unsigned lzi_ = 0; asm volatile("" : "+v"(lzi_)); const int rc_ = (c_) - 1; constexpr int st_ = (ST_); const char* kc_ = Kg + (size_t)rc_ * TILEB + lzi_; \
        _Pragma("unroll") for (int i_ = 0; i_ < NIL; ++i_) { const int piece_ = ti * NIL + i_, off_ = piece_ * 1024 + lane * 16, row_ = off_ / ROWB, p_ = (off_ % ROWB) >> 4; \
            __builtin_amdgcn_global_load_lds((const unsigned*)(kc_ + row_ * ROWB + ((p_ ^ (row_ & 15)) << 4)), (LAS unsigned*)(L + LK + st_ * TILEB + piece_ * 1024), 16, 0, 0); } \
        if (ti < 2) { const int off_ = ti * 1024 + lane * 16, wv_ = off_ >> 7, p_ = (off_ & 127) >> 4; \
            __builtin_amdgcn_global_load_lds((const unsigned*)(Vg + (size_t)wv_ * SEQ * 2 + (size_t)rc_ * 128 + ((p_ ^ ((wv_ >> 1) & 7)) << 4)), (LAS unsigned*)(L + LV + st_ * 2048 + ti * 1024), 16, 0, 0); } \
        if (GLA && ti == 2) __builtin_amdgcn_global_load_lds((const unsigned*)((const char*)(BC + (size_t)(b * SEQ + rc_ * 64 + 63) * 512 + h * 128) + lane * 16), (LAS unsigned*)(L + LDEC + st_ * 1024), 16, 0, 0); \
        _Pragma("unroll") for (int k_ = 0; k_ < KS; ++k_) QSET[k_] = gload16(qlane + (size_t)rc_ * TILEB + k_ * 64); } while (0)
#define S3_WAIT_PREV() do { if (ti < 2 || (GLA && ti == 2)) { if (NIL + KS == 16) S2_WAITV(17); else S2_WAITV(9); } else { if (NIL + KS == 16) S2_WAITV(16); else S2_WAITV(8); } } while (0)
    for (int i = F.tid * 16; i < TILEB; i += NTHREADS * 16) *(LAS u32x4*)(L + LK + i) = (u32x4){0, 0, 0, 0};
    for (int i = F.tid * 16; i < 2048; i += NTHREADS * 16) *(LAS u32x4*)(L + LV + i) = (u32x4){0, 0, 0, 0};
    for (int i = F.tid * 16; i < 16 * ROWB; i += NTHREADS * 16) { *(LAS u32x4*)(L + LS + i) = (u32x4){0, 0, 0, 0}; *(LAS u32x4*)(L + LQM + i) = (u32x4){0, 0, 0, 0}; }
    __syncthreads();
    if (!GLA) {
        for (int idx = F.tid; idx < 16 * 128; idx += NTHREADS) { const int j = idx >> 7, c = idx & 127, row = 48 + j;
            const float* rq = RAW + (size_t)j * ldraw + h * 256; const float* rk = rq + 1024;
            const float rev = ((float)j * ROPE_INV[c]) * 0.15915494309189535f; const float frc = rev - floorf(rev);
            const float sn = __builtin_amdgcn_sinf(frc), cs = __builtin_amdgcn_cosf(frc);
            const float dq = __builtin_amdgcn_exp2f((float)(row + 1) * L2G[h]), dk = 0.0625f * __builtin_amdgcn_exp2f(-(float)(row + 1) * L2G[h]);
            const float q1v = rq[c], q2v = rq[c + 128], k1 = rk[c], k2 = rk[c + 128];
            const int a1 = row * ROWB + ((((c >> 3)) ^ (row & 15)) << 4) + (c & 7) * 2, a2 = row * ROWB + ((((c + 128) >> 3) ^ (row & 15)) << 4) + (c & 7) * 2;
            *(LAS bf16_t*)(L + LQM + j * ROWB + c * 2) = f2bf((q1v * cs - q2v * sn) * dq); *(LAS bf16_t*)(L + LQM + j * ROWB + (c + 128) * 2) = f2bf((q1v * sn + q2v * cs) * dq);
            *(LAS bf16_t*)(L + LK + a1) = f2bf((k1 * cs - k2 * sn) * dk); *(LAS bf16_t*)(L + LK + a2) = f2bf((k1 * sn + k2 * cs) * dk); }
        if (F.tid < 256) { const int j = F.tid >> 4, wv = F.tid & 15, tok = 48 + j;
            *(LAS bf16_t*)(L + LV + wv * 128 + (((tok >> 3) ^ ((wv >> 1) & 7)) << 4) + (tok & 7) * 2) = f2bf(RAW[(size_t)j * ldraw + 2048 + h * 512 + 16 * s + wv]); }
    } else {
        if (F.tid < 128) { const int d = F.tid; const float* wgp = F.in[13] + h * 128 + d; const float bias = F.in[14][h * 128 + d]; float cum = 0.f;
            for (int j = 0; j < 16; ++j) { float a = bias;
                for (int r = 0; r < 16; ++r) a += RAW[(size_t)j * ldraw + 3072 + r] * wgp[r * 512];
                cum += (fminf(a, 0.f) - __logf(1.0f + __expf(-fabsf(a)))) * 0.0625f;
                const int row = 48 + j;
                *(LAS bf16_t*)(L + LK + row * ROWB + (((d >> 3) ^ (row & 15)) << 4) + (d & 7) * 2) = f2bf(RAW[(size_t)j * ldraw + 512 + h * 128 + d] * __expf(-cum)); }
            *(LAS float*)(L + LDEC + d * 4) = cum; }
        if (F.tid >= 256) { const int j = (F.tid - 256) >> 4, wv = F.tid & 15, tok = 48 + j;
            *(LAS bf16_t*)(L + LV + wv * 128 + (((tok >> 3) ^ ((wv >> 1) & 7)) << 4) + (tok & 7) * 2) = f2bf(RAW[(size_t)j * ldraw + 1024 + h * 256 + 16 * s + wv]); }
    }
    f32x4 S[NTU];
#pragma unroll
    for (int tt = 0; tt < NTU; ++tt) S[tt] = (f32x4){0.f, 0.f, 0.f, 0.f};
    const float g64 = GLA ? 1.0f : __builtin_amdgcn_exp2f(64.0f * L2G[h]);
    __syncthreads();
#pragma unroll
    for (int k = 0; k < KS; ++k) { q0[k] = *(const LAS bf16x8*)(L + LQM + (ti == 3 ? r16 : 0) * ROWB + (4 * k + g) * 16); if (ti != 3) q0[k] = (bf16x8){0, 0, 0, 0, 0, 0, 0, 0}; asm volatile("" : "=v"(q1[k])); asm volatile("" : "=v"(q2[k])); }
    LDS_WAIT();
    if (hf) S3_ISSUE(1, 1, q1);
    f32x4 ot_prev = (f32x4){0.f, 0.f, 0.f, 0.f};
#define S3_STEP(c_, ST, QC, QN2) do { const int c = (c_), sb = c & 1; constexpr int st = (ST); \
        unsigned lz_ = 0; asm volatile("" : "+v"(lz_)); LAS unsigned char* const Lz = L + lz_; const unsigned Lbz = Lb + lz_;   \
        if (hf == 0) { \
              \
            if (c >= 1) { const f32x4 part = *(const LAS f32x4*)(Lz + LOT + ti * 1024 + lane * 16); const f32x4 ot = ot_prev + part; const int irow = 16 * ti + r16; \
                if (c >= 2) { const size_t grow = (size_t)b * SEQ + (c - 2) * 64 + irow; u32x2 pk; pk.x = cvt_pk_bf16(ot[0], ot[1]); pk.y = cvt_pk_bf16(ot[2], ot[3]); \
                    *(u32x2*)(O + grow * LDO + h * DV + 16 * s + 4 * g) = pk; } \
                else if (!GLA && b == 0 && irow >= 48) { float* MO = WSP(float, WS_META + META_MO); *(f32x4*)(MO + (size_t)(irow - 48) * 2048 + h * 512 + 16 * s + 4 * g) = ot; } } \
              \
            { bf16x8 vbb[2]; \
              _Pragma("unroll") for (int ks = 0; ks < 2; ++ks) vbb[ks] = *(const LAS bf16x8*)(Lz + LV + st * 2048 + r16 * 128 + (((4 * ks + g) ^ ((r16 >> 1) & 7)) << 4)); \
              _Pragma("unroll") for (int tt = 0; tt < NTU; ++tt) { const int tile = ti + 4 * tt, d0 = 16 * tile, dcol = d0 + 4 * (r16 & 3), chunk = dcol >> 3, sub = (dcol & 7) * 2; \
                  s16x4 klo[2], khi[2]; \
                  _Pragma("unroll") for (int ks = 0; ks < 2; ++ks) { const int r1 = 32 * ks + 8 * g + (r16 >> 2), r2 = r1 + 4; \
                      klo[ks] = ds_tr_asm(Lbz + LK + st * TILEB + r1 * ROWB + ((chunk ^ (r1 & 15)) << 4) + sub); \
                      khi[ks] = ds_tr_asm(Lbz + LK + st * TILEB + r2 * ROWB + ((chunk ^ (r2 & 15)) << 4) + sub); } \
                  asm volatile("s_waitcnt lgkmcnt(0)" ::: "memory"); __builtin_amdgcn_sched_barrier(0); \
                  _Pragma("unroll") for (int ks = 0; ks < 2; ++ks) { const s16x4 lo = klo[ks], hi = khi[ks]; \
                      const bf16x8 ka = (bf16x8){lo[0], lo[1], lo[2], lo[3], hi[0], hi[1], hi[2], hi[3]}; \
                      S[tt] = __builtin_amdgcn_mfma_f32_16x16x32_bf16(ka, vbb[ks], S[tt], 0, 0, 0); } \
                  if (GLA) { const f32x4 dl = *(const LAS f32x4*)(Lz + LDEC + st * 1024 + (16 * tile + 4 * g) * 4); \
                      S[tt][0] *= __expf(dl[0]); S[tt][1] *= __expf(dl[1]); S[tt][2] *= __expf(dl[2]); S[tt][3] *= __expf(dl[3]); } else S[tt] = S[tt] * g64; \
                  u32x2 pk; pk.x = cvt_pk_bf16(S[tt][0], S[tt][1]); pk.y = cvt_pk_bf16(S[tt][2], S[tt][3]); \
                  *(LAS u32x2*)(Lz + LS + (sb ^ 1) * 16 * ROWB + r16 * ROWB + (((2 * tile + (g >> 1)) ^ r16) << 4) + (g & 1) * 8) = pk; } } \
        } else { \
            if (c + 2 <= 128) S3_ISSUE(c + 2, (ST + 2) % 3, QN2); \
              \
            { const LAS unsigned char* kb = Lz + LK + st * TILEB + r16 * ROWB; const int i = 16 * ti + r16; \
              _Pragma("unroll") for (int th = 0; th < 2; ++th) { f32x4 pa = (f32x4){0.f, 0.f, 0.f, 0.f}, pb = pa; \
                  if (2 * th <= ti) { \
                      _Pragma("unroll") for (int ks = 0; ks < KS; ++ks) { const int ch = ((4 * ks + g) ^ r16) << 4; \
                          const bf16x8 ka = *(const LAS bf16x8*)(kb + (2 * th) * 16 * ROWB + ch), kc2 = *(const LAS bf16x8*)(kb + (2 * th + 1) * 16 * ROWB + ch); \
                          pa = __builtin_amdgcn_mfma_f32_16x16x32_bf16(ka, QC[ks], pa, 0, 0, 0); pb = __builtin_amdgcn_mfma_f32_16x16x32_bf16(kc2, QC[ks], pb, 0, 0, 0); \
                          if (ks & 1) __builtin_amdgcn_sched_barrier(0); } } \
                  _Pragma("unroll") for (int tq = 0; tq < 2; ++tq) { const int tj = 2 * th + tq, j0 = 16 * tj + 4 * g; const f32x4 pt = tq ? pb : pa; \
                      const float v0 = (j0 + 0 <= i) ? pt[0] : 0.f, v1 = (j0 + 1 <= i) ? pt[1] : 0.f, v2 = (j0 + 2 <= i) ? pt[2] : 0.f, v3 = (j0 + 3 <= i) ? pt[3] : 0.f; \
                      u32x2 pk; pk.x = cvt_pk_bf16(v0, v1); pk.y = cvt_pk_bf16(v2, v3); \
                      *(LAS u32x2*)(Lz + LP + i * 128 + (((2 * tj + (g >> 1)) ^ ((i >> 1) & 7)) << 4) + (g & 1) * 8) = pk; } } } \
        } \
        LDS_WAIT(); __builtin_amdgcn_s_barrier(); asm volatile("" ::: "memory"); \
        if (hf == 0) {   \
            const int irow = 16 * ti + r16; f32x4 ot = (f32x4){0.f, 0.f, 0.f, 0.f}; \
            _Pragma("unroll") for (int ks = 0; ks < 2; ++ks) { \
                const bf16x8 va = *(const LAS bf16x8*)(Lz + LV + st * 2048 + r16 * 128 + (((4 * ks + g) ^ ((r16 >> 1) & 7)) << 4)); \
                const bf16x8 pb = *(const LAS bf16x8*)(Lz + LP + irow * 128 + (((4 * ks + g) ^ ((irow >> 1) & 7)) << 4)); \
                ot = __builtin_amdgcn_mfma_f32_16x16x32_bf16(va, pb, ot, 0, 0, 0); } \
            ot_prev = ot; \
        } else {   \
            f32x4 oa = (f32x4){0.f, 0.f, 0.f, 0.f}, ob = oa; \
            _Pragma("unroll") for (int ks = 0; ks < KS; ks += 2) { \
                const bf16x8 sa = *(const LAS bf16x8*)(Lz + LS + sb * 16 * ROWB + r16 * ROWB + (((4 * ks + g) ^ r16) << 4)); \
                const bf16x8 sc = *(const LAS bf16x8*)(Lz + LS + sb * 16 * ROWB + r16 * ROWB + (((4 * (ks + 1) + g) ^ r16) << 4)); \
                oa = __builtin_amdgcn_mfma_f32_16x16x32_bf16(sa, QC[ks], oa, 0, 0, 0); ob = __builtin_amdgcn_mfma_f32_16x16x32_bf16(sc, QC[ks + 1], ob, 0, 0, 0); __builtin_amdgcn_sched_barrier(0); } \
            *(LAS f32x4*)(Lz + LOT + ti * 1024 + lane * 16) = oa + ob; \
            if (c + 2 <= 128) S3_WAIT_PREV(); else S2_WAITV(0); \
        } \
        LDS_WAIT(); __builtin_amdgcn_s_barrier(); asm volatile("" ::: "memory"); __builtin_amdgcn_sched_barrier(0); \
    } while (0)
#define S3_PIN(Q) do { _Pragma("unroll") for (int k_ = 0; k_ < KS; ++k_) asm volatile("" : "+v"(Q[k_])); } while (0)
    for (int c3 = 0; c3 < 129; c3 += 3) {
        S3_STEP(c3, 0, q0, q2);     S3_PIN(q1);
        S3_STEP(c3 + 1, 1, q1, q0); S3_PIN(q2);
        S3_STEP(c3 + 2, 2, q2, q1); S3_PIN(q0);
    }
    if (hf == 0) { const f32x4 part = *(const LAS f32x4*)(L + LOT + ti * 1024 + lane * 16); const f32x4 ot = ot_prev + part; const int irow = 16 * ti + r16;
        const size_t grow = (size_t)b * SEQ + 127 * 64 + irow; u32x2 pk; pk.x = cvt_pk_bf16(ot[0], ot[1]); pk.y = cvt_pk_bf16(ot[2], ot[3]);
        *(u32x2*)(O + grow * LDO + h * DV + 16 * s + 4 * g) = pk; }
#undef S3_ISSUE
#undef S3_WAIT_PREV
#undef S3_STEP
#undef S3_PIN
}

template <int DK, int DV, bool GLA>
__device__ __forceinline__ void s2v4_phase(Frame& F, const int unit, const bf16_t* QH, const bf16_t* KH, const bf16_t* VT, bf16_t* O, const float* BC, int ldraw) {
    constexpr int NS = DV / 16, ROWB = DK * 2, TILEB = 32 * ROWB, NIL = TILEB / 1024 / 4, NTU = DK / 64, LDO = 4 * DV, KS = DK / 32, NSTEP = 257;
    constexpr int LK = 0, LQ = 3 * TILEB, LV = 6 * TILEB, LDEC = LV + 3 * 1024, LP = LDEC + 3 * 1024, LS = LP + 2048, LOT = LS + 2 * 16 * ROWB, LEND = LOT + 4096;
    static_assert(LEND + 256 <= LDS_MISC, "S2 LDS map");
    static_assert(NIL == 4 || NIL == 2, "S2 wait immediates");
    if (unit >= 8 * NS) return;
    const int bh = unit & 7, s = unit >> 3, b = bh >> 2, h = bh & 3;
    const int lane = F.lane, g = lane >> 4, r16 = lane & 15, w = F.wave, li = w >> 1, hf = w & 1, qi = li >> 1, kj = li & 1;
    LAS unsigned char* L = F.lds; const unsigned Lb = (unsigned)(uintptr_t)L;
    const float* RAW = WSP(float, WS_META + META_RAW);
    const char* Qg = (const char*)(QH + (size_t)bh * SEQ * DK); const char* Kg = (const char*)(KH + (size_t)bh * SEQ * DK);
    const char* Vg = (const char*)(VT + ((size_t)bh * DV + 16 * s) * SEQ);
#define S4_ISSUE(c_, st_) do { const int rc_ = (c_) - 1; const char* kc_ = Kg + (size_t)rc_ * TILEB; const char* qc_ = Qg + (size_t)rc_ * TILEB; \
        _Pragma("unroll") for (int i_ = 0; i_ < NIL; ++i_) { const int piece_ = li * NIL + i_, off_ = piece_ * 1024 + lane * 16, row_ = off_ / ROWB, p_ = (off_ % ROWB) >> 4; const int so_ = row_ * ROWB + ((p_ ^ (row_ & 15)) << 4); \
            __builtin_amdgcn_global_load_lds((const unsigned*)(kc_ + so_), (LAS unsigned*)(L + LK + (st_) * TILEB + piece_ * 1024), 16, 0, 0); \
            __builtin_amdgcn_global_load_lds((const unsigned*)(qc_ + so_), (LAS unsigned*)(L + LQ + (st_) * TILEB + piece_ * 1024), 16, 0, 0); } \
        if (li == 0) { const int wv_ = lane >> 2, p_ = lane & 3; \
            __builtin_amdgcn_global_load_lds((const unsigned*)(Vg + (size_t)wv_ * SEQ * 2 + (size_t)rc_ * 64 + ((p_ ^ ((wv_ >> 2) & 3)) << 4)), (LAS unsigned*)(L + LV + (st_) * 1024), 16, 0, 0); } \
        if (GLA && li == 1) __builtin_amdgcn_global_load_lds((const unsigned*)((const char*)(BC + (size_t)(b * SEQ + rc_ * 32 + 31) * 512 + h * 128) + lane * 16), (LAS unsigned*)(L + LDEC + (st_) * 1024), 16, 0, 0); } while (0)
#define S4_WAIT_PREV() do { if (li == 0 || (GLA && li == 1)) { if (NIL == 4) S2_WAITV(9); else S2_WAITV(5); } else { if (NIL == 4) S2_WAITV(8); else S2_WAITV(4); } } while (0)
    for (int i = F.tid * 16; i < TILEB; i += NTHREADS * 16) { *(LAS u32x4*)(L + LK + i) = (u32x4){0, 0, 0, 0}; *(LAS u32x4*)(L + LQ + i) = (u32x4){0, 0, 0, 0}; }
    for (int i = F.tid * 16; i < 1024; i += NTHREADS * 16) *(LAS u32x4*)(L + LV + i) = (u32x4){0, 0, 0, 0};
    for (int i = F.tid * 16; i < 16 * ROWB; i += NTHREADS * 16) *(LAS u32x4*)(L + LS + i) = (u32x4){0, 0, 0, 0};
    __syncthreads();
    if (!GLA) {
        for (int idx = F.tid; idx < 16 * 128; idx += NTHREADS) { const int j = idx >> 7, c = idx & 127, row = 16 + j;
            const float* rq = RAW + (size_t)j * ldraw + h * 256; const float* rk = rq + 1024;
            const float rev = ((float)j * ROPE_INV[c]) * 0.15915494309189535f; const float frc = rev - floorf(rev);
            const float sn = __builtin_amdgcn_sinf(frc), cs = __builtin_amdgcn_cosf(frc);
            const float dq = __builtin_amdgcn_exp2f((float)(row + 1) * L2G[h]), dk = 0.0625f * __builtin_amdgcn_exp2f(-(float)(row + 1) * L2G[h]);
            const float q1v = rq[c], q2v = rq[c + 128], k1 = rk[c], k2 = rk[c + 128];
            const int a1 = row * ROWB + ((((c >> 3)) ^ (row & 15)) << 4) + (c & 7) * 2, a2 = row * ROWB + ((((c + 128) >> 3) ^ (row & 15)) << 4) + (c & 7) * 2;
            *(LAS bf16_t*)(L + LQ + a1) = f2bf((q1v * cs - q2v * sn) * dq); *(LAS bf16_t*)(L + LQ + a2) = f2bf((q1v * sn + q2v * cs) * dq);
            *(LAS bf16_t*)(L + LK + a1) = f2bf((k1 * cs - k2 * sn) * dk); *(LAS bf16_t*)(L + LK + a2) = f2bf((k1 * sn + k2 * cs) * dk); }
        if (F.tid < 256) { const int j = F.tid >> 4, wv = F.tid & 15, tok = 16 + j;
            *(LAS bf16_t*)(L + LV + wv * 64 + (((tok >> 3) ^ ((wv >> 2) & 3)) << 4) + (tok & 7) * 2) = f2bf(RAW[(size_t)j * ldraw + 2048 + h * 512 + 16 * s + wv]); }
    } else {
        if (F.tid < 128) { const int d = F.tid; const float* wgp = F.in[13] + h * 128 + d; const float bias = F.in[14][h * 128 + d]; float cum = 0.f;
            for (int j = 0; j < 16; ++j) { float a = bias;
                for (int r = 0; r < 16; ++r) a += RAW[(size_t)j * ldraw + 3072 + r] * wgp[r * 512];
                cum += (fminf(a, 0.f) - __logf(1.0f + __expf(-fabsf(a)))) * 0.0625f;
                const int row = 16 + j;
                *(LAS bf16_t*)(L + LK + row * ROWB + (((d >> 3) ^ (row & 15)) << 4) + (d & 7) * 2) = f2bf(RAW[(size_t)j * ldraw + 512 + h * 128 + d] * __expf(-cum)); }
            *(LAS float*)(L + LDEC + d * 4) = cum; }
        if (F.tid >= 256) { const int j = (F.tid - 256) >> 4, wv = F.tid & 15, tok = 16 + j;
            *(LAS bf16_t*)(L + LV + wv * 64 + (((tok >> 3) ^ ((wv >> 2) & 3)) << 4) + (tok & 7) * 2) = f2bf(RAW[(size_t)j * ldraw + 1024 + h * 256 + 16 * s + wv]); }
    }
    f32x4 S[NTU];
#pragma unroll
    for (int tt = 0; tt < NTU; ++tt) S[tt] = (f32x4){0.f, 0.f, 0.f, 0.f};
    const float g32 = GLA ? 1.0f : __builtin_amdgcn_exp2f(32.0f * L2G[h]);
    __syncthreads();
    if (hf) S4_ISSUE(1, 1);
    f32x4 ot_prev = (f32x4){0.f, 0.f, 0.f, 0.f};
    int st = 0;
#if defined(PROBE2)
    unsigned long long pacc = 0ull, pt0 = 0ull; const unsigned long long ptot0 = __builtin_amdgcn_s_memtime();
#define P2T(q, stmt) do { if (PROBE2 == (q) && !GLA) { stmt; } } while (0)
#else
#define P2T(q, stmt) do {} while (0)
#endif
    for (int c = 0; c < NSTEP; ++c) {
        P2T(2, if (hf == 1) pt0 = __builtin_amdgcn_s_memtime()); P2T(3, if (hf == 0) pt0 = __builtin_amdgcn_s_memtime());
        const int sb = c & 1, st2 = (st == 0) ? 2 : st - 1;
        unsigned lz_ = 0; asm volatile("" : "+v"(lz_)); LAS unsigned char* const Lz = L + lz_; const unsigned Lbz = Lb + lz_;
        if (hf == 0) {
            if (li == 3) { constexpr int PFD = 8, LPT = TILEB / 128, LPB = 2 * LPT / NS; const int rcp = c + PFD - 1;
                if (rcp < 256) { const char* pa_ = nullptr;
                    if (lane < LPB) { const int ln = s * LPB + lane; pa_ = (ln < LPT) ? Kg + (size_t)rcp * TILEB + ln * 128 : Qg + (size_t)rcp * TILEB + (ln - LPT) * 128; }
                    else if (lane >= 16 && lane < 32) pa_ = Vg + (size_t)(lane - 16) * SEQ * 2 + (size_t)rcp * 64;
                    else if (GLA && lane == 32 && s == 0) pa_ = (const char*)(BC + (size_t)(b * SEQ + rcp * 32 + 31) * 512 + h * 128);
                    if (pa_) glds_touch(pa_, (unsigned)__builtin_amdgcn_readfirstlane((int)(Lb + LEND))); } }
            if (li < 2 && c >= 1) { const f32x4 pa = *(const LAS f32x4*)(Lz + LOT + (li * 2) * 1024 + lane * 16), pb = *(const LAS f32x4*)(Lz + LOT + (li * 2 + 1) * 1024 + lane * 16);
                const f32x4 ot = ot_prev + (pa + pb); const int irow = 16 * li + r16;
                if (c >= 2) { const size_t grow = (size_t)b * SEQ + (size_t)(c - 2) * 32 + irow; u32x2 pk; pk.x = cvt_pk_bf16(ot[0], ot[1]); pk.y = cvt_pk_bf16(ot[2], ot[3]);
                    *(u32x2*)(O + grow * LDO + h * DV + 16 * s + 4 * g) = pk; }
                else if (!GLA && b == 0 && irow >= 16) { float* MO = WSP(float, WS_META + META_MO); *(f32x4*)(MO + (size_t)(irow - 16) * 2048 + h * 512 + 16 * s + 4 * g) = ot; } }
            { s16x4 klo[NTU], khi[NTU];
              const bf16x8 vb = *(const LAS bf16x8*)(Lz + LV + st * 1024 + r16 * 64 + ((g ^ ((r16 >> 2) & 3)) << 4));
#pragma unroll
              for (int tt = 0; tt < NTU; ++tt) { const int tile = li + 4 * tt, d0 = 16 * tile, dcol = d0 + 4 * (r16 & 3), chunk = dcol >> 3, sub = (dcol & 7) * 2;
                  const int r1 = 8 * g + (r16 >> 2), r2 = r1 + 4;
                  klo[tt] = ds_tr_asm(Lbz + LK + st * TILEB + r1 * ROWB + ((chunk ^ (r1 & 15)) << 4) + sub);
                  khi[tt] = ds_tr_asm(Lbz + LK + st * TILEB + r2 * ROWB + ((chunk ^ (r2 & 15)) << 4) + sub); }
              asm volatile("s_waitcnt lgkmcnt(0)" ::: "memory"); __builtin_amdgcn_sched_barrier(0);
#pragma unroll
              for (int tt = 0; tt < NTU; ++tt) {
                  const bf16x8 ka = (bf16x8){klo[tt][0], klo[tt][1], klo[tt][2], klo[tt][3], khi[tt][0], khi[tt][1], khi[tt][2], khi[tt][3]};
                  S[tt] = __builtin_amdgcn_mfma_f32_16x16x32_bf16(ka, vb, S[tt], 0, 0, 0); }
#pragma unroll
              for (int tt = 0; tt < NTU; ++tt) { const int tile = li + 4 * tt;
                  if (GLA) { const f32x4 dl = *(const LAS f32x4*)(Lz + LDEC + st * 1024 + (16 * tile + 4 * g) * 4);
                      S[tt][0] *= __expf(dl[0]); S[tt][1] *= __expf(dl[1]); S[tt][2] *= __expf(dl[2]); S[tt][3] *= __expf(dl[3]); } else S[tt] = S[tt] * g32;
                  u32x2 pk; pk.x = cvt_pk_bf16(S[tt][0], S[tt][1]); pk.y = cvt_pk_bf16(S[tt][2], S[tt][3]);
                  *(LAS u32x2*)(Lz + LS + (sb ^ 1) * 16 * ROWB + r16 * ROWB + (((2 * tile + (g >> 1)) ^ r16) << 4) + (g & 1) * 8) = pk; } }
        } else {
            if (c + 2 < NSTEP) S4_ISSUE(c + 2, st2);
            { f32x4 pa = (f32x4){0.f, 0.f, 0.f, 0.f}, pb = pa;
              if (kj <= qi) { const LAS unsigned char* kb = Lz + LK + st * TILEB + (16 * kj + r16) * ROWB; const LAS unsigned char* qb = Lz + LQ + st * TILEB + (16 * qi + r16) * ROWB;
#pragma unroll
                  for (int ks = 0; ks < KS; ks += 2) { const int ch0 = ((4 * ks + g) ^ r16) << 4, ch1 = ((4 * (ks + 1) + g) ^ r16) << 4;
                      const bf16x8 k0 = *(const LAS bf16x8*)(kb + ch0), q0 = *(const LAS bf16x8*)(qb + ch0), k1 = *(const LAS bf16x8*)(kb + ch1), q1 = *(const LAS bf16x8*)(qb + ch1);
                      pa = __builtin_amdgcn_mfma_f32_16x16x32_bf16(k0, q0, pa, 0, 0, 0); pb = __builtin_amdgcn_mfma_f32_16x16x32_bf16(k1, q1, pb, 0, 0, 0); } }
              const f32x4 pt = pa + pb; const int i = 16 * qi + r16, j0 = 16 * kj + 4 * g;
              const float v0 = (j0 + 0 <= i) ? pt[0] : 0.f, v1 = (j0 + 1 <= i) ? pt[1] : 0.f, v2 = (j0 + 2 <= i) ? pt[2] : 0.f, v3 = (j0 + 3 <= i) ? pt[3] : 0.f;
              u32x2 pk; pk.x = cvt_pk_bf16(v0, v1); pk.y = cvt_pk_bf16(v2, v3);
              *(LAS u32x2*)(Lz + LP + i * 64 + (((2 * kj + (g >> 1)) ^ ((i >> 2) & 3)) << 4) + (g & 1) * 8) = pk; }
        }
        LDS_WAIT();
        P2T(2, if (hf == 1) pacc += __builtin_amdgcn_s_memtime() - pt0); P2T(3, if (hf == 0) pacc += __builtin_amdgcn_s_memtime() - pt0);
        P2T(5, pt0 = __builtin_amdgcn_s_memtime());
        __builtin_amdgcn_s_barrier(); asm volatile("" ::: "memory"); __builtin_amdgcn_sched_barrier(0);
        P2T(5, pacc += __builtin_amdgcn_s_memtime() - pt0);
        P2T(4, if (hf == 1) pt0 = __builtin_amdgcn_s_memtime());
        if (hf == 0) {
            if (li < 2) { const int irow = 16 * li + r16;
                const bf16x8 va = *(const LAS bf16x8*)(Lz + LV + st * 1024 + r16 * 64 + ((g ^ ((r16 >> 2) & 3)) << 4));
                const bf16x8 pb = *(const LAS bf16x8*)(Lz + LP + irow * 64 + ((g ^ ((irow >> 2) & 3)) << 4));
                ot_prev = __builtin_amdgcn_mfma_f32_16x16x32_bf16(va, pb, (f32x4){0.f, 0.f, 0.f, 0.f}, 0, 0, 0); }
        } else {
            f32x4 oa = (f32x4){0.f, 0.f, 0.f, 0.f}, ob = oa;
            const LAS unsigned char* sp = Lz + LS + sb * 16 * ROWB + r16 * ROWB; const LAS unsigned char* qb = Lz + LQ + st * TILEB + (16 * qi + r16) * ROWB;
#pragma unroll
            for (int kk = 0; kk < KS / 2; kk += 2) { const int ks = kj * (KS / 2) + kk; const int ch0 = ((4 * ks + g) ^ r16) << 4, ch1 = ((4 * (ks + 1) + g) ^ r16) << 4;
                const bf16x8 s0 = *(const LAS bf16x8*)(sp + ch0), q0 = *(const LAS bf16x8*)(qb + ch0), s1 = *(const LAS bf16x8*)(sp + ch1), q1 = *(const LAS bf16x8*)(qb + ch1);
                oa = __builtin_amdgcn_mfma_f32_16x16x32_bf16(s0, q0, oa, 0, 0, 0); ob = __builtin_amdgcn_mfma_f32_16x16x32_bf16(s1, q1, ob, 0, 0, 0); }
            *(LAS f32x4*)(Lz + LOT + (qi * 2 + kj) * 1024 + lane * 16) = oa + ob;
            P2T(4, pacc += __builtin_amdgcn_s_memtime() - pt0); P2T(1, pt0 = __builtin_amdgcn_s_memtime());
            if (c + 2 < NSTEP) S4_WAIT_PREV(); else S2_WAITV(0);
            P2T(1, pacc += __builtin_amdgcn_s_memtime() - pt0);
        }
        LDS_WAIT(); __builtin_amdgcn_s_barrier(); asm volatile("" ::: "memory"); __builtin_amdgcn_sched_barrier(0);
        st = (st == 2) ? 0 : st + 1;
    }
#if defined(PROBE2)
    if (!GLA && unit == 0) { if (PROBE2 == 0) pacc = __builtin_amdgcn_s_memtime() - ptot0; const int pw = (PROBE2 == 3 || PROBE2 == 5 || PROBE2 == 0) ? 0 : 1; if (w == pw && lane == 0) { volatile LAS unsigned* MI = (volatile LAS unsigned*)(F.lds + LDS_MISC); MI[20] = (unsigned)pacc; MI[21] = (unsigned)(pacc >> 32); } }
#endif
    if (hf == 0 && li < 2) { const f32x4 pa = *(const LAS f32x4*)(L + LOT + (li * 2) * 1024 + lane * 16), pb = *(const LAS f32x4*)(L + LOT + (li * 2 + 1) * 1024 + lane * 16);
        const f32x4 ot = ot_prev + (pa + pb); const int irow = 16 * li + r16;
        const size_t grow = (size_t)b * SEQ + (size_t)(NSTEP - 2) * 32 + irow; u32x2 pk; pk.x = cvt_pk_bf16(ot[0], ot[1]); pk.y = cvt_pk_bf16(ot[2], ot[3]);
        *(u32x2*)(O + grow * LDO + h * DV + 16 * s + 4 * g) = pk; }
#undef S4_ISSUE
#undef S4_WAIT_PREV
}

template <int DK, int DV, bool GLA>
__device__ __forceinline__ void s2v5_phase(Frame& F, const int unit, const bf16_t* QH, const bf16_t* KH, const bf16_t* VT, bf16_t* O, const float* BC, int ldraw) {
    constexpr int NS = DV / 16, ROWB = DK * 2, TILEB = 32 * ROWB, NIL = TILEB / 1024 / 4, NTU = DK / 64, LDO = 4 * DV, KS = DK / 32, NSTEP = 257;
    constexpr int LK = 0, LQ = 2 * TILEB, LV = 4 * TILEB, LDEC = LV + 2 * 1024, LP = LDEC + 2 * 1024, LS = LP + 2048, LOT = LS + 2 * 16 * ROWB, LEND = LOT + 4096;
    static_assert(LEND <= LDS_MISC, "S2 LDS map");
    if (unit >= 8 * NS) return;
    const int bh = unit & 7, s = unit >> 3, b = bh >> 2, h = bh & 3;
    const int lane = F.lane, g = lane >> 4, r16 = lane & 15, w = F.wave, li = w & 3, hf = w >> 2, qi = li >> 1, kj = li & 1;
    LAS unsigned char* L = F.lds; const unsigned Lb = (unsigned)(uintptr_t)L;
    const float* RAW = WSP(float, WS_META + META_RAW);
    const char* Qg = (const char*)(QH + (size_t)bh * SEQ * DK); const char* Kg = (const char*)(KH + (size_t)bh * SEQ * DK);
    const char* Vg = (const char*)(VT + ((size_t)bh * DV + 16 * s) * SEQ);
    u32x4 ra[2 * NIL + 1], rb[2 * NIL + 1];
#pragma unroll
    for (int i = 0; i < 2 * NIL + 1; ++i) { ra[i] = (u32x4){0, 0, 0, 0}; rb[i] = ra[i]; }
#define S5_LOAD(c_, R) do { const int rc_ = ((c_) - 1 < 255) ? (c_) - 1 : 255;     const char* kc_ = Kg + (size_t)rc_ * TILEB; const char* qc_ = Qg + (size_t)rc_ * TILEB; \
        _Pragma("unroll") for (int i_ = 0; i_ < NIL; ++i_) { const int piece_ = li * NIL + i_, off_ = piece_ * 1024 + lane * 16, row_ = off_ / ROWB, p_ = (off_ % ROWB) >> 4; const int so_ = row_ * ROWB + ((p_ ^ (row_ & 15)) << 4); \
            R[i_] = *(const u32x4*)(kc_ + so_); R[NIL + i_] = *(const u32x4*)(qc_ + so_); } \
        if (li == 0) { const int wv_ = lane >> 2, p_ = lane & 3; R[2 * NIL] = *(const u32x4*)(Vg + (size_t)wv_ * SEQ * 2 + (size_t)rc_ * 64 + ((p_ ^ ((wv_ >> 2) & 3)) << 4)); } \
        if (GLA && li == 1) R[2 * NIL] = *(const u32x4*)((const char*)(BC + (size_t)(b * SEQ + rc_ * 32 + 31) * 512 + h * 128) + lane * 16); } while (0)
#define S5_WRITE(st_, R) do { \
        _Pragma("unroll") for (int i_ = 0; i_ < NIL; ++i_) { const int piece_ = li * NIL + i_; \
            *(LAS u32x4*)(L + LK + (st_) * TILEB + piece_ * 1024 + lane * 16) = R[i_]; *(LAS u32x4*)(L + LQ + (st_) * TILEB + piece_ * 1024 + lane * 16) = R[NIL + i_]; } \
        if (li == 0) *(LAS u32x4*)(L + LV + (st_) * 1024 + lane * 16) = R[2 * NIL]; \
        if (GLA && li == 1) *(LAS u32x4*)(L + LDEC + (st_) * 1024 + lane * 16) = R[2 * NIL]; } while (0)
    for (int i = F.tid * 16; i < TILEB; i += NTHREADS * 16) { *(LAS u32x4*)(L + LK + i) = (u32x4){0, 0, 0, 0}; *(LAS u32x4*)(L + LQ + i) = (u32x4){0, 0, 0, 0}; }
    for (int i = F.tid * 16; i < 1024; i += NTHREADS * 16) *(LAS u32x4*)(L + LV + i) = (u32x4){0, 0, 0, 0};
    for (int i = F.tid * 16; i < 16 * ROWB; i += NTHREADS * 16) *(LAS u32x4*)(L + LS + i) = (u32x4){0, 0, 0, 0};
    __syncthreads();
    if (!GLA) {
        for (int idx = F.tid; idx < 16 * 128; idx += NTHREADS) { const int j = idx >> 7, c = idx & 127, row = 16 + j;
            const float* rq = RAW + (size_t)j * ldraw + h * 256; const float* rk = rq + 1024;
            const float rev = ((float)j * ROPE_INV[c]) * 0.15915494309189535f; const float frc = rev - floorf(rev);
            const float sn = __builtin_amdgcn_sinf(frc), cs = __builtin_amdgcn_cosf(frc);
            const float dq = __builtin_amdgcn_exp2f((float)(row + 1) * L2G[h]), dk = 0.0625f * __builtin_amdgcn_exp2f(-(float)(row + 1) * L2G[h]);
            const float q1v = rq[c], q2v = rq[c + 128], k1 = rk[c], k2 = rk[c + 128];
            const int a1 = row * ROWB + ((((c >> 3)) ^ (row & 15)) << 4) + (c & 7) * 2, a2 = row * ROWB + ((((c + 128) >> 3) ^ (row & 15)) << 4) + (c & 7) * 2;
            *(LAS bf16_t*)(L + LQ + a1) = f2bf((q1v * cs - q2v * sn) * dq); *(LAS bf16_t*)(L + LQ + a2) = f2bf((q1v * sn + q2v * cs) * dq);
            *(LAS bf16_t*)(L + LK + a1) = f2bf((k1 * cs - k2 * sn) * dk); *(LAS bf16_t*)(L + LK + a2) = f2bf((k1 * sn + k2 * cs) * dk); }
        if (F.tid < 256) { const int j = F.tid >> 4, wv = F.tid & 15, tok = 16 + j;
            *(LAS bf16_t*)(L + LV + wv * 64 + (((tok >> 3) ^ ((wv >> 2) & 3)) << 4) + (tok & 7) * 2) = f2bf(RAW[(size_t)j * ldraw + 2048 + h * 512 + 16 * s + wv]); }
    } else {
        if (F.tid < 128) { const int d = F.tid; const float* wgp = F.in[13] + h * 128 + d; const float bias = F.in[14][h * 128 + d]; float cum = 0.f;
            for (int j = 0; j < 16; ++j) { float a = bias;
                for (int r = 0; r < 16; ++r) a += RAW[(size_t)j * ldraw + 3072 + r] * wgp[r * 512];
                cum += (fminf(a, 0.f) - __logf(1.0f + __expf(-fabsf(a)))) * 0.0625f;
                const int row = 16 + j;
                *(LAS bf16_t*)(L + LK + row * ROWB + (((d >> 3) ^ (row & 15)) << 4) + (d & 7) * 2) = f2bf(RAW[(size_t)j * ldraw + 512 + h * 128 + d] * __expf(-cum)); }
            *(LAS float*)(L + LDEC + d * 4) = cum; }
        if (F.tid >= 256) { const int j = (F.tid - 256) >> 4, wv = F.tid & 15, tok = 16 + j;
            *(LAS bf16_t*)(L + LV + wv * 64 + (((tok >> 3) ^ ((wv >> 2) & 3)) << 4) + (tok & 7) * 2) = f2bf(RAW[(size_t)j * ldraw + 1024 + h * 256 + 16 * s + wv]); }
    }
    f32x4 S[NTU];
#pragma unroll
    for (int tt = 0; tt < NTU; ++tt) S[tt] = (f32x4){0.f, 0.f, 0.f, 0.f};
    const float g32 = GLA ? 1.0f : __builtin_amdgcn_exp2f(32.0f * L2G[h]);
    __syncthreads();
    if (hf) S5_LOAD(1, rb);
    f32x4 ot_prev = (f32x4){0.f, 0.f, 0.f, 0.f};
#define S5_ODD(c_, ST, RL, RW) do { const int c = (c_); constexpr int st = (ST), sb = (ST); P3T(1, pt0 = __builtin_amdgcn_s_memtime()); \
        LAS unsigned char* const Lz = L; \
        S5_LOAD(c + 2, RL); P3T(1, pacc += __builtin_amdgcn_s_memtime() - pt0); P3T(2, pt0 = __builtin_amdgcn_s_memtime()); \
        { f32x4 pa = (f32x4){0.f, 0.f, 0.f, 0.f}, pb = pa; \
          if (kj <= qi) { const LAS unsigned char* kb = Lz + LK + st * TILEB + (16 * kj + r16) * ROWB; const LAS unsigned char* qb = Lz + LQ + st * TILEB + (16 * qi + r16) * ROWB; \
              _Pragma("unroll") for (int ks = 0; ks < KS; ks += 2) { const int ch0 = ((4 * ks + g) ^ r16) << 4, ch1 = ((4 * (ks + 1) + g) ^ r16) << 4; \
                  const bf16x8 k0 = *(const LAS bf16x8*)(kb + ch0), q0 = *(const LAS bf16x8*)(qb + ch0), k1 = *(const LAS bf16x8*)(kb + ch1), q1 = *(const LAS bf16x8*)(qb + ch1); \
                  pa = __builtin_amdgcn_mfma_f32_16x16x32_bf16(k0, q0, pa, 0, 0, 0); pb = __builtin_amdgcn_mfma_f32_16x16x32_bf16(k1, q1, pb, 0, 0, 0); } } \
          const f32x4 pt = pa + pb; const int i = 16 * qi + r16, j0 = 16 * kj + 4 * g; \
          const float v0 = (j0 + 0 <= i) ? pt[0] : 0.f, v1 = (j0 + 1 <= i) ? pt[1] : 0.f, v2 = (j0 + 2 <= i) ? pt[2] : 0.f, v3 = (j0 + 3 <= i) ? pt[3] : 0.f; \
          u32x2 pk; pk.x = cvt_pk_bf16(v0, v1); pk.y = cvt_pk_bf16(v2, v3); \
          *(LAS u32x2*)(Lz + LP + i * 64 + (((2 * kj + (g >> 1)) ^ ((i >> 2) & 3)) << 4) + (g & 1) * 8) = pk; } \
        LDS_WAIT(); P3T(2, pacc += __builtin_amdgcn_s_memtime() - pt0); P3T(3, pt0 = __builtin_amdgcn_s_memtime()); __builtin_amdgcn_s_barrier(); asm volatile("" ::: "memory"); P3T(3, pacc += __builtin_amdgcn_s_memtime() - pt0); P3T(4, pt0 = __builtin_amdgcn_s_memtime()); \
        { f32x4 oa = (f32x4){0.f, 0.f, 0.f, 0.f}, ob = oa; \
          const LAS unsigned char* sp = Lz + LS + sb * 16 * ROWB + r16 * ROWB; const LAS unsigned char* qb = Lz + LQ + st * TILEB + (16 * qi + r16) * ROWB; \
          _Pragma("unroll") for (int kk = 0; kk < KS / 2; kk += 2) { const int ks = kj * (KS / 2) + kk; const int ch0 = ((4 * ks + g) ^ r16) << 4, ch1 = ((4 * (ks + 1) + g) ^ r16) << 4; \
              const bf16x8 s0 = *(const LAS bf16x8*)(sp + ch0), q0 = *(const LAS bf16x8*)(qb + ch0), s1 = *(const LAS bf16x8*)(sp + ch1), q1 = *(const LAS bf16x8*)(qb + ch1); \
              oa = __builtin_amdgcn_mfma_f32_16x16x32_bf16(s0, q0, oa, 0, 0, 0); ob = __builtin_amdgcn_mfma_f32_16x16x32_bf16(s1, q1, ob, 0, 0, 0); } \
          *(LAS f32x4*)(Lz + LOT + (qi * 2 + kj) * 1024 + lane * 16) = oa + ob; } \
        P3T(4, pacc += __builtin_amdgcn_s_memtime() - pt0); P3T(5, pt0 = __builtin_amdgcn_s_memtime()); S5_WRITE(st ^ 1, RW); \
        LDS_WAIT(); P3T(5, pacc += __builtin_amdgcn_s_memtime() - pt0); P3T(6, pt0 = __builtin_amdgcn_s_memtime()); __builtin_amdgcn_s_barrier(); asm volatile("" ::: "memory"); P3T(6, pacc += __builtin_amdgcn_s_memtime() - pt0); \
    } while (0)
#define S5_EVEN(c_, ST) do { const int c = (c_); constexpr int st = (ST), sb = (ST); \
        LAS unsigned char* const Lz = L; const unsigned Lbz = Lb; \
        if (li < 2 && c >= 1) { const f32x4 pa = *(const LAS f32x4*)(Lz + LOT + (li * 2) * 1024 + lane * 16), pb = *(const LAS f32x4*)(Lz + LOT + (li * 2 + 1) * 1024 + lane * 16); \
            const f32x4 ot = ot_prev + (pa + pb); const int irow = 16 * li + r16; \
            if (c >= 2) { const size_t grow = (size_t)b * SEQ + (size_t)(c - 2) * 32 + irow; u32x2 pk; pk.x = cvt_pk_bf16(ot[0], ot[1]); pk.y = cvt_pk_bf16(ot[2], ot[3]); \
                *(u32x2*)(O + grow * LDO + h * DV + 16 * s + 4 * g) = pk; } \
            else if (!GLA && b == 0 && irow >= 16) { float* MO = WSP(float, WS_META + META_MO); *(f32x4*)(MO + (size_t)(irow - 16) * 2048 + h * 512 + 16 * s + 4 * g) = ot; } } \
        { s16x4 klo[NTU], khi[NTU]; \
          const bf16x8 vb = *(const LAS bf16x8*)(Lz + LV + st * 1024 + r16 * 64 + ((g ^ ((r16 >> 2) & 3)) << 4)); \
          _Pragma("unroll") for (int tt = 0; tt < NTU; ++tt) { const int tile = li + 4 * tt, d0 = 16 * tile, dcol = d0 + 4 * (r16 & 3), chunk = dcol >> 3, sub = (dcol & 7) * 2; \
              const int r1 = 8 * g + (r16 >> 2), r2 = r1 + 4; \
              klo[tt] = ds_tr_asm(Lbz + LK + st * TILEB + r1 * ROWB + ((chunk ^ (r1 & 15)) << 4) + sub); \
              khi[tt] = ds_tr_asm(Lbz + LK + st * TILEB + r2 * ROWB + ((chunk ^ (r2 & 15)) << 4) + sub); } \
          asm volatile("s_waitcnt lgkmcnt(0)" ::: "memory"); __builtin_amdgcn_sched_barrier(0); \
          _Pragma("unroll") for (int tt = 0; tt < NTU; ++tt) { \
              const bf16x8 ka = (bf16x8){klo[tt][0], klo[tt][1], klo[tt][2], klo[tt][3], khi[tt][0], khi[tt][1], khi[tt][2], khi[tt][3]}; \
              S[tt] = __builtin_amdgcn_mfma_f32_16x16x32_bf16(ka, vb, S[tt], 0, 0, 0); } \
          _Pragma("unroll") for (int tt = 0; tt < NTU; ++tt) { const int tile = li + 4 * tt; \
              if (GLA) { const f32x4 dl = *(const LAS f32x4*)(Lz + LDEC + st * 1024 + (16 * tile + 4 * g) * 4); \
                  S[tt][0] *= __expf(dl[0]); S[tt][1] *= __expf(dl[1]); S[tt][2] *= __expf(dl[2]); S[tt][3] *= __expf(dl[3]); } else S[tt] = S[tt] * g32; \
              u32x2 pk; pk.x = cvt_pk_bf16(S[tt][0], S[tt][1]); pk.y = cvt_pk_bf16(S[tt][2], S[tt][3]); \
              *(LAS u32x2*)(Lz + LS + (sb ^ 1) * 16 * ROWB + r16 * ROWB + (((2 * tile + (g >> 1)) ^ r16) << 4) + (g & 1) * 8) = pk; } } \
        LDS_WAIT(); __builtin_amdgcn_s_barrier(); asm volatile("" ::: "memory"); \
        if (li < 2) { const int irow = 16 * li + r16; \
            const bf16x8 va = *(const LAS bf16x8*)(Lz + LV + st * 1024 + r16 * 64 + ((g ^ ((r16 >> 2) & 3)) << 4)); \
            const bf16x8 pb = *(const LAS bf16x8*)(Lz + LP + irow * 64 + ((g ^ ((irow >> 2) & 3)) << 4)); \
            ot_prev = __builtin_amdgcn_mfma_f32_16x16x32_bf16(va, pb, (f32x4){0.f, 0.f, 0.f, 0.f}, 0, 0, 0); } \
        LDS_WAIT(); __builtin_amdgcn_s_barrier(); asm volatile("" ::: "memory"); \
    } while (0)
#if defined(PROBE3)
    unsigned long long pacc = 0ull, pt0 = 0ull;
#define P3T(q, stmt) do { if (PROBE3 == (q) && !GLA) { stmt; } } while (0)
#else
#define P3T(q, stmt) do {} while (0)
#endif
    if (hf) {
        for (int c2 = 0; c2 < 256; c2 += 2) { S5_ODD(c2, 0, ra, rb); S5_ODD(c2 + 1, 1, rb, ra); }
        S5_ODD(256, 0, ra, rb);
#if defined(PROBE3)
        if (!GLA && unit == 0 && w == 5 && lane == 0) { volatile LAS unsigned* MI = (volatile LAS unsigned*)(F.lds + LDS_MISC); MI[20] = (unsigned)pacc; MI[21] = (unsigned)(pacc >> 32); }
#endif
    } else {
        for (int c2 = 0; c2 < 256; c2 += 2) { S5_EVEN(c2, 0); S5_EVEN(c2 + 1, 1); }
        S5_EVEN(256, 0);
        if (li < 2) { const f32x4 pa = *(const LAS f32x4*)(L + LOT + (li * 2) * 1024 + lane * 16), pb = *(const LAS f32x4*)(L + LOT + (li * 2 + 1) * 1024 + lane * 16);
            const f32x4 ot = ot_prev + (pa + pb); const int irow = 16 * li + r16;
            const size_t grow = (size_t)b * SEQ + (size_t)(NSTEP - 2) * 32 + irow; u32x2 pk; pk.x = cvt_pk_bf16(ot[0], ot[1]); pk.y = cvt_pk_bf16(ot[2], ot[3]);
            *(u32x2*)(O + grow * LDO + h * DV + 16 * s + 4 * g) = pk; }
    }
#undef S5_ODD
#undef S5_EVEN
#undef S5_LOAD
#undef S5_WRITE
}

__device__ __forceinline__ void final_phase(Frame& F, const float* SS, const float* gain) {
    const int gw = F.vcu * NWAVES + F.wave, NGW = F.G * NWAVES; const bf16_t* HB = WSP(bf16_t, WS_HB);
    f32x4 gv[4];
#pragma unroll
    for (int j = 0; j < 4; ++j) gv[j] = *(const f32x4*)(gain + 4 * F.lane + 256 * j);
    for (int m = gw; m < M; m += NGW) { float* row = F.out + (size_t)m * D; const float rs = row_rstd(SS, m);
#pragma unroll
        for (int j = 0; j < 4; ++j) { const u32x2 hv = *(const u32x2*)(HB + (size_t)m * D + 4 * F.lane + 256 * j);
            f32x4 v = (f32x4){bf_lo(hv.x), bf_hi(hv.x), bf_lo(hv.y), bf_hi(hv.y)}; v = v * rs * gv[j]; *(f32x4*)(row + 4 * F.lane + 256 * j) = v; } }
}
__device__ __forceinline__ void p0_rows(Frame& F) {
    const int gw = F.vcu * NWAVES + F.wave, NGW = F.G * NWAVES; const float* x = F.in[0]; bf16_t* HB = WSP(bf16_t, WS_HB); float* SS = WSP(float, WS_SS);
    for (int m = gw; m < M; m += 2 * NGW) { const int m2 = m + NGW;
        f32x4 va[4], vb[4];
#pragma unroll
        for (int j = 0; j < 4; ++j) { va[j] = *(const f32x4*)(x + (size_t)m * D + 4 * F.lane + 256 * j); vb[j] = *(const f32x4*)(x + (size_t)m2 * D + 4 * F.lane + 256 * j); }
        float s = 0.f, s2 = 0.f;
#pragma unroll
        for (int j = 0; j < 4; ++j) { const f32x4 v = va[j], u = vb[j]; s += (v[0] * v[0] + v[1] * v[1]) + (v[2] * v[2] + v[3] * v[3]); s2 += (u[0] * u[0] + u[1] * u[1]) + (u[2] * u[2] + u[3] * u[3]);
            u32x2 pk; pk.x = cvt_pk_bf16(v[0], v[1]); pk.y = cvt_pk_bf16(v[2], v[3]); *(u32x2*)(HB + (size_t)m * D + 4 * F.lane + 256 * j) = pk;
            pk.x = cvt_pk_bf16(u[0], u[1]); pk.y = cvt_pk_bf16(u[2], u[3]); *(u32x2*)(HB + (size_t)m2 * D + 4 * F.lane + 256 * j) = pk; }
        s = wave_sum(s); s2 = wave_sum(s2);
        if (F.lane < 16) { SS[(size_t)m * 16 + F.lane] = F.lane == 0 ? s : 0.f; SS[(size_t)m2 * 16 + F.lane] = F.lane == 0 ? s2 : 0.f; } }
    if (blockIdx.x == 0) { float* HM = WSP(float, WS_META + META_HM); for (int i = F.tid; i < 16 * D; i += NTHREADS) HM[i] = F.in[1][i]; }
}

#ifndef S2FN
#define S2FN s2v5_phase
#endif
struct Args { const float* in[18]; float* out; unsigned char* ws; int ph_lo, ph_hi; };
constexpr int N_PHASES = 19;
__global__ void __launch_bounds__(NTHREADS, 2) fwd(Args args) {
    extern __shared__ __attribute__((aligned(16))) unsigned char lds_raw[];
    Frame F;
    F.lds = (LAS unsigned char*)lds_raw;
    F.tid = threadIdx.x; F.lane = F.tid & 63; F.wave = __builtin_amdgcn_readfirstlane(F.tid >> 6);
    F.G = gridDim.x; { const int bx = blockIdx.x; F.vcu = (F.G % 8 == 0) ? (bx % 8) * (F.G / 8) + bx / 8 : bx; }
    F.ws = args.ws; F.out = args.out;
#pragma unroll
    for (int i = 0; i < 18; ++i) F.in[i] = args.in[i];
    volatile LAS unsigned* MISC = (volatile LAS unsigned*)(F.lds + LDS_MISC);
    if (F.tid < 64) MISC[F.tid] = 0u;
    __syncthreads();
    XcdBarrier bar = xcd_barrier_post(WSP(unsigned, WS_CTL) + CW_BAR, MISC + 8);
    const int lo = args.ph_lo, hi = args.ph_hi;
    __syncthreads();
    F.vb = (int)blockIdx.x;
    int vblk = (int)blockIdx.x;
#define IN(k) (lo <= (k) && (k) < hi)
#if defined(PROBE_PHASE)
    unsigned long long t_prev = __builtin_amdgcn_s_memrealtime(), t_probe = 0ull;
#define SEAM(k) do { if (IN(k) && IN((k) + 1)) xcd_barrier(bar); { const unsigned long long t_now = __builtin_amdgcn_s_memrealtime(); if ((k) == PROBE_PHASE) t_probe = t_now - t_prev; t_prev = t_now; } } while (0)
#else
#define SEAM(k) do { if (IN(k) && IN((k) + 1)) xcd_barrier(bar); } while (0)
#endif
    bf16_t* HB = WSP(bf16_t, WS_HB); float* SS = WSP(float, WS_SS); float* H = F.out;
    bf16_t* ACT = WSP(bf16_t, WS_ACT);
    const int gw = F.vcu * NWAVES + F.wave, NGW = F.G * NWAVES;
    float* RAW = WSP(float, WS_META + META_RAW); float* HM = WSP(float, WS_META + META_HM);

#define FFN_IN(win, do_meta) do { \
        if ((do_meta) && meta_has_tiles(F, 2 * DFF, 128, 128)) { meta_prep_h(F); meta_tiles<0>(F, WSP(bf16_t, (win)), 2 * DFF, D, RAW, 2 * DFF, 1.f, 128, 128); } \
        pg8::Order S_; S_.init(M / 256, 22, F.G, vblk); PtrNormal P_{(const char*)HB, (const char*)WSP(bf16_t, (win)), (size_t)256 * D * 2}; \
        EpiSwiglu E_{SS, ACT}; pg8::gemm_phase(F.lds, D, S_, P_, E_); } while (0)
#define FFN_OUT(wout, do_meta, F32B) do { \
        if (do_meta) { meta_prep_act_q(F); meta_tiles_ksplit(F, WSP(bf16_t, (wout)), DFF, 704, HM, 0.5f); } \
        pg8::Order S_; S_.init(M / 256, 4, F.G, vblk); PtrNormal P_{(const char*)ACT, (const char*)WSP(bf16_t, (wout)), (size_t)256 * DFF * 2}; \
        EpiResid<F32B> E_{F.in[0], HB, SS, 0.5f}; pg8::gemm_phase(F.lds, DFF, S_, P_, E_); } while (0)

#define slack (vblk >= 128)
#define sgw ((vblk - 128) * NWAVES + F.wave)
    const int SNGW = 128 * NWAVES;
    if (IN(0)) {
        int cb = conv_job(F, job_ffn_in(F, 0, 0, WS_WFFN_A + WF_IN), 0, gw, NGW); cb = conv_job(F, job_ffn_out(F, 0, 0, WS_WFFN_A + WF_OUT), cb, gw, NGW);
        p0_rows(F);
    }
    SEAM(0);
    if (lo == 0 && hi == N_PHASES && F.G == 256) {
        const unsigned* barw = WSP(unsigned, WS_CTL) + CW_BAR; bool ok = true;
#pragma unroll
        for (int j = 0; j < 8; ++j) ok = ok && (__hip_atomic_load(barw + XB_XCNT(j), __ATOMIC_RELAXED, __HIP_MEMORY_SCOPE_AGENT) == 32u);
        const unsigned rank = MISC[10], xcc = MISC[11];
        if (ok && rank < 32u && xcc < 8u) vblk = (int)(rank * 8u + xcc);
    }
    F.vb = vblk;
    if (IN(1)) {
        if (slack) { ConvJob J;
            J.W = F.in[9]; J.ldn = 6144; J.K = D; J.N = 6144; J.col0 = 0; J.kind = 0; J.gain = F.in[5]; J.WT = WSP(bf16_t, WS_WMIX + WM_RET_IN);
            int cb = conv_job(F, J, 0, sgw, SNGW);
            J.W = F.in[11]; J.ldn = D; J.K = 2048; J.N = D; J.col0 = 0; J.kind = 0; J.gain = F.in[10]; J.WT = WSP(bf16_t, WS_WMIX + WM_RET_OUT);
            cb = conv_job(F, J, cb, sgw, SNGW);
            cb = conv_job(F, job_ffn_in(F, 0, 1, WS_WFFN_C), cb, sgw, SNGW); __syncthreads(); }
        FFN_IN(WS_WFFN_A + WF_IN, true);
    }
    SEAM(1);
    if (IN(2)) FFN_OUT(WS_WFFN_A + WF_OUT, true, false);
    SEAM(2);
    if (IN(3)) {
        if (meta_has_tiles(F, 6144, 0, 256)) { meta_prep_h(F); meta_tiles<0>(F, WSP(bf16_t, WS_WMIX + WM_RET_IN), 6144, D, RAW, 6144, 1.f, 0, 256); }
        pg8::Order S_; S_.init(M / 256, 16, F.G, vblk);
        PtrSwapFrom P_{(const char*)HB, (const char*)WSP(bf16_t, WS_WMIX + WM_RET_IN), (size_t)256 * D * 2, 8};
        EpiRetIn E_{SS, WSP(bf16_t, WS_QH), WSP(bf16_t, WS_KH), WSP(bf16_t, WS_VT)}; pg8::gemm_phase(F.lds, D, S_, P_, E_);
    }
    SEAM(3);
    if (IN(4)) S2FN<256, 512, false>(F, vblk, WSP(bf16_t, WS_QH), WSP(bf16_t, WS_KH), WSP(bf16_t, WS_VT), WSP(bf16_t, WS_O), nullptr, 6144);
    SEAM(4);
    if (IN(5)) {
        (void)conv_job(F, job_ffn_out(F, 0, 1, WS_WFFN_A + WF_OUT), 0, gw, NGW);
        __syncthreads();
        pg8::Order S_; S_.init(M / 256, 8, F.G, vblk); PtrNormal P_{(const char*)HB, (const char*)(WSP(bf16_t, WS_WMIX + WM_RET_IN) + (size_t)4096 * D), (size_t)256 * D * 2};
        EpiGate<512, 2048> E_{SS, WSP(bf16_t, WS_O), WSP(bf16_t, WS_VT), (LAS float*)(F.lds + 132096)}; pg8::gemm_phase(F.lds, D, S_, P_, E_);
    }
    SEAM(5);
    if (IN(6)) {
        { meta_prep_y_q(F); meta_tiles_ksplit(F, WSP(bf16_t, WS_WMIX + WM_RET_OUT), 2048, 512, HM, 1.0f); }
        pg8::Order S_; S_.init(M / 256, 4, F.G, vblk); PtrNormal P_{(const char*)WSP(bf16_t, WS_VT), (const char*)WSP(bf16_t, WS_WMIX + WM_RET_OUT), (size_t)256 * 2048 * 2};
        EpiResid<false> E_{nullptr, HB, SS, 1.0f}; pg8::gemm_phase(F.lds, 2048, S_, P_, E_);
    }
    SEAM(6);
    if (IN(7)) {
        if (slack) { int cb = conv_job(F, job_ffn_in(F, 1, 0, WS_WFFN_B + WF_IN), 0, sgw, SNGW); cb = conv_job(F, job_ffn_out(F, 1, 0, WS_WFFN_B + WF_OUT), cb, sgw, SNGW);
            ConvJob J;
            J.W = F.in[12]; J.ldn = 3088; J.K = D; J.N = 3072; J.col0 = 0; J.kind = 0; J.gain = F.in[5] + D; J.WT = WSP(bf16_t, WS_WMIX + WM_GLA_IN);
            cb = conv_job(F, J, cb, sgw, SNGW);
            J.W = F.in[16]; J.ldn = D; J.K = D; J.N = D; J.col0 = 0; J.kind = 0; J.gain = F.in[15]; J.WT = WSP(bf16_t, WS_WMIX + WM_GLA_OUT);
            cb = conv_job(F, J, cb, sgw, SNGW);
            if (vblk == F.G - 1) { bf16_t* WZ = WSP(bf16_t, WS_WMIX + WM_GLA_Z); const float* W = F.in[12]; const float* gn = F.in[5] + D;
                for (int i = F.tid; i < 16 * D; i += NTHREADS) { const int k = i >> 4, r = i & 15; WZ[r * D + k] = f2bf(W[(size_t)k * 3088 + 3072 + r] * gn[k]); } }
            __syncthreads(); }
        FFN_IN(WS_WFFN_C, true);
    }
    SEAM(7);
    if (IN(8)) FFN_OUT(WS_WFFN_A + WF_OUT, true, false);
    SEAM(8);
    if (IN(9)) {
        if (slack) { int cb = conv_job(F, job_ffn_in(F, 1, 1, WS_WFFN_A + WF_IN), 0, sgw, SNGW); cb = conv_job(F, job_ffn_out(F, 1, 1, WS_WFFN_A + WF_OUT), cb, sgw, SNGW); __syncthreads(); }
        FFN_IN(WS_WFFN_B + WF_IN, true);
    }
    SEAM(9);
    if (IN(10)) FFN_OUT(WS_WFFN_B + WF_OUT, true, false);
    SEAM(10);
    if (IN(11)) {
        if (meta_has_tiles(F, 2048, 0, 256)) { meta_prep_h(F); meta_tiles<0>(F, WSP(bf16_t, WS_WMIX + WM_GLA_IN), 2048, D, RAW, 3088, 1.f, 0, 256); }
        if (F.vb == 0) meta_tiles<0>(F, WSP(bf16_t, WS_WMIX + WM_GLA_Z), 16, D, RAW + 3072, 3088, 1.f, 0, 256);
        __syncthreads();
        z_phase(F, HB, SS, WSP(bf16_t, WS_WMIX + WM_GLA_Z), F.in[13], F.in[14], WSP(float, WS_BC));
    }
    SEAM(11);
    if (IN(12)) {
        pg8::Order S_; S_.init(M / 256, 8, F.G, vblk);
        PtrSwapFrom P_{(const char*)HB, (const char*)WSP(bf16_t, WS_WMIX + WM_GLA_IN), (size_t)256 * D * 2, 4};
        EpiGlaIn E_{SS, WSP(float, WS_BC), WSP(bf16_t, WS_QH2), WSP(bf16_t, WS_KH2), WSP(bf16_t, WS_VT2)}; pg8::gemm_phase(F.lds, D, S_, P_, E_);
    }
    SEAM(12);
    if (IN(13)) S2FN<128, 256, true>(F, vblk, WSP(bf16_t, WS_QH2), WSP(bf16_t, WS_KH2), WSP(bf16_t, WS_VT2), WSP(bf16_t, WS_O2), WSP(float, WS_BC), 3088);
    SEAM(13);
    if (IN(14)) {
        pg8::Order S_; S_.init(M / 256, 4, F.G, vblk); PtrNormal P_{(const char*)HB, (const char*)WSP(bf16_t, WS_WMIX + WM_GLA_G), (size_t)256 * D * 2};
        EpiGate<256, 1024> E_{SS, WSP(bf16_t, WS_O2), WSP(bf16_t, WS_VT2), (LAS float*)(F.lds + 132096)}; pg8::gemm_phase(F.lds, D, S_, P_, E_);
    }
    SEAM(14);
    if (IN(15)) {
        pg8::Order S_; S_.init(M / 256, 4, F.G, vblk); PtrNormal P_{(const char*)WSP(bf16_t, WS_VT2), (const char*)WSP(bf16_t, WS_WMIX + WM_GLA_OUT), (size_t)256 * D * 2};
        EpiResid<false> E_{nullptr, HB, SS, 1.0f}; pg8::gemm_phase(F.lds, D, S_, P_, E_);
    }
    SEAM(15);
    if (IN(16)) FFN_IN(WS_WFFN_A + WF_IN, false);
    SEAM(16);
    if (IN(17)) FFN_OUT(WS_WFFN_A + WF_OUT, false, false);
    SEAM(17);
    if (IN(18)) final_phase(F, SS, F.in[17]);
#if defined(PROBE2) || defined(PROBE3)
    __syncthreads();
    if (vblk == 0 && F.tid == 0) { const unsigned long long cyc = ((unsigned long long)MISC[21] << 32) | MISC[20]; const unsigned long long t0 = __builtin_amdgcn_s_memtime(); while (__builtin_amdgcn_s_memtime() - t0 < 4ull * cyc) __builtin_amdgcn_s_sleep(16); }
#endif
#if defined(PROBE_PHASE)
    { const unsigned long long t_now = __builtin_amdgcn_s_memrealtime(); if (18 == PROBE_PHASE) t_probe = t_now - t_prev;
      if (blockIdx.x == 0 && F.tid == 0) { const unsigned long long t_end = t_now + (unsigned long long)PROBE_MULT * t_probe; while (__builtin_amdgcn_s_memrealtime() < t_end) __builtin_amdgcn_s_sleep(16); } }
#endif
#undef slack
#undef sgw
#undef IN
#undef SEAM
#undef FFN_IN
#undef FFN_OUT
}
}
#ifndef MK_MODE
#define MK_MODE 0
#endif
#if MK_MODE == 2
namespace dbg {
__global__ void adapt(const float* Hreal, const float* HMtmp, float* Hn) {
    const size_t i = (size_t)blockIdx.x * blockDim.x + threadIdx.x;
    if (i >= (size_t)nv::ROWS * nv::D) return;
    const int d = (int)(i % nv::D); const size_t row = i / nv::D; const int b = (int)(row / nv::TT), s = (int)(row % nv::TT);
    Hn[i] = s < nv::NMETA ? HMtmp[s * nv::D + d] : Hreal[((size_t)b * nv::SEQ + (s - nv::NMETA)) * nv::D + d];
}
}
#endif
extern "C" void kernel_launch(void* const* d_in, const int* in_sizes, int n_in, void* d_out, int out_size, void* d_ws, size_t ws_size, hipStream_t stream) {
    static int grid = 0;
    if (grid == 0) {
        if (n_in != 18 || out_size != mk::M * mk::D || ws_size < mk::WS_NEED) { fprintf(stderr, "kernel_launch: unexpected sizes n_in %d out %d ws %zu\n", n_in, out_size, ws_size); grid = -1; return; }
        int dev = 0, cus = 0, per_cu = 0;
        if (hipGetDevice(&dev) != hipSuccess || hipDeviceGetAttribute(&cus, hipDeviceAttributeMultiprocessorCount, dev) != hipSuccess) { grid = -1; return; }
        if (hipFuncSetAttribute((const void*)mk::fwd, hipFuncAttributeMaxDynamicSharedMemorySize, mk::LDS_BYTES) != hipSuccess) { fprintf(stderr, "kernel_launch: hipFuncSetAttribute failed\n"); grid = -1; return; }
        if (hipOccupancyMaxActiveBlocksPerMultiprocessor(&per_cu, (const void*)mk::fwd, mk::NTHREADS, mk::LDS_BYTES) != hipSuccess || per_cu < 1) { fprintf(stderr, "kernel_launch: occupancy query says %d\n", per_cu); per_cu = 1; }
        (void)hipGetLastError();
        grid = cus;
        if (grid != 256) fprintf(stderr, "kernel_launch: %d CUs (built for 256)\n", grid);
    }
    if (grid < 0) return;
    (void)hipMemsetAsync((char*)d_ws + mk::WS_CTL, 0, mk::CTL_ZERO_BYTES, stream);
    mk::Args a{};
    for (int i = 0; i < 18; ++i) a.in[i] = (const float*)d_in[i];
    a.out = (float*)d_out; a.ws = (unsigned char*)d_ws;
#if MK_MODE == 0
    a.ph_lo = 0; a.ph_hi = mk::N_PHASES;
    hipLaunchKernelGGL(mk::fwd, dim3(grid), dim3(mk::NTHREADS), mk::LDS_BYTES, stream, a);
#elif MK_MODE == 1
    for (int p = 0; p < mk::N_PHASES; ++p) { a.ph_lo = p; a.ph_hi = p + 1; hipLaunchKernelGGL(mk::fwd, dim3(grid), dim3(mk::NTHREADS), mk::LDS_BYTES, stream, a); }
#else
    for (int p = 0; p < MK_CUT; ++p) { a.ph_lo = p; a.ph_hi = p + 1; hipLaunchKernelGGL(mk::fwd, dim3(grid), dim3(mk::NTHREADS), mk::LDS_BYTES, stream, a); }
    {
        float* tmp = (float*)((char*)d_ws + 250 * mk::MiB);
        (void)hipMemcpyAsync(tmp, (char*)d_ws + mk::WS_META + mk::META_HM, 16 * 1024 * 4, hipMemcpyDeviceToDevice, stream);
        hipLaunchKernelGGL(dbg::adapt, dim3((unsigned)(((size_t)nv::ROWS * nv::D + 255) / 256)), dim3(256), 0, stream, (const float*)d_out, (const float*)tmp, (float*)d_ws);
        nv::forward(stream, d_in, (float*)d_out, (char*)d_ws, MK_STAGE);
    }
#endif
}
```

```cpp
#include <hip/hip_runtime.h>
#include <cstdint>
#include <cstdio>
#include <cmath>
#define MK_MODE 0
namespace mk {
#define LAS __attribute__((address_space(3)))
#define GAS __attribute__((address_space(1)))
typedef unsigned short bf16_t;
typedef short bf16x8 __attribute__((ext_vector_type(8)));
typedef short s16x4 __attribute__((ext_vector_type(4)));
typedef float f32x4 __attribute__((ext_vector_type(4)));
typedef float f32x2 __attribute__((ext_vector_type(2)));
typedef unsigned u32x4 __attribute__((ext_vector_type(4)));
typedef unsigned u32x2 __attribute__((ext_vector_type(2)));

constexpr int M = 16384, D = 1024, DFF = 2816, SEQ = 8192, NMETA = 16;
constexpr int NWAVES = 8, NTHREADS = 512;
constexpr size_t MiB = 1u << 20;
constexpr size_t WS_CTL = 0, CTL_ZERO_BYTES = 1 * MiB;
constexpr size_t CTL_OSS_RET = 256 * 1024, CTL_OSS_GLA = 512 * 1024, CTL_MOSS = 768 * 1024;
constexpr size_t WS_HB = 1 * MiB, WS_SS = 33 * MiB, WS_META = 34 * MiB, WS_WMIX = 35 * MiB;
constexpr size_t META_HM = 0, META_RAW = 64 * 1024, META_MO = 448 * 1024;
constexpr size_t WS_WFFN_A = 52 * MiB, WS_ACT = 69 * MiB, WS_WFFN_B = 157 * MiB, WS_WFFN_C = 244 * MiB;
constexpr size_t WS_QH = 52 * MiB, WS_KH = 84 * MiB, WS_VT = 116 * MiB, WS_O = 180 * MiB;
constexpr size_t WS_BC = 69 * MiB, WS_QH2 = 101 * MiB, WS_KH2 = 117 * MiB, WS_VT2 = 133 * MiB, WS_O2 = 174 * MiB;
constexpr size_t WS_NEED = 256 * MiB;
constexpr size_t WM_RET_IN = 0, WM_RET_OUT = 12 * MiB;
constexpr size_t WM_GLA_IN = 0, WM_GLA_G = 4 * MiB, WM_GLA_OUT = 6 * MiB, WM_GLA_Z = 8 * MiB;
constexpr size_t WF_IN = 0, WF_OUT = 11 * MiB;
constexpr int CW_BAR = 4096;

constexpr int LDS_BYTES = 163840;
constexpr int LDS_MISC = LDS_BYTES - 256;

__constant__ float L2G[4] = {-0.04580368961312478f, -0.02272007650008353f, -0.011315313227834133f, -0.005646563141142062f};
__constant__ float ROPE_INV[128] = {
  1.000000000e+00f, 9.300450087e-01f, 8.649836779e-01f, 8.044736385e-01f,
  7.481966019e-01f, 6.958565116e-01f, 6.471778154e-01f, 6.019044518e-01f,
  5.597981811e-01f, 5.206375122e-01f, 4.842162728e-01f, 4.503428936e-01f,
  4.188391268e-01f, 3.895392120e-01f, 3.622889817e-01f, 3.369450271e-01f,
  3.133740425e-01f, 2.914519310e-01f, 2.710633874e-01f, 2.521011233e-01f,
  2.344653904e-01f, 2.180633694e-01f, 2.028087080e-01f, 1.886212230e-01f,
  1.754262149e-01f, 1.631542742e-01f, 1.517407894e-01f, 1.411257535e-01f,
  1.312533021e-01f, 1.220714748e-01f, 1.135319397e-01f, 1.055898219e-01f,
  9.820328653e-02f, 9.133346379e-02f, 8.494423330e-02f, 7.900195569e-02f,
  7.347535342e-02f, 6.833537668e-02f, 6.355497986e-02f, 5.910899118e-02f,
  5.497401953e-02f, 5.112830922e-02f, 4.755162448e-02f, 4.422515258e-02f,
  4.113136977e-02f, 3.825402260e-02f, 3.557796404e-02f, 3.308910504e-02f,
  3.077435680e-02f, 2.862153389e-02f, 2.661931701e-02f, 2.475716174e-02f,
  2.302526683e-02f, 2.141453326e-02f, 1.991648041e-02f, 1.852322184e-02f,
  1.722742990e-02f, 1.602228358e-02f, 1.490144618e-02f, 1.385901403e-02f,
  1.288950257e-02f, 1.198781747e-02f, 1.114920899e-02f, 1.036926545e-02f,
  9.643883444e-03f, 8.969245479e-03f, 8.341802284e-03f, 7.758250926e-03f,
  7.215522230e-03f, 6.710760761e-03f, 6.241309457e-03f, 5.804697983e-03f,
  5.398627371e-03f, 5.020966288e-03f, 4.669724498e-03f, 4.343053792e-03f,
  4.039235413e-03f, 3.756670747e-03f, 3.493872471e-03f, 3.249458736e-03f,
  3.022142686e-03f, 2.810728736e-03f, 2.614103956e-03f, 2.431234345e-03f,
  2.261157380e-03f, 2.102978062e-03f, 1.955864020e-03f, 1.819041790e-03f,
  1.691789716e-03f, 1.573440502e-03f, 1.463370281e-03f, 1.361000235e-03f,
  1.265791478e-03f, 1.177242957e-03f, 1.094888896e-03f, 1.018295996e-03f,
  9.470609948e-04f, 8.808093844e-04f, 8.191923262e-04f, 7.618857198e-04f,
  7.085879333e-04f, 6.590186385e-04f, 6.129170069e-04f, 5.700403708e-04f,
  5.301629426e-04f, 4.930753494e-04f, 4.585822753e-04f, 4.265021416e-04f,
  3.966661752e-04f, 3.689173318e-04f, 3.431097430e-04f, 3.191074939e-04f,
  2.967843320e-04f, 2.760227653e-04f, 2.567135962e-04f, 2.387551940e-04f,
  2.220530587e-04f, 2.065193403e-04f, 1.920722716e-04f, 1.786358480e-04f,
  1.661392889e-04f, 1.545170089e-04f, 1.437077590e-04f, 1.336546848e-04f,
  1.243048755e-04f, 1.156091312e-04f, 1.075216787e-04f, 9.999999747e-05f,
};

#define LDS_WAIT() asm volatile("s_waitcnt lgkmcnt(0)" ::: "memory")
#define VM_WAIT() asm volatile("s_waitcnt vmcnt(0)" ::: "memory")
#define RLX_AGENT __ATOMIC_RELAXED, __HIP_MEMORY_SCOPE_AGENT

__device__ __forceinline__ unsigned cvt_pk_bf16(float lo, float hi) { unsigned r; asm volatile("v_cvt_pk_bf16_f32 %0, %1, %2" : "=v"(r) : "v"(lo), "v"(hi)); return r; }
__device__ __forceinline__ float bf_lo(unsigned w) { return __uint_as_float(w << 16); }
__device__ __forceinline__ float bf_hi(unsigned w) { return __uint_as_float(w & 0xffff0000u); }
__device__ __forceinline__ unsigned short f2bf(float f) { return (unsigned short)(cvt_pk_bf16(f, 0.f) & 0xffffu); }
__device__ __forceinline__ float fsilu(float v) { return v * __builtin_amdgcn_rcpf(1.0f + __expf(-v)); }
__device__ __forceinline__ float wave_sum(float v) {
#pragma unroll
    for (int o = 1; o < 64; o <<= 1) v += __shfl_xor(v, o);
    return v;
}
__device__ __forceinline__ float row_rstd(const float* SS, int row) {
    const f32x4* p = (const f32x4*)(SS + (size_t)row * 16);
    const f32x4 a = p[0], b = p[1], c = p[2], d = p[3];
    const float s = ((a.x + a.y) + (a.z + a.w)) + ((b.x + b.y) + (b.z + b.w)) + ((c.x + c.y) + (c.z + c.w)) + ((d.x + d.y) + (d.z + d.w));
    return 1.0f / sqrtf(s * (1.0f / 1024.0f) + 1e-6f);
}

#define XB_TMO      128
#define XB_XCNT(j)  (256  + 64 * (j))
#define XB_XSUB(j)  (1280 + 64 * (j))
#define XB_XGEN(j)  (2304 + 64 * (j))
#define XB_TOP      3328
#define XB_TOPGEN   3392
#define XCD_BAR_WORDS 3456
#define XB_SPIN_CAP (1u << 18)
__device__ __forceinline__ unsigned xb_ld(unsigned* p)              { return __hip_atomic_load(p, __ATOMIC_RELAXED, __HIP_MEMORY_SCOPE_AGENT); }
__device__ __forceinline__ unsigned xb_add(unsigned* p, unsigned v) { return __hip_atomic_fetch_add(p, v, __ATOMIC_RELAXED, __HIP_MEMORY_SCOPE_AGENT); }
__device__ __forceinline__ unsigned xb_xcc_id() { return (unsigned)__builtin_amdgcn_s_getreg((3 << 11) | 20) & 0xFu; }
#define XB_SPIN(cond, bar) do { unsigned _sp = 0; while (cond) { __builtin_amdgcn_s_sleep(1); \
    if ((++_sp & 255u) == 0u) { if (xb_ld(&(bar)[XB_TMO])) break; if (_sp > XB_SPIN_CAP) { atomicAdd(&(bar)[XB_TMO], 1u); break; } } } } while (0)
struct XcdBarrier { unsigned* bar; unsigned x; volatile LAS unsigned* st; };
__device__ __forceinline__ XcdBarrier xcd_barrier_post(unsigned* bar, volatile LAS unsigned* st) {
    XcdBarrier b; b.bar = bar; b.x = xb_xcc_id(); b.st = st;
    if (threadIdx.x == 0) { const unsigned rank = xb_add(&bar[XB_XCNT(b.x)], 1u); st[2] = rank; st[3] = b.x; }
    return b;
}
__device__ __forceinline__ void xcd_barrier_complete(unsigned* bar, unsigned x, unsigned& nloc, unsigned& nx) {
    const unsigned G = gridDim.x * gridDim.y * gridDim.z;
    unsigned sum, cnt, mine, sp = 0u;
    for (;;) {
        sum = 0u; cnt = 0u; mine = 0u;
#pragma unroll
        for (unsigned j = 0; j < 16; ++j) { const unsigned c = xb_ld(&bar[XB_XCNT(j)]); sum += c; cnt += (c > 0u) ? 1u : 0u; mine = (j == x) ? c : mine; }
        if (sum == G) break;
        __builtin_amdgcn_s_sleep(1);
        if ((++sp & 255u) == 0u) { if (xb_ld(&bar[XB_TMO])) break; if (sp > XB_SPIN_CAP) { atomicAdd(&bar[XB_TMO], 1u); break; } }
    }
    nloc = mine > 0u ? mine : 1u; nx = cnt > 0u ? cnt : 1u;
}
__device__ __forceinline__ void xcd_barrier(const XcdBarrier& b) {
    asm volatile("s_waitcnt vmcnt(0)" ::: "memory");
    __syncthreads();
    if (threadIdx.x == 0) {
        unsigned* bar = b.bar;
        __builtin_amdgcn_s_waitcnt(0);
        unsigned nloc = b.st[0], nx = b.st[1];
        if (nloc == 0u) { xcd_barrier_complete(bar, b.x, nloc, nx); b.st[0] = nloc; b.st[1] = nx; }
        const unsigned old = xb_add(&bar[XB_XSUB(b.x)], 1u);
        const unsigned gen = old / nloc;
        if (old + 1u == (gen + 1u) * nloc) {
            __builtin_amdgcn_fence(__ATOMIC_RELEASE, "agent");
            asm volatile("s_waitcnt vmcnt(0)" ::: "memory");
            const unsigned og = xb_add(&bar[XB_TOP], 1u);
            const unsigned tg = og / nx;
            if (og + 1u == (tg + 1u) * nx) xb_add(&bar[XB_TOPGEN], 1u);
            else XB_SPIN(xb_ld(&bar[XB_TOPGEN]) == tg, bar);
            __builtin_amdgcn_fence(__ATOMIC_ACQUIRE, "agent");
            xb_add(&bar[XB_XGEN(b.x)], 1u);
            asm volatile("s_waitcnt vmcnt(0)" ::: "memory");
        } else {
            XB_SPIN(xb_ld(&bar[XB_XGEN(b.x)]) == gen, bar);
            __builtin_amdgcn_fence(__ATOMIC_ACQUIRE, "agent");
            asm volatile("s_waitcnt vmcnt(0)" ::: "memory");
        }
    }
    __syncthreads();
}

namespace pg8 {
constexpr int BM = 256, BK = 64, HALF = 128, HTB = HALF * BK * 2, STAGE_BYTES = 8 * HTB, NXCD = 8, WGM = 8;
__host__ __device__ __forceinline__ int lds_byte(int r, int c) { const int st = (r >> 4) * 2 + (c >> 5), rr = r & 15, cc = c & 31, ob = rr * 64 + cc * 2; return st * 1024 + (ob ^ (((ob >> 9) & 1) << 5)); }
__host__ __device__ __forceinline__ void stage_rc(int b, int& R, int& C) { const int st = b / 1024, sb = b % 1024, swz = sb ^ (((sb >> 9) & 1) << 5); R = (st >> 1) * 16 + swz / 64; C = (st & 1) * 32 + (swz % 64) / 2; }
__host__ __device__ __forceinline__ int perm32(int rho) { const int n = rho >> 4, i = rho & 15; return 8 * (i >> 2) + 4 * n + (i & 3); }
struct Unit { int pm, pn; };
struct Order {
    int nM, nN, nwg, G, c;
    __device__ void init(int nM_, int nN_, int G_, int c_) { nM = nM_; nN = nN_; nwg = nM * nN; G = G_; c = c_; }
    __device__ bool next(int i, Unit& u) const {
        const long L = (long)i * G + c; if (L >= nwg) return false;
        int wgid = (int)L; { const int q = nwg / NXCD, r = nwg % NXCD, xcd = wgid % NXCD, off = wgid / NXCD; wgid = (xcd < r ? xcd * (q + 1) : r * (q + 1) + (xcd - r) * q) + off; }
        const int nig = WGM * nN, gid = wgid / nig, fm = gid * WGM, gsz = (nM - fm) < WGM ? (nM - fm) : WGM;
        u.pm = fm + ((wgid % nig) % gsz); u.pn = (wgid % nig) / gsz; return true;
    }
};
template <class Epi, class Ptr>
__device__ __forceinline__ void gemm_phase(LAS unsigned char* lds, const int K, const Order& S, const Ptr& P, const Epi& E) {
    const int tid = threadIdx.x, wid = __builtin_amdgcn_readfirstlane(tid >> 6), lane = tid & 63, wr = wid >> 2, wc = wid & 3, fr = lane & 15, fq = lane >> 4;
    const int nt = K / BK;
    unsigned voffA[2], voffB[2];
#pragma unroll
    for (int i = 0; i < 2; ++i) { int R, C; stage_rc(tid * 16 + i * 8192, R, C); const int Rb = (R & ~31) + perm32(R & 31);
        voffA[i] = (unsigned)(R * K + C) * 2u; voffB[i] = (unsigned)(Rb * K + C) * 2u; }
    const size_t kstep = (size_t)(BK * 2);
    const size_t hstep = (size_t)HALF * K * 2;
    const unsigned ldsw = (unsigned)wid * 1024u;
    const int aoff = lds_byte(wr * 64 + fr, fq * 8), boff = lds_byte(wc * 32 + fr, fq * 8);
#define PG8_SA(b, h) (((b) * 2 + (h)) * HTB)
#define PG8_SB(b, h) ((4 + (b) * 2 + (h)) * HTB)
#define PG8_STAGE(bufoff, gbase, voff) do { _Pragma("unroll") for (int _i = 0; _i < 2; ++_i) \
        __builtin_amdgcn_global_load_lds((const unsigned*)((const char*)(gbase) + (voff)[_i]), (LAS unsigned*)(lds + (bufoff) + ldsw + _i * 8192), 16, 0, 0); } while (0)
#define PG8_LDA(dst, b, h) do { _Pragma("unroll") for (int m = 0; m < 4; ++m) _Pragma("unroll") for (int k = 0; k < 2; ++k) dst[m][k] = *(const LAS bf16x8*)(lds + PG8_SA(b, h) + aoff + m * 2048 + k * 1024); } while (0)
#define PG8_LDB(dst, b, h) do { _Pragma("unroll") for (int n = 0; n < 2; ++n) _Pragma("unroll") for (int k = 0; k < 2; ++k) dst[n][k] = *(const LAS bf16x8*)(lds + PG8_SB(b, h) + boff + n * 2048 + k * 1024); } while (0)
#define PG8_MMA(ai, bj, At, Bt) do { __builtin_amdgcn_s_setprio(1); _Pragma("unroll") for (int m = 0; m < 4; ++m) _Pragma("unroll") for (int n = 0; n < 2; ++n) _Pragma("unroll") for (int k = 0; k < 2; ++k) \
        acc[ai][bj][m][n] = __builtin_amdgcn_mfma_f32_16x16x32_bf16(Bt[n][k], At[m][k], acc[ai][bj][m][n], 0, 0, 0); __builtin_amdgcn_s_setprio(0); } while (0)
#define PG8_WAIT_V(n) asm volatile("s_waitcnt vmcnt(" #n ")" ::: "memory")
#define PG8_WAIT_L(n) asm volatile("s_waitcnt lgkmcnt(" #n ")" ::: "memory")
#define PG8_BAR __builtin_amdgcn_s_barrier()
#define PG8_SCHED __builtin_amdgcn_sched_barrier(0)
    Unit cur, nxt; int ui = 0;
    if (!S.next(0, cur)) return;
    f32x4 acc[2][2][4][2];
#pragma unroll
    for (int a = 0; a < 2; ++a)
#pragma unroll
        for (int b = 0; b < 2; ++b)
#pragma unroll
            for (int m = 0; m < 4; ++m)
#pragma unroll
                for (int n = 0; n < 2; ++n) acc[a][b][m][n] = (f32x4){0.f, 0.f, 0.f, 0.f};
    bf16x8 At[4][2], B0[2][2], B1[2][2];
    const char* cA; const char* cB; P.ptrs(cur, cA, cB);
    PG8_STAGE(PG8_SB(0, 0), cB, voffB); PG8_STAGE(PG8_SB(0, 1), cB + hstep, voffB); PG8_STAGE(PG8_SA(0, 0), cA, voffA); PG8_STAGE(PG8_SA(0, 1), cA + hstep, voffA);
    if (wr == 1) PG8_BAR;
    PG8_WAIT_V(2); PG8_BAR;
    PG8_STAGE(PG8_SB(1, 0), cB + kstep, voffB); PG8_STAGE(PG8_SA(1, 0), cA + kstep, voffA); PG8_STAGE(PG8_SB(1, 1), cB + hstep + kstep, voffB);
    PG8_WAIT_V(6); PG8_BAR;
    for (;;) {
        const bool has_next = S.next(ui + 1, nxt);
        const char* nA = cA; const char* nB = cB; if (has_next) P.ptrs(nxt, nA, nB);
        for (int t = 0; t < nt; t += 2) {
            const bool last = (t == nt - 2);
            const char* a1 = cA + (size_t)(t + 1) * kstep;
            const char* a2 = last ? nA : cA + (size_t)(t + 2) * kstep; const char* b2 = last ? nB : cB + (size_t)(t + 2) * kstep;
            const char* a3 = a2 + kstep; const char* b3 = b2 + kstep;
            PG8_LDB(B0, 0, 0); PG8_LDB(B1, 0, 1); PG8_SCHED; PG8_LDA(At, 0, 0); PG8_STAGE(PG8_SA(1, 1), a1 + hstep, voffA);
            PG8_WAIT_V(8); PG8_WAIT_L(0); PG8_BAR; PG8_MMA(0, 0, At, B0); PG8_MMA(0, 1, At, B1); PG8_BAR; PG8_SCHED;
            PG8_LDA(At, 0, 1); PG8_STAGE(PG8_SB(0, 0), b2, voffB); PG8_STAGE(PG8_SB(0, 1), b2 + hstep, voffB); PG8_STAGE(PG8_SA(0, 0), a2, voffA);
            PG8_WAIT_V(8); PG8_WAIT_L(0); PG8_BAR; PG8_MMA(1, 0, At, B0); PG8_MMA(1, 1, At, B1); PG8_BAR; PG8_SCHED;
            PG8_LDB(B0, 1, 0); PG8_LDB(B1, 1, 1); PG8_SCHED; PG8_LDA(At, 1, 0); PG8_STAGE(PG8_SA(0, 1), a2 + hstep, voffA);
            PG8_WAIT_V(8); PG8_WAIT_L(0); PG8_BAR; PG8_MMA(0, 0, At, B0); PG8_MMA(0, 1, At, B1); PG8_BAR; PG8_SCHED;
            PG8_LDA(At, 1, 1); PG8_STAGE(PG8_SB(1, 0), b3, voffB); PG8_STAGE(PG8_SB(1, 1), b3 + hstep, voffB); PG8_STAGE(PG8_SA(1, 0), a3, voffA);
            PG8_WAIT_V(8); PG8_WAIT_L(0); PG8_BAR; PG8_MMA(1, 0, At, B0); PG8_MMA(1, 1, At, B1); PG8_BAR; PG8_SCHED;
        }
        if (wr == 0) PG8_BAR;
        E(acc, cur, wr, wc, fr, fq);
        if (!has_next) break;
#pragma unroll
        for (int a = 0; a < 2; ++a)
#pragma unroll
            for (int b = 0; b < 2; ++b)
#pragma unroll
                for (int m = 0; m < 4; ++m)
#pragma unroll
                    for (int n = 0; n < 2; ++n) acc[a][b][m][n] = (f32x4){0.f, 0.f, 0.f, 0.f};
        cur = nxt; cA = nA; cB = nB; ++ui;
        if (wr == 1) PG8_BAR;
    }
    PG8_WAIT_V(0);
    PG8_BAR;
#undef PG8_SA
#undef PG8_SB
#undef PG8_STAGE
#undef PG8_LDA
#undef PG8_LDB
#undef PG8_MMA
#undef PG8_WAIT_V
#undef PG8_WAIT_L
#undef PG8_BAR
#undef PG8_SCHED
}
}
struct Frame {
    LAS unsigned char* lds;
    int tid, lane, wave, vcu, G, vb;
    unsigned char* ws;
    const float* in[18];
    float* out;
};
#define WSP(T, off) ((T*)(F.ws + (off)))

__device__ __forceinline__ void conv_item(const float* W, int ldn, int srccol0, int k0, const float* gain, bf16_t* WT, int K, int dstrow0, LAS float* scr, int lane) {
    float v[32];
    const float* wp = W + (size_t)(k0 + (lane >> 5)) * ldn + srccol0 + (lane & 31);
#pragma unroll
    for (int i = 0; i < 32; ++i) v[i] = wp[(size_t)(2 * i) * ldn];
    const int c = lane & 7;
    float gn[8];
#pragma unroll
    for (int e = 0; e < 8; ++e) gn[e] = gain ? gain[k0 + 8 * c + e] : 1.0f;
#pragma unroll
    for (int i = 0; i < 32; ++i) scr[(2 * i + (lane >> 5)) * 33 + (lane & 31)] = v[i];
    LDS_WAIT(); asm volatile("" ::: "memory");
#pragma unroll
    for (int j = 0; j < 4; ++j) { const int n = (lane >> 3) + 8 * j; const LAS float* s = scr + (8 * c) * 33 + n;
        u32x4 o; o.x = cvt_pk_bf16(s[0 * 33] * gn[0], s[1 * 33] * gn[1]); o.y = cvt_pk_bf16(s[2 * 33] * gn[2], s[3 * 33] * gn[3]);
        o.z = cvt_pk_bf16(s[4 * 33] * gn[4], s[5 * 33] * gn[5]); o.w = cvt_pk_bf16(s[6 * 33] * gn[6], s[7 * 33] * gn[7]);
        *(u32x4*)(WT + (size_t)(dstrow0 + n) * K + k0 + 8 * c) = o; }
    LDS_WAIT(); asm volatile("" ::: "memory");
}
struct ConvJob { const float* W; int ldn, K, N, col0, kind; const float* gain; bf16_t* WT; };
__device__ __forceinline__ int conv_items(const ConvJob& J) { return (J.K / 64) * (J.N / 32); }
__device__ __forceinline__ void conv_run(const ConvJob& J, int item, LAS float* scr, int lane) {
    const int nblk = J.N / 32, kb = item / nblk, nb = item % nblk; const int n0 = 32 * nb;
    int src;
    if (J.kind == 0) src = J.col0 + n0; else { const int u = n0 >> 8, j = n0 & 255; src = (j < 128) ? u * 128 + j : 2816 + u * 128 + (j - 128); }
    conv_item(J.W, J.ldn, src, 64 * kb, J.gain, J.WT, J.K, n0, scr, lane);
}
__device__ __forceinline__ int conv_job(Frame& F, const ConvJob& J, int base, int gw, int ngw) {
    LAS float* scr = (LAS float*)(F.lds + F.wave * 16384);
    const int n = conv_items(J);
    const int first = (gw - base % ngw + ngw) % ngw;
    for (int it = first; it < n; it += ngw) conv_run(J, it, scr, F.lane);
    return base + n;
}
__device__ __forceinline__ ConvJob job_ffn_in(Frame& F, int layer, int which  , size_t dst) {
    ConvJob J; J.W = F.in[which ? 7 : 3] + (size_t)layer * D * 2 * DFF; J.ldn = 2 * DFF; J.K = D; J.N = 2 * DFF; J.col0 = 0; J.kind = 1; J.gain = F.in[which ? 6 : 2] + layer * D; J.WT = WSP(bf16_t, dst); return J; }
__device__ __forceinline__ ConvJob job_ffn_out(Frame& F, int layer, int which, size_t dst) {
    ConvJob J; J.W = F.in[which ? 8 : 4] + (size_t)layer * DFF * D; J.ldn = D; J.K = DFF; J.N = D; J.col0 = 0; J.kind = 0; J.gain = nullptr; J.WT = WSP(bf16_t, dst); return J; }

struct EpiSwiglu {
    const float* SS; bf16_t* ACT;
    __device__ __forceinline__ void operator()(const f32x4 (&acc)[2][2][4][2], const pg8::Unit& u, int wr, int wc, int fr, int fq) const {
#pragma unroll
        for (int ai = 0; ai < 2; ++ai)
#pragma unroll
            for (int m = 0; m < 4; ++m) {
                const int row = u.pm * 256 + ai * 128 + wr * 64 + m * 16 + fr; const float rs = row_rstd(SS, row);
                float v[8];
#pragma unroll
                for (int n = 0; n < 2; ++n)
#pragma unroll
                    for (int j = 0; j < 4; ++j) { const float g = acc[ai][0][m][n][j] * rs, up = acc[ai][1][m][n][j] * rs; v[4 * n + j] = fsilu(g) * up; }
                u32x4 w; w.x = cvt_pk_bf16(v[0], v[1]); w.y = cvt_pk_bf16(v[2], v[3]); w.z = cvt_pk_bf16(v[4], v[5]); w.w = cvt_pk_bf16(v[6], v[7]);
                *(u32x4*)(ACT + (size_t)row * DFF + u.pn * 128 + wc * 32 + 8 * fq) = w;
            }
    }
};
template <bool BASE_F32> struct EpiResid {
    const float* xbase; bf16_t* HB; float* SS; float alpha;
    __device__ __forceinline__ void operator()(const f32x4 (&acc)[2][2][4][2], const pg8::Unit& u, int wr, int wc, int fr, int fq) const {
#pragma unroll
        for (int ai = 0; ai < 2; ++ai)
#pragma unroll
            for (int m = 0; m < 4; ++m) {
                const int row = u.pm * 256 + ai * 128 + wr * 64 + m * 16 + fr; float ss = 0.f;
#pragma unroll
                for (int bj = 0; bj < 2; ++bj) {
                    const size_t off = (size_t)row * D + u.pn * 256 + bj * 128 + wc * 32 + 8 * fq;
                    f32x4 b0, b1;
                    if (BASE_F32) { b0 = *(const f32x4*)(xbase + off); b1 = *(const f32x4*)(xbase + off + 4); }
                    else { const u32x4 hv = *(const u32x4*)(HB + off); b0 = (f32x4){bf_lo(hv.x), bf_hi(hv.x), bf_lo(hv.y), bf_hi(hv.y)}; b1 = (f32x4){bf_lo(hv.z), bf_hi(hv.z), bf_lo(hv.w), bf_hi(hv.w)}; }
                    const f32x4 v0 = b0 + acc[ai][bj][m][0] * alpha, v1 = b1 + acc[ai][bj][m][1] * alpha;
                    u32x4 w; w.x = cvt_pk_bf16(v0[0], v0[1]); w.y = cvt_pk_bf16(v0[2], v0[3]); w.z = cvt_pk_bf16(v1[0], v1[1]); w.w = cvt_pk_bf16(v1[2], v1[3]);
                    *(u32x4*)(HB + off) = w;
                    ss += (v0[0] * v0[0] + v0[1] * v0[1]) + (v0[2] * v0[2] + v0[3] * v0[3]) + (v1[0] * v1[0] + v1[1] * v1[1]) + (v1[2] * v1[2] + v1[3] * v1[3]);
                }
                ss += __shfl_xor(ss, 16); ss += __shfl_xor(ss, 32);
                if (fq == 0) SS[(size_t)row * 16 + u.pn * 4 + wc] = ss;
            }
    }
};
struct EpiRetIn {
    const float* SS; bf16_t* QH; bf16_t* KH; bf16_t* VT;
    __device__ __forceinline__ void operator()(const f32x4 (&acc)[2][2][4][2], const pg8::Unit& u, int wr, int wc, int fr, int fq) const {
        if (u.pn < 8) {
            const bool isq = u.pn < 4; const int head = u.pn & 3; bf16_t* dst = isq ? QH : KH;
            const float l2g = isq ? L2G[head] : -L2G[head], sc = isq ? 1.0f : 0.0625f;
            float inv[8];
#pragma unroll
            for (int e = 0; e < 8; ++e) inv[e] = ROPE_INV[wc * 32 + 8 * fq + e];
#pragma unroll
            for (int ai = 0; ai < 2; ++ai)
#pragma unroll
                for (int m = 0; m < 4; ++m) {
                    const int row = u.pm * 256 + ai * 128 + wr * 64 + m * 16 + fr; const float rs = row_rstd(SS, row);
                    const int b = row >> 13, t = row & 8191; const float pos = (float)(t + NMETA);
                    const float dec = __builtin_amdgcn_exp2f((float)((t & 31) + 1) * l2g) * sc * rs;
                    float o1[8], o2[8];
#pragma unroll
                    for (int n = 0; n < 2; ++n)
#pragma unroll
                        for (int j = 0; j < 4; ++j) { const int e = 4 * n + j;
                            const float rev = (pos * inv[e]) * 0.15915494309189535f; const float frc = rev - floorf(rev);
                            const float sn = __builtin_amdgcn_sinf(frc), cs = __builtin_amdgcn_cosf(frc);
                            const float t1 = acc[ai][0][m][n][j], t2 = acc[ai][1][m][n][j];
                            o1[e] = (t1 * cs - t2 * sn) * dec; o2[e] = (t1 * sn + t2 * cs) * dec; }
                    bf16_t* p = dst + ((size_t)(b * 4 + head) * SEQ + t) * 256 + wc * 32 + 8 * fq;
                    u32x4 w; w.x = cvt_pk_bf16(o1[0], o1[1]); w.y = cvt_pk_bf16(o1[2], o1[3]); w.z = cvt_pk_bf16(o1[4], o1[5]); w.w = cvt_pk_bf16(o1[6], o1[7]);
                    *(u32x4*)p = w;
                    w.x = cvt_pk_bf16(o2[0], o2[1]); w.y = cvt_pk_bf16(o2[2], o2[3]); w.z = cvt_pk_bf16(o2[4], o2[5]); w.w = cvt_pk_bf16(o2[6], o2[7]);
                    *(u32x4*)(p + 128) = w;
                }
        } else {
            float rs[2][8];
#pragma unroll
            for (int bj = 0; bj < 2; ++bj)
#pragma unroll
                for (int e = 0; e < 8; ++e) rs[bj][e] = row_rstd(SS, u.pm * 256 + bj * 128 + wc * 32 + 8 * fq + e);
            const int b = u.pm >> 5, t0 = (u.pm & 31) * 256;
#pragma unroll
            for (int ai = 0; ai < 2; ++ai)
#pragma unroll
                for (int m = 0; m < 4; ++m) {
                    const int vc = (u.pn - 8) * 256 + ai * 128 + wr * 64 + m * 16 + fr; const int head = vc >> 9, dvi = vc & 511;
                    bf16_t* p = VT + ((size_t)(b * 4 + head) * 512 + dvi) * SEQ + t0 + wc * 32 + 8 * fq;
#pragma unroll
                    for (int bj = 0; bj < 2; ++bj) {
                        const f32x4 v0 = acc[ai][bj][m][0], v1 = acc[ai][bj][m][1];
                        u32x4 w; w.x = cvt_pk_bf16(v0[0] * rs[bj][0], v0[1] * rs[bj][1]); w.y = cvt_pk_bf16(v0[2] * rs[bj][2], v0[3] * rs[bj][3]);
                        w.z = cvt_pk_bf16(v1[0] * rs[bj][4], v1[1] * rs[bj][5]); w.w = cvt_pk_bf16(v1[2] * rs[bj][6], v1[3] * rs[bj][7]);
                        *(u32x4*)(p + bj * 128) = w;
                    }
                }
        }
    }
};
template <int DV, int LDO> struct EpiGate {
    const float* SS; const bf16_t* O; bf16_t* Y; LAS float* RO;
    __device__ __forceinline__ void operator()(const f32x4 (&acc)[2][2][4][2], const pg8::Unit& u, int wr, int wc, int fr, int fq) const {
        const int wid = wr * 4 + wc, lane = fq * 16 + fr; const int head = (u.pn * 256) / DV;
        {   const bf16_t* ob = O + (size_t)(u.pm * 256 + wid * 32) * LDO + head * DV;
#pragma unroll
            for (int i0 = 0; i0 < 32; i0 += 8) { float sv[8];
#pragma unroll
                for (int i = 0; i < 8; ++i) { float s;
                    if (DV == 512) { const u32x4 v = *(const u32x4*)(ob + (size_t)(i0 + i) * LDO + lane * 8);
                        const float a0 = bf_lo(v.x), a1 = bf_hi(v.x), a2 = bf_lo(v.y), a3 = bf_hi(v.y), a4 = bf_lo(v.z), a5 = bf_hi(v.z), a6 = bf_lo(v.w), a7 = bf_hi(v.w);
                        s = ((a0 * a0 + a1 * a1) + (a2 * a2 + a3 * a3)) + ((a4 * a4 + a5 * a5) + (a6 * a6 + a7 * a7)); }
                    else { const u32x2 v = *(const u32x2*)(ob + (size_t)(i0 + i) * LDO + lane * 4);
                        const float a0 = bf_lo(v.x), a1 = bf_hi(v.x), a2 = bf_lo(v.y), a3 = bf_hi(v.y); s = (a0 * a0 + a1 * a1) + (a2 * a2 + a3 * a3); }
                    sv[i] = s; }
#pragma unroll
                for (int i = 0; i < 8; ++i) { const float t = wave_sum(sv[i]); if (lane == 0) RO[wid * 32 + i0 + i] = 1.0f / sqrtf(t * (1.0f / (float)DV) + 1e-6f); } }
            LDS_WAIT(); __builtin_amdgcn_s_barrier(); asm volatile("" ::: "memory"); }
#pragma unroll
        for (int ai = 0; ai < 2; ++ai)
#pragma unroll
            for (int m = 0; m < 4; ++m) {
                const int rl = ai * 128 + wr * 64 + m * 16 + fr, row = u.pm * 256 + rl; const float rs = row_rstd(SS, row); const float ro = RO[rl];
#pragma unroll
                for (int bj = 0; bj < 2; ++bj) {
                    const int col = u.pn * 256 + bj * 128 + wc * 32 + 8 * fq;
                    const u32x4 ov = *(const u32x4*)(O + (size_t)row * LDO + col);
                    const f32x4 g0 = acc[ai][bj][m][0] * rs, g1 = acc[ai][bj][m][1] * rs;
                    u32x4 w;
                    w.x = cvt_pk_bf16(bf_lo(ov.x) * ro * fsilu(g0[0]), bf_hi(ov.x) * ro * fsilu(g0[1]));
                    w.y = cvt_pk_bf16(bf_lo(ov.y) * ro * fsilu(g0[2]), bf_hi(ov.y) * ro * fsilu(g0[3]));
                    w.z = cvt_pk_bf16(bf_lo(ov.z) * ro * fsilu(g1[0]), bf_hi(ov.z) * ro * fsilu(g1[1]));
                    w.w = cvt_pk_bf16(bf_lo(ov.w) * ro * fsilu(g1[2]), bf_hi(ov.w) * ro * fsilu(g1[3]));
                    *(u32x4*)(Y + (size_t)row * LDO + col) = w;
                }
            }
        asm volatile("" ::: "memory"); __builtin_amdgcn_s_barrier(); asm volatile("" ::: "memory");
    }
};
struct EpiGlaIn {
    const float* SS; const float* BC; bf16_t* QH; bf16_t* KH; bf16_t* VT;
    __device__ __forceinline__ void operator()(const f32x4 (&acc)[2][2][4][2], const pg8::Unit& u, int wr, int wc, int fr, int fq) const {
        if (u.pn < 4) {
            const bool isq = u.pn < 2; bf16_t* dst = isq ? QH : KH;
#pragma unroll
            for (int ai = 0; ai < 2; ++ai)
#pragma unroll
                for (int m = 0; m < 4; ++m) {
                    const int row = u.pm * 256 + ai * 128 + wr * 64 + m * 16 + fr; const float rs = row_rstd(SS, row) * (isq ? 0.08838834764831845f : 1.0f);
                    const int b = row >> 13, t = row & 8191;
#pragma unroll
                    for (int bj = 0; bj < 2; ++bj) {
                        const int cq = (u.pn & 1) * 256 + bj * 128 + wc * 32 + 8 * fq; const int head = cq >> 7, d = cq & 127;
                        const f32x4 c0 = *(const f32x4*)(BC + (size_t)row * 512 + cq), c1 = *(const f32x4*)(BC + (size_t)row * 512 + cq + 4);
                        float v[8];
#pragma unroll
                        for (int j = 0; j < 4; ++j) { v[j] = acc[ai][bj][m][0][j] * rs * __expf(isq ? c0[j] : -c0[j]); v[4 + j] = acc[ai][bj][m][1][j] * rs * __expf(isq ? c1[j] : -c1[j]); }
                        u32x4 w; w.x = cvt_pk_bf16(v[0], v[1]); w.y = cvt_pk_bf16(v[2], v[3]); w.z = cvt_pk_bf16(v[4], v[5]); w.w = cvt_pk_bf16(v[6], v[7]);
                        *(u32x4*)(dst + ((size_t)(b * 4 + head) * SEQ + t) * 128 + d) = w;
                    }
                }
        } else {
            float rs[2][8];
#pragma unroll
            for (int bj = 0; bj < 2; ++bj)
#pragma unroll
                for (int e = 0; e < 8; ++e) rs[bj][e] = row_rstd(SS, u.pm * 256 + bj * 128 + wc * 32 + 8 * fq + e);
            const int b = u.pm >> 5, t0 = (u.pm & 31) * 256; const int head = u.pn - 4;
#pragma unroll
            for (int ai = 0; ai < 2; ++ai)
#pragma unroll
                for (int m = 0; m < 4; ++m) {
                    const int dvi = ai * 128 + wr * 64 + m * 16 + fr;
                    bf16_t* p = VT + ((size_t)(b * 4 + head) * 256 + dvi) * SEQ + t0 + wc * 32 + 8 * fq;
#pragma unroll
                    for (int bj = 0; bj < 2; ++bj) {
                        const f32x4 v0 = acc[ai][bj][m][0], v1 = acc[ai][bj][m][1];
                        u32x4 w; w.x = cvt_pk_bf16(v0[0] * rs[bj][0], v0[1] * rs[bj][1]); w.y = cvt_pk_bf16(v0[2] * rs[bj][2], v0[3] * rs[bj][3]);
                        w.z = cvt_pk_bf16(v1[0] * rs[bj][4], v1[1] * rs[bj][5]); w.w = cvt_pk_bf16(v1[2] * rs[bj][6], v1[3] * rs[bj][7]);
                        *(u32x4*)(p + bj * 128) = w;
                    }
                }
        }
    }
};
struct PtrNormal { const char* A; const char* B; size_t tstep;
    __device__ __forceinline__ void ptrs(const pg8::Unit& u, const char*& cA, const char*& cB) const { cA = A + (size_t)u.pm * tstep; cB = B + (size_t)u.pn * tstep; } };
struct PtrSwapFrom { const char* A; const char* B; size_t tstep; int pn_swap;
    __device__ __forceinline__ void ptrs(const pg8::Unit& u, const char*& cA, const char*& cB) const {
        const char* a = A + (size_t)u.pm * tstep; const char* b = B + (size_t)u.pn * tstep;
        if (u.pn >= pn_swap) { cA = b; cB = a; } else { cA = a; cB = b; } } };

constexpr int MA_RS_OFF = 98304, MA_RED_OFF = 100352;
template <int MODE> __device__ __forceinline__ void meta_tiles(Frame& F, const bf16_t* Bt, int N, int K, float* out, int ldo, float alpha, int b0, int nb) {
    const int lane = F.lane, g = lane >> 4, r16 = lane & 15, pitch = K + 8;
    const LAS bf16_t* A = (const LAS bf16_t*)F.lds; const LAS float* rsA = (const LAS float*)(F.lds + MA_RS_OFF); LAS f32x4* red = (LAS f32x4*)(F.lds + MA_RED_OFF);
    const int ksteps = K / 32, per = ksteps / 8;
    for (int tile = F.vb - b0; tile < N / 16; tile += nb) {
        f32x4 acc = (f32x4){0.f, 0.f, 0.f, 0.f};
        const bf16_t* bp = Bt + (size_t)(tile * 16 + r16) * K + 8 * g;
        for (int ks = F.wave * per; ks < (F.wave + 1) * per; ++ks) {
            const bf16x8 a = *(const LAS bf16x8*)(A + r16 * pitch + ks * 32 + 8 * g);
            const bf16x8 b = *(const bf16x8*)(bp + ks * 32);
            acc = __builtin_amdgcn_mfma_f32_16x16x32_bf16(a, b, acc, 0, 0, 0);
        }
        red[F.wave * 64 + lane] = acc;
        __syncthreads();
        if (F.wave == 0) {
            f32x4 s = red[lane];
#pragma unroll
            for (int w = 1; w < 8; ++w) s += red[w * 64 + lane];
#pragma unroll
            for (int j = 0; j < 4; ++j) { const int r = 4 * g + j; float* o = out + (size_t)r * ldo + tile * 16 + r16;
                if (MODE == 0) *o = s[j] * rsA[r]; else *o = *o + alpha * s[j]; }
        }
        __syncthreads();
    }
}
__device__ __forceinline__ bool meta_has_tiles(Frame& F, int N, int b0, int nb) { const int r = F.vb - b0; return r >= 0 && r < nb && r < N / 16; }
__device__ __forceinline__ void meta_prep_h(Frame& F) {
    const float* HM = WSP(float, WS_META + META_HM); LAS bf16_t* A = (LAS bf16_t*)F.lds; LAS float* rsA = (LAS float*)(F.lds + MA_RS_OFF);
    for (int r = F.wave; r < 16; r += 8) { float s = 0.f;
        for (int k = F.lane; k < D; k += 64) { const float v = HM[r * D + k]; s += v * v; A[r * (D + 8) + k] = f2bf(v); }
        s = wave_sum(s); if (F.lane == 0) rsA[r] = 1.0f / sqrtf(s * (1.0f / 1024.0f) + 1e-6f); }
    __syncthreads();
}
__device__ __forceinline__ void meta_prep_act(Frame& F) {
    const float* RAW = WSP(float, WS_META + META_RAW); LAS bf16_t* A = (LAS bf16_t*)F.lds; LAS float* rsA = (LAS float*)(F.lds + MA_RS_OFF);
    for (int i = F.tid; i < 16 * DFF; i += NTHREADS) { const int r = i / DFF, k = i % DFF, u = k >> 7, j = k & 127;
        const float g = RAW[r * 5632 + u * 256 + j], up = RAW[r * 5632 + u * 256 + 128 + j]; A[r * (DFF + 8) + k] = f2bf(fsilu(g) * up); }
    if (F.tid < 16) rsA[F.tid] = 1.f;
    __syncthreads();
}
__device__ __forceinline__ void meta_prep_y(Frame& F) {
    const float* RAW = WSP(float, WS_META + META_RAW); const float* MO = WSP(float, WS_META + META_MO);
    LAS bf16_t* A = (LAS bf16_t*)F.lds; LAS float* rsA = (LAS float*)(F.lds + MA_RS_OFF); LAS float* mro = (LAS float*)(F.lds + MA_RED_OFF);
    for (int p = F.wave; p < 64; p += 8) { const int r = p >> 2, head = p & 3; float sacc = 0.f;
        for (int k = F.lane; k < 512; k += 64) { const float v = MO[r * 2048 + head * 512 + k]; sacc += v * v; }
        sacc = wave_sum(sacc); if (F.lane == 0) mro[p] = 1.0f / sqrtf(sacc * (1.0f / 512.0f) + 1e-6f); }
    __syncthreads();
    for (int i = F.tid; i < 16 * 2048; i += NTHREADS) { const int r = i >> 11, k = i & 2047, head = k >> 9;
        A[r * (2048 + 8) + k] = f2bf(MO[r * 2048 + k] * mro[r * 4 + head] * fsilu(RAW[r * 6144 + 4096 + k])); }
    if (F.tid < 16) rsA[F.tid] = 1.f;
    __syncthreads();
}

__device__ __forceinline__ void meta_tiles_ksplit(Frame& F, const bf16_t* Bt, int K, int KQ, float* out, float alpha) {
    const int lane = F.lane, g = lane >> 4, r16 = lane & 15, pitch = KQ + 8;
    const LAS bf16_t* A = (const LAS bf16_t*)F.lds; LAS f32x4* red = (LAS f32x4*)(F.lds + MA_RED_OFF);
    const int item = F.vb; if (item >= 256) return;
    const int tile = item >> 2, kq = item & 3, nks = KQ / 32;
    f32x4 acc = (f32x4){0.f, 0.f, 0.f, 0.f};
    const bf16_t* bp = Bt + (size_t)(tile * 16 + r16) * K + kq * KQ + 8 * g;
    for (int ks = F.wave; ks < nks; ks += 8) {
        const bf16x8 a = *(const LAS bf16x8*)(A + r16 * pitch + ks * 32 + 8 * g);
        const bf16x8 b = *(const bf16x8*)(bp + ks * 32);
        acc = __builtin_amdgcn_mfma_f32_16x16x32_bf16(a, b, acc, 0, 0, 0);
    }
    red[F.wave * 64 + lane] = acc;
    __syncthreads();
    if (F.wave == 0) { f32x4 sacc = red[lane];
#pragma unroll
        for (int w = 1; w < 8; ++w) sacc += red[w * 64 + lane];
#pragma unroll
        for (int j = 0; j < 4; ++j) atomicAdd(out + (size_t)(4 * g + j) * D + tile * 16 + r16, alpha * sacc[j]); }
    __syncthreads();
}
__device__ __forceinline__ void meta_prep_act_q(Frame& F) {
    const float* RAW = WSP(float, WS_META + META_RAW); LAS bf16_t* A = (LAS bf16_t*)F.lds; const int kq = F.vb & 3;
    for (int i = F.tid; i < 16 * 704; i += NTHREADS) { const int r = i / 704, kk = i % 704, k = kq * 704 + kk, u = k >> 7, j = k & 127;
        const float gt = RAW[r * 5632 + u * 256 + j], up = RAW[r * 5632 + u * 256 + 128 + j]; A[r * (704 + 8) + kk] = f2bf(fsilu(gt) * up); }
    __syncthreads();
}
__device__ __forceinline__ void meta_prep_y_q(Frame& F) {
    const float* RAW = WSP(float, WS_META + META_RAW); const float* MO = WSP(float, WS_META + META_MO);
    LAS bf16_t* A = (LAS bf16_t*)F.lds; LAS float* mro = (LAS float*)(F.lds + MA_RED_OFF); const int head = F.vb & 3;
    for (int r = F.wave; r < 16; r += 8) { float sacc = 0.f;
        for (int k = F.lane; k < 512; k += 64) { const float v = MO[r * 2048 + head * 512 + k]; sacc += v * v; }
        sacc = wave_sum(sacc); if (F.lane == 0) mro[r] = 1.0f / sqrtf(sacc * (1.0f / 512.0f) + 1e-6f); }
    __syncthreads();
    for (int i = F.tid; i < 16 * 512; i += NTHREADS) { const int r = i >> 9, kk = i & 511, k = head * 512 + kk;
        A[r * (512 + 8) + kk] = f2bf(MO[r * 2048 + k] * mro[r] * fsilu(RAW[r * 6144 + 4096 + k])); }
    __syncthreads();
}
__device__ __forceinline__ void z_phase(Frame& F, const bf16_t* HB, const float* SS, const bf16_t* WZ, const float* wg, const float* bg, float* BC) {
    LAS float* zpart = (LAS float*)F.lds;
    LAS float* zs = (LAS float*)(F.lds + 8192);
    const int lane = F.lane, g = lane >> 4, r16 = lane & 15;
    for (int cidx = blockIdx.x; cidx < M / 64; cidx += F.G) {
        const int row0 = cidx * 64;
        { const int tile = F.wave & 3, kh = F.wave >> 2; f32x4 acc = (f32x4){0.f, 0.f, 0.f, 0.f};
          const bf16_t* ap = HB + (size_t)(row0 + tile * 16 + r16) * D + 8 * g; const bf16_t* bp = WZ + (size_t)r16 * D + 8 * g;
#pragma unroll 4
          for (int ks = kh * 16; ks < kh * 16 + 16; ++ks) {
              const bf16x8 a = *(const bf16x8*)(ap + ks * 32), b = *(const bf16x8*)(bp + ks * 32);
              acc = __builtin_amdgcn_mfma_f32_16x16x32_bf16(a, b, acc, 0, 0, 0);
          }
#pragma unroll
          for (int j = 0; j < 4; ++j) zpart[(kh * 64 + tile * 16 + 4 * g + j) * 16 + r16] = acc[j]; }
        __syncthreads();
        for (int i = F.tid; i < 64 * 16; i += NTHREADS) { const int t = i >> 4; zs[i] = (zpart[i] + zpart[1024 + i]) * row_rstd(SS, row0 + t); }
        __syncthreads();
        { const int c = F.tid; float w[16];
#pragma unroll
          for (int r = 0; r < 16; ++r) w[r] = wg[r * 512 + c];
          const float bias = bg[c]; float cum = 0.f;
          for (int t = 0; t < 64; ++t) { float a = bias; if (t == 32) cum = 0.f;
#pragma unroll
              for (int r = 0; r < 16; ++r) a += zs[t * 16 + r] * w[r];
              const float ls = fminf(a, 0.f) - __logf(1.0f + __expf(-fabsf(a)));
              cum += ls * 0.0625f; BC[(size_t)(row0 + t) * 512 + c] = cum; } }
        __syncthreads();
    }
}

typedef short v4i16_t __attribute__((ext_vector_type(4)));
__device__ __forceinline__ s16x4 ds_tr_asm(unsigned addr) { s16x4 r; asm volatile("ds_read_b64_tr_b16 %0, %1" : "=v"(r) : "v"(addr) : "memory"); return r; }
__device__ __forceinline__ s16x4 ds_tr(const LAS unsigned char* p) { return __builtin_bit_cast(s16x4, __builtin_amdgcn_ds_read_tr16_b64_v4i16((LAS v4i16_t*)p)); }
template <int DK, int DV, bool GLA>
__device__ __forceinline__ void s2_phase(Frame& F, const bf16_t* QH, const bf16_t* KH, const bf16_t* VT, bf16_t* O, float* OSS, const float* BC, int ldraw) {
    constexpr int NS = DV / 16, ROWB = DK * 2, TILEB = 64 * ROWB, NI = TILEB / 1024 / 8, NT = DK / 128, LDO = 4 * DV;
    constexpr int LQ = 0, LK = 2 * TILEB, LV = 4 * TILEB, LP = LV + 4096, LS = LP + 8192, LDEC = LS + 2 * 16 * ROWB;
    static_assert(LDEC + 2 * DK * 4 <= LDS_MISC, "S2 LDS map");
    const int unit = blockIdx.x; if (unit >= 8 * NS) return;
    const int bh = unit & 7, s = unit >> 3, b = bh >> 2, h = bh & 3;
    const int lane = F.lane, g = lane >> 4, r16 = lane & 15, w = F.wave;
    LAS unsigned char* L = F.lds; const unsigned Lb = (unsigned)(uintptr_t)L;
    const float* RAW = WSP(float, WS_META + META_RAW);
    for (int i = F.tid * 16; i < TILEB; i += NTHREADS * 16) { *(LAS u32x4*)(L + LQ + i) = (u32x4){0, 0, 0, 0}; *(LAS u32x4*)(L + LK + i) = (u32x4){0, 0, 0, 0}; }
    for (int i = F.tid * 16; i < 2048; i += NTHREADS * 16) *(LAS u32x4*)(L + LV + i) = (u32x4){0, 0, 0, 0};
    for (int i = F.tid * 16; i < 16 * ROWB; i += NTHREADS * 16) *(LAS u32x4*)(L + LS + i) = (u32x4){0, 0, 0, 0};
    __syncthreads();
    if (!GLA) {
        for (int idx = F.tid; idx < 16 * 128; idx += NTHREADS) { const int j = idx >> 7, c = idx & 127, row = 48 + j;
            const float* rq = RAW + (size_t)j * ldraw + h * 256; const float* rk = rq + 1024;
            const float rev = ((float)j * ROPE_INV[c]) * 0.15915494309189535f; const float frc = rev - floorf(rev);
            const float sn = __builtin_amdgcn_sinf(frc), cs = __builtin_amdgcn_cosf(frc);
            const float dq = __builtin_amdgcn_exp2f((float)(row + 1) * L2G[h]), dk = 0.0625f * __builtin_amdgcn_exp2f(-(float)(row + 1) * L2G[h]);
            const float q1 = rq[c], q2 = rq[c + 128], k1 = rk[c], k2 = rk[c + 128];
            const int a1 = row * ROWB + ((((c >> 3)) ^ (row & 15)) << 4) + (c & 7) * 2, a2 = row * ROWB + ((((c + 128) >> 3) ^ (row & 15)) << 4) + (c & 7) * 2;
            *(LAS bf16_t*)(L + LQ + a1) = f2bf((q1 * cs - q2 * sn) * dq); *(LAS bf16_t*)(L + LQ + a2) = f2bf((q1 * sn + q2 * cs) * dq);
            *(LAS bf16_t*)(L + LK + a1) = f2bf((k1 * cs - k2 * sn) * dk); *(LAS bf16_t*)(L + LK + a2) = f2bf((k1 * sn + k2 * cs) * dk); }
        if (F.tid < 256) { const int j = F.tid >> 4, wv = F.tid & 15, tok = 48 + j;
            *(LAS bf16_t*)(L + LV + wv * 128 + (((tok >> 3) ^ ((wv >> 1) & 7)) << 4) + (tok & 7) * 2) = f2bf(RAW[(size_t)j * ldraw + 2048 + h * 512 + 16 * s + wv]); }
    } else {
        if (F.tid < 128) { const int d = F.tid; const float* wgp = F.in[13] + h * 128 + d; const float bias = F.in[14][h * 128 + d]; float cum = 0.f;
            for (int j = 0; j < 16; ++j) { float a = bias;
                for (int r = 0; r < 16; ++r) a += RAW[(size_t)j * ldraw + 3072 + r] * wgp[r * 512];
                cum += (fminf(a, 0.f) - __logf(1.0f + __expf(-fabsf(a)))) * 0.0625f;
                const int row = 48 + j;
                *(LAS bf16_t*)(L + LK + row * ROWB + (((d >> 3) ^ (row & 15)) << 4) + (d & 7) * 2) = f2bf(RAW[(size_t)j * ldraw + 512 + h * 128 + d] * __expf(-cum)); }
            *(LAS float*)(L + LDEC + d * 4) = __expf(cum); }
        if (F.tid >= 256) { const int j = (F.tid - 256) >> 4, wv = F.tid & 15, tok = 48 + j;
            *(LAS bf16_t*)(L + LV + wv * 128 + (((tok >> 3) ^ ((wv >> 1) & 7)) << 4) + (tok & 7) * 2) = f2bf(RAW[(size_t)j * ldraw + 1024 + h * 256 + 16 * s + wv]); }
    }
    f32x4 S[NT];
#pragma unroll
    for (int tt = 0; tt < NT; ++tt) S[tt] = (f32x4){0.f, 0.f, 0.f, 0.f};
    const float g64 = GLA ? 1.0f : __builtin_amdgcn_exp2f(64.0f * L2G[h]);
    const char* Qg = (const char*)(QH + (size_t)bh * SEQ * DK); const char* Kg = (const char*)(KH + (size_t)bh * SEQ * DK);
    const char* Vg = (const char*)(VT + ((size_t)bh * DV + 16 * s) * SEQ);
    __syncthreads();
    for (int c = 0; c <= 128; ++c) {
        const int buf = c & 1;
        if (c < 128) {
            const char* qc = Qg + (size_t)c * TILEB; const char* kc = Kg + (size_t)c * TILEB;
#pragma unroll
            for (int i = 0; i < NI; ++i) { const int piece = w * NI + i, off = piece * 1024 + lane * 16, row = off / ROWB, p = (off % ROWB) >> 4; const int so = row * ROWB + ((p ^ (row & 15)) << 4);
                __builtin_amdgcn_global_load_lds((const unsigned*)(qc + so), (LAS unsigned*)(L + LQ + (buf ^ 1) * TILEB + piece * 1024), 16, 0, 0);
                __builtin_amdgcn_global_load_lds((const unsigned*)(kc + so), (LAS unsigned*)(L + LK + (buf ^ 1) * TILEB + piece * 1024), 16, 0, 0); }
            if (w < 2) { const int off = w * 1024 + lane * 16, wv = off >> 7, p = (off & 127) >> 4;
                __builtin_amdgcn_global_load_lds((const unsigned*)(Vg + (size_t)wv * SEQ * 2 + (size_t)c * 128 + ((p ^ ((wv >> 1) & 7)) << 4)), (LAS unsigned*)(L + LV + (buf ^ 1) * 2048 + w * 1024), 16, 0, 0); }
        }
        { const int ti = w >> 1, tj0 = 2 * (w & 1); f32x4 pt0 = (f32x4){0.f, 0.f, 0.f, 0.f}, pt1 = pt0;
          const int qrow = 16 * ti + r16, kr0 = 16 * tj0 + r16, kr1 = kr0 + 16;
          const LAS unsigned char* qb = L + LQ + buf * TILEB + qrow * ROWB; const LAS unsigned char* kb0 = L + LK + buf * TILEB + kr0 * ROWB; const LAS unsigned char* kb1 = L + LK + buf * TILEB + kr1 * ROWB;
#pragma unroll
          for (int ks = 0; ks < DK / 32; ++ks) { const int ch = ((4 * ks + g) ^ r16) << 4;
              const bf16x8 qf = *(const LAS bf16x8*)(qb + ch), k0 = *(const LAS bf16x8*)(kb0 + ch), k1 = *(const LAS bf16x8*)(kb1 + ch);
              pt0 = __builtin_amdgcn_mfma_f32_16x16x32_bf16(k0, qf, pt0, 0, 0, 0); pt1 = __builtin_amdgcn_mfma_f32_16x16x32_bf16(k1, qf, pt1, 0, 0, 0); }
          const int i = qrow;
#pragma unroll
          for (int tjj = 0; tjj < 2; ++tjj) { const f32x4 pt = tjj ? pt1 : pt0; const int tj = tj0 + tjj, j0 = 16 * tj + 4 * g;
              const float v0 = (j0 + 0 <= i) ? pt[0] : 0.f, v1 = (j0 + 1 <= i) ? pt[1] : 0.f, v2 = (j0 + 2 <= i) ? pt[2] : 0.f, v3 = (j0 + 3 <= i) ? pt[3] : 0.f;
              u32x2 pk; pk.x = cvt_pk_bf16(v0, v1); pk.y = cvt_pk_bf16(v2, v3);
              *(LAS u32x2*)(L + LP + i * 128 + (((2 * tj + (g >> 1)) ^ ((i >> 1) & 7)) << 4) + (g & 1) * 8) = pk; } }
        LDS_WAIT(); __builtin_amdgcn_s_barrier(); asm volatile("" ::: "memory");
        if (w < 4) { const int irow = 16 * w + r16; f32x4 ot = (f32x4){0.f, 0.f, 0.f, 0.f};
#pragma unroll
            for (int ks = 0; ks < 2; ++ks) {
                const bf16x8 va = *(const LAS bf16x8*)(L + LV + buf * 2048 + r16 * 128 + (((4 * ks + g) ^ ((r16 >> 1) & 7)) << 4));
                const bf16x8 pb = *(const LAS bf16x8*)(L + LP + irow * 128 + (((4 * ks + g) ^ ((irow >> 1) & 7)) << 4));
                ot = __builtin_amdgcn_mfma_f32_16x16x32_bf16(va, pb, ot, 0, 0, 0); }
#pragma unroll
            for (int ks = 0; ks < DK / 32; ++ks) { const int ch = ((4 * ks + g) ^ r16) << 4;
                const bf16x8 sa = *(const LAS bf16x8*)(L + LS + buf * 16 * ROWB + r16 * ROWB + ch);
                const bf16x8 qb = *(const LAS bf16x8*)(L + LQ + buf * TILEB + irow * ROWB + ch);
                ot = __builtin_amdgcn_mfma_f32_16x16x32_bf16(sa, qb, ot, 0, 0, 0); }
            float ss = (ot[0] * ot[0] + ot[1] * ot[1]) + (ot[2] * ot[2] + ot[3] * ot[3]);
            ss += __shfl_xor(ss, 16); ss += __shfl_xor(ss, 32);
            if (c >= 1) { const size_t grow = (size_t)b * SEQ + (c - 1) * 64 + irow;
                u32x2 pk; pk.x = cvt_pk_bf16(ot[0], ot[1]); pk.y = cvt_pk_bf16(ot[2], ot[3]);
                *(u32x2*)(O + grow * LDO + h * DV + 16 * s + 4 * g) = pk;
                if (g == 0) atomicAdd(OSS + grow * 4 + h, ss);
            } else if (!GLA && b == 0 && irow >= 48) { float* MO = WSP(float, WS_META + META_MO); float* MOSS = WSP(float, WS_CTL + CTL_MOSS);
                *(f32x4*)(MO + (size_t)(irow - 48) * 2048 + h * 512 + 16 * s + 4 * g) = ot;
                if (g == 0) atomicAdd(MOSS + (irow - 48) * 4 + h, ss); } }
        {
#pragma unroll
          for (int ks = 0; ks < 2; ++ks) {
              const bf16x8 vb = *(const LAS bf16x8*)(L + LV + buf * 2048 + r16 * 128 + (((4 * ks + g) ^ ((r16 >> 1) & 7)) << 4));
#pragma unroll
              for (int tt = 0; tt < NT; ++tt) { const int d0 = 16 * (w + 8 * tt), dcol = d0 + 4 * (r16 & 3), chunk = dcol >> 3, sub = (dcol & 7) * 2;
                  const int r1 = 32 * ks + 8 * g + (r16 >> 2), r2 = r1 + 4;
                  const s16x4 lo = ds_tr(L + LK + buf * TILEB + r1 * ROWB + ((chunk ^ (r1 & 15)) << 4) + sub);
                  const s16x4 hi = ds_tr(L + LK + buf * TILEB + r2 * ROWB + ((chunk ^ (r2 & 15)) << 4) + sub);
                  const bf16x8 ka = (bf16x8){lo[0], lo[1], lo[2], lo[3], hi[0], hi[1], hi[2], hi[3]};
                  S[tt] = __builtin_amdgcn_mfma_f32_16x16x32_bf16(ka, vb, S[tt], 0, 0, 0); } }
#pragma unroll
          for (int tt = 0; tt < NT; ++tt) { const int tile = w + 8 * tt;
              if (GLA) { const f32x4 dc = *(const LAS f32x4*)(L + LDEC + buf * DK * 4 + (16 * tile + 4 * g) * 4); S[tt] = S[tt] * dc; } else S[tt] = S[tt] * g64;
              u32x2 pk; pk.x = cvt_pk_bf16(S[tt][0], S[tt][1]); pk.y = cvt_pk_bf16(S[tt][2], S[tt][3]);
              *(LAS u32x2*)(L + LS + (buf ^ 1) * 16 * ROWB + r16 * ROWB + (((2 * tile + (g >> 1)) ^ r16) << 4) + (g & 1) * 8) = pk; } }
        if (GLA && c < 128 && F.tid < DK) *(LAS float*)(L + LDEC + (buf ^ 1) * DK * 4 + F.tid * 4) = __expf(BC[(size_t)(b * SEQ + c * 64 + 63) * 512 + h * 128 + F.tid]);
        __syncthreads();
    }
}

__device__ __forceinline__ bf16x8 gload16(const void* p) { bf16x8 r; asm volatile("global_load_dwordx4 %0, %1, off" : "=v"(r) : "v"(p) : "memory"); return r; }
__device__ __forceinline__ void glds_touch(const void* gsrc, unsigned lds_dst) { unsigned keep; asm volatile("s_mov_b32 %0, m0\n\ts_mov_b32 m0, %2\n\ts_nop 0\n\tglobal_load_lds_dword %1, off\n\ts_mov_b32 m0, %0" : "=&s"(keep) : "v"(gsrc), "s"(lds_dst) : "memory"); }
#define S2_WAITV(n) asm volatile("s_waitcnt vmcnt(" #n ")" ::: "memory")
template <int DK, int DV, bool GLA>
__device__ __forceinline__ void s2v2_phase(Frame& F, const bf16_t* QH, const bf16_t* KH, const bf16_t* VT, bf16_t* O, float* OSS, const float* BC, int ldraw) {
    constexpr int NS = DV / 16, ROWB = DK * 2, TILEB = 64 * ROWB, NI = TILEB / 1024 / 8, NT = DK / 128, LDO = 4 * DV, KS = DK / 32;
    constexpr int LK = 0, LV = 3 * TILEB, LDEC = LV + 3 * 2048, LP = LDEC + 3 * 1024, LS = LP + 8192, LOT = LS + 2 * 16 * ROWB, LQM = LOT + 4096, LEND = LQM + 16 * ROWB;
    static_assert(LEND <= LDS_MISC, "S2 LDS map");
    const int unit = blockIdx.x; if (unit >= 8 * NS) return;
    const int bh = unit & 7, s = unit >> 3, b = bh >> 2, h = bh & 3;
    const int lane = F.lane, g = lane >> 4, r16 = lane & 15, w = F.wave, ti = w >> 1, hf = w & 1;
    LAS unsigned char* L = F.lds; const unsigned Lb = (unsigned)(uintptr_t)L;
    const float* RAW = WSP(float, WS_META + META_RAW);
    const char* Qg = (const char*)(QH + (size_t)bh * SEQ * DK); const char* Kg = (const char*)(KH + (size_t)bh * SEQ * DK);
    const char* Vg = (const char*)(VT + ((size_t)bh * DV + 16 * s) * SEQ);
    const char* qlane = Qg + (size_t)(16 * ti + r16) * ROWB + g * 16;
    bf16x8 q0[KS], q1[KS], q2[KS];
#define S2_ISSUE(c_, QSET) do { const int rc_ = (c_) - 1, st_ = (c_) % 3; const char* kc_ = Kg + (size_t)rc_ * TILEB; \
        _Pragma("unroll") for (int i_ = 0; i_ < NI; ++i_) { const int piece_ = w * NI + i_, off_ = piece_ * 1024 + lane * 16, row_ = off_ / ROWB, p_ = (off_ % ROWB) >> 4; \
            __builtin_amdgcn_global_load_lds((const unsigned*)(kc_ + row_ * ROWB + ((p_ ^ (row_ & 15)) << 4)), (LAS unsigned*)(L + LK + st_ * TILEB + piece_ * 1024), 16, 0, 0); } \
        if (w < 2) { const int off_ = w * 1024 + lane * 16, wv_ = off_ >> 7, p_ = (off_ & 127) >> 4; \
            __builtin_amdgcn_global_load_lds((const unsigned*)(Vg + (size_t)wv_ * SEQ * 2 + (size_t)rc_ * 128 + ((p_ ^ ((wv_ >> 1) & 7)) << 4)), (LAS unsigned*)(L + LV + st_ * 2048 + w * 1024), 16, 0, 0); } \
        if (GLA && w == 2) __builtin_amdgcn_global_load_lds((const unsigned*)((const char*)(BC + (size_t)(b * SEQ + rc_ * 64 + 63) * 512 + h * 128) + lane * 16), (LAS unsigned*)(L + LDEC + st_ * 1024), 16, 0, 0); \
        _Pragma("unroll") for (int k_ = 0; k_ < KS; ++k_) QSET[k_] = gload16(qlane + (size_t)rc_ * TILEB + k_ * 64); } while (0)
#define S2_WAIT_PREV() do { if (w < 2 || (GLA && w == 2)) { if (NI + KS + 1 == 13) S2_WAITV(13); else S2_WAITV(7); } else { if (NI + KS == 12) S2_WAITV(12); else S2_WAITV(6); } } while (0)
    static_assert((NI + KS == 12) || (NI + KS == 6), "S2 wait immediates");
    for (int i = F.tid * 16; i < TILEB; i += NTHREADS * 16) *(LAS u32x4*)(L + LK + i) = (u32x4){0, 0, 0, 0};
    for (int i = F.tid * 16; i < 2048; i += NTHREADS * 16) *(LAS u32x4*)(L + LV + i) = (u32x4){0, 0, 0, 0};
    for (int i = F.tid * 16; i < 16 * ROWB; i += NTHREADS * 16) { *(LAS u32x4*)(L + LS + i) = (u32x4){0, 0, 0, 0}; *(LAS u32x4*)(L + LQM + i) = (u32x4){0, 0, 0, 0}; }
    __syncthreads();
    if (!GLA) {
        for (int idx = F.tid; idx < 16 * 128; idx += NTHREADS) { const int j = idx >> 7, c = idx & 127, row = 48 + j;
            const float* rq = RAW + (size_t)j * ldraw + h * 256; const float* rk = rq + 1024;
            const float rev = ((float)j * ROPE_INV[c]) * 0.15915494309189535f; const float frc = rev - floorf(rev);
            const float sn = __builtin_amdgcn_sinf(frc), cs = __builtin_amdgcn_cosf(frc);
            const float dq = __builtin_amdgcn_exp2f((float)(row + 1) * L2G[h]), dk = 0.0625f * __builtin_amdgcn_exp2f(-(float)(row + 1) * L2G[h]);
            const float q1v = rq[c], q2v = rq[c + 128], k1 = rk[c], k2 = rk[c + 128];
            const int a1 = row * ROWB + ((((c >> 3)) ^ (row & 15)) << 4) + (c & 7) * 2, a2 = row * ROWB + ((((c + 128) >> 3) ^ (row & 15)) << 4) + (c & 7) * 2;
            *(LAS bf16_t*)(L + LQM + j * ROWB + c * 2) = f2bf((q1v * cs - q2v * sn) * dq); *(LAS bf16_t*)(L + LQM + j * ROWB + (c + 128) * 2) = f2bf((q1v * sn + q2v * cs) * dq);
            *(LAS bf16_t*)(L + LK + a1) = f2bf((k1 * cs - k2 * sn) * dk); *(LAS bf16_t*)(L + LK + a2) = f2bf((k1 * sn + k2 * cs) * dk); }
        if (F.tid < 256) { const int j = F.tid >> 4, wv = F.tid & 15, tok = 48 + j;
            *(LAS bf16_t*)(L + LV + wv * 128 + (((tok >> 3) ^ ((wv >> 1) & 7)) << 4) + (tok & 7) * 2) = f2bf(RAW[(size_t)j * ldraw + 2048 + h * 512 + 16 * s + wv]); }
    } else {
        if (F.tid < 128) { const int d = F.tid; const float* wgp = F.in[13] + h * 128 + d; const float bias = F.in[14][h * 128 + d]; float cum = 0.f;
            for (int j = 0; j < 16; ++j) { float a = bias;
                for (int r = 0; r < 16; ++r) a += RAW[(size_t)j * ldraw + 3072 + r] * wgp[r * 512];
                cum += (fminf(a, 0.f) - __logf(1.0f + __expf(-fabsf(a)))) * 0.0625f;
                const int row = 48 + j;
                *(LAS bf16_t*)(L + LK + row * ROWB + (((d >> 3) ^ (row & 15)) << 4) + (d & 7) * 2) = f2bf(RAW[(size_t)j * ldraw + 512 + h * 128 + d] * __expf(-cum)); }
            *(LAS float*)(L + LDEC + d * 4) = cum; }
        if (F.tid >= 256) { const int j = (F.tid - 256) >> 4, wv = F.tid & 15, tok = 48 + j;
            *(LAS bf16_t*)(L + LV + wv * 128 + (((tok >> 3) ^ ((wv >> 1) & 7)) << 4) + (tok & 7) * 2) = f2bf(RAW[(size_t)j * ldraw + 1024 + h * 256 + 16 * s + wv]); }
    }
    f32x4 S[NT];
#pragma unroll
    for (int tt = 0; tt < NT; ++tt) S[tt] = (f32x4){0.f, 0.f, 0.f, 0.f};
    const float g64 = GLA ? 1.0f : __builtin_amdgcn_exp2f(64.0f * L2G[h]);
    __syncthreads();
#pragma unroll
    for (int k = 0; k < KS; ++k) { q0[k] = *(const LAS bf16x8*)(L + LQM + (ti == 3 ? r16 : 0) * ROWB + (4 * k + g) * 16); if (ti != 3) q0[k] = (bf16x8){0, 0, 0, 0, 0, 0, 0, 0}; q1[k] = q0[k]; q2[k] = q0[k]; }
    LDS_WAIT();
    S2_ISSUE(1, q1);
    f32x4 ot_prev = (f32x4){0.f, 0.f, 0.f, 0.f}; float ss_prev = 0.f;
#define S2_STEP(c_, QC, QN2) do { const int c = (c_), st = c % 3, sb = c & 1; \
          \
        if (hf == 0 && c >= 1) { const f32x4 part = *(const LAS f32x4*)(L + LOT + ti * 1024 + lane * 16); const f32x4 ot = ot_prev + part; const int irow = 16 * ti + r16; \
            if (c >= 2) { const size_t grow = (size_t)b * SEQ + (c - 2) * 64 + irow; u32x2 pk; pk.x = cvt_pk_bf16(ot[0], ot[1]); pk.y = cvt_pk_bf16(ot[2], ot[3]); \
                *(u32x2*)(O + grow * LDO + h * DV + 16 * s + 4 * g) = pk; } \
            else if (!GLA && b == 0 && irow >= 48) { float* MO = WSP(float, WS_META + META_MO); \
                *(f32x4*)(MO + (size_t)(irow - 48) * 2048 + h * 512 + 16 * s + 4 * g) = ot; } } \
        if (c + 2 <= 128) S2_ISSUE(c + 2, QN2); \
          \
        { const int tj0 = 2 * hf; f32x4 pt0 = (f32x4){0.f, 0.f, 0.f, 0.f}, pt1 = pt0; \
          const LAS unsigned char* kb0 = L + LK + st * TILEB + (16 * tj0 + r16) * ROWB; const LAS unsigned char* kb1 = kb0 + 16 * ROWB; \
          _Pragma("unroll") for (int ks = 0; ks < KS; ++ks) { const int ch = ((4 * ks + g) ^ r16) << 4; \
              const bf16x8 k0 = *(const LAS bf16x8*)(kb0 + ch), k1 = *(const LAS bf16x8*)(kb1 + ch); \
              pt0 = __builtin_amdgcn_mfma_f32_16x16x32_bf16(k0, QC[ks], pt0, 0, 0, 0); pt1 = __builtin_amdgcn_mfma_f32_16x16x32_bf16(k1, QC[ks], pt1, 0, 0, 0); } \
          const int i = 16 * ti + r16; \
          _Pragma("unroll") for (int tjj = 0; tjj < 2; ++tjj) { const f32x4 pt = tjj ? pt1 : pt0; const int tj = tj0 + tjj, j0 = 16 * tj + 4 * g; \
              const float v0 = (j0 + 0 <= i) ? pt[0] : 0.f, v1 = (j0 + 1 <= i) ? pt[1] : 0.f, v2 = (j0 + 2 <= i) ? pt[2] : 0.f, v3 = (j0 + 3 <= i) ? pt[3] : 0.f; \
              u32x2 pk; pk.x = cvt_pk_bf16(v0, v1); pk.y = cvt_pk_bf16(v2, v3); \
              *(LAS u32x2*)(L + LP + i * 128 + (((2 * tj + (g >> 1)) ^ ((i >> 1) & 7)) << 4) + (g & 1) * 8) = pk; } } \
        LDS_WAIT(); __builtin_amdgcn_s_barrier(); asm volatile("" ::: "memory"); \
          \
        { const int irow = 16 * ti + r16; f32x4 ot = (f32x4){0.f, 0.f, 0.f, 0.f}; \
          if (hf == 0) { _Pragma("unroll") for (int ks = 0; ks < 2; ++ks) { \
                const bf16x8 va = *(const LAS bf16x8*)(L + LV + st * 2048 + r16 * 128 + (((4 * ks + g) ^ ((r16 >> 1) & 7)) << 4)); \
                const bf16x8 pb = *(const LAS bf16x8*)(L + LP + irow * 128 + (((4 * ks + g) ^ ((irow >> 1) & 7)) << 4)); \
                ot = __builtin_amdgcn_mfma_f32_16x16x32_bf16(va, pb, ot, 0, 0, 0); } } \
          if (hf == 0) { _Pragma("unroll") for (int kk = 0; kk < KS / 2; ++kk) { \
              const bf16x8 sa = *(const LAS bf16x8*)(L + LS + sb * 16 * ROWB + r16 * ROWB + (((4 * kk + g) ^ r16) << 4)); \
              ot = __builtin_amdgcn_mfma_f32_16x16x32_bf16(sa, QC[kk], ot, 0, 0, 0); } } \
          else { _Pragma("unroll") for (int kk = KS / 2; kk < KS; ++kk) { \
              const bf16x8 sa = *(const LAS bf16x8*)(L + LS + sb * 16 * ROWB + r16 * ROWB + (((4 * kk + g) ^ r16) << 4)); \
              ot = __builtin_amdgcn_mfma_f32_16x16x32_bf16(sa, QC[kk], ot, 0, 0, 0); } } \
          if (hf == 1) *(LAS f32x4*)(L + LOT + ti * 1024 + lane * 16) = ot; else ot_prev = ot; } \
          \
        { s16x4 klo[2][NT], khi[2][NT]; bf16x8 vbb[2]; \
          _Pragma("unroll") for (int ks = 0; ks < 2; ++ks) { \
              vbb[ks] = *(const LAS bf16x8*)(L + LV + st * 2048 + r16 * 128 + (((4 * ks + g) ^ ((r16 >> 1) & 7)) << 4)); \
              _Pragma("unroll") for (int tt = 0; tt < NT; ++tt) { const int d0 = 16 * (w + 8 * tt), dcol = d0 + 4 * (r16 & 3), chunk = dcol >> 3, sub = (dcol & 7) * 2; \
                  const int r1 = 32 * ks + 8 * g + (r16 >> 2), r2 = r1 + 4; \
                  klo[ks][tt] = ds_tr_asm(Lb + LK + st * TILEB + r1 * ROWB + ((chunk ^ (r1 & 15)) << 4) + sub); \
                  khi[ks][tt] = ds_tr_asm(Lb + LK + st * TILEB + r2 * ROWB + ((chunk ^ (r2 & 15)) << 4) + sub); } } \
          asm volatile("s_waitcnt lgkmcnt(0)" ::: "memory"); __builtin_amdgcn_sched_barrier(0); \
          _Pragma("unroll") for (int ks = 0; ks < 2; ++ks) _Pragma("unroll") for (int tt = 0; tt < NT; ++tt) { \
                  const s16x4 lo = klo[ks][tt], hi = khi[ks][tt]; \
                  const bf16x8 ka = (bf16x8){lo[0], lo[1], lo[2], lo[3], hi[0], hi[1], hi[2], hi[3]}; \
                  S[tt] = __builtin_amdgcn_mfma_f32_16x16x32_bf16(ka, vbb[ks], S[tt], 0, 0, 0); } \
          _Pragma("unroll") for (int tt = 0; tt < NT; ++tt) { const int tile = w + 8 * tt; \
              if (GLA) { const f32x4 dl = *(const LAS f32x4*)(L + LDEC + st * 1024 + (16 * tile + 4 * g) * 4); \
                  S[tt][0] *= __expf(dl[0]); S[tt][1] *= __expf(dl[1]); S[tt][2] *= __expf(dl[2]); S[tt][3] *= __expf(dl[3]); } else S[tt] = S[tt] * g64; \
              u32x2 pk; pk.x = cvt_pk_bf16(S[tt][0], S[tt][1]); pk.y = cvt_pk_bf16(S[tt][2], S[tt][3]); \
              *(LAS u32x2*)(L + LS + (sb ^ 1) * 16 * ROWB + r16 * ROWB + (((2 * tile + (g >> 1)) ^ r16) << 4) + (g & 1) * 8) = pk; } } \
          \
        if (c + 2 <= 128) S2_WAIT_PREV(); else S2_WAITV(0); \
        LDS_WAIT(); __builtin_amdgcn_s_barrier(); asm volatile("" ::: "memory"); __builtin_amdgcn_sched_barrier(0); \
    } while (0)
#define S2_PIN(Q) do { _Pragma("unroll") for (int k_ = 0; k_ < KS; ++k_) asm volatile("" : "+v"(Q[k_])); } while (0)
    for (int c3 = 0; c3 < 129; c3 += 3) {
        S2_STEP(c3, q0, q2);     S2_PIN(q1);
        S2_STEP(c3 + 1, q1, q0); S2_PIN(q2);
        S2_STEP(c3 + 2, q2, q1); S2_PIN(q0);
    }
    if (hf == 0) { const f32x4 part = *(const LAS f32x4*)(L + LOT + ti * 1024 + lane * 16); const f32x4 ot = ot_prev + part; const int irow = 16 * ti + r16;
        const size_t grow = (size_t)b * SEQ + 127 * 64 + irow; u32x2 pk; pk.x = cvt_pk_bf16(ot[0], ot[1]); pk.y = cvt_pk_bf16(ot[2], ot[3]);
        *(u32x2*)(O + grow * LDO + h * DV + 16 * s + 4 * g) = pk; }
#undef S2_ISSUE
#undef S2_WAIT_PREV
#undef S2_STEP
#undef S2_PIN
}

template <int DK, int DV, bool GLA>
__device__ __forceinline__ void s2v3_phase(Frame& F, const bf16_t* QH, const bf16_t* KH, const bf16_t* VT, bf16_t* O, const float* BC, int ldraw) {
    constexpr int NS = DV / 16, ROWB = DK * 2, TILEB = 64 * ROWB, NIL = TILEB / 1024 / 4, NTU = DK / 64, LDO = 4 * DV, KS = DK / 32;
    constexpr int LK = 0, LV = 3 * TILEB, LDEC = LV + 3 * 2048, LP = LDEC + 3 * 1024, LS = LP + 8192, LOT = LS + 2 * 16 * ROWB, LQM = LOT + 4096, LEND = LQM + 16 * ROWB;
    static_assert(LEND <= LDS_MISC, "S2 LDS map");
    static_assert((NIL + KS == 16) || (NIL + KS == 8), "S2 wait immediates");
    const int unit = blockIdx.x; if (unit >= 8 * NS) return;
    const int bh = unit & 7, s = unit >> 3, b = bh >> 2, h = bh & 3;
    const int lane = F.lane, g = lane >> 4, r16 = lane & 15, w = F.wave, ti = w >> 1, hf = w & 1;
    LAS unsigned char* L = F.lds; const unsigned Lb = (unsigned)(uintptr_t)L;
    const float* RAW = WSP(float, WS_META + META_RAW);
    const char* Qg = (const char*)(QH + (size_t)bh * SEQ * DK); const char* Kg = (const char*)(KH + (size_t)bh * SEQ * DK);
    const char* Vg = (const char*)(VT + ((size_t)bh * DV + 16 * s) * SEQ);
    const char* qlane = Qg + (size_t)(16 * ti + r16) * ROWB + g * 16;
    bf16x8 q0[KS], q1[KS], q2[KS];
#define S3_ISSUE(c_, ST_, QSET) do { unsigned lzi_ = 0; asm volatile("" : "+v"(lzi_)); const int rc_ = (c_) - 1; constexpr int st_ = (ST_); const char* kc_ = Kg + (size_t)rc_ * TILEB + lzi_; \
        _Pragma("unroll") for (int i_ = 0; i_ < NIL; ++i_) { const int piece_ = ti * NIL + i_, off_ = piece_ * 1024 + lane * 16, row_ = off_ / ROWB, p_ = (off_ % ROWB) >> 4; \
            __builtin_amdgcn_global_load_lds((const unsigned*)(kc_ + row_ * ROWB + ((p_ ^ (row_ & 15)) << 4)), (LAS unsigned*)(L + LK + st_ * TILEB + piece_ * 1024), 16, 0, 0); } \
        if (ti < 2) { const int off_ = ti * 1024 + lane * 16, wv_ = off_ >> 7, p_ = (off_ & 127) >> 4; \
            __builtin_amdgcn_global_load_lds((const unsigned*)(Vg + (size_t)wv_ * SEQ * 2 + (size_t)rc_ * 128 + ((p_ ^ ((wv_ >> 1) & 7)) << 4)), (LAS unsigned*)(L + LV + st_ * 2048 + ti * 1024), 16, 0, 0); } \
        if (GLA && ti == 2) __builtin_amdgcn_global_load_lds((const unsigned*)((const char*)(BC + (size_t)(b * SEQ + rc_ * 64 + 63) * 512 + h * 128) + lane * 16), (LAS unsigned*)(L + LDEC + st_ * 1024), 16, 0, 0); \
        _Pragma("unroll") for (int k_ = 0; k_ < KS; ++k_) QSET[k_] = gload16(qlane + (size_t)rc_ * TILEB + k_ * 64); } while (0)
#define S3_WAIT_PREV() do { if (ti < 2 || (GLA && ti == 2)) { if (NIL + KS == 16) S2_WAITV(17); else S2_WAITV(9); } else { if (NIL + KS == 16) S2_WAITV(16); else S2_WAITV(8); } } while (0)
    for (int i = F.tid * 16; i < TILEB; i += NTHREADS * 16) *(LAS u32x4*)(L + LK + i) = (u32x4){0, 0, 0, 0};
    for (int i = F.tid * 16; i < 2048; i += NTHREADS * 16) *(LAS u32x4*)(L + LV + i) = (u32x4){0, 0, 0, 0};
    for (int i = F.tid * 16; i < 16 * ROWB; i += NTHREADS * 16) { *(LAS u32x4*)(L + LS + i) = (u32x4){0, 0, 0, 0}; *(LAS u32x4*)(L + LQM + i) = (u32x4){0, 0, 0, 0}; }
    __syncthreads();
    if (!GLA) {
        for (int idx = F.tid; idx < 16 * 128; idx += NTHREADS) { const int j = idx >> 7, c = idx & 127, row = 48 + j;
            const float* rq = RAW + (size_t)j * ldraw + h * 256; const float* rk = rq + 1024;
            const float rev = ((float)j * ROPE_INV[c]) * 0.15915494309189535f; const float frc = rev - floorf(rev);
            const float sn = __builtin_amdgcn_sinf(frc), cs = __builtin_amdgcn_cosf(frc);
            const float dq = __builtin_amdgcn_exp2f((float)(row + 1) * L2G[h]), dk = 0.0625f * __builtin_amdgcn_exp2f(-(float)(row + 1) * L2G[h]);
            const float q1v = rq[c], q2v = rq[c + 128], k1 = rk[c], k2 = rk[c + 128];
            const int a1 = row * ROWB + ((((c >> 3)) ^ (row & 15)) << 4) + (c & 7) * 2, a2 = row * ROWB + ((((c + 128) >> 3) ^ (row & 15)) << 4) + (c & 7) * 2;
            *(LAS bf16_t*)(L + LQM + j * ROWB + c * 2) = f2bf((q1v * cs - q2v * sn) * dq); *(LAS bf16_t*)(L + LQM + j * ROWB + (c + 128) * 2) = f2bf((q1v * sn + q2v * cs) * dq);
            *(LAS bf16_t*)(L + LK + a1) = f2bf((k1 * cs - k2 * sn) * dk); *(LAS bf16_t*)(L + LK + a2) = f2bf((k1 * sn + k2 * cs) * dk); }
        if (F.tid < 256) { const int j = F.tid >> 4, wv = F.tid & 15, tok = 48 + j;
            *(LAS bf16_t*)(L + LV + wv * 128 + (((tok >> 3) ^ ((wv >> 1) & 7)) << 4) + (tok & 7) * 2) = f2bf(RAW[(size_t)j * ldraw + 2048 + h * 512 + 16 * s + wv]); }
    } else {
        if (F.tid < 128) { const int d = F.tid; const float* wgp = F.in[13] + h * 128 + d; const float bias = F.in[14][h * 128 + d]; float cum = 0.f;
            for (int j = 0; j < 16; ++j) { float a = bias;
                for (int r = 0; r < 16; ++r) a += RAW[(size_t)j * ldraw + 3072 + r] * wgp[r * 512];
                cum += (fminf(a, 0.f) - __logf(1.0f + __expf(-fabsf(a)))) * 0.0625f;
                const int row = 48 + j;
                *(LAS bf16_t*)(L + LK + row * ROWB + (((d >> 3) ^ (row & 15)) << 4) + (d & 7) * 2) = f2bf(RAW[(size_t)j * ldraw + 512 + h * 128 + d] * __expf(-cum)); }
            *(LAS float*)(L + LDEC + d * 4) = cum; }
        if (F.tid >= 256) { const int j = (F.tid - 256) >> 4, wv = F.tid & 15, tok = 48 + j;
            *(LAS bf16_t*)(L + LV + wv * 128 + (((tok >> 3) ^ ((wv >> 1) & 7)) << 4) + (tok & 7) * 2) = f2bf(RAW[(size_t)j * ldraw + 1024 + h * 256 + 16 * s + wv]); }
    }
    f32x4 S[NTU];
#pragma unroll
    for (int tt = 0; tt < NTU; ++tt) S[tt] = (f32x4){0.f, 0.f, 0.f, 0.f};
    const float g64 = GLA ? 1.0f : __builtin_amdgcn_exp2f(64.0f * L2G[h]);
    __syncthreads();
#pragma unroll
    for (int k = 0; k < KS; ++k) { q0[k] = *(const LAS bf16x8*)(L + LQM + (ti == 3 ? r16 : 0) * ROWB + (4 * k + g) * 16); if (ti != 3) q0[k] = (bf16x8){0, 0, 0, 0, 0, 0, 0, 0}; asm volatile("" : "=v"(q1[k])); asm volatile("" : "=v"(q2[k])); }
    LDS_WAIT();
    if (hf) S3_ISSUE(1, 1, q1);
    f32x4 ot_prev = (f32x4){0.f, 0.f, 0.f, 0.f};
#define S3_STEP(c_, ST, QC, QN2) do { const int c = (c_), sb = c & 1; constexpr int st = (ST); \
        unsigned lz_ = 0; asm volatile("" : "+v"(lz_)); LAS unsigned char* const Lz = L + lz_; const unsigned Lbz = Lb + lz_;   \
        if (hf == 0) { \
              \
            if (c >= 1) { const f32x4 part = *(const LAS f32x4*)(Lz + LOT + ti * 1024 + lane * 16); const f32x4 ot = ot_prev + part; const int irow = 16 * ti + r16; \
                if (c >= 2) { const size_t grow = (size_t)b * SEQ + (c - 2) * 64 + irow; u32x2 pk; pk.x = cvt_pk_bf16(ot[0], ot[1]); pk.y = cvt_pk_bf16(ot[2], ot[3]); \
                    *(u32x2*)(O + grow * LDO + h * DV + 16 * s + 4 * g) = pk; } \
                else if (!GLA && b == 0 && irow >= 48) { float* MO = WSP(float, WS_META + META_MO); *(f32x4*)(MO + (size_t)(irow - 48) * 2048 + h * 512 + 16 * s + 4 * g) = ot; } } \
              \
            { bf16x8 vbb[2]; \
              _Pragma("unroll") for (int ks = 0; ks < 2; ++ks) vbb[ks] = *(const LAS bf16x8*)(Lz + LV + st * 2048 + r16 * 128 + (((4 * ks + g) ^ ((r16 >> 1) & 7)) << 4)); \
              _Pragma("unroll") for (int tt = 0; tt < NTU; ++tt) { const int tile = ti + 4 * tt, d0 = 16 * tile, dcol = d0 + 4 * (r16 & 3), chunk = dcol >> 3, sub = (dcol & 7) * 2; \
                  s16x4 klo[2], khi[2]; \
                  _Pragma("unroll") for (int ks = 0; ks < 2; ++ks) { const int r1 = 32 * ks + 8 * g + (r16 >> 2), r2 = r1 + 4; \
                      klo[ks] = ds_tr_asm(Lbz + LK + st * TILEB + r1 * ROWB + ((chunk ^ (r1 & 15)) << 4) + sub); \
                      khi[ks] = ds_tr_asm(Lbz + LK + st * TILEB + r2 * ROWB + ((chunk ^ (r2 & 15)) << 4) + sub); } \
                  asm volatile("s_waitcnt lgkmcnt(0)" ::: "memory"); __builtin_amdgcn_sched_barrier(0); \
                  _Pragma("unroll") for (int ks = 0; ks < 2; ++ks) { const s16x4 lo = klo[ks], hi = khi[ks]; \
                      const bf16x8 ka = (bf16x8){lo[0], lo[1], lo[2], lo[3], hi[0], hi[1], hi[2], hi[3]}; \
                      S[tt] = __builtin_amdgcn_mfma_f32_16x16x32_bf16(ka, vbb[ks], S[tt], 0, 0, 0); } \
                  if (GLA) { const f32x4 dl = *(const LAS f32x4*)(Lz + LDEC + st * 1024 + (16 * tile + 4 * g) * 4); \
                      S[tt][0] *= __expf(dl[0]); S[tt][1] *= __expf(dl[1]); S[tt][2] *= __expf(dl[2]); S[tt][3] *= __expf(dl[3]); } else S[tt] = S[tt] * g64; \
                  u32x2 pk; pk.x = cvt_pk_bf16(S[tt][0], S[tt][1]); pk.y = cvt_pk_bf16(S[tt][2], S[tt][3]); \
                  *(LAS u32x2*)(Lz + LS + (sb ^ 1) * 16 * ROWB + r16 * ROWB + (((2 * tile + (g >> 1)) ^ r16) << 4) + (g & 1) * 8) = pk; } } \
        } else { \
            if (c + 2 <= 128) S3_ISSUE(c + 2, (ST + 2) % 3, QN2); \
              \
            { const LAS unsigned char* kb = Lz + LK + st * TILEB + r16 * ROWB; const int i = 16 * ti + r16; \
              _Pragma("unroll") for (int th = 0; th < 2; ++th) { f32x4 pa = (f32x4){0.f, 0.f, 0.f, 0.f}, pb = pa; \
                  if (2 * th <= ti) { \
                      _Pragma("unroll") for (int ks = 0; ks < KS; ++ks) { const int ch = ((4 * ks + g) ^ r16) << 4; \
                          const bf16x8 ka = *(const LAS bf16x8*)(kb + (2 * th) * 16 * ROWB + ch), kc2 = *(const LAS bf16x8*)(kb + (2 * th + 1) * 16 * ROWB + ch); \
                          pa = __builtin_amdgcn_mfma_f32_16x16x32_bf16(ka, QC[ks], pa, 0, 0, 0); pb = __builtin_amdgcn_mfma_f32_16x16x32_bf16(kc2, QC[ks], pb, 0, 0, 0); \
                          if (ks & 1) __builtin_amdgcn_sched_barrier(0); } } \
                  _Pragma("unroll") for (int tq = 0; tq < 2; ++tq) { const int tj = 2 * th + tq, j0 = 16 * tj + 4 * g; const f32x4 pt = tq ? pb : pa; \
                      const float v0 = (j0 + 0 <= i) ? pt[0] : 0.f, v1 = (j0 + 1 <= i) ? pt[1] : 0.f, v2 = (j0 + 2 <= i) ? pt[2] : 0.f, v3 = (j0 + 3 <= i) ? pt[3] : 0.f; \
                      u32x2 pk; pk.x = cvt_pk_bf16(v0, v1); pk.y = cvt_pk_bf16(v2, v3); \
                      *(LAS u32x2*)(Lz + LP + i * 128 + (((2 * tj + (g >> 1)) ^ ((i >> 1) & 7)) << 4) + (g & 1) * 8) = pk; } } } \
        } \
        LDS_WAIT(); __builtin_amdgcn_s_barrier(); asm volatile("" ::: "memory"); \
        if (hf == 0) {   \
            const int irow = 16 * ti + r16; f32x4 ot = (f32x4){0.f, 0.f, 0.f, 0.f}; \
            _Pragma("unroll") for (int ks = 0; ks < 2; ++ks) { \
                const bf16x8 va = *(const LAS bf16x8*)(Lz + LV + st * 2048 + r16 * 128 + (((4 * ks + g) ^ ((r16 >> 1) & 7)) << 4)); \
                const bf16x8 pb = *(const LAS bf16x8*)(Lz + LP + irow * 128 + (((4 * ks + g) ^ ((irow >> 1) & 7)) << 4)); \
                ot = __builtin_amdgcn_mfma_f32_16x16x32_bf16(va, pb, ot, 0, 0, 0); } \
            ot_prev = ot; \
        } else {   \
            f32x4 oa = (f32x4){0.f, 0.f, 0.f, 0.f}, ob = oa; \
            _Pragma("unroll") for (int ks = 0; ks < KS; ks += 2) { \
                const bf16x8 sa = *(const LAS bf16x8*)(Lz + LS + sb * 16 * ROWB + r16 * ROWB + (((4 * ks + g) ^ r16) << 4)); \
                const bf16x8 sc = *(const LAS bf16x8*)(Lz + LS + sb * 16 * ROWB + r16 * ROWB + (((4 * (ks + 1) + g) ^ r16) << 4)); \
                oa = __builtin_amdgcn_mfma_f32_16x16x32_bf16(sa, QC[ks], oa, 0, 0, 0); ob = __builtin_amdgcn_mfma_f32_16x16x32_bf16(sc, QC[ks + 1], ob, 0, 0, 0); __builtin_amdgcn_sched_barrier(0); } \
            *(LAS f32x4*)(Lz + LOT + ti * 1024 + lane * 16) = oa + ob; \
            if (c + 2 <= 128) S3_WAIT_PREV(); else S2_WAITV(0); \
        } \
        LDS_WAIT(); __builtin_amdgcn_s_barrier(); asm volatile("" ::: "memory"); __builtin_amdgcn_sched_barrier(0); \
    } while (0)
#define S3_PIN(Q) do { _Pragma("unroll") for (int k_ = 0; k_ < KS; ++k_) asm volatile("" : "+v"(Q[k_])); } while (0)
    for (int c3 = 0; c3 < 129; c3 += 3) {
        S3_STEP(c3, 0, q0, q2);     S3_PIN(q1);
        S3_STEP(c3 + 1, 1, q1, q0); S3_PIN(q2);
        S3_STEP(c3 + 2, 2, q2, q1); S3_PIN(q0);
    }
    if (hf == 0) { const f32x4 part = *(const LAS f32x4*)(L + LOT + ti * 1024 + lane * 16); const f32x4 ot = ot_prev + part; const int irow = 16 * ti + r16;
        const size_t grow = (size_t)b * SEQ + 127 * 64 + irow; u32x2 pk; pk.x = cvt_pk_bf16(ot[0], ot[1]); pk.y = cvt_pk_bf16(ot[2], ot[3]);
        *(u32x2*)(O + grow * LDO + h * DV + 16 * s + 4 * g) = pk; }
#undef S3_ISSUE
#undef S3_WAIT_PREV
#undef S3_STEP
#undef S3_PIN
}

template <int DK, int DV, bool GLA>
__device__ __forceinline__ void s2v4_phase(Frame& F, const int unit, const bf16_t* QH, const bf16_t* KH, const bf16_t* VT, bf16_t* O, const float* BC, int ldraw) {
    constexpr int NS = DV / 16, ROWB = DK * 2, TILEB = 32 * ROWB, NIL = TILEB / 1024 / 4, NTU = DK / 64, LDO = 4 * DV, KS = DK / 32, NSTEP = 257;
    constexpr int LK = 0, LQ = 3 * TILEB, LV = 6 * TILEB, LDEC = LV + 3 * 1024, LP = LDEC + 3 * 1024, LS = LP + 2048, LOT = LS + 2 * 16 * ROWB, LEND = LOT + 4096;
    static_assert(LEND + 256 <= LDS_MISC, "S2 LDS map");
    static_assert(NIL == 4 || NIL == 2, "S2 wait immediates");
    if (unit >= 8 * NS) return;
    const int bh = unit & 7, s = unit >> 3, b = bh >> 2, h = bh & 3;
    const int lane = F.lane, g = lane >> 4, r16 = lane & 15, w = F.wave, li = w >> 1, hf = w & 1, qi = li >> 1, kj = li & 1;
    LAS unsigned char* L = F.lds; const unsigned Lb = (unsigned)(uintptr_t)L;
    const float* RAW = WSP(float, WS_META + META_RAW);
    const char* Qg = (const char*)(QH + (size_t)bh * SEQ * DK); const char* Kg = (const char*)(KH + (size_t)bh * SEQ * DK);
    const char* Vg = (const char*)(VT + ((size_t)bh * DV + 16 * s) * SEQ);
#define S4_ISSUE(c_, st_) do { const int rc_ = (c_) - 1; const char* kc_ = Kg + (size_t)rc_ * TILEB; const char* qc_ = Qg + (size_t)rc_ * TILEB; \
        _Pragma("unroll") for (int i_ = 0; i_ < NIL; ++i_) { const int piece_ = li * NIL + i_, off_ = piece_ * 1024 + lane * 16, row_ = off_ / ROWB, p_ = (off_ % ROWB) >> 4; const int so_ = row_ * ROWB + ((p_ ^ (row_ & 15)) << 4); \
            __builtin_amdgcn_global_load_lds((const unsigned*)(kc_ + so_), (LAS unsigned*)(L + LK + (st_) * TILEB + piece_ * 1024), 16, 0, 0); \
            __builtin_amdgcn_global_load_lds((const unsigned*)(qc_ + so_), (LAS unsigned*)(L + LQ + (st_) * TILEB + piece_ * 1024), 16, 0, 0); } \
        if (li == 0) { const int wv_ = lane >> 2, p_ = lane & 3; \
            __builtin_amdgcn_global_load_lds((const unsigned*)(Vg + (size_t)wv_ * SEQ * 2 + (size_t)rc_ * 64 + ((p_ ^ ((wv_ >> 2) & 3)) << 4)), (LAS unsigned*)(L + LV + (st_) * 1024), 16, 0, 0); } \
        if (GLA && li == 1) __builtin_amdgcn_global_load_lds((const unsigned*)((const char*)(BC + (size_t)(b * SEQ + rc_ * 32 + 31) * 512 + h * 128) + lane * 16), (LAS unsigned*)(L + LDEC + (st_) * 1024), 16, 0, 0); } while (0)
#define S4_WAIT_PREV() do { if (li == 0 || (GLA && li == 1)) { if (NIL == 4) S2_WAITV(9); else S2_WAITV(5); } else { if (NIL == 4) S2_WAITV(8); else S2_WAITV(4); } } while (0)
    for (int i = F.tid * 16; i < TILEB; i += NTHREADS * 16) { *(LAS u32x4*)(L + LK + i) = (u32x4){0, 0, 0, 0}; *(LAS u32x4*)(L + LQ + i) = (u32x4){0, 0, 0, 0}; }
    for (int i = F.tid * 16; i < 1024; i += NTHREADS * 16) *(LAS u32x4*)(L + LV + i) = (u32x4){0, 0, 0, 0};
    for (int i = F.tid * 16; i < 16 * ROWB; i += NTHREADS * 16) *(LAS u32x4*)(L + LS + i) = (u32x4){0, 0, 0, 0};
    __syncthreads();
    if (!GLA) {
        for (int idx = F.tid; idx < 16 * 128; idx += NTHREADS) { const int j = idx >> 7, c = idx & 127, row = 16 + j;
            const float* rq = RAW + (size_t)j * ldraw + h * 256; const float* rk = rq + 1024;
            const float rev = ((float)j * ROPE_INV[c]) * 0.15915494309189535f; const float frc = rev - floorf(rev);
            const float sn = __builtin_amdgcn_sinf(frc), cs = __builtin_amdgcn_cosf(frc);
            const float dq = __builtin_amdgcn_exp2f((float)(row + 1) * L2G[h]), dk = 0.0625f * __builtin_amdgcn_exp2f(-(float)(row + 1) * L2G[h]);
            const float q1v = rq[c], q2v = rq[c + 128], k1 = rk[c], k2 = rk[c + 128];
            const int a1 = row * ROWB + ((((c >> 3)) ^ (row & 15)) << 4) + (c & 7) * 2, a2 = row * ROWB + ((((c + 128) >> 3) ^ (row & 15)) << 4) + (c & 7) * 2;
            *(LAS bf16_t*)(L + LQ + a1) = f2bf((q1v * cs - q2v * sn) * dq); *(LAS bf16_t*)(L + LQ + a2) = f2bf((q1v * sn + q2v * cs) * dq);
            *(LAS bf16_t*)(L + LK + a1) = f2bf((k1 * cs - k2 * sn) * dk); *(LAS bf16_t*)(L + LK + a2) = f2bf((k1 * sn + k2 * cs) * dk); }
        if (F.tid < 256) { const int j = F.tid >> 4, wv = F.tid & 15, tok = 16 + j;
            *(LAS bf16_t*)(L + LV + wv * 64 + (((tok >> 3) ^ ((wv >> 2) & 3)) << 4) + (tok & 7) * 2) = f2bf(RAW[(size_t)j * ldraw + 2048 + h * 512 + 16 * s + wv]); }
    } else {
        if (F.tid < 128) { const int d = F.tid; const float* wgp = F.in[13] + h * 128 + d; const float bias = F.in[14][h * 128 + d]; float cum = 0.f;
            for (int j = 0; j < 16; ++j) { float a = bias;
                for (int r = 0; r < 16; ++r) a += RAW[(size_t)j * ldraw + 3072 + r] * wgp[r * 512];
                cum += (fminf(a, 0.f) - __logf(1.0f + __expf(-fabsf(a)))) * 0.0625f;
                const int row = 16 + j;
                *(LAS bf16_t*)(L + LK + row * ROWB + (((d >> 3) ^ (row & 15)) << 4) + (d & 7) * 2) = f2bf(RAW[(size_t)j * ldraw + 512 + h * 128 + d] * __expf(-cum)); }
            *(LAS float*)(L + LDEC + d * 4) = cum; }
        if (F.tid >= 256) { const int j = (F.tid - 256) >> 4, wv = F.tid & 15, tok = 16 + j;
            *(LAS bf16_t*)(L + LV + wv * 64 + (((tok >> 3) ^ ((wv >> 2) & 3)) << 4) + (tok & 7) * 2) = f2bf(RAW[(size_t)j * ldraw + 1024 + h * 256 + 16 * s + wv]); }
    }
    f32x4 S[NTU];
#pragma unroll
    for (int tt = 0; tt < NTU; ++tt) S[tt] = (f32x4){0.f, 0.f, 0.f, 0.f};
    const float g32 = GLA ? 1.0f : __builtin_amdgcn_exp2f(32.0f * L2G[h]);
    __syncthreads();
    if (hf) S4_ISSUE(1, 1);
    f32x4 ot_prev = (f32x4){0.f, 0.f, 0.f, 0.f};
    int st = 0;
#if defined(PROBE2)
    unsigned long long pacc = 0ull, pt0 = 0ull; const unsigned long long ptot0 = __builtin_amdgcn_s_memtime();
#define P2T(q, stmt) do { if (PROBE2 == (q) && !GLA) { stmt; } } while (0)
#else
#define P2T(q, stmt) do {} while (0)
#endif
    for (int c = 0; c < NSTEP; ++c) {
        P2T(2, if (hf == 1) pt0 = __builtin_amdgcn_s_memtime()); P2T(3, if (hf == 0) pt0 = __builtin_amdgcn_s_memtime());
        const int sb = c & 1, st2 = (st == 0) ? 2 : st - 1;
        unsigned lz_ = 0; asm volatile("" : "+v"(lz_)); LAS unsigned char* const Lz = L + lz_; const unsigned Lbz = Lb + lz_;
        if (hf == 0) {
            if (li == 3) { constexpr int PFD = 8, LPT = TILEB / 128, LPB = 2 * LPT / NS; const int rcp = c + PFD - 1;
                if (rcp < 256) { const char* pa_ = nullptr;
                    if (lane < LPB) { const int ln = s * LPB + lane; pa_ = (ln < LPT) ? Kg + (size_t)rcp * TILEB + ln * 128 : Qg + (size_t)rcp * TILEB + (ln - LPT) * 128; }
                    else if (lane >= 16 && lane < 32) pa_ = Vg + (size_t)(lane - 16) * SEQ * 2 + (size_t)rcp * 64;
                    else if (GLA && lane == 32 && s == 0) pa_ = (const char*)(BC + (size_t)(b * SEQ + rcp * 32 + 31) * 512 + h * 128);
                    if (pa_) glds_touch(pa_, (unsigned)__builtin_amdgcn_readfirstlane((int)(Lb + LEND))); } }
            if (li < 2 && c >= 1) { const f32x4 pa = *(const LAS f32x4*)(Lz + LOT + (li * 2) * 1024 + lane * 16), pb = *(const LAS f32x4*)(Lz + LOT + (li * 2 + 1) * 1024 + lane * 16);
                const f32x4 ot = ot_prev + (pa + pb); const int irow = 16 * li + r16;
                if (c >= 2) { const size_t grow = (size_t)b * SEQ + (size_t)(c - 2) * 32 + irow; u32x2 pk; pk.x = cvt_pk_bf16(ot[0], ot[1]); pk.y = cvt_pk_bf16(ot[2], ot[3]);
                    *(u32x2*)(O + grow * LDO + h * DV + 16 * s + 4 * g) = pk; }
                else if (!GLA && b == 0 && irow >= 16) { float* MO = WSP(float, WS_META + META_MO); *(f32x4*)(MO + (size_t)(irow - 16) * 2048 + h * 512 + 16 * s + 4 * g) = ot; } }
            { s16x4 klo[NTU], khi[NTU];
              const bf16x8 vb = *(const LAS bf16x8*)(Lz + LV + st * 1024 + r16 * 64 + ((g ^ ((r16 >> 2) & 3)) << 4));
#pragma unroll
              for (int tt = 0; tt < NTU; ++tt) { const int tile = li + 4 * tt, d0 = 16 * tile, dcol = d0 + 4 * (r16 & 3), chunk = dcol >> 3, sub = (dcol & 7) * 2;
                  const int r1 = 8 * g + (r16 >> 2), r2 = r1 + 4;
                  klo[tt] = ds_tr_asm(Lbz + LK + st * TILEB + r1 * ROWB + ((chunk ^ (r1 & 15)) << 4) + sub);
                  khi[tt] = ds_tr_asm(Lbz + LK + st * TILEB + r2 * ROWB + ((chunk ^ (r2 & 15)) << 4) + sub); }
              asm volatile("s_waitcnt lgkmcnt(0)" ::: "memory"); __builtin_amdgcn_sched_barrier(0);
#pragma unroll
              for (int tt = 0; tt < NTU; ++tt) {
                  const bf16x8 ka = (bf16x8){klo[tt][0], klo[tt][1], klo[tt][2], klo[tt][3], khi[tt][0], khi[tt][1], khi[tt][2], khi[tt][3]};
                  S[tt] = __builtin_amdgcn_mfma_f32_16x16x32_bf16(ka, vb, S[tt], 0, 0, 0); }
#pragma unroll
              for (int tt = 0; tt < NTU; ++tt) { const int tile = li + 4 * tt;
                  if (GLA) { const f32x4 dl = *(const LAS f32x4*)(Lz + LDEC + st * 1024 + (16 * tile + 4 * g) * 4);
                      S[tt][0] *= __expf(dl[0]); S[tt][1] *= __expf(dl[1]); S[tt][2] *= __expf(dl[2]); S[tt][3] *= __expf(dl[3]); } else S[tt] = S[tt] * g32;
                  u32x2 pk; pk.x = cvt_pk_bf16(S[tt][0], S[tt][1]); pk.y = cvt_pk_bf16(S[tt][2], S[tt][3]);
                  *(LAS u32x2*)(Lz + LS + (sb ^ 1) * 16 * ROWB + r16 * ROWB + (((2 * tile + (g >> 1)) ^ r16) << 4) + (g & 1) * 8) = pk; } }
        } else {
            if (c + 2 < NSTEP) S4_ISSUE(c + 2, st2);
            { f32x4 pa = (f32x4){0.f, 0.f, 0.f, 0.f}, pb = pa;
              if (kj <= qi) { const LAS unsigned char* kb = Lz + LK + st * TILEB + (16 * kj + r16) * ROWB; const LAS unsigned char* qb = Lz + LQ + st * TILEB + (16 * qi + r16) * ROWB;
#pragma unroll
                  for (int ks = 0; ks < KS; ks += 2) { const int ch0 = ((4 * ks + g) ^ r16) << 4, ch1 = ((4 * (ks + 1) + g) ^ r16) << 4;
                      const bf16x8 k0 = *(const LAS bf16x8*)(kb + ch0), q0 = *(const LAS bf16x8*)(qb + ch0), k1 = *(const LAS bf16x8*)(kb + ch1), q1 = *(const LAS bf16x8*)(qb + ch1);
                      pa = __builtin_amdgcn_mfma_f32_16x16x32_bf16(k0, q0, pa, 0, 0, 0); pb = __builtin_amdgcn_mfma_f32_16x16x32_bf16(k1, q1, pb, 0, 0, 0); } }
              const f32x4 pt = pa + pb; const int i = 16 * qi + r16, j0 = 16 * kj + 4 * g;
              const float v0 = (j0 + 0 <= i) ? pt[0] : 0.f, v1 = (j0 + 1 <= i) ? pt[1] : 0.f, v2 = (j0 + 2 <= i) ? pt[2] : 0.f, v3 = (j0 + 3 <= i) ? pt[3] : 0.f;
              u32x2 pk; pk.x = cvt_pk_bf16(v0, v1); pk.y = cvt_pk_bf16(v2, v3);
              *(LAS u32x2*)(Lz + LP + i * 64 + (((2 * kj + (g >> 1)) ^ ((i >> 2) & 3)) << 4) + (g & 1) * 8) = pk; }
        }
        LDS_WAIT();
        P2T(2, if (hf == 1) pacc += __builtin_amdgcn_s_memtime() - pt0); P2T(3, if (hf == 0) pacc += __builtin_amdgcn_s_memtime() - pt0);
        P2T(5, pt0 = __builtin_amdgcn_s_memtime());
        __builtin_amdgcn_s_barrier(); asm volatile("" ::: "memory"); __builtin_amdgcn_sched_barrier(0);
        P2T(5, pacc += __builtin_amdgcn_s_memtime() - pt0);
        P2T(4, if (hf == 1) pt0 = __builtin_amdgcn_s_memtime());
        if (hf == 0) {
            if (li < 2) { const int irow = 16 * li + r16;
                const bf16x8 va = *(const LAS bf16x8*)(Lz + LV + st * 1024 + r16 * 64 + ((g ^ ((r16 >> 2) & 3)) << 4));
                const bf16x8 pb = *(const LAS bf16x8*)(Lz + LP + irow * 64 + ((g ^ ((irow >> 2) & 3)) << 4));
                ot_prev = __builtin_amdgcn_mfma_f32_16x16x32_bf16(va, pb, (f32x4){0.f, 0.f, 0.f, 0.f}, 0, 0, 0); }
        } else {
            f32x4 oa = (f32x4){0.f, 0.f, 0.f, 0.f}, ob = oa;
            const LAS unsigned char* sp = Lz + LS + sb * 16 * ROWB + r16 * ROWB; const LAS unsigned char* qb = Lz + LQ + st * TILEB + (16 * qi + r16) * ROWB;
#pragma unroll
            for (int kk = 0; kk < KS / 2; kk += 2) { const int ks = kj * (KS / 2) + kk; const int ch0 = ((4 * ks + g) ^ r16) << 4, ch1 = ((4 * (ks + 1) + g) ^ r16) << 4;
                const bf16x8 s0 = *(const LAS bf16x8*)(sp + ch0), q0 = *(const LAS bf16x8*)(qb + ch0), s1 = *(const LAS bf16x8*)(sp + ch1), q1 = *(const LAS bf16x8*)(qb + ch1);
                oa = __builtin_amdgcn_mfma_f32_16x16x32_bf16(s0, q0, oa, 0, 0, 0); ob = __builtin_amdgcn_mfma_f32_16x16x32_bf16(s1, q1, ob, 0, 0, 0); }
            *(LAS f32x4*)(Lz + LOT + (qi * 2 + kj) * 1024 + lane * 16) = oa + ob;
            P2T(4, pacc += __builtin_amdgcn_s_memtime() - pt0); P2T(1, pt0 = __builtin_amdgcn_s_memtime());
            if (c + 2 < NSTEP) S4_WAIT_PREV(); else S2_WAITV(0);
            P2T(1, pacc += __builtin_amdgcn_s_memtime() - pt0);
        }
        LDS_WAIT(); __builtin_amdgcn_s_barrier(); asm volatile("" ::: "memory"); __builtin_amdgcn_sched_barrier(0);
        st = (st == 2) ? 0 : st + 1;
    }
#if defined(PROBE2)
    if (!GLA && unit == 0) { if (PROBE2 == 0) pacc = __builtin_amdgcn_s_memtime() - ptot0; const int pw = (PROBE2 == 3 || PROBE2 == 5 || PROBE2 == 0) ? 0 : 1; if (w == pw && lane == 0) { volatile LAS unsigned* MI = (volatile LAS unsigned*)(F.lds + LDS_MISC); MI[20] = (unsigned)pacc; MI[21] = (unsigned)(pacc >> 32); } }
#endif
    if (hf == 0 && li < 2) { const f32x4 pa = *(const LAS f32x4*)(L + LOT + (li * 2) * 1024 + lane * 16), pb = *(const LAS f32x4*)(L + LOT + (li * 2 + 1) * 1024 + lane * 16);
        const f32x4 ot = ot_prev + (pa + pb); const int irow = 16 * li + r16;
        const size_t grow = (size_t)b * SEQ + (size_t)(NSTEP - 2) * 32 + irow; u32x2 pk; pk.x = cvt_pk_bf16(ot[0], ot[1]); pk.y = cvt_pk_bf16(ot[2], ot[3]);
        *(u32x2*)(O + grow * LDO + h * DV + 16 * s + 4 * g) = pk; }
#undef S4_ISSUE
#undef S4_WAIT_PREV
}

template <int DK, int DV, bool GLA>
__device__ __forceinline__ void s2v5_phase(Frame& F, const int unit, const bf16_t* QH, const bf16_t* KH, const bf16_t* VT, bf16_t* O, const float* BC, int ldraw) {
    constexpr int NS = DV / 16, ROWB = DK * 2, TILEB = 32 * ROWB, NIL = TILEB / 1024 / 4, NTU = DK / 64, LDO = 4 * DV, KS = DK / 32, NSTEP = 257;
    constexpr int LK = 0, LQ = 2 * TILEB, LV = 4 * TILEB, LDEC = LV + 2 * 1024, LP = LDEC + 2 * 1024, LS = LP + 2048, LOT = LS + 2 * 16 * ROWB, LEND = LOT + 4096;
    static_assert(LEND <= LDS_MISC, "S2 LDS map");
    if (unit >= 8 * NS) return;
    const int bh = unit & 7, s = unit >> 3, b = bh >> 2, h = bh & 3;
    const int lane = F.lane, g = lane >> 4, r16 = lane & 15, w = F.wave, li = w & 3, hf = w >> 2, qi = li >> 1, kj = li & 1;
    LAS unsigned char* L = F.lds; const unsigned Lb = (unsigned)(uintptr_t)L;
    const float* RAW = WSP(float, WS_META + META_RAW);
    const char* Qg = (const char*)(QH + (size_t)bh * SEQ * DK); const char* Kg = (const char*)(KH + (size_t)bh * SEQ * DK);
    const char* Vg = (const char*)(VT + ((size_t)bh * DV + 16 * s) * SEQ);
    u32x4 ra[2 * NIL + 1], rb[2 * NIL + 1];
#pragma unroll
    for (int i = 0; i < 2 * NIL + 1; ++i) { ra[i] = (u32x4){0, 0, 0, 0}; rb[i] = ra[i]; }
#define S5_LOAD(c_, R) do { const int rc_ = ((c_) - 1 < 255) ? (c_) - 1 : 255;     const char* kc_ = Kg + (size_t)rc_ * TILEB; const char* qc_ = Qg + (size_t)rc_ * TILEB; \
        _Pragma("unroll") for (int i_ = 0; i_ < NIL; ++i_) { const int piece_ = li * NIL + i_, off_ = piece_ * 1024 + lane * 16, row_ = off_ / ROWB, p_ = (off_ % ROWB) >> 4; const int so_ = row_ * ROWB + ((p_ ^ (row_ & 15)) << 4); \
            R[i_] = *(const u32x4*)(kc_ + so_); R[NIL + i_] = *(const u32x4*)(qc_ + so_); } \
        if (li == 0) { const int wv_ = lane >> 2, p_ = lane & 3; R[2 * NIL] = *(const u32x4*)(Vg + (size_t)wv_ * SEQ * 2 + (size_t)rc_ * 64 + ((p_ ^ ((wv_ >> 2) & 3)) << 4)); } \
        if (GLA && li == 1) R[2 * NIL] = *(const u32x4*)((const char*)(BC + (size_t)(b * SEQ + rc_ * 32 + 31) * 512 + h * 128) + lane * 16); } while (0)
#define S5_WRITE(st_, R) do { \
        _Pragma("unroll") for (int i_ = 0; i_ < NIL; ++i_) { const int piece_ = li * NIL + i_; \
            *(LAS u32x4*)(L + LK + (st_) * TILEB + piece_ * 1024 + lane * 16) = R[i_]; *(LAS u32x4*)(L + LQ + (st_) * TILEB + piece_ * 1024 + lane * 16) = R[NIL + i_]; } \
        if (li == 0) *(LAS u32x4*)(L + LV + (st_) * 1024 + lane * 16) = R[2 * NIL]; \
        if (GLA && li == 1) *(LAS u32x4*)(L + LDEC + (st_) * 1024 + lane * 16) = R[2 * NIL]; } while (0)
    for (int i = F.tid * 16; i < TILEB; i += NTHREADS * 16) { *(LAS u32x4*)(L + LK + i) = (u32x4){0, 0, 0, 0}; *(LAS u32x4*)(L + LQ + i) = (u32x4){0, 0, 0, 0}; }
    for (int i = F.tid * 16; i < 1024; i += NTHREADS * 16) *(LAS u32x4*)(L + LV + i) = (u32x4){0, 0, 0, 0};
    for (int i = F.tid * 16; i < 16 * ROWB; i += NTHREADS * 16) *(LAS u32x4*)(L + LS + i) = (u32x4){0, 0, 0, 0};
    __syncthreads();
    if (!GLA) {
        for (int idx = F.tid; idx < 16 * 128; idx += NTHREADS) { const int j = idx >> 7, c = idx & 127, row = 16 + j;
            const float* rq = RAW + (size_t)j * ldraw + h * 256; const float* rk = rq + 1024;
            const float rev = ((float)j * ROPE_INV[c]) * 0.15915494309189535f; const float frc = rev - floorf(rev);
            const float sn = __builtin_amdgcn_sinf(frc), cs = __builtin_amdgcn_cosf(frc);
            const float dq = __builtin_amdgcn_exp2f((float)(row + 1) * L2G[h]), dk = 0.0625f * __builtin_amdgcn_exp2f(-(float)(row + 1) * L2G[h]);
            const float q1v = rq[c], q2v = rq[c + 128], k1 = rk[c], k2 = rk[c + 128];
            const int a1 = row * ROWB + ((((c >> 3)) ^ (row & 15)) << 4) + (c & 7) * 2, a2 = row * ROWB + ((((c + 128) >> 3) ^ (row & 15)) << 4) + (c & 7) * 2;
            *(LAS bf16_t*)(L + LQ + a1) = f2bf((q1v * cs - q2v * sn) * dq); *(LAS bf16_t*)(L + LQ + a2) = f2bf((q1v * sn + q2v * cs) * dq);
            *(LAS bf16_t*)(L + LK + a1) = f2bf((k1 * cs - k2 * sn) * dk); *(LAS bf16_t*)(L + LK + a2) = f2bf((k1 * sn + k2 * cs) * dk); }
        if (F.tid < 256) { const int j = F.tid >> 4, wv = F.tid & 15, tok = 16 + j;
            *(LAS bf16_t*)(L + LV + wv * 64 + (((tok >> 3) ^ ((wv >> 2) & 3)) << 4) + (tok & 7) * 2) = f2bf(RAW[(size_t)j * ldraw + 2048 + h * 512 + 16 * s + wv]); }
    } else {
        if (F.tid < 128) { const int d = F.tid; const float* wgp = F.in[13] + h * 128 + d; const float bias = F.in[14][h * 128 + d]; float cum = 0.f;
            for (int j = 0; j < 16; ++j) { float a = bias;
                for (int r = 0; r < 16; ++r) a += RAW[(size_t)j * ldraw + 3072 + r] * wgp[r * 512];
                cum += (fminf(a, 0.f) - __logf(1.0f + __expf(-fabsf(a)))) * 0.0625f;
                const int row = 16 + j;
                *(LAS bf16_t*)(L + LK + row * ROWB + (((d >> 3) ^ (row & 15)) << 4) + (d & 7) * 2) = f2bf(RAW[(size_t)j * ldraw + 512 + h * 128 + d] * __expf(-cum)); }
            *(LAS float*)(L + LDEC + d * 4) = cum; }
        if (F.tid >= 256) { const int j = (F.tid - 256) >> 4, wv = F.tid & 15, tok = 16 + j;
            *(LAS bf16_t*)(L + LV + wv * 64 + (((tok >> 3) ^ ((wv >> 2) & 3)) << 4) + (tok & 7) * 2) = f2bf(RAW[(size_t)j * ldraw + 1024 + h * 256 + 16 * s + wv]); }
    }
    f32x4 S[NTU];
#pragma unroll
    for (int tt = 0; tt < NTU; ++tt) S[tt] = (f32x4){0.f, 0.f, 0.f, 0.f};
    const float g32 = GLA ? 1.0f : __builtin_amdgcn_exp2f(32.0f * L2G[h]);
    __syncthreads();
    if (hf) S5_LOAD(1, rb);
#define S5_ODD(c_, ST, RL, RW) do { const int c = (c_); constexpr int st = (ST), sb = (ST); P3T(1, pt0 = __builtin_amdgcn_s_memtime()); \
        LAS unsigned char* const Lz = L; \
        S5_LOAD(c + 2, RL); P3T(1, pacc += __builtin_amdgcn_s_memtime() - pt0); P3T(2, pt0 = __builtin_amdgcn_s_memtime()); \
        { f32x4 pa = (f32x4){0.f, 0.f, 0.f, 0.f}, pb = pa; \
          if (kj <= qi) { const LAS unsigned char* kb = Lz + LK + st * TILEB + (16 * kj + r16) * ROWB; const LAS unsigned char* qb = Lz + LQ + st * TILEB + (16 * qi + r16) * ROWB; \
              _Pragma("unroll") for (int ks = 0; ks < KS; ks += 2) { const int ch0 = ((4 * ks + g) ^ r16) << 4, ch1 = ((4 * (ks + 1) + g) ^ r16) << 4; \
                  const bf16x8 k0 = *(const LAS bf16x8*)(kb + ch0), q0 = *(const LAS bf16x8*)(qb + ch0), k1 = *(const LAS bf16x8*)(kb + ch1), q1 = *(const LAS bf16x8*)(qb + ch1); \
                  pa = __builtin_amdgcn_mfma_f32_16x16x32_bf16(k0, q0, pa, 0, 0, 0); pb = __builtin_amdgcn_mfma_f32_16x16x32_bf16(k1, q1, pb, 0, 0, 0); } } \
          const f32x4 pt = pa + pb; const int i = 16 * qi + r16, j0 = 16 * kj + 4 * g; \
          const float v0 = (j0 + 0 <= i) ? pt[0] : 0.f, v1 = (j0 + 1 <= i) ? pt[1] : 0.f, v2 = (j0 + 2 <= i) ? pt[2] : 0.f, v3 = (j0 + 3 <= i) ? pt[3] : 0.f; \
          u32x2 pk; pk.x = cvt_pk_bf16(v0, v1); pk.y = cvt_pk_bf16(v2, v3); \
          *(LAS u32x2*)(Lz + LP + i * 64 + (((2 * kj + (g >> 1)) ^ ((i >> 2) & 3)) << 4) + (g & 1) * 8) = pk; } \
        LDS_WAIT(); P3T(2, pacc += __builtin_amdgcn_s_memtime() - pt0); P3T(3, pt0 = __builtin_amdgcn_s_memtime()); __builtin_amdgcn_s_barrier(); asm volatile("" ::: "memory"); P3T(3, pacc += __builtin_amdgcn_s_memtime() - pt0); P3T(4, pt0 = __builtin_amdgcn_s_memtime()); \
        P3T(4, pacc += __builtin_amdgcn_s_memtime() - pt0); P3T(5, pt0 = __builtin_amdgcn_s_memtime()); S5_WRITE(st ^ 1, RW); \
        LDS_WAIT(); P3T(5, pacc += __builtin_amdgcn_s_memtime() - pt0); P3T(6, pt0 = __builtin_amdgcn_s_memtime()); __builtin_amdgcn_s_barrier(); asm volatile("" ::: "memory"); P3T(6, pacc += __builtin_amdgcn_s_memtime() - pt0); \
    } while (0)
#define S5_EVEN(c_, ST) do { const int c = (c_); constexpr int st = (ST), sb = (ST); P3T(7, pt0 = __builtin_amdgcn_s_memtime()); \
        LAS unsigned char* const Lz = L; const unsigned Lbz = Lb; \
        P3T(7, pacc += __builtin_amdgcn_s_memtime() - pt0); P3T(8, pt0 = __builtin_amdgcn_s_memtime()); \
        { s16x4 klo[NTU], khi[NTU]; \
          const bf16x8 vb = *(const LAS bf16x8*)(Lz + LV + st * 1024 + r16 * 64 + ((g ^ ((r16 >> 2) & 3)) << 4)); \
          _Pragma("unroll") for (int tt = 0; tt < NTU; ++tt) { const int tile = li + 4 * tt, d0 = 16 * tile, dcol = d0 + 4 * (r16 & 3), chunk = dcol >> 3, sub = (dcol & 7) * 2; \
              const int r1 = 8 * g + (r16 >> 2), r2 = r1 + 4; \
              klo[tt] = ds_tr_asm(Lbz + LK + st * TILEB + r1 * ROWB + ((chunk ^ (r1 & 15)) << 4) + sub); \
              khi[tt] = ds_tr_asm(Lbz + LK + st * TILEB + r2 * ROWB + ((chunk ^ (r2 & 15)) << 4) + sub); } \
          asm volatile("s_waitcnt lgkmcnt(0)" ::: "memory"); __builtin_amdgcn_sched_barrier(0); \
          _Pragma("unroll") for (int tt = 0; tt < NTU; ++tt) { \
              const bf16x8 ka = (bf16x8){klo[tt][0], klo[tt][1], klo[tt][2], klo[tt][3], khi[tt][0], khi[tt][1], khi[tt][2], khi[tt][3]}; \
              S[tt] = __builtin_amdgcn_mfma_f32_16x16x32_bf16(ka, vb, S[tt], 0, 0, 0); } \
          _Pragma("unroll") for (int tt = 0; tt < NTU; ++tt) { const int tile = li + 4 * tt; \
              if (GLA) { const f32x4 dl = *(const LAS f32x4*)(Lz + LDEC + st * 1024 + (16 * tile + 4 * g) * 4); \
                  S[tt][0] *= __expf(dl[0]); S[tt][1] *= __expf(dl[1]); S[tt][2] *= __expf(dl[2]); S[tt][3] *= __expf(dl[3]); } else S[tt] = S[tt] * g32; \
              u32x2 pk; pk.x = cvt_pk_bf16(S[tt][0], S[tt][1]); pk.y = cvt_pk_bf16(S[tt][2], S[tt][3]); \
              *(LAS u32x2*)(Lz + LS + (sb ^ 1) * 16 * ROWB + r16 * ROWB + (((2 * tile + (g >> 1)) ^ r16) << 4) + (g & 1) * 8) = pk; } } \
        LDS_WAIT(); P3T(8, pacc += __builtin_amdgcn_s_memtime() - pt0); P3T(9, pt0 = __builtin_amdgcn_s_memtime()); __builtin_amdgcn_s_barrier(); asm volatile("" ::: "memory"); P3T(9, pacc += __builtin_amdgcn_s_memtime() - pt0); P3T(10, pt0 = __builtin_amdgcn_s_memtime()); \
        if (li < 2) { const int irow = 16 * li + r16;        \
            const bf16x8 va = *(const LAS bf16x8*)(Lz + LV + st * 1024 + r16 * 64 + ((g ^ ((r16 >> 2) & 3)) << 4)); \
            const bf16x8 pb = *(const LAS bf16x8*)(Lz + LP + irow * 64 + ((g ^ ((irow >> 2) & 3)) << 4)); \
            f32x4 oa = __builtin_amdgcn_mfma_f32_16x16x32_bf16(va, pb, (f32x4){0.f, 0.f, 0.f, 0.f}, 0, 0, 0), ob = (f32x4){0.f, 0.f, 0.f, 0.f}; \
            const LAS unsigned char* sp = Lz + LS + sb * 16 * ROWB + r16 * ROWB; const LAS unsigned char* qb = Lz + LQ + st * TILEB + irow * ROWB; \
            _Pragma("unroll") for (int ks = 0; ks < KS; ks += 2) { const int ch0 = ((4 * ks + g) ^ r16) << 4, ch1 = ((4 * (ks + 1) + g) ^ r16) << 4; \
                const bf16x8 s0 = *(const LAS bf16x8*)(sp + ch0), q0 = *(const LAS bf16x8*)(qb + ch0), s1 = *(const LAS bf16x8*)(sp + ch1), q1 = *(const LAS bf16x8*)(qb + ch1); \
                oa = __builtin_amdgcn_mfma_f32_16x16x32_bf16(s0, q0, oa, 0, 0, 0); ob = __builtin_amdgcn_mfma_f32_16x16x32_bf16(s1, q1, ob, 0, 0, 0); } \
            const f32x4 ot = oa + ob; \
            if (c >= 1) { const size_t grow = (size_t)b * SEQ + (size_t)(c - 1) * 32 + irow; u32x2 pk; pk.x = cvt_pk_bf16(ot[0], ot[1]); pk.y = cvt_pk_bf16(ot[2], ot[3]); \
                *(u32x2*)(O + grow * LDO + h * DV + 16 * s + 4 * g) = pk; } \
            else if (!GLA && b == 0 && irow >= 16) { float* MO = WSP(float, WS_META + META_MO); *(f32x4*)(MO + (size_t)(irow - 16) * 2048 + h * 512 + 16 * s + 4 * g) = ot; } } \
        LDS_WAIT(); P3T(10, pacc += __builtin_amdgcn_s_memtime() - pt0); P3T(11, pt0 = __builtin_amdgcn_s_memtime()); __builtin_amdgcn_s_barrier(); asm volatile("" ::: "memory"); P3T(11, pacc += __builtin_amdgcn_s_memtime() - pt0); \
    } while (0)
#if defined(PROBE3)
    unsigned long long pacc = 0ull, pt0 = 0ull;
#define P3T(q, stmt) do { if (PROBE3 == (q) && !GLA) { stmt; } } while (0)
#else
#define P3T(q, stmt) do {} while (0)
#endif
    if (hf) {
        for (int c2 = 0; c2 < 256; c2 += 2) { S5_ODD(c2, 0, ra, rb); S5_ODD(c2 + 1, 1, rb, ra); }
        S5_ODD(256, 0, ra, rb);
#if defined(PROBE3)
        if (!GLA && PROBE3 < 7 && unit == 0 && w == 5 && lane == 0) { volatile LAS unsigned* MI = (volatile LAS unsigned*)(F.lds + LDS_MISC); MI[20] = (unsigned)pacc; MI[21] = (unsigned)(pacc >> 32); }
#endif
    } else {
        for (int c2 = 0; c2 < 256; c2 += 2) { S5_EVEN(c2, 0); S5_EVEN(c2 + 1, 1); }
        S5_EVEN(256, 0);
#if defined(PROBE3)
        if (!GLA && PROBE3 >= 7 && unit == 0 && w == 0 && lane == 0) { volatile LAS unsigned* MI = (volatile LAS unsigned*)(F.lds + LDS_MISC); MI[20] = (unsigned)pacc; MI[21] = (unsigned)(pacc >> 32); }
#endif
    }
#undef S5_ODD
#undef S5_EVEN
#undef S5_LOAD
#undef S5_WRITE
}

template <int DK, int DV, bool GLA>
__device__ __forceinline__ void s2v6_phase(Frame& F, const int unit, const bf16_t* QH, const bf16_t* KH, const bf16_t* VT, bf16_t* O, const float* BC, int ldraw) {
    constexpr int NS = DV / 16, ROWB = DK * 2, TILEB = 32 * ROWB, NIL = TILEB / 1024 / 4, LDO = 4 * DV, KS = DK / 32, NSTEP = 257, NLO = DK / 128, NHI = DK / 32 - NLO;
    constexpr int LK = 0, LQ = 3 * TILEB, LV = 6 * TILEB, LDEC = LV + 3 * 1024, LP = LDEC + 3 * 1024, LS = LP + 2 * 2048, LEND = LS + 2 * 16 * ROWB;
    static_assert(LEND <= LDS_MISC, "S2 LDS map");
    if (unit >= 8 * NS) return;
    const int bh = unit & 7, s = unit >> 3, b = bh >> 2, h = bh & 3;
    const int lane = F.lane, g = lane >> 4, r16 = lane & 15, w = F.wave, li = w & 3, hf = w >> 2, qi = li >> 1, kj = li & 1;
    LAS unsigned char* L = F.lds; const unsigned Lb = (unsigned)(uintptr_t)L;
    const float* RAW = WSP(float, WS_META + META_RAW);
    const char* Qg = (const char*)(QH + (size_t)bh * SEQ * DK); const char* Kg = (const char*)(KH + (size_t)bh * SEQ * DK);
    const char* Vg = (const char*)(VT + ((size_t)bh * DV + 16 * s) * SEQ);
    u32x4 ra[2 * NIL + 1], rb[2 * NIL + 1];
#pragma unroll
    for (int i = 0; i < 2 * NIL + 1; ++i) { ra[i] = (u32x4){0, 0, 0, 0}; rb[i] = ra[i]; }
#define S6_LOAD(c_, R) do { const int rc_ = ((c_) - 1 < 255) ? (c_) - 1 : 255; const char* kc_ = Kg + (size_t)rc_ * TILEB; const char* qc_ = Qg + (size_t)rc_ * TILEB; \
        _Pragma("unroll") for (int i_ = 0; i_ < NIL; ++i_) { const int piece_ = li * NIL + i_, off_ = piece_ * 1024 + lane * 16, row_ = off_ / ROWB, p_ = (off_ % ROWB) >> 4; const int so_ = row_ * ROWB + ((p_ ^ (row_ & 15)) << 4); \
            R[i_] = *(const u32x4*)(kc_ + so_); R[NIL + i_] = *(const u32x4*)(qc_ + so_); } \
        if (li == 0) { const int wv_ = lane >> 2, p_ = lane & 3; R[2 * NIL] = *(const u32x4*)(Vg + (size_t)wv_ * SEQ * 2 + (size_t)rc_ * 64 + ((p_ ^ ((wv_ >> 2) & 3)) << 4)); } \
        if (GLA && li == 1) R[2 * NIL] = *(const u32x4*)((const char*)(BC + (size_t)(b * SEQ + rc_ * 32 + 31) * 512 + h * 128) + lane * 16); } while (0)
#define S6_WRITE(st_, R) do { \
        _Pragma("unroll") for (int i_ = 0; i_ < NIL; ++i_) { const int piece_ = li * NIL + i_; \
            *(LAS u32x4*)(L + LK + (st_) * TILEB + piece_ * 1024 + lane * 16) = R[i_]; *(LAS u32x4*)(L + LQ + (st_) * TILEB + piece_ * 1024 + lane * 16) = R[NIL + i_]; } \
        if (li == 0) *(LAS u32x4*)(L + LV + (st_) * 1024 + lane * 16) = R[2 * NIL]; \
        if (GLA && li == 1) *(LAS u32x4*)(L + LDEC + (st_) * 1024 + lane * 16) = R[2 * NIL]; } while (0)
#define S6_PT(st_, pb_) do { f32x4 pa = (f32x4){0.f, 0.f, 0.f, 0.f}, pc = pa; \
        if (kj <= qi) { const LAS unsigned char* kb = L + LK + (st_) * TILEB + (16 * kj + r16) * ROWB; const LAS unsigned char* qb = L + LQ + (st_) * TILEB + (16 * qi + r16) * ROWB; \
            _Pragma("unroll") for (int ks = 0; ks < KS; ks += 2) { const int ch0 = ((4 * ks + g) ^ r16) << 4, ch1 = ((4 * (ks + 1) + g) ^ r16) << 4; \
                const bf16x8 k0 = *(const LAS bf16x8*)(kb + ch0), q0 = *(const LAS bf16x8*)(qb + ch0), k1 = *(const LAS bf16x8*)(kb + ch1), q1 = *(const LAS bf16x8*)(qb + ch1); \
                pa = __builtin_amdgcn_mfma_f32_16x16x32_bf16(k0, q0, pa, 0, 0, 0); pc = __builtin_amdgcn_mfma_f32_16x16x32_bf16(k1, q1, pc, 0, 0, 0); } } \
        const f32x4 pt = pa + pc; const int i = 16 * qi + r16, j0 = 16 * kj + 4 * g; \
        const float v0 = (j0 + 0 <= i) ? pt[0] : 0.f, v1 = (j0 + 1 <= i) ? pt[1] : 0.f, v2 = (j0 + 2 <= i) ? pt[2] : 0.f, v3 = (j0 + 3 <= i) ? pt[3] : 0.f; \
        u32x2 pk; pk.x = cvt_pk_bf16(v0, v1); pk.y = cvt_pk_bf16(v2, v3); \
        *(LAS u32x2*)(L + LP + (pb_) * 2048 + i * 64 + (((2 * kj + (g >> 1)) ^ ((i >> 2) & 3)) << 4) + (g & 1) * 8) = pk; } while (0)
    for (int i = F.tid * 16; i < TILEB; i += NTHREADS * 16) { *(LAS u32x4*)(L + LK + i) = (u32x4){0, 0, 0, 0}; *(LAS u32x4*)(L + LQ + i) = (u32x4){0, 0, 0, 0}; }
    for (int i = F.tid * 16; i < 1024; i += NTHREADS * 16) *(LAS u32x4*)(L + LV + i) = (u32x4){0, 0, 0, 0};
    for (int i = F.tid * 16; i < 16 * ROWB; i += NTHREADS * 16) *(LAS u32x4*)(L + LS + i) = (u32x4){0, 0, 0, 0};
    __syncthreads();
    if (!GLA) {
        for (int idx = F.tid; idx < 16 * 128; idx += NTHREADS) { const int j = idx >> 7, c = idx & 127, row = 16 + j;
            const float* rq = RAW + (size_t)j * ldraw + h * 256; const float* rk = rq + 1024;
            const float rev = ((float)j * ROPE_INV[c]) * 0.15915494309189535f; const float frc = rev - floorf(rev);
            const float sn = __builtin_amdgcn_sinf(frc), cs = __builtin_amdgcn_cosf(frc);
            const float dq = __builtin_amdgcn_exp2f((float)(row + 1) * L2G[h]), dk = 0.0625f * __builtin_amdgcn_exp2f(-(float)(row + 1) * L2G[h]);
            const float q1v = rq[c], q2v = rq[c + 128], k1 = rk[c], k2 = rk[c + 128];
            const int a1 = row * ROWB + ((((c >> 3)) ^ (row & 15)) << 4) + (c & 7) * 2, a2 = row * ROWB + ((((c + 128) >> 3) ^ (row & 15)) << 4) + (c & 7) * 2;
            *(LAS bf16_t*)(L + LQ + a1) = f2bf((q1v * cs - q2v * sn) * dq); *(LAS bf16_t*)(L + LQ + a2) = f2bf((q1v * sn + q2v * cs) * dq);
            *(LAS bf16_t*)(L + LK + a1) = f2bf((k1 * cs - k2 * sn) * dk); *(LAS bf16_t*)(L + LK + a2) = f2bf((k1 * sn + k2 * cs) * dk); }
        if (F.tid < 256) { const int j = F.tid >> 4, wv = F.tid & 15, tok = 16 + j;
            *(LAS bf16_t*)(L + LV + wv * 64 + (((tok >> 3) ^ ((wv >> 2) & 3)) << 4) + (tok & 7) * 2) = f2bf(RAW[(size_t)j * ldraw + 2048 + h * 512 + 16 * s + wv]); }
    } else {
        if (F.tid < 128) { const int d = F.tid; const float* wgp = F.in[13] + h * 128 + d; const float bias = F.in[14][h * 128 + d]; float cum = 0.f;
            for (int j = 0; j < 16; ++j) { float a = bias;
                for (int r = 0; r < 16; ++r) a += RAW[(size_t)j * ldraw + 3072 + r] * wgp[r * 512];
                cum += (fminf(a, 0.f) - __logf(1.0f + __expf(-fabsf(a)))) * 0.0625f;
                const int row = 16 + j;
                *(LAS bf16_t*)(L + LK + row * ROWB + (((d >> 3) ^ (row & 15)) << 4) + (d & 7) * 2) = f2bf(RAW[(size_t)j * ldraw + 512 + h * 128 + d] * __expf(-cum)); }
            *(LAS float*)(L + LDEC + d * 4) = cum; }
        if (F.tid >= 256) { const int j = (F.tid - 256) >> 4, wv = F.tid & 15, tok = 16 + j;
            *(LAS bf16_t*)(L + LV + wv * 64 + (((tok >> 3) ^ ((wv >> 2) & 3)) << 4) + (tok & 7) * 2) = f2bf(RAW[(size_t)j * ldraw + 1024 + h * 256 + 16 * s + wv]); }
    }
    const float g32 = GLA ? 1.0f : __builtin_amdgcn_exp2f(32.0f * L2G[h]);
    if (hf) { S6_LOAD(1, ra); S6_WRITE(1, ra); }
    __syncthreads();
    if (hf) { S6_PT(0, 0); S6_LOAD(2, rb); }
    __syncthreads();
    if (hf) {
#define S6_ODD(t_, RL, RW) do { const int t = (t_); S6_LOAD(t + 3, RL); if (t + 1 < NSTEP) S6_PT(s1, (t + 1) & 1); S6_WRITE(s2, RW); \
            LDS_WAIT(); __builtin_amdgcn_s_barrier(); asm volatile("" ::: "memory"); { const int o_ = s0; s0 = s1; s1 = s2; s2 = o_; } } while (0)
        int s0 = 0, s1 = 1, s2 = 2;
        for (int t2 = 0; t2 < 256; t2 += 2) { S6_ODD(t2, ra, rb); S6_ODD(t2 + 1, rb, ra); }
        S6_ODD(256, ra, rb);
#undef S6_ODD
    } else {
        f32x4 S[NHI];
#pragma unroll
        for (int tt = 0; tt < NHI; ++tt) S[tt] = (f32x4){0.f, 0.f, 0.f, 0.f};
        int s0 = 0;
        for (int t = 0; t < NSTEP; ++t) { const int sb = t & 1;
            { s16x4 klo[NHI], khi[NHI];
              const bf16x8 vb = *(const LAS bf16x8*)(L + LV + s0 * 1024 + r16 * 64 + ((g ^ ((r16 >> 2) & 3)) << 4));
#pragma unroll
              for (int tt = 0; tt < NHI; ++tt) if (li >= 2 || tt < NLO) { const int tile = (li < 2) ? li + 2 * tt : 2 * NLO + (li - 2) + 2 * tt, d0 = 16 * tile, dcol = d0 + 4 * (r16 & 3), chunk = dcol >> 3, sub = (dcol & 7) * 2;
                  const int r1 = 8 * g + (r16 >> 2), r2 = r1 + 4;
                  klo[tt] = ds_tr_asm(Lb + LK + s0 * TILEB + r1 * ROWB + ((chunk ^ (r1 & 15)) << 4) + sub);
                  khi[tt] = ds_tr_asm(Lb + LK + s0 * TILEB + r2 * ROWB + ((chunk ^ (r2 & 15)) << 4) + sub); }
              asm volatile("s_waitcnt lgkmcnt(0)" ::: "memory"); __builtin_amdgcn_sched_barrier(0);
#pragma unroll
              for (int tt = 0; tt < NHI; ++tt) if (li >= 2 || tt < NLO) {
                  const bf16x8 ka = (bf16x8){klo[tt][0], klo[tt][1], klo[tt][2], klo[tt][3], khi[tt][0], khi[tt][1], khi[tt][2], khi[tt][3]};
                  S[tt] = __builtin_amdgcn_mfma_f32_16x16x32_bf16(ka, vb, S[tt], 0, 0, 0); }
#pragma unroll
              for (int tt = 0; tt < NHI; ++tt) if (li >= 2 || tt < NLO) { const int tile = (li < 2) ? li + 2 * tt : 2 * NLO + (li - 2) + 2 * tt;
                  if (GLA) { const f32x4 dl = *(const LAS f32x4*)(L + LDEC + s0 * 1024 + (16 * tile + 4 * g) * 4);
                      S[tt][0] *= __expf(dl[0]); S[tt][1] *= __expf(dl[1]); S[tt][2] *= __expf(dl[2]); S[tt][3] *= __expf(dl[3]); } else S[tt] = S[tt] * g32;
                  u32x2 pk; pk.x = cvt_pk_bf16(S[tt][0], S[tt][1]); pk.y = cvt_pk_bf16(S[tt][2], S[tt][3]);
                  *(LAS u32x2*)(L + LS + (sb ^ 1) * 16 * ROWB + r16 * ROWB + (((2 * tile + (g >> 1)) ^ r16) << 4) + (g & 1) * 8) = pk; } }
            if (li < 2) { const int irow = 16 * li + r16;
                const bf16x8 va = *(const LAS bf16x8*)(L + LV + s0 * 1024 + r16 * 64 + ((g ^ ((r16 >> 2) & 3)) << 4));
                const bf16x8 pb = *(const LAS bf16x8*)(L + LP + sb * 2048 + irow * 64 + ((g ^ ((irow >> 2) & 3)) << 4));
                f32x4 oa = __builtin_amdgcn_mfma_f32_16x16x32_bf16(va, pb, (f32x4){0.f, 0.f, 0.f, 0.f}, 0, 0, 0), ob = (f32x4){0.f, 0.f, 0.f, 0.f};
                const LAS unsigned char* sp = L + LS + sb * 16 * ROWB + r16 * ROWB; const LAS unsigned char* qb = L + LQ + s0 * TILEB + irow * ROWB;
#pragma unroll
                for (int ks = 0; ks < KS; ks += 2) { const int ch0 = ((4 * ks + g) ^ r16) << 4, ch1 = ((4 * (ks + 1) + g) ^ r16) << 4;
                    const bf16x8 sv0 = *(const LAS bf16x8*)(sp + ch0), q0 = *(const LAS bf16x8*)(qb + ch0), sv1 = *(const LAS bf16x8*)(sp + ch1), q1 = *(const LAS bf16x8*)(qb + ch1);
                    oa = __builtin_amdgcn_mfma_f32_16x16x32_bf16(sv0, q0, oa, 0, 0, 0); ob = __builtin_amdgcn_mfma_f32_16x16x32_bf16(sv1, q1, ob, 0, 0, 0); }
                const f32x4 ot = oa + ob;
                if (t >= 1) { const size_t grow = (size_t)b * SEQ + (size_t)(t - 1) * 32 + irow; u32x2 pk; pk.x = cvt_pk_bf16(ot[0], ot[1]); pk.y = cvt_pk_bf16(ot[2], ot[3]);
                    *(u32x2*)(O + grow * LDO + h * DV + 16 * s + 4 * g) = pk; }
                else if (!GLA && b == 0 && irow >= 16) { float* MO = WSP(float, WS_META + META_MO); *(f32x4*)(MO + (size_t)(irow - 16) * 2048 + h * 512 + 16 * s + 4 * g) = ot; } }
            LDS_WAIT(); __builtin_amdgcn_s_barrier(); asm volatile("" ::: "memory");
            s0 = (s0 == 2) ? 0 : s0 + 1;
        }
    }
#undef S6_LOAD
#undef S6_WRITE
#undef S6_PT
}

__device__ __forceinline__ void final_phase(Frame& F, const float* SS, const float* gain) {
    const int gw = F.vcu * NWAVES + F.wave, NGW = F.G * NWAVES; const bf16_t* HB = WSP(bf16_t, WS_HB);
    f32x4 gv[4];
#pragma unroll
    for (int j = 0; j < 4; ++j) gv[j] = *(const f32x4*)(gain + 4 * F.lane + 256 * j);
    for (int m = gw; m < M; m += NGW) { float* row = F.out + (size_t)m * D; const float rs = row_rstd(SS, m);
#pragma unroll
        for (int j = 0; j < 4; ++j) { const u32x2 hv = *(const u32x2*)(HB + (size_t)m * D + 4 * F.lane + 256 * j);
            f32x4 v = (f32x4){bf_lo(hv.x), bf_hi(hv.x), bf_lo(hv.y), bf_hi(hv.y)}; v = v * rs * gv[j]; *(f32x4*)(row + 4 * F.lane + 256 * j) = v; } }
}
__device__ __forceinline__ void p0_rows(Frame& F) {
    const int gw = F.vcu * NWAVES + F.wave, NGW = F.G * NWAVES; const float* x = F.in[0]; bf16_t* HB = WSP(bf16_t, WS_HB); float* SS = WSP(float, WS_SS);
    for (int m = gw; m < M; m += 2 * NGW) { const int m2 = m + NGW;
        f32x4 va[4], vb[4];
#pragma unroll
        for (int j = 0; j < 4; ++j) { va[j] = *(const f32x4*)(x + (size_t)m * D + 4 * F.lane + 256 * j); vb[j] = *(const f32x4*)(x + (size_t)m2 * D + 4 * F.lane + 256 * j); }
        float s = 0.f, s2 = 0.f;
#pragma unroll
        for (int j = 0; j < 4; ++j) { const f32x4 v = va[j], u = vb[j]; s += (v[0] * v[0] + v[1] * v[1]) + (v[2] * v[2] + v[3] * v[3]); s2 += (u[0] * u[0] + u[1] * u[1]) + (u[2] * u[2] + u[3] * u[3]);
            u32x2 pk; pk.x = cvt_pk_bf16(v[0], v[1]); pk.y = cvt_pk_bf16(v[2], v[3]); *(u32x2*)(HB + (size_t)m * D + 4 * F.lane + 256 * j) = pk;
            pk.x = cvt_pk_bf16(u[0], u[1]); pk.y = cvt_pk_bf16(u[2], u[3]); *(u32x2*)(HB + (size_t)m2 * D + 4 * F.lane + 256 * j) = pk; }
        s = wave_sum(s); s2 = wave_sum(s2);
        if (F.lane < 16) { SS[(size_t)m * 16 + F.lane] = F.lane == 0 ? s : 0.f; SS[(size_t)m2 * 16 + F.lane] = F.lane == 0 ? s2 : 0.f; } }
    if (blockIdx.x == 0) { float* HM = WSP(float, WS_META + META_HM); for (int i = F.tid; i < 16 * D; i += NTHREADS) HM[i] = F.in[1][i]; }
}

#ifndef S2FN
#define S2FN s2v6_phase
#endif
struct Args { const float* in[18]; float* out; unsigned char* ws; int ph_lo, ph_hi; };
constexpr int N_PHASES = 19;
__global__ void __launch_bounds__(NTHREADS, 2) fwd(Args args) {
    extern __shared__ __attribute__((aligned(16))) unsigned char lds_raw[];
    Frame F;
    F.lds = (LAS unsigned char*)lds_raw;
    F.tid = threadIdx.x; F.lane = F.tid & 63; F.wave = __builtin_amdgcn_readfirstlane(F.tid >> 6);
    F.G = gridDim.x; { const int bx = blockIdx.x; F.vcu = (F.G % 8 == 0) ? (bx % 8) * (F.G / 8) + bx / 8 : bx; }
    F.ws = args.ws; F.out = args.out;
#pragma unroll
    for (int i = 0; i < 18; ++i) F.in[i] = args.in[i];
    volatile LAS unsigned* MISC = (volatile LAS unsigned*)(F.lds + LDS_MISC);
    if (F.tid < 64) MISC[F.tid] = 0u;
    __syncthreads();
    XcdBarrier bar = xcd_barrier_post(WSP(unsigned, WS_CTL) + CW_BAR, MISC + 8);
    const int lo = args.ph_lo, hi = args.ph_hi;
    __syncthreads();
    F.vb = (int)blockIdx.x;
    int vblk = (int)blockIdx.x;
#define IN(k) (lo <= (k) && (k) < hi)
#if defined(PROBE_PHASE)
    unsigned long long t_prev = __builtin_amdgcn_s_memrealtime(), t_probe = 0ull;
#define SEAM(k) do { if (IN(k) && IN((k) + 1)) xcd_barrier(bar); { const unsigned long long t_now = __builtin_amdgcn_s_memrealtime(); if ((k) == PROBE_PHASE) t_probe = t_now - t_prev; t_prev = t_now; } } while (0)
#else
#define SEAM(k) do { if (IN(k) && IN((k) + 1)) xcd_barrier(bar); } while (0)
#endif
    bf16_t* HB = WSP(bf16_t, WS_HB); float* SS = WSP(float, WS_SS); float* H = F.out;
    bf16_t* ACT = WSP(bf16_t, WS_ACT);
    const int gw = F.vcu * NWAVES + F.wave, NGW = F.G * NWAVES;
    float* RAW = WSP(float, WS_META + META_RAW); float* HM = WSP(float, WS_META + META_HM);

#define FFN_IN(win, do_meta) do { \
        if ((do_meta) && meta_has_tiles(F, 2 * DFF, 128, 128)) { meta_prep_h(F); meta_tiles<0>(F, WSP(bf16_t, (win)), 2 * DFF, D, RAW, 2 * DFF, 1.f, 128, 128); } \
        pg8::Order S_; S_.init(M / 256, 22, F.G, vblk); PtrNormal P_{(const char*)HB, (const char*)WSP(bf16_t, (win)), (size_t)256 * D * 2}; \
        EpiSwiglu E_{SS, ACT}; pg8::gemm_phase(F.lds, D, S_, P_, E_); } while (0)
#define FFN_OUT(wout, do_meta, F32B) do { \
        if (do_meta) { meta_prep_act_q(F); meta_tiles_ksplit(F, WSP(bf16_t, (wout)), DFF, 704, HM, 0.5f); } \
        pg8::Order S_; S_.init(M / 256, 4, F.G, vblk); PtrNormal P_{(const char*)ACT, (const char*)WSP(bf16_t, (wout)), (size_t)256 * DFF * 2}; \
        EpiResid<F32B> E_{F.in[0], HB, SS, 0.5f}; pg8::gemm_phase(F.lds, DFF, S_, P_, E_); } while (0)

#define slack (vblk >= 128)
#define sgw ((vblk - 128) * NWAVES + F.wave)
    const int SNGW = 128 * NWAVES;
    if (IN(0)) {
        int cb = conv_job(F, job_ffn_in(F, 0, 0, WS_WFFN_A + WF_IN), 0, gw, NGW); cb = conv_job(F, job_ffn_out(F, 0, 0, WS_WFFN_A + WF_OUT), cb, gw, NGW);
        p0_rows(F);
    }
    SEAM(0);
    if (lo == 0 && hi == N_PHASES && F.G == 256) {
        const unsigned* barw = WSP(unsigned, WS_CTL) + CW_BAR; bool ok = true;
#pragma unroll
        for (int j = 0; j < 8; ++j) ok = ok && (__hip_atomic_load(barw + XB_XCNT(j), __ATOMIC_RELAXED, __HIP_MEMORY_SCOPE_AGENT) == 32u);
        const unsigned rank = MISC[10], xcc = MISC[11];
        if (ok && rank < 32u && xcc < 8u) vblk = (int)(rank * 8u + xcc);
    }
    F.vb = vblk;
    if (IN(1)) {
        if (slack) { ConvJob J;
            J.W = F.in[9]; J.ldn = 6144; J.K = D; J.N = 6144; J.col0 = 0; J.kind = 0; J.gain = F.in[5]; J.WT = WSP(bf16_t, WS_WMIX + WM_RET_IN);
            int cb = conv_job(F, J, 0, sgw, SNGW);
            J.W = F.in[11]; J.ldn = D; J.K = 2048; J.N = D; J.col0 = 0; J.kind = 0; J.gain = F.in[10]; J.WT = WSP(bf16_t, WS_WMIX + WM_RET_OUT);
            cb = conv_job(F, J, cb, sgw, SNGW);
            cb = conv_job(F, job_ffn_in(F, 0, 1, WS_WFFN_C), cb, sgw, SNGW); __syncthreads(); }
        FFN_IN(WS_WFFN_A + WF_IN, true);
    }
    SEAM(1);
    if (IN(2)) FFN_OUT(WS_WFFN_A + WF_OUT, true, false);
    SEAM(2);
    if (IN(3)) {
        if (meta_has_tiles(F, 6144, 0, 256)) { meta_prep_h(F); meta_tiles<0>(F, WSP(bf16_t, WS_WMIX + WM_RET_IN), 6144, D, RAW, 6144, 1.f, 0, 256); }
        pg8::Order S_; S_.init(M / 256, 16, F.G, vblk);
        PtrSwapFrom P_{(const char*)HB, (const char*)WSP(bf16_t, WS_WMIX + WM_RET_IN), (size_t)256 * D * 2, 8};
        EpiRetIn E_{SS, WSP(bf16_t, WS_QH), WSP(bf16_t, WS_KH), WSP(bf16_t, WS_VT)}; pg8::gemm_phase(F.lds, D, S_, P_, E_);
    }
    SEAM(3);
    if (IN(4)) S2FN<256, 512, false>(F, vblk, WSP(bf16_t, WS_QH), WSP(bf16_t, WS_KH), WSP(bf16_t, WS_VT), WSP(bf16_t, WS_O), nullptr, 6144);
    SEAM(4);
    if (IN(5)) {
        (void)conv_job(F, job_ffn_out(F, 0, 1, WS_WFFN_A + WF_OUT), 0, gw, NGW);
        __syncthreads();
        pg8::Order S_; S_.init(M / 256, 8, F.G, vblk); PtrNormal P_{(const char*)HB, (const char*)(WSP(bf16_t, WS_WMIX + WM_RET_IN) + (size_t)4096 * D), (size_t)256 * D * 2};
        EpiGate<512, 2048> E_{SS, WSP(bf16_t, WS_O), WSP(bf16_t, WS_VT), (LAS float*)(F.lds + 132096)}; pg8::gemm_phase(F.lds, D, S_, P_, E_);
    }
    SEAM(5);
    if (IN(6)) {
        { meta_prep_y_q(F); meta_tiles_ksplit(F, WSP(bf16_t, WS_WMIX + WM_RET_OUT), 2048, 512, HM, 1.0f); }
        pg8::Order S_; S_.init(M / 256, 4, F.G, vblk); PtrNormal P_{(const char*)WSP(bf16_t, WS_VT), (const char*)WSP(bf16_t, WS_WMIX + WM_RET_OUT), (size_t)256 * 2048 * 2};
        EpiResid<false> E_{nullptr, HB, SS, 1.0f}; pg8::gemm_phase(F.lds, 2048, S_, P_, E_);
    }
    SEAM(6);
    if (IN(7)) {
        if (slack) { int cb = conv_job(F, job_ffn_in(F, 1, 0, WS_WFFN_B + WF_IN), 0, sgw, SNGW); cb = conv_job(F, job_ffn_out(F, 1, 0, WS_WFFN_B + WF_OUT), cb, sgw, SNGW);
            ConvJob J;
            J.W = F.in[12]; J.ldn = 3088; J.K = D; J.N = 3072; J.col0 = 0; J.kind = 0; J.gain = F.in[5] + D; J.WT = WSP(bf16_t, WS_WMIX + WM_GLA_IN);
            cb = conv_job(F, J, cb, sgw, SNGW);
            J.W = F.in[16]; J.ldn = D; J.K = D; J.N = D; J.col0 = 0; J.kind = 0; J.gain = F.in[15]; J.WT = WSP(bf16_t, WS_WMIX + WM_GLA_OUT);
            cb = conv_job(F, J, cb, sgw, SNGW);
            if (vblk == F.G - 1) { bf16_t* WZ = WSP(bf16_t, WS_WMIX + WM_GLA_Z); const float* W = F.in[12]; const float* gn = F.in[5] + D;
                for (int i = F.tid; i < 16 * D; i += NTHREADS) { const int k = i >> 4, r = i & 15; WZ[r * D + k] = f2bf(W[(size_t)k * 3088 + 3072 + r] * gn[k]); } }
            __syncthreads(); }
        FFN_IN(WS_WFFN_C, true);
    }
    SEAM(7);
    if (IN(8)) FFN_OUT(WS_WFFN_A + WF_OUT, true, false);
    SEAM(8);
    if (IN(9)) {
        if (slack) { int cb = conv_job(F, job_ffn_in(F, 1, 1, WS_WFFN_A + WF_IN), 0, sgw, SNGW); cb = conv_job(F, job_ffn_out(F, 1, 1, WS_WFFN_A + WF_OUT), cb, sgw, SNGW); __syncthreads(); }
        FFN_IN(WS_WFFN_B + WF_IN, true);
    }
    SEAM(9);
    if (IN(10)) FFN_OUT(WS_WFFN_B + WF_OUT, true, false);
    SEAM(10);
    if (IN(11)) {
        if (meta_has_tiles(F, 2048, 0, 256)) { meta_prep_h(F); meta_tiles<0>(F, WSP(bf16_t, WS_WMIX + WM_GLA_IN), 2048, D, RAW, 3088, 1.f, 0, 256); }
        if (F.vb == 0) meta_tiles<0>(F, WSP(bf16_t, WS_WMIX + WM_GLA_Z), 16, D, RAW + 3072, 3088, 1.f, 0, 256);
        __syncthreads();
        z_phase(F, HB, SS, WSP(bf16_t, WS_WMIX + WM_GLA_Z), F.in[13], F.in[14], WSP(float, WS_BC));
    }
    SEAM(11);
    if (IN(12)) {
        pg8::Order S_; S_.init(M / 256, 8, F.G, vblk);
        PtrSwapFrom P_{(const char*)HB, (const char*)WSP(bf16_t, WS_WMIX + WM_GLA_IN), (size_t)256 * D * 2, 4};
        EpiGlaIn E_{SS, WSP(float, WS_BC), WSP(bf16_t, WS_QH2), WSP(bf16_t, WS_KH2), WSP(bf16_t, WS_VT2)}; pg8::gemm_phase(F.lds, D, S_, P_, E_);
    }
    SEAM(12);
    if (IN(13)) S2FN<128, 256, true>(F, vblk, WSP(bf16_t, WS_QH2), WSP(bf16_t, WS_KH2), WSP(bf16_t, WS_VT2), WSP(bf16_t, WS_O2), WSP(float, WS_BC), 3088);
    SEAM(13);
    if (IN(14)) {
        pg8::Order S_; S_.init(M / 256, 4, F.G, vblk); PtrNormal P_{(const char*)HB, (const char*)WSP(bf16_t, WS_WMIX + WM_GLA_G), (size_t)256 * D * 2};
        EpiGate<256, 1024> E_{SS, WSP(bf16_t, WS_O2), WSP(bf16_t, WS_VT2), (LAS float*)(F.lds + 132096)}; pg8::gemm_phase(F.lds, D, S_, P_, E_);
    }
    SEAM(14);
    if (IN(15)) {
        pg8::Order S_; S_.init(M / 256, 4, F.G, vblk); PtrNormal P_{(const char*)WSP(bf16_t, WS_VT2), (const char*)WSP(bf16_t, WS_WMIX + WM_GLA_OUT), (size_t)256 * D * 2};
        EpiResid<false> E_{nullptr, HB, SS, 1.0f}; pg8::gemm_phase(F.lds, D, S_, P_, E_);
    }
    SEAM(15);
    if (IN(16)) FFN_IN(WS_WFFN_A + WF_IN, false);
    SEAM(16);
    if (IN(17)) FFN_OUT(WS_WFFN_A + WF_OUT, false, false);
    SEAM(17);
    if (IN(18)) final_phase(F, SS, F.in[17]);
#if defined(PROBE2) || defined(PROBE3)
    __syncthreads();
    if (vblk == 0 && F.tid == 0) { const unsigned long long cyc = ((unsigned long long)MISC[21] << 32) | MISC[20]; const unsigned long long t0 = __builtin_amdgcn_s_memtime(); while (__builtin_amdgcn_s_memtime() - t0 < 4ull * cyc) __builtin_amdgcn_s_sleep(16); }
#endif
#if defined(PROBE_PHASE)
    { const unsigned long long t_now = __builtin_amdgcn_s_memrealtime(); if (18 == PROBE_PHASE) t_probe = t_now - t_prev;
      if (blockIdx.x == 0 && F.tid == 0) { const unsigned long long t_end = t_now + (unsigned long long)PROBE_MULT * t_probe; while (__builtin_amdgcn_s_memrealtime() < t_end) __builtin_amdgcn_s_sleep(16); } }
#endif
#undef slack
#undef sgw
#undef IN
#undef SEAM
#undef FFN_IN
#undef FFN_OUT
}
}
#ifndef MK_MODE
#define MK_MODE 0
#endif
#if MK_MODE == 2
namespace dbg {
__global__ void adapt(const float* Hreal, const float* HMtmp, float* Hn) {
    const size_t i = (size_t)blockIdx.x * blockDim.x + threadIdx.x;
    if (i >= (size_t)nv::ROWS * nv::D) return;
    const int d = (int)(i % nv::D); const size_t row = i / nv::D; const int b = (int)(row / nv::TT), s = (int)(row % nv::TT);
    Hn[i] = s < nv::NMETA ? HMtmp[s * nv::D + d] : Hreal[((size_t)b * nv::SEQ + (s - nv::NMETA)) * nv::D + d];
}
}
#endif
extern "C" void kernel_launch(void* const* d_in, const int* in_sizes, int n_in, void* d_out, int out_size, void* d_ws, size_t ws_size, hipStream_t stream) {
    static int grid = 0;
    if (grid == 0) {
        if (n_in != 18 || out_size != mk::M * mk::D || ws_size < mk::WS_NEED) { fprintf(stderr, "kernel_launch: unexpected sizes n_in %d out %d ws %zu\n", n_in, out_size, ws_size); grid = -1; return; }
        int dev = 0, cus = 0, per_cu = 0;
        if (hipGetDevice(&dev) != hipSuccess || hipDeviceGetAttribute(&cus, hipDeviceAttributeMultiprocessorCount, dev) != hipSuccess) { grid = -1; return; }
        if (hipFuncSetAttribute((const void*)mk::fwd, hipFuncAttributeMaxDynamicSharedMemorySize, mk::LDS_BYTES) != hipSuccess) { fprintf(stderr, "kernel_launch: hipFuncSetAttribute failed\n"); grid = -1; return; }
        if (hipOccupancyMaxActiveBlocksPerMultiprocessor(&per_cu, (const void*)mk::fwd, mk::NTHREADS, mk::LDS_BYTES) != hipSuccess || per_cu < 1) { fprintf(stderr, "kernel_launch: occupancy query says %d\n", per_cu); per_cu = 1; }
        (void)hipGetLastError();
        grid = cus;
        if (grid != 256) fprintf(stderr, "kernel_launch: %d CUs (built for 256)\n", grid);
    }
    if (grid < 0) return;
    (void)hipMemsetAsync((char*)d_ws + mk::WS_CTL, 0, mk::CTL_ZERO_BYTES, stream);
    mk::Args a{};
    for (int i = 0; i < 18; ++i) a.in[i] = (const float*)d_in[i];
    a.out = (float*)d_out; a.ws = (unsigned char*)d_ws;
#if MK_MODE == 0
    a.ph_lo = 0; a.ph_hi = mk::N_PHASES;
    hipLaunchKernelGGL(mk::fwd, dim3(grid), dim3(mk::NTHREADS), mk::LDS_BYTES, stream, a);
#elif MK_MODE == 1
    for (int p = 0; p < mk::N_PHASES; ++p) { a.ph_lo = p; a.ph_hi = p + 1; hipLaunchKernelGGL(mk::fwd, dim3(grid), dim3(mk::NTHREADS), mk::LDS_BYTES, stream, a); }
#else
    for (int p = 0; p < MK_CUT; ++p) { a.ph_lo = p; a.ph_hi = p + 1; hipLaunchKernelGGL(mk::fwd, dim3(grid), dim3(mk::NTHREADS), mk::LDS_BYTES, stream, a); }
    {
        float* tmp = (float*)((char*)d_ws + 250 * mk::MiB);
        (void)hipMemcpyAsync(tmp, (char*)d_ws + mk::WS_META + mk::META_HM, 16 * 1024 * 4, hipMemcpyDeviceToDevice, stream);
        hipLaunchKernelGGL(dbg::adapt, dim3((unsigned)(((size_t)nv::ROWS * nv::D + 255) / 256)), dim3(256), 0, stream, (const float*)d_out, (const float*)tmp, (float*)d_ws);
        nv::forward(stream, d_in, (float*)d_out, (char*)d_ws, MK_STAGE);
    }
#endif
}
```

```cpp
#include <hip/hip_runtime.h>
#include <cstdint>
#include <cstdio>
#include <cmath>
#define MK_MODE 0
namespace mk {
#define LAS __attribute__((address_space(3)))
#define GAS __attribute__((address_space(1)))
typedef unsigned short bf16_t;
typedef short bf16x8 __attribute__((ext_vector_type(8)));
typedef short s16x4 __attribute__((ext_vector_type(4)));
typedef float f32x4 __attribute__((ext_vector_type(4)));
typedef float f32x2 __attribute__((ext_vector_type(2)));
typedef unsigned u32x4 __attribute__((ext_vector_type(4)));
typedef unsigned u32x2 __attribute__((ext_vector_type(2)));

constexpr int M = 16384, D = 1024, DFF = 2816, SEQ = 8192, NMETA = 16;
constexpr int NWAVES = 8, NTHREADS = 512;
constexpr size_t MiB = 1u << 20;
constexpr size_t WS_CTL = 0, CTL_ZERO_BYTES = 1 * MiB;
constexpr size_t CTL_OSS_RET = 256 * 1024, CTL_OSS_GLA = 512 * 1024, CTL_MOSS = 768 * 1024;
constexpr size_t WS_HB = 1 * MiB, WS_SS = 33 * MiB, WS_META = 34 * MiB, WS_WMIX = 35 * MiB;
constexpr size_t META_HM = 0, META_RAW = 64 * 1024, META_MO = 448 * 1024;
constexpr size_t WS_WFFN_A = 52 * MiB, WS_ACT = 69 * MiB, WS_WFFN_B = 157 * MiB, WS_WFFN_C = 244 * MiB;
constexpr size_t WS_QH = 52 * MiB, WS_KH = 84 * MiB, WS_VT = 116 * MiB, WS_O = 180 * MiB;
constexpr size_t WS_BC = 69 * MiB, WS_QH2 = 101 * MiB, WS_KH2 = 117 * MiB, WS_VT2 = 133 * MiB, WS_O2 = 174 * MiB;
constexpr size_t WS_NEED = 256 * MiB;
constexpr size_t WM_RET_IN = 0, WM_RET_OUT = 12 * MiB;
constexpr size_t WM_GLA_IN = 0, WM_GLA_G = 4 * MiB, WM_GLA_OUT = 6 * MiB, WM_GLA_Z = 8 * MiB;
constexpr size_t WF_IN = 0, WF_OUT = 11 * MiB;
constexpr int CW_BAR = 4096;

constexpr int LDS_BYTES = 163840;
constexpr int LDS_MISC = LDS_BYTES - 256;

__constant__ float L2G[4] = {-0.04580368961312478f, -0.02272007650008353f, -0.011315313227834133f, -0.005646563141142062f};
__constant__ float ROPE_INV[128] = {
  1.000000000e+00f, 9.300450087e-01f, 8.649836779e-01f, 8.044736385e-01f,
  7.481966019e-01f, 6.958565116e-01f, 6.471778154e-01f, 6.019044518e-01f,
  5.597981811e-01f, 5.206375122e-01f, 4.842162728e-01f, 4.503428936e-01f,
  4.188391268e-01f, 3.895392120e-01f, 3.622889817e-01f, 3.369450271e-01f,
  3.133740425e-01f, 2.914519310e-01f, 2.710633874e-01f, 2.521011233e-01f,
  2.344653904e-01f, 2.180633694e-01f, 2.028087080e-01f, 1.886212230e-01f,
  1.754262149e-01f, 1.631542742e-01f, 1.517407894e-01f, 1.411257535e-01f,
  1.312533021e-01f, 1.220714748e-01f, 1.135319397e-01f, 1.055898219e-01f,
  9.820328653e-02f, 9.133346379e-02f, 8.494423330e-02f, 7.900195569e-02f,
  7.347535342e-02f, 6.833537668e-02f, 6.355497986e-02f, 5.910899118e-02f,
  5.497401953e-02f, 5.112830922e-02f, 4.755162448e-02f, 4.422515258e-02f,
  4.113136977e-02f, 3.825402260e-02f, 3.557796404e-02f, 3.308910504e-02f,
  3.077435680e-02f, 2.862153389e-02f, 2.661931701e-02f, 2.475716174e-02f,
  2.302526683e-02f, 2.141453326e-02f, 1.991648041e-02f, 1.852322184e-02f,
  1.722742990e-02f, 1.602228358e-02f, 1.490144618e-02f, 1.385901403e-02f,
  1.288950257e-02f, 1.198781747e-02f, 1.114920899e-02f, 1.036926545e-02f,
  9.643883444e-03f, 8.969245479e-03f, 8.341802284e-03f, 7.758250926e-03f,
  7.215522230e-03f, 6.710760761e-03f, 6.241309457e-03f, 5.804697983e-03f,
  5.398627371e-03f, 5.020966288e-03f, 4.669724498e-03f, 4.343053792e-03f,
  4.039235413e-03f, 3.756670747e-03f, 3.493872471e-03f, 3.249458736e-03f,
  3.022142686e-03f, 2.810728736e-03f, 2.614103956e-03f, 2.431234345e-03f,
  2.261157380e-03f, 2.102978062e-03f, 1.955864020e-03f, 1.819041790e-03f,
  1.691789716e-03f, 1.573440502e-03f, 1.463370281e-03f, 1.361000235e-03f,
  1.265791478e-03f, 1.177242957e-03f, 1.094888896e-03f, 1.018295996e-03f,
  9.470609948e-04f, 8.808093844e-04f, 8.191923262e-04f, 7.618857198e-04f,
  7.085879333e-04f, 6.590186385e-04f, 6.129170069e-04f, 5.700403708e-04f,
  5.301629426e-04f, 4.930753494e-04f, 4.585822753e-04f, 4.265021416e-04f,
  3.966661752e-04f, 3.689173318e-04f, 3.431097430e-04f, 3.191074939e-04f,
  2.967843320e-04f, 2.760227653e-04f, 2.567135962e-04f, 2.387551940e-04f,
  2.220530587e-04f, 2.065193403e-04f, 1.920722716e-04f, 1.786358480e-04f,
  1.661392889e-04f, 1.545170089e-04f, 1.437077590e-04f, 1.336546848e-04f,
  1.243048755e-04f, 1.156091312e-04f, 1.075216787e-04f, 9.999999747e-05f,
};

#define LDS_WAIT() asm volatile("s_waitcnt lgkmcnt(0)" ::: "memory")
#define VM_WAIT() asm volatile("s_waitcnt vmcnt(0)" ::: "memory")
#define RLX_AGENT __ATOMIC_RELAXED, __HIP_MEMORY_SCOPE_AGENT

__device__ __forceinline__ unsigned cvt_pk_bf16(float lo, float hi) { unsigned r; asm volatile("v_cvt_pk_bf16_f32 %0, %1, %2" : "=v"(r) : "v"(lo), "v"(hi)); return r; }
__device__ __forceinline__ float bf_lo(unsigned w) { return __uint_as_float(w << 16); }
__device__ __forceinline__ float bf_hi(unsigned w) { return __uint_as_float(w & 0xffff0000u); }
__device__ __forceinline__ unsigned short f2bf(float f) { return (unsigned short)(cvt_pk_bf16(f, 0.f) & 0xffffu); }
__device__ __forceinline__ float fsilu(float v) { return v * __builtin_amdgcn_rcpf(1.0f + __expf(-v)); }
__device__ __forceinline__ float wave_sum(float v) {
#pragma unroll
    for (int o = 1; o < 64; o <<= 1) v += __shfl_xor(v, o);
    return v;
}
__device__ __forceinline__ float row_rstd(const float* SS, int row) {
    const f32x4* p = (const f32x4*)(SS + (size_t)row * 16);
    const f32x4 a = p[0], b = p[1], c = p[2], d = p[3];
    const float s = ((a.x + a.y) + (a.z + a.w)) + ((b.x + b.y) + (b.z + b.w)) + ((c.x + c.y) + (c.z + c.w)) + ((d.x + d.y) + (d.z + d.w));
    return 1.0f / sqrtf(s * (1.0f / 1024.0f) + 1e-6f);
}

#define XB_TMO      128
#define XB_XCNT(j)  (256  + 64 * (j))
#define XB_XSUB(j)  (1280 + 64 * (j))
#define XB_XGEN(j)  (2304 + 64 * (j))
#define XB_TOP      3328
#define XB_TOPGEN   3392
#define XCD_BAR_WORDS 3456
#define XB_SPIN_CAP (1u << 18)
__device__ __forceinline__ unsigned xb_ld(unsigned* p)              { return __hip_atomic_load(p, __ATOMIC_RELAXED, __HIP_MEMORY_SCOPE_AGENT); }
__device__ __forceinline__ unsigned xb_add(unsigned* p, unsigned v) { return __hip_atomic_fetch_add(p, v, __ATOMIC_RELAXED, __HIP_MEMORY_SCOPE_AGENT); }
__device__ __forceinline__ unsigned xb_xcc_id() { return (unsigned)__builtin_amdgcn_s_getreg((3 << 11) | 20) & 0xFu; }
#define XB_SPIN(cond, bar) do { unsigned _sp = 0; while (cond) { __builtin_amdgcn_s_sleep(1); \
    if ((++_sp & 255u) == 0u) { if (xb_ld(&(bar)[XB_TMO])) break; if (_sp > XB_SPIN_CAP) { atomicAdd(&(bar)[XB_TMO], 1u); break; } } } } while (0)
struct XcdBarrier { unsigned* bar; unsigned x; volatile LAS unsigned* st; };
__device__ __forceinline__ XcdBarrier xcd_barrier_post(unsigned* bar, volatile LAS unsigned* st) {
    XcdBarrier b; b.bar = bar; b.x = xb_xcc_id(); b.st = st;
    if (threadIdx.x == 0) { const unsigned rank = xb_add(&bar[XB_XCNT(b.x)], 1u); st[2] = rank; st[3] = b.x; }
    return b;
}
__device__ __forceinline__ void xcd_barrier_complete(unsigned* bar, unsigned x, unsigned& nloc, unsigned& nx) {
    const unsigned G = gridDim.x * gridDim.y * gridDim.z;
    unsigned sum, cnt, mine, sp = 0u;
    for (;;) {
        sum = 0u; cnt = 0u; mine = 0u;
#pragma unroll
        for (unsigned j = 0; j < 16; ++j) { const unsigned c = xb_ld(&bar[XB_XCNT(j)]); sum += c; cnt += (c > 0u) ? 1u : 0u; mine = (j == x) ? c : mine; }
        if (sum == G) break;
        __builtin_amdgcn_s_sleep(1);
        if ((++sp & 255u) == 0u) { if (xb_ld(&bar[XB_TMO])) break; if (sp > XB_SPIN_CAP) { atomicAdd(&bar[XB_TMO], 1u); break; } }
    }
    nloc = mine > 0u ? mine : 1u; nx = cnt > 0u ? cnt : 1u;
}
__device__ __forceinline__ void xcd_barrier(const XcdBarrier& b) {
    asm volatile("s_waitcnt vmcnt(0)" ::: "memory");
    __syncthreads();
    if (threadIdx.x == 0) {
        unsigned* bar = b.bar;
        __builtin_amdgcn_s_waitcnt(0);
        unsigned nloc = b.st[0], nx = b.st[1];
        if (nloc == 0u) { xcd_barrier_complete(bar, b.x, nloc, nx); b.st[0] = nloc; b.st[1] = nx; }
        const unsigned old = xb_add(&bar[XB_XSUB(b.x)], 1u);
        const unsigned gen = old / nloc;
        if (old + 1u == (gen + 1u) * nloc) {
            __builtin_amdgcn_fence(__ATOMIC_RELEASE, "agent");
            asm volatile("s_waitcnt vmcnt(0)" ::: "memory");
            const unsigned og = xb_add(&bar[XB_TOP], 1u);
            const unsigned tg = og / nx;
            if (og + 1u == (tg + 1u) * nx) xb_add(&bar[XB_TOPGEN], 1u);
            else XB_SPIN(xb_ld(&bar[XB_TOPGEN]) == tg, bar);
            __builtin_amdgcn_fence(__ATOMIC_ACQUIRE, "agent");
            xb_add(&bar[XB_XGEN(b.x)], 1u);
            asm volatile("s_waitcnt vmcnt(0)" ::: "memory");
        } else {
            XB_SPIN(xb_ld(&bar[XB_XGEN(b.x)]) == gen, bar);
            __builtin_amdgcn_fence(__ATOMIC_ACQUIRE, "agent");
            asm volatile("s_waitcnt vmcnt(0)" ::: "memory");
        }
    }
    __syncthreads();
}

namespace pg8 {
constexpr int BM = 256, BK = 64, HALF = 128, HTB = HALF * BK * 2, STAGE_BYTES = 8 * HTB, NXCD = 8, WGM = 8;
__host__ __device__ __forceinline__ int lds_byte(int r, int c) { const int st = (r >> 4) * 2 + (c >> 5), rr = r & 15, cc = c & 31, ob = rr * 64 + cc * 2; return st * 1024 + (ob ^ (((ob >> 9) & 1) << 5)); }
__host__ __device__ __forceinline__ void stage_rc(int b, int& R, int& C) { const int st = b / 1024, sb = b % 1024, swz = sb ^ (((sb >> 9) & 1) << 5); R = (st >> 1) * 16 + swz / 64; C = (st & 1) * 32 + (swz % 64) / 2; }
__host__ __device__ __forceinline__ int perm32(int rho) { const int n = rho >> 4, i = rho & 15; return 8 * (i >> 2) + 4 * n + (i & 3); }
struct Unit { int pm, pn; };
struct Order {
    int nM, nN, nwg, G, c;
    __device__ void init(int nM_, int nN_, int G_, int c_) { nM = nM_; nN = nN_; nwg = nM * nN; G = G_; c = c_; }
    __device__ bool next(int i, Unit& u) const {
        const long L = (long)i * G + c; if (L >= nwg) return false;
        int wgid = (int)L; { const int q = nwg / NXCD, r = nwg % NXCD, xcd = wgid % NXCD, off = wgid / NXCD; wgid = (xcd < r ? xcd * (q + 1) : r * (q + 1) + (xcd - r) * q) + off; }
        const int nig = WGM * nN, gid = wgid / nig, fm = gid * WGM, gsz = (nM - fm) < WGM ? (nM - fm) : WGM;
        u.pm = fm + ((wgid % nig) % gsz); u.pn = (wgid % nig) / gsz; return true;
    }
};
#if defined(PROBE4)
__device__ unsigned long long g_dummy_;
#endif
template <class Epi, class Ptr>
__device__ __forceinline__ void gemm_phase(LAS unsigned char* lds, const int K, const Order& S, const Ptr& P, const Epi& E) {
    const int tid = threadIdx.x, wid = __builtin_amdgcn_readfirstlane(tid >> 6), lane = tid & 63, wr = wid >> 2, wc = wid & 3, fr = lane & 15, fq = lane >> 4;
    const int nt = K / BK;
    unsigned voffA[2], voffB[2];
#pragma unroll
    for (int i = 0; i < 2; ++i) { int R, C; stage_rc(tid * 16 + i * 8192, R, C); const int Rb = (R & ~31) + perm32(R & 31);
        voffA[i] = (unsigned)(R * K + C) * 2u; voffB[i] = (unsigned)(Rb * K + C) * 2u; }
    const size_t kstep = (size_t)(BK * 2);
    const size_t hstep = (size_t)HALF * K * 2;
    const unsigned ldsw = (unsigned)wid * 1024u;
    const int aoff = lds_byte(wr * 64 + fr, fq * 8), boff = lds_byte(wc * 32 + fr, fq * 8);
#define PG8_SA(b, h) (((b) * 2 + (h)) * HTB)
#define PG8_SB(b, h) ((4 + (b) * 2 + (h)) * HTB)
#define PG8_STAGE(bufoff, gbase, voff) do { _Pragma("unroll") for (int _i = 0; _i < 2; ++_i) \
        __builtin_amdgcn_global_load_lds((const unsigned*)((const char*)(gbase) + (voff)[_i]), (LAS unsigned*)(lds + (bufoff) + ldsw + _i * 8192), 16, 0, 0); } while (0)
#define PG8_LDA(dst, b, h) do { _Pragma("unroll") for (int m = 0; m < 4; ++m) _Pragma("unroll") for (int k = 0; k < 2; ++k) dst[m][k] = *(const LAS bf16x8*)(lds + PG8_SA(b, h) + aoff + m * 2048 + k * 1024); } while (0)
#define PG8_LDB(dst, b, h) do { _Pragma("unroll") for (int n = 0; n < 2; ++n) _Pragma("unroll") for (int k = 0; k < 2; ++k) dst[n][k] = *(const LAS bf16x8*)(lds + PG8_SB(b, h) + boff + n * 2048 + k * 1024); } while (0)
#define PG8_MMA(ai, bj, At, Bt) do { __builtin_amdgcn_s_setprio(1); _Pragma("unroll") for (int m = 0; m < 4; ++m) _Pragma("unroll") for (int n = 0; n < 2; ++n) _Pragma("unroll") for (int k = 0; k < 2; ++k) \
        acc[ai][bj][m][n] = __builtin_amdgcn_mfma_f32_16x16x32_bf16(Bt[n][k], At[m][k], acc[ai][bj][m][n], 0, 0, 0); __builtin_amdgcn_s_setprio(0); } while (0)
#define PG8_WAIT_V(n) asm volatile("s_waitcnt vmcnt(" #n ")" ::: "memory")
#define PG8_WAIT_L(n) asm volatile("s_waitcnt lgkmcnt(" #n ")" ::: "memory")
#define PG8_BAR __builtin_amdgcn_s_barrier()
#define PG8_SCHED __builtin_amdgcn_sched_barrier(0)
#if defined(PROBE4)
    unsigned long long g_pacc = 0ull;
#endif
    Unit cur, nxt; int ui = 0;
    if (!S.next(0, cur)) return;
    f32x4 acc[2][2][4][2];
#pragma unroll
    for (int a = 0; a < 2; ++a)
#pragma unroll
        for (int b = 0; b < 2; ++b)
#pragma unroll
            for (int m = 0; m < 4; ++m)
#pragma unroll
                for (int n = 0; n < 2; ++n) acc[a][b][m][n] = (f32x4){0.f, 0.f, 0.f, 0.f};
    bf16x8 At[4][2], B0[2][2], B1[2][2];
    const char* cA; const char* cB; P.ptrs(cur, cA, cB);
    PG8_STAGE(PG8_SB(0, 0), cB, voffB); PG8_STAGE(PG8_SB(0, 1), cB + hstep, voffB); PG8_STAGE(PG8_SA(0, 0), cA, voffA); PG8_STAGE(PG8_SA(0, 1), cA + hstep, voffA);
    if (wr == 1) PG8_BAR;
    PG8_WAIT_V(2); PG8_BAR;
    PG8_STAGE(PG8_SB(1, 0), cB + kstep, voffB); PG8_STAGE(PG8_SA(1, 0), cA + kstep, voffA); PG8_STAGE(PG8_SB(1, 1), cB + hstep + kstep, voffB);
    PG8_WAIT_V(6); PG8_BAR;
    for (;;) {
        const bool has_next = S.next(ui + 1, nxt);
        const char* nA = cA; const char* nB = cB; if (has_next) P.ptrs(nxt, nA, nB);
        for (int t = 0; t < nt; t += 2) {
            const bool last = (t == nt - 2);
            const char* a1 = cA + (size_t)(t + 1) * kstep;
            const char* a2 = last ? nA : cA + (size_t)(t + 2) * kstep; const char* b2 = last ? nB : cB + (size_t)(t + 2) * kstep;
            const char* a3 = a2 + kstep; const char* b3 = b2 + kstep;
            PG8_LDB(B0, 0, 0); PG8_LDB(B1, 0, 1); PG8_SCHED; PG8_LDA(At, 0, 0); PG8_STAGE(PG8_SA(1, 1), a1 + hstep, voffA);
            PG8_WAIT_V(8); PG8_WAIT_L(0); PG8_BAR; PG8_MMA(0, 0, At, B0); PG8_MMA(0, 1, At, B1); PG8_BAR; PG8_SCHED;
            PG8_LDA(At, 0, 1); PG8_STAGE(PG8_SB(0, 0), b2, voffB); PG8_STAGE(PG8_SB(0, 1), b2 + hstep, voffB); PG8_STAGE(PG8_SA(0, 0), a2, voffA);
            PG8_WAIT_V(8); PG8_WAIT_L(0); PG8_BAR; PG8_MMA(1, 0, At, B0); PG8_MMA(1, 1, At, B1); PG8_BAR; PG8_SCHED;
            PG8_LDB(B0, 1, 0); PG8_LDB(B1, 1, 1); PG8_SCHED; PG8_LDA(At, 1, 0); PG8_STAGE(PG8_SA(0, 1), a2 + hstep, voffA);
            PG8_WAIT_V(8); PG8_WAIT_L(0); PG8_BAR; PG8_MMA(0, 0, At, B0); PG8_MMA(0, 1, At, B1); PG8_BAR; PG8_SCHED;
            PG8_LDA(At, 1, 1); PG8_STAGE(PG8_SB(1, 0), b3, voffB); PG8_STAGE(PG8_SB(1, 1), b3 + hstep, voffB); PG8_STAGE(PG8_SA(1, 0), a3, voffA);
            PG8_WAIT_V(8); PG8_WAIT_L(0); PG8_BAR; PG8_MMA(1, 0, At, B0); PG8_MMA(1, 1, At, B1); PG8_BAR; PG8_SCHED;
        }
        if (wr == 0) PG8_BAR;
#if defined(PROBE4)
        unsigned long long pe0_ = __builtin_amdgcn_s_memtime();
#endif
        E(acc, cur, wr, wc, fr, fq);
#if defined(PROBE4)
        if (PROBE4 == 1) { asm volatile("s_waitcnt vmcnt(0)" ::: "memory"); }
        g_pacc += __builtin_amdgcn_s_memtime() - pe0_;
#endif
        if (!has_next) break;
#pragma unroll
        for (int a = 0; a < 2; ++a)
#pragma unroll
            for (int b = 0; b < 2; ++b)
#pragma unroll
                for (int m = 0; m < 4; ++m)
#pragma unroll
                    for (int n = 0; n < 2; ++n) acc[a][b][m][n] = (f32x4){0.f, 0.f, 0.f, 0.f};
        cur = nxt; cA = nA; cB = nB; ++ui;
        if (wr == 1) PG8_BAR;
    }
    PG8_WAIT_V(0);
    PG8_BAR;
#if defined(PROBE4)
    if (blockIdx.x == 0 && tid == 0 && K == 1024 && S.nN == 22) { volatile LAS unsigned* MI = (volatile LAS unsigned*)(lds + LDS_MISC); const unsigned long long v = (((unsigned long long)MI[21] << 32) | MI[20]) + g_pacc; MI[20] = (unsigned)v; MI[21] = (unsigned)(v >> 32); }
#endif
#undef PG8_SA
#undef PG8_SB
#undef PG8_STAGE
#undef PG8_LDA
#undef PG8_LDB
#undef PG8_MMA
#undef PG8_WAIT_V
#undef PG8_WAIT_L
#undef PG8_BAR
#undef PG8_SCHED
}
}
struct Frame {
    LAS unsigned char* lds;
    int tid, lane, wave, vcu, G, vb;
    unsigned char* ws;
    const float* in[18];
    float* out;
};
#define WSP(T, off) ((T*)(F.ws + (off)))

__device__ __forceinline__ void conv_item(const float* W, int ldn, int srccol0, int k0, const float* gain, bf16_t* WT, int K, int dstrow0, LAS float* scr, int lane) {
    float v[32];
    const float* wp = W + (size_t)(k0 + (lane >> 5)) * ldn + srccol0 + (lane & 31);
#pragma unroll
    for (int i = 0; i < 32; ++i) v[i] = wp[(size_t)(2 * i) * ldn];
    const int c = lane & 7;
    float gn[8];
#pragma unroll
    for (int e = 0; e < 8; ++e) gn[e] = gain ? gain[k0 + 8 * c + e] : 1.0f;
#pragma unroll
    for (int i = 0; i < 32; ++i) scr[(2 * i + (lane >> 5)) * 33 + (lane & 31)] = v[i];
    LDS_WAIT(); asm volatile("" ::: "memory");
#pragma unroll
    for (int j = 0; j < 4; ++j) { const int n = (lane >> 3) + 8 * j; const LAS float* s = scr + (8 * c) * 33 + n;
        u32x4 o; o.x = cvt_pk_bf16(s[0 * 33] * gn[0], s[1 * 33] * gn[1]); o.y = cvt_pk_bf16(s[2 * 33] * gn[2], s[3 * 33] * gn[3]);
        o.z = cvt_pk_bf16(s[4 * 33] * gn[4], s[5 * 33] * gn[5]); o.w = cvt_pk_bf16(s[6 * 33] * gn[6], s[7 * 33] * gn[7]);
        *(u32x4*)(WT + (size_t)(dstrow0 + n) * K + k0 + 8 * c) = o; }
    LDS_WAIT(); asm volatile("" ::: "memory");
}
struct ConvJob { const float* W; int ldn, K, N, col0, kind; const float* gain; bf16_t* WT; };
__device__ __forceinline__ int conv_items(const ConvJob& J) { return (J.K / 64) * (J.N / 32); }
__device__ __forceinline__ void conv_run(const ConvJob& J, int item, LAS float* scr, int lane) {
    const int nblk = J.N / 32, kb = item / nblk, nb = item % nblk; const int n0 = 32 * nb;
    int src;
    if (J.kind == 0) src = J.col0 + n0; else { const int u = n0 >> 8, j = n0 & 255; src = (j < 128) ? u * 128 + j : 2816 + u * 128 + (j - 128); }
    conv_item(J.W, J.ldn, src, 64 * kb, J.gain, J.WT, J.K, n0, scr, lane);
}
__device__ __forceinline__ int conv_job(Frame& F, const ConvJob& J, int base, int gw, int ngw) {
    LAS float* scr = (LAS float*)(F.lds + F.wave * 16384);
    const int n = conv_items(J);
    const int first = (gw - base % ngw + ngw) % ngw;
    for (int it = first; it < n; it += ngw) conv_run(J, it, scr, F.lane);
    return base + n;
}
__device__ __forceinline__ ConvJob job_ffn_in(Frame& F, int layer, int which  , size_t dst) {
    ConvJob J; J.W = F.in[which ? 7 : 3] + (size_t)layer * D * 2 * DFF; J.ldn = 2 * DFF; J.K = D; J.N = 2 * DFF; J.col0 = 0; J.kind = 1; J.gain = F.in[which ? 6 : 2] + layer * D; J.WT = WSP(bf16_t, dst); return J; }
__device__ __forceinline__ ConvJob job_ffn_out(Frame& F, int layer, int which, size_t dst) {
    ConvJob J; J.W = F.in[which ? 8 : 4] + (size_t)layer * DFF * D; J.ldn = D; J.K = DFF; J.N = D; J.col0 = 0; J.kind = 0; J.gain = nullptr; J.WT = WSP(bf16_t, dst); return J; }

__device__ __forceinline__ f32x2 pk_silu_mul(f32x2 g, f32x2 u, float c1, float rs2) {
    const f32x2 t = g * c1; f32x2 e; e.x = __builtin_amdgcn_exp2f(t.x); e.y = __builtin_amdgcn_exp2f(t.y);
    const f32x2 d = e + 1.0f; f32x2 r; r.x = __builtin_amdgcn_rcpf(d.x); r.y = __builtin_amdgcn_rcpf(d.y);
    return (g * u) * (r * rs2);
}
#define ROWS8_RSTD(SSp, rowbase, rsv) do { const float a_ = row_rstd(SSp, (rowbase) + fq * 16), b_ = row_rstd(SSp, (rowbase) + 128 + fq * 16); \
        _Pragma("unroll") for (int k_ = 0; k_ < 8; ++k_) rsv[k_] = __shfl(k_ < 4 ? a_ : b_, fr + 16 * (k_ & 3)); } while (0)

struct EpiSwiglu {
    const float* SS; bf16_t* ACT;
    __device__ __forceinline__ void operator()(const f32x4 (&acc)[2][2][4][2], const pg8::Unit& u, int wr, int wc, int fr, int fq) const {
        float rsv[8]; ROWS8_RSTD(SS, u.pm * 256 + wr * 64 + fr, rsv);
#pragma unroll
        for (int ai = 0; ai < 2; ++ai)
#pragma unroll
            for (int m = 0; m < 4; ++m) {
                const int row = u.pm * 256 + ai * 128 + wr * 64 + m * 16 + fr; const float rs = rsv[ai * 4 + m], c1 = rs * -1.4426950408889634f, rs2 = rs * rs;
                f32x2 v[4];
#pragma unroll
                for (int n = 0; n < 2; ++n) { const f32x4 g = acc[ai][0][m][n], up = acc[ai][1][m][n];
                    v[2 * n] = pk_silu_mul((f32x2){g[0], g[1]}, (f32x2){up[0], up[1]}, c1, rs2); v[2 * n + 1] = pk_silu_mul((f32x2){g[2], g[3]}, (f32x2){up[2], up[3]}, c1, rs2); }
                u32x4 w; w.x = cvt_pk_bf16(v[0].x, v[0].y); w.y = cvt_pk_bf16(v[1].x, v[1].y); w.z = cvt_pk_bf16(v[2].x, v[2].y); w.w = cvt_pk_bf16(v[3].x, v[3].y);
                *(u32x4*)(ACT + (size_t)row * DFF + u.pn * 128 + wc * 32 + 8 * fq) = w;
            }
    }
};
template <bool BASE_F32> struct EpiResid {
    const float* xbase; bf16_t* HB; float* SS; float alpha;
    __device__ __forceinline__ void operator()(const f32x4 (&acc)[2][2][4][2], const pg8::Unit& u, int wr, int wc, int fr, int fq) const {
#pragma unroll
        for (int ai = 0; ai < 2; ++ai)
#pragma unroll
            for (int m = 0; m < 4; ++m) {
                const int row = u.pm * 256 + ai * 128 + wr * 64 + m * 16 + fr; float ss = 0.f;
#pragma unroll
                for (int bj = 0; bj < 2; ++bj) {
                    const size_t off = (size_t)row * D + u.pn * 256 + bj * 128 + wc * 32 + 8 * fq;
                    f32x4 b0, b1;
                    if (BASE_F32) { b0 = *(const f32x4*)(xbase + off); b1 = *(const f32x4*)(xbase + off + 4); }
                    else { const u32x4 hv = *(const u32x4*)(HB + off); b0 = (f32x4){bf_lo(hv.x), bf_hi(hv.x), bf_lo(hv.y), bf_hi(hv.y)}; b1 = (f32x4){bf_lo(hv.z), bf_hi(hv.z), bf_lo(hv.w), bf_hi(hv.w)}; }
                    const f32x4 v0 = b0 + acc[ai][bj][m][0] * alpha, v1 = b1 + acc[ai][bj][m][1] * alpha;
                    u32x4 w; w.x = cvt_pk_bf16(v0[0], v0[1]); w.y = cvt_pk_bf16(v0[2], v0[3]); w.z = cvt_pk_bf16(v1[0], v1[1]); w.w = cvt_pk_bf16(v1[2], v1[3]);
                    *(u32x4*)(HB + off) = w;
                    ss += (v0[0] * v0[0] + v0[1] * v0[1]) + (v0[2] * v0[2] + v0[3] * v0[3]) + (v1[0] * v1[0] + v1[1] * v1[1]) + (v1[2] * v1[2] + v1[3] * v1[3]);
                }
                ss += __shfl_xor(ss, 16); ss += __shfl_xor(ss, 32);
                if (fq == 0) SS[(size_t)row * 16 + u.pn * 4 + wc] = ss;
            }
    }
};
struct EpiRetIn {
    const float* SS; bf16_t* QH; bf16_t* KH; bf16_t* VT;
    __device__ __forceinline__ void operator()(const f32x4 (&acc)[2][2][4][2], const pg8::Unit& u, int wr, int wc, int fr, int fq) const {
        if (u.pn < 8) {
            const bool isq = u.pn < 4; const int head = u.pn & 3; bf16_t* dst = isq ? QH : KH;
            const float l2g = isq ? L2G[head] : -L2G[head], sc = isq ? 1.0f : 0.0625f;
            float inv[8];
#pragma unroll
            for (int e = 0; e < 8; ++e) inv[e] = ROPE_INV[wc * 32 + 8 * fq + e];
#pragma unroll
            for (int ai = 0; ai < 2; ++ai)
#pragma unroll
                for (int m = 0; m < 4; ++m) {
                    const int row = u.pm * 256 + ai * 128 + wr * 64 + m * 16 + fr; const float rs = row_rstd(SS, row);
                    const int b = row >> 13, t = row & 8191; const float pos = (float)(t + NMETA);
                    const float dec = __builtin_amdgcn_exp2f((float)((t & 31) + 1) * l2g) * sc * rs;
                    float o1[8], o2[8];
#pragma unroll
                    for (int n = 0; n < 2; ++n)
#pragma unroll
                        for (int j = 0; j < 4; ++j) { const int e = 4 * n + j;
                            const float rev = (pos * inv[e]) * 0.15915494309189535f; const float frc = rev - floorf(rev);
                            const float sn = __builtin_amdgcn_sinf(frc), cs = __builtin_amdgcn_cosf(frc);
                            const float t1 = acc[ai][0][m][n][j], t2 = acc[ai][1][m][n][j];
                            o1[e] = (t1 * cs - t2 * sn) * dec; o2[e] = (t1 * sn + t2 * cs) * dec; }
                    bf16_t* p = dst + ((size_t)(b * 4 + head) * SEQ + t) * 256 + wc * 32 + 8 * fq;
                    u32x4 w; w.x = cvt_pk_bf16(o1[0], o1[1]); w.y = cvt_pk_bf16(o1[2], o1[3]); w.z = cvt_pk_bf16(o1[4], o1[5]); w.w = cvt_pk_bf16(o1[6], o1[7]);
                    *(u32x4*)p = w;
                    w.x = cvt_pk_bf16(o2[0], o2[1]); w.y = cvt_pk_bf16(o2[2], o2[3]); w.z = cvt_pk_bf16(o2[4], o2[5]); w.w = cvt_pk_bf16(o2[6], o2[7]);
                    *(u32x4*)(p + 128) = w;
                }
        } else {
            float rs[2][8];
#pragma unroll
            for (int bj = 0; bj < 2; ++bj)
#pragma unroll
                for (int e = 0; e < 8; ++e) rs[bj][e] = row_rstd(SS, u.pm * 256 + bj * 128 + wc * 32 + 8 * fq + e);
            const int b = u.pm >> 5, t0 = (u.pm & 31) * 256;
#pragma unroll
            for (int ai = 0; ai < 2; ++ai)
#pragma unroll
                for (int m = 0; m < 4; ++m) {
                    const int vc = (u.pn - 8) * 256 + ai * 128 + wr * 64 + m * 16 + fr; const int head = vc >> 9, dvi = vc & 511;
                    bf16_t* p = VT + ((size_t)(b * 4 + head) * 512 + dvi) * SEQ + t0 + wc * 32 + 8 * fq;
#pragma unroll
                    for (int bj = 0; bj < 2; ++bj) {
                        const f32x4 v0 = acc[ai][bj][m][0], v1 = acc[ai][bj][m][1];
                        u32x4 w; w.x = cvt_pk_bf16(v0[0] * rs[bj][0], v0[1] * rs[bj][1]); w.y = cvt_pk_bf16(v0[2] * rs[bj][2], v0[3] * rs[bj][3]);
                        w.z = cvt_pk_bf16(v1[0] * rs[bj][4], v1[1] * rs[bj][5]); w.w = cvt_pk_bf16(v1[2] * rs[bj][6], v1[3] * rs[bj][7]);
                        *(u32x4*)(p + bj * 128) = w;
                    }
                }
        }
    }
};
template <int DV, int LDO> struct EpiGate {
    const float* SS; const bf16_t* O; bf16_t* Y; LAS float* RO;
    __device__ __forceinline__ void operator()(const f32x4 (&acc)[2][2][4][2], const pg8::Unit& u, int wr, int wc, int fr, int fq) const {
        const int wid = wr * 4 + wc, lane = fq * 16 + fr; const int head = (u.pn * 256) / DV;
        {   const bf16_t* ob = O + (size_t)(u.pm * 256 + wid * 32) * LDO + head * DV;
#pragma unroll
            for (int i0 = 0; i0 < 32; i0 += 8) { float sv[8];
#pragma unroll
                for (int i = 0; i < 8; ++i) { float s;
                    if (DV == 512) { const u32x4 v = *(const u32x4*)(ob + (size_t)(i0 + i) * LDO + lane * 8);
                        const float a0 = bf_lo(v.x), a1 = bf_hi(v.x), a2 = bf_lo(v.y), a3 = bf_hi(v.y), a4 = bf_lo(v.z), a5 = bf_hi(v.z), a6 = bf_lo(v.w), a7 = bf_hi(v.w);
                        s = ((a0 * a0 + a1 * a1) + (a2 * a2 + a3 * a3)) + ((a4 * a4 + a5 * a5) + (a6 * a6 + a7 * a7)); }
                    else { const u32x2 v = *(const u32x2*)(ob + (size_t)(i0 + i) * LDO + lane * 4);
                        const float a0 = bf_lo(v.x), a1 = bf_hi(v.x), a2 = bf_lo(v.y), a3 = bf_hi(v.y); s = (a0 * a0 + a1 * a1) + (a2 * a2 + a3 * a3); }
                    sv[i] = s; }
#pragma unroll
                for (int i = 0; i < 8; ++i) { const float t = wave_sum(sv[i]); if (lane == 0) RO[wid * 32 + i0 + i] = 1.0f / sqrtf(t * (1.0f / (float)DV) + 1e-6f); } }
            LDS_WAIT(); __builtin_amdgcn_s_barrier(); asm volatile("" ::: "memory"); }
        float rsv[8]; ROWS8_RSTD(SS, u.pm * 256 + wr * 64 + fr, rsv);
#pragma unroll
        for (int ai = 0; ai < 2; ++ai)
#pragma unroll
            for (int m = 0; m < 4; ++m) {
                const int rl = ai * 128 + wr * 64 + m * 16 + fr, row = u.pm * 256 + rl; const float rs = rsv[ai * 4 + m]; const float ro = RO[rl]; const float c1 = rs * -1.4426950408889634f, rs2 = rs * ro;
#pragma unroll
                for (int bj = 0; bj < 2; ++bj) {
                    const int col = u.pn * 256 + bj * 128 + wc * 32 + 8 * fq;
                    const u32x4 ov = *(const u32x4*)(O + (size_t)row * LDO + col);
                    const f32x4 g0 = acc[ai][bj][m][0], g1 = acc[ai][bj][m][1];
                    const f32x2 y0 = pk_silu_mul((f32x2){g0[0], g0[1]}, (f32x2){bf_lo(ov.x), bf_hi(ov.x)}, c1, rs2), y1 = pk_silu_mul((f32x2){g0[2], g0[3]}, (f32x2){bf_lo(ov.y), bf_hi(ov.y)}, c1, rs2);
                    const f32x2 y2 = pk_silu_mul((f32x2){g1[0], g1[1]}, (f32x2){bf_lo(ov.z), bf_hi(ov.z)}, c1, rs2), y3 = pk_silu_mul((f32x2){g1[2], g1[3]}, (f32x2){bf_lo(ov.w), bf_hi(ov.w)}, c1, rs2);
                    u32x4 w; w.x = cvt_pk_bf16(y0.x, y0.y); w.y = cvt_pk_bf16(y1.x, y1.y); w.z = cvt_pk_bf16(y2.x, y2.y); w.w = cvt_pk_bf16(y3.x, y3.y);
                    *(u32x4*)(Y + (size_t)row * LDO + col) = w;
                }
            }
        asm volatile("" ::: "memory"); __builtin_amdgcn_s_barrier(); asm volatile("" ::: "memory");
    }
};
struct EpiGlaIn {
    const float* SS; const float* BC; bf16_t* QH; bf16_t* KH; bf16_t* VT;
    __device__ __forceinline__ void operator()(const f32x4 (&acc)[2][2][4][2], const pg8::Unit& u, int wr, int wc, int fr, int fq) const {
        if (u.pn < 4) {
            const bool isq = u.pn < 2; bf16_t* dst = isq ? QH : KH;
#pragma unroll
            for (int ai = 0; ai < 2; ++ai)
#pragma unroll
                for (int m = 0; m < 4; ++m) {
                    const int row = u.pm * 256 + ai * 128 + wr * 64 + m * 16 + fr; const float rs = row_rstd(SS, row) * (isq ? 0.08838834764831845f : 1.0f);
                    const int b = row >> 13, t = row & 8191;
#pragma unroll
                    for (int bj = 0; bj < 2; ++bj) {
                        const int cq = (u.pn & 1) * 256 + bj * 128 + wc * 32 + 8 * fq; const int head = cq >> 7, d = cq & 127;
                        const f32x4 c0 = *(const f32x4*)(BC + (size_t)row * 512 + cq), c1 = *(const f32x4*)(BC + (size_t)row * 512 + cq + 4);
                        float v[8];
#pragma unroll
                        for (int j = 0; j < 4; ++j) { v[j] = acc[ai][bj][m][0][j] * rs * __expf(isq ? c0[j] : -c0[j]); v[4 + j] = acc[ai][bj][m][1][j] * rs * __expf(isq ? c1[j] : -c1[j]); }
                        u32x4 w; w.x = cvt_pk_bf16(v[0], v[1]); w.y = cvt_pk_bf16(v[2], v[3]); w.z = cvt_pk_bf16(v[4], v[5]); w.w = cvt_pk_bf16(v[6], v[7]);
                        *(u32x4*)(dst + ((size_t)(b * 4 + head) * SEQ + t) * 128 + d) = w;
                    }
                }
        } else {
            float rs[2][8];
#pragma unroll
            for (int bj = 0; bj < 2; ++bj)
#pragma unroll
                for (int e = 0; e < 8; ++e) rs[bj][e] = row_rstd(SS, u.pm * 256 + bj * 128 + wc * 32 + 8 * fq + e);
            const int b = u.pm >> 5, t0 = (u.pm & 31) * 256; const int head = u.pn - 4;
#pragma unroll
            for (int ai = 0; ai < 2; ++ai)
#pragma unroll
                for (int m = 0; m < 4; ++m) {
                    const int dvi = ai * 128 + wr * 64 + m * 16 + fr;
                    bf16_t* p = VT + ((size_t)(b * 4 + head) * 256 + dvi) * SEQ + t0 + wc * 32 + 8 * fq;
#pragma unroll
                    for (int bj = 0; bj < 2; ++bj) {
                        const f32x4 v0 = acc[ai][bj][m][0], v1 = acc[ai][bj][m][1];
                        u32x4 w; w.x = cvt_pk_bf16(v0[0] * rs[bj][0], v0[1] * rs[bj][1]); w.y = cvt_pk_bf16(v0[2] * rs[bj][2], v0[3] * rs[bj][3]);
                        w.z = cvt_pk_bf16(v1[0] * rs[bj][4], v1[1] * rs[bj][5]); w.w = cvt_pk_bf16(v1[2] * rs[bj][6], v1[3] * rs[bj][7]);
                        *(u32x4*)(p + bj * 128) = w;
                    }
                }
        }
    }
};
struct PtrNormal { const char* A; const char* B; size_t tstep;
    __device__ __forceinline__ void ptrs(const pg8::Unit& u, const char*& cA, const char*& cB) const { cA = A + (size_t)u.pm * tstep; cB = B + (size_t)u.pn * tstep; } };
struct PtrSwapFrom { const char* A; const char* B; size_t tstep; int pn_swap;
    __device__ __forceinline__ void ptrs(const pg8::Unit& u, const char*& cA, const char*& cB) const {
        const char* a = A + (size_t)u.pm * tstep; const char* b = B + (size_t)u.pn * tstep;
        if (u.pn >= pn_swap) { cA = b; cB = a; } else { cA = a; cB = b; } } };

constexpr int MA_RS_OFF = 98304, MA_RED_OFF = 100352;
template <int MODE> __device__ __forceinline__ void meta_tiles(Frame& F, const bf16_t* Bt, int N, int K, float* out, int ldo, float alpha, int b0, int nb) {
    const int lane = F.lane, g = lane >> 4, r16 = lane & 15, pitch = K + 8;
    const LAS bf16_t* A = (const LAS bf16_t*)F.lds; const LAS float* rsA = (const LAS float*)(F.lds + MA_RS_OFF); LAS f32x4* red = (LAS f32x4*)(F.lds + MA_RED_OFF);
    const int ksteps = K / 32, per = ksteps / 8;
    for (int tile = F.vb - b0; tile < N / 16; tile += nb) {
        f32x4 acc = (f32x4){0.f, 0.f, 0.f, 0.f};
        const bf16_t* bp = Bt + (size_t)(tile * 16 + r16) * K + 8 * g;
        for (int ks = F.wave * per; ks < (F.wave + 1) * per; ++ks) {
            const bf16x8 a = *(const LAS bf16x8*)(A + r16 * pitch + ks * 32 + 8 * g);
            const bf16x8 b = *(const bf16x8*)(bp + ks * 32);
            acc = __builtin_amdgcn_mfma_f32_16x16x32_bf16(a, b, acc, 0, 0, 0);
        }
        red[F.wave * 64 + lane] = acc;
        __syncthreads();
        if (F.wave == 0) {
            f32x4 s = red[lane];
#pragma unroll
            for (int w = 1; w < 8; ++w) s += red[w * 64 + lane];
#pragma unroll
            for (int j = 0; j < 4; ++j) { const int r = 4 * g + j; float* o = out + (size_t)r * ldo + tile * 16 + r16;
                if (MODE == 0) *o = s[j] * rsA[r]; else *o = *o + alpha * s[j]; }
        }
        __syncthreads();
    }
}
__device__ __forceinline__ bool meta_has_tiles(Frame& F, int N, int b0, int nb) { const int r = F.vb - b0; return r >= 0 && r < nb && r < N / 16; }
__device__ __forceinline__ void meta_prep_h(Frame& F) {
    const float* HM = WSP(float, WS_META + META_HM); LAS bf16_t* A = (LAS bf16_t*)F.lds; LAS float* rsA = (LAS float*)(F.lds + MA_RS_OFF);
    for (int r = F.wave; r < 16; r += 8) { float s = 0.f;
        for (int k = F.lane; k < D; k += 64) { const float v = HM[r * D + k]; s += v * v; A[r * (D + 8) + k] = f2bf(v); }
        s = wave_sum(s); if (F.lane == 0) rsA[r] = 1.0f / sqrtf(s * (1.0f / 1024.0f) + 1e-6f); }
    __syncthreads();
}
__device__ __forceinline__ void meta_prep_act(Frame& F) {
    const float* RAW = WSP(float, WS_META + META_RAW); LAS bf16_t* A = (LAS bf16_t*)F.lds; LAS float* rsA = (LAS float*)(F.lds + MA_RS_OFF);
    for (int i = F.tid; i < 16 * DFF; i += NTHREADS) { const int r = i / DFF, k = i % DFF, u = k >> 7, j = k & 127;
        const float g = RAW[r * 5632 + u * 256 + j], up = RAW[r * 5632 + u * 256 + 128 + j]; A[r * (DFF + 8) + k] = f2bf(fsilu(g) * up); }
    if (F.tid < 16) rsA[F.tid] = 1.f;
    __syncthreads();
}
__device__ __forceinline__ void meta_prep_y(Frame& F) {
    const float* RAW = WSP(float, WS_META + META_RAW); const float* MO = WSP(float, WS_META + META_MO);
    LAS bf16_t* A = (LAS bf16_t*)F.lds; LAS float* rsA = (LAS float*)(F.lds + MA_RS_OFF); LAS float* mro = (LAS float*)(F.lds + MA_RED_OFF);
    for (int p = F.wave; p < 64; p += 8) { const int r = p >> 2, head = p & 3; float sacc = 0.f;
        for (int k = F.lane; k < 512; k += 64) { const float v = MO[r * 2048 + head * 512 + k]; sacc += v * v; }
        sacc = wave_sum(sacc); if (F.lane == 0) mro[p] = 1.0f / sqrtf(sacc * (1.0f / 512.0f) + 1e-6f); }
    __syncthreads();
    for (int i = F.tid; i < 16 * 2048; i += NTHREADS) { const int r = i >> 11, k = i & 2047, head = k >> 9;
        A[r * (2048 + 8) + k] = f2bf(MO[r * 2048 + k] * mro[r * 4 + head] * fsilu(RAW[r * 6144 + 4096 + k])); }
    if (F.tid < 16) rsA[F.tid] = 1.f;
    __syncthreads();
}

__device__ __forceinline__ void meta_tiles_ksplit(Frame& F, const bf16_t* Bt, int K, int KQ, float* out, float alpha) {
    const int lane = F.lane, g = lane >> 4, r16 = lane & 15, pitch = KQ + 8;
    const LAS bf16_t* A = (const LAS bf16_t*)F.lds; LAS f32x4* red = (LAS f32x4*)(F.lds + MA_RED_OFF);
    const int item = F.vb; if (item >= 256) return;
    const int tile = item >> 2, kq = item & 3, nks = KQ / 32;
    f32x4 acc = (f32x4){0.f, 0.f, 0.f, 0.f};
    const bf16_t* bp = Bt + (size_t)(tile * 16 + r16) * K + kq * KQ + 8 * g;
    for (int ks = F.wave; ks < nks; ks += 8) {
        const bf16x8 a = *(const LAS bf16x8*)(A + r16 * pitch + ks * 32 + 8 * g);
        const bf16x8 b = *(const bf16x8*)(bp + ks * 32);
        acc = __builtin_amdgcn_mfma_f32_16x16x32_bf16(a, b, acc, 0, 0, 0);
    }
    red[F.wave * 64 + lane] = acc;
    __syncthreads();
    if (F.wave == 0) { f32x4 sacc = red[lane];
#pragma unroll
        for (int w = 1; w < 8; ++w) sacc += red[w * 64 + lane];
#pragma unroll
        for (int j = 0; j < 4; ++j) atomicAdd(out + (size_t)(4 * g + j) * D + tile * 16 + r16, alpha * sacc[j]); }
    __syncthreads();
}
__device__ __forceinline__ void meta_prep_act_q(Frame& F) {
    const float* RAW = WSP(float, WS_META + META_RAW); LAS bf16_t* A = (LAS bf16_t*)F.lds; const int kq = F.vb & 3;
    for (int i = F.tid; i < 16 * 704; i += NTHREADS) { const int r = i / 704, kk = i % 704, k = kq * 704 + kk, u = k >> 7, j = k & 127;
        const float gt = RAW[r * 5632 + u * 256 + j], up = RAW[r * 5632 + u * 256 + 128 + j]; A[r * (704 + 8) + kk] = f2bf(fsilu(gt) * up); }
    __syncthreads();
}
__device__ __forceinline__ void meta_prep_y_q(Frame& F) {
    const float* RAW = WSP(float, WS_META + META_RAW); const float* MO = WSP(float, WS_META + META_MO);
    LAS bf16_t* A = (LAS bf16_t*)F.lds; LAS float* mro = (LAS float*)(F.lds + MA_RED_OFF); const int head = F.vb & 3;
    for (int r = F.wave; r < 16; r += 8) { float sacc = 0.f;
        for (int k = F.lane; k < 512; k += 64) { const float v = MO[r * 2048 + head * 512 + k]; sacc += v * v; }
        sacc = wave_sum(sacc); if (F.lane == 0) mro[r] = 1.0f / sqrtf(sacc * (1.0f / 512.0f) + 1e-6f); }
    __syncthreads();
    for (int i = F.tid; i < 16 * 512; i += NTHREADS) { const int r = i >> 9, kk = i & 511, k = head * 512 + kk;
        A[r * (512 + 8) + kk] = f2bf(MO[r * 2048 + k] * mro[r] * fsilu(RAW[r * 6144 + 4096 + k])); }
    __syncthreads();
}
__device__ __forceinline__ void z_phase(Frame& F, const bf16_t* HB, const float* SS, const bf16_t* WZ, const float* wg, const float* bg, float* BC) {
    LAS float* zpart = (LAS float*)F.lds;
    LAS float* zs = (LAS float*)(F.lds + 8192);
    const int lane = F.lane, g = lane >> 4, r16 = lane & 15;
    for (int cidx = blockIdx.x; cidx < M / 64; cidx += F.G) {
        const int row0 = cidx * 64;
        { const int tile = F.wave & 3, kh = F.wave >> 2; f32x4 acc = (f32x4){0.f, 0.f, 0.f, 0.f};
          const bf16_t* ap = HB + (size_t)(row0 + tile * 16 + r16) * D + 8 * g; const bf16_t* bp = WZ + (size_t)r16 * D + 8 * g;
#pragma unroll
          for (int ks = kh * 16; ks < kh * 16 + 16; ++ks) {
              const bf16x8 a = *(const bf16x8*)(ap + ks * 32), b = *(const bf16x8*)(bp + ks * 32);
              acc = __builtin_amdgcn_mfma_f32_16x16x32_bf16(a, b, acc, 0, 0, 0);
          }
#pragma unroll
          for (int j = 0; j < 4; ++j) zpart[(kh * 64 + tile * 16 + 4 * g + j) * 16 + r16] = acc[j]; }
        __syncthreads();
        for (int i = F.tid; i < 64 * 16; i += NTHREADS) { const int t = i >> 4; zs[i] = (zpart[i] + zpart[1024 + i]) * row_rstd(SS, row0 + t); }
        __syncthreads();
        { const int c = F.tid; float w[16];
#pragma unroll
          for (int r = 0; r < 16; ++r) w[r] = wg[r * 512 + c];
          const float bias = bg[c]; float cum = 0.f;
          for (int t = 0; t < 64; ++t) { float a = bias; if (t == 32) cum = 0.f;
#pragma unroll
              for (int r = 0; r < 16; ++r) a += zs[t * 16 + r] * w[r];
              const float ls = fminf(a, 0.f) - __logf(1.0f + __expf(-fabsf(a)));
              cum += ls * 0.0625f; BC[(size_t)(row0 + t) * 512 + c] = cum; } }
        __syncthreads();
    }
}

typedef short v4i16_t __attribute__((ext_vector_type(4)));
__device__ __forceinline__ s16x4 ds_tr_asm(unsigned addr) { s16x4 r; asm volatile("ds_read_b64_tr_b16 %0, %1" : "=v"(r) : "v"(addr) : "memory"); return r; }
__device__ __forceinline__ s16x4 ds_tr(const LAS unsigned char* p) { return __builtin_bit_cast(s16x4, __builtin_amdgcn_ds_read_tr16_b64_v4i16((LAS v4i16_t*)p)); }
template <int DK, int DV, bool GLA>
__device__ __forceinline__ void s2_phase(Frame& F, const bf16_t* QH, const bf16_t* KH, const bf16_t* VT, bf16_t* O, float* OSS, const float* BC, int ldraw) {
    constexpr int NS = DV / 16, ROWB = DK * 2, TILEB = 64 * ROWB, NI = TILEB / 1024 / 8, NT = DK / 128, LDO = 4 * DV;
    constexpr int LQ = 0, LK = 2 * TILEB, LV = 4 * TILEB, LP = LV + 4096, LS = LP + 8192, LDEC = LS + 2 * 16 * ROWB;
    static_assert(LDEC + 2 * DK * 4 <= LDS_MISC, "S2 LDS map");
    const int unit = blockIdx.x; if (unit >= 8 * NS) return;
    const int bh = unit & 7, s = unit >> 3, b = bh >> 2, h = bh & 3;
    const int lane = F.lane, g = lane >> 4, r16 = lane & 15, w = F.wave;
    LAS unsigned char* L = F.lds; const unsigned Lb = (unsigned)(uintptr_t)L;
    const float* RAW = WSP(float, WS_META + META_RAW);
    for (int i = F.tid * 16; i < TILEB; i += NTHREADS * 16) { *(LAS u32x4*)(L + LQ + i) = (u32x4){0, 0, 0, 0}; *(LAS u32x4*)(L + LK + i) = (u32x4){0, 0, 0, 0}; }
    for (int i = F.tid * 16; i < 2048; i += NTHREADS * 16) *(LAS u32x4*)(L + LV + i) = (u32x4){0, 0, 0, 0};
    for (int i = F.tid * 16; i < 16 * ROWB; i += NTHREADS * 16) *(LAS u32x4*)(L + LS + i) = (u32x4){0, 0, 0, 0};
    __syncthreads();
    if (!GLA) {
        for (int idx = F.tid; idx < 16 * 128; idx += NTHREADS) { const int j = idx >> 7, c = idx & 127, row = 48 + j;
            const float* rq = RAW + (size_t)j * ldraw + h * 256; const float* rk = rq + 1024;
            const float rev = ((float)j * ROPE_INV[c]) * 0.15915494309189535f; const float frc = rev - floorf(rev);
            const float sn = __builtin_amdgcn_sinf(frc), cs = __builtin_amdgcn_cosf(frc);
            const float dq = __builtin_amdgcn_exp2f((float)(row + 1) * L2G[h]), dk = 0.0625f * __builtin_amdgcn_exp2f(-(float)(row + 1) * L2G[h]);
            const float q1 = rq[c], q2 = rq[c + 128], k1 = rk[c], k2 = rk[c + 128];
            const int a1 = row * ROWB + ((((c >> 3)) ^ (row & 15)) << 4) + (c & 7) * 2, a2 = row * ROWB + ((((c + 128) >> 3) ^ (row & 15)) << 4) + (c & 7) * 2;
            *(LAS bf16_t*)(L + LQ + a1) = f2bf((q1 * cs - q2 * sn) * dq); *(LAS bf16_t*)(L + LQ + a2) = f2bf((q1 * sn + q2 * cs) * dq);
            *(LAS bf16_t*)(L + LK + a1) = f2bf((k1 * cs - k2 * sn) * dk); *(LAS bf16_t*)(L + LK + a2) = f2bf((k1 * sn + k2 * cs) * dk); }
        if (F.tid < 256) { const int j = F.tid >> 4, wv = F.tid & 15, tok = 48 + j;
            *(LAS bf16_t*)(L + LV + wv * 128 + (((tok >> 3) ^ ((wv >> 1) & 7)) << 4) + (tok & 7) * 2) = f2bf(RAW[(size_t)j * ldraw + 2048 + h * 512 + 16 * s + wv]); }
    } else {
        if (F.tid < 128) { const int d = F.tid; const float* wgp = F.in[13] + h * 128 + d; const float bias = F.in[14][h * 128 + d]; float cum = 0.f;
            for (int j = 0; j < 16; ++j) { float a = bias;
                for (int r = 0; r < 16; ++r) a += RAW[(size_t)j * ldraw + 3072 + r] * wgp[r * 512];
                cum += (fminf(a, 0.f) - __logf(1.0f + __expf(-fabsf(a)))) * 0.0625f;
                const int row = 48 + j;
                *(LAS bf16_t*)(L + LK + row * ROWB + (((d >> 3) ^ (row & 15)) << 4) + (d & 7) * 2) = f2bf(RAW[(size_t)j * ldraw + 512 + h * 128 + d] * __expf(-cum)); }
            *(LAS float*)(L + LDEC + d * 4) = __expf(cum); }
        if (F.tid >= 256) { const int j = (F.tid - 256) >> 4, wv = F.tid & 15, tok = 48 + j;
            *(LAS bf16_t*)(L + LV + wv * 128 + (((tok >> 3) ^ ((wv >> 1) & 7)) << 4) + (tok & 7) * 2) = f2bf(RAW[(size_t)j * ldraw + 1024 + h * 256 + 16 * s + wv]); }
    }
    f32x4 S[NT];
#pragma unroll
    for (int tt = 0; tt < NT; ++tt) S[tt] = (f32x4){0.f, 0.f, 0.f, 0.f};
    const float g64 = GLA ? 1.0f : __builtin_amdgcn_exp2f(64.0f * L2G[h]);
    const char* Qg = (const char*)(QH + (size_t)bh * SEQ * DK); const char* Kg = (const char*)(KH + (size_t)bh * SEQ * DK);
    const char* Vg = (const char*)(VT + ((size_t)bh * DV + 16 * s) * SEQ);
    __syncthreads();
    for (int c = 0; c <= 128; ++c) {
        const int buf = c & 1;
        if (c < 128) {
            const char* qc = Qg + (size_t)c * TILEB; const char* kc = Kg + (size_t)c * TILEB;
#pragma unroll
            for (int i = 0; i < NI; ++i) { const int piece = w * NI + i, off = piece * 1024 + lane * 16, row = off / ROWB, p = (off % ROWB) >> 4; const int so = row * ROWB + ((p ^ (row & 15)) << 4);
                __builtin_amdgcn_global_load_lds((const unsigned*)(qc + so), (LAS unsigned*)(L + LQ + (buf ^ 1) * TILEB + piece * 1024), 16, 0, 0);
                __builtin_amdgcn_global_load_lds((const unsigned*)(kc + so), (LAS unsigned*)(L + LK + (buf ^ 1) * TILEB + piece * 1024), 16, 0, 0); }
            if (w < 2) { const int off = w * 1024 + lane * 16, wv = off >> 7, p = (off & 127) >> 4;
                __builtin_amdgcn_global_load_lds((const unsigned*)(Vg + (size_t)wv * SEQ * 2 + (size_t)c * 128 + ((p ^ ((wv >> 1) & 7)) << 4)), (LAS unsigned*)(L + LV + (buf ^ 1) * 2048 + w * 1024), 16, 0, 0); }
        }
        { const int ti = w >> 1, tj0 = 2 * (w & 1); f32x4 pt0 = (f32x4){0.f, 0.f, 0.f, 0.f}, pt1 = pt0;
          const int qrow = 16 * ti + r16, kr0 = 16 * tj0 + r16, kr1 = kr0 + 16;
          const LAS unsigned char* qb = L + LQ + buf * TILEB + qrow * ROWB; const LAS unsigned char* kb0 = L + LK + buf * TILEB + kr0 * ROWB; const LAS unsigned char* kb1 = L + LK + buf * TILEB + kr1 * ROWB;
#pragma unroll
          for (int ks = 0; ks < DK / 32; ++ks) { const int ch = ((4 * ks + g) ^ r16) << 4;
              const bf16x8 qf = *(const LAS bf16x8*)(qb + ch), k0 = *(const LAS bf16x8*)(kb0 + ch), k1 = *(const LAS bf16x8*)(kb1 + ch);
              pt0 = __builtin_amdgcn_mfma_f32_16x16x32_bf16(k0, qf, pt0, 0, 0, 0); pt1 = __builtin_amdgcn_mfma_f32_16x16x32_bf16(k1, qf, pt1, 0, 0, 0); }
          const int i = qrow;
#pragma unroll
          for (int tjj = 0; tjj < 2; ++tjj) { const f32x4 pt = tjj ? pt1 : pt0; const int tj = tj0 + tjj, j0 = 16 * tj + 4 * g;
              const float v0 = (j0 + 0 <= i) ? pt[0] : 0.f, v1 = (j0 + 1 <= i) ? pt[1] : 0.f, v2 = (j0 + 2 <= i) ? pt[2] : 0.f, v3 = (j0 + 3 <= i) ? pt[3] : 0.f;
              u32x2 pk; pk.x = cvt_pk_bf16(v0, v1); pk.y = cvt_pk_bf16(v2, v3);
              *(LAS u32x2*)(L + LP + i * 128 + (((2 * tj + (g >> 1)) ^ ((i >> 1) & 7)) << 4) + (g & 1) * 8) = pk; } }
        LDS_WAIT(); __builtin_amdgcn_s_barrier(); asm volatile("" ::: "memory");
        if (w < 4) { const int irow = 16 * w + r16; f32x4 ot = (f32x4){0.f, 0.f, 0.f, 0.f};
#pragma unroll
            for (int ks = 0; ks < 2; ++ks) {
                const bf16x8 va = *(const LAS bf16x8*)(L + LV + buf * 2048 + r16 * 128 + (((4 * ks + g) ^ ((r16 >> 1) & 7)) << 4));
                const bf16x8 pb = *(const LAS bf16x8*)(L + LP + irow * 128 + (((4 * ks + g) ^ ((irow >> 1) & 7)) << 4));
                ot = __builtin_amdgcn_mfma_f32_16x16x32_bf16(va, pb, ot, 0, 0, 0); }
#pragma unroll
            for (int ks = 0; ks < DK / 32; ++ks) { const int ch = ((4 * ks + g) ^ r16) << 4;
                const bf16x8 sa = *(const LAS bf16x8*)(L + LS + buf * 16 * ROWB + r16 * ROWB + ch);
                const bf16x8 qb = *(const LAS bf16x8*)(L + LQ + buf * TILEB + irow * ROWB + ch);
                ot = __builtin_amdgcn_mfma_f32_16x16x32_bf16(sa, qb, ot, 0, 0, 0); }
            float ss = (ot[0] * ot[0] + ot[1] * ot[1]) + (ot[2] * ot[2] + ot[3] * ot[3]);
            ss += __shfl_xor(ss, 16); ss += __shfl_xor(ss, 32);
            if (c >= 1) { const size_t grow = (size_t)b * SEQ + (c - 1) * 64 + irow;
                u32x2 pk; pk.x = cvt_pk_bf16(ot[0], ot[1]); pk.y = cvt_pk_bf16(ot[2], ot[3]);
                *(u32x2*)(O + grow * LDO + h * DV + 16 * s + 4 * g) = pk;
                if (g == 0) atomicAdd(OSS + grow * 4 + h, ss);
            } else if (!GLA && b == 0 && irow >= 48) { float* MO = WSP(float, WS_META + META_MO); float* MOSS = WSP(float, WS_CTL + CTL_MOSS);
                *(f32x4*)(MO + (size_t)(irow - 48) * 2048 + h * 512 + 16 * s + 4 * g) = ot;
                if (g == 0) atomicAdd(MOSS + (irow - 48) * 4 + h, ss); } }
        {
#pragma unroll
          for (int ks = 0; ks < 2; ++ks) {
              const bf16x8 vb = *(const LAS bf16x8*)(L + LV + buf * 2048 + r16 * 128 + (((4 * ks + g) ^ ((r16 >> 1) & 7)) << 4));
#pragma unroll
              for (int tt = 0; tt < NT; ++tt) { const int d0 = 16 * (w + 8 * tt), dcol = d0 + 4 * (r16 & 3), chunk = dcol >> 3, sub = (dcol & 7) * 2;
                  const int r1 = 32 * ks + 8 * g + (r16 >> 2), r2 = r1 + 4;
                  const s16x4 lo = ds_tr(L + LK + buf * TILEB + r1 * ROWB + ((chunk ^ (r1 & 15)) << 4) + sub);
                  const s16x4 hi = ds_tr(L + LK + buf * TILEB + r2 * ROWB + ((chunk ^ (r2 & 15)) << 4) + sub);
                  const bf16x8 ka = (bf16x8){lo[0], lo[1], lo[2], lo[3], hi[0], hi[1], hi[2], hi[3]};
                  S[tt] = __builtin_amdgcn_mfma_f32_16x16x32_bf16(ka, vb, S[tt], 0, 0, 0); } }
#pragma unroll
          for (int tt = 0; tt < NT; ++tt) { const int tile = w + 8 * tt;
              if (GLA) { const f32x4 dc = *(const LAS f32x4*)(L + LDEC + buf * DK * 4 + (16 * tile + 4 * g) * 4); S[tt] = S[tt] * dc; } else S[tt] = S[tt] * g64;
              u32x2 pk; pk.x = cvt_pk_bf16(S[tt][0], S[tt][1]); pk.y = cvt_pk_bf16(S[tt][2], S[tt][3]);
              *(LAS u32x2*)(L + LS + (buf ^ 1) * 16 * ROWB + r16 * ROWB + (((2 * tile + (g >> 1)) ^ r16) << 4) + (g & 1) * 8) = pk; } }
        if (GLA && c < 128 && F.tid < DK) *(LAS float*)(L + LDEC + (buf ^ 1) * DK * 4 + F.tid * 4) = __expf(BC[(size_t)(b * SEQ + c * 64 + 63) * 512 + h * 128 + F.tid]);
        __syncthreads();
    }
}

__device__ __forceinline__ bf16x8 gload16(const void* p) { bf16x8 r; asm volatile("global_load_dwordx4 %0, %1, off" : "=v"(r) : "v"(p) : "memory"); return r; }
__device__ __forceinline__ void glds_touch(const void* gsrc, unsigned lds_dst) { unsigned keep; asm volatile("s_mov_b32 %0, m0\n\ts_mov_b32 m0, %2\n\ts_nop 0\n\tglobal_load_lds_dword %1, off\n\ts_mov_b32 m0, %0" : "=&s"(keep) : "v"(gsrc), "s"(lds_dst) : "memory"); }
#define S2_WAITV(n) asm volatile("s_waitcnt vmcnt(" #n ")" ::: "memory")
template <int DK, int DV, bool GLA>
__device__ __forceinline__ void s2v2_phase(Frame& F, const bf16_t* QH, const bf16_t* KH, const bf16_t* VT, bf16_t* O, float* OSS, const float* BC, int ldraw) {
    constexpr int NS = DV / 16, ROWB = DK * 2, TILEB = 64 * ROWB, NI = TILEB / 1024 / 8, NT = DK / 128, LDO = 4 * DV, KS = DK / 32;
    constexpr int LK = 0, LV = 3 * TILEB, LDEC = LV + 3 * 2048, LP = LDEC + 3 * 1024, LS = LP + 8192, LOT = LS + 2 * 16 * ROWB, LQM = LOT + 4096, LEND = LQM + 16 * ROWB;
    static_assert(LEND <= LDS_MISC, "S2 LDS map");
    const int unit = blockIdx.x; if (unit >= 8 * NS) return;
    const int bh = unit & 7, s = unit >> 3, b = bh >> 2, h = bh & 3;
    const int lane = F.lane, g = lane >> 4, r16 = lane & 15, w = F.wave, ti = w >> 1, hf = w & 1;
    LAS unsigned char* L = F.lds; const unsigned Lb = (unsigned)(uintptr_t)L;
    const float* RAW = WSP(float, WS_META + META_RAW);
    const char* Qg = (const char*)(QH + (size_t)bh * SEQ * DK); const char* Kg = (const char*)(KH + (size_t)bh * SEQ * DK);
    const char* Vg = (const char*)(VT + ((size_t)bh * DV + 16 * s) * SEQ);
    const char* qlane = Qg + (size_t)(16 * ti + r16) * ROWB + g * 16;
    bf16x8 q0[KS], q1[KS], q2[KS];
#define S2_ISSUE(c_, QSET) do { const int rc_ = (c_) - 1, st_ = (c_) % 3; const char* kc_ = Kg + (size_t)rc_ * TILEB; \
        _Pragma("unroll") for (int i_ = 0; i_ < NI; ++i_) { const int piece_ = w * NI + i_, off_ = piece_ * 1024 + lane * 16, row_ = off_ / ROWB, p_ = (off_ % ROWB) >> 4; \
            __builtin_amdgcn_global_load_lds((const unsigned*)(kc_ + row_ * ROWB + ((p_ ^ (row_ & 15)) << 4)), (LAS unsigned*)(L + LK + st_ * TILEB + piece_ * 1024), 16, 0, 0); } \
        if (w < 2) { const int off_ = w * 1024 + lane * 16, wv_ = off_ >> 7, p_ = (off_ & 127) >> 4; \
            __builtin_amdgcn_global_load_lds((const unsigned*)(Vg + (size_t)wv_ * SEQ * 2 + (size_t)rc_ * 128 + ((p_ ^ ((wv_ >> 1) & 7)) << 4)), (LAS unsigned*)(L + LV + st_ * 2048 + w * 1024), 16, 0, 0); } \
        if (GLA && w == 2) __builtin_amdgcn_global_load_lds((const unsigned*)((const char*)(BC + (size_t)(b * SEQ + rc_ * 64 + 63) * 512 + h * 128) + lane * 16), (LAS unsigned*)(L + LDEC + st_ * 1024), 16, 0, 0); \
        _Pragma("unroll") for (int k_ = 0; k_ < KS; ++k_) QSET[k_] = gload16(qlane + (size_t)rc_ * TILEB + k_ * 64); } while (0)
#define S2_WAIT_PREV() do { if (w < 2 || (GLA && w == 2)) { if (NI + KS + 1 == 13) S2_WAITV(13); else S2_WAITV(7); } else { if (NI + KS == 12) S2_WAITV(12); else S2_WAITV(6); } } while (0)
    static_assert((NI + KS == 12) || (NI + KS == 6), "S2 wait immediates");
    for (int i = F.tid * 16; i < TILEB; i += NTHREADS * 16) *(LAS u32x4*)(L + LK + i) = (u32x4){0, 0, 0, 0};
    for (int i = F.tid * 16; i < 2048; i += NTHREADS * 16) *(LAS u32x4*)(L + LV + i) = (u32x4){0, 0, 0, 0};
    for (int i = F.tid * 16; i < 16 * ROWB; i += NTHREADS * 16) { *(LAS u32x4*)(L + LS + i) = (u32x4){0, 0, 0, 0}; *(LAS u32x4*)(L + LQM + i) = (u32x4){0, 0, 0, 0}; }
    __syncthreads();
    if (!GLA) {
        for (int idx = F.tid; idx < 16 * 128; idx += NTHREADS) { const int j = idx >> 7, c = idx & 127, row = 48 + j;
            const float* rq = RAW + (size_t)j * ldraw + h * 256; const float* rk = rq + 1024;
            const float rev = ((float)j * ROPE_INV[c]) * 0.15915494309189535f; const float frc = rev - floorf(rev);
            const float sn = __builtin_amdgcn_sinf(frc), cs = __builtin_amdgcn_cosf(frc);
            const float dq = __builtin_amdgcn_exp2f((float)(row + 1) * L2G[h]), dk = 0.0625f * __builtin_amdgcn_exp2f(-(float)(row + 1) * L2G[h]);
            const float q1v = rq[c], q2v = rq[c + 128], k1 = rk[c], k2 = rk[c + 128];
            const int a1 = row * ROWB + ((((c >> 3)) ^ (row & 15)) << 4) + (c & 7) * 2, a2 = row * ROWB + ((((c + 128) >> 3) ^ (row & 15)) << 4) + (c & 7) * 2;
            *(LAS bf16_t*)(L + LQM + j * ROWB + c * 2) = f2bf((q1v * cs - q2v * sn) * dq); *(LAS bf16_t*)(L + LQM + j * ROWB + (c + 128) * 2) = f2bf((q1v * sn + q2v * cs) * dq);
            *(LAS bf16_t*)(L + LK + a1) = f2bf((k1 * cs - k2 * sn) * dk); *(LAS bf16_t*)(L + LK + a2) = f2bf((k1 * sn + k2 * cs) * dk); }
        if (F.tid < 256) { const int j = F.tid >> 4, wv = F.tid & 15, tok = 48 + j;
            *(LAS bf16_t*)(L + LV + wv * 128 + (((tok >> 3) ^ ((wv >> 1) & 7)) << 4) + (tok & 7) * 2) = f2bf(RAW[(size_t)j * ldraw + 2048 + h * 512 + 16 * s + wv]); }
    } else {
        if (F.tid < 128) { const int d = F.tid; const float* wgp = F.in[13] + h * 128 + d; const float bias = F.in[14][h * 128 + d]; float cum = 0.f;
            for (int j = 0; j < 16; ++j) { float a = bias;
                for (int r = 0; r < 16; ++r) a += RAW[(size_t)j * ldraw + 3072 + r] * wgp[r * 512];
                cum += (fminf(a, 0.f) - __logf(1.0f + __expf(-fabsf(a)))) * 0.0625f;
                const int row = 48 + j;
                *(LAS bf16_t*)(L + LK + row * ROWB + (((d >> 3) ^ (row & 15)) << 4) + (d & 7) * 2) = f2bf(RAW[(size_t)j * ldraw + 512 + h * 128 + d] * __expf(-cum)); }
            *(LAS float*)(L + LDEC + d * 4) = cum; }
        if (F.tid >= 256) { const int j = (F.tid - 256) >> 4, wv = F.tid & 15, tok = 48 + j;
            *(LAS bf16_t*)(L + LV + wv * 128 + (((tok >> 3) ^ ((wv >> 1) & 7)) << 4) + (tok & 7) * 2) = f2bf(RAW[(size_t)j * ldraw + 1024 + h * 256 + 16 * s + wv]); }
    }
    f32x4 S[NT];
#pragma unroll
    for (int tt = 0; tt < NT; ++tt) S[tt] = (f32x4){0.f, 0.f, 0.f, 0.f};
    const float g64 = GLA ? 1.0f : __builtin_amdgcn_exp2f(64.0f * L2G[h]);
    __syncthreads();
#pragma unroll
    for (int k = 0; k < KS; ++k) { q0[k] = *(const LAS bf16x8*)(L + LQM + (ti == 3 ? r16 : 0) * ROWB + (4 * k + g) * 16); if (ti != 3) q0[k] = (bf16x8){0, 0, 0, 0, 0, 0, 0, 0}; q1[k] = q0[k]; q2[k] = q0[k]; }
    LDS_WAIT();
    S2_ISSUE(1, q1);
    f32x4 ot_prev = (f32x4){0.f, 0.f, 0.f, 0.f}; float ss_prev = 0.f;
#define S2_STEP(c_, QC, QN2) do { const int c = (c_), st = c % 3, sb = c & 1; \
          \
        if (hf == 0 && c >= 1) { const f32x4 part = *(const LAS f32x4*)(L + LOT + ti * 1024 + lane * 16); const f32x4 ot = ot_prev + part; const int irow = 16 * ti + r16; \
            if (c >= 2) { const size_t grow = (size_t)b * SEQ + (c - 2) * 64 + irow; u32x2 pk; pk.x = cvt_pk_bf16(ot[0], ot[1]); pk.y = cvt_pk_bf16(ot[2], ot[3]); \
                *(u32x2*)(O + grow * LDO + h * DV + 16 * s + 4 * g) = pk; } \
            else if (!GLA && b == 0 && irow >= 48) { float* MO = WSP(float, WS_META + META_MO); \
                *(f32x4*)(MO + (size_t)(irow - 48) * 2048 + h * 512 + 16 * s + 4 * g) = ot; } } \
        if (c + 2 <= 128) S2_ISSUE(c + 2, QN2); \
          \
        { const int tj0 = 2 * hf; f32x4 pt0 = (f32x4){0.f, 0.f, 0.f, 0.f}, pt1 = pt0; \
          const LAS unsigned char* kb0 = L + LK + st * TILEB + (16 * tj0 + r16) * ROWB; const LAS unsigned char* kb1 = kb0 + 16 * ROWB; \
          _Pragma("unroll") for (int ks = 0; ks < KS; ++ks) { const int ch = ((4 * ks + g) ^ r16) << 4; \
              const bf16x8 k0 = *(const LAS bf16x8*)(kb0 + ch), k1 = *(const LAS bf16x8*)(kb1 + ch); \
              pt0 = __builtin_amdgcn_mfma_f32_16x16x32_bf16(k0, QC[ks], pt0, 0, 0, 0); pt1 = __builtin_amdgcn_mfma_f32_16x16x32_bf16(k1, QC[ks], pt1, 0, 0, 0); } \
          const int i = 16 * ti + r16; \
          _Pragma("unroll") for (int tjj = 0; tjj < 2; ++tjj) { const f32x4 pt = tjj ? pt1 : pt0; const int tj = tj0 + tjj, j0 = 16 * tj + 4 * g; \
              const float v0 = (j0 + 0 <= i) ? pt[0] : 0.f, v1 = (j0 + 1 <= i) ? pt[1] : 0.f, v2 = (j0 + 2 <= i) ? pt[2] : 0.f, v3 = (j0 + 3 <= i) ? pt[3] : 0.f; \
              u32x2 pk; pk.x = cvt_pk_bf16(v0, v1); pk.y = cvt_pk_bf16(v2, v3); \
              *(LAS u32x2*)(L + LP + i * 128 + (((2 * tj + (g >> 1)) ^ ((i >> 1) & 7)) << 4) + (g & 1) * 8) = pk; } } \
        LDS_WAIT(); __builtin_amdgcn_s_barrier(); asm volatile("" ::: "memory"); \
          \
        { const int irow = 16 * ti + r16; f32x4 ot = (f32x4){0.f, 0.f, 0.f, 0.f}; \
          if (hf == 0) { _Pragma("unroll") for (int ks = 0; ks < 2; ++ks) { \
                const bf16x8 va = *(const LAS bf16x8*)(L + LV + st * 2048 + r16 * 128 + (((4 * ks + g) ^ ((r16 >> 1) & 7)) << 4)); \
                const bf16x8 pb = *(const LAS bf16x8*)(L + LP + irow * 128 + (((4 * ks + g) ^ ((irow >> 1) & 7)) << 4)); \
                ot = __builtin_amdgcn_mfma_f32_16x16x32_bf16(va, pb, ot, 0, 0, 0); } } \
          if (hf == 0) { _Pragma("unroll") for (int kk = 0; kk < KS / 2; ++kk) { \
              const bf16x8 sa = *(const LAS bf16x8*)(L + LS + sb * 16 * ROWB + r16 * ROWB + (((4 * kk + g) ^ r16) << 4)); \
              ot = __builtin_amdgcn_mfma_f32_16x16x32_bf16(sa, QC[kk], ot, 0, 0, 0); } } \
          else { _Pragma("unroll") for (int kk = KS / 2; kk < KS; ++kk) { \
              const bf16x8 sa = *(const LAS bf16x8*)(L + LS + sb * 16 * ROWB + r16 * ROWB + (((4 * kk + g) ^ r16) << 4)); \
              ot = __builtin_amdgcn_mfma_f32_16x16x32_bf16(sa, QC[kk], ot, 0, 0, 0); } } \
          if (hf == 1) *(LAS f32x4*)(L + LOT + ti * 1024 + lane * 16) = ot; else ot_prev = ot; } \
          \
        { s16x4 klo[2][NT], khi[2][NT]; bf16x8 vbb[2]; \
          _Pragma("unroll") for (int ks = 0; ks < 2; ++ks) { \
              vbb[ks] = *(const LAS bf16x8*)(L + LV + st * 2048 + r16 * 128 + (((4 * ks + g) ^ ((r16 >> 1) & 7)) << 4)); \
              _Pragma("unroll") for (int tt = 0; tt < NT; ++tt) { const int d0 = 16 * (w + 8 * tt), dcol = d0 + 4 * (r16 & 3), chunk = dcol >> 3, sub = (dcol & 7) * 2; \
                  const int r1 = 32 * ks + 8 * g + (r16 >> 2), r2 = r1 + 4; \
                  klo[ks][tt] = ds_tr_asm(Lb + LK + st * TILEB + r1 * ROWB + ((chunk ^ (r1 & 15)) << 4) + sub); \
                  khi[ks][tt] = ds_tr_asm(Lb + LK + st * TILEB + r2 * ROWB + ((chunk ^ (r2 & 15)) << 4) + sub); } } \
          asm volatile("s_waitcnt lgkmcnt(0)" ::: "memory"); __builtin_amdgcn_sched_barrier(0); \
          _Pragma("unroll") for (int ks = 0; ks < 2; ++ks) _Pragma("unroll") for (int tt = 0; tt < NT; ++tt) { \
                  const s16x4 lo = klo[ks][tt], hi = khi[ks][tt]; \
                  const bf16x8 ka = (bf16x8){lo[0], lo[1], lo[2], lo[3], hi[0], hi[1], hi[2], hi[3]}; \
                  S[tt] = __builtin_amdgcn_mfma_f32_16x16x32_bf16(ka, vbb[ks], S[tt], 0, 0, 0); } \
          _Pragma("unroll") for (int tt = 0; tt < NT; ++tt) { const int tile = w + 8 * tt; \
              if (GLA) { const f32x4 dl = *(const LAS f32x4*)(L + LDEC + st * 1024 + (16 * tile + 4 * g) * 4); \
                  S[tt][0] *= __expf(dl[0]); S[tt][1] *= __expf(dl[1]); S[tt][2] *= __expf(dl[2]); S[tt][3] *= __expf(dl[3]); } else S[tt] = S[tt] * g64; \
              u32x2 pk; pk.x = cvt_pk_bf16(S[tt][0], S[tt][1]); pk.y = cvt_pk_bf16(S[tt][2], S[tt][3]); \
              *(LAS u32x2*)(L + LS + (sb ^ 1) * 16 * ROWB + r16 * ROWB + (((2 * tile + (g >> 1)) ^ r16) << 4) + (g & 1) * 8) = pk; } } \
          \
        if (c + 2 <= 128) S2_WAIT_PREV(); else S2_WAITV(0); \
        LDS_WAIT(); __builtin_amdgcn_s_barrier(); asm volatile("" ::: "memory"); __builtin_amdgcn_sched_barrier(0); \
    } while (0)
#define S2_PIN(Q) do { _Pragma("unroll") for (int k_ = 0; k_ < KS; ++k_) asm volatile("" : "+v"(Q[k_])); } while (0)
    for (int c3 = 0; c3 < 129; c3 += 3) {
        S2_STEP(c3, q0, q2);     S2_PIN(q1);
        S2_STEP(c3 + 1, q1, q0); S2_PIN(q2);
        S2_STEP(c3 + 2, q2, q1); S2_PIN(q0);
    }
    if (hf == 0) { const f32x4 part = *(const LAS f32x4*)(L + LOT + ti * 1024 + lane * 16); const f32x4 ot = ot_prev + part; const int irow = 16 * ti + r16;
        const size_t grow = (size_t)b * SEQ + 127 * 64 + irow; u32x2 pk; pk.x = cvt_pk_bf16(ot[0], ot[1]); pk.y = cvt_pk_bf16(ot[2], ot[3]);
        *(u32x2*)(O + grow * LDO + h * DV + 16 * s + 4 * g) = pk; }
#undef S2_ISSUE
#undef S2_WAIT_PREV
#undef S2_STEP
#undef S2_PIN
}

template <int DK, int DV, bool GLA>
__device__ __forceinline__ void s2v3_phase(Frame& F, const bf16_t* QH, const bf16_t* KH, const bf16_t* VT, bf16_t* O, const float* BC, int ldraw) {
    constexpr int NS = DV / 16, ROWB = DK * 2, TILEB = 64 * ROWB, NIL = TILEB / 1024 / 4, NTU = DK / 64, LDO = 4 * DV, KS = DK / 32;
    constexpr int LK = 0, LV = 3 * TILEB, LDEC = LV + 3 * 2048, LP = LDEC + 3 * 1024, LS = LP + 8192, LOT = LS + 2 * 16 * ROWB, LQM = LOT + 4096, LEND = LQM + 16 * ROWB;
    static_assert(LEND <= LDS_MISC, "S2 LDS map");
    static_assert((NIL + KS == 16) || (NIL + KS == 8), "S2 wait immediates");
    const int unit = blockIdx.x; if (unit >= 8 * NS) return;
    const int bh = unit & 7, s = unit >> 3, b = bh >> 2, h = bh & 3;
    const int lane = F.lane, g = lane >> 4, r16 = lane & 15, w = F.wave, ti = w >> 1, hf = w & 1;
    LAS unsigned char* L = F.lds; const unsigned Lb = (unsigned)(uintptr_t)L;
    const float* RAW = WSP(float, WS_META + META_RAW);
    const char* Qg = (const char*)(QH + (size_t)bh * SEQ * DK); const char* Kg = (const char*)(KH + (size_t)bh * SEQ * DK);
    const char* Vg = (const char*)(VT + ((size_t)bh * DV + 16 * s) * SEQ);
    const char* qlane = Qg + (size_t)(16 * ti + r16) * ROWB + g * 16;
    bf16x8 q0[KS], q1[KS], q2[KS];
#define S3_ISSUE(c_, ST_, QSET) do { unsigned lzi_ = 0; asm volatile("" : "+v"(lzi_)); const int rc_ = (c_) - 1; constexpr int st_ = (ST_); const char* kc_ = Kg + (size_t)rc_ * TILEB + lzi_; \
        _Pragma("unroll") for (int i_ = 0; i_ < NIL; ++i_) { const int piece_ = ti * NIL + i_, off_ = piece_ * 1024 + lane * 16, row_ = off_ / ROWB, p_ = (off_ % ROWB) >> 4; \
            __builtin_amdgcn_global_load_lds((const unsigned*)(kc_ + row_ * ROWB + ((p_ ^ (row_ & 15)) << 4)), (LAS unsigned*)(L + LK + st_ * TILEB + piece_ * 1024), 16, 0, 0); } \
        if (ti < 2) { const int off_ = ti * 1024 + lane * 16, wv_ = off_ >> 7, p_ = (off_ & 127) >> 4; \
            __builtin_amdgcn_global_load_lds((const unsigned*)(Vg + (size_t)wv_ * SEQ * 2 + (size_t)rc_ * 128 + ((p_ ^ ((wv_ >> 1) & 7)) << 4)), (LAS unsigned*)(L + LV + st_ * 2048 + ti * 1024), 16, 0, 0); } \
        if (GLA && ti == 2) __builtin_amdgcn_global_load_lds((const unsigned*)((const char*)(BC + (size_t)(b * SEQ + rc_ * 64 + 63) * 512 + h * 128) + lane * 16), (LAS unsigned*)(L + LDEC + st_ * 1024), 16, 0, 0); \
        _Pragma("unroll") for (int k_ = 0; k_ < KS; ++k_) QSET[k_] = gload16(qlane + (size_t)rc_ * TILEB + k_ * 64); } while (0)
#define S3_WAIT_PREV() do { if (ti < 2 || (GLA && ti == 2)) { if (NIL + KS == 16) S2_WAITV(17); else S2_WAITV(9); } else { if (NIL + KS == 16) S2_WAITV(16); else S2_WAITV(8); } } while (0)
    for (int i = F.tid * 16; i < TILEB; i += NTHREADS * 16) *(LAS u32x4*)(L + LK + i) = (u32x4){0, 0, 0, 0};
    for (int i = F.tid * 16; i < 2048; i += NTHREADS * 16) *(LAS u32x4*)(L + LV + i) = (u32x4){0, 0, 0, 0};
    for (int i = F.tid * 16; i < 16 * ROWB; i += NTHREADS * 16) { *(LAS u32x4*)(L + LS + i) = (u32x4){0, 0, 0, 0}; *(LAS u32x4*)(L + LQM + i) = (u32x4){0, 0, 0, 0}; }
    __syncthreads();
    if (!GLA) {
        for (int idx = F.tid; idx < 16 * 128; idx += NTHREADS) { const int j = idx >> 7, c = idx & 127, row = 48 + j;
            const float* rq = RAW + (size_t)j * ldraw + h * 256; const float* rk = rq + 1024;
            const float rev = ((float)j * ROPE_INV[c]) * 0.15915494309189535f; const float frc = rev - floorf(rev);
            const float sn = __builtin_amdgcn_sinf(frc), cs = __builtin_amdgcn_cosf(frc);
            const float dq = __builtin_amdgcn_exp2f((float)(row + 1) * L2G[h]), dk = 0.0625f * __builtin_amdgcn_exp2f(-(float)(row + 1) * L2G[h]);
            const float q1v = rq[c], q2v = rq[c + 128], k1 = rk[c], k2 = rk[c + 128];
            const int a1 = row * ROWB + ((((c >> 3)) ^ (row & 15)) << 4) + (c & 7) * 2, a2 = row * ROWB + ((((c + 128) >> 3) ^ (row & 15)) << 4) + (c & 7) * 2;
            *(LAS bf16_t*)(L + LQM + j * ROWB + c * 2) = f2bf((q1v * cs - q2v * sn) * dq); *(LAS bf16_t*)(L + LQM + j * ROWB + (c + 128) * 2) = f2bf((q1v * sn + q2v * cs) * dq);
            *(LAS bf16_t*)(L + LK + a1) = f2bf((k1 * cs - k2 * sn) * dk); *(LAS bf16_t*)(L + LK + a2) = f2bf((k1 * sn + k2 * cs) * dk); }
        if (F.tid < 256) { const int j = F.tid >> 4, wv = F.tid & 15, tok = 48 + j;
            *(LAS bf16_t*)(L + LV + wv * 128 + (((tok >> 3) ^ ((wv >> 1) & 7)) << 4) + (tok & 7) * 2) = f2bf(RAW[(size_t)j * ldraw + 2048 + h * 512 + 16 * s + wv]); }
    } else {
        if (F.tid < 128) { const int d = F.tid; const float* wgp = F.in[13] + h * 128 + d; const float bias = F.in[14][h * 128 + d]; float cum = 0.f;
            for (int j = 0; j < 16; ++j) { float a = bias;
                for (int r = 0; r < 16; ++r) a += RAW[(size_t)j * ldraw + 3072 + r] * wgp[r * 512];
                cum += (fminf(a, 0.f) - __logf(1.0f + __expf(-fabsf(a)))) * 0.0625f;
                const int row = 48 + j;
                *(LAS bf16_t*)(L + LK + row * ROWB + (((d >> 3) ^ (row & 15)) << 4) + (d & 7) * 2) = f2bf(RAW[(size_t)j * ldraw + 512 + h * 128 + d] * __expf(-cum)); }
            *(LAS float*)(L + LDEC + d * 4) = cum; }
        if (F.tid >= 256) { const int j = (F.tid - 256) >> 4, wv = F.tid & 15, tok = 48 + j;
            *(LAS bf16_t*)(L + LV + wv * 128 + (((tok >> 3) ^ ((wv >> 1) & 7)) << 4) + (tok & 7) * 2) = f2bf(RAW[(size_t)j * ldraw + 1024 + h * 256 + 16 * s + wv]); }
    }
    f32x4 S[NTU];
#pragma unroll
    for (int tt = 0; tt < NTU; ++tt) S[tt] = (f32x4){0.f, 0.f, 0.f, 0.f};
    const float g64 = GLA ? 1.0f : __builtin_amdgcn_exp2f(64.0f * L2G[h]);
    __syncthreads();
#pragma unroll
    for (int k = 0; k < KS; ++k) { q0[k] = *(const LAS bf16x8*)(L + LQM + (ti == 3 ? r16 : 0) * ROWB + (4 * k + g) * 16); if (ti != 3) q0[k] = (bf16x8){0, 0, 0, 0, 0, 0, 0, 0}; asm volatile("" : "=v"(q1[k])); asm volatile("" : "=v"(q2[k])); }
    LDS_WAIT();
    if (hf) S3_ISSUE(1, 1, q1);
    f32x4 ot_prev = (f32x4){0.f, 0.f, 0.f, 0.f};
#define S3_STEP(c_, ST, QC, QN2) do { const int c = (c_), sb = c & 1; constexpr int st = (ST); \
        unsigned lz_ = 0; asm volatile("" : "+v"(lz_)); LAS unsigned char* const Lz = L + lz_; const unsigned Lbz = Lb + lz_;   \
        if (hf == 0) { \
              \
            if (c >= 1) { const f32x4 part = *(const LAS f32x4*)(Lz + LOT + ti * 1024 + lane * 16); const f32x4 ot = ot_prev + part; const int irow = 16 * ti + r16; \
                if (c >= 2) { const size_t grow = (size_t)b * SEQ + (c - 2) * 64 + irow; u32x2 pk; pk.x = cvt_pk_bf16(ot[0], ot[1]); pk.y = cvt_pk_bf16(ot[2], ot[3]); \
                    *(u32x2*)(O + grow * LDO + h * DV + 16 * s + 4 * g) = pk; } \
                else if (!GLA && b == 0 && irow >= 48) { float* MO = WSP(float, WS_META + META_MO); *(f32x4*)(MO + (size_t)(irow - 48) * 2048 + h * 512 + 16 * s + 4 * g) = ot; } } \
              \
            { bf16x8 vbb[2]; \
              _Pragma("unroll") for (int ks = 0; ks < 2; ++ks) vbb[ks] = *(const LAS bf16x8*)(Lz + LV + st * 2048 + r16 * 128 + (((4 * ks + g) ^ ((r16 >> 1) & 7)) << 4)); \
              _Pragma("unroll") for (int tt = 0; tt < NTU; ++tt) { const int tile = ti + 4 * tt, d0 = 16 * tile, dcol = d0 + 4 * (r16 & 3), chunk = dcol >> 3, sub = (dcol & 7) * 2; \
                  s16x4 klo[2], khi[2]; \
                  _Pragma("unroll") for (int ks = 0; ks < 2; ++ks) { const int r1 = 32 * ks + 8 * g + (r16 >> 2), r2 = r1 + 4; \
                      klo[ks] = ds_tr_asm(Lbz + LK + st * TILEB + r1 * ROWB + ((chunk ^ (r1 & 15)) << 4) + sub); \
                      khi[ks] = ds_tr_asm(Lbz + LK + st * TILEB + r2 * ROWB + ((chunk ^ (r2 & 15)) << 4) + sub); } \
                  asm volatile("s_waitcnt lgkmcnt(0)" ::: "memory"); __builtin_amdgcn_sched_barrier(0); \
                  _Pragma("unroll") for (int ks = 0; ks < 2; ++ks) { const s16x4 lo = klo[ks], hi = khi[ks]; \
                      const bf16x8 ka = (bf16x8){lo[0], lo[1], lo[2], lo[3], hi[0], hi[1], hi[2], hi[3]}; \
                      S[tt] = __builtin_amdgcn_mfma_f32_16x16x32_bf16(ka, vbb[ks], S[tt], 0, 0, 0); } \
                  if (GLA) { const f32x4 dl = *(const LAS f32x4*)(Lz + LDEC + st * 1024 + (16 * tile + 4 * g) * 4); \
                      S[tt][0] *= __expf(dl[0]); S[tt][1] *= __expf(dl[1]); S[tt][2] *= __expf(dl[2]); S[tt][3] *= __expf(dl[3]); } else S[tt] = S[tt] * g64; \
                  u32x2 pk; pk.x = cvt_pk_bf16(S[tt][0], S[tt][1]); pk.y = cvt_pk_bf16(S[tt][2], S[tt][3]); \
                  *(LAS u32x2*)(Lz + LS + (sb ^ 1) * 16 * ROWB + r16 * ROWB + (((2 * tile + (g >> 1)) ^ r16) << 4) + (g & 1) * 8) = pk; } } \
        } else { \
            if (c + 2 <= 128) S3_ISSUE(c + 2, (ST + 2) % 3, QN2); \
              \
            { const LAS unsigned char* kb = Lz + LK + st * TILEB + r16 * ROWB; const int i = 16 * ti + r16; \
              _Pragma("unroll") for (int th = 0; th < 2; ++th) { f32x4 pa = (f32x4){0.f, 0.f, 0.f, 0.f}, pb = pa; \
                  if (2 * th <= ti) { \
                      _Pragma("unroll") for (int ks = 0; ks < KS; ++ks) { const int ch = ((4 * ks + g) ^ r16) << 4; \
                          const bf16x8 ka = *(const LAS bf16x8*)(kb + (2 * th) * 16 * ROWB + ch), kc2 = *(const LAS bf16x8*)(kb + (2 * th + 1) * 16 * ROWB + ch); \
                          pa = __builtin_amdgcn_mfma_f32_16x16x32_bf16(ka, QC[ks], pa, 0, 0, 0); pb = __builtin_amdgcn_mfma_f32_16x16x32_bf16(kc2, QC[ks], pb, 0, 0, 0); \
                          if (ks & 1) __builtin_amdgcn_sched_barrier(0); } } \
                  _Pragma("unroll") for (int tq = 0; tq < 2; ++tq) { const int tj = 2 * th + tq, j0 = 16 * tj + 4 * g; const f32x4 pt = tq ? pb : pa; \
                      const float v0 = (j0 + 0 <= i) ? pt[0] : 0.f, v1 = (j0 + 1 <= i) ? pt[1] : 0.f, v2 = (j0 + 2 <= i) ? pt[2] : 0.f, v3 = (j0 + 3 <= i) ? pt[3] : 0.f; \
                      u32x2 pk; pk.x = cvt_pk_bf16(v0, v1); pk.y = cvt_pk_bf16(v2, v3); \
                      *(LAS u32x2*)(Lz + LP + i * 128 + (((2 * tj + (g >> 1)) ^ ((i >> 1) & 7)) << 4) + (g & 1) * 8) = pk; } } } \
        } \
        LDS_WAIT(); __builtin_amdgcn_s_barrier(); asm volatile("" ::: "memory"); \
        if (hf == 0) {   \
            const int irow = 16 * ti + r16; f32x4 ot = (f32x4){0.f, 0.f, 0.f, 0.f}; \
            _Pragma("unroll") for (int ks = 0; ks < 2; ++ks) { \
                const bf16x8 va = *(const LAS bf16x8*)(Lz + LV + st * 2048 + r16 * 128 + (((4 * ks + g) ^ ((r16 >> 1) & 7)) << 4)); \
                const bf16x8 pb = *(const LAS bf16x8*)(Lz + LP + irow * 128 + (((4 * ks + g) ^ ((irow >> 1) & 7)) << 4)); \
                ot = __builtin_amdgcn_mfma_f32_16x16x32_bf16(va, pb, ot, 0, 0, 0); } \
            ot_prev = ot; \
        } else {   \
            f32x4 oa = (f32x4){0.f, 0.f, 0.f, 0.f}, ob = oa; \
            _Pragma("unroll") for (int ks = 0; ks < KS; ks += 2) { \
                const bf16x8 sa = *(const LAS bf16x8*)(Lz + LS + sb * 16 * ROWB + r16 * ROWB + (((4 * ks + g) ^ r16) << 4)); \
                const bf16x8 sc = *(const LAS bf16x8*)(Lz + LS + sb * 16 * ROWB + r16 * ROWB + (((4 * (ks + 1) + g) ^ r16) << 4)); \
                oa = __builtin_amdgcn_mfma_f32_16x16x32_bf16(sa, QC[ks], oa, 0, 0, 0); ob = __builtin_amdgcn_mfma_f32_16x16x32_bf16(sc, QC[ks + 1], ob, 0, 0, 0); __builtin_amdgcn_sched_barrier(0); } \
            *(LAS f32x4*)(Lz + LOT + ti * 1024 + lane * 16) = oa + ob; \
            if (c + 2 <= 128) S3_WAIT_PREV(); else S2_WAITV(0); \
        } \
        LDS_WAIT(); __builtin_amdgcn_s_barrier(); asm volatile("" ::: "memory"); __builtin_amdgcn_sched_barrier(0); \
    } while (0)
#define S3_PIN(Q) do { _Pragma("unroll") for (int k_ = 0; k_ < KS; ++k_) asm volatile("" : "+v"(Q[k_])); } while (0)
    for (int c3 = 0; c3 < 129; c3 += 3) {
        S3_STEP(c3, 0, q0, q2);     S3_PIN(q1);
        S3_STEP(c3 + 1, 1, q1, q0); S3_PIN(q2);
        S3_STEP(c3 + 2, 2, q2, q1); S3_PIN(q0);
    }
    if (hf == 0) { const f32x4 part = *(const LAS f32x4*)(L + LOT + ti * 1024 + lane * 16); const f32x4 ot = ot_prev + part; const int irow = 16 * ti + r16;
        const size_t grow = (size_t)b * SEQ + 127 * 64 + irow; u32x2 pk; pk.x = cvt_pk_bf16(ot[0], ot[1]); pk.y = cvt_pk_bf16(ot[2], ot[3]);
        *(u32x2*)(O + grow * LDO + h * DV + 16 * s + 4 * g) = pk; }
#undef S3_ISSUE
#undef S3_WAIT_PREV
#undef S3_STEP
#undef S3_PIN
}

template <int DK, int DV, bool GLA>
__device__ __forceinline__ void s2v4_phase(Frame& F, const int unit, const bf16_t* QH, const bf16_t* KH, const bf16_t* VT, bf16_t* O, const float* BC, int ldraw) {
    constexpr int NS = DV / 16, ROWB = DK * 2, TILEB = 32 * ROWB, NIL = TILEB / 1024 / 4, NTU = DK / 64, LDO = 4 * DV, KS = DK / 32, NSTEP = 257;
    constexpr int LK = 0, LQ = 3 * TILEB, LV = 6 * TILEB, LDEC = LV + 3 * 1024, LP = LDEC + 3 * 1024, LS = LP + 2048, LOT = LS + 2 * 16 * ROWB, LEND = LOT + 4096;
    static_assert(LEND + 256 <= LDS_MISC, "S2 LDS map");
    static_assert(NIL == 4 || NIL == 2, "S2 wait immediates");
    if (unit >= 8 * NS) return;
    const int bh = unit & 7, s = unit >> 3, b = bh >> 2, h = bh & 3;
    const int lane = F.lane, g = lane >> 4, r16 = lane & 15, w = F.wave, li = w >> 1, hf = w & 1, qi = li >> 1, kj = li & 1;
    LAS unsigned char* L = F.lds; const unsigned Lb = (unsigned)(uintptr_t)L;
    const float* RAW = WSP(float, WS_META + META_RAW);
    const char* Qg = (const char*)(QH + (size_t)bh * SEQ * DK); const char* Kg = (const char*)(KH + (size_t)bh * SEQ * DK);
    const char* Vg = (const char*)(VT + ((size_t)bh * DV + 16 * s) * SEQ);
#define S4_ISSUE(c_, st_) do { const int rc_ = (c_) - 1; const char* kc_ = Kg + (size_t)rc_ * TILEB; const char* qc_ = Qg + (size_t)rc_ * TILEB; \
        _Pragma("unroll") for (int i_ = 0; i_ < NIL; ++i_) { const int piece_ = li * NIL + i_, off_ = piece_ * 1024 + lane * 16, row_ = off_ / ROWB, p_ = (off_ % ROWB) >> 4; const int so_ = row_ * ROWB + ((p_ ^ (row_ & 15)) << 4); \
            __builtin_amdgcn_global_load_lds((const unsigned*)(kc_ + so_), (LAS unsigned*)(L + LK + (st_) * TILEB + piece_ * 1024), 16, 0, 0); \
            __builtin_amdgcn_global_load_lds((const unsigned*)(qc_ + so_), (LAS unsigned*)(L + LQ + (st_) * TILEB + piece_ * 1024), 16, 0, 0); } \
        if (li == 0) { const int wv_ = lane >> 2, p_ = lane & 3; \
            __builtin_amdgcn_global_load_lds((const unsigned*)(Vg + (size_t)wv_ * SEQ * 2 + (size_t)rc_ * 64 + ((p_ ^ ((wv_ >> 2) & 3)) << 4)), (LAS unsigned*)(L + LV + (st_) * 1024), 16, 0, 0); } \
        if (GLA && li == 1) __builtin_amdgcn_global_load_lds((const unsigned*)((const char*)(BC + (size_t)(b * SEQ + rc_ * 32 + 31) * 512 + h * 128) + lane * 16), (LAS unsigned*)(L + LDEC + (st_) * 1024), 16, 0, 0); } while (0)
#define S4_WAIT_PREV() do { if (li == 0 || (GLA && li == 1)) { if (NIL == 4) S2_WAITV(9); else S2_WAITV(5); } else { if (NIL == 4) S2_WAITV(8); else S2_WAITV(4); } } while (0)
    for (int i = F.tid * 16; i < TILEB; i += NTHREADS * 16) { *(LAS u32x4*)(L + LK + i) = (u32x4){0, 0, 0, 0}; *(LAS u32x4*)(L + LQ + i) = (u32x4){0, 0, 0, 0}; }
    for (int i = F.tid * 16; i < 1024; i += NTHREADS * 16) *(LAS u32x4*)(L + LV + i) = (u32x4){0, 0, 0, 0};
    for (int i = F.tid * 16; i < 16 * ROWB; i += NTHREADS * 16) *(LAS u32x4*)(L + LS + i) = (u32x4){0, 0, 0, 0};
    __syncthreads();
    if (!GLA) {
        for (int idx = F.tid; idx < 16 * 128; idx += NTHREADS) { const int j = idx >> 7, c = idx & 127, row = 16 + j;
            const float* rq = RAW + (size_t)j * ldraw + h * 256; const float* rk = rq + 1024;
            const float rev = ((float)j * ROPE_INV[c]) * 0.15915494309189535f; const float frc = rev - floorf(rev);
            const float sn = __builtin_amdgcn_sinf(frc), cs = __builtin_amdgcn_cosf(frc);
            const float dq = __builtin_amdgcn_exp2f((float)(row + 1) * L2G[h]), dk = 0.0625f * __builtin_amdgcn_exp2f(-(float)(row + 1) * L2G[h]);
            const float q1v = rq[c], q2v = rq[c + 128], k1 = rk[c], k2 = rk[c + 128];
            const int a1 = row * ROWB + ((((c >> 3)) ^ (row & 15)) << 4) + (c & 7) * 2, a2 = row * ROWB + ((((c + 128) >> 3) ^ (row & 15)) << 4) + (c & 7) * 2;
            *(LAS bf16_t*)(L + LQ + a1) = f2bf((q1v * cs - q2v * sn) * dq); *(LAS bf16_t*)(L + LQ + a2) = f2bf((q1v * sn + q2v * cs) * dq);
            *(LAS bf16_t*)(L + LK + a1) = f2bf((k1 * cs - k2 * sn) * dk); *(LAS bf16_t*)(L + LK + a2) = f2bf((k1 * sn + k2 * cs) * dk); }
        if (F.tid < 256) { const int j = F.tid >> 4, wv = F.tid & 15, tok = 16 + j;
            *(LAS bf16_t*)(L + LV + wv * 64 + (((tok >> 3) ^ ((wv >> 2) & 3)) << 4) + (tok & 7) * 2) = f2bf(RAW[(size_t)j * ldraw + 2048 + h * 512 + 16 * s + wv]); }
    } else {
        if (F.tid < 128) { const int d = F.tid; const float* wgp = F.in[13] + h * 128 + d; const float bias = F.in[14][h * 128 + d]; float cum = 0.f;
            for (int j = 0; j < 16; ++j) { float a = bias;
                for (int r = 0; r < 16; ++r) a += RAW[(size_t)j * ldraw + 3072 + r] * wgp[r * 512];
                cum += (fminf(a, 0.f) - __logf(1.0f + __expf(-fabsf(a)))) * 0.0625f;
                const int row = 16 + j;
                *(LAS bf16_t*)(L + LK + row * ROWB + (((d >> 3) ^ (row & 15)) << 4) + (d & 7) * 2) = f2bf(RAW[(size_t)j * ldraw + 512 + h * 128 + d] * __expf(-cum)); }
            *(LAS float*)(L + LDEC + d * 4) = cum; }
        if (F.tid >= 256) { const int j = (F.tid - 256) >> 4, wv = F.tid & 15, tok = 16 + j;
            *(LAS bf16_t*)(L + LV + wv * 64 + (((tok >> 3) ^ ((wv >> 2) & 3)) << 4) + (tok & 7) * 2) = f2bf(RAW[(size_t)j * ldraw + 1024 + h * 256 + 16 * s + wv]); }
    }
    f32x4 S[NTU];
#pragma unroll
    for (int tt = 0; tt < NTU; ++tt) S[tt] = (f32x4){0.f, 0.f, 0.f, 0.f};
    const float g32 = GLA ? 1.0f : __builtin_amdgcn_exp2f(32.0f * L2G[h]);
    __syncthreads();
    if (hf) S4_ISSUE(1, 1);
    f32x4 ot_prev = (f32x4){0.f, 0.f, 0.f, 0.f};
    int st = 0;
#if defined(PROBE2)
    unsigned long long pacc = 0ull, pt0 = 0ull; const unsigned long long ptot0 = __builtin_amdgcn_s_memtime();
#define P2T(q, stmt) do { if (PROBE2 == (q) && !GLA) { stmt; } } while (0)
#else
#define P2T(q, stmt) do {} while (0)
#endif
    for (int c = 0; c < NSTEP; ++c) {
        P2T(2, if (hf == 1) pt0 = __builtin_amdgcn_s_memtime()); P2T(3, if (hf == 0) pt0 = __builtin_amdgcn_s_memtime());
        const int sb = c & 1, st2 = (st == 0) ? 2 : st - 1;
        unsigned lz_ = 0; asm volatile("" : "+v"(lz_)); LAS unsigned char* const Lz = L + lz_; const unsigned Lbz = Lb + lz_;
        if (hf == 0) {
            if (li == 3) { constexpr int PFD = 8, LPT = TILEB / 128, LPB = 2 * LPT / NS; const int rcp = c + PFD - 1;
                if (rcp < 256) { const char* pa_ = nullptr;
                    if (lane < LPB) { const int ln = s * LPB + lane; pa_ = (ln < LPT) ? Kg + (size_t)rcp * TILEB + ln * 128 : Qg + (size_t)rcp * TILEB + (ln - LPT) * 128; }
                    else if (lane >= 16 && lane < 32) pa_ = Vg + (size_t)(lane - 16) * SEQ * 2 + (size_t)rcp * 64;
                    else if (GLA && lane == 32 && s == 0) pa_ = (const char*)(BC + (size_t)(b * SEQ + rcp * 32 + 31) * 512 + h * 128);
                    if (pa_) glds_touch(pa_, (unsigned)__builtin_amdgcn_readfirstlane((int)(Lb + LEND))); } }
            if (li < 2 && c >= 1) { const f32x4 pa = *(const LAS f32x4*)(Lz + LOT + (li * 2) * 1024 + lane * 16), pb = *(const LAS f32x4*)(Lz + LOT + (li * 2 + 1) * 1024 + lane * 16);
                const f32x4 ot = ot_prev + (pa + pb); const int irow = 16 * li + r16;
                if (c >= 2) { const size_t grow = (size_t)b * SEQ + (size_t)(c - 2) * 32 + irow; u32x2 pk; pk.x = cvt_pk_bf16(ot[0], ot[1]); pk.y = cvt_pk_bf16(ot[2], ot[3]);
                    *(u32x2*)(O + grow * LDO + h * DV + 16 * s + 4 * g) = pk; }
                else if (!GLA && b == 0 && irow >= 16) { float* MO = WSP(float, WS_META + META_MO); *(f32x4*)(MO + (size_t)(irow - 16) * 2048 + h * 512 + 16 * s + 4 * g) = ot; } }
            { s16x4 klo[NTU], khi[NTU];
              const bf16x8 vb = *(const LAS bf16x8*)(Lz + LV + st * 1024 + r16 * 64 + ((g ^ ((r16 >> 2) & 3)) << 4));
#pragma unroll
              for (int tt = 0; tt < NTU; ++tt) { const int tile = li + 4 * tt, d0 = 16 * tile, dcol = d0 + 4 * (r16 & 3), chunk = dcol >> 3, sub = (dcol & 7) * 2;
                  const int r1 = 8 * g + (r16 >> 2), r2 = r1 + 4;
                  klo[tt] = ds_tr_asm(Lbz + LK + st * TILEB + r1 * ROWB + ((chunk ^ (r1 & 15)) << 4) + sub);
                  khi[tt] = ds_tr_asm(Lbz + LK + st * TILEB + r2 * ROWB + ((chunk ^ (r2 & 15)) << 4) + sub); }
              asm volatile("s_waitcnt lgkmcnt(0)" ::: "memory"); __builtin_amdgcn_sched_barrier(0);
#pragma unroll
              for (int tt = 0; tt < NTU; ++tt) {
                  const bf16x8 ka = (bf16x8){klo[tt][0], klo[tt][1], klo[tt][2], klo[tt][3], khi[tt][0], khi[tt][1], khi[tt][2], khi[tt][3]};
                  S[tt] = __builtin_amdgcn_mfma_f32_16x16x32_bf16(ka, vb, S[tt], 0, 0, 0); }
#pragma unroll
              for (int tt = 0; tt < NTU; ++tt) { const int tile = li + 4 * tt;
                  if (GLA) { const f32x4 dl = *(const LAS f32x4*)(Lz + LDEC + st * 1024 + (16 * tile + 4 * g) * 4);
                      S[tt][0] *= __expf(dl[0]); S[tt][1] *= __expf(dl[1]); S[tt][2] *= __expf(dl[2]); S[tt][3] *= __expf(dl[3]); } else S[tt] = S[tt] * g32;
                  u32x2 pk; pk.x = cvt_pk_bf16(S[tt][0], S[tt][1]); pk.y = cvt_pk_bf16(S[tt][2], S[tt][3]);
                  *(LAS u32x2*)(Lz + LS + (sb ^ 1) * 16 * ROWB + r16 * ROWB + (((2 * tile + (g >> 1)) ^ r16) << 4) + (g & 1) * 8) = pk; } }
        } else {
            if (c + 2 < NSTEP) S4_ISSUE(c + 2, st2);
            { f32x4 pa = (f32x4){0.f, 0.f, 0.f, 0.f}, pb = pa;
              if (kj <= qi) { const LAS unsigned char* kb = Lz + LK + st * TILEB + (16 * kj + r16) * ROWB; const LAS unsigned char* qb = Lz + LQ + st * TILEB + (16 * qi + r16) * ROWB;
#pragma unroll
                  for (int ks = 0; ks < KS; ks += 2) { const int ch0 = ((4 * ks + g) ^ r16) << 4, ch1 = ((4 * (ks + 1) + g) ^ r16) << 4;
                      const bf16x8 k0 = *(const LAS bf16x8*)(kb + ch0), q0 = *(const LAS bf16x8*)(qb + ch0), k1 = *(const LAS bf16x8*)(kb + ch1), q1 = *(const LAS bf16x8*)(qb + ch1);
                      pa = __builtin_amdgcn_mfma_f32_16x16x32_bf16(k0, q0, pa, 0, 0, 0); pb = __builtin_amdgcn_mfma_f32_16x16x32_bf16(k1, q1, pb, 0, 0, 0); } }
              const f32x4 pt = pa + pb; const int i = 16 * qi + r16, j0 = 16 * kj + 4 * g;
              const float v0 = (j0 + 0 <= i) ? pt[0] : 0.f, v1 = (j0 + 1 <= i) ? pt[1] : 0.f, v2 = (j0 + 2 <= i) ? pt[2] : 0.f, v3 = (j0 + 3 <= i) ? pt[3] : 0.f;
              u32x2 pk; pk.x = cvt_pk_bf16(v0, v1); pk.y = cvt_pk_bf16(v2, v3);
              *(LAS u32x2*)(Lz + LP + i * 64 + (((2 * kj + (g >> 1)) ^ ((i >> 2) & 3)) << 4) + (g & 1) * 8) = pk; }
        }
        LDS_WAIT();
        P2T(2, if (hf == 1) pacc += __builtin_amdgcn_s_memtime() - pt0); P2T(3, if (hf == 0) pacc += __builtin_amdgcn_s_memtime() - pt0);
        P2T(5, pt0 = __builtin_amdgcn_s_memtime());
        __builtin_amdgcn_s_barrier(); asm volatile("" ::: "memory"); __builtin_amdgcn_sched_barrier(0);
        P2T(5, pacc += __builtin_amdgcn_s_memtime() - pt0);
        P2T(4, if (hf == 1) pt0 = __builtin_amdgcn_s_memtime());
        if (hf == 0) {
            if (li < 2) { const int irow = 16 * li + r16;
                const bf16x8 va = *(const LAS bf16x8*)(Lz + LV + st * 1024 + r16 * 64 + ((g ^ ((r16 >> 2) & 3)) << 4));
                const bf16x8 pb = *(const LAS bf16x8*)(Lz + LP + irow * 64 + ((g ^ ((irow >> 2) & 3)) << 4));
                ot_prev = __builtin_amdgcn_mfma_f32_16x16x32_bf16(va, pb, (f32x4){0.f, 0.f, 0.f, 0.f}, 0, 0, 0); }
        } else {
            f32x4 oa = (f32x4){0.f, 0.f, 0.f, 0.f}, ob = oa;
            const LAS unsigned char* sp = Lz + LS + sb * 16 * ROWB + r16 * ROWB; const LAS unsigned char* qb = Lz + LQ + st * TILEB + (16 * qi + r16) * ROWB;
#pragma unroll
            for (int kk = 0; kk < KS / 2; kk += 2) { const int ks = kj * (KS / 2) + kk; const int ch0 = ((4 * ks + g) ^ r16) << 4, ch1 = ((4 * (ks + 1) + g) ^ r16) << 4;
                const bf16x8 s0 = *(const LAS bf16x8*)(sp + ch0), q0 = *(const LAS bf16x8*)(qb + ch0), s1 = *(const LAS bf16x8*)(sp + ch1), q1 = *(const LAS bf16x8*)(qb + ch1);
                oa = __builtin_amdgcn_mfma_f32_16x16x32_bf16(s0, q0, oa, 0, 0, 0); ob = __builtin_amdgcn_mfma_f32_16x16x32_bf16(s1, q1, ob, 0, 0, 0); }
            *(LAS f32x4*)(Lz + LOT + (qi * 2 + kj) * 1024 + lane * 16) = oa + ob;
            P2T(4, pacc += __builtin_amdgcn_s_memtime() - pt0); P2T(1, pt0 = __builtin_amdgcn_s_memtime());
            if (c + 2 < NSTEP) S4_WAIT_PREV(); else S2_WAITV(0);
            P2T(1, pacc += __builtin_amdgcn_s_memtime() - pt0);
        }
        LDS_WAIT(); __builtin_amdgcn_s_barrier(); asm volatile("" ::: "memory"); __builtin_amdgcn_sched_barrier(0);
        st = (st == 2) ? 0 : st + 1;
    }
#if defined(PROBE2)
    if (!GLA && unit == 0) { if (PROBE2 == 0) pacc = __builtin_amdgcn_s_memtime() - ptot0; const int pw = (PROBE2 == 3 || PROBE2 == 5 || PROBE2 == 0) ? 0 : 1; if (w == pw && lane == 0) { volatile LAS unsigned* MI = (volatile LAS unsigned*)(F.lds + LDS_MISC); MI[20] = (unsigned)pacc; MI[21] = (unsigned)(pacc >> 32); } }
#endif
    if (hf == 0 && li < 2) { const f32x4 pa = *(const LAS f32x4*)(L + LOT + (li * 2) * 1024 + lane * 16), pb = *(const LAS f32x4*)(L + LOT + (li * 2 + 1) * 1024 + lane * 16);
        const f32x4 ot = ot_prev + (pa + pb); const int irow = 16 * li + r16;
        const size_t grow = (size_t)b * SEQ + (size_t)(NSTEP - 2) * 32 + irow; u32x2 pk; pk.x = cvt_pk_bf16(ot[0], ot[1]); pk.y = cvt_pk_bf16(ot[2], ot[3]);
        *(u32x2*)(O + grow * LDO + h * DV + 16 * s + 4 * g) = pk; }
#undef S4_ISSUE
#undef S4_WAIT_PREV
}

template <int DK, int DV, bool GLA>
__device__ __forceinline__ void s2v5_phase(Frame& F, const int unit, const bf16_t* QH, const bf16_t* KH, const bf16_t* VT, bf16_t* O, const float* BC, int ldraw) {
    constexpr int NS = DV / 16, ROWB = DK * 2, TILEB = 32 * ROWB, NIL = TILEB / 1024 / 4, NTU = DK / 64, LDO = 4 * DV, KS = DK / 32, NSTEP = 257;
    constexpr int LK = 0, LQ = 2 * TILEB, LV = 4 * TILEB, LDEC = LV + 2 * 1024, LP = LDEC + 2 * 1024, LS = LP + 2048, LOT = LS + 2 * 16 * ROWB, LEND = LOT + 4096;
    static_assert(LEND <= LDS_MISC, "S2 LDS map");
    if (unit >= 8 * NS) return;
    const int bh = unit & 7, s = unit >> 3, b = bh >> 2, h = bh & 3;
    const int lane = F.lane, g = lane >> 4, r16 = lane & 15, w = F.wave, li = w & 3, hf = w >> 2, qi = li >> 1, kj = li & 1;
    LAS unsigned char* L = F.lds; const unsigned Lb = (unsigned)(uintptr_t)L;
    const float* RAW = WSP(float, WS_META + META_RAW);
    const char* Qg = (const char*)(QH + (size_t)bh * SEQ * DK); const char* Kg = (const char*)(KH + (size_t)bh * SEQ * DK);
    const char* Vg = (const char*)(VT + ((size_t)bh * DV + 16 * s) * SEQ);
    u32x4 ra[2 * NIL + 1], rb[2 * NIL + 1];
#pragma unroll
    for (int i = 0; i < 2 * NIL + 1; ++i) { ra[i] = (u32x4){0, 0, 0, 0}; rb[i] = ra[i]; }
#define S5_LOAD(c_, R) do { const int rc_ = ((c_) - 1 < 255) ? (c_) - 1 : 255;     const char* kc_ = Kg + (size_t)rc_ * TILEB; const char* qc_ = Qg + (size_t)rc_ * TILEB; \
        _Pragma("unroll") for (int i_ = 0; i_ < NIL; ++i_) { const int piece_ = li * NIL + i_, off_ = piece_ * 1024 + lane * 16, row_ = off_ / ROWB, p_ = (off_ % ROWB) >> 4; const int so_ = row_ * ROWB + ((p_ ^ (row_ & 15)) << 4); \
            R[i_] = *(const u32x4*)(kc_ + so_); R[NIL + i_] = *(const u32x4*)(qc_ + so_); } \
        if (li == 0) { const int wv_ = lane >> 2, p_ = lane & 3; R[2 * NIL] = *(const u32x4*)(Vg + (size_t)wv_ * SEQ * 2 + (size_t)rc_ * 64 + ((p_ ^ ((wv_ >> 2) & 3)) << 4)); } \
        if (GLA && li == 1) R[2 * NIL] = *(const u32x4*)((const char*)(BC + (size_t)(b * SEQ + rc_ * 32 + 31) * 512 + h * 128) + lane * 16); } while (0)
#define S5_WRITE(st_, R) do { \
        _Pragma("unroll") for (int i_ = 0; i_ < NIL; ++i_) { const int piece_ = li * NIL + i_; \
            *(LAS u32x4*)(L + LK + (st_) * TILEB + piece_ * 1024 + lane * 16) = R[i_]; *(LAS u32x4*)(L + LQ + (st_) * TILEB + piece_ * 1024 + lane * 16) = R[NIL + i_]; } \
        if (li == 0) *(LAS u32x4*)(L + LV + (st_) * 1024 + lane * 16) = R[2 * NIL]; \
        if (GLA && li == 1) *(LAS u32x4*)(L + LDEC + (st_) * 1024 + lane * 16) = R[2 * NIL]; } while (0)
    for (int i = F.tid * 16; i < TILEB; i += NTHREADS * 16) { *(LAS u32x4*)(L + LK + i) = (u32x4){0, 0, 0, 0}; *(LAS u32x4*)(L + LQ + i) = (u32x4){0, 0, 0, 0}; }
    for (int i = F.tid * 16; i < 1024; i += NTHREADS * 16) *(LAS u32x4*)(L + LV + i) = (u32x4){0, 0, 0, 0};
    for (int i = F.tid * 16; i < 16 * ROWB; i += NTHREADS * 16) *(LAS u32x4*)(L + LS + i) = (u32x4){0, 0, 0, 0};
    __syncthreads();
    if (!GLA) {
        for (int idx = F.tid; idx < 16 * 128; idx += NTHREADS) { const int j = idx >> 7, c = idx & 127, row = 16 + j;
            const float* rq = RAW + (size_t)j * ldraw + h * 256; const float* rk = rq + 1024;
            const float rev = ((float)j * ROPE_INV[c]) * 0.15915494309189535f; const float frc = rev - floorf(rev);
            const float sn = __builtin_amdgcn_sinf(frc), cs = __builtin_amdgcn_cosf(frc);
            const float dq = __builtin_amdgcn_exp2f((float)(row + 1) * L2G[h]), dk = 0.0625f * __builtin_amdgcn_exp2f(-(float)(row + 1) * L2G[h]);
            const float q1v = rq[c], q2v = rq[c + 128], k1 = rk[c], k2 = rk[c + 128];
            const int a1 = row * ROWB + ((((c >> 3)) ^ (row & 15)) << 4) + (c & 7) * 2, a2 = row * ROWB + ((((c + 128) >> 3) ^ (row & 15)) << 4) + (c & 7) * 2;
            *(LAS bf16_t*)(L + LQ + a1) = f2bf((q1v * cs - q2v * sn) * dq); *(LAS bf16_t*)(L + LQ + a2) = f2bf((q1v * sn + q2v * cs) * dq);
            *(LAS bf16_t*)(L + LK + a1) = f2bf((k1 * cs - k2 * sn) * dk); *(LAS bf16_t*)(L + LK + a2) = f2bf((k1 * sn + k2 * cs) * dk); }
        if (F.tid < 256) { const int j = F.tid >> 4, wv = F.tid & 15, tok = 16 + j;
            *(LAS bf16_t*)(L + LV + wv * 64 + (((tok >> 3) ^ ((wv >> 2) & 3)) << 4) + (tok & 7) * 2) = f2bf(RAW[(size_t)j * ldraw + 2048 + h * 512 + 16 * s + wv]); }
    } else {
        if (F.tid < 128) { const int d = F.tid; const float* wgp = F.in[13] + h * 128 + d; const float bias = F.in[14][h * 128 + d]; float cum = 0.f;
            for (int j = 0; j < 16; ++j) { float a = bias;
                for (int r = 0; r < 16; ++r) a += RAW[(size_t)j * ldraw + 3072 + r] * wgp[r * 512];
                cum += (fminf(a, 0.f) - __logf(1.0f + __expf(-fabsf(a)))) * 0.0625f;
                const int row = 16 + j;
                *(LAS bf16_t*)(L + LK + row * ROWB + (((d >> 3) ^ (row & 15)) << 4) + (d & 7) * 2) = f2bf(RAW[(size_t)j * ldraw + 512 + h * 128 + d] * __expf(-cum)); }
            *(LAS float*)(L + LDEC + d * 4) = cum; }
        if (F.tid >= 256) { const int j = (F.tid - 256) >> 4, wv = F.tid & 15, tok = 16 + j;
            *(LAS bf16_t*)(L + LV + wv * 64 + (((tok >> 3) ^ ((wv >> 2) & 3)) << 4) + (tok & 7) * 2) = f2bf(RAW[(size_t)j * ldraw + 1024 + h * 256 + 16 * s + wv]); }
    }
    f32x4 S[NTU];
#pragma unroll
    for (int tt = 0; tt < NTU; ++tt) S[tt] = (f32x4){0.f, 0.f, 0.f, 0.f};
    const float g32 = GLA ? 1.0f : __builtin_amdgcn_exp2f(32.0f * L2G[h]);
    __syncthreads();
    if (hf) S5_LOAD(1, rb);
#define S5_ODD(c_, ST, RL, RW) do { const int c = (c_); constexpr int st = (ST), sb = (ST); P3T(1, pt0 = __builtin_amdgcn_s_memtime()); \
        LAS unsigned char* const Lz = L; \
        S5_LOAD(c + 2, RL); P3T(1, pacc += __builtin_amdgcn_s_memtime() - pt0); P3T(2, pt0 = __builtin_amdgcn_s_memtime()); \
        { f32x4 pa = (f32x4){0.f, 0.f, 0.f, 0.f}, pb = pa; \
          if (kj <= qi) { const LAS unsigned char* kb = Lz + LK + st * TILEB + (16 * kj + r16) * ROWB; const LAS unsigned char* qb = Lz + LQ + st * TILEB + (16 * qi + r16) * ROWB; \
              _Pragma("unroll") for (int ks = 0; ks < KS; ks += 2) { const int ch0 = ((4 * ks + g) ^ r16) << 4, ch1 = ((4 * (ks + 1) + g) ^ r16) << 4; \
                  const bf16x8 k0 = *(const LAS bf16x8*)(kb + ch0), q0 = *(const LAS bf16x8*)(qb + ch0), k1 = *(const LAS bf16x8*)(kb + ch1), q1 = *(const LAS bf16x8*)(qb + ch1); \
                  pa = __builtin_amdgcn_mfma_f32_16x16x32_bf16(k0, q0, pa, 0, 0, 0); pb = __builtin_amdgcn_mfma_f32_16x16x32_bf16(k1, q1, pb, 0, 0, 0); } } \
          const f32x4 pt = pa + pb; const int i = 16 * qi + r16, j0 = 16 * kj + 4 * g; \
          const float v0 = (j0 + 0 <= i) ? pt[0] : 0.f, v1 = (j0 + 1 <= i) ? pt[1] : 0.f, v2 = (j0 + 2 <= i) ? pt[2] : 0.f, v3 = (j0 + 3 <= i) ? pt[3] : 0.f; \
          u32x2 pk; pk.x = cvt_pk_bf16(v0, v1); pk.y = cvt_pk_bf16(v2, v3); \
          *(LAS u32x2*)(Lz + LP + i * 64 + (((2 * kj + (g >> 1)) ^ ((i >> 2) & 3)) << 4) + (g & 1) * 8) = pk; } \
        LDS_WAIT(); P3T(2, pacc += __builtin_amdgcn_s_memtime() - pt0); P3T(3, pt0 = __builtin_amdgcn_s_memtime()); __builtin_amdgcn_s_barrier(); asm volatile("" ::: "memory"); P3T(3, pacc += __builtin_amdgcn_s_memtime() - pt0); P3T(4, pt0 = __builtin_amdgcn_s_memtime()); \
        P3T(4, pacc += __builtin_amdgcn_s_memtime() - pt0); P3T(5, pt0 = __builtin_amdgcn_s_memtime()); S5_WRITE(st ^ 1, RW); \
        LDS_WAIT(); P3T(5, pacc += __builtin_amdgcn_s_memtime() - pt0); P3T(6, pt0 = __builtin_amdgcn_s_memtime()); __builtin_amdgcn_s_barrier(); asm volatile("" ::: "memory"); P3T(6, pacc += __builtin_amdgcn_s_memtime() - pt0); \
    } while (0)
#define S5_EVEN(c_, ST) do { const int c = (c_); constexpr int st = (ST), sb = (ST); P3T(7, pt0 = __builtin_amdgcn_s_memtime()); \
        LAS unsigned char* const Lz = L; const unsigned Lbz = Lb; \
        P3T(7, pacc += __builtin_amdgcn_s_memtime() - pt0); P3T(8, pt0 = __builtin_amdgcn_s_memtime()); \
        { s16x4 klo[NTU], khi[NTU]; \
          const bf16x8 vb = *(const LAS bf16x8*)(Lz + LV + st * 1024 + r16 * 64 + ((g ^ ((r16 >> 2) & 3)) << 4)); \
          _Pragma("unroll") for (int tt = 0; tt < NTU; ++tt) { const int tile = li + 4 * tt, d0 = 16 * tile, dcol = d0 + 4 * (r16 & 3), chunk = dcol >> 3, sub = (dcol & 7) * 2; \
              const int r1 = 8 * g + (r16 >> 2), r2 = r1 + 4; \
              klo[tt] = ds_tr_asm(Lbz + LK + st * TILEB + r1 * ROWB + ((chunk ^ (r1 & 15)) << 4) + sub); \
              khi[tt] = ds_tr_asm(Lbz + LK + st * TILEB + r2 * ROWB + ((chunk ^ (r2 & 15)) << 4) + sub); } \
          asm volatile("s_waitcnt lgkmcnt(0)" ::: "memory"); __builtin_amdgcn_sched_barrier(0); \
          _Pragma("unroll") for (int tt = 0; tt < NTU; ++tt) { \
              const bf16x8 ka = (bf16x8){klo[tt][0], klo[tt][1], klo[tt][2], klo[tt][3], khi[tt][0], khi[tt][1], khi[tt][2], khi[tt][3]}; \
              S[tt] = __builtin_amdgcn_mfma_f32_16x16x32_bf16(ka, vb, S[tt], 0, 0, 0); } \
          _Pragma("unroll") for (int tt = 0; tt < NTU; ++tt) { const int tile = li + 4 * tt; \
              if (GLA) { const f32x4 dl = *(const LAS f32x4*)(Lz + LDEC + st * 1024 + (16 * tile + 4 * g) * 4); \
                  S[tt][0] *= __expf(dl[0]); S[tt][1] *= __expf(dl[1]); S[tt][2] *= __expf(dl[2]); S[tt][3] *= __expf(dl[3]); } else S[tt] = S[tt] * g32; \
              u32x2 pk; pk.x = cvt_pk_bf16(S[tt][0], S[tt][1]); pk.y = cvt_pk_bf16(S[tt][2], S[tt][3]); \
              *(LAS u32x2*)(Lz + LS + (sb ^ 1) * 16 * ROWB + r16 * ROWB + (((2 * tile + (g >> 1)) ^ r16) << 4) + (g & 1) * 8) = pk; } } \
        LDS_WAIT(); P3T(8, pacc += __builtin_amdgcn_s_memtime() - pt0); P3T(9, pt0 = __builtin_amdgcn_s_memtime()); __builtin_amdgcn_s_barrier(); asm volatile("" ::: "memory"); P3T(9, pacc += __builtin_amdgcn_s_memtime() - pt0); P3T(10, pt0 = __builtin_amdgcn_s_memtime()); \
        if (li < 2) { const int irow = 16 * li + r16;        \
            const bf16x8 va = *(const LAS bf16x8*)(Lz + LV + st * 1024 + r16 * 64 + ((g ^ ((r16 >> 2) & 3)) << 4)); \
            const bf16x8 pb = *(const LAS bf16x8*)(Lz + LP + irow * 64 + ((g ^ ((irow >> 2) & 3)) << 4)); \
            f32x4 oa = __builtin_amdgcn_mfma_f32_16x16x32_bf16(va, pb, (f32x4){0.f, 0.f, 0.f, 0.f}, 0, 0, 0), ob = (f32x4){0.f, 0.f, 0.f, 0.f}; \
            const LAS unsigned char* sp = Lz + LS + sb * 16 * ROWB + r16 * ROWB; const LAS unsigned char* qb = Lz + LQ + st * TILEB + irow * ROWB; \
            _Pragma("unroll") for (int ks = 0; ks < KS; ks += 2) { const int ch0 = ((4 * ks + g) ^ r16) << 4, ch1 = ((4 * (ks + 1) + g) ^ r16) << 4; \
                const bf16x8 s0 = *(const LAS bf16x8*)(sp + ch0), q0 = *(const LAS bf16x8*)(qb + ch0), s1 = *(const LAS bf16x8*)(sp + ch1), q1 = *(const LAS bf16x8*)(qb + ch1); \
                oa = __builtin_amdgcn_mfma_f32_16x16x32_bf16(s0, q0, oa, 0, 0, 0); ob = __builtin_amdgcn_mfma_f32_16x16x32_bf16(s1, q1, ob, 0, 0, 0); } \
            const f32x4 ot = oa + ob; \
            if (c >= 1) { const size_t grow = (size_t)b * SEQ + (size_t)(c - 1) * 32 + irow; u32x2 pk; pk.x = cvt_pk_bf16(ot[0], ot[1]); pk.y = cvt_pk_bf16(ot[2], ot[3]); \
                *(u32x2*)(O + grow * LDO + h * DV + 16 * s + 4 * g) = pk; } \
            else if (!GLA && b == 0 && irow >= 16) { float* MO = WSP(float, WS_META + META_MO); *(f32x4*)(MO + (size_t)(irow - 16) * 2048 + h * 512 + 16 * s + 4 * g) = ot; } } \
        LDS_WAIT(); P3T(10, pacc += __builtin_amdgcn_s_memtime() - pt0); P3T(11, pt0 = __builtin_amdgcn_s_memtime()); __builtin_amdgcn_s_barrier(); asm volatile("" ::: "memory"); P3T(11, pacc += __builtin_amdgcn_s_memtime() - pt0); \
    } while (0)
#if defined(PROBE3)
    unsigned long long pacc = 0ull, pt0 = 0ull;
#define P3T(q, stmt) do { if (PROBE3 == (q) && !GLA) { stmt; } } while (0)
#else
#define P3T(q, stmt) do {} while (0)
#endif
    if (hf) {
        for (int c2 = 0; c2 < 256; c2 += 2) { S5_ODD(c2, 0, ra, rb); S5_ODD(c2 + 1, 1, rb, ra); }
        S5_ODD(256, 0, ra, rb);
#if defined(PROBE3)
        if (!GLA && PROBE3 < 7 && unit == 0 && w == 5 && lane == 0) { volatile LAS unsigned* MI = (volatile LAS unsigned*)(F.lds + LDS_MISC); MI[20] = (unsigned)pacc; MI[21] = (unsigned)(pacc >> 32); }
#endif
    } else {
        for (int c2 = 0; c2 < 256; c2 += 2) { S5_EVEN(c2, 0); S5_EVEN(c2 + 1, 1); }
        S5_EVEN(256, 0);
#if defined(PROBE3)
        if (!GLA && PROBE3 >= 7 && unit == 0 && w == 0 && lane == 0) { volatile LAS unsigned* MI = (volatile LAS unsigned*)(F.lds + LDS_MISC); MI[20] = (unsigned)pacc; MI[21] = (unsigned)(pacc >> 32); }
#endif
    }
#undef S5_ODD
#undef S5_EVEN
#undef S5_LOAD
#undef S5_WRITE
}

template <int DK, int DV, bool GLA>
__device__ __forceinline__ void s2v6_phase(Frame& F, const int unit, const bf16_t* QH, const bf16_t* KH, const bf16_t* VT, bf16_t* O, const float* BC, int ldraw) {
    constexpr int NS = DV / 16, ROWB = DK * 2, TILEB = 32 * ROWB, NIL = TILEB / 1024 / 4, LDO = 4 * DV, KS = DK / 32, NSTEP = 257, NLO = DK / 128, NHI = DK / 32 - NLO;
    constexpr int LK = 0, LQ = 3 * TILEB, LV = 6 * TILEB, LDEC = LV + 3 * 1024, LP = LDEC + 3 * 1024, LS = LP + 2 * 2048, LEND = LS + 2 * 16 * ROWB;
    static_assert(LEND <= LDS_MISC, "S2 LDS map");
    if (unit >= 8 * NS) return;
    const int bh = unit & 7, s = unit >> 3, b = bh >> 2, h = bh & 3;
    const int lane = F.lane, g = lane >> 4, r16 = lane & 15, w = F.wave, li = w & 3, hf = w >> 2, qi = li >> 1, kj = li & 1;
    LAS unsigned char* L = F.lds; const unsigned Lb = (unsigned)(uintptr_t)L;
    const float* RAW = WSP(float, WS_META + META_RAW);
    const char* Qg = (const char*)(QH + (size_t)bh * SEQ * DK); const char* Kg = (const char*)(KH + (size_t)bh * SEQ * DK);
    const char* Vg = (const char*)(VT + ((size_t)bh * DV + 16 * s) * SEQ);
    u32x4 ra[2 * NIL + 1], rb[2 * NIL + 1], rc[2 * NIL + 1];
#pragma unroll
    for (int i = 0; i < 2 * NIL + 1; ++i) { ra[i] = (u32x4){0, 0, 0, 0}; rb[i] = ra[i]; rc[i] = ra[i]; }
#define S6_LOAD(c_, R) do { const int rc_ = ((c_) - 1 < 255) ? (c_) - 1 : 255; const char* kc_ = Kg + (size_t)rc_ * TILEB; const char* qc_ = Qg + (size_t)rc_ * TILEB; \
        _Pragma("unroll") for (int i_ = 0; i_ < NIL; ++i_) { const int piece_ = li * NIL + i_, off_ = piece_ * 1024 + lane * 16, row_ = off_ / ROWB, p_ = (off_ % ROWB) >> 4; const int so_ = row_ * ROWB + ((p_ ^ (row_ & 15)) << 4); \
            R[i_] = *(const u32x4*)(kc_ + so_); R[NIL + i_] = *(const u32x4*)(qc_ + so_); } \
        if (li == 0) { const int wv_ = lane >> 2, p_ = lane & 3; R[2 * NIL] = *(const u32x4*)(Vg + (size_t)wv_ * SEQ * 2 + (size_t)rc_ * 64 + ((p_ ^ ((wv_ >> 2) & 3)) << 4)); } \
        if (GLA && li == 1) R[2 * NIL] = *(const u32x4*)((const char*)(BC + (size_t)(b * SEQ + rc_ * 32 + 31) * 512 + h * 128) + lane * 16); } while (0)
#define S6_WRITE(st_, R) do { \
        _Pragma("unroll") for (int i_ = 0; i_ < NIL; ++i_) { const int piece_ = li * NIL + i_; \
            *(LAS u32x4*)(L + LK + (st_) * TILEB + piece_ * 1024 + lane * 16) = R[i_]; *(LAS u32x4*)(L + LQ + (st_) * TILEB + piece_ * 1024 + lane * 16) = R[NIL + i_]; } \
        if (li == 0) *(LAS u32x4*)(L + LV + (st_) * 1024 + lane * 16) = R[2 * NIL]; \
        if (GLA && li == 1) *(LAS u32x4*)(L + LDEC + (st_) * 1024 + lane * 16) = R[2 * NIL]; } while (0)
#define S6_PT(st_, pb_) do { f32x4 pa = (f32x4){0.f, 0.f, 0.f, 0.f}, pc = pa; \
        if (kj <= qi) { const LAS unsigned char* kb = L + LK + (st_) * TILEB + (16 * kj + r16) * ROWB; const LAS unsigned char* qb = L + LQ + (st_) * TILEB + (16 * qi + r16) * ROWB; \
            _Pragma("unroll") for (int ks = 0; ks < KS; ks += 2) { const int ch0 = ((4 * ks + g) ^ r16) << 4, ch1 = ((4 * (ks + 1) + g) ^ r16) << 4; \
                const bf16x8 k0 = *(const LAS bf16x8*)(kb + ch0), q0 = *(const LAS bf16x8*)(qb + ch0), k1 = *(const LAS bf16x8*)(kb + ch1), q1 = *(const LAS bf16x8*)(qb + ch1); \
                pa = __builtin_amdgcn_mfma_f32_16x16x32_bf16(k0, q0, pa, 0, 0, 0); pc = __builtin_amdgcn_mfma_f32_16x16x32_bf16(k1, q1, pc, 0, 0, 0); } } \
        const f32x4 pt = pa + pc; const int i = 16 * qi + r16, j0 = 16 * kj + 4 * g; \
        const float v0 = (j0 + 0 <= i) ? pt[0] : 0.f, v1 = (j0 + 1 <= i) ? pt[1] : 0.f, v2 = (j0 + 2 <= i) ? pt[2] : 0.f, v3 = (j0 + 3 <= i) ? pt[3] : 0.f; \
        u32x2 pk; pk.x = cvt_pk_bf16(v0, v1); pk.y = cvt_pk_bf16(v2, v3); \
        *(LAS u32x2*)(L + LP + (pb_) * 2048 + i * 64 + (((2 * kj + (g >> 1)) ^ ((i >> 2) & 3)) << 4) + (g & 1) * 8) = pk; } while (0)
    for (int i = F.tid * 16; i < TILEB; i += NTHREADS * 16) { *(LAS u32x4*)(L + LK + i) = (u32x4){0, 0, 0, 0}; *(LAS u32x4*)(L + LQ + i) = (u32x4){0, 0, 0, 0}; }
    for (int i = F.tid * 16; i < 1024; i += NTHREADS * 16) *(LAS u32x4*)(L + LV + i) = (u32x4){0, 0, 0, 0};
    for (int i = F.tid * 16; i < 16 * ROWB; i += NTHREADS * 16) *(LAS u32x4*)(L + LS + i) = (u32x4){0, 0, 0, 0};
    __syncthreads();
    if (!GLA) {
        for (int idx = F.tid; idx < 16 * 128; idx += NTHREADS) { const int j = idx >> 7, c = idx & 127, row = 16 + j;
            const float* rq = RAW + (size_t)j * ldraw + h * 256; const float* rk = rq + 1024;
            const float rev = ((float)j * ROPE_INV[c]) * 0.15915494309189535f; const float frc = rev - floorf(rev);
            const float sn = __builtin_amdgcn_sinf(frc), cs = __builtin_amdgcn_cosf(frc);
            const float dq = __builtin_amdgcn_exp2f((float)(row + 1) * L2G[h]), dk = 0.0625f * __builtin_amdgcn_exp2f(-(float)(row + 1) * L2G[h]);
            const float q1v = rq[c], q2v = rq[c + 128], k1 = rk[c], k2 = rk[c + 128];
            const int a1 = row * ROWB + ((((c >> 3)) ^ (row & 15)) << 4) + (c & 7) * 2, a2 = row * ROWB + ((((c + 128) >> 3) ^ (row & 15)) << 4) + (c & 7) * 2;
            *(LAS bf16_t*)(L + LQ + a1) = f2bf((q1v * cs - q2v * sn) * dq); *(LAS bf16_t*)(L + LQ + a2) = f2bf((q1v * sn + q2v * cs) * dq);
            *(LAS bf16_t*)(L + LK + a1) = f2bf((k1 * cs - k2 * sn) * dk); *(LAS bf16_t*)(L + LK + a2) = f2bf((k1 * sn + k2 * cs) * dk); }
        if (F.tid < 256) { const int j = F.tid >> 4, wv = F.tid & 15, tok = 16 + j;
            *(LAS bf16_t*)(L + LV + wv * 64 + (((tok >> 3) ^ ((wv >> 2) & 3)) << 4) + (tok & 7) * 2) = f2bf(RAW[(size_t)j * ldraw + 2048 + h * 512 + 16 * s + wv]); }
    } else {
        if (F.tid < 128) { const int d = F.tid; const float* wgp = F.in[13] + h * 128 + d; const float bias = F.in[14][h * 128 + d]; float cum = 0.f;
            for (int j = 0; j < 16; ++j) { float a = bias;
                for (int r = 0; r < 16; ++r) a += RAW[(size_t)j * ldraw + 3072 + r] * wgp[r * 512];
                cum += (fminf(a, 0.f) - __logf(1.0f + __expf(-fabsf(a)))) * 0.0625f;
                const int row = 16 + j;
                *(LAS bf16_t*)(L + LK + row * ROWB + (((d >> 3) ^ (row & 15)) << 4) + (d & 7) * 2) = f2bf(RAW[(size_t)j * ldraw + 512 + h * 128 + d] * __expf(-cum)); }
            *(LAS float*)(L + LDEC + d * 4) = cum; }
        if (F.tid >= 256) { const int j = (F.tid - 256) >> 4, wv = F.tid & 15, tok = 16 + j;
            *(LAS bf16_t*)(L + LV + wv * 64 + (((tok >> 3) ^ ((wv >> 2) & 3)) << 4) + (tok & 7) * 2) = f2bf(RAW[(size_t)j * ldraw + 1024 + h * 256 + 16 * s + wv]); }
    }
    const float g32 = GLA ? 1.0f : __builtin_amdgcn_exp2f(32.0f * L2G[h]);
    if (hf) { S6_LOAD(1, ra); S6_WRITE(1, ra); }
    __syncthreads();
    if (hf) { S6_PT(0, 0); S6_LOAD(2, rb); S6_LOAD(3, rc); }
    __syncthreads();
    if (hf) {
#define S6_ODD(t_, RL, RW) do { const int t = (t_); S6_LOAD(t + 4, RL); if (t + 1 < NSTEP) S6_PT(s1, (t + 1) & 1); S6_WRITE(s2, RW); \
            LDS_WAIT(); __builtin_amdgcn_s_barrier(); asm volatile("" ::: "memory"); { const int o_ = s0; s0 = s1; s1 = s2; s2 = o_; } } while (0)
        int s0 = 0, s1 = 1, s2 = 2;
        for (int t3 = 0; t3 < 255; t3 += 3) { S6_ODD(t3, ra, rb); S6_ODD(t3 + 1, rb, rc); S6_ODD(t3 + 2, rc, ra); }
        S6_ODD(255, ra, rb); S6_ODD(256, rb, rc);
#undef S6_ODD
    } else {
        f32x4 S[NHI];
#pragma unroll
        for (int tt = 0; tt < NHI; ++tt) S[tt] = (f32x4){0.f, 0.f, 0.f, 0.f};
        int s0 = 0;
        for (int t = 0; t < NSTEP; ++t) { const int sb = t & 1;
            { s16x4 klo[NHI], khi[NHI];
              const bf16x8 vb = *(const LAS bf16x8*)(L + LV + s0 * 1024 + r16 * 64 + ((g ^ ((r16 >> 2) & 3)) << 4));
#pragma unroll
              for (int tt = 0; tt < NHI; ++tt) if (li >= 2 || tt < NLO) { const int tile = (li < 2) ? li + 2 * tt : 2 * NLO + (li - 2) + 2 * tt, d0 = 16 * tile, dcol = d0 + 4 * (r16 & 3), chunk = dcol >> 3, sub = (dcol & 7) * 2;
                  const int r1 = 8 * g + (r16 >> 2), r2 = r1 + 4;
                  klo[tt] = ds_tr_asm(Lb + LK + s0 * TILEB + r1 * ROWB + ((chunk ^ (r1 & 15)) << 4) + sub);
                  khi[tt] = ds_tr_asm(Lb + LK + s0 * TILEB + r2 * ROWB + ((chunk ^ (r2 & 15)) << 4) + sub); }
              asm volatile("s_waitcnt lgkmcnt(0)" ::: "memory"); __builtin_amdgcn_sched_barrier(0);
#pragma unroll
              for (int tt = 0; tt < NHI; ++tt) if (li >= 2 || tt < NLO) {
                  const bf16x8 ka = (bf16x8){klo[tt][0], klo[tt][1], klo[tt][2], klo[tt][3], khi[tt][0], khi[tt][1], khi[tt][2], khi[tt][3]};
                  S[tt] = __builtin_amdgcn_mfma_f32_16x16x32_bf16(ka, vb, S[tt], 0, 0, 0); }
#pragma unroll
              for (int tt = 0; tt < NHI; ++tt) if (li >= 2 || tt < NLO) { const int tile = (li < 2) ? li + 2 * tt : 2 * NLO + (li - 2) + 2 * tt;
                  if (GLA) { const f32x4 dl = *(const LAS f32x4*)(L + LDEC + s0 * 1024 + (16 * tile + 4 * g) * 4);
                      S[tt][0] *= __expf(dl[0]); S[tt][1] *= __expf(dl[1]); S[tt][2] *= __expf(dl[2]); S[tt][3] *= __expf(dl[3]); } else S[tt] = S[tt] * g32;
                  u32x2 pk; pk.x = cvt_pk_bf16(S[tt][0], S[tt][1]); pk.y = cvt_pk_bf16(S[tt][2], S[tt][3]);
                  *(LAS u32x2*)(L + LS + (sb ^ 1) * 16 * ROWB + r16 * ROWB + (((2 * tile + (g >> 1)) ^ r16) << 4) + (g & 1) * 8) = pk; } }
            if (li < 2) { const int irow = 16 * li + r16;
                const bf16x8 va = *(const LAS bf16x8*)(L + LV + s0 * 1024 + r16 * 64 + ((g ^ ((r16 >> 2) & 3)) << 4));
                const bf16x8 pb = *(const LAS bf16x8*)(L + LP + sb * 2048 + irow * 64 + ((g ^ ((irow >> 2) & 3)) << 4));
                f32x4 oa = __builtin_amdgcn_mfma_f32_16x16x32_bf16(va, pb, (f32x4){0.f, 0.f, 0.f, 0.f}, 0, 0, 0), ob = (f32x4){0.f, 0.f, 0.f, 0.f};
                const LAS unsigned char* sp = L + LS + sb * 16 * ROWB + r16 * ROWB; const LAS unsigned char* qb = L + LQ + s0 * TILEB + irow * ROWB;
#pragma unroll
                for (int ks = 0; ks < KS; ks += 2) { const int ch0 = ((4 * ks + g) ^ r16) << 4, ch1 = ((4 * (ks + 1) + g) ^ r16) << 4;
                    const bf16x8 sv0 = *(const LAS bf16x8*)(sp + ch0), q0 = *(const LAS bf16x8*)(qb + ch0), sv1 = *(const LAS bf16x8*)(sp + ch1), q1 = *(const LAS bf16x8*)(qb + ch1);
                    oa = __builtin_amdgcn_mfma_f32_16x16x32_bf16(sv0, q0, oa, 0, 0, 0); ob = __builtin_amdgcn_mfma_f32_16x16x32_bf16(sv1, q1, ob, 0, 0, 0); }
                const f32x4 ot = oa + ob;
                if (t >= 1) { const size_t grow = (size_t)b * SEQ + (size_t)(t - 1) * 32 + irow; u32x2 pk; pk.x = cvt_pk_bf16(ot[0], ot[1]); pk.y = cvt_pk_bf16(ot[2], ot[3]);
                    *(u32x2*)(O + grow * LDO + h * DV + 16 * s + 4 * g) = pk; }
                else if (!GLA && b == 0 && irow >= 16) { float* MO = WSP(float, WS_META + META_MO); *(f32x4*)(MO + (size_t)(irow - 16) * 2048 + h * 512 + 16 * s + 4 * g) = ot; } }
            LDS_WAIT(); __builtin_amdgcn_s_barrier(); asm volatile("" ::: "memory");
            s0 = (s0 == 2) ? 0 : s0 + 1;
        }
    }
#undef S6_LOAD
#undef S6_WRITE
#undef S6_PT
}

__device__ __forceinline__ void final_phase(Frame& F, const float* SS, const float* gain) {
    const int gw = F.vcu * NWAVES + F.wave, NGW = F.G * NWAVES; const bf16_t* HB = WSP(bf16_t, WS_HB);
    f32x4 gv[4];
#pragma unroll
    for (int j = 0; j < 4; ++j) gv[j] = *(const f32x4*)(gain + 4 * F.lane + 256 * j);
    for (int m = gw; m < M; m += NGW) { float* row = F.out + (size_t)m * D; const float rs = row_rstd(SS, m);
#pragma unroll
        for (int j = 0; j < 4; ++j) { const u32x2 hv = *(const u32x2*)(HB + (size_t)m * D + 4 * F.lane + 256 * j);
            f32x4 v = (f32x4){bf_lo(hv.x), bf_hi(hv.x), bf_lo(hv.y), bf_hi(hv.y)}; v = v * rs * gv[j]; *(f32x4*)(row + 4 * F.lane + 256 * j) = v; } }
}
__device__ __forceinline__ void p0_rows(Frame& F) {
    const int gw = F.vcu * NWAVES + F.wave, NGW = F.G * NWAVES; const float* x = F.in[0]; bf16_t* HB = WSP(bf16_t, WS_HB); float* SS = WSP(float, WS_SS);
    for (int m = gw; m < M; m += 2 * NGW) { const int m2 = m + NGW;
        f32x4 va[4], vb[4];
#pragma unroll
        for (int j = 0; j < 4; ++j) { va[j] = *(const f32x4*)(x + (size_t)m * D + 4 * F.lane + 256 * j); vb[j] = *(const f32x4*)(x + (size_t)m2 * D + 4 * F.lane + 256 * j); }
        float s = 0.f, s2 = 0.f;
#pragma unroll
        for (int j = 0; j < 4; ++j) { const f32x4 v = va[j], u = vb[j]; s += (v[0] * v[0] + v[1] * v[1]) + (v[2] * v[2] + v[3] * v[3]); s2 += (u[0] * u[0] + u[1] * u[1]) + (u[2] * u[2] + u[3] * u[3]);
            u32x2 pk; pk.x = cvt_pk_bf16(v[0], v[1]); pk.y = cvt_pk_bf16(v[2], v[3]); *(u32x2*)(HB + (size_t)m * D + 4 * F.lane + 256 * j) = pk;
            pk.x = cvt_pk_bf16(u[0], u[1]); pk.y = cvt_pk_bf16(u[2], u[3]); *(u32x2*)(HB + (size_t)m2 * D + 4 * F.lane + 256 * j) = pk; }
        s = wave_sum(s); s2 = wave_sum(s2);
        if (F.lane < 16) { SS[(size_t)m * 16 + F.lane] = F.lane == 0 ? s : 0.f; SS[(size_t)m2 * 16 + F.lane] = F.lane == 0 ? s2 : 0.f; } }
    if (blockIdx.x == 0) { float* HM = WSP(float, WS_META + META_HM); for (int i = F.tid; i < 16 * D; i += NTHREADS) HM[i] = F.in[1][i]; }
}

#ifndef S2FN
#define S2FN s2v6_phase
#endif
struct Args { const float* in[18]; float* out; unsigned char* ws; int ph_lo, ph_hi; };
constexpr int N_PHASES = 19;
__global__ void __launch_bounds__(NTHREADS, 2) fwd(Args args) {
    extern __shared__ __attribute__((aligned(16))) unsigned char lds_raw[];
    Frame F;
    F.lds = (LAS unsigned char*)lds_raw;
    F.tid = threadIdx.x; F.lane = F.tid & 63; F.wave = __builtin_amdgcn_readfirstlane(F.tid >> 6);
    F.G = gridDim.x; { const int bx = blockIdx.x; F.vcu = (F.G % 8 == 0) ? (bx % 8) * (F.G / 8) + bx / 8 : bx; }
    F.ws = args.ws; F.out = args.out;
#pragma unroll
    for (int i = 0; i < 18; ++i) F.in[i] = args.in[i];
    volatile LAS unsigned* MISC = (volatile LAS unsigned*)(F.lds + LDS_MISC);
    if (F.tid < 64) MISC[F.tid] = 0u;
    __syncthreads();
    XcdBarrier bar = xcd_barrier_post(WSP(unsigned, WS_CTL) + CW_BAR, MISC + 8);
    const int lo = args.ph_lo, hi = args.ph_hi;
    __syncthreads();
    F.vb = (int)blockIdx.x;
    int vblk = (int)blockIdx.x;
#define IN(k) (lo <= (k) && (k) < hi)
#if defined(PROBE_PHASE)
    unsigned long long t_prev = __builtin_amdgcn_s_memrealtime(), t_probe = 0ull;
#define SEAM(k) do { if (IN(k) && IN((k) + 1)) xcd_barrier(bar); { const unsigned long long t_now = __builtin_amdgcn_s_memrealtime(); if ((k) == PROBE_PHASE) t_probe = t_now - t_prev; t_prev = t_now; } } while (0)
#else
#define SEAM(k) do { if (IN(k) && IN((k) + 1)) xcd_barrier(bar); } while (0)
#endif
    bf16_t* HB = WSP(bf16_t, WS_HB); float* SS = WSP(float, WS_SS); float* H = F.out;
    bf16_t* ACT = WSP(bf16_t, WS_ACT);
    const int gw = F.vcu * NWAVES + F.wave, NGW = F.G * NWAVES;
    float* RAW = WSP(float, WS_META + META_RAW); float* HM = WSP(float, WS_META + META_HM);

#define FFN_IN(win, do_meta) do { \
        if ((do_meta) && meta_has_tiles(F, 2 * DFF, 128, 128)) { meta_prep_h(F); meta_tiles<0>(F, WSP(bf16_t, (win)), 2 * DFF, D, RAW, 2 * DFF, 1.f, 128, 128); } \
        pg8::Order S_; S_.init(M / 256, 22, F.G, vblk); PtrNormal P_{(const char*)HB, (const char*)WSP(bf16_t, (win)), (size_t)256 * D * 2}; \
        EpiSwiglu E_{SS, ACT}; pg8::gemm_phase(F.lds, D, S_, P_, E_); } while (0)
#define FFN_OUT(woutp, do_meta, F32B) do { const bf16_t* wo_ = (woutp); \
        if (do_meta) { meta_prep_act_q(F); meta_tiles_ksplit(F, wo_, DFF, 704, HM, 0.5f); } \
        pg8::Order S_; S_.init(M / 256, 4, F.G, vblk); PtrNormal P_{(const char*)ACT, (const char*)wo_, (size_t)256 * DFF * 2}; \
        EpiResid<F32B> E_{F.in[0], HB, SS, 0.5f}; pg8::gemm_phase(F.lds, DFF, S_, P_, E_); } while (0)

#define slack (vblk >= 128)
#define sgw ((vblk - 128) * NWAVES + F.wave)
    const int SNGW = 128 * NWAVES;
    if (IN(0)) {
        int cb = conv_job(F, job_ffn_in(F, 0, 0, WS_WFFN_A + WF_IN), 0, gw, NGW); cb = conv_job(F, job_ffn_out(F, 0, 0, WS_WFFN_A + WF_OUT), cb, gw, NGW);
        p0_rows(F);
    }
    SEAM(0);
    if (lo == 0 && hi == N_PHASES && F.G == 256) {
        const unsigned* barw = WSP(unsigned, WS_CTL) + CW_BAR; bool ok = true;
#pragma unroll
        for (int j = 0; j < 8; ++j) ok = ok && (__hip_atomic_load(barw + XB_XCNT(j), __ATOMIC_RELAXED, __HIP_MEMORY_SCOPE_AGENT) == 32u);
        const unsigned rank = MISC[10], xcc = MISC[11];
        if (ok && rank < 32u && xcc < 8u) vblk = (int)(rank * 8u + xcc);
    }
    F.vb = vblk;
    if (IN(1)) {
        if (slack) { ConvJob J;
            J.W = F.in[9]; J.ldn = 6144; J.K = D; J.N = 6144; J.col0 = 0; J.kind = 0; J.gain = F.in[5]; J.WT = WSP(bf16_t, WS_WMIX + WM_RET_IN);
            int cb = conv_job(F, J, 0, sgw, SNGW);
            J.W = F.in[11]; J.ldn = D; J.K = 2048; J.N = D; J.col0 = 0; J.kind = 0; J.gain = F.in[10]; J.WT = WSP(bf16_t, WS_WMIX + WM_RET_OUT);
            cb = conv_job(F, J, cb, sgw, SNGW);
            cb = conv_job(F, job_ffn_in(F, 0, 1, WS_WFFN_C), cb, sgw, SNGW);
            { ConvJob J2 = job_ffn_out(F, 0, 1, 0); J2.WT = (bf16_t*)F.out; cb = conv_job(F, J2, cb, sgw, SNGW); }
            __syncthreads(); }
        FFN_IN(WS_WFFN_A + WF_IN, true);
    }
    SEAM(1);
    if (IN(2)) FFN_OUT(WSP(bf16_t, WS_WFFN_A + WF_OUT), true, false);
    SEAM(2);
    if (IN(3)) {
        if (meta_has_tiles(F, 6144, 0, 256)) { meta_prep_h(F); meta_tiles<0>(F, WSP(bf16_t, WS_WMIX + WM_RET_IN), 6144, D, RAW, 6144, 1.f, 0, 256); }
        pg8::Order S_; S_.init(M / 256, 16, F.G, vblk);
        PtrSwapFrom P_{(const char*)HB, (const char*)WSP(bf16_t, WS_WMIX + WM_RET_IN), (size_t)256 * D * 2, 8};
        EpiRetIn E_{SS, WSP(bf16_t, WS_QH), WSP(bf16_t, WS_KH), WSP(bf16_t, WS_VT)}; pg8::gemm_phase(F.lds, D, S_, P_, E_);
    }
    SEAM(3);
    if (IN(4)) S2FN<256, 512, false>(F, vblk, WSP(bf16_t, WS_QH), WSP(bf16_t, WS_KH), WSP(bf16_t, WS_VT), WSP(bf16_t, WS_O), nullptr, 6144);
    SEAM(4);
    if (IN(5)) {
        pg8::Order S_; S_.init(M / 256, 8, F.G, vblk); PtrNormal P_{(const char*)HB, (const char*)(WSP(bf16_t, WS_WMIX + WM_RET_IN) + (size_t)4096 * D), (size_t)256 * D * 2};
        EpiGate<512, 2048> E_{SS, WSP(bf16_t, WS_O), WSP(bf16_t, WS_VT), (LAS float*)(F.lds + 132096)}; pg8::gemm_phase(F.lds, D, S_, P_, E_);
    }
    SEAM(5);
    if (IN(6)) {
        { meta_prep_y_q(F); meta_tiles_ksplit(F, WSP(bf16_t, WS_WMIX + WM_RET_OUT), 2048, 512, HM, 1.0f); }
        pg8::Order S_; S_.init(M / 256, 4, F.G, vblk); PtrNormal P_{(const char*)WSP(bf16_t, WS_VT), (const char*)WSP(bf16_t, WS_WMIX + WM_RET_OUT), (size_t)256 * 2048 * 2};
        EpiResid<false> E_{nullptr, HB, SS, 1.0f}; pg8::gemm_phase(F.lds, 2048, S_, P_, E_);
    }
    SEAM(6);
    if (IN(7)) {
        if (slack) { int cb = conv_job(F, job_ffn_in(F, 1, 0, WS_WFFN_B + WF_IN), 0, sgw, SNGW); cb = conv_job(F, job_ffn_out(F, 1, 0, WS_WFFN_B + WF_OUT), cb, sgw, SNGW);
            ConvJob J;
            J.W = F.in[12]; J.ldn = 3088; J.K = D; J.N = 3072; J.col0 = 0; J.kind = 0; J.gain = F.in[5] + D; J.WT = WSP(bf16_t, WS_WMIX + WM_GLA_IN);
            cb = conv_job(F, J, cb, sgw, SNGW);
            J.W = F.in[16]; J.ldn = D; J.K = D; J.N = D; J.col0 = 0; J.kind = 0; J.gain = F.in[15]; J.WT = WSP(bf16_t, WS_WMIX + WM_GLA_OUT);
            cb = conv_job(F, J, cb, sgw, SNGW);
            if (vblk == F.G - 1) { bf16_t* WZ = WSP(bf16_t, WS_WMIX + WM_GLA_Z); const float* W = F.in[12]; const float* gn = F.in[5] + D;
                for (int i = F.tid; i < 16 * D; i += NTHREADS) { const int k = i >> 4, r = i & 15; WZ[r * D + k] = f2bf(W[(size_t)k * 3088 + 3072 + r] * gn[k]); } }
            __syncthreads(); }
        FFN_IN(WS_WFFN_C, true);
    }
    SEAM(7);
    if (IN(8)) FFN_OUT((const bf16_t*)F.out, true, false);
    SEAM(8);
    if (IN(9)) {
        if (slack) { int cb = conv_job(F, job_ffn_in(F, 1, 1, WS_WFFN_A + WF_IN), 0, sgw, SNGW); cb = conv_job(F, job_ffn_out(F, 1, 1, WS_WFFN_A + WF_OUT), cb, sgw, SNGW); __syncthreads(); }
        FFN_IN(WS_WFFN_B + WF_IN, true);
    }
    SEAM(9);
    if (IN(10)) FFN_OUT(WSP(bf16_t, WS_WFFN_B + WF_OUT), true, false);
    SEAM(10);
    if (IN(11)) {
        if (meta_has_tiles(F, 2048, 0, 256)) { meta_prep_h(F); meta_tiles<0>(F, WSP(bf16_t, WS_WMIX + WM_GLA_IN), 2048, D, RAW, 3088, 1.f, 0, 256); }
        if (F.vb == 0) meta_tiles<0>(F, WSP(bf16_t, WS_WMIX + WM_GLA_Z), 16, D, RAW + 3072, 3088, 1.f, 0, 256);
        __syncthreads();
        z_phase(F, HB, SS, WSP(bf16_t, WS_WMIX + WM_GLA_Z), F.in[13], F.in[14], WSP(float, WS_BC));
    }
    SEAM(11);
    if (IN(12)) {
        pg8::Order S_; S_.init(M / 256, 8, F.G, vblk);
        PtrSwapFrom P_{(const char*)HB, (const char*)WSP(bf16_t, WS_WMIX + WM_GLA_IN), (size_t)256 * D * 2, 4};
        EpiGlaIn E_{SS, WSP(float, WS_BC), WSP(bf16_t, WS_QH2), WSP(bf16_t, WS_KH2), WSP(bf16_t, WS_VT2)}; pg8::gemm_phase(F.lds, D, S_, P_, E_);
    }
    SEAM(12);
    if (IN(13)) S2FN<128, 256, true>(F, vblk, WSP(bf16_t, WS_QH2), WSP(bf16_t, WS_KH2), WSP(bf16_t, WS_VT2), WSP(bf16_t, WS_O2), WSP(float, WS_BC), 3088);
    SEAM(13);
    if (IN(14)) {
        pg8::Order S_; S_.init(M / 256, 4, F.G, vblk); PtrNormal P_{(const char*)HB, (const char*)WSP(bf16_t, WS_WMIX + WM_GLA_G), (size_t)256 * D * 2};
        EpiGate<256, 1024> E_{SS, WSP(bf16_t, WS_O2), WSP(bf16_t, WS_VT2), (LAS float*)(F.lds + 132096)}; pg8::gemm_phase(F.lds, D, S_, P_, E_);
    }
    SEAM(14);
    if (IN(15)) {
        pg8::Order S_; S_.init(M / 256, 4, F.G, vblk); PtrNormal P_{(const char*)WSP(bf16_t, WS_VT2), (const char*)WSP(bf16_t, WS_WMIX + WM_GLA_OUT), (size_t)256 * D * 2};
        EpiResid<false> E_{nullptr, HB, SS, 1.0f}; pg8::gemm_phase(F.lds, D, S_, P_, E_);
    }
    SEAM(15);
    if (IN(16)) FFN_IN(WS_WFFN_A + WF_IN, false);
    SEAM(16);
    if (IN(17)) FFN_OUT(WSP(bf16_t, WS_WFFN_A + WF_OUT), false, false);
    SEAM(17);
    if (IN(18)) final_phase(F, SS, F.in[17]);
#if defined(PROBE2) || defined(PROBE3) || defined(PROBE4)
    __syncthreads();
    if (blockIdx.x == 0 && F.tid == 0) { const unsigned long long cyc = ((unsigned long long)MISC[21] << 32) | MISC[20]; const unsigned long long t0 = __builtin_amdgcn_s_memtime(); while (__builtin_amdgcn_s_memtime() - t0 < 4ull * cyc) __builtin_amdgcn_s_sleep(16); }
#endif
#if defined(PROBE_PHASE)
    { const unsigned long long t_now = __builtin_amdgcn_s_memrealtime(); if (18 == PROBE_PHASE) t_probe = t_now - t_prev;
      if (blockIdx.x == 0 && F.tid == 0) { const unsigned long long t_end = t_now + (unsigned long long)PROBE_MULT * t_probe; while (__builtin_amdgcn_s_memrealtime() < t_end) __builtin_amdgcn_s_sleep(16); } }
#endif
#undef slack
#undef sgw
#undef IN
#undef SEAM
#undef FFN_IN
#undef FFN_OUT
}
}
#ifndef MK_MODE
#define MK_MODE 0
#endif
#if MK_MODE == 2
namespace dbg {
__global__ void adapt(const float* Hreal, const float* HMtmp, float* Hn) {
    const size_t i = (size_t)blockIdx.x * blockDim.x + threadIdx.x;
    if (i >= (size_t)nv::ROWS * nv::D) return;
    const int d = (int)(i % nv::D); const size_t row = i / nv::D; const int b = (int)(row / nv::TT), s = (int)(row % nv::TT);
    Hn[i] = s < nv::NMETA ? HMtmp[s * nv::D + d] : Hreal[((size_t)b * nv::SEQ + (s - nv::NMETA)) * nv::D + d];
}
}
#endif
extern "C" void kernel_launch(void* const* d_in, const int* in_sizes, int n_in, void* d_out, int out_size, void* d_ws, size_t ws_size, hipStream_t stream) {
    static int grid = 0;
    if (grid == 0) {
        if (n_in != 18 || out_size != mk::M * mk::D || ws_size < mk::WS_NEED) { fprintf(stderr, "kernel_launch: unexpected sizes n_in %d out %d ws %zu\n", n_in, out_size, ws_size); grid = -1; return; }
        int dev = 0, cus = 0, per_cu = 0;
        if (hipGetDevice(&dev) != hipSuccess || hipDeviceGetAttribute(&cus, hipDeviceAttributeMultiprocessorCount, dev) != hipSuccess) { grid = -1; return; }
        if (hipFuncSetAttribute((const void*)mk::fwd, hipFuncAttributeMaxDynamicSharedMemorySize, mk::LDS_BYTES) != hipSuccess) { fprintf(stderr, "kernel_launch: hipFuncSetAttribute failed\n"); grid = -1; return; }
        if (hipOccupancyMaxActiveBlocksPerMultiprocessor(&per_cu, (const void*)mk::fwd, mk::NTHREADS, mk::LDS_BYTES) != hipSuccess || per_cu < 1) { fprintf(stderr, "kernel_launch: occupancy query says %d\n", per_cu); per_cu = 1; }
        (void)hipGetLastError();
        grid = cus;
        if (grid != 256) fprintf(stderr, "kernel_launch: %d CUs (built for 256)\n", grid);
    }
    if (grid < 0) return;
    (void)hipMemsetAsync((char*)d_ws + mk::WS_CTL, 0, mk::CTL_ZERO_BYTES, stream);
    mk::Args a{};
    for (int i = 0; i < 18; ++i) a.in[i] = (const float*)d_in[i];
    a.out = (float*)d_out; a.ws = (unsigned char*)d_ws;
#if MK_MODE == 0
    a.ph_lo = 0; a.ph_hi = mk::N_PHASES;
    hipLaunchKernelGGL(mk::fwd, dim3(grid), dim3(mk::NTHREADS), mk::LDS_BYTES, stream, a);
#elif MK_MODE == 1
    for (int p = 0; p < mk::N_PHASES; ++p) { a.ph_lo = p; a.ph_hi = p + 1; hipLaunchKernelGGL(mk::fwd, dim3(grid), dim3(mk::NTHREADS), mk::LDS_BYTES, stream, a); }
#else
    for (int p = 0; p < MK_CUT; ++p) { a.ph_lo = p; a.ph_hi = p + 1; hipLaunchKernelGGL(mk::fwd, dim3(grid), dim3(mk::NTHREADS), mk::LDS_BYTES, stream, a); }
    {
        float* tmp = (float*)((char*)d_ws + 250 * mk::MiB);
        (void)hipMemcpyAsync(tmp, (char*)d_ws + mk::WS_META + mk::META_HM, 16 * 1024 * 4, hipMemcpyDeviceToDevice, stream);
        hipLaunchKernelGGL(dbg::adapt, dim3((unsigned)(((size_t)nv::ROWS * nv::D + 255) / 256)), dim3(256), 0, stream, (const float*)d_out, (const float*)tmp, (float*)d_ws);
        nv::forward(stream, d_in, (float*)d_out, (char*)d_ws, MK_STAGE);
    }
#endif
}
```

```cpp
#include <hip/hip_runtime.h>
#include <cstdint>
#include <cstdio>
#include <cmath>
#define MK_MODE 0
namespace mk {
#define LAS __attribute__((address_space(3)))
#define GAS __attribute__((address_space(1)))
typedef unsigned short bf16_t;
typedef short bf16x8 __attribute__((ext_vector_type(8)));
typedef short s16x4 __attribute__((ext_vector_type(4)));
typedef float f32x4 __attribute__((ext_vector_type(4)));
typedef float f32x2 __attribute__((ext_vector_type(2)));
typedef unsigned u32x4 __attribute__((ext_vector_type(4)));
typedef unsigned u32x2 __attribute__((ext_vector_type(2)));

constexpr int M = 16384, D = 1024, DFF = 2816, SEQ = 8192, NMETA = 16;
constexpr int NWAVES = 8, NTHREADS = 512;
constexpr size_t MiB = 1u << 20;
constexpr size_t WS_CTL = 0, CTL_ZERO_BYTES = 1 * MiB;
constexpr size_t CTL_OSS_RET = 256 * 1024, CTL_OSS_GLA = 512 * 1024, CTL_MOSS = 768 * 1024;
constexpr size_t WS_HB = 1 * MiB, WS_SS = 33 * MiB, WS_META = 34 * MiB, WS_WMIX = 35 * MiB;
constexpr size_t META_HM = 0, META_RAW = 64 * 1024, META_MO = 448 * 1024;
constexpr size_t WS_WFFN_A = 52 * MiB, WS_ACT = 69 * MiB, WS_WFFN_B = 157 * MiB, WS_WFFN_C = 244 * MiB;
constexpr size_t WS_QH = 52 * MiB, WS_KH = 84 * MiB, WS_VT = 116 * MiB, WS_O = 180 * MiB;
constexpr size_t WS_BC = 69 * MiB, WS_QH2 = 101 * MiB, WS_KH2 = 117 * MiB, WS_VT2 = 133 * MiB, WS_O2 = 174 * MiB;
constexpr size_t WS_G2 = 208 * MiB;
constexpr size_t WS_NEED = 256 * MiB;
constexpr size_t WM_RET_IN = 0, WM_RET_OUT = 12 * MiB;
constexpr size_t WM_GLA_IN = 0, WM_GLA_G = 4 * MiB, WM_GLA_OUT = 6 * MiB, WM_GLA_Z = 8 * MiB;
constexpr size_t WF_IN = 0, WF_OUT = 11 * MiB;
constexpr int CW_BAR = 4096;

constexpr int LDS_BYTES = 163840;
constexpr int LDS_MISC = LDS_BYTES - 256;

__constant__ float L2G[4] = {-0.04580368961312478f, -0.02272007650008353f, -0.011315313227834133f, -0.005646563141142062f};
__constant__ float ROPE_INV[128] = {
  1.000000000e+00f, 9.300450087e-01f, 8.649836779e-01f, 8.044736385e-01f,
  7.481966019e-01f, 6.958565116e-01f, 6.471778154e-01f, 6.019044518e-01f,
  5.597981811e-01f, 5.206375122e-01f, 4.842162728e-01f, 4.503428936e-01f,
  4.188391268e-01f, 3.895392120e-01f, 3.622889817e-01f, 3.369450271e-01f,
  3.133740425e-01f, 2.914519310e-01f, 2.710633874e-01f, 2.521011233e-01f,
  2.344653904e-01f, 2.180633694e-01f, 2.028087080e-01f, 1.886212230e-01f,
  1.754262149e-01f, 1.631542742e-01f, 1.517407894e-01f, 1.411257535e-01f,
  1.312533021e-01f, 1.220714748e-01f, 1.135319397e-01f, 1.055898219e-01f,
  9.820328653e-02f, 9.133346379e-02f, 8.494423330e-02f, 7.900195569e-02f,
  7.347535342e-02f, 6.833537668e-02f, 6.355497986e-02f, 5.910899118e-02f,
  5.497401953e-02f, 5.112830922e-02f, 4.755162448e-02f, 4.422515258e-02f,
  4.113136977e-02f, 3.825402260e-02f, 3.557796404e-02f, 3.308910504e-02f,
  3.077435680e-02f, 2.862153389e-02f, 2.661931701e-02f, 2.475716174e-02f,
  2.302526683e-02f, 2.141453326e-02f, 1.991648041e-02f, 1.852322184e-02f,
  1.722742990e-02f, 1.602228358e-02f, 1.490144618e-02f, 1.385901403e-02f,
  1.288950257e-02f, 1.198781747e-02f, 1.114920899e-02f, 1.036926545e-02f,
  9.643883444e-03f, 8.969245479e-03f, 8.341802284e-03f, 7.758250926e-03f,
  7.215522230e-03f, 6.710760761e-03f, 6.241309457e-03f, 5.804697983e-03f,
  5.398627371e-03f, 5.020966288e-03f, 4.669724498e-03f, 4.343053792e-03f,
  4.039235413e-03f, 3.756670747e-03f, 3.493872471e-03f, 3.249458736e-03f,
  3.022142686e-03f, 2.810728736e-03f, 2.614103956e-03f, 2.431234345e-03f,
  2.261157380e-03f, 2.102978062e-03f, 1.955864020e-03f, 1.819041790e-03f,
  1.691789716e-03f, 1.573440502e-03f, 1.463370281e-03f, 1.361000235e-03f,
  1.265791478e-03f, 1.177242957e-03f, 1.094888896e-03f, 1.018295996e-03f,
  9.470609948e-04f, 8.808093844e-04f, 8.191923262e-04f, 7.618857198e-04f,
  7.085879333e-04f, 6.590186385e-04f, 6.129170069e-04f, 5.700403708e-04f,
  5.301629426e-04f, 4.930753494e-04f, 4.585822753e-04f, 4.265021416e-04f,
  3.966661752e-04f, 3.689173318e-04f, 3.431097430e-04f, 3.191074939e-04f,
  2.967843320e-04f, 2.760227653e-04f, 2.567135962e-04f, 2.387551940e-04f,
  2.220530587e-04f, 2.065193403e-04f, 1.920722716e-04f, 1.786358480e-04f,
  1.661392889e-04f, 1.545170089e-04f, 1.437077590e-04f, 1.336546848e-04f,
  1.243048755e-04f, 1.156091312e-04f, 1.075216787e-04f, 9.999999747e-05f,
};

#define LDS_WAIT() asm volatile("s_waitcnt lgkmcnt(0)" ::: "memory")
#define VM_WAIT() asm volatile("s_waitcnt vmcnt(0)" ::: "memory")
#define RLX_AGENT __ATOMIC_RELAXED, __HIP_MEMORY_SCOPE_AGENT

__device__ __forceinline__ unsigned cvt_pk_bf16(float lo, float hi) { unsigned r; asm volatile("v_cvt_pk_bf16_f32 %0, %1, %2" : "=v"(r) : "v"(lo), "v"(hi)); return r; }
__device__ __forceinline__ float bf_lo(unsigned w) { return __uint_as_float(w << 16); }
__device__ __forceinline__ float bf_hi(unsigned w) { return __uint_as_float(w & 0xffff0000u); }
__device__ __forceinline__ unsigned short f2bf(float f) { return (unsigned short)(cvt_pk_bf16(f, 0.f) & 0xffffu); }
__device__ __forceinline__ float fsilu(float v) { return v * __builtin_amdgcn_rcpf(1.0f + __expf(-v)); }
__device__ __forceinline__ float wave_sum(float v) {
#pragma unroll
    for (int o = 1; o < 64; o <<= 1) v += __shfl_xor(v, o);
    return v;
}
__device__ __forceinline__ float row_rstd(const float* SS, int row) {
    const f32x4* p = (const f32x4*)(SS + (size_t)row * 16);
    const f32x4 a = p[0], b = p[1], c = p[2], d = p[3];
    const float s = ((a.x + a.y) + (a.z + a.w)) + ((b.x + b.y) + (b.z + b.w)) + ((c.x + c.y) + (c.z + c.w)) + ((d.x + d.y) + (d.z + d.w));
    return 1.0f / sqrtf(s * (1.0f / 1024.0f) + 1e-6f);
}

#define XB_TMO      128
#define XB_XCNT(j)  (256  + 64 * (j))
#define XB_XSUB(j)  (1280 + 64 * (j))
#define XB_XGEN(j)  (2304 + 64 * (j))
#define XB_TOP      3328
#define XB_TOPGEN   3392
#define XCD_BAR_WORDS 3456
#define XB_SPIN_CAP (1u << 18)
__device__ __forceinline__ unsigned xb_ld(unsigned* p)              { return __hip_atomic_load(p, __ATOMIC_RELAXED, __HIP_MEMORY_SCOPE_AGENT); }
__device__ __forceinline__ unsigned xb_add(unsigned* p, unsigned v) { return __hip_atomic_fetch_add(p, v, __ATOMIC_RELAXED, __HIP_MEMORY_SCOPE_AGENT); }
__device__ __forceinline__ unsigned xb_xcc_id() { return (unsigned)__builtin_amdgcn_s_getreg((3 << 11) | 20) & 0xFu; }
#define XB_SPIN(cond, bar) do { unsigned _sp = 0; while (cond) { __builtin_amdgcn_s_sleep(1); \
    if ((++_sp & 255u) == 0u) { if (xb_ld(&(bar)[XB_TMO])) break; if (_sp > XB_SPIN_CAP) { atomicAdd(&(bar)[XB_TMO], 1u); break; } } } } while (0)
struct XcdBarrier { unsigned* bar; unsigned x; volatile LAS unsigned* st; };
__device__ __forceinline__ XcdBarrier xcd_barrier_post(unsigned* bar, volatile LAS unsigned* st) {
    XcdBarrier b; b.bar = bar; b.x = xb_xcc_id(); b.st = st;
    if (threadIdx.x == 0) { const unsigned rank = xb_add(&bar[XB_XCNT(b.x)], 1u); st[2] = rank; st[3] = b.x; }
    return b;
}
__device__ __forceinline__ void xcd_barrier_complete(unsigned* bar, unsigned x, unsigned& nloc, unsigned& nx) {
    const unsigned G = gridDim.x * gridDim.y * gridDim.z;
    unsigned sum, cnt, mine, sp = 0u;
    for (;;) {
        sum = 0u; cnt = 0u; mine = 0u;
#pragma unroll
        for (unsigned j = 0; j < 16; ++j) { const unsigned c = xb_ld(&bar[XB_XCNT(j)]); sum += c; cnt += (c > 0u) ? 1u : 0u; mine = (j == x) ? c : mine; }
        if (sum == G) break;
        __builtin_amdgcn_s_sleep(1);
        if ((++sp & 255u) == 0u) { if (xb_ld(&bar[XB_TMO])) break; if (sp > XB_SPIN_CAP) { atomicAdd(&bar[XB_TMO], 1u); break; } }
    }
    nloc = mine > 0u ? mine : 1u; nx = cnt > 0u ? cnt : 1u;
}
__device__ __forceinline__ void xcd_barrier(const XcdBarrier& b) {
    asm volatile("s_waitcnt vmcnt(0)" ::: "memory");
    __syncthreads();
    if (threadIdx.x == 0) {
        unsigned* bar = b.bar;
        __builtin_amdgcn_s_waitcnt(0);
        unsigned nloc = b.st[0], nx = b.st[1];
        if (nloc == 0u) { xcd_barrier_complete(bar, b.x, nloc, nx); b.st[0] = nloc; b.st[1] = nx; }
        const unsigned old = xb_add(&bar[XB_XSUB(b.x)], 1u);
        const unsigned gen = old / nloc;
        if (old + 1u == (gen + 1u) * nloc) {
            __builtin_amdgcn_fence(__ATOMIC_RELEASE, "agent");
            asm volatile("s_waitcnt vmcnt(0)" ::: "memory");
            const unsigned og = xb_add(&bar[XB_TOP], 1u);
            const unsigned tg = og / nx;
            if (og + 1u == (tg + 1u) * nx) xb_add(&bar[XB_TOPGEN], 1u);
            else XB_SPIN(xb_ld(&bar[XB_TOPGEN]) == tg, bar);
            __builtin_amdgcn_fence(__ATOMIC_ACQUIRE, "agent");
            xb_add(&bar[XB_XGEN(b.x)], 1u);
            asm volatile("s_waitcnt vmcnt(0)" ::: "memory");
        } else {
            XB_SPIN(xb_ld(&bar[XB_XGEN(b.x)]) == gen, bar);
            __builtin_amdgcn_fence(__ATOMIC_ACQUIRE, "agent");
            asm volatile("s_waitcnt vmcnt(0)" ::: "memory");
        }
    }
    __syncthreads();
}

namespace pg8 {
constexpr int BM = 256, BK = 64, HALF = 128, HTB = HALF * BK * 2, STAGE_BYTES = 8 * HTB, NXCD = 8, WGM = 8;
__host__ __device__ __forceinline__ int lds_byte(int r, int c) { const int st = (r >> 4) * 2 + (c >> 5), rr = r & 15, cc = c & 31, ob = rr * 64 + cc * 2; return st * 1024 + (ob ^ (((ob >> 9) & 1) << 5)); }
__host__ __device__ __forceinline__ void stage_rc(int b, int& R, int& C) { const int st = b / 1024, sb = b % 1024, swz = sb ^ (((sb >> 9) & 1) << 5); R = (st >> 1) * 16 + swz / 64; C = (st & 1) * 32 + (swz % 64) / 2; }
__host__ __device__ __forceinline__ int perm32(int rho) { const int n = rho >> 4, i = rho & 15; return 8 * (i >> 2) + 4 * n + (i & 3); }
struct Unit { int pm, pn; };
struct Order {
    int nM, nN, nwg, G, c;
    __device__ void init(int nM_, int nN_, int G_, int c_) { nM = nM_; nN = nN_; nwg = nM * nN; G = G_; c = c_; }
    __device__ bool next(int i, Unit& u) const {
        const long L = (long)i * G + c; if (L >= nwg) return false;
        int wgid = (int)L; { const int q = nwg / NXCD, r = nwg % NXCD, xcd = wgid % NXCD, off = wgid / NXCD; wgid = (xcd < r ? xcd * (q + 1) : r * (q + 1) + (xcd - r) * q) + off; }
        const int nig = WGM * nN, gid = wgid / nig, fm = gid * WGM, gsz = (nM - fm) < WGM ? (nM - fm) : WGM;
        u.pm = fm + ((wgid % nig) % gsz); u.pn = (wgid % nig) / gsz; return true;
    }
};
#if defined(PROBE4)
__device__ unsigned long long g_dummy_;
#endif
template <class Epi, class Ptr>
__device__ __forceinline__ void gemm_phase(LAS unsigned char* lds, const int K, const Order& S, const Ptr& P, const Epi& E) {
    const int tid = threadIdx.x, wid = __builtin_amdgcn_readfirstlane(tid >> 6), lane = tid & 63, wr = wid >> 2, wc = wid & 3, fr = lane & 15, fq = lane >> 4;
    const int nt = K / BK;
    unsigned voffA[2], voffB[2];
#pragma unroll
    for (int i = 0; i < 2; ++i) { int R, C; stage_rc(tid * 16 + i * 8192, R, C); const int Rb = (R & ~31) + perm32(R & 31);
        voffA[i] = (unsigned)(R * K + C) * 2u; voffB[i] = (unsigned)(Rb * K + C) * 2u; }
    const size_t kstep = (size_t)(BK * 2);
    const size_t hstep = (size_t)HALF * K * 2;
    const unsigned ldsw = (unsigned)wid * 1024u;
    const int aoff = lds_byte(wr * 64 + fr, fq * 8), boff = lds_byte(wc * 32 + fr, fq * 8);
#define PG8_SA(b, h) (((b) * 2 + (h)) * HTB)
#define PG8_SB(b, h) ((4 + (b) * 2 + (h)) * HTB)
#define PG8_STAGE(bufoff, gbase, voff) do { _Pragma("unroll") for (int _i = 0; _i < 2; ++_i) \
        __builtin_amdgcn_global_load_lds((const unsigned*)((const char*)(gbase) + (voff)[_i]), (LAS unsigned*)(lds + (bufoff) + ldsw + _i * 8192), 16, 0, 0); } while (0)
#define PG8_LDA(dst, b, h) do { _Pragma("unroll") for (int m = 0; m < 4; ++m) _Pragma("unroll") for (int k = 0; k < 2; ++k) dst[m][k] = *(const LAS bf16x8*)(lds + PG8_SA(b, h) + aoff + m * 2048 + k * 1024); } while (0)
#define PG8_LDB(dst, b, h) do { _Pragma("unroll") for (int n = 0; n < 2; ++n) _Pragma("unroll") for (int k = 0; k < 2; ++k) dst[n][k] = *(const LAS bf16x8*)(lds + PG8_SB(b, h) + boff + n * 2048 + k * 1024); } while (0)
#define PG8_MMA(ai, bj, At, Bt) do { __builtin_amdgcn_s_setprio(1); _Pragma("unroll") for (int m = 0; m < 4; ++m) _Pragma("unroll") for (int n = 0; n < 2; ++n) _Pragma("unroll") for (int k = 0; k < 2; ++k) \
        acc[ai][bj][m][n] = __builtin_amdgcn_mfma_f32_16x16x32_bf16(Bt[n][k], At[m][k], acc[ai][bj][m][n], 0, 0, 0); __builtin_amdgcn_s_setprio(0); } while (0)
#define PG8_WAIT_V(n) asm volatile("s_waitcnt vmcnt(" #n ")" ::: "memory")
#define PG8_WAIT_L(n) asm volatile("s_waitcnt lgkmcnt(" #n ")" ::: "memory")
#define PG8_BAR __builtin_amdgcn_s_barrier()
#define PG8_SCHED __builtin_amdgcn_sched_barrier(0)
#if defined(PROBE4)
    unsigned long long g_pacc = 0ull;
#endif
    Unit cur, nxt; int ui = 0;
    if (!S.next(0, cur)) return;
    f32x4 acc[2][2][4][2];
#pragma unroll
    for (int a = 0; a < 2; ++a)
#pragma unroll
        for (int b = 0; b < 2; ++b)
#pragma unroll
            for (int m = 0; m < 4; ++m)
#pragma unroll
                for (int n = 0; n < 2; ++n) acc[a][b][m][n] = (f32x4){0.f, 0.f, 0.f, 0.f};
    bf16x8 At[4][2], B0[2][2], B1[2][2];
    const char* cA; const char* cB; P.ptrs(cur, cA, cB);
    PG8_STAGE(PG8_SB(0, 0), cB, voffB); PG8_STAGE(PG8_SB(0, 1), cB + hstep, voffB); PG8_STAGE(PG8_SA(0, 0), cA, voffA); PG8_STAGE(PG8_SA(0, 1), cA + hstep, voffA);
    if (wr == 1) PG8_BAR;
    PG8_WAIT_V(2); PG8_BAR;
    PG8_STAGE(PG8_SB(1, 0), cB + kstep, voffB); PG8_STAGE(PG8_SA(1, 0), cA + kstep, voffA); PG8_STAGE(PG8_SB(1, 1), cB + hstep + kstep, voffB);
    PG8_WAIT_V(6); PG8_BAR;
    for (;;) {
        const bool has_next = S.next(ui + 1, nxt);
        const char* nA = cA; const char* nB = cB; if (has_next) P.ptrs(nxt, nA, nB);
        for (int t = 0; t < nt; t += 2) {
            const bool last = (t == nt - 2);
            const char* a1 = cA + (size_t)(t + 1) * kstep;
            const char* a2 = last ? nA : cA + (size_t)(t + 2) * kstep; const char* b2 = last ? nB : cB + (size_t)(t + 2) * kstep;
            const char* a3 = a2 + kstep; const char* b3 = b2 + kstep;
            PG8_LDB(B0, 0, 0); PG8_LDB(B1, 0, 1); PG8_SCHED; PG8_LDA(At, 0, 0); PG8_STAGE(PG8_SA(1, 1), a1 + hstep, voffA);
            PG8_WAIT_V(8); PG8_WAIT_L(0); PG8_BAR; PG8_MMA(0, 0, At, B0); PG8_MMA(0, 1, At, B1); PG8_BAR; PG8_SCHED;
            PG8_LDA(At, 0, 1); PG8_STAGE(PG8_SB(0, 0), b2, voffB); PG8_STAGE(PG8_SB(0, 1), b2 + hstep, voffB); PG8_STAGE(PG8_SA(0, 0), a2, voffA);
            PG8_WAIT_V(8); PG8_WAIT_L(0); PG8_BAR; PG8_MMA(1, 0, At, B0); PG8_MMA(1, 1, At, B1); PG8_BAR; PG8_SCHED;
            PG8_LDB(B0, 1, 0); PG8_LDB(B1, 1, 1); PG8_SCHED; PG8_LDA(At, 1, 0); PG8_STAGE(PG8_SA(0, 1), a2 + hstep, voffA);
            PG8_WAIT_V(8); PG8_WAIT_L(0); PG8_BAR; PG8_MMA(0, 0, At, B0); PG8_MMA(0, 1, At, B1); PG8_BAR; PG8_SCHED;
            PG8_LDA(At, 1, 1); PG8_STAGE(PG8_SB(1, 0), b3, voffB); PG8_STAGE(PG8_SB(1, 1), b3 + hstep, voffB); PG8_STAGE(PG8_SA(1, 0), a3, voffA);
            PG8_WAIT_V(8); PG8_WAIT_L(0); PG8_BAR; PG8_MMA(1, 0, At, B0); PG8_MMA(1, 1, At, B1); PG8_BAR; PG8_SCHED;
        }
        if (wr == 0) PG8_BAR;
#if defined(PROBE4)
        unsigned long long pe0_ = __builtin_amdgcn_s_memtime();
#endif
        E(acc, cur, wr, wc, fr, fq);
#if defined(PROBE4)
        if (PROBE4 == 1) { asm volatile("s_waitcnt vmcnt(0)" ::: "memory"); }
        g_pacc += __builtin_amdgcn_s_memtime() - pe0_;
#endif
        if (!has_next) break;
#pragma unroll
        for (int a = 0; a < 2; ++a)
#pragma unroll
            for (int b = 0; b < 2; ++b)
#pragma unroll
                for (int m = 0; m < 4; ++m)
#pragma unroll
                    for (int n = 0; n < 2; ++n) acc[a][b][m][n] = (f32x4){0.f, 0.f, 0.f, 0.f};
        cur = nxt; cA = nA; cB = nB; ++ui;
        if (wr == 1) PG8_BAR;
    }
    PG8_WAIT_V(0);
    PG8_BAR;
#if defined(PROBE4)
    if (blockIdx.x == 0 && tid == 0 && K == 1024 && S.nN == 22) { volatile LAS unsigned* MI = (volatile LAS unsigned*)(lds + LDS_MISC); const unsigned long long v = (((unsigned long long)MI[21] << 32) | MI[20]) + g_pacc; MI[20] = (unsigned)v; MI[21] = (unsigned)(v >> 32); }
#endif
#undef PG8_SA
#undef PG8_SB
#undef PG8_STAGE
#undef PG8_LDA
#undef PG8_LDB
#undef PG8_MMA
#undef PG8_WAIT_V
#undef PG8_WAIT_L
#undef PG8_BAR
#undef PG8_SCHED
}
}
struct Frame {
    LAS unsigned char* lds;
    int tid, lane, wave, vcu, G, vb;
    unsigned char* ws;
    const float* in[18];
    float* out;
};
#define WSP(T, off) ((T*)(F.ws + (off)))

__device__ __forceinline__ void conv_item(const float* W, int ldn, int srccol0, int k0, const float* gain, bf16_t* WT, int K, int dstrow0, LAS float* scr, int lane) {
    float v[32];
    const float* wp = W + (size_t)(k0 + (lane >> 5)) * ldn + srccol0 + (lane & 31);
#pragma unroll
    for (int i = 0; i < 32; ++i) v[i] = wp[(size_t)(2 * i) * ldn];
    const int c = lane & 7;
    float gn[8];
#pragma unroll
    for (int e = 0; e < 8; ++e) gn[e] = gain ? gain[k0 + 8 * c + e] : 1.0f;
#pragma unroll
    for (int i = 0; i < 32; ++i) scr[(2 * i + (lane >> 5)) * 33 + (lane & 31)] = v[i];
    LDS_WAIT(); asm volatile("" ::: "memory");
#pragma unroll
    for (int j = 0; j < 4; ++j) { const int n = (lane >> 3) + 8 * j; const LAS float* s = scr + (8 * c) * 33 + n;
        u32x4 o; o.x = cvt_pk_bf16(s[0 * 33] * gn[0], s[1 * 33] * gn[1]); o.y = cvt_pk_bf16(s[2 * 33] * gn[2], s[3 * 33] * gn[3]);
        o.z = cvt_pk_bf16(s[4 * 33] * gn[4], s[5 * 33] * gn[5]); o.w = cvt_pk_bf16(s[6 * 33] * gn[6], s[7 * 33] * gn[7]);
        *(u32x4*)(WT + (size_t)(dstrow0 + n) * K + k0 + 8 * c) = o; }
    LDS_WAIT(); asm volatile("" ::: "memory");
}
struct ConvJob { const float* W; int ldn, K, N, col0, kind; const float* gain; bf16_t* WT; };
__device__ __forceinline__ int conv_items(const ConvJob& J) { return (J.K / 64) * (J.N / 32); }
__device__ __forceinline__ void conv_run(const ConvJob& J, int item, LAS float* scr, int lane) {
    const int nblk = J.N / 32, kb = item / nblk, nb = item % nblk; const int n0 = 32 * nb;
    int src;
    if (J.kind == 0) src = J.col0 + n0; else { const int u = n0 >> 8, j = n0 & 255; src = (j < 128) ? u * 128 + j : 2816 + u * 128 + (j - 128); }
    conv_item(J.W, J.ldn, src, 64 * kb, J.gain, J.WT, J.K, n0, scr, lane);
}
__device__ __forceinline__ int conv_job(Frame& F, const ConvJob& J, int base, int gw, int ngw) {
    LAS float* scr = (LAS float*)(F.lds + F.wave * 16384);
    const int n = conv_items(J);
    const int first = (gw - base % ngw + ngw) % ngw;
    for (int it = first; it < n; it += ngw) conv_run(J, it, scr, F.lane);
    return base + n;
}
__device__ __forceinline__ ConvJob job_ffn_in(Frame& F, int layer, int which  , size_t dst) {
    ConvJob J; J.W = F.in[which ? 7 : 3] + (size_t)layer * D * 2 * DFF; J.ldn = 2 * DFF; J.K = D; J.N = 2 * DFF; J.col0 = 0; J.kind = 1; J.gain = F.in[which ? 6 : 2] + layer * D; J.WT = WSP(bf16_t, dst); return J; }
__device__ __forceinline__ ConvJob job_ffn_out(Frame& F, int layer, int which, size_t dst) {
    ConvJob J; J.W = F.in[which ? 8 : 4] + (size_t)layer * DFF * D; J.ldn = D; J.K = DFF; J.N = D; J.col0 = 0; J.kind = 0; J.gain = nullptr; J.WT = WSP(bf16_t, dst); return J; }

__device__ __forceinline__ f32x2 pk_silu_mul(f32x2 g, f32x2 u, float c1, float rs2) {
    const f32x2 t = g * c1; f32x2 e; e.x = __builtin_amdgcn_exp2f(t.x); e.y = __builtin_amdgcn_exp2f(t.y);
    const f32x2 d = e + 1.0f; f32x2 r; r.x = __builtin_amdgcn_rcpf(d.x); r.y = __builtin_amdgcn_rcpf(d.y);
    return (g * u) * (r * rs2);
}
#define ROWS8_RSTD(SSp, rowbase, rsv) do { const float a_ = row_rstd(SSp, (rowbase) + fq * 16), b_ = row_rstd(SSp, (rowbase) + 128 + fq * 16); \
        _Pragma("unroll") for (int k_ = 0; k_ < 8; ++k_) rsv[k_] = __shfl(k_ < 4 ? a_ : b_, fr + 16 * (k_ & 3)); } while (0)

struct EpiSwiglu {
    const float* SS; bf16_t* ACT;
    __device__ __forceinline__ void operator()(const f32x4 (&acc)[2][2][4][2], const pg8::Unit& u, int wr, int wc, int fr, int fq) const {
        float rsv[8]; ROWS8_RSTD(SS, u.pm * 256 + wr * 64 + fr, rsv);
#pragma unroll
        for (int ai = 0; ai < 2; ++ai)
#pragma unroll
            for (int m = 0; m < 4; ++m) {
                const int row = u.pm * 256 + ai * 128 + wr * 64 + m * 16 + fr; const float rs = rsv[ai * 4 + m], c1 = rs * -1.4426950408889634f, rs2 = rs * rs;
                f32x2 v[4];
#pragma unroll
                for (int n = 0; n < 2; ++n) { const f32x4 g = acc[ai][0][m][n], up = acc[ai][1][m][n];
                    v[2 * n] = pk_silu_mul((f32x2){g[0], g[1]}, (f32x2){up[0], up[1]}, c1, rs2); v[2 * n + 1] = pk_silu_mul((f32x2){g[2], g[3]}, (f32x2){up[2], up[3]}, c1, rs2); }
                u32x4 w; w.x = cvt_pk_bf16(v[0].x, v[0].y); w.y = cvt_pk_bf16(v[1].x, v[1].y); w.z = cvt_pk_bf16(v[2].x, v[2].y); w.w = cvt_pk_bf16(v[3].x, v[3].y);
                *(u32x4*)(ACT + (size_t)row * DFF + u.pn * 128 + wc * 32 + 8 * fq) = w;
            }
    }
};
template <bool BASE_F32> struct EpiResid {
    const float* xbase; bf16_t* HB; float* SS; float alpha;
    __device__ __forceinline__ void operator()(const f32x4 (&acc)[2][2][4][2], const pg8::Unit& u, int wr, int wc, int fr, int fq) const {
#pragma unroll
        for (int ai = 0; ai < 2; ++ai)
#pragma unroll
            for (int m = 0; m < 4; ++m) {
                const int row = u.pm * 256 + ai * 128 + wr * 64 + m * 16 + fr; float ss = 0.f;
#pragma unroll
                for (int bj = 0; bj < 2; ++bj) {
                    const size_t off = (size_t)row * D + u.pn * 256 + bj * 128 + wc * 32 + 8 * fq;
                    f32x4 b0, b1;
                    if (BASE_F32) { b0 = *(const f32x4*)(xbase + off); b1 = *(const f32x4*)(xbase + off + 4); }
                    else { const u32x4 hv = *(const u32x4*)(HB + off); b0 = (f32x4){bf_lo(hv.x), bf_hi(hv.x), bf_lo(hv.y), bf_hi(hv.y)}; b1 = (f32x4){bf_lo(hv.z), bf_hi(hv.z), bf_lo(hv.w), bf_hi(hv.w)}; }
                    const f32x4 v0 = b0 + acc[ai][bj][m][0] * alpha, v1 = b1 + acc[ai][bj][m][1] * alpha;
                    u32x4 w; w.x = cvt_pk_bf16(v0[0], v0[1]); w.y = cvt_pk_bf16(v0[2], v0[3]); w.z = cvt_pk_bf16(v1[0], v1[1]); w.w = cvt_pk_bf16(v1[2], v1[3]);
                    *(u32x4*)(HB + off) = w;
                    ss += (v0[0] * v0[0] + v0[1] * v0[1]) + (v0[2] * v0[2] + v0[3] * v0[3]) + (v1[0] * v1[0] + v1[1] * v1[1]) + (v1[2] * v1[2] + v1[3] * v1[3]);
                }
                ss += __shfl_xor(ss, 16); ss += __shfl_xor(ss, 32);
                if (fq == 0) SS[(size_t)row * 16 + u.pn * 4 + wc] = ss;
            }
    }
};
struct EpiRetIn {
    const float* SS; bf16_t* QH; bf16_t* KH; bf16_t* VT;
    __device__ __forceinline__ void operator()(const f32x4 (&acc)[2][2][4][2], const pg8::Unit& u, int wr, int wc, int fr, int fq) const {
        if (u.pn < 8) {
            const bool isq = u.pn < 4; const int head = u.pn & 3; bf16_t* dst = isq ? QH : KH;
            const float l2g = isq ? L2G[head] : -L2G[head], sc = isq ? 1.0f : 0.0625f;
            float inv[8];
#pragma unroll
            for (int e = 0; e < 8; ++e) inv[e] = ROPE_INV[wc * 32 + 8 * fq + e];
            float rsv[8]; ROWS8_RSTD(SS, u.pm * 256 + wr * 64 + fr, rsv);
#pragma unroll
            for (int ai = 0; ai < 2; ++ai)
#pragma unroll
                for (int m = 0; m < 4; ++m) {
                    const int row = u.pm * 256 + ai * 128 + wr * 64 + m * 16 + fr; const float rs = rsv[ai * 4 + m];
                    const int b = row >> 13, t = row & 8191; const float pos = (float)(t + NMETA);
                    const float dec = __builtin_amdgcn_exp2f((float)((t & 31) + 1) * l2g) * sc * rs;
                    float o1[8], o2[8];
#pragma unroll
                    for (int n = 0; n < 2; ++n)
#pragma unroll
                        for (int j = 0; j < 4; ++j) { const int e = 4 * n + j;
                            const float rev = (pos * inv[e]) * 0.15915494309189535f; const float frc = rev - floorf(rev);
                            const float sn = __builtin_amdgcn_sinf(frc), cs = __builtin_amdgcn_cosf(frc);
                            const float t1 = acc[ai][0][m][n][j], t2 = acc[ai][1][m][n][j];
                            o1[e] = (t1 * cs - t2 * sn) * dec; o2[e] = (t1 * sn + t2 * cs) * dec; }
                    bf16_t* p = dst + ((size_t)(b * 4 + head) * SEQ + t) * 256 + wc * 32 + 8 * fq;
                    u32x4 w; w.x = cvt_pk_bf16(o1[0], o1[1]); w.y = cvt_pk_bf16(o1[2], o1[3]); w.z = cvt_pk_bf16(o1[4], o1[5]); w.w = cvt_pk_bf16(o1[6], o1[7]);
                    *(u32x4*)p = w;
                    w.x = cvt_pk_bf16(o2[0], o2[1]); w.y = cvt_pk_bf16(o2[2], o2[3]); w.z = cvt_pk_bf16(o2[4], o2[5]); w.w = cvt_pk_bf16(o2[6], o2[7]);
                    *(u32x4*)(p + 128) = w;
                }
        } else {
            float rs[2][8];
            { const float mine = row_rstd(SS, u.pm * 256 + (fr >> 3) * 128 + wc * 32 + 8 * fq + (fr & 7));
#pragma unroll
              for (int bj = 0; bj < 2; ++bj)
#pragma unroll
                  for (int e = 0; e < 8; ++e) rs[bj][e] = __shfl(mine, bj * 8 + e + 16 * fq); }
            const int b = u.pm >> 5, t0 = (u.pm & 31) * 256;
#pragma unroll
            for (int ai = 0; ai < 2; ++ai)
#pragma unroll
                for (int m = 0; m < 4; ++m) {
                    const int vc = (u.pn - 8) * 256 + ai * 128 + wr * 64 + m * 16 + fr; const int head = vc >> 9, dvi = vc & 511;
                    bf16_t* p = VT + ((size_t)(b * 4 + head) * 512 + dvi) * SEQ + t0 + wc * 32 + 8 * fq;
#pragma unroll
                    for (int bj = 0; bj < 2; ++bj) {
                        const f32x4 v0 = acc[ai][bj][m][0], v1 = acc[ai][bj][m][1];
                        u32x4 w; w.x = cvt_pk_bf16(v0[0] * rs[bj][0], v0[1] * rs[bj][1]); w.y = cvt_pk_bf16(v0[2] * rs[bj][2], v0[3] * rs[bj][3]);
                        w.z = cvt_pk_bf16(v1[0] * rs[bj][4], v1[1] * rs[bj][5]); w.w = cvt_pk_bf16(v1[2] * rs[bj][6], v1[3] * rs[bj][7]);
                        *(u32x4*)(p + bj * 128) = w;
                    }
                }
        }
    }
};
template <int DV, int LDO> struct EpiGate {
    const float* SS; const bf16_t* O; bf16_t* Y; LAS float* RO;
    __device__ __forceinline__ void operator()(const f32x4 (&acc)[2][2][4][2], const pg8::Unit& u, int wr, int wc, int fr, int fq) const {
        const int wid = wr * 4 + wc, lane = fq * 16 + fr; const int head = (u.pn * 256) / DV;
        {   const bf16_t* ob = O + (size_t)(u.pm * 256 + wid * 32) * LDO + head * DV;
#pragma unroll
            for (int i0 = 0; i0 < 32; i0 += 8) { float sv[8];
#pragma unroll
                for (int i = 0; i < 8; ++i) { float s;
                    if (DV == 512) { const u32x4 v = *(const u32x4*)(ob + (size_t)(i0 + i) * LDO + lane * 8);
                        const float a0 = bf_lo(v.x), a1 = bf_hi(v.x), a2 = bf_lo(v.y), a3 = bf_hi(v.y), a4 = bf_lo(v.z), a5 = bf_hi(v.z), a6 = bf_lo(v.w), a7 = bf_hi(v.w);
                        s = ((a0 * a0 + a1 * a1) + (a2 * a2 + a3 * a3)) + ((a4 * a4 + a5 * a5) + (a6 * a6 + a7 * a7)); }
                    else { const u32x2 v = *(const u32x2*)(ob + (size_t)(i0 + i) * LDO + lane * 4);
                        const float a0 = bf_lo(v.x), a1 = bf_hi(v.x), a2 = bf_lo(v.y), a3 = bf_hi(v.y); s = (a0 * a0 + a1 * a1) + (a2 * a2 + a3 * a3); }
                    sv[i] = s; }
#pragma unroll
                for (int i = 0; i < 8; ++i) { const float t = wave_sum(sv[i]); if (lane == 0) RO[wid * 32 + i0 + i] = 1.0f / sqrtf(t * (1.0f / (float)DV) + 1e-6f); } }
            LDS_WAIT(); __builtin_amdgcn_s_barrier(); asm volatile("" ::: "memory"); }
        float rsv[8]; ROWS8_RSTD(SS, u.pm * 256 + wr * 64 + fr, rsv);
#pragma unroll
        for (int ai = 0; ai < 2; ++ai)
#pragma unroll
            for (int m = 0; m < 4; ++m) {
                const int rl = ai * 128 + wr * 64 + m * 16 + fr, row = u.pm * 256 + rl; const float rs = rsv[ai * 4 + m]; const float ro = RO[rl]; const float c1 = rs * -1.4426950408889634f, rs2 = rs * ro;
#pragma unroll
                for (int bj = 0; bj < 2; ++bj) {
                    const int col = u.pn * 256 + bj * 128 + wc * 32 + 8 * fq;
                    const u32x4 ov = *(const u32x4*)(O + (size_t)row * LDO + col);
                    const f32x4 g0 = acc[ai][bj][m][0], g1 = acc[ai][bj][m][1];
                    const f32x2 y0 = pk_silu_mul((f32x2){g0[0], g0[1]}, (f32x2){bf_lo(ov.x), bf_hi(ov.x)}, c1, rs2), y1 = pk_silu_mul((f32x2){g0[2], g0[3]}, (f32x2){bf_lo(ov.y), bf_hi(ov.y)}, c1, rs2);
                    const f32x2 y2 = pk_silu_mul((f32x2){g1[0], g1[1]}, (f32x2){bf_lo(ov.z), bf_hi(ov.z)}, c1, rs2), y3 = pk_silu_mul((f32x2){g1[2], g1[3]}, (f32x2){bf_lo(ov.w), bf_hi(ov.w)}, c1, rs2);
                    u32x4 w; w.x = cvt_pk_bf16(y0.x, y0.y); w.y = cvt_pk_bf16(y1.x, y1.y); w.z = cvt_pk_bf16(y2.x, y2.y); w.w = cvt_pk_bf16(y3.x, y3.y);
                    *(u32x4*)(Y + (size_t)row * LDO + col) = w;
                }
            }
        asm volatile("" ::: "memory"); __builtin_amdgcn_s_barrier(); asm volatile("" ::: "memory");
    }
};

struct EpiSiluG {
    const float* SS; bf16_t* G; int ldg;
    __device__ __forceinline__ void operator()(const f32x4 (&acc)[2][2][4][2], const pg8::Unit& u, int wr, int wc, int fr, int fq) const {
        float rsv[8]; ROWS8_RSTD(SS, u.pm * 256 + wr * 64 + fr, rsv);
#pragma unroll
        for (int ai = 0; ai < 2; ++ai)
#pragma unroll
            for (int m = 0; m < 4; ++m) {
                const int row = u.pm * 256 + ai * 128 + wr * 64 + m * 16 + fr; const float rs = rsv[ai * 4 + m], c1 = rs * -1.4426950408889634f;
#pragma unroll
                for (int bj = 0; bj < 2; ++bj) { const f32x4 g0 = acc[ai][bj][m][0], g1 = acc[ai][bj][m][1]; const f32x2 one = (f32x2){1.f, 1.f};
                    const f32x2 y0 = pk_silu_mul((f32x2){g0[0], g0[1]}, one, c1, rs), y1 = pk_silu_mul((f32x2){g0[2], g0[3]}, one, c1, rs);
                    const f32x2 y2 = pk_silu_mul((f32x2){g1[0], g1[1]}, one, c1, rs), y3 = pk_silu_mul((f32x2){g1[2], g1[3]}, one, c1, rs);
                    u32x4 w; w.x = cvt_pk_bf16(y0.x, y0.y); w.y = cvt_pk_bf16(y1.x, y1.y); w.z = cvt_pk_bf16(y2.x, y2.y); w.w = cvt_pk_bf16(y3.x, y3.y);
                    *(u32x4*)(G + (size_t)row * ldg + u.pn * 256 + bj * 128 + wc * 32 + 8 * fq) = w; }
            }
    }
};
struct EpiGlaIn {
    const float* SS; const float* BC; bf16_t* QH; bf16_t* KH; bf16_t* VT;
    __device__ __forceinline__ void operator()(const f32x4 (&acc)[2][2][4][2], const pg8::Unit& u, int wr, int wc, int fr, int fq) const {
        if (u.pn < 4) {
            const bool isq = u.pn < 2; bf16_t* dst = isq ? QH : KH;
            float rsv[8]; ROWS8_RSTD(SS, u.pm * 256 + wr * 64 + fr, rsv);
#pragma unroll
            for (int ai = 0; ai < 2; ++ai)
#pragma unroll
                for (int m = 0; m < 4; ++m) {
                    const int row = u.pm * 256 + ai * 128 + wr * 64 + m * 16 + fr; const float rs = rsv[ai * 4 + m] * (isq ? 0.08838834764831845f : 1.0f);
                    const int b = row >> 13, t = row & 8191;
#pragma unroll
                    for (int bj = 0; bj < 2; ++bj) {
                        const int cq = (u.pn & 1) * 256 + bj * 128 + wc * 32 + 8 * fq; const int head = cq >> 7, d = cq & 127;
                        const f32x4 c0 = *(const f32x4*)(BC + (size_t)row * 512 + cq), c1 = *(const f32x4*)(BC + (size_t)row * 512 + cq + 4);
                        float v[8];
#pragma unroll
                        for (int j = 0; j < 4; ++j) { v[j] = acc[ai][bj][m][0][j] * rs * __expf(isq ? c0[j] : -c0[j]); v[4 + j] = acc[ai][bj][m][1][j] * rs * __expf(isq ? c1[j] : -c1[j]); }
                        u32x4 w; w.x = cvt_pk_bf16(v[0], v[1]); w.y = cvt_pk_bf16(v[2], v[3]); w.z = cvt_pk_bf16(v[4], v[5]); w.w = cvt_pk_bf16(v[6], v[7]);
                        *(u32x4*)(dst + ((size_t)(b * 4 + head) * SEQ + t) * 128 + d) = w;
                    }
                }
        } else {
            float rs[2][8];
            { const float mine = row_rstd(SS, u.pm * 256 + (fr >> 3) * 128 + wc * 32 + 8 * fq + (fr & 7));
#pragma unroll
              for (int bj = 0; bj < 2; ++bj)
#pragma unroll
                  for (int e = 0; e < 8; ++e) rs[bj][e] = __shfl(mine, bj * 8 + e + 16 * fq); }
            const int b = u.pm >> 5, t0 = (u.pm & 31) * 256; const int head = u.pn - 4;
#pragma unroll
            for (int ai = 0; ai < 2; ++ai)
#pragma unroll
                for (int m = 0; m < 4; ++m) {
                    const int dvi = ai * 128 + wr * 64 + m * 16 + fr;
                    bf16_t* p = VT + ((size_t)(b * 4 + head) * 256 + dvi) * SEQ + t0 + wc * 32 + 8 * fq;
#pragma unroll
                    for (int bj = 0; bj < 2; ++bj) {
                        const f32x4 v0 = acc[ai][bj][m][0], v1 = acc[ai][bj][m][1];
                        u32x4 w; w.x = cvt_pk_bf16(v0[0] * rs[bj][0], v0[1] * rs[bj][1]); w.y = cvt_pk_bf16(v0[2] * rs[bj][2], v0[3] * rs[bj][3]);
                        w.z = cvt_pk_bf16(v1[0] * rs[bj][4], v1[1] * rs[bj][5]); w.w = cvt_pk_bf16(v1[2] * rs[bj][6], v1[3] * rs[bj][7]);
                        *(u32x4*)(p + bj * 128) = w;
                    }
                }
        }
    }
};
struct PtrNormal { const char* A; const char* B; size_t tstep;
    __device__ __forceinline__ void ptrs(const pg8::Unit& u, const char*& cA, const char*& cB) const { cA = A + (size_t)u.pm * tstep; cB = B + (size_t)u.pn * tstep; } };
struct PtrSwapFrom { const char* A; const char* B; size_t tstep; int pn_swap;
    __device__ __forceinline__ void ptrs(const pg8::Unit& u, const char*& cA, const char*& cB) const {
        const char* a = A + (size_t)u.pm * tstep; const char* b = B + (size_t)u.pn * tstep;
        if (u.pn >= pn_swap) { cA = b; cB = a; } else { cA = a; cB = b; } } };

constexpr int MA_RS_OFF = 98304, MA_RED_OFF = 100352;
template <int MODE> __device__ __forceinline__ void meta_tiles(Frame& F, const bf16_t* Bt, int N, int K, float* out, int ldo, float alpha, int b0, int nb) {
    const int lane = F.lane, g = lane >> 4, r16 = lane & 15, pitch = K + 8;
    const LAS bf16_t* A = (const LAS bf16_t*)F.lds; const LAS float* rsA = (const LAS float*)(F.lds + MA_RS_OFF); LAS f32x4* red = (LAS f32x4*)(F.lds + MA_RED_OFF);
    const int ksteps = K / 32, per = ksteps / 8;
    for (int tile = F.vb - b0; tile < N / 16; tile += nb) {
        f32x4 acc = (f32x4){0.f, 0.f, 0.f, 0.f};
        const bf16_t* bp = Bt + (size_t)(tile * 16 + r16) * K + 8 * g;
        for (int ks = F.wave * per; ks < (F.wave + 1) * per; ++ks) {
            const bf16x8 a = *(const LAS bf16x8*)(A + r16 * pitch + ks * 32 + 8 * g);
            const bf16x8 b = *(const bf16x8*)(bp + ks * 32);
            acc = __builtin_amdgcn_mfma_f32_16x16x32_bf16(a, b, acc, 0, 0, 0);
        }
        red[F.wave * 64 + lane] = acc;
        __syncthreads();
        if (F.wave == 0) {
            f32x4 s = red[lane];
#pragma unroll
            for (int w = 1; w < 8; ++w) s += red[w * 64 + lane];
#pragma unroll
            for (int j = 0; j < 4; ++j) { const int r = 4 * g + j; float* o = out + (size_t)r * ldo + tile * 16 + r16;
                if (MODE == 0) *o = s[j] * rsA[r]; else *o = *o + alpha * s[j]; }
        }
        __syncthreads();
    }
}
__device__ __forceinline__ bool meta_has_tiles(Frame& F, int N, int b0, int nb) { const int r = F.vb - b0; return r >= 0 && r < nb && r < N / 16; }
__device__ __forceinline__ void meta_prep_h(Frame& F) {
    const float* HM = WSP(float, WS_META + META_HM); LAS bf16_t* A = (LAS bf16_t*)F.lds; LAS float* rsA = (LAS float*)(F.lds + MA_RS_OFF);
    for (int r = F.wave; r < 16; r += 8) { float s = 0.f;
        for (int k = F.lane; k < D; k += 64) { const float v = HM[r * D + k]; s += v * v; A[r * (D + 8) + k] = f2bf(v); }
        s = wave_sum(s); if (F.lane == 0) rsA[r] = 1.0f / sqrtf(s * (1.0f / 1024.0f) + 1e-6f); }
    __syncthreads();
}
__device__ __forceinline__ void meta_prep_act(Frame& F) {
    const float* RAW = WSP(float, WS_META + META_RAW); LAS bf16_t* A = (LAS bf16_t*)F.lds; LAS float* rsA = (LAS float*)(F.lds + MA_RS_OFF);
    for (int i = F.tid; i < 16 * DFF; i += NTHREADS) { const int r = i / DFF, k = i % DFF, u = k >> 7, j = k & 127;
        const float g = RAW[r * 5632 + u * 256 + j], up = RAW[r * 5632 + u * 256 + 128 + j]; A[r * (DFF + 8) + k] = f2bf(fsilu(g) * up); }
    if (F.tid < 16) rsA[F.tid] = 1.f;
    __syncthreads();
}
__device__ __forceinline__ void meta_prep_y(Frame& F) {
    const float* RAW = WSP(float, WS_META + META_RAW); const float* MO = WSP(float, WS_META + META_MO);
    LAS bf16_t* A = (LAS bf16_t*)F.lds; LAS float* rsA = (LAS float*)(F.lds + MA_RS_OFF); LAS float* mro = (LAS float*)(F.lds + MA_RED_OFF);
    for (int p = F.wave; p < 64; p += 8) { const int r = p >> 2, head = p & 3; float sacc = 0.f;
        for (int k = F.lane; k < 512; k += 64) { const float v = MO[r * 2048 + head * 512 + k]; sacc += v * v; }
        sacc = wave_sum(sacc); if (F.lane == 0) mro[p] = 1.0f / sqrtf(sacc * (1.0f / 512.0f) + 1e-6f); }
    __syncthreads();
    for (int i = F.tid; i < 16 * 2048; i += NTHREADS) { const int r = i >> 11, k = i & 2047, head = k >> 9;
        A[r * (2048 + 8) + k] = f2bf(MO[r * 2048 + k] * mro[r * 4 + head] * fsilu(RAW[r * 6144 + 4096 + k])); }
    if (F.tid < 16) rsA[F.tid] = 1.f;
    __syncthreads();
}

__device__ __forceinline__ void meta_tiles_ksplit(Frame& F, const bf16_t* Bt, int K, int KQ, float* out, float alpha) {
    const int lane = F.lane, g = lane >> 4, r16 = lane & 15, pitch = KQ + 8;
    const LAS bf16_t* A = (const LAS bf16_t*)F.lds; LAS f32x4* red = (LAS f32x4*)(F.lds + MA_RED_OFF);
    const int item = F.vb; if (item >= 256) return;
    const int tile = item >> 2, kq = item & 3, nks = KQ / 32;
    f32x4 acc = (f32x4){0.f, 0.f, 0.f, 0.f};
    const bf16_t* bp = Bt + (size_t)(tile * 16 + r16) * K + kq * KQ + 8 * g;
    for (int ks = F.wave; ks < nks; ks += 8) {
        const bf16x8 a = *(const LAS bf16x8*)(A + r16 * pitch + ks * 32 + 8 * g);
        const bf16x8 b = *(const bf16x8*)(bp + ks * 32);
        acc = __builtin_amdgcn_mfma_f32_16x16x32_bf16(a, b, acc, 0, 0, 0);
    }
    red[F.wave * 64 + lane] = acc;
    __syncthreads();
    if (F.wave == 0) { f32x4 sacc = red[lane];
#pragma unroll
        for (int w = 1; w < 8; ++w) sacc += red[w * 64 + lane];
#pragma unroll
        for (int j = 0; j < 4; ++j) atomicAdd(out + (size_t)(4 * g + j) * D + tile * 16 + r16, alpha * sacc[j]); }
    __syncthreads();
}
__device__ __forceinline__ void meta_prep_act_q(Frame& F) {
    const float* RAW = WSP(float, WS_META + META_RAW); LAS bf16_t* A = (LAS bf16_t*)F.lds; const int kq = F.vb & 3;
    for (int i = F.tid; i < 16 * 704; i += NTHREADS) { const int r = i / 704, kk = i % 704, k = kq * 704 + kk, u = k >> 7, j = k & 127;
        const float gt = RAW[r * 5632 + u * 256 + j], up = RAW[r * 5632 + u * 256 + 128 + j]; A[r * (704 + 8) + kk] = f2bf(fsilu(gt) * up); }
    __syncthreads();
}
__device__ __forceinline__ void meta_prep_y_q(Frame& F) {
    const float* RAW = WSP(float, WS_META + META_RAW); const float* MO = WSP(float, WS_META + META_MO);
    LAS bf16_t* A = (LAS bf16_t*)F.lds; LAS float* mro = (LAS float*)(F.lds + MA_RED_OFF); const int head = F.vb & 3;
    for (int r = F.wave; r < 16; r += 8) { float sacc = 0.f;
        for (int k = F.lane; k < 512; k += 64) { const float v = MO[r * 2048 + head * 512 + k]; sacc += v * v; }
        sacc = wave_sum(sacc); if (F.lane == 0) mro[r] = 1.0f / sqrtf(sacc * (1.0f / 512.0f) + 1e-6f); }
    __syncthreads();
    for (int i = F.tid; i < 16 * 512; i += NTHREADS) { const int r = i >> 9, kk = i & 511, k = head * 512 + kk;
        A[r * (512 + 8) + kk] = f2bf(MO[r * 2048 + k] * mro[r] * fsilu(RAW[r * 6144 + 4096 + k])); }
    __syncthreads();
}
__device__ __forceinline__ void z_phase(Frame& F, const bf16_t* HB, const float* SS, const bf16_t* WZ, const float* wg, const float* bg, float* BC) {
    LAS float* zpart = (LAS float*)F.lds;
    LAS float* zs = (LAS float*)(F.lds + 8192);
    const int lane = F.lane, g = lane >> 4, r16 = lane & 15;
    for (int cidx = blockIdx.x; cidx < M / 64; cidx += F.G) {
        const int row0 = cidx * 64;
        { const int tile = F.wave & 3, kh = F.wave >> 2; f32x4 acc = (f32x4){0.f, 0.f, 0.f, 0.f};
          const bf16_t* ap = HB + (size_t)(row0 + tile * 16 + r16) * D + 8 * g; const bf16_t* bp = WZ + (size_t)r16 * D + 8 * g;
#pragma unroll
          for (int ks = kh * 16; ks < kh * 16 + 16; ++ks) {
              const bf16x8 a = *(const bf16x8*)(ap + ks * 32), b = *(const bf16x8*)(bp + ks * 32);
              acc = __builtin_amdgcn_mfma_f32_16x16x32_bf16(a, b, acc, 0, 0, 0);
          }
#pragma unroll
          for (int j = 0; j < 4; ++j) zpart[(kh * 64 + tile * 16 + 4 * g + j) * 16 + r16] = acc[j]; }
        __syncthreads();
        for (int i = F.tid; i < 64 * 16; i += NTHREADS) { const int t = i >> 4; zs[i] = (zpart[i] + zpart[1024 + i]) * row_rstd(SS, row0 + t); }
        __syncthreads();
        { const int c = F.tid; float w[16];
#pragma unroll
          for (int r = 0; r < 16; ++r) w[r] = wg[r * 512 + c];
          const float bias = bg[c]; float cum = 0.f;
          for (int t = 0; t < 64; ++t) { float a = bias; if (t == 32) cum = 0.f;
              const f32x4 z0 = *(const LAS f32x4*)(zs + t * 16), z1 = *(const LAS f32x4*)(zs + t * 16 + 4), z2 = *(const LAS f32x4*)(zs + t * 16 + 8), z3 = *(const LAS f32x4*)(zs + t * 16 + 12);
#pragma unroll
              for (int r = 0; r < 4; ++r) a += z0[r] * w[r] + z1[r] * w[4 + r] + z2[r] * w[8 + r] + z3[r] * w[12 + r];
              const float ls = fminf(a, 0.f) - __logf(1.0f + __expf(-fabsf(a)));
              cum += ls * 0.0625f; BC[(size_t)(row0 + t) * 512 + c] = cum; } }
        __syncthreads();
    }
}

typedef short v4i16_t __attribute__((ext_vector_type(4)));
__device__ __forceinline__ s16x4 ds_tr_asm(unsigned addr) { s16x4 r; asm volatile("ds_read_b64_tr_b16 %0, %1" : "=v"(r) : "v"(addr) : "memory"); return r; }
__device__ __forceinline__ s16x4 ds_tr(const LAS unsigned char* p) { return __builtin_bit_cast(s16x4, __builtin_amdgcn_ds_read_tr16_b64_v4i16((LAS v4i16_t*)p)); }
template <int DK, int DV, bool GLA>
__device__ __forceinline__ void s2_phase(Frame& F, const bf16_t* QH, const bf16_t* KH, const bf16_t* VT, bf16_t* O, float* OSS, const float* BC, int ldraw) {
    constexpr int NS = DV / 16, ROWB = DK * 2, TILEB = 64 * ROWB, NI = TILEB / 1024 / 8, NT = DK / 128, LDO = 4 * DV;
    constexpr int LQ = 0, LK = 2 * TILEB, LV = 4 * TILEB, LP = LV + 4096, LS = LP + 8192, LDEC = LS + 2 * 16 * ROWB;
    static_assert(LDEC + 2 * DK * 4 <= LDS_MISC, "S2 LDS map");
    const int unit = blockIdx.x; if (unit >= 8 * NS) return;
    const int bh = unit & 7, s = unit >> 3, b = bh >> 2, h = bh & 3;
    const int lane = F.lane, g = lane >> 4, r16 = lane & 15, w = F.wave;
    LAS unsigned char* L = F.lds; const unsigned Lb = (unsigned)(uintptr_t)L;
    const float* RAW = WSP(float, WS_META + META_RAW);
    for (int i = F.tid * 16; i < TILEB; i += NTHREADS * 16) { *(LAS u32x4*)(L + LQ + i) = (u32x4){0, 0, 0, 0}; *(LAS u32x4*)(L + LK + i) = (u32x4){0, 0, 0, 0}; }
    for (int i = F.tid * 16; i < 2048; i += NTHREADS * 16) *(LAS u32x4*)(L + LV + i) = (u32x4){0, 0, 0, 0};
    for (int i = F.tid * 16; i < 16 * ROWB; i += NTHREADS * 16) *(LAS u32x4*)(L + LS + i) = (u32x4){0, 0, 0, 0};
    __syncthreads();
    if (!GLA) {
        for (int idx = F.tid; idx < 16 * 128; idx += NTHREADS) { const int j = idx >> 7, c = idx & 127, row = 48 + j;
            const float* rq = RAW + (size_t)j * ldraw + h * 256; const float* rk = rq + 1024;
            const float rev = ((float)j * ROPE_INV[c]) * 0.15915494309189535f; const float frc = rev - floorf(rev);
            const float sn = __builtin_amdgcn_sinf(frc), cs = __builtin_amdgcn_cosf(frc);
            const float dq = __builtin_amdgcn_exp2f((float)(row + 1) * L2G[h]), dk = 0.0625f * __builtin_amdgcn_exp2f(-(float)(row + 1) * L2G[h]);
            const float q1 = rq[c], q2 = rq[c + 128], k1 = rk[c], k2 = rk[c + 128];
            const int a1 = row * ROWB + ((((c >> 3)) ^ (row & 15)) << 4) + (c & 7) * 2, a2 = row * ROWB + ((((c + 128) >> 3) ^ (row & 15)) << 4) + (c & 7) * 2;
            *(LAS bf16_t*)(L + LQ + a1) = f2bf((q1 * cs - q2 * sn) * dq); *(LAS bf16_t*)(L + LQ + a2) = f2bf((q1 * sn + q2 * cs) * dq);
            *(LAS bf16_t*)(L + LK + a1) = f2bf((k1 * cs - k2 * sn) * dk); *(LAS bf16_t*)(L + LK + a2) = f2bf((k1 * sn + k2 * cs) * dk); }
        if (F.tid < 256) { const int j = F.tid >> 4, wv = F.tid & 15, tok = 48 + j;
            *(LAS bf16_t*)(L + LV + wv * 128 + (((tok >> 3) ^ ((wv >> 1) & 7)) << 4) + (tok & 7) * 2) = f2bf(RAW[(size_t)j * ldraw + 2048 + h * 512 + 16 * s + wv]); }
    } else {
        if (F.tid < 128) { const int d = F.tid; const float* wgp = F.in[13] + h * 128 + d; const float bias = F.in[14][h * 128 + d]; float cum = 0.f;
            for (int j = 0; j < 16; ++j) { float a = bias;
                for (int r = 0; r < 16; ++r) a += RAW[(size_t)j * ldraw + 3072 + r] * wgp[r * 512];
                cum += (fminf(a, 0.f) - __logf(1.0f + __expf(-fabsf(a)))) * 0.0625f;
                const int row = 48 + j;
                *(LAS bf16_t*)(L + LK + row * ROWB + (((d >> 3) ^ (row & 15)) << 4) + (d & 7) * 2) = f2bf(RAW[(size_t)j * ldraw + 512 + h * 128 + d] * __expf(-cum)); }
            *(LAS float*)(L + LDEC + d * 4) = __expf(cum); }
        if (F.tid >= 256) { const int j = (F.tid - 256) >> 4, wv = F.tid & 15, tok = 48 + j;
            *(LAS bf16_t*)(L + LV + wv * 128 + (((tok >> 3) ^ ((wv >> 1) & 7)) << 4) + (tok & 7) * 2) = f2bf(RAW[(size_t)j * ldraw + 1024 + h * 256 + 16 * s + wv]); }
    }
    f32x4 S[NT];
#pragma unroll
    for (int tt = 0; tt < NT; ++tt) S[tt] = (f32x4){0.f, 0.f, 0.f, 0.f};
    const float g64 = GLA ? 1.0f : __builtin_amdgcn_exp2f(64.0f * L2G[h]);
    const char* Qg = (const char*)(QH + (size_t)bh * SEQ * DK); const char* Kg = (const char*)(KH + (size_t)bh * SEQ * DK);
    const char* Vg = (const char*)(VT + ((size_t)bh * DV + 16 * s) * SEQ);
    __syncthreads();
    for (int c = 0; c <= 128; ++c) {
        const int buf = c & 1;
        if (c < 128) {
            const char* qc = Qg + (size_t)c * TILEB; const char* kc = Kg + (size_t)c * TILEB;
#pragma unroll
            for (int i = 0; i < NI; ++i) { const int piece = w * NI + i, off = piece * 1024 + lane * 16, row = off / ROWB, p = (off % ROWB) >> 4; const int so = row * ROWB + ((p ^ (row & 15)) << 4);
                __builtin_amdgcn_global_load_lds((const unsigned*)(qc + so), (LAS unsigned*)(L + LQ + (buf ^ 1) * TILEB + piece * 1024), 16, 0, 0);
                __builtin_amdgcn_global_load_lds((const unsigned*)(kc + so), (LAS unsigned*)(L + LK + (buf ^ 1) * TILEB + piece * 1024), 16, 0, 0); }
            if (w < 2) { const int off = w * 1024 + lane * 16, wv = off >> 7, p = (off & 127) >> 4;
                __builtin_amdgcn_global_load_lds((const unsigned*)(Vg + (size_t)wv * SEQ * 2 + (size_t)c * 128 + ((p ^ ((wv >> 1) & 7)) << 4)), (LAS unsigned*)(L + LV + (buf ^ 1) * 2048 + w * 1024), 16, 0, 0); }
        }
        { const int ti = w >> 1, tj0 = 2 * (w & 1); f32x4 pt0 = (f32x4){0.f, 0.f, 0.f, 0.f}, pt1 = pt0;
          const int qrow = 16 * ti + r16, kr0 = 16 * tj0 + r16, kr1 = kr0 + 16;
          const LAS unsigned char* qb = L + LQ + buf * TILEB + qrow * ROWB; const LAS unsigned char* kb0 = L + LK + buf * TILEB + kr0 * ROWB; const LAS unsigned char* kb1 = L + LK + buf * TILEB + kr1 * ROWB;
#pragma unroll
          for (int ks = 0; ks < DK / 32; ++ks) { const int ch = ((4 * ks + g) ^ r16) << 4;
              const bf16x8 qf = *(const LAS bf16x8*)(qb + ch), k0 = *(const LAS bf16x8*)(kb0 + ch), k1 = *(const LAS bf16x8*)(kb1 + ch);
              pt0 = __builtin_amdgcn_mfma_f32_16x16x32_bf16(k0, qf, pt0, 0, 0, 0); pt1 = __builtin_amdgcn_mfma_f32_16x16x32_bf16(k1, qf, pt1, 0, 0, 0); }
          const int i = qrow;
#pragma unroll
          for (int tjj = 0; tjj < 2; ++tjj) { const f32x4 pt = tjj ? pt1 : pt0; const int tj = tj0 + tjj, j0 = 16 * tj + 4 * g;
              const float v0 = (j0 + 0 <= i) ? pt[0] : 0.f, v1 = (j0 + 1 <= i) ? pt[1] : 0.f, v2 = (j0 + 2 <= i) ? pt[2] : 0.f, v3 = (j0 + 3 <= i) ? pt[3] : 0.f;
              u32x2 pk; pk.x = cvt_pk_bf16(v0, v1); pk.y = cvt_pk_bf16(v2, v3);
              *(LAS u32x2*)(L + LP + i * 128 + (((2 * tj + (g >> 1)) ^ ((i >> 1) & 7)) << 4) + (g & 1) * 8) = pk; } }
        LDS_WAIT(); __builtin_amdgcn_s_barrier(); asm volatile("" ::: "memory");
        if (w < 4) { const int irow = 16 * w + r16; f32x4 ot = (f32x4){0.f, 0.f, 0.f, 0.f};
#pragma unroll
            for (int ks = 0; ks < 2; ++ks) {
                const bf16x8 va = *(const LAS bf16x8*)(L + LV + buf * 2048 + r16 * 128 + (((4 * ks + g) ^ ((r16 >> 1) & 7)) << 4));
                const bf16x8 pb = *(const LAS bf16x8*)(L + LP + irow * 128 + (((4 * ks + g) ^ ((irow >> 1) & 7)) << 4));
                ot = __builtin_amdgcn_mfma_f32_16x16x32_bf16(va, pb, ot, 0, 0, 0); }
#pragma unroll
            for (int ks = 0; ks < DK / 32; ++ks) { const int ch = ((4 * ks + g) ^ r16) << 4;
                const bf16x8 sa = *(const LAS bf16x8*)(L + LS + buf * 16 * ROWB + r16 * ROWB + ch);
                const bf16x8 qb = *(const LAS bf16x8*)(L + LQ + buf * TILEB + irow * ROWB + ch);
                ot = __builtin_amdgcn_mfma_f32_16x16x32_bf16(sa, qb, ot, 0, 0, 0); }
            float ss = (ot[0] * ot[0] + ot[1] * ot[1]) + (ot[2] * ot[2] + ot[3] * ot[3]);
            ss += __shfl_xor(ss, 16); ss += __shfl_xor(ss, 32);
            if (c >= 1) { const size_t grow = (size_t)b * SEQ + (c - 1) * 64 + irow;
                u32x2 pk; pk.x = cvt_pk_bf16(ot[0], ot[1]); pk.y = cvt_pk_bf16(ot[2], ot[3]);
                *(u32x2*)(O + grow * LDO + h * DV + 16 * s + 4 * g) = pk;
                if (g == 0) atomicAdd(OSS + grow * 4 + h, ss);
            } else if (!GLA && b == 0 && irow >= 48) { float* MO = WSP(float, WS_META + META_MO); float* MOSS = WSP(float, WS_CTL + CTL_MOSS);
                *(f32x4*)(MO + (size_t)(irow - 48) * 2048 + h * 512 + 16 * s + 4 * g) = ot;
                if (g == 0) atomicAdd(MOSS + (irow - 48) * 4 + h, ss); } }
        {
#pragma unroll
          for (int ks = 0; ks < 2; ++ks) {
              const bf16x8 vb = *(const LAS bf16x8*)(L + LV + buf * 2048 + r16 * 128 + (((4 * ks + g) ^ ((r16 >> 1) & 7)) << 4));
#pragma unroll
              for (int tt = 0; tt < NT; ++tt) { const int d0 = 16 * (w + 8 * tt), dcol = d0 + 4 * (r16 & 3), chunk = dcol >> 3, sub = (dcol & 7) * 2;
                  const int r1 = 32 * ks + 8 * g + (r16 >> 2), r2 = r1 + 4;
                  const s16x4 lo = ds_tr(L + LK + buf * TILEB + r1 * ROWB + ((chunk ^ (r1 & 15)) << 4) + sub);
                  const s16x4 hi = ds_tr(L + LK + buf * TILEB + r2 * ROWB + ((chunk ^ (r2 & 15)) << 4) + sub);
                  const bf16x8 ka = (bf16x8){lo[0], lo[1], lo[2], lo[3], hi[0], hi[1], hi[2], hi[3]};
                  S[tt] = __builtin_amdgcn_mfma_f32_16x16x32_bf16(ka, vb, S[tt], 0, 0, 0); } }
#pragma unroll
          for (int tt = 0; tt < NT; ++tt) { const int tile = w + 8 * tt;
              if (GLA) { const f32x4 dc = *(const LAS f32x4*)(L + LDEC + buf * DK * 4 + (16 * tile + 4 * g) * 4); S[tt] = S[tt] * dc; } else S[tt] = S[tt] * g64;
              u32x2 pk; pk.x = cvt_pk_bf16(S[tt][0], S[tt][1]); pk.y = cvt_pk_bf16(S[tt][2], S[tt][3]);
              *(LAS u32x2*)(L + LS + (buf ^ 1) * 16 * ROWB + r16 * ROWB + (((2 * tile + (g >> 1)) ^ r16) << 4) + (g & 1) * 8) = pk; } }
        if (GLA && c < 128 && F.tid < DK) *(LAS float*)(L + LDEC + (buf ^ 1) * DK * 4 + F.tid * 4) = __expf(BC[(size_t)(b * SEQ + c * 64 + 63) * 512 + h * 128 + F.tid]);
        __syncthreads();
    }
}

__device__ __forceinline__ bf16x8 gload16(const void* p) { bf16x8 r; asm volatile("global_load_dwordx4 %0, %1, off" : "=v"(r) : "v"(p) : "memory"); return r; }
__device__ __forceinline__ void glds_touch(const void* gsrc, unsigned lds_dst) { unsigned keep; asm volatile("s_mov_b32 %0, m0\n\ts_mov_b32 m0, %2\n\ts_nop 0\n\tglobal_load_lds_dword %1, off\n\ts_mov_b32 m0, %0" : "=&s"(keep) : "v"(gsrc), "s"(lds_dst) : "memory"); }
#define S2_WAITV(n) asm volatile("s_waitcnt vmcnt(" #n ")" ::: "memory")
template <int DK, int DV, bool GLA>
__device__ __forceinline__ void s2v2_phase(Frame& F, const bf16_t* QH, const bf16_t* KH, const bf16_t* VT, bf16_t* O, float* OSS, const float* BC, int ldraw) {
    constexpr int NS = DV / 16, ROWB = DK * 2, TILEB = 64 * ROWB, NI = TILEB / 1024 / 8, NT = DK / 128, LDO = 4 * DV, KS = DK / 32;
    constexpr int LK = 0, LV = 3 * TILEB, LDEC = LV + 3 * 2048, LP = LDEC + 3 * 1024, LS = LP + 8192, LOT = LS + 2 * 16 * ROWB, LQM = LOT + 4096, LEND = LQM + 16 * ROWB;
    static_assert(LEND <= LDS_MISC, "S2 LDS map");
    const int unit = blockIdx.x; if (unit >= 8 * NS) return;
    const int bh = unit & 7, s = unit >> 3, b = bh >> 2, h = bh & 3;
    const int lane = F.lane, g = lane >> 4, r16 = lane & 15, w = F.wave, ti = w >> 1, hf = w & 1;
    LAS unsigned char* L = F.lds; const unsigned Lb = (unsigned)(uintptr_t)L;
    const float* RAW = WSP(float, WS_META + META_RAW);
    const char* Qg = (const char*)(QH + (size_t)bh * SEQ * DK); const char* Kg = (const char*)(KH + (size_t)bh * SEQ * DK);
    const char* Vg = (const char*)(VT + ((size_t)bh * DV + 16 * s) * SEQ);
    const char* qlane = Qg + (size_t)(16 * ti + r16) * ROWB + g * 16;
    bf16x8 q0[KS], q1[KS], q2[KS];
#define S2_ISSUE(c_, QSET) do { const int rc_ = (c_) - 1, st_ = (c_) % 3; const char* kc_ = Kg + (size_t)rc_ * TILEB; \
        _Pragma("unroll") for (int i_ = 0; i_ < NI; ++i_) { const int piece_ = w * NI + i_, off_ = piece_ * 1024 + lane * 16, row_ = off_ / ROWB, p_ = (off_ % ROWB) >> 4; \
            __builtin_amdgcn_global_load_lds((const unsigned*)(kc_ + row_ * ROWB + ((p_ ^ (row_ & 15)) << 4)), (LAS unsigned*)(L + LK + st_ * TILEB + piece_ * 1024), 16, 0, 0); } \
        if (w < 2) { const int off_ = w * 1024 + lane * 16, wv_ = off_ >> 7, p_ = (off_ & 127) >> 4; \
            __builtin_amdgcn_global_load_lds((const unsigned*)(Vg + (size_t)wv_ * SEQ * 2 + (size_t)rc_ * 128 + ((p_ ^ ((wv_ >> 1) & 7)) << 4)), (LAS unsigned*)(L + LV + st_ * 2048 + w * 1024), 16, 0, 0); } \
        if (GLA && w == 2) __builtin_amdgcn_global_load_lds((const unsigned*)((const char*)(BC + (size_t)(b * SEQ + rc_ * 64 + 63) * 512 + h * 128) + lane * 16), (LAS unsigned*)(L + LDEC + st_ * 1024), 16, 0, 0); \
        _Pragma("unroll") for (int k_ = 0; k_ < KS; ++k_) QSET[k_] = gload16(qlane + (size_t)rc_ * TILEB + k_ * 64); } while (0)
#define S2_WAIT_PREV() do { if (w < 2 || (GLA && w == 2)) { if (NI + KS + 1 == 13) S2_WAITV(13); else S2_WAITV(7); } else { if (NI + KS == 12) S2_WAITV(12); else S2_WAITV(6); } } while (0)
    static_assert((NI + KS == 12) || (NI + KS == 6), "S2 wait immediates");
    for (int i = F.tid * 16; i < TILEB; i += NTHREADS * 16) *(LAS u32x4*)(L + LK + i) = (u32x4){0, 0, 0, 0};
    for (int i = F.tid * 16; i < 2048; i += NTHREADS * 16) *(LAS u32x4*)(L + LV + i) = (u32x4){0, 0, 0, 0};
    for (int i = F.tid * 16; i < 16 * ROWB; i += NTHREADS * 16) { *(LAS u32x4*)(L + LS + i) = (u32x4){0, 0, 0, 0}; *(LAS u32x4*)(L + LQM + i) = (u32x4){0, 0, 0, 0}; }
    __syncthreads();
    if (!GLA) {
        for (int idx = F.tid; idx < 16 * 128; idx += NTHREADS) { const int j = idx >> 7, c = idx & 127, row = 48 + j;
            const float* rq = RAW + (size_t)j * ldraw + h * 256; const float* rk = rq + 1024;
            const float rev = ((float)j * ROPE_INV[c]) * 0.15915494309189535f; const float frc = rev - floorf(rev);
            const float sn = __builtin_amdgcn_sinf(frc), cs = __builtin_amdgcn_cosf(frc);
            const float dq = __builtin_amdgcn_exp2f((float)(row + 1) * L2G[h]), dk = 0.0625f * __builtin_amdgcn_exp2f(-(float)(row + 1) * L2G[h]);
            const float q1v = rq[c], q2v = rq[c + 128], k1 = rk[c], k2 = rk[c + 128];
            const int a1 = row * ROWB + ((((c >> 3)) ^ (row & 15)) << 4) + (c & 7) * 2, a2 = row * ROWB + ((((c + 128) >> 3) ^ (row & 15)) << 4) + (c & 7) * 2;
            *(LAS bf16_t*)(L + LQM + j * ROWB + c * 2) = f2bf((q1v * cs - q2v * sn) * dq); *(LAS bf16_t*)(L + LQM + j * ROWB + (c + 128) * 2) = f2bf((q1v * sn + q2v * cs) * dq);
            *(LAS bf16_t*)(L + LK + a1) = f2bf((k1 * cs - k2 * sn) * dk); *(LAS bf16_t*)(L + LK + a2) = f2bf((k1 * sn + k2 * cs) * dk); }
        if (F.tid < 256) { const int j = F.tid >> 4, wv = F.tid & 15, tok = 48 + j;
            *(LAS bf16_t*)(L + LV + wv * 128 + (((tok >> 3) ^ ((wv >> 1) & 7)) << 4) + (tok & 7) * 2) = f2bf(RAW[(size_t)j * ldraw + 2048 + h * 512 + 16 * s + wv]); }
    } else {
        if (F.tid < 128) { const int d = F.tid; const float* wgp = F.in[13] + h * 128 + d; const float bias = F.in[14][h * 128 + d]; float cum = 0.f;
            for (int j = 0; j < 16; ++j) { float a = bias;
                for (int r = 0; r < 16; ++r) a += RAW[(size_t)j * ldraw + 3072 + r] * wgp[r * 512];
                cum += (fminf(a, 0.f) - __logf(1.0f + __expf(-fabsf(a)))) * 0.0625f;
                const int row = 48 + j;
                *(LAS bf16_t*)(L + LK + row * ROWB + (((d >> 3) ^ (row & 15)) << 4) + (d & 7) * 2) = f2bf(RAW[(size_t)j * ldraw + 512 + h * 128 + d] * __expf(-cum)); }
            *(LAS float*)(L + LDEC + d * 4) = cum; }
        if (F.tid >= 256) { const int j = (F.tid - 256) >> 4, wv = F.tid & 15, tok = 48 + j;
            *(LAS bf16_t*)(L + LV + wv * 128 + (((tok >> 3) ^ ((wv >> 1) & 7)) << 4) + (tok & 7) * 2) = f2bf(RAW[(size_t)j * ldraw + 1024 + h * 256 + 16 * s + wv]); }
    }
    f32x4 S[NT];
#pragma unroll
    for (int tt = 0; tt < NT; ++tt) S[tt] = (f32x4){0.f, 0.f, 0.f, 0.f};
    const float g64 = GLA ? 1.0f : __builtin_amdgcn_exp2f(64.0f * L2G[h]);
    __syncthreads();
#pragma unroll
    for (int k = 0; k < KS; ++k) { q0[k] = *(const LAS bf16x8*)(L + LQM + (ti == 3 ? r16 : 0) * ROWB + (4 * k + g) * 16); if (ti != 3) q0[k] = (bf16x8){0, 0, 0, 0, 0, 0, 0, 0}; q1[k] = q0[k]; q2[k] = q0[k]; }
    LDS_WAIT();
    S2_ISSUE(1, q1);
    f32x4 ot_prev = (f32x4){0.f, 0.f, 0.f, 0.f}; float ss_prev = 0.f;
#define S2_STEP(c_, QC, QN2) do { const int c = (c_), st = c % 3, sb = c & 1; \
          \
        if (hf == 0 && c >= 1) { const f32x4 part = *(const LAS f32x4*)(L + LOT + ti * 1024 + lane * 16); const f32x4 ot = ot_prev + part; const int irow = 16 * ti + r16; \
            if (c >= 2) { const size_t grow = (size_t)b * SEQ + (c - 2) * 64 + irow; u32x2 pk; pk.x = cvt_pk_bf16(ot[0], ot[1]); pk.y = cvt_pk_bf16(ot[2], ot[3]); \
                *(u32x2*)(O + grow * LDO + h * DV + 16 * s + 4 * g) = pk; } \
            else if (!GLA && b == 0 && irow >= 48) { float* MO = WSP(float, WS_META + META_MO); \
                *(f32x4*)(MO + (size_t)(irow - 48) * 2048 + h * 512 + 16 * s + 4 * g) = ot; } } \
        if (c + 2 <= 128) S2_ISSUE(c + 2, QN2); \
          \
        { const int tj0 = 2 * hf; f32x4 pt0 = (f32x4){0.f, 0.f, 0.f, 0.f}, pt1 = pt0; \
          const LAS unsigned char* kb0 = L + LK + st * TILEB + (16 * tj0 + r16) * ROWB; const LAS unsigned char* kb1 = kb0 + 16 * ROWB; \
          _Pragma("unroll") for (int ks = 0; ks < KS; ++ks) { const int ch = ((4 * ks + g) ^ r16) << 4; \
              const bf16x8 k0 = *(const LAS bf16x8*)(kb0 + ch), k1 = *(const LAS bf16x8*)(kb1 + ch); \
              pt0 = __builtin_amdgcn_mfma_f32_16x16x32_bf16(k0, QC[ks], pt0, 0, 0, 0); pt1 = __builtin_amdgcn_mfma_f32_16x16x32_bf16(k1, QC[ks], pt1, 0, 0, 0); } \
          const int i = 16 * ti + r16; \
          _Pragma("unroll") for (int tjj = 0; tjj < 2; ++tjj) { const f32x4 pt = tjj ? pt1 : pt0; const int tj = tj0 + tjj, j0 = 16 * tj + 4 * g; \
              const float v0 = (j0 + 0 <= i) ? pt[0] : 0.f, v1 = (j0 + 1 <= i) ? pt[1] : 0.f, v2 = (j0 + 2 <= i) ? pt[2] : 0.f, v3 = (j0 + 3 <= i) ? pt[3] : 0.f; \
              u32x2 pk; pk.x = cvt_pk_bf16(v0, v1); pk.y = cvt_pk_bf16(v2, v3); \
              *(LAS u32x2*)(L + LP + i * 128 + (((2 * tj + (g >> 1)) ^ ((i >> 1) & 7)) << 4) + (g & 1) * 8) = pk; } } \
        LDS_WAIT(); __builtin_amdgcn_s_barrier(); asm volatile("" ::: "memory"); \
          \
        { const int irow = 16 * ti + r16; f32x4 ot = (f32x4){0.f, 0.f, 0.f, 0.f}; \
          if (hf == 0) { _Pragma("unroll") for (int ks = 0; ks < 2; ++ks) { \
                const bf16x8 va = *(const LAS bf16x8*)(L + LV + st * 2048 + r16 * 128 + (((4 * ks + g) ^ ((r16 >> 1) & 7)) << 4)); \
                const bf16x8 pb = *(const LAS bf16x8*)(L + LP + irow * 128 + (((4 * ks + g) ^ ((irow >> 1) & 7)) << 4)); \
                ot = __builtin_amdgcn_mfma_f32_16x16x32_bf16(va, pb, ot, 0, 0, 0); } } \
          if (hf == 0) { _Pragma("unroll") for (int kk = 0; kk < KS / 2; ++kk) { \
              const bf16x8 sa = *(const LAS bf16x8*)(L + LS + sb * 16 * ROWB + r16 * ROWB + (((4 * kk + g) ^ r16) << 4)); \
              ot = __builtin_amdgcn_mfma_f32_16x16x32_bf16(sa, QC[kk], ot, 0, 0, 0); } } \
          else { _Pragma("unroll") for (int kk = KS / 2; kk < KS; ++kk) { \
              const bf16x8 sa = *(const LAS bf16x8*)(L + LS + sb * 16 * ROWB + r16 * ROWB + (((4 * kk + g) ^ r16) << 4)); \
              ot = __builtin_amdgcn_mfma_f32_16x16x32_bf16(sa, QC[kk], ot, 0, 0, 0); } } \
          if (hf == 1) *(LAS f32x4*)(L + LOT + ti * 1024 + lane * 16) = ot; else ot_prev = ot; } \
          \
        { s16x4 klo[2][NT], khi[2][NT]; bf16x8 vbb[2]; \
          _Pragma("unroll") for (int ks = 0; ks < 2; ++ks) { \
              vbb[ks] = *(const LAS bf16x8*)(L + LV + st * 2048 + r16 * 128 + (((4 * ks + g) ^ ((r16 >> 1) & 7)) << 4)); \
              _Pragma("unroll") for (int tt = 0; tt < NT; ++tt) { const int d0 = 16 * (w + 8 * tt), dcol = d0 + 4 * (r16 & 3), chunk = dcol >> 3, sub = (dcol & 7) * 2; \
                  const int r1 = 32 * ks + 8 * g + (r16 >> 2), r2 = r1 + 4; \
                  klo[ks][tt] = ds_tr_asm(Lb + LK + st * TILEB + r1 * ROWB + ((chunk ^ (r1 & 15)) << 4) + sub); \
                  khi[ks][tt] = ds_tr_asm(Lb + LK + st * TILEB + r2 * ROWB + ((chunk ^ (r2 & 15)) << 4) + sub); } } \
          asm volatile("s_waitcnt lgkmcnt(0)" ::: "memory"); __builtin_amdgcn_sched_barrier(0); \
          _Pragma("unroll") for (int ks = 0; ks < 2; ++ks) _Pragma("unroll") for (int tt = 0; tt < NT; ++tt) { \
                  const s16x4 lo = klo[ks][tt], hi = khi[ks][tt]; \
                  const bf16x8 ka = (bf16x8){lo[0], lo[1], lo[2], lo[3], hi[0], hi[1], hi[2], hi[3]}; \
                  S[tt] = __builtin_amdgcn_mfma_f32_16x16x32_bf16(ka, vbb[ks], S[tt], 0, 0, 0); } \
          _Pragma("unroll") for (int tt = 0; tt < NT; ++tt) { const int tile = w + 8 * tt; \
              if (GLA) { const f32x4 dl = *(const LAS f32x4*)(L + LDEC + st * 1024 + (16 * tile + 4 * g) * 4); \
                  S[tt][0] *= __expf(dl[0]); S[tt][1] *= __expf(dl[1]); S[tt][2] *= __expf(dl[2]); S[tt][3] *= __expf(dl[3]); } else S[tt] = S[tt] * g64; \
              u32x2 pk; pk.x = cvt_pk_bf16(S[tt][0], S[tt][1]); pk.y = cvt_pk_bf16(S[tt][2], S[tt][3]); \
              *(LAS u32x2*)(L + LS + (sb ^ 1) * 16 * ROWB + r16 * ROWB + (((2 * tile + (g >> 1)) ^ r16) << 4) + (g & 1) * 8) = pk; } } \
          \
        if (c + 2 <= 128) S2_WAIT_PREV(); else S2_WAITV(0); \
        LDS_WAIT(); __builtin_amdgcn_s_barrier(); asm volatile("" ::: "memory"); __builtin_amdgcn_sched_barrier(0); \
    } while (0)
#define S2_PIN(Q) do { _Pragma("unroll") for (int k_ = 0; k_ < KS; ++k_) asm volatile("" : "+v"(Q[k_])); } while (0)
    for (int c3 = 0; c3 < 129; c3 += 3) {
        S2_STEP(c3, q0, q2);     S2_PIN(q1);
        S2_STEP(c3 + 1, q1, q0); S2_PIN(q2);
        S2_STEP(c3 + 2, q2, q1); S2_PIN(q0);
    }
    if (hf == 0) { const f32x4 part = *(const LAS f32x4*)(L + LOT + ti * 1024 + lane * 16); const f32x4 ot = ot_prev + part; const int irow = 16 * ti + r16;
        const size_t grow = (size_t)b * SEQ + 127 * 64 + irow; u32x2 pk; pk.x = cvt_pk_bf16(ot[0], ot[1]); pk.y = cvt_pk_bf16(ot[2], ot[3]);
        *(u32x2*)(O + grow * LDO + h * DV + 16 * s + 4 * g) = pk; }
#undef S2_ISSUE
#undef S2_WAIT_PREV
#undef S2_STEP
#undef S2_PIN
}

template <int DK, int DV, bool GLA>
__device__ __forceinline__ void s2v3_phase(Frame& F, const bf16_t* QH, const bf16_t* KH, const bf16_t* VT, bf16_t* O, const float* BC, int ldraw) {
    constexpr int NS = DV / 16, ROWB = DK * 2, TILEB = 64 * ROWB, NIL = TILEB / 1024 / 4, NTU = DK / 64, LDO = 4 * DV, KS = DK / 32;
    constexpr int LK = 0, LV = 3 * TILEB, LDEC = LV + 3 * 2048, LP = LDEC + 3 * 1024, LS = LP + 8192, LOT = LS + 2 * 16 * ROWB, LQM = LOT + 4096, LEND = LQM + 16 * ROWB;
    static_assert(LEND <= LDS_MISC, "S2 LDS map");
    static_assert((NIL + KS == 16) || (NIL + KS == 8), "S2 wait immediates");
    const int unit = blockIdx.x; if (unit >= 8 * NS) return;
    const int bh = unit & 7, s = unit >> 3, b = bh >> 2, h = bh & 3;
    const int lane = F.lane, g = lane >> 4, r16 = lane & 15, w = F.wave, ti = w >> 1, hf = w & 1;
    LAS unsigned char* L = F.lds; const unsigned Lb = (unsigned)(uintptr_t)L;
    const float* RAW = WSP(float, WS_META + META_RAW);
    const char* Qg = (const char*)(QH + (size_t)bh * SEQ * DK); const char* Kg = (const char*)(KH + (size_t)bh * SEQ * DK);
    const char* Vg = (const char*)(VT + ((size_t)bh * DV + 16 * s) * SEQ);
    const char* qlane = Qg + (size_t)(16 * ti + r16) * ROWB + g * 16;
    bf16x8 q0[KS], q1[KS], q2[KS];
#define S3_ISSUE(c_, ST_, QSET) do { unsigned lzi_ = 0; asm volatile("" : "+v"(lzi_)); const int rc_ = (c_) - 1; constexpr int st_ = (ST_); const char* kc_ = Kg + (size_t)rc_ * TILEB + lzi_; \
        _Pragma("unroll") for (int i_ = 0; i_ < NIL; ++i_) { const int piece_ = ti * NIL + i_, off_ = piece_ * 1024 + lane * 16, row_ = off_ / ROWB, p_ = (off_ % ROWB) >> 4; \
            __builtin_amdgcn_global_load_lds((const unsigned*)(kc_ + row_ * ROWB + ((p_ ^ (row_ & 15)) << 4)), (LAS unsigned*)(L + LK + st_ * TILEB + piece_ * 1024), 16, 0, 0); } \
        if (ti < 2) { const int off_ = ti * 1024 + lane * 16, wv_ = off_ >> 7, p_ = (off_ & 127) >> 4; \
            __builtin_amdgcn_global_load_lds((const unsigned*)(Vg + (size_t)wv_ * SEQ * 2 + (size_t)rc_ * 128 + ((p_ ^ ((wv_ >> 1) & 7)) << 4)), (LAS unsigned*)(L + LV + st_ * 2048 + ti * 1024), 16, 0, 0); } \
        if (GLA && ti == 2) __builtin_amdgcn_global_load_lds((const unsigned*)((const char*)(BC + (size_t)(b * SEQ + rc_ * 64 + 63) * 512 + h * 128) + lane * 16), (LAS unsigned*)(L + LDEC + st_ * 1024), 16, 0, 0); \
        _Pragma("unroll") for (int k_ = 0; k_ < KS; ++k_) QSET[k_] = gload16(qlane + (size_t)rc_ * TILEB + k_ * 64); } while (0)
#define S3_WAIT_PREV() do { if (ti < 2 || (GLA && ti == 2)) { if (NIL + KS == 16) S2_WAITV(17); else S2_WAITV(9); } else { if (NIL + KS == 16) S2_WAITV(16); else S2_WAITV(8); } } while (0)
    for (int i = F.tid * 16; i < TILEB; i += NTHREADS * 16) *(LAS u32x4*)(L + LK + i) = (u32x4){0, 0, 0, 0};
    for (int i = F.tid * 16; i < 2048; i += NTHREADS * 16) *(LAS u32x4*)(L + LV + i) = (u32x4){0, 0, 0, 0};
    for (int i = F.tid * 16; i < 16 * ROWB; i += NTHREADS * 16) { *(LAS u32x4*)(L + LS + i) = (u32x4){0, 0, 0, 0}; *(LAS u32x4*)(L + LQM + i) = (u32x4){0, 0, 0, 0}; }
    __syncthreads();
    if (!GLA) {
        for (int idx = F.tid; idx < 16 * 128; idx += NTHREADS) { const int j = idx >> 7, c = idx & 127, row = 48 + j;
            const float* rq = RAW + (size_t)j * ldraw + h * 256; const float* rk = rq + 1024;
            const float rev = ((float)j * ROPE_INV[c]) * 0.15915494309189535f; const float frc = rev - floorf(rev);
            const float sn = __builtin_amdgcn_sinf(frc), cs = __builtin_amdgcn_cosf(frc);
            const float dq = __builtin_amdgcn_exp2f((float)(row + 1) * L2G[h]), dk = 0.0625f * __builtin_amdgcn_exp2f(-(float)(row + 1) * L2G[h]);
            const float q1v = rq[c], q2v = rq[c + 128], k1 = rk[c], k2 = rk[c + 128];
            const int a1 = row * ROWB + ((((c >> 3)) ^ (row & 15)) << 4) + (c & 7) * 2, a2 = row * ROWB + ((((c + 128) >> 3) ^ (row & 15)) << 4) + (c & 7) * 2;
            *(LAS bf16_t*)(L + LQM + j * ROWB + c * 2) = f2bf((q1v * cs - q2v * sn) * dq); *(LAS bf16_t*)(L + LQM + j * ROWB + (c + 128) * 2) = f2bf((q1v * sn + q2v * cs) * dq);
            *(LAS bf16_t*)(L + LK + a1) = f2bf((k1 * cs - k2 * sn) * dk); *(LAS bf16_t*)(L + LK + a2) = f2bf((k1 * sn + k2 * cs) * dk); }
        if (F.tid < 256) { const int j = F.tid >> 4, wv = F.tid & 15, tok = 48 + j;
            *(LAS bf16_t*)(L + LV + wv * 128 + (((tok >> 3) ^ ((wv >> 1) & 7)) << 4) + (tok & 7) * 2) = f2bf(RAW[(size_t)j * ldraw + 2048 + h * 512 + 16 * s + wv]); }
    } else {
        if (F.tid < 128) { const int d = F.tid; const float* wgp = F.in[13] + h * 128 + d; const float bias = F.in[14][h * 128 + d]; float cum = 0.f;
            for (int j = 0; j < 16; ++j) { float a = bias;
                for (int r = 0; r < 16; ++r) a += RAW[(size_t)j * ldraw + 3072 + r] * wgp[r * 512];
                cum += (fminf(a, 0.f) - __logf(1.0f + __expf(-fabsf(a)))) * 0.0625f;
                const int row = 48 + j;
                *(LAS bf16_t*)(L + LK + row * ROWB + (((d >> 3) ^ (row & 15)) << 4) + (d & 7) * 2) = f2bf(RAW[(size_t)j * ldraw + 512 + h * 128 + d] * __expf(-cum)); }
            *(LAS float*)(L + LDEC + d * 4) = cum; }
        if (F.tid >= 256) { const int j = (F.tid - 256) >> 4, wv = F.tid & 15, tok = 48 + j;
            *(LAS bf16_t*)(L + LV + wv * 128 + (((tok >> 3) ^ ((wv >> 1) & 7)) << 4) + (tok & 7) * 2) = f2bf(RAW[(size_t)j * ldraw + 1024 + h * 256 + 16 * s + wv]); }
    }
    f32x4 S[NTU];
#pragma unroll
    for (int tt = 0; tt < NTU; ++tt) S[tt] = (f32x4){0.f, 0.f, 0.f, 0.f};
    const float g64 = GLA ? 1.0f : __builtin_amdgcn_exp2f(64.0f * L2G[h]);
    __syncthreads();
#pragma unroll
    for (int k = 0; k < KS; ++k) { q0[k] = *(const LAS bf16x8*)(L + LQM + (ti == 3 ? r16 : 0) * ROWB + (4 * k + g) * 16); if (ti != 3) q0[k] = (bf16x8){0, 0, 0, 0, 0, 0, 0, 0}; asm volatile("" : "=v"(q1[k])); asm volatile("" : "=v"(q2[k])); }
    LDS_WAIT();
    if (hf) S3_ISSUE(1, 1, q1);
    f32x4 ot_prev = (f32x4){0.f, 0.f, 0.f, 0.f};
#define S3_STEP(c_, ST, QC, QN2) do { const int c = (c_), sb = c & 1; constexpr int st = (ST); \
        unsigned lz_ = 0; asm volatile("" : "+v"(lz_)); LAS unsigned char* const Lz = L + lz_; const unsigned Lbz = Lb + lz_;   \
        if (hf == 0) { \
              \
            if (c >= 1) { const f32x4 part = *(const LAS f32x4*)(Lz + LOT + ti * 1024 + lane * 16); const f32x4 ot = ot_prev + part; const int irow = 16 * ti + r16; \
                if (c >= 2) { const size_t grow = (size_t)b * SEQ + (c - 2) * 64 + irow; u32x2 pk; pk.x = cvt_pk_bf16(ot[0], ot[1]); pk.y = cvt_pk_bf16(ot[2], ot[3]); \
                    *(u32x2*)(O + grow * LDO + h * DV + 16 * s + 4 * g) = pk; } \
                else if (!GLA && b == 0 && irow >= 48) { float* MO = WSP(float, WS_META + META_MO); *(f32x4*)(MO + (size_t)(irow - 48) * 2048 + h * 512 + 16 * s + 4 * g) = ot; } } \
              \
            { bf16x8 vbb[2]; \
              _Pragma("unroll") for (int ks = 0; ks < 2; ++ks) vbb[ks] = *(const LAS bf16x8*)(Lz + LV + st * 2048 + r16 * 128 + (((4 * ks + g) ^ ((r16 >> 1) & 7)) << 4)); \
              _Pragma("unroll") for (int tt = 0; tt < NTU; ++tt) { const int tile = ti + 4 * tt, d0 = 16 * tile, dcol = d0 + 4 * (r16 & 3), chunk = dcol >> 3, sub = (dcol & 7) * 2; \
                  s16x4 klo[2], khi[2]; \
                  _Pragma("unroll") for (int ks = 0; ks < 2; ++ks) { const int r1 = 32 * ks + 8 * g + (r16 >> 2), r2 = r1 + 4; \
                      klo[ks] = ds_tr_asm(Lbz + LK + st * TILEB + r1 * ROWB + ((chunk ^ (r1 & 15)) << 4) + sub); \
                      khi[ks] = ds_tr_asm(Lbz + LK + st * TILEB + r2 * ROWB + ((chunk ^ (r2 & 15)) << 4) + sub); } \
                  asm volatile("s_waitcnt lgkmcnt(0)" ::: "memory"); __builtin_amdgcn_sched_barrier(0); \
                  _Pragma("unroll") for (int ks = 0; ks < 2; ++ks) { const s16x4 lo = klo[ks], hi = khi[ks]; \
                      const bf16x8 ka = (bf16x8){lo[0], lo[1], lo[2], lo[3], hi[0], hi[1], hi[2], hi[3]}; \
                      S[tt] = __builtin_amdgcn_mfma_f32_16x16x32_bf16(ka, vbb[ks], S[tt], 0, 0, 0); } \
                  if (GLA) { const f32x4 dl = *(const LAS f32x4*)(Lz + LDEC + st * 1024 + (16 * tile + 4 * g) * 4); \
                      S[tt][0] *= __expf(dl[0]); S[tt][1] *= __expf(dl[1]); S[tt][2] *= __expf(dl[2]); S[tt][3] *= __expf(dl[3]); } else S[tt] = S[tt] * g64; \
                  u32x2 pk; pk.x = cvt_pk_bf16(S[tt][0], S[tt][1]); pk.y = cvt_pk_bf16(S[tt][2], S[tt][3]); \
                  *(LAS u32x2*)(Lz + LS + (sb ^ 1) * 16 * ROWB + r16 * ROWB + (((2 * tile + (g >> 1)) ^ r16) << 4) + (g & 1) * 8) = pk; } } \
        } else { \
            if (c + 2 <= 128) S3_ISSUE(c + 2, (ST + 2) % 3, QN2); \
              \
            { const LAS unsigned char* kb = Lz + LK + st * TILEB + r16 * ROWB; const int i = 16 * ti + r16; \
              _Pragma("unroll") for (int th = 0; th < 2; ++th) { f32x4 pa = (f32x4){0.f, 0.f, 0.f, 0.f}, pb = pa; \
                  if (2 * th <= ti) { \
                      _Pragma("unroll") for (int ks = 0; ks < KS; ++ks) { const int ch = ((4 * ks + g) ^ r16) << 4; \
                          const bf16x8 ka = *(const LAS bf16x8*)(kb + (2 * th) * 16 * ROWB + ch), kc2 = *(const LAS bf16x8*)(kb + (2 * th + 1) * 16 * ROWB + ch); \
                          pa = __builtin_amdgcn_mfma_f32_16x16x32_bf16(ka, QC[ks], pa, 0, 0, 0); pb = __builtin_amdgcn_mfma_f32_16x16x32_bf16(kc2, QC[ks], pb, 0, 0, 0); \
                          if (ks & 1) __builtin_amdgcn_sched_barrier(0); } } \
                  _Pragma("unroll") for (int tq = 0; tq < 2; ++tq) { const int tj = 2 * th + tq, j0 = 16 * tj + 4 * g; const f32x4 pt = tq ? pb : pa; \
                      const float v0 = (j0 + 0 <= i) ? pt[0] : 0.f, v1 = (j0 + 1 <= i) ? pt[1] : 0.f, v2 = (j0 + 2 <= i) ? pt[2] : 0.f, v3 = (j0 + 3 <= i) ? pt[3] : 0.f; \
                      u32x2 pk; pk.x = cvt_pk_bf16(v0, v1); pk.y = cvt_pk_bf16(v2, v3); \
                      *(LAS u32x2*)(Lz + LP + i * 128 + (((2 * tj + (g >> 1)) ^ ((i >> 1) & 7)) << 4) + (g & 1) * 8) = pk; } } } \
        } \
        LDS_WAIT(); __builtin_amdgcn_s_barrier(); asm volatile("" ::: "memory"); \
        if (hf == 0) {   \
            const int irow = 16 * ti + r16; f32x4 ot = (f32x4){0.f, 0.f, 0.f, 0.f}; \
            _Pragma("unroll") for (int ks = 0; ks < 2; ++ks) { \
                const bf16x8 va = *(const LAS bf16x8*)(Lz + LV + st * 2048 + r16 * 128 + (((4 * ks + g) ^ ((r16 >> 1) & 7)) << 4)); \
                const bf16x8 pb = *(const LAS bf16x8*)(Lz + LP + irow * 128 + (((4 * ks + g) ^ ((irow >> 1) & 7)) << 4)); \
                ot = __builtin_amdgcn_mfma_f32_16x16x32_bf16(va, pb, ot, 0, 0, 0); } \
            ot_prev = ot; \
        } else {   \
            f32x4 oa = (f32x4){0.f, 0.f, 0.f, 0.f}, ob = oa; \
            _Pragma("unroll") for (int ks = 0; ks < KS; ks += 2) { \
                const bf16x8 sa = *(const LAS bf16x8*)(Lz + LS + sb * 16 * ROWB + r16 * ROWB + (((4 * ks + g) ^ r16) << 4)); \
                const bf16x8 sc = *(const LAS bf16x8*)(Lz + LS + sb * 16 * ROWB + r16 * ROWB + (((4 * (ks + 1) + g) ^ r16) << 4)); \
                oa = __builtin_amdgcn_mfma_f32_16x16x32_bf16(sa, QC[ks], oa, 0, 0, 0); ob = __builtin_amdgcn_mfma_f32_16x16x32_bf16(sc, QC[ks + 1], ob, 0, 0, 0); __builtin_amdgcn_sched_barrier(0); } \
            *(LAS f32x4*)(Lz + LOT + ti * 1024 + lane * 16) = oa + ob; \
            if (c + 2 <= 128) S3_WAIT_PREV(); else S2_WAITV(0); \
        } \
        LDS_WAIT(); __builtin_amdgcn_s_barrier(); asm volatile("" ::: "memory"); __builtin_amdgcn_sched_barrier(0); \
    } while (0)
#define S3_PIN(Q) do { _Pragma("unroll") for (int k_ = 0; k_ < KS; ++k_) asm volatile("" : "+v"(Q[k_])); } while (0)
    for (int c3 = 0; c3 < 129; c3 += 3) {
        S3_STEP(c3, 0, q0, q2);     S3_PIN(q1);
        S3_STEP(c3 + 1, 1, q1, q0); S3_PIN(q2);
        S3_STEP(c3 + 2, 2, q2, q1); S3_PIN(q0);
    }
    if (hf == 0) { const f32x4 part = *(const LAS f32x4*)(L + LOT + ti * 1024 + lane * 16); const f32x4 ot = ot_prev + part; const int irow = 16 * ti + r16;
        const size_t grow = (size_t)b * SEQ + 127 * 64 + irow; u32x2 pk; pk.x = cvt_pk_bf16(ot[0], ot[1]); pk.y = cvt_pk_bf16(ot[2], ot[3]);
        *(u32x2*)(O + grow * LDO + h * DV + 16 * s + 4 * g) = pk; }
#undef S3_ISSUE
#undef S3_WAIT_PREV
#undef S3_STEP
#undef S3_PIN
}

template <int DK, int DV, bool GLA>
__device__ __forceinline__ void s2v4_phase(Frame& F, const int unit, const bf16_t* QH, const bf16_t* KH, const bf16_t* VT, bf16_t* O, const float* BC, int ldraw) {
    constexpr int NS = DV / 16, ROWB = DK * 2, TILEB = 32 * ROWB, NIL = TILEB / 1024 / 4, NTU = DK / 64, LDO = 4 * DV, KS = DK / 32, NSTEP = 257;
    constexpr int LK = 0, LQ = 3 * TILEB, LV = 6 * TILEB, LDEC = LV + 3 * 1024, LP = LDEC + 3 * 1024, LS = LP + 2048, LOT = LS + 2 * 16 * ROWB, LEND = LOT + 4096;
    static_assert(LEND + 256 <= LDS_MISC, "S2 LDS map");
    static_assert(NIL == 4 || NIL == 2, "S2 wait immediates");
    if (unit >= 8 * NS) return;
    const int bh = unit & 7, s = unit >> 3, b = bh >> 2, h = bh & 3;
    const int lane = F.lane, g = lane >> 4, r16 = lane & 15, w = F.wave, li = w >> 1, hf = w & 1, qi = li >> 1, kj = li & 1;
    LAS unsigned char* L = F.lds; const unsigned Lb = (unsigned)(uintptr_t)L;
    const float* RAW = WSP(float, WS_META + META_RAW);
    const char* Qg = (const char*)(QH + (size_t)bh * SEQ * DK); const char* Kg = (const char*)(KH + (size_t)bh * SEQ * DK);
    const char* Vg = (const char*)(VT + ((size_t)bh * DV + 16 * s) * SEQ);
#define S4_ISSUE(c_, st_) do { const int rc_ = (c_) - 1; const char* kc_ = Kg + (size_t)rc_ * TILEB; const char* qc_ = Qg + (size_t)rc_ * TILEB; \
        _Pragma("unroll") for (int i_ = 0; i_ < NIL; ++i_) { const int piece_ = li * NIL + i_, off_ = piece_ * 1024 + lane * 16, row_ = off_ / ROWB, p_ = (off_ % ROWB) >> 4; const int so_ = row_ * ROWB + ((p_ ^ (row_ & 15)) << 4); \
            __builtin_amdgcn_global_load_lds((const unsigned*)(kc_ + so_), (LAS unsigned*)(L + LK + (st_) * TILEB + piece_ * 1024), 16, 0, 0); \
            __builtin_amdgcn_global_load_lds((const unsigned*)(qc_ + so_), (LAS unsigned*)(L + LQ + (st_) * TILEB + piece_ * 1024), 16, 0, 0); } \
        if (li == 0) { const int wv_ = lane >> 2, p_ = lane & 3; \
            __builtin_amdgcn_global_load_lds((const unsigned*)(Vg + (size_t)wv_ * SEQ * 2 + (size_t)rc_ * 64 + ((p_ ^ ((wv_ >> 2) & 3)) << 4)), (LAS unsigned*)(L + LV + (st_) * 1024), 16, 0, 0); } \
        if (GLA && li == 1) __builtin_amdgcn_global_load_lds((const unsigned*)((const char*)(BC + (size_t)(b * SEQ + rc_ * 32 + 31) * 512 + h * 128) + lane * 16), (LAS unsigned*)(L + LDEC + (st_) * 1024), 16, 0, 0); } while (0)
#define S4_WAIT_PREV() do { if (li == 0 || (GLA && li == 1)) { if (NIL == 4) S2_WAITV(9); else S2_WAITV(5); } else { if (NIL == 4) S2_WAITV(8); else S2_WAITV(4); } } while (0)
    for (int i = F.tid * 16; i < TILEB; i += NTHREADS * 16) { *(LAS u32x4*)(L + LK + i) = (u32x4){0, 0, 0, 0}; *(LAS u32x4*)(L + LQ + i) = (u32x4){0, 0, 0, 0}; }
    for (int i = F.tid * 16; i < 1024; i += NTHREADS * 16) *(LAS u32x4*)(L + LV + i) = (u32x4){0, 0, 0, 0};
    for (int i = F.tid * 16; i < 16 * ROWB; i += NTHREADS * 16) *(LAS u32x4*)(L + LS + i) = (u32x4){0, 0, 0, 0};
    __syncthreads();
    if (!GLA) {
        for (int idx = F.tid; idx < 16 * 128; idx += NTHREADS) { const int j = idx >> 7, c = idx & 127, row = 16 + j;
            const float* rq = RAW + (size_t)j * ldraw + h * 256; const float* rk = rq + 1024;
            const float rev = ((float)j * ROPE_INV[c]) * 0.15915494309189535f; const float frc = rev - floorf(rev);
            const float sn = __builtin_amdgcn_sinf(frc), cs = __builtin_amdgcn_cosf(frc);
            const float dq = __builtin_amdgcn_exp2f((float)(row + 1) * L2G[h]), dk = 0.0625f * __builtin_amdgcn_exp2f(-(float)(row + 1) * L2G[h]);
            const float q1v = rq[c], q2v = rq[c + 128], k1 = rk[c], k2 = rk[c + 128];
            const int a1 = row * ROWB + ((((c >> 3)) ^ (row & 15)) << 4) + (c & 7) * 2, a2 = row * ROWB + ((((c + 128) >> 3) ^ (row & 15)) << 4) + (c & 7) * 2;
            *(LAS bf16_t*)(L + LQ + a1) = f2bf((q1v * cs - q2v * sn) * dq); *(LAS bf16_t*)(L + LQ + a2) = f2bf((q1v * sn + q2v * cs) * dq);
            *(LAS bf16_t*)(L + LK + a1) = f2bf((k1 * cs - k2 * sn) * dk); *(LAS bf16_t*)(L + LK + a2) = f2bf((k1 * sn + k2 * cs) * dk); }
        if (F.tid < 256) { const int j = F.tid >> 4, wv = F.tid & 15, tok = 16 + j;
            *(LAS bf16_t*)(L + LV + wv * 64 + (((tok >> 3) ^ ((wv >> 2) & 3)) << 4) + (tok & 7) * 2) = f2bf(RAW[(size_t)j * ldraw + 2048 + h * 512 + 16 * s + wv]); }
    } else {
        if (F.tid < 128) { const int d = F.tid; const float* wgp = F.in[13] + h * 128 + d; const float bias = F.in[14][h * 128 + d]; float cum = 0.f;
            for (int j = 0; j < 16; ++j) { float a = bias;
                for (int r = 0; r < 16; ++r) a += RAW[(size_t)j * ldraw + 3072 + r] * wgp[r * 512];
                cum += (fminf(a, 0.f) - __logf(1.0f + __expf(-fabsf(a)))) * 0.0625f;
                const int row = 16 + j;
                *(LAS bf16_t*)(L + LK + row * ROWB + (((d >> 3) ^ (row & 15)) << 4) + (d & 7) * 2) = f2bf(RAW[(size_t)j * ldraw + 512 + h * 128 + d] * __expf(-cum)); }
            *(LAS float*)(L + LDEC + d * 4) = cum; }
        if (F.tid >= 256) { const int j = (F.tid - 256) >> 4, wv = F.tid & 15, tok = 16 + j;
            *(LAS bf16_t*)(L + LV + wv * 64 + (((tok >> 3) ^ ((wv >> 2) & 3)) << 4) + (tok & 7) * 2) = f2bf(RAW[(size_t)j * ldraw + 1024 + h * 256 + 16 * s + wv]); }
    }
    f32x4 S[NTU];
#pragma unroll
    for (int tt = 0; tt < NTU; ++tt) S[tt] = (f32x4){0.f, 0.f, 0.f, 0.f};
    const float g32 = GLA ? 1.0f : __builtin_amdgcn_exp2f(32.0f * L2G[h]);
    __syncthreads();
    if (hf) S4_ISSUE(1, 1);
    f32x4 ot_prev = (f32x4){0.f, 0.f, 0.f, 0.f};
    int st = 0;
#if defined(PROBE2)
    unsigned long long pacc = 0ull, pt0 = 0ull; const unsigned long long ptot0 = __builtin_amdgcn_s_memtime();
#define P2T(q, stmt) do { if (PROBE2 == (q) && !GLA) { stmt; } } while (0)
#else
#define P2T(q, stmt) do {} while (0)
#endif
    for (int c = 0; c < NSTEP; ++c) {
        P2T(2, if (hf == 1) pt0 = __builtin_amdgcn_s_memtime()); P2T(3, if (hf == 0) pt0 = __builtin_amdgcn_s_memtime());
        const int sb = c & 1, st2 = (st == 0) ? 2 : st - 1;
        unsigned lz_ = 0; asm volatile("" : "+v"(lz_)); LAS unsigned char* const Lz = L + lz_; const unsigned Lbz = Lb + lz_;
        if (hf == 0) {
            if (li == 3) { constexpr int PFD = 8, LPT = TILEB / 128, LPB = 2 * LPT / NS; const int rcp = c + PFD - 1;
                if (rcp < 256) { const char* pa_ = nullptr;
                    if (lane < LPB) { const int ln = s * LPB + lane; pa_ = (ln < LPT) ? Kg + (size_t)rcp * TILEB + ln * 128 : Qg + (size_t)rcp * TILEB + (ln - LPT) * 128; }
                    else if (lane >= 16 && lane < 32) pa_ = Vg + (size_t)(lane - 16) * SEQ * 2 + (size_t)rcp * 64;
                    else if (GLA && lane == 32 && s == 0) pa_ = (const char*)(BC + (size_t)(b * SEQ + rcp * 32 + 31) * 512 + h * 128);
                    if (pa_) glds_touch(pa_, (unsigned)__builtin_amdgcn_readfirstlane((int)(Lb + LEND))); } }
            if (li < 2 && c >= 1) { const f32x4 pa = *(const LAS f32x4*)(Lz + LOT + (li * 2) * 1024 + lane * 16), pb = *(const LAS f32x4*)(Lz + LOT + (li * 2 + 1) * 1024 + lane * 16);
                const f32x4 ot = ot_prev + (pa + pb); const int irow = 16 * li + r16;
                if (c >= 2) { const size_t grow = (size_t)b * SEQ + (size_t)(c - 2) * 32 + irow; u32x2 pk; pk.x = cvt_pk_bf16(ot[0], ot[1]); pk.y = cvt_pk_bf16(ot[2], ot[3]);
                    *(u32x2*)(O + grow * LDO + h * DV + 16 * s + 4 * g) = pk; }
                else if (!GLA && b == 0 && irow >= 16) { float* MO = WSP(float, WS_META + META_MO); *(f32x4*)(MO + (size_t)(irow - 16) * 2048 + h * 512 + 16 * s + 4 * g) = ot; } }
            { s16x4 klo[NTU], khi[NTU];
              const bf16x8 vb = *(const LAS bf16x8*)(Lz + LV + st * 1024 + r16 * 64 + ((g ^ ((r16 >> 2) & 3)) << 4));
#pragma unroll
              for (int tt = 0; tt < NTU; ++tt) { const int tile = li + 4 * tt, d0 = 16 * tile, dcol = d0 + 4 * (r16 & 3), chunk = dcol >> 3, sub = (dcol & 7) * 2;
                  const int r1 = 8 * g + (r16 >> 2), r2 = r1 + 4;
                  klo[tt] = ds_tr_asm(Lbz + LK + st * TILEB + r1 * ROWB + ((chunk ^ (r1 & 15)) << 4) + sub);
                  khi[tt] = ds_tr_asm(Lbz + LK + st * TILEB + r2 * ROWB + ((chunk ^ (r2 & 15)) << 4) + sub); }
              asm volatile("s_waitcnt lgkmcnt(0)" ::: "memory"); __builtin_amdgcn_sched_barrier(0);
#pragma unroll
              for (int tt = 0; tt < NTU; ++tt) {
                  const bf16x8 ka = (bf16x8){klo[tt][0], klo[tt][1], klo[tt][2], klo[tt][3], khi[tt][0], khi[tt][1], khi[tt][2], khi[tt][3]};
                  S[tt] = __builtin_amdgcn_mfma_f32_16x16x32_bf16(ka, vb, S[tt], 0, 0, 0); }
#pragma unroll
              for (int tt = 0; tt < NTU; ++tt) { const int tile = li + 4 * tt;
                  if (GLA) { const f32x4 dl = *(const LAS f32x4*)(Lz + LDEC + st * 1024 + (16 * tile + 4 * g) * 4);
                      S[tt][0] *= __expf(dl[0]); S[tt][1] *= __expf(dl[1]); S[tt][2] *= __expf(dl[2]); S[tt][3] *= __expf(dl[3]); } else S[tt] = S[tt] * g32;
                  u32x2 pk; pk.x = cvt_pk_bf16(S[tt][0], S[tt][1]); pk.y = cvt_pk_bf16(S[tt][2], S[tt][3]);
                  *(LAS u32x2*)(Lz + LS + (sb ^ 1) * 16 * ROWB + r16 * ROWB + (((2 * tile + (g >> 1)) ^ r16) << 4) + (g & 1) * 8) = pk; } }
        } else {
            if (c + 2 < NSTEP) S4_ISSUE(c + 2, st2);
            { f32x4 pa = (f32x4){0.f, 0.f, 0.f, 0.f}, pb = pa;
              if (kj <= qi) { const LAS unsigned char* kb = Lz + LK + st * TILEB + (16 * kj + r16) * ROWB; const LAS unsigned char* qb = Lz + LQ + st * TILEB + (16 * qi + r16) * ROWB;
#pragma unroll
                  for (int ks = 0; ks < KS; ks += 2) { const int ch0 = ((4 * ks + g) ^ r16) << 4, ch1 = ((4 * (ks + 1) + g) ^ r16) << 4;
                      const bf16x8 k0 = *(const LAS bf16x8*)(kb + ch0), q0 = *(const LAS bf16x8*)(qb + ch0), k1 = *(const LAS bf16x8*)(kb + ch1), q1 = *(const LAS bf16x8*)(qb + ch1);
                      pa = __builtin_amdgcn_mfma_f32_16x16x32_bf16(k0, q0, pa, 0, 0, 0); pb = __builtin_amdgcn_mfma_f32_16x16x32_bf16(k1, q1, pb, 0, 0, 0); } }
              const f32x4 pt = pa + pb; const int i = 16 * qi + r16, j0 = 16 * kj + 4 * g;
              const float v0 = (j0 + 0 <= i) ? pt[0] : 0.f, v1 = (j0 + 1 <= i) ? pt[1] : 0.f, v2 = (j0 + 2 <= i) ? pt[2] : 0.f, v3 = (j0 + 3 <= i) ? pt[3] : 0.f;
              u32x2 pk; pk.x = cvt_pk_bf16(v0, v1); pk.y = cvt_pk_bf16(v2, v3);
              *(LAS u32x2*)(Lz + LP + i * 64 + (((2 * kj + (g >> 1)) ^ ((i >> 2) & 3)) << 4) + (g & 1) * 8) = pk; }
        }
        LDS_WAIT();
        P2T(2, if (hf == 1) pacc += __builtin_amdgcn_s_memtime() - pt0); P2T(3, if (hf == 0) pacc += __builtin_amdgcn_s_memtime() - pt0);
        P2T(5, pt0 = __builtin_amdgcn_s_memtime());
        __builtin_amdgcn_s_barrier(); asm volatile("" ::: "memory"); __builtin_amdgcn_sched_barrier(0);
        P2T(5, pacc += __builtin_amdgcn_s_memtime() - pt0);
        P2T(4, if (hf == 1) pt0 = __builtin_amdgcn_s_memtime());
        if (hf == 0) {
            if (li < 2) { const int irow = 16 * li + r16;
                const bf16x8 va = *(const LAS bf16x8*)(Lz + LV + st * 1024 + r16 * 64 + ((g ^ ((r16 >> 2) & 3)) << 4));
                const bf16x8 pb = *(const LAS bf16x8*)(Lz + LP + irow * 64 + ((g ^ ((irow >> 2) & 3)) << 4));
                ot_prev = __builtin_amdgcn_mfma_f32_16x16x32_bf16(va, pb, (f32x4){0.f, 0.f, 0.f, 0.f}, 0, 0, 0); }
        } else {
            f32x4 oa = (f32x4){0.f, 0.f, 0.f, 0.f}, ob = oa;
            const LAS unsigned char* sp = Lz + LS + sb * 16 * ROWB + r16 * ROWB; const LAS unsigned char* qb = Lz + LQ + st * TILEB + (16 * qi + r16) * ROWB;
#pragma unroll
            for (int kk = 0; kk < KS / 2; kk += 2) { const int ks = kj * (KS / 2) + kk; const int ch0 = ((4 * ks + g) ^ r16) << 4, ch1 = ((4 * (ks + 1) + g) ^ r16) << 4;
                const bf16x8 s0 = *(const LAS bf16x8*)(sp + ch0), q0 = *(const LAS bf16x8*)(qb + ch0), s1 = *(const LAS bf16x8*)(sp + ch1), q1 = *(const LAS bf16x8*)(qb + ch1);
                oa = __builtin_amdgcn_mfma_f32_16x16x32_bf16(s0, q0, oa, 0, 0, 0); ob = __builtin_amdgcn_mfma_f32_16x16x32_bf16(s1, q1, ob, 0, 0, 0); }
            *(LAS f32x4*)(Lz + LOT + (qi * 2 + kj) * 1024 + lane * 16) = oa + ob;
            P2T(4, pacc += __builtin_amdgcn_s_memtime() - pt0); P2T(1, pt0 = __builtin_amdgcn_s_memtime());
            if (c + 2 < NSTEP) S4_WAIT_PREV(); else S2_WAITV(0);
            P2T(1, pacc += __builtin_amdgcn_s_memtime() - pt0);
        }
        LDS_WAIT(); __builtin_amdgcn_s_barrier(); asm volatile("" ::: "memory"); __builtin_amdgcn_sched_barrier(0);
        st = (st == 2) ? 0 : st + 1;
    }
#if defined(PROBE2)
    if (!GLA && unit == 0) { if (PROBE2 == 0) pacc = __builtin_amdgcn_s_memtime() - ptot0; const int pw = (PROBE2 == 3 || PROBE2 == 5 || PROBE2 == 0) ? 0 : 1; if (w == pw && lane == 0) { volatile LAS unsigned* MI = (volatile LAS unsigned*)(F.lds + LDS_MISC); MI[20] = (unsigned)pacc; MI[21] = (unsigned)(pacc >> 32); } }
#endif
    if (hf == 0 && li < 2) { const f32x4 pa = *(const LAS f32x4*)(L + LOT + (li * 2) * 1024 + lane * 16), pb = *(const LAS f32x4*)(L + LOT + (li * 2 + 1) * 1024 + lane * 16);
        const f32x4 ot = ot_prev + (pa + pb); const int irow = 16 * li + r16;
        const size_t grow = (size_t)b * SEQ + (size_t)(NSTEP - 2) * 32 + irow; u32x2 pk; pk.x = cvt_pk_bf16(ot[0], ot[1]); pk.y = cvt_pk_bf16(ot[2], ot[3]);
        *(u32x2*)(O + grow * LDO + h * DV + 16 * s + 4 * g) = pk; }
#undef S4_ISSUE
#undef S4_WAIT_PREV
}

template <int DK, int DV, bool GLA>
__device__ __forceinline__ void s2v5_phase(Frame& F, const int unit, const bf16_t* QH, const bf16_t* KH, const bf16_t* VT, bf16_t* O, const float* BC, int ldraw) {
    constexpr int NS = DV / 16, ROWB = DK * 2, TILEB = 32 * ROWB, NIL = TILEB / 1024 / 4, NTU = DK / 64, LDO = 4 * DV, KS = DK / 32, NSTEP = 257;
    constexpr int LK = 0, LQ = 2 * TILEB, LV = 4 * TILEB, LDEC = LV + 2 * 1024, LP = LDEC + 2 * 1024, LS = LP + 2048, LOT = LS + 2 * 16 * ROWB, LEND = LOT + 4096;
    static_assert(LEND <= LDS_MISC, "S2 LDS map");
    if (unit >= 8 * NS) return;
    const int bh = unit & 7, s = unit >> 3, b = bh >> 2, h = bh & 3;
    const int lane = F.lane, g = lane >> 4, r16 = lane & 15, w = F.wave, li = w & 3, hf = w >> 2, qi = li >> 1, kj = li & 1;
    LAS unsigned char* L = F.lds; const unsigned Lb = (unsigned)(uintptr_t)L;
    const float* RAW = WSP(float, WS_META + META_RAW);
    const char* Qg = (const char*)(QH + (size_t)bh * SEQ * DK); const char* Kg = (const char*)(KH + (size_t)bh * SEQ * DK);
    const char* Vg = (const char*)(VT + ((size_t)bh * DV + 16 * s) * SEQ);
    u32x4 ra[2 * NIL + 1], rb[2 * NIL + 1];
#pragma unroll
    for (int i = 0; i < 2 * NIL + 1; ++i) { ra[i] = (u32x4){0, 0, 0, 0}; rb[i] = ra[i]; }
#define S5_LOAD(c_, R) do { const int rc_ = ((c_) - 1 < 255) ? (c_) - 1 : 255;     const char* kc_ = Kg + (size_t)rc_ * TILEB; const char* qc_ = Qg + (size_t)rc_ * TILEB; \
        _Pragma("unroll") for (int i_ = 0; i_ < NIL; ++i_) { const int piece_ = li * NIL + i_, off_ = piece_ * 1024 + lane * 16, row_ = off_ / ROWB, p_ = (off_ % ROWB) >> 4; const int so_ = row_ * ROWB + ((p_ ^ (row_ & 15)) << 4); \
            R[i_] = *(const u32x4*)(kc_ + so_); R[NIL + i_] = *(const u32x4*)(qc_ + so_); } \
        if (li == 0) { const int wv_ = lane >> 2, p_ = lane & 3; R[2 * NIL] = *(const u32x4*)(Vg + (size_t)wv_ * SEQ * 2 + (size_t)rc_ * 64 + ((p_ ^ ((wv_ >> 2) & 3)) << 4)); } \
        if (GLA && li == 1) R[2 * NIL] = *(const u32x4*)((const char*)(BC + (size_t)(b * SEQ + rc_ * 32 + 31) * 512 + h * 128) + lane * 16); } while (0)
#define S5_WRITE(st_, R) do { \
        _Pragma("unroll") for (int i_ = 0; i_ < NIL; ++i_) { const int piece_ = li * NIL + i_; \
            *(LAS u32x4*)(L + LK + (st_) * TILEB + piece_ * 1024 + lane * 16) = R[i_]; *(LAS u32x4*)(L + LQ + (st_) * TILEB + piece_ * 1024 + lane * 16) = R[NIL + i_]; } \
        if (li == 0) *(LAS u32x4*)(L + LV + (st_) * 1024 + lane * 16) = R[2 * NIL]; \
        if (GLA && li == 1) *(LAS u32x4*)(L + LDEC + (st_) * 1024 + lane * 16) = R[2 * NIL]; } while (0)
    for (int i = F.tid * 16; i < TILEB; i += NTHREADS * 16) { *(LAS u32x4*)(L + LK + i) = (u32x4){0, 0, 0, 0}; *(LAS u32x4*)(L + LQ + i) = (u32x4){0, 0, 0, 0}; }
    for (int i = F.tid * 16; i < 1024; i += NTHREADS * 16) *(LAS u32x4*)(L + LV + i) = (u32x4){0, 0, 0, 0};
    for (int i = F.tid * 16; i < 16 * ROWB; i += NTHREADS * 16) *(LAS u32x4*)(L + LS + i) = (u32x4){0, 0, 0, 0};
    __syncthreads();
    if (!GLA) {
        for (int idx = F.tid; idx < 16 * 128; idx += NTHREADS) { const int j = idx >> 7, c = idx & 127, row = 16 + j;
            const float* rq = RAW + (size_t)j * ldraw + h * 256; const float* rk = rq + 1024;
            const float rev = ((float)j * ROPE_INV[c]) * 0.15915494309189535f; const float frc = rev - floorf(rev);
            const float sn = __builtin_amdgcn_sinf(frc), cs = __builtin_amdgcn_cosf(frc);
            const float dq = __builtin_amdgcn_exp2f((float)(row + 1) * L2G[h]), dk = 0.0625f * __builtin_amdgcn_exp2f(-(float)(row + 1) * L2G[h]);
            const float q1v = rq[c], q2v = rq[c + 128], k1 = rk[c], k2 = rk[c + 128];
            const int a1 = row * ROWB + ((((c >> 3)) ^ (row & 15)) << 4) + (c & 7) * 2, a2 = row * ROWB + ((((c + 128) >> 3) ^ (row & 15)) << 4) + (c & 7) * 2;
            *(LAS bf16_t*)(L + LQ + a1) = f2bf((q1v * cs - q2v * sn) * dq); *(LAS bf16_t*)(L + LQ + a2) = f2bf((q1v * sn + q2v * cs) * dq);
            *(LAS bf16_t*)(L + LK + a1) = f2bf((k1 * cs - k2 * sn) * dk); *(LAS bf16_t*)(L + LK + a2) = f2bf((k1 * sn + k2 * cs) * dk); }
        if (F.tid < 256) { const int j = F.tid >> 4, wv = F.tid & 15, tok = 16 + j;
            *(LAS bf16_t*)(L + LV + wv * 64 + (((tok >> 3) ^ ((wv >> 2) & 3)) << 4) + (tok & 7) * 2) = f2bf(RAW[(size_t)j * ldraw + 2048 + h * 512 + 16 * s + wv]); }
    } else {
        if (F.tid < 128) { const int d = F.tid; const float* wgp = F.in[13] + h * 128 + d; const float bias = F.in[14][h * 128 + d]; float cum = 0.f;
            for (int j = 0; j < 16; ++j) { float a = bias;
                for (int r = 0; r < 16; ++r) a += RAW[(size_t)j * ldraw + 3072 + r] * wgp[r * 512];
                cum += (fminf(a, 0.f) - __logf(1.0f + __expf(-fabsf(a)))) * 0.0625f;
                const int row = 16 + j;
                *(LAS bf16_t*)(L + LK + row * ROWB + (((d >> 3) ^ (row & 15)) << 4) + (d & 7) * 2) = f2bf(RAW[(size_t)j * ldraw + 512 + h * 128 + d] * __expf(-cum)); }
            *(LAS float*)(L + LDEC + d * 4) = cum; }
        if (F.tid >= 256) { const int j = (F.tid - 256) >> 4, wv = F.tid & 15, tok = 16 + j;
            *(LAS bf16_t*)(L + LV + wv * 64 + (((tok >> 3) ^ ((wv >> 2) & 3)) << 4) + (tok & 7) * 2) = f2bf(RAW[(size_t)j * ldraw + 1024 + h * 256 + 16 * s + wv]); }
    }
    f32x4 S[NTU];
#pragma unroll
    for (int tt = 0; tt < NTU; ++tt) S[tt] = (f32x4){0.f, 0.f, 0.f, 0.f};
    const float g32 = GLA ? 1.0f : __builtin_amdgcn_exp2f(32.0f * L2G[h]);
    __syncthreads();
    if (hf) S5_LOAD(1, rb);
#define S5_ODD(c_, ST, RL, RW) do { const int c = (c_); constexpr int st = (ST), sb = (ST); P3T(1, pt0 = __builtin_amdgcn_s_memtime()); \
        LAS unsigned char* const Lz = L; \
        S5_LOAD(c + 2, RL); P3T(1, pacc += __builtin_amdgcn_s_memtime() - pt0); P3T(2, pt0 = __builtin_amdgcn_s_memtime()); \
        { f32x4 pa = (f32x4){0.f, 0.f, 0.f, 0.f}, pb = pa; \
          if (kj <= qi) { const LAS unsigned char* kb = Lz + LK + st * TILEB + (16 * kj + r16) * ROWB; const LAS unsigned char* qb = Lz + LQ + st * TILEB + (16 * qi + r16) * ROWB; \
              _Pragma("unroll") for (int ks = 0; ks < KS; ks += 2) { const int ch0 = ((4 * ks + g) ^ r16) << 4, ch1 = ((4 * (ks + 1) + g) ^ r16) << 4; \
                  const bf16x8 k0 = *(const LAS bf16x8*)(kb + ch0), q0 = *(const LAS bf16x8*)(qb + ch0), k1 = *(const LAS bf16x8*)(kb + ch1), q1 = *(const LAS bf16x8*)(qb + ch1); \
                  pa = __builtin_amdgcn_mfma_f32_16x16x32_bf16(k0, q0, pa, 0, 0, 0); pb = __builtin_amdgcn_mfma_f32_16x16x32_bf16(k1, q1, pb, 0, 0, 0); } } \
          const f32x4 pt = pa + pb; const int i = 16 * qi + r16, j0 = 16 * kj + 4 * g; \
          const float v0 = (j0 + 0 <= i) ? pt[0] : 0.f, v1 = (j0 + 1 <= i) ? pt[1] : 0.f, v2 = (j0 + 2 <= i) ? pt[2] : 0.f, v3 = (j0 + 3 <= i) ? pt[3] : 0.f; \
          u32x2 pk; pk.x = cvt_pk_bf16(v0, v1); pk.y = cvt_pk_bf16(v2, v3); \
          *(LAS u32x2*)(Lz + LP + i * 64 + (((2 * kj + (g >> 1)) ^ ((i >> 2) & 3)) << 4) + (g & 1) * 8) = pk; } \
        LDS_WAIT(); P3T(2, pacc += __builtin_amdgcn_s_memtime() - pt0); P3T(3, pt0 = __builtin_amdgcn_s_memtime()); __builtin_amdgcn_s_barrier(); asm volatile("" ::: "memory"); P3T(3, pacc += __builtin_amdgcn_s_memtime() - pt0); P3T(4, pt0 = __builtin_amdgcn_s_memtime()); \
        P3T(4, pacc += __builtin_amdgcn_s_memtime() - pt0); P3T(5, pt0 = __builtin_amdgcn_s_memtime()); S5_WRITE(st ^ 1, RW); \
        LDS_WAIT(); P3T(5, pacc += __builtin_amdgcn_s_memtime() - pt0); P3T(6, pt0 = __builtin_amdgcn_s_memtime()); __builtin_amdgcn_s_barrier(); asm volatile("" ::: "memory"); P3T(6, pacc += __builtin_amdgcn_s_memtime() - pt0); \
    } while (0)
#define S5_EVEN(c_, ST) do { const int c = (c_); constexpr int st = (ST), sb = (ST); P3T(7, pt0 = __builtin_amdgcn_s_memtime()); \
        LAS unsigned char* const Lz = L; const unsigned Lbz = Lb; \
        P3T(7, pacc += __builtin_amdgcn_s_memtime() - pt0); P3T(8, pt0 = __builtin_amdgcn_s_memtime()); \
        { s16x4 klo[NTU], khi[NTU]; \
          const bf16x8 vb = *(const LAS bf16x8*)(Lz + LV + st * 1024 + r16 * 64 + ((g ^ ((r16 >> 2) & 3)) << 4)); \
          _Pragma("unroll") for (int tt = 0; tt < NTU; ++tt) { const int tile = li + 4 * tt, d0 = 16 * tile, dcol = d0 + 4 * (r16 & 3), chunk = dcol >> 3, sub = (dcol & 7) * 2; \
              const int r1 = 8 * g + (r16 >> 2), r2 = r1 + 4; \
              klo[tt] = ds_tr_asm(Lbz + LK + st * TILEB + r1 * ROWB + ((chunk ^ (r1 & 15)) << 4) + sub); \
              khi[tt] = ds_tr_asm(Lbz + LK + st * TILEB + r2 * ROWB + ((chunk ^ (r2 & 15)) << 4) + sub); } \
          asm volatile("s_waitcnt lgkmcnt(0)" ::: "memory"); __builtin_amdgcn_sched_barrier(0); \
          _Pragma("unroll") for (int tt = 0; tt < NTU; ++tt) { \
              const bf16x8 ka = (bf16x8){klo[tt][0], klo[tt][1], klo[tt][2], klo[tt][3], khi[tt][0], khi[tt][1], khi[tt][2], khi[tt][3]}; \
              S[tt] = __builtin_amdgcn_mfma_f32_16x16x32_bf16(ka, vb, S[tt], 0, 0, 0); } \
          _Pragma("unroll") for (int tt = 0; tt < NTU; ++tt) { const int tile = li + 4 * tt; \
              if (GLA) { const f32x4 dl = *(const LAS f32x4*)(Lz + LDEC + st * 1024 + (16 * tile + 4 * g) * 4); \
                  S[tt][0] *= __expf(dl[0]); S[tt][1] *= __expf(dl[1]); S[tt][2] *= __expf(dl[2]); S[tt][3] *= __expf(dl[3]); } else S[tt] = S[tt] * g32; \
              u32x2 pk; pk.x = cvt_pk_bf16(S[tt][0], S[tt][1]); pk.y = cvt_pk_bf16(S[tt][2], S[tt][3]); \
              *(LAS u32x2*)(Lz + LS + (sb ^ 1) * 16 * ROWB + r16 * ROWB + (((2 * tile + (g >> 1)) ^ r16) << 4) + (g & 1) * 8) = pk; } } \
        LDS_WAIT(); P3T(8, pacc += __builtin_amdgcn_s_memtime() - pt0); P3T(9, pt0 = __builtin_amdgcn_s_memtime()); __builtin_amdgcn_s_barrier(); asm volatile("" ::: "memory"); P3T(9, pacc += __builtin_amdgcn_s_memtime() - pt0); P3T(10, pt0 = __builtin_amdgcn_s_memtime()); \
        if (li < 2) { const int irow = 16 * li + r16;        \
            const bf16x8 va = *(const LAS bf16x8*)(Lz + LV + st * 1024 + r16 * 64 + ((g ^ ((r16 >> 2) & 3)) << 4)); \
            const bf16x8 pb = *(const LAS bf16x8*)(Lz + LP + irow * 64 + ((g ^ ((irow >> 2) & 3)) << 4)); \
            f32x4 oa = __builtin_amdgcn_mfma_f32_16x16x32_bf16(va, pb, (f32x4){0.f, 0.f, 0.f, 0.f}, 0, 0, 0), ob = (f32x4){0.f, 0.f, 0.f, 0.f}; \
            const LAS unsigned char* sp = Lz + LS + sb * 16 * ROWB + r16 * ROWB; const LAS unsigned char* qb = Lz + LQ + st * TILEB + irow * ROWB; \
            _Pragma("unroll") for (int ks = 0; ks < KS; ks += 2) { const int ch0 = ((4 * ks + g) ^ r16) << 4, ch1 = ((4 * (ks + 1) + g) ^ r16) << 4; \
                const bf16x8 s0 = *(const LAS bf16x8*)(sp + ch0), q0 = *(const LAS bf16x8*)(qb + ch0), s1 = *(const LAS bf16x8*)(sp + ch1), q1 = *(const LAS bf16x8*)(qb + ch1); \
                oa = __builtin_amdgcn_mfma_f32_16x16x32_bf16(s0, q0, oa, 0, 0, 0); ob = __builtin_amdgcn_mfma_f32_16x16x32_bf16(s1, q1, ob, 0, 0, 0); } \
            const f32x4 ot = oa + ob; \
            if (c >= 1) { const size_t grow = (size_t)b * SEQ + (size_t)(c - 1) * 32 + irow; u32x2 pk; pk.x = cvt_pk_bf16(ot[0], ot[1]); pk.y = cvt_pk_bf16(ot[2], ot[3]); \
                *(u32x2*)(O + grow * LDO + h * DV + 16 * s + 4 * g) = pk; } \
            else if (!GLA && b == 0 && irow >= 16) { float* MO = WSP(float, WS_META + META_MO); *(f32x4*)(MO + (size_t)(irow - 16) * 2048 + h * 512 + 16 * s + 4 * g) = ot; } } \
        LDS_WAIT(); P3T(10, pacc += __builtin_amdgcn_s_memtime() - pt0); P3T(11, pt0 = __builtin_amdgcn_s_memtime()); __builtin_amdgcn_s_barrier(); asm volatile("" ::: "memory"); P3T(11, pacc += __builtin_amdgcn_s_memtime() - pt0); \
    } while (0)
#if defined(PROBE3)
    unsigned long long pacc = 0ull, pt0 = 0ull;
#define P3T(q, stmt) do { if (PROBE3 == (q) && !GLA) { stmt; } } while (0)
#else
#define P3T(q, stmt) do {} while (0)
#endif
    if (hf) {
        for (int c2 = 0; c2 < 256; c2 += 2) { S5_ODD(c2, 0, ra, rb); S5_ODD(c2 + 1, 1, rb, ra); }
        S5_ODD(256, 0, ra, rb);
#if defined(PROBE3)
        if (!GLA && PROBE3 < 7 && unit == 0 && w == 5 && lane == 0) { volatile LAS unsigned* MI = (volatile LAS unsigned*)(F.lds + LDS_MISC); MI[20] = (unsigned)pacc; MI[21] = (unsigned)(pacc >> 32); }
#endif
    } else {
        for (int c2 = 0; c2 < 256; c2 += 2) { S5_EVEN(c2, 0); S5_EVEN(c2 + 1, 1); }
        S5_EVEN(256, 0);
#if defined(PROBE3)
        if (!GLA && PROBE3 >= 7 && unit == 0 && w == 0 && lane == 0) { volatile LAS unsigned* MI = (volatile LAS unsigned*)(F.lds + LDS_MISC); MI[20] = (unsigned)pacc; MI[21] = (unsigned)(pacc >> 32); }
#endif
    }
#undef S5_ODD
#undef S5_EVEN
#undef S5_LOAD
#undef S5_WRITE
}

template <int DK, int DV, bool GLA>
__device__ __forceinline__ void s2v6_phase(Frame& F, const int unit, const bf16_t* QH, const bf16_t* KH, const bf16_t* VT, bf16_t* O, const float* BC, int ldraw) {
    constexpr int NS = DV / 16, ROWB = DK * 2, TILEB = 32 * ROWB, NIL = TILEB / 1024 / 4, LDO = 4 * DV, KS = DK / 32, NSTEP = 257, NLO = DK / 128, NHI = DK / 32 - NLO;
    constexpr int LK = 0, LQ = 3 * TILEB, LV = 6 * TILEB, LDEC = LV + 3 * 1024, LP = LDEC + 3 * 1024, LS = LP + 2 * 2048, LEND = LS + 2 * 16 * ROWB;
    static_assert(LEND <= LDS_MISC, "S2 LDS map");
    if (unit >= 8 * NS) return;
    const int bh = unit & 7, s = unit >> 3, b = bh >> 2, h = bh & 3;
    const int lane = F.lane, g = lane >> 4, r16 = lane & 15, w = F.wave, li = w & 3, hf = w >> 2, qi = li >> 1, kj = li & 1;
    LAS unsigned char* L = F.lds; const unsigned Lb = (unsigned)(uintptr_t)L;
    const float* RAW = WSP(float, WS_META + META_RAW);
    const char* Qg = (const char*)(QH + (size_t)bh * SEQ * DK); const char* Kg = (const char*)(KH + (size_t)bh * SEQ * DK);
    const char* Vg = (const char*)(VT + ((size_t)bh * DV + 16 * s) * SEQ);
    u32x4 ra[2 * NIL + 1], rb[2 * NIL + 1], rc[2 * NIL + 1];
#pragma unroll
    for (int i = 0; i < 2 * NIL + 1; ++i) { ra[i] = (u32x4){0, 0, 0, 0}; rb[i] = ra[i]; rc[i] = ra[i]; }
#define S6_LOAD(c_, R) do { const int rc_ = ((c_) - 1 < 255) ? (c_) - 1 : 255; const char* kc_ = Kg + (size_t)rc_ * TILEB; const char* qc_ = Qg + (size_t)rc_ * TILEB; \
        _Pragma("unroll") for (int i_ = 0; i_ < NIL; ++i_) { const int piece_ = li * NIL + i_, off_ = piece_ * 1024 + lane * 16, row_ = off_ / ROWB, p_ = (off_ % ROWB) >> 4; const int so_ = row_ * ROWB + ((p_ ^ (row_ & 15)) << 4); \
            R[i_] = *(const u32x4*)(kc_ + so_); R[NIL + i_] = *(const u32x4*)(qc_ + so_); } \
        if (li == 0) { const int wv_ = lane >> 2, p_ = lane & 3; R[2 * NIL] = *(const u32x4*)(Vg + (size_t)wv_ * SEQ * 2 + (size_t)rc_ * 64 + ((p_ ^ ((wv_ >> 2) & 3)) << 4)); } \
        if (GLA && li == 1) R[2 * NIL] = *(const u32x4*)((const char*)(BC + (size_t)(b * SEQ + rc_ * 32 + 31) * 512 + h * 128) + lane * 16); } while (0)
#define S6_WRITE(st_, R) do { \
        _Pragma("unroll") for (int i_ = 0; i_ < NIL; ++i_) { const int piece_ = li * NIL + i_; \
            *(LAS u32x4*)(L + LK + (st_) * TILEB + piece_ * 1024 + lane * 16) = R[i_]; *(LAS u32x4*)(L + LQ + (st_) * TILEB + piece_ * 1024 + lane * 16) = R[NIL + i_]; } \
        if (li == 0) *(LAS u32x4*)(L + LV + (st_) * 1024 + lane * 16) = R[2 * NIL]; \
        if (GLA && li == 1) *(LAS u32x4*)(L + LDEC + (st_) * 1024 + lane * 16) = R[2 * NIL]; } while (0)
#define S6_PT(st_, pb_) do { f32x4 pa = (f32x4){0.f, 0.f, 0.f, 0.f}, pc = pa; \
        if (kj <= qi) { const LAS unsigned char* kb = L + LK + (st_) * TILEB + (16 * kj + r16) * ROWB; const LAS unsigned char* qb = L + LQ + (st_) * TILEB + (16 * qi + r16) * ROWB; \
            _Pragma("unroll") for (int ks = 0; ks < KS; ks += 2) { const int ch0 = ((4 * ks + g) ^ r16) << 4, ch1 = ((4 * (ks + 1) + g) ^ r16) << 4; \
                const bf16x8 k0 = *(const LAS bf16x8*)(kb + ch0), q0 = *(const LAS bf16x8*)(qb + ch0), k1 = *(const LAS bf16x8*)(kb + ch1), q1 = *(const LAS bf16x8*)(qb + ch1); \
                pa = __builtin_amdgcn_mfma_f32_16x16x32_bf16(k0, q0, pa, 0, 0, 0); pc = __builtin_amdgcn_mfma_f32_16x16x32_bf16(k1, q1, pc, 0, 0, 0); } } \
        const f32x4 pt = pa + pc; const int i = 16 * qi + r16, j0 = 16 * kj + 4 * g; \
        const float v0 = (j0 + 0 <= i) ? pt[0] : 0.f, v1 = (j0 + 1 <= i) ? pt[1] : 0.f, v2 = (j0 + 2 <= i) ? pt[2] : 0.f, v3 = (j0 + 3 <= i) ? pt[3] : 0.f; \
        u32x2 pk; pk.x = cvt_pk_bf16(v0, v1); pk.y = cvt_pk_bf16(v2, v3); \
        *(LAS u32x2*)(L + LP + (pb_) * 2048 + i * 64 + (((2 * kj + (g >> 1)) ^ ((i >> 2) & 3)) << 4) + (g & 1) * 8) = pk; } while (0)
    for (int i = F.tid * 16; i < TILEB; i += NTHREADS * 16) { *(LAS u32x4*)(L + LK + i) = (u32x4){0, 0, 0, 0}; *(LAS u32x4*)(L + LQ + i) = (u32x4){0, 0, 0, 0}; }
    for (int i = F.tid * 16; i < 1024; i += NTHREADS * 16) *(LAS u32x4*)(L + LV + i) = (u32x4){0, 0, 0, 0};
    for (int i = F.tid * 16; i < 16 * ROWB; i += NTHREADS * 16) *(LAS u32x4*)(L + LS + i) = (u32x4){0, 0, 0, 0};
    __syncthreads();
    if (!GLA) {
        for (int idx = F.tid; idx < 16 * 128; idx += NTHREADS) { const int j = idx >> 7, c = idx & 127, row = 16 + j;
            const float* rq = RAW + (size_t)j * ldraw + h * 256; const float* rk = rq + 1024;
            const float rev = ((float)j * ROPE_INV[c]) * 0.15915494309189535f; const float frc = rev - floorf(rev);
            const float sn = __builtin_amdgcn_sinf(frc), cs = __builtin_amdgcn_cosf(frc);
            const float dq = __builtin_amdgcn_exp2f((float)(row + 1) * L2G[h]), dk = 0.0625f * __builtin_amdgcn_exp2f(-(float)(row + 1) * L2G[h]);
            const float q1v = rq[c], q2v = rq[c + 128], k1 = rk[c], k2 = rk[c + 128];
            const int a1 = row * ROWB + ((((c >> 3)) ^ (row & 15)) << 4) + (c & 7) * 2, a2 = row * ROWB + ((((c + 128) >> 3) ^ (row & 15)) << 4) + (c & 7) * 2;
            *(LAS bf16_t*)(L + LQ + a1) = f2bf((q1v * cs - q2v * sn) * dq); *(LAS bf16_t*)(L + LQ + a2) = f2bf((q1v * sn + q2v * cs) * dq);
            *(LAS bf16_t*)(L + LK + a1) = f2bf((k1 * cs - k2 * sn) * dk); *(LAS bf16_t*)(L + LK + a2) = f2bf((k1 * sn + k2 * cs) * dk); }
        if (F.tid < 256) { const int j = F.tid >> 4, wv = F.tid & 15, tok = 16 + j;
            *(LAS bf16_t*)(L + LV + wv * 64 + (((tok >> 3) ^ ((wv >> 2) & 3)) << 4) + (tok & 7) * 2) = f2bf(RAW[(size_t)j * ldraw + 2048 + h * 512 + 16 * s + wv]); }
    } else {
        if (F.tid < 128) { const int d = F.tid; const float* wgp = F.in[13] + h * 128 + d; const float bias = F.in[14][h * 128 + d]; float cum = 0.f;
            for (int j = 0; j < 16; ++j) { float a = bias;
                for (int r = 0; r < 16; ++r) a += RAW[(size_t)j * ldraw + 3072 + r] * wgp[r * 512];
                cum += (fminf(a, 0.f) - __logf(1.0f + __expf(-fabsf(a)))) * 0.0625f;
                const int row = 16 + j;
                *(LAS bf16_t*)(L + LK + row * ROWB + (((d >> 3) ^ (row & 15)) << 4) + (d & 7) * 2) = f2bf(RAW[(size_t)j * ldraw + 512 + h * 128 + d] * __expf(-cum)); }
            *(LAS float*)(L + LDEC + d * 4) = cum; }
        if (F.tid >= 256) { const int j = (F.tid - 256) >> 4, wv = F.tid & 15, tok = 16 + j;
            *(LAS bf16_t*)(L + LV + wv * 64 + (((tok >> 3) ^ ((wv >> 2) & 3)) << 4) + (tok & 7) * 2) = f2bf(RAW[(size_t)j * ldraw + 1024 + h * 256 + 16 * s + wv]); }
    }
    const float g32 = GLA ? 1.0f : __builtin_amdgcn_exp2f(32.0f * L2G[h]);
    if (hf) { S6_LOAD(1, ra); S6_WRITE(1, ra); }
    __syncthreads();
    if (hf) { S6_PT(0, 0); S6_LOAD(2, rb); S6_LOAD(3, rc); }
    __syncthreads();
    if (hf) {
#define S6_ODD(t_, RL, RW) do { const int t = (t_); S6_LOAD(t + 4, RL); if (t + 1 < NSTEP) S6_PT(s1, (t + 1) & 1); S6_WRITE(s2, RW); \
            LDS_WAIT(); __builtin_amdgcn_s_barrier(); asm volatile("" ::: "memory"); { const int o_ = s0; s0 = s1; s1 = s2; s2 = o_; } } while (0)
        int s0 = 0, s1 = 1, s2 = 2;
        for (int t3 = 0; t3 < 255; t3 += 3) { S6_ODD(t3, ra, rb); S6_ODD(t3 + 1, rb, rc); S6_ODD(t3 + 2, rc, ra); }
        S6_ODD(255, ra, rb); S6_ODD(256, rb, rc);
#undef S6_ODD
    } else {
        f32x4 S[NHI];
#pragma unroll
        for (int tt = 0; tt < NHI; ++tt) S[tt] = (f32x4){0.f, 0.f, 0.f, 0.f};
        int s0 = 0;
        for (int t = 0; t < NSTEP; ++t) { const int sb = t & 1;
            { s16x4 klo[NHI], khi[NHI];
              const bf16x8 vb = *(const LAS bf16x8*)(L + LV + s0 * 1024 + r16 * 64 + ((g ^ ((r16 >> 2) & 3)) << 4));
#pragma unroll
              for (int tt = 0; tt < NHI; ++tt) if (li >= 2 || tt < NLO) { const int tile = (li < 2) ? li + 2 * tt : 2 * NLO + (li - 2) + 2 * tt, d0 = 16 * tile, dcol = d0 + 4 * (r16 & 3), chunk = dcol >> 3, sub = (dcol & 7) * 2;
                  const int r1 = 8 * g + (r16 >> 2), r2 = r1 + 4;
                  klo[tt] = ds_tr_asm(Lb + LK + s0 * TILEB + r1 * ROWB + ((chunk ^ (r1 & 15)) << 4) + sub);
                  khi[tt] = ds_tr_asm(Lb + LK + s0 * TILEB + r2 * ROWB + ((chunk ^ (r2 & 15)) << 4) + sub); }
              asm volatile("s_waitcnt lgkmcnt(0)" ::: "memory"); __builtin_amdgcn_sched_barrier(0);
#pragma unroll
              for (int tt = 0; tt < NHI; ++tt) if (li >= 2 || tt < NLO) {
                  const bf16x8 ka = (bf16x8){klo[tt][0], klo[tt][1], klo[tt][2], klo[tt][3], khi[tt][0], khi[tt][1], khi[tt][2], khi[tt][3]};
                  S[tt] = __builtin_amdgcn_mfma_f32_16x16x32_bf16(ka, vb, S[tt], 0, 0, 0); }
#pragma unroll
              for (int tt = 0; tt < NHI; ++tt) if (li >= 2 || tt < NLO) { const int tile = (li < 2) ? li + 2 * tt : 2 * NLO + (li - 2) + 2 * tt;
                  if (GLA) { const f32x4 dl = *(const LAS f32x4*)(L + LDEC + s0 * 1024 + (16 * tile + 4 * g) * 4);
                      S[tt][0] *= __expf(dl[0]); S[tt][1] *= __expf(dl[1]); S[tt][2] *= __expf(dl[2]); S[tt][3] *= __expf(dl[3]); } else S[tt] = S[tt] * g32;
                  u32x2 pk; pk.x = cvt_pk_bf16(S[tt][0], S[tt][1]); pk.y = cvt_pk_bf16(S[tt][2], S[tt][3]);
                  *(LAS u32x2*)(L + LS + (sb ^ 1) * 16 * ROWB + r16 * ROWB + (((2 * tile + (g >> 1)) ^ r16) << 4) + (g & 1) * 8) = pk; } }
            if (li < 2) { const int irow = 16 * li + r16;
                const bf16x8 va = *(const LAS bf16x8*)(L + LV + s0 * 1024 + r16 * 64 + ((g ^ ((r16 >> 2) & 3)) << 4));
                const bf16x8 pb = *(const LAS bf16x8*)(L + LP + sb * 2048 + irow * 64 + ((g ^ ((irow >> 2) & 3)) << 4));
                f32x4 oa = __builtin_amdgcn_mfma_f32_16x16x32_bf16(va, pb, (f32x4){0.f, 0.f, 0.f, 0.f}, 0, 0, 0), ob = (f32x4){0.f, 0.f, 0.f, 0.f};
                const LAS unsigned char* sp = L + LS + sb * 16 * ROWB + r16 * ROWB; const LAS unsigned char* qb = L + LQ + s0 * TILEB + irow * ROWB;
#pragma unroll
                for (int ks = 0; ks < KS; ks += 2) { const int ch0 = ((4 * ks + g) ^ r16) << 4, ch1 = ((4 * (ks + 1) + g) ^ r16) << 4;
                    const bf16x8 sv0 = *(const LAS bf16x8*)(sp + ch0), q0 = *(const LAS bf16x8*)(qb + ch0), sv1 = *(const LAS bf16x8*)(sp + ch1), q1 = *(const LAS bf16x8*)(qb + ch1);
                    oa = __builtin_amdgcn_mfma_f32_16x16x32_bf16(sv0, q0, oa, 0, 0, 0); ob = __builtin_amdgcn_mfma_f32_16x16x32_bf16(sv1, q1, ob, 0, 0, 0); }
                const f32x4 ot = oa + ob;
                if (t >= 1) { const size_t grow = (size_t)b * SEQ + (size_t)(t - 1) * 32 + irow; u32x2 pk; pk.x = cvt_pk_bf16(ot[0], ot[1]); pk.y = cvt_pk_bf16(ot[2], ot[3]);
                    *(u32x2*)(O + grow * LDO + h * DV + 16 * s + 4 * g) = pk; }
                else if (!GLA && b == 0 && irow >= 16) { float* MO = WSP(float, WS_META + META_MO); *(f32x4*)(MO + (size_t)(irow - 16) * 2048 + h * 512 + 16 * s + 4 * g) = ot; } }
            LDS_WAIT(); __builtin_amdgcn_s_barrier(); asm volatile("" ::: "memory");
            s0 = (s0 == 2) ? 0 : s0 + 1;
        }
    }
#undef S6_LOAD
#undef S6_WRITE
#undef S6_PT
}

__device__ __forceinline__ void gla_gate_phase(Frame& F, const bf16_t* O, const bf16_t* G, bf16_t* Y) {
    const int gw = F.vcu * NWAVES + F.wave, NGW = F.G * NWAVES; const int head = F.lane >> 4;
    for (int m = gw; m < M; m += NGW) {
        const u32x4 o0 = *(const u32x4*)(O + (size_t)m * 1024 + 16 * F.lane), o1 = *(const u32x4*)(O + (size_t)m * 1024 + 16 * F.lane + 8);
        const u32x4 g0 = *(const u32x4*)(G + (size_t)m * 1024 + 16 * F.lane), g1 = *(const u32x4*)(G + (size_t)m * 1024 + 16 * F.lane + 8);
        float ov[16] = {bf_lo(o0.x), bf_hi(o0.x), bf_lo(o0.y), bf_hi(o0.y), bf_lo(o0.z), bf_hi(o0.z), bf_lo(o0.w), bf_hi(o0.w), bf_lo(o1.x), bf_hi(o1.x), bf_lo(o1.y), bf_hi(o1.y), bf_lo(o1.z), bf_hi(o1.z), bf_lo(o1.w), bf_hi(o1.w)};
        const float gv[16] = {bf_lo(g0.x), bf_hi(g0.x), bf_lo(g0.y), bf_hi(g0.y), bf_lo(g0.z), bf_hi(g0.z), bf_lo(g0.w), bf_hi(g0.w), bf_lo(g1.x), bf_hi(g1.x), bf_lo(g1.y), bf_hi(g1.y), bf_lo(g1.z), bf_hi(g1.z), bf_lo(g1.w), bf_hi(g1.w)};
        float ssum = 0.f;
#pragma unroll
        for (int i = 0; i < 16; ++i) ssum += ov[i] * ov[i];
        ssum += __shfl_xor(ssum, 1); ssum += __shfl_xor(ssum, 2); ssum += __shfl_xor(ssum, 4); ssum += __shfl_xor(ssum, 8);
        const float ro = 1.0f / sqrtf(ssum * (1.0f / 256.0f) + 1e-6f);
        u32x4 y0, y1;
        y0.x = cvt_pk_bf16(ov[0] * ro * gv[0], ov[1] * ro * gv[1]); y0.y = cvt_pk_bf16(ov[2] * ro * gv[2], ov[3] * ro * gv[3]); y0.z = cvt_pk_bf16(ov[4] * ro * gv[4], ov[5] * ro * gv[5]); y0.w = cvt_pk_bf16(ov[6] * ro * gv[6], ov[7] * ro * gv[7]);
        y1.x = cvt_pk_bf16(ov[8] * ro * gv[8], ov[9] * ro * gv[9]); y1.y = cvt_pk_bf16(ov[10] * ro * gv[10], ov[11] * ro * gv[11]); y1.z = cvt_pk_bf16(ov[12] * ro * gv[12], ov[13] * ro * gv[13]); y1.w = cvt_pk_bf16(ov[14] * ro * gv[14], ov[15] * ro * gv[15]);
        *(u32x4*)(Y + (size_t)m * 1024 + 16 * F.lane) = y0; *(u32x4*)(Y + (size_t)m * 1024 + 16 * F.lane + 8) = y1;
        (void)head;
    }
}
__device__ __forceinline__ void final_phase(Frame& F, const float* SS, const float* gain) {
    const int gw = F.vcu * NWAVES + F.wave, NGW = F.G * NWAVES; const bf16_t* HB = WSP(bf16_t, WS_HB);
    f32x4 gv[4];
#pragma unroll
    for (int j = 0; j < 4; ++j) gv[j] = *(const f32x4*)(gain + 4 * F.lane + 256 * j);
    for (int m = gw; m < M; m += NGW) { float* row = F.out + (size_t)m * D; const float rs = row_rstd(SS, m);
#pragma unroll
        for (int j = 0; j < 4; ++j) { const u32x2 hv = *(const u32x2*)(HB + (size_t)m * D + 4 * F.lane + 256 * j);
            f32x4 v = (f32x4){bf_lo(hv.x), bf_hi(hv.x), bf_lo(hv.y), bf_hi(hv.y)}; v = v * rs * gv[j]; *(f32x4*)(row + 4 * F.lane + 256 * j) = v; } }
}
__device__ __forceinline__ void p0_rows(Frame& F) {
    const int gw = F.vcu * NWAVES + F.wave, NGW = F.G * NWAVES; const float* x = F.in[0]; bf16_t* HB = WSP(bf16_t, WS_HB); float* SS = WSP(float, WS_SS);
    for (int m = gw; m < M; m += 2 * NGW) { const int m2 = m + NGW;
        f32x4 va[4], vb[4];
#pragma unroll
        for (int j = 0; j < 4; ++j) { va[j] = *(const f32x4*)(x + (size_t)m * D + 4 * F.lane + 256 * j); vb[j] = *(const f32x4*)(x + (size_t)m2 * D + 4 * F.lane + 256 * j); }
        float s = 0.f, s2 = 0.f;
#pragma unroll
        for (int j = 0; j < 4; ++j) { const f32x4 v = va[j], u = vb[j]; s += (v[0] * v[0] + v[1] * v[1]) + (v[2] * v[2] + v[3] * v[3]); s2 += (u[0] * u[0] + u[1] * u[1]) + (u[2] * u[2] + u[3] * u[3]);
            u32x2 pk; pk.x = cvt_pk_bf16(v[0], v[1]); pk.y = cvt_pk_bf16(v[2], v[3]); *(u32x2*)(HB + (size_t)m * D + 4 * F.lane + 256 * j) = pk;
            pk.x = cvt_pk_bf16(u[0], u[1]); pk.y = cvt_pk_bf16(u[2], u[3]); *(u32x2*)(HB + (size_t)m2 * D + 4 * F.lane + 256 * j) = pk; }
        s = wave_sum(s); s2 = wave_sum(s2);
        if (F.lane < 16) { SS[(size_t)m * 16 + F.lane] = F.lane == 0 ? s : 0.f; SS[(size_t)m2 * 16 + F.lane] = F.lane == 0 ? s2 : 0.f; } }
    if (blockIdx.x == 0) { float* HM = WSP(float, WS_META + META_HM); for (int i = F.tid; i < 16 * D; i += NTHREADS) HM[i] = F.in[1][i]; }
}

#ifndef S2FN
#define S2FN s2v6_phase
#endif
struct Args { const float* in[18]; float* out; unsigned char* ws; int ph_lo, ph_hi; };
constexpr int N_PHASES = 19;
__global__ void __launch_bounds__(NTHREADS, 2) fwd(Args args) {
    extern __shared__ __attribute__((aligned(16))) unsigned char lds_raw[];
    Frame F;
    F.lds = (LAS unsigned char*)lds_raw;
    F.tid = threadIdx.x; F.lane = F.tid & 63; F.wave = __builtin_amdgcn_readfirstlane(F.tid >> 6);
    F.G = gridDim.x; { const int bx = blockIdx.x; F.vcu = (F.G % 8 == 0) ? (bx % 8) * (F.G / 8) + bx / 8 : bx; }
    F.ws = args.ws; F.out = args.out;
#pragma unroll
    for (int i = 0; i < 18; ++i) F.in[i] = args.in[i];
    volatile LAS unsigned* MISC = (volatile LAS unsigned*)(F.lds + LDS_MISC);
    if (F.tid < 64) MISC[F.tid] = 0u;
    __syncthreads();
    XcdBarrier bar = xcd_barrier_post(WSP(unsigned, WS_CTL) + CW_BAR, MISC + 8);
    const int lo = args.ph_lo, hi = args.ph_hi;
    __syncthreads();
    F.vb = (int)blockIdx.x;
    int vblk = (int)blockIdx.x;
#define IN(k) (lo <= (k) && (k) < hi)
#if defined(PROBE_PHASE)
    unsigned long long t_prev = __builtin_amdgcn_s_memrealtime(), t_probe = 0ull;
#define SEAM(k) do { if (IN(k) && IN((k) + 1)) xcd_barrier(bar); { const unsigned long long t_now = __builtin_amdgcn_s_memrealtime(); if ((k) == PROBE_PHASE) t_probe = t_now - t_prev; t_prev = t_now; } } while (0)
#else
#define SEAM(k) do { if (IN(k) && IN((k) + 1)) xcd_barrier(bar); } while (0)
#endif
    bf16_t* HB = WSP(bf16_t, WS_HB); float* SS = WSP(float, WS_SS); float* H = F.out;
    bf16_t* ACT = WSP(bf16_t, WS_ACT);
    const int gw = F.vcu * NWAVES + F.wave, NGW = F.G * NWAVES;
    float* RAW = WSP(float, WS_META + META_RAW); float* HM = WSP(float, WS_META + META_HM);

#define FFN_IN(win, do_meta) do { \
        if ((do_meta) && meta_has_tiles(F, 2 * DFF, 128, 128)) { meta_prep_h(F); meta_tiles<0>(F, WSP(bf16_t, (win)), 2 * DFF, D, RAW, 2 * DFF, 1.f, 128, 128); } \
        pg8::Order S_; S_.init(M / 256, 22, F.G, vblk); PtrNormal P_{(const char*)HB, (const char*)WSP(bf16_t, (win)), (size_t)256 * D * 2}; \
        EpiSwiglu E_{SS, ACT}; pg8::gemm_phase(F.lds, D, S_, P_, E_); } while (0)
#define FFN_OUT(woutp, do_meta, F32B) do { const bf16_t* wo_ = (woutp); \
        if (do_meta) { meta_prep_act_q(F); meta_tiles_ksplit(F, wo_, DFF, 704, HM, 0.5f); } \
        pg8::Order S_; S_.init(M / 256, 4, F.G, vblk); PtrNormal P_{(const char*)ACT, (const char*)wo_, (size_t)256 * DFF * 2}; \
        EpiResid<F32B> E_{F.in[0], HB, SS, 0.5f}; pg8::gemm_phase(F.lds, DFF, S_, P_, E_); } while (0)

#define slack (vblk >= 128)
#define sgw ((vblk - 128) * NWAVES + F.wave)
    const int SNGW = 128 * NWAVES;
    if (IN(0)) {
        int cb = conv_job(F, job_ffn_in(F, 0, 0, WS_WFFN_A + WF_IN), 0, gw, NGW); cb = conv_job(F, job_ffn_out(F, 0, 0, WS_WFFN_A + WF_OUT), cb, gw, NGW);
        p0_rows(F);
    }
    SEAM(0);
    if (lo == 0 && hi == N_PHASES && F.G == 256) {
        const unsigned* barw = WSP(unsigned, WS_CTL) + CW_BAR; bool ok = true;
#pragma unroll
        for (int j = 0; j < 8; ++j) ok = ok && (__hip_atomic_load(barw + XB_XCNT(j), __ATOMIC_RELAXED, __HIP_MEMORY_SCOPE_AGENT) == 32u);
        const unsigned rank = MISC[10], xcc = MISC[11];
        if (ok && rank < 32u && xcc < 8u) vblk = (int)(rank * 8u + xcc);
    }
    F.vb = vblk;
    if (IN(1)) {
        if (slack) { ConvJob J;
            J.W = F.in[9]; J.ldn = 6144; J.K = D; J.N = 6144; J.col0 = 0; J.kind = 0; J.gain = F.in[5]; J.WT = WSP(bf16_t, WS_WMIX + WM_RET_IN);
            int cb = conv_job(F, J, 0, sgw, SNGW);
            J.W = F.in[11]; J.ldn = D; J.K = 2048; J.N = D; J.col0 = 0; J.kind = 0; J.gain = F.in[10]; J.WT = WSP(bf16_t, WS_WMIX + WM_RET_OUT);
            cb = conv_job(F, J, cb, sgw, SNGW);
            cb = conv_job(F, job_ffn_in(F, 0, 1, WS_WFFN_C), cb, sgw, SNGW);
            { ConvJob J2 = job_ffn_out(F, 0, 1, 0); J2.WT = (bf16_t*)F.out; cb = conv_job(F, J2, cb, sgw, SNGW); }
            __syncthreads(); }
        FFN_IN(WS_WFFN_A + WF_IN, true);
    }
    SEAM(1);
    if (IN(2)) FFN_OUT(WSP(bf16_t, WS_WFFN_A + WF_OUT), true, false);
    SEAM(2);
    if (IN(3)) {
        if (meta_has_tiles(F, 6144, 0, 256)) { meta_prep_h(F); meta_tiles<0>(F, WSP(bf16_t, WS_WMIX + WM_RET_IN), 6144, D, RAW, 6144, 1.f, 0, 256); }
        pg8::Order S_; S_.init(M / 256, 16, F.G, vblk);
        PtrSwapFrom P_{(const char*)HB, (const char*)WSP(bf16_t, WS_WMIX + WM_RET_IN), (size_t)256 * D * 2, 8};
        EpiRetIn E_{SS, WSP(bf16_t, WS_QH), WSP(bf16_t, WS_KH), WSP(bf16_t, WS_VT)}; pg8::gemm_phase(F.lds, D, S_, P_, E_);
    }
    SEAM(3);
    if (IN(4)) S2FN<256, 512, false>(F, vblk, WSP(bf16_t, WS_QH), WSP(bf16_t, WS_KH), WSP(bf16_t, WS_VT), WSP(bf16_t, WS_O), nullptr, 6144);
    SEAM(4);
    if (IN(5)) {
        pg8::Order S_; S_.init(M / 256, 8, F.G, vblk); PtrNormal P_{(const char*)HB, (const char*)(WSP(bf16_t, WS_WMIX + WM_RET_IN) + (size_t)4096 * D), (size_t)256 * D * 2};
        EpiGate<512, 2048> E_{SS, WSP(bf16_t, WS_O), WSP(bf16_t, WS_VT), (LAS float*)(F.lds + 132096)}; pg8::gemm_phase(F.lds, D, S_, P_, E_);
    }
    SEAM(5);
    if (IN(6)) {
        { meta_prep_y_q(F); meta_tiles_ksplit(F, WSP(bf16_t, WS_WMIX + WM_RET_OUT), 2048, 512, HM, 1.0f); }
        pg8::Order S_; S_.init(M / 256, 4, F.G, vblk); PtrNormal P_{(const char*)WSP(bf16_t, WS_VT), (const char*)WSP(bf16_t, WS_WMIX + WM_RET_OUT), (size_t)256 * 2048 * 2};
        EpiResid<false> E_{nullptr, HB, SS, 1.0f}; pg8::gemm_phase(F.lds, 2048, S_, P_, E_);
    }
    SEAM(6);
    if (IN(7)) {
        if (slack) { int cb = conv_job(F, job_ffn_in(F, 1, 0, WS_WFFN_B + WF_IN), 0, sgw, SNGW); cb = conv_job(F, job_ffn_out(F, 1, 0, WS_WFFN_B + WF_OUT), cb, sgw, SNGW);
            ConvJob J;
            J.W = F.in[12]; J.ldn = 3088; J.K = D; J.N = 3072; J.col0 = 0; J.kind = 0; J.gain = F.in[5] + D; J.WT = WSP(bf16_t, WS_WMIX + WM_GLA_IN);
            cb = conv_job(F, J, cb, sgw, SNGW);
            J.W = F.in[16]; J.ldn = D; J.K = D; J.N = D; J.col0 = 0; J.kind = 0; J.gain = F.in[15]; J.WT = WSP(bf16_t, WS_WMIX + WM_GLA_OUT);
            cb = conv_job(F, J, cb, sgw, SNGW);
            if (vblk == F.G - 1) { bf16_t* WZ = WSP(bf16_t, WS_WMIX + WM_GLA_Z); const float* W = F.in[12]; const float* gn = F.in[5] + D;
                for (int i = F.tid; i < 16 * D; i += NTHREADS) { const int k = i >> 4, r = i & 15; WZ[r * D + k] = f2bf(W[(size_t)k * 3088 + 3072 + r] * gn[k]); } }
            __syncthreads(); }
        FFN_IN(WS_WFFN_C, true);
    }
    SEAM(7);
    if (IN(8)) FFN_OUT((const bf16_t*)F.out, true, false);
    SEAM(8);
    if (IN(9)) {
        if (slack) { int cb = conv_job(F, job_ffn_in(F, 1, 1, WS_WFFN_A + WF_IN), 0, sgw, SNGW); cb = conv_job(F, job_ffn_out(F, 1, 1, WS_WFFN_A + WF_OUT), cb, sgw, SNGW); __syncthreads(); }
        FFN_IN(WS_WFFN_B + WF_IN, true);
    }
    SEAM(9);
    if (IN(10)) FFN_OUT(WSP(bf16_t, WS_WFFN_B + WF_OUT), true, false);
    SEAM(10);
    if (IN(11)) {
        if (meta_has_tiles(F, 2048, 0, 256)) { meta_prep_h(F); meta_tiles<0>(F, WSP(bf16_t, WS_WMIX + WM_GLA_IN), 2048, D, RAW, 3088, 1.f, 0, 256); }
        if (F.vb == 0) meta_tiles<0>(F, WSP(bf16_t, WS_WMIX + WM_GLA_Z), 16, D, RAW + 3072, 3088, 1.f, 0, 256);
        __syncthreads();
        z_phase(F, HB, SS, WSP(bf16_t, WS_WMIX + WM_GLA_Z), F.in[13], F.in[14], WSP(float, WS_BC));
    }
    SEAM(11);
    if (IN(12)) {
        pg8::Order S_; S_.init(M / 256, 8, F.G, vblk);
        PtrSwapFrom P_{(const char*)HB, (const char*)WSP(bf16_t, WS_WMIX + WM_GLA_IN), (size_t)256 * D * 2, 4};
        EpiGlaIn E_{SS, WSP(float, WS_BC), WSP(bf16_t, WS_QH2), WSP(bf16_t, WS_KH2), WSP(bf16_t, WS_VT2)}; pg8::gemm_phase(F.lds, D, S_, P_, E_);
    }
    SEAM(12);
    if (IN(13)) {
        if (vblk < 128) S2FN<128, 256, true>(F, vblk, WSP(bf16_t, WS_QH2), WSP(bf16_t, WS_KH2), WSP(bf16_t, WS_VT2), WSP(bf16_t, WS_O2), WSP(float, WS_BC), 3088);
        else {
            pg8::Order S_; S_.init(M / 256, 4, 128, vblk - 128); PtrNormal P_{(const char*)HB, (const char*)WSP(bf16_t, WS_WMIX + WM_GLA_G), (size_t)256 * D * 2};
            EpiSiluG E_{SS, WSP(bf16_t, WS_G2), 1024}; pg8::gemm_phase(F.lds, D, S_, P_, E_);
        }
    }
    SEAM(13);
    if (IN(14)) gla_gate_phase(F, WSP(bf16_t, WS_O2), WSP(bf16_t, WS_G2), WSP(bf16_t, WS_VT2));
    SEAM(14);
    if (IN(15)) {
        pg8::Order S_; S_.init(M / 256, 4, F.G, vblk); PtrNormal P_{(const char*)WSP(bf16_t, WS_VT2), (const char*)WSP(bf16_t, WS_WMIX + WM_GLA_OUT), (size_t)256 * D * 2};
        EpiResid<false> E_{nullptr, HB, SS, 1.0f}; pg8::gemm_phase(F.lds, D, S_, P_, E_);
    }
    SEAM(15);
    if (IN(16)) FFN_IN(WS_WFFN_A + WF_IN, false);
    SEAM(16);
    if (IN(17)) FFN_OUT(WSP(bf16_t, WS_WFFN_A + WF_OUT), false, false);
    SEAM(17);
    if (IN(18)) final_phase(F, SS, F.in[17]);
#if defined(PROBE2) || defined(PROBE3) || defined(PROBE4)
    __syncthreads();
    if (blockIdx.x == 0 && F.tid == 0) { const unsigned long long cyc = ((unsigned long long)MISC[21] << 32) | MISC[20]; const unsigned long long t0 = __builtin_amdgcn_s_memtime(); while (__builtin_amdgcn_s_memtime() - t0 < 4ull * cyc) __builtin_amdgcn_s_sleep(16); }
#endif
#if defined(PROBE_PHASE)
    { const unsigned long long t_now = __builtin_amdgcn_s_memrealtime(); if (18 == PROBE_PHASE) t_probe = t_now - t_prev;
      if (blockIdx.x == 0 && F.tid == 0) { const unsigned long long t_end = t_now + (unsigned long long)PROBE_MULT * t_probe; while (__builtin_amdgcn_s_memrealtime() < t_end) __builtin_amdgcn_s_sleep(16); } }
#endif
#undef slack
#undef sgw
#undef IN
#undef SEAM
#undef FFN_IN
#undef FFN_OUT
}
}
#ifndef MK_MODE
#define MK_MODE 0
#endif
#if MK_MODE == 2
namespace dbg {
__global__ void adapt(const float* Hreal, const float* HMtmp, float* Hn) {
    const size_t i = (size_t)blockIdx.x * blockDim.x + threadIdx.x;
    if (i >= (size_t)nv::ROWS * nv::D) return;
    const int d = (int)(i % nv::D); const size_t row = i / nv::D; const int b = (int)(row / nv::TT), s = (int)(row % nv::TT);
    Hn[i] = s < nv::NMETA ? HMtmp[s * nv::D + d] : Hreal[((size_t)b * nv::SEQ + (s - nv::NMETA)) * nv::D + d];
}
}
#endif
extern "C" void kernel_launch(void* const* d_in, const int* in_sizes, int n_in, void* d_out, int out_size, void* d_ws, size_t ws_size, hipStream_t stream) {
    static int grid = 0;
    if (grid == 0) {
        if (n_in != 18 || out_size != mk::M * mk::D || ws_size < mk::WS_NEED) { fprintf(stderr, "kernel_launch: unexpected sizes n_in %d out %d ws %zu\n", n_in, out_size, ws_size); grid = -1; return; }
        int dev = 0, cus = 0, per_cu = 0;
        if (hipGetDevice(&dev) != hipSuccess || hipDeviceGetAttribute(&cus, hipDeviceAttributeMultiprocessorCount, dev) != hipSuccess) { grid = -1; return; }
        if (hipFuncSetAttribute((const void*)mk::fwd, hipFuncAttributeMaxDynamicSharedMemorySize, mk::LDS_BYTES) != hipSuccess) { fprintf(stderr, "kernel_launch: hipFuncSetAttribute failed\n"); grid = -1; return; }
        if (hipOccupancyMaxActiveBlocksPerMultiprocessor(&per_cu, (const void*)mk::fwd, mk::NTHREADS, mk::LDS_BYTES) != hipSuccess || per_cu < 1) { fprintf(stderr, "kernel_launch: occupancy query says %d\n", per_cu); per_cu = 1; }
        (void)hipGetLastError();
        grid = cus;
        if (grid != 256) fprintf(stderr, "kernel_launch: %d CUs (built for 256)\n", grid);
    }
    if (grid < 0) return;
    (void)hipMemsetAsync((char*)d_ws + mk::WS_CTL, 0, mk::CTL_ZERO_BYTES, stream);
    mk::Args a{};
    for (int i = 0; i < 18; ++i) a.in[i] = (const float*)d_in[i];
    a.out = (float*)d_out; a.ws = (unsigned char*)d_ws;
#if MK_MODE == 0
    a.ph_lo = 0; a.ph_hi = mk::N_PHASES;
    hipLaunchKernelGGL(mk::fwd, dim3(grid), dim3(mk::NTHREADS), mk::LDS_BYTES, stream, a);
#elif MK_MODE == 1
    for (int p = 0; p < mk::N_PHASES; ++p) { a.ph_lo = p; a.ph_hi = p + 1; hipLaunchKernelGGL(mk::fwd, dim3(grid), dim3(mk::NTHREADS), mk::LDS_BYTES, stream, a); }
#else
    for (int p = 0; p < MK_CUT; ++p) { a.ph_lo = p; a.ph_hi = p + 1; hipLaunchKernelGGL(mk::fwd, dim3(grid), dim3(mk::NTHREADS), mk::LDS_BYTES, stream, a); }
    {
        float* tmp = (float*)((char*)d_ws + 250 * mk::MiB);
        (void)hipMemcpyAsync(tmp, (char*)d_ws + mk::WS_META + mk::META_HM, 16 * 1024 * 4, hipMemcpyDeviceToDevice, stream);
        hipLaunchKernelGGL(dbg::adapt, dim3((unsigned)(((size_t)nv::ROWS * nv::D + 255) / 256)), dim3(256), 0, stream, (const float*)d_out, (const float*)tmp, (float*)d_ws);
        nv::forward(stream, d_in, (float*)d_out, (char*)d_ws, MK_STAGE);
    }
#endif
}
```

```cpp
#include <hip/hip_runtime.h>
#include <cstdint>
#include <cstdio>
#include <cmath>
#define MK_MODE 0
namespace mk {
#define LAS __attribute__((address_space(3)))
#define GAS __attribute__((address_space(1)))
typedef unsigned short bf16_t;
typedef short bf16x8 __attribute__((ext_vector_type(8)));
typedef short s16x4 __attribute__((ext_vector_type(4)));
typedef float f32x4 __attribute__((ext_vector_type(4)));
typedef float f32x2 __attribute__((ext_vector_type(2)));
typedef unsigned u32x4 __attribute__((ext_vector_type(4)));
typedef unsigned u32x2 __attribute__((ext_vector_type(2)));

constexpr int M = 16384, D = 1024, DFF = 2816, SEQ = 8192, NMETA = 16;
constexpr int NWAVES = 8, NTHREADS = 512;
constexpr size_t MiB = 1u << 20;
constexpr size_t WS_CTL = 0, CTL_ZERO_BYTES = 1 * MiB;
constexpr size_t CTL_OSS_RET = 256 * 1024, CTL_OSS_GLA = 512 * 1024, CTL_MOSS = 768 * 1024;
constexpr size_t WS_HB = 1 * MiB, WS_SS = 33 * MiB, WS_META = 34 * MiB, WS_WMIX = 35 * MiB;
constexpr size_t META_HM = 0, META_RAW = 64 * 1024, META_MO = 448 * 1024;
constexpr size_t WS_WFFN_A = 52 * MiB, WS_ACT = 69 * MiB, WS_WFFN_B = 157 * MiB, WS_WFFN_C = 244 * MiB;
constexpr size_t WS_QH = 52 * MiB, WS_KH = 84 * MiB, WS_VT = 116 * MiB, WS_O = 180 * MiB;
constexpr size_t WS_BC = 69 * MiB, WS_QH2 = 101 * MiB, WS_KH2 = 117 * MiB, WS_VT2 = 133 * MiB, WS_O2 = 174 * MiB;
constexpr size_t WS_G2 = 208 * MiB;
constexpr size_t WS_NEED = 256 * MiB;
constexpr size_t WM_RET_IN = 0, WM_RET_OUT = 12 * MiB;
constexpr size_t WM_GLA_IN = 0, WM_GLA_G = 4 * MiB, WM_GLA_OUT = 6 * MiB, WM_GLA_Z = 8 * MiB;
constexpr size_t WF_IN = 0, WF_OUT = 11 * MiB;
constexpr int CW_BAR = 4096;

constexpr int LDS_BYTES = 163840;
constexpr int LDS_MISC = LDS_BYTES - 256;

__constant__ float L2G[4] = {-0.04580368961312478f, -0.02272007650008353f, -0.011315313227834133f, -0.005646563141142062f};
__constant__ float ROPE_INV[128] = {
  1.000000000e+00f, 9.300450087e-01f, 8.649836779e-01f, 8.044736385e-01f,
  7.481966019e-01f, 6.958565116e-01f, 6.471778154e-01f, 6.019044518e-01f,
  5.597981811e-01f, 5.206375122e-01f, 4.842162728e-01f, 4.503428936e-01f,
  4.188391268e-01f, 3.895392120e-01f, 3.622889817e-01f, 3.369450271e-01f,
  3.133740425e-01f, 2.914519310e-01f, 2.710633874e-01f, 2.521011233e-01f,
  2.344653904e-01f, 2.180633694e-01f, 2.028087080e-01f, 1.886212230e-01f,
  1.754262149e-01f, 1.631542742e-01f, 1.517407894e-01f, 1.411257535e-01f,
  1.312533021e-01f, 1.220714748e-01f, 1.135319397e-01f, 1.055898219e-01f,
  9.820328653e-02f, 9.133346379e-02f, 8.494423330e-02f, 7.900195569e-02f,
  7.347535342e-02f, 6.833537668e-02f, 6.355497986e-02f, 5.910899118e-02f,
  5.497401953e-02f, 5.112830922e-02f, 4.755162448e-02f, 4.422515258e-02f,
  4.113136977e-02f, 3.825402260e-02f, 3.557796404e-02f, 3.308910504e-02f,
  3.077435680e-02f, 2.862153389e-02f, 2.661931701e-02f, 2.475716174e-02f,
  2.302526683e-02f, 2.141453326e-02f, 1.991648041e-02f, 1.852322184e-02f,
  1.722742990e-02f, 1.602228358e-02f, 1.490144618e-02f, 1.385901403e-02f,
  1.288950257e-02f, 1.198781747e-02f, 1.114920899e-02f, 1.036926545e-02f,
  9.643883444e-03f, 8.969245479e-03f, 8.341802284e-03f, 7.758250926e-03f,
  7.215522230e-03f, 6.710760761e-03f, 6.241309457e-03f, 5.804697983e-03f,
  5.398627371e-03f, 5.020966288e-03f, 4.669724498e-03f, 4.343053792e-03f,
  4.039235413e-03f, 3.756670747e-03f, 3.493872471e-03f, 3.249458736e-03f,
  3.022142686e-03f, 2.810728736e-03f, 2.614103956e-03f, 2.431234345e-03f,
  2.261157380e-03f, 2.102978062e-03f, 1.955864020e-03f, 1.819041790e-03f,
  1.691789716e-03f, 1.573440502e-03f, 1.463370281e-03f, 1.361000235e-03f,
  1.265791478e-03f, 1.177242957e-03f, 1.094888896e-03f, 1.018295996e-03f,
  9.470609948e-04f, 8.808093844e-04f, 8.191923262e-04f, 7.618857198e-04f,
  7.085879333e-04f, 6.590186385e-04f, 6.129170069e-04f, 5.700403708e-04f,
  5.301629426e-04f, 4.930753494e-04f, 4.585822753e-04f, 4.265021416e-04f,
  3.966661752e-04f, 3.689173318e-04f, 3.431097430e-04f, 3.191074939e-04f,
  2.967843320e-04f, 2.760227653e-04f, 2.567135962e-04f, 2.387551940e-04f,
  2.220530587e-04f, 2.065193403e-04f, 1.920722716e-04f, 1.786358480e-04f,
  1.661392889e-04f, 1.545170089e-04f, 1.437077590e-04f, 1.336546848e-04f,
  1.243048755e-04f, 1.156091312e-04f, 1.075216787e-04f, 9.999999747e-05f,
};

#define LDS_WAIT() asm volatile("s_waitcnt lgkmcnt(0)" ::: "memory")
#define VM_WAIT() asm volatile("s_waitcnt vmcnt(0)" ::: "memory")
#define RLX_AGENT __ATOMIC_RELAXED, __HIP_MEMORY_SCOPE_AGENT

__device__ __forceinline__ unsigned cvt_pk_bf16(float lo, float hi) { unsigned r; asm volatile("v_cvt_pk_bf16_f32 %0, %1, %2" : "=v"(r) : "v"(lo), "v"(hi)); return r; }
__device__ __forceinline__ float bf_lo(unsigned w) { return __uint_as_float(w << 16); }
__device__ __forceinline__ float bf_hi(unsigned w) { return __uint_as_float(w & 0xffff0000u); }
__device__ __forceinline__ unsigned short f2bf(float f) { return (unsigned short)(cvt_pk_bf16(f, 0.f) & 0xffffu); }
__device__ __forceinline__ float fsilu(float v) { return v * __builtin_amdgcn_rcpf(1.0f + __expf(-v)); }
__device__ __forceinline__ float wave_sum(float v) {
#pragma unroll
    for (int o = 1; o < 64; o <<= 1) v += __shfl_xor(v, o);
    return v;
}
__device__ __forceinline__ float row_rstd(const float* SS, int row) {
    const f32x4* p = (const f32x4*)(SS + (size_t)row * 16);
    const f32x4 a = p[0], b = p[1], c = p[2], d = p[3];
    const float s = ((a.x + a.y) + (a.z + a.w)) + ((b.x + b.y) + (b.z + b.w)) + ((c.x + c.y) + (c.z + c.w)) + ((d.x + d.y) + (d.z + d.w));
    return 1.0f / sqrtf(s * (1.0f / 1024.0f) + 1e-6f);
}

#define XB_TMO      128
#define XB_XCNT(j)  (256  + 64 * (j))
#define XB_XSUB(j)  (1280 + 64 * (j))
#define XB_XGEN(j)  (2304 + 64 * (j))
#define XB_TOP      3328
#define XB_TOPGEN   3392
#define XCD_BAR_WORDS 3456
#define XB_SPIN_CAP (1u << 18)
__device__ __forceinline__ unsigned xb_ld(unsigned* p)              { return __hip_atomic_load(p, __ATOMIC_RELAXED, __HIP_MEMORY_SCOPE_AGENT); }
__device__ __forceinline__ unsigned xb_add(unsigned* p, unsigned v) { return __hip_atomic_fetch_add(p, v, __ATOMIC_RELAXED, __HIP_MEMORY_SCOPE_AGENT); }
__device__ __forceinline__ unsigned xb_xcc_id() { return (unsigned)__builtin_amdgcn_s_getreg((3 << 11) | 20) & 0xFu; }
#define XB_SPIN(cond, bar) do { unsigned _sp = 0; while (cond) { __builtin_amdgcn_s_sleep(1); \
    if ((++_sp & 255u) == 0u) { if (xb_ld(&(bar)[XB_TMO])) break; if (_sp > XB_SPIN_CAP) { atomicAdd(&(bar)[XB_TMO], 1u); break; } } } } while (0)
struct XcdBarrier { unsigned* bar; unsigned x; volatile LAS unsigned* st; };
__device__ __forceinline__ XcdBarrier xcd_barrier_post(unsigned* bar, volatile LAS unsigned* st) {
    XcdBarrier b; b.bar = bar; b.x = xb_xcc_id(); b.st = st;
    if (threadIdx.x == 0) { const unsigned rank = xb_add(&bar[XB_XCNT(b.x)], 1u); st[2] = rank; st[3] = b.x; }
    return b;
}
__device__ __forceinline__ void xcd_barrier_complete(unsigned* bar, unsigned x, unsigned& nloc, unsigned& nx) {
    const unsigned G = gridDim.x * gridDim.y * gridDim.z;
    unsigned sum, cnt, mine, sp = 0u;
    for (;;) {
        sum = 0u; cnt = 0u; mine = 0u;
#pragma unroll
        for (unsigned j = 0; j < 16; ++j) { const unsigned c = xb_ld(&bar[XB_XCNT(j)]); sum += c; cnt += (c > 0u) ? 1u : 0u; mine = (j == x) ? c : mine; }
        if (sum == G) break;
        __builtin_amdgcn_s_sleep(1);
        if ((++sp & 255u) == 0u) { if (xb_ld(&bar[XB_TMO])) break; if (sp > XB_SPIN_CAP) { atomicAdd(&bar[XB_TMO], 1u); break; } }
    }
    nloc = mine > 0u ? mine : 1u; nx = cnt > 0u ? cnt : 1u;
}
__device__ __forceinline__ void xcd_barrier(const XcdBarrier& b) {
    asm volatile("s_waitcnt vmcnt(0)" ::: "memory");
    __syncthreads();
    if (threadIdx.x == 0) {
        unsigned* bar = b.bar;
        __builtin_amdgcn_s_waitcnt(0);
        unsigned nloc = b.st[0], nx = b.st[1];
        if (nloc == 0u) { xcd_barrier_complete(bar, b.x, nloc, nx); b.st[0] = nloc; b.st[1] = nx; }
        const unsigned old = xb_add(&bar[XB_XSUB(b.x)], 1u);
        const unsigned gen = old / nloc;
        if (old + 1u == (gen + 1u) * nloc) {
            __builtin_amdgcn_fence(__ATOMIC_RELEASE, "agent");
            asm volatile("s_waitcnt vmcnt(0)" ::: "memory");
            const unsigned og = xb_add(&bar[XB_TOP], 1u);
            const unsigned tg = og / nx;
            if (og + 1u == (tg + 1u) * nx) xb_add(&bar[XB_TOPGEN], 1u);
            else XB_SPIN(xb_ld(&bar[XB_TOPGEN]) == tg, bar);
            __builtin_amdgcn_fence(__ATOMIC_ACQUIRE, "agent");
            xb_add(&bar[XB_XGEN(b.x)], 1u);
            asm volatile("s_waitcnt vmcnt(0)" ::: "memory");
        } else {
            XB_SPIN(xb_ld(&bar[XB_XGEN(b.x)]) == gen, bar);
            __builtin_amdgcn_fence(__ATOMIC_ACQUIRE, "agent");
            asm volatile("s_waitcnt vmcnt(0)" ::: "memory");
        }
    }
    __syncthreads();
}

namespace pg8 {
constexpr int BM = 256, BK = 64, HALF = 128, HTB = HALF * BK * 2, STAGE_BYTES = 8 * HTB, NXCD = 8, WGM = 8;
__host__ __device__ __forceinline__ int lds_byte(int r, int c) { const int st = (r >> 4) * 2 + (c >> 5), rr = r & 15, cc = c & 31, ob = rr * 64 + cc * 2; return st * 1024 + (ob ^ (((ob >> 9) & 1) << 5)); }
__host__ __device__ __forceinline__ void stage_rc(int b, int& R, int& C) { const int st = b / 1024, sb = b % 1024, swz = sb ^ (((sb >> 9) & 1) << 5); R = (st >> 1) * 16 + swz / 64; C = (st & 1) * 32 + (swz % 64) / 2; }
__host__ __device__ __forceinline__ int perm32(int rho) { const int n = rho >> 4, i = rho & 15; return 8 * (i >> 2) + 4 * n + (i & 3); }
struct Unit { int pm, pn; };
struct Order {
    int nM, nN, nwg, G, c;
    __device__ void init(int nM_, int nN_, int G_, int c_) { nM = nM_; nN = nN_; nwg = nM * nN; G = G_; c = c_; }
    __device__ bool next(int i, Unit& u) const {
        const long L = (long)i * G + c; if (L >= nwg) return false;
        int wgid = (int)L; { const int q = nwg / NXCD, r = nwg % NXCD, xcd = wgid % NXCD, off = wgid / NXCD; wgid = (xcd < r ? xcd * (q + 1) : r * (q + 1) + (xcd - r) * q) + off; }
        const int nig = WGM * nN, gid = wgid / nig, fm = gid * WGM, gsz = (nM - fm) < WGM ? (nM - fm) : WGM;
        u.pm = fm + ((wgid % nig) % gsz); u.pn = (wgid % nig) / gsz; return true;
    }
};
#if defined(PROBE4)
__device__ unsigned long long g_dummy_;
#endif
template <class Epi, class Ptr>
__device__ __forceinline__ void gemm_phase(LAS unsigned char* lds, const int K, const Order& S, const Ptr& P, const Epi& E) {
    const int tid = threadIdx.x, wid = __builtin_amdgcn_readfirstlane(tid >> 6), lane = tid & 63, wr = wid >> 2, wc = wid & 3, fr = lane & 15, fq = lane >> 4;
    const int nt = K / BK;
    unsigned voffA[2], voffB[2];
#pragma unroll
    for (int i = 0; i < 2; ++i) { int R, C; stage_rc(tid * 16 + i * 8192, R, C); const int Rb = (R & ~31) + perm32(R & 31);
        voffA[i] = (unsigned)(R * K + C) * 2u; voffB[i] = (unsigned)(Rb * K + C) * 2u; }
    const size_t kstep = (size_t)(BK * 2);
    const size_t hstep = (size_t)HALF * K * 2;
    const unsigned ldsw = (unsigned)wid * 1024u;
    const int aoff = lds_byte(wr * 64 + fr, fq * 8), boff = lds_byte(wc * 32 + fr, fq * 8);
#define PG8_SA(b, h) (((b) * 2 + (h)) * HTB)
#define PG8_SB(b, h) ((4 + (b) * 2 + (h)) * HTB)
#define PG8_STAGE(bufoff, gbase, voff) do { _Pragma("unroll") for (int _i = 0; _i < 2; ++_i) \
        __builtin_amdgcn_global_load_lds((const unsigned*)((const char*)(gbase) + (voff)[_i]), (LAS unsigned*)(lds + (bufoff) + ldsw + _i * 8192), 16, 0, 0); } while (0)
#define PG8_LDA(dst, b, h) do { _Pragma("unroll") for (int m = 0; m < 4; ++m) _Pragma("unroll") for (int k = 0; k < 2; ++k) dst[m][k] = *(const LAS bf16x8*)(lds + PG8_SA(b, h) + aoff + m * 2048 + k * 1024); } while (0)
#define PG8_LDB(dst, b, h) do { _Pragma("unroll") for (int n = 0; n < 2; ++n) _Pragma("unroll") for (int k = 0; k < 2; ++k) dst[n][k] = *(const LAS bf16x8*)(lds + PG8_SB(b, h) + boff + n * 2048 + k * 1024); } while (0)
#define PG8_MMA(ai, bj, At, Bt) do { __builtin_amdgcn_s_setprio(1); _Pragma("unroll") for (int m = 0; m < 4; ++m) _Pragma("unroll") for (int n = 0; n < 2; ++n) _Pragma("unroll") for (int k = 0; k < 2; ++k) \
        acc[ai][bj][m][n] = __builtin_amdgcn_mfma_f32_16x16x32_bf16(Bt[n][k], At[m][k], acc[ai][bj][m][n], 0, 0, 0); __builtin_amdgcn_s_setprio(0); } while (0)
#define PG8_WAIT_V(n) asm volatile("s_waitcnt vmcnt(" #n ")" ::: "memory")
#define PG8_WAIT_L(n) asm volatile("s_waitcnt lgkmcnt(" #n ")" ::: "memory")
#define PG8_BAR __builtin_amdgcn_s_barrier()
#define PG8_SCHED __builtin_amdgcn_sched_barrier(0)
#if defined(PROBE4)
    unsigned long long g_pacc = 0ull;
#endif
    Unit cur, nxt; int ui = 0;
    if (!S.next(0, cur)) return;
    f32x4 acc[2][2][4][2];
#pragma unroll
    for (int a = 0; a < 2; ++a)
#pragma unroll
        for (int b = 0; b < 2; ++b)
#pragma unroll
            for (int m = 0; m < 4; ++m)
#pragma unroll
                for (int n = 0; n < 2; ++n) acc[a][b][m][n] = (f32x4){0.f, 0.f, 0.f, 0.f};
    bf16x8 At[4][2], B0[2][2], B1[2][2];
    const char* cA; const char* cB; P.ptrs(cur, cA, cB);
    PG8_STAGE(PG8_SB(0, 0), cB, voffB); PG8_STAGE(PG8_SB(0, 1), cB + hstep, voffB); PG8_STAGE(PG8_SA(0, 0), cA, voffA); PG8_STAGE(PG8_SA(0, 1), cA + hstep, voffA);
    if (wr == 1) PG8_BAR;
    PG8_WAIT_V(2); PG8_BAR;
    PG8_STAGE(PG8_SB(1, 0), cB + kstep, voffB); PG8_STAGE(PG8_SA(1, 0), cA + kstep, voffA); PG8_STAGE(PG8_SB(1, 1), cB + hstep + kstep, voffB);
    PG8_WAIT_V(6); PG8_BAR;
    for (;;) {
        const bool has_next = S.next(ui + 1, nxt);
        const char* nA = cA; const char* nB = cB; if (has_next) P.ptrs(nxt, nA, nB);
        for (int t = 0; t < nt; t += 2) {
            const bool last = (t == nt - 2);
            const char* a1 = cA + (size_t)(t + 1) * kstep;
            const char* a2 = last ? nA : cA + (size_t)(t + 2) * kstep; const char* b2 = last ? nB : cB + (size_t)(t + 2) * kstep;
            const char* a3 = a2 + kstep; const char* b3 = b2 + kstep;
            PG8_LDB(B0, 0, 0); PG8_LDB(B1, 0, 1); PG8_SCHED; PG8_LDA(At, 0, 0); PG8_STAGE(PG8_SA(1, 1), a1 + hstep, voffA);
            PG8_WAIT_V(8); PG8_WAIT_L(0); PG8_BAR; PG8_MMA(0, 0, At, B0); PG8_MMA(0, 1, At, B1); PG8_BAR; PG8_SCHED;
            PG8_LDA(At, 0, 1); PG8_STAGE(PG8_SB(0, 0), b2, voffB); PG8_STAGE(PG8_SB(0, 1), b2 + hstep, voffB); PG8_STAGE(PG8_SA(0, 0), a2, voffA);
            PG8_WAIT_V(8); PG8_WAIT_L(0); PG8_BAR; PG8_MMA(1, 0, At, B0); PG8_MMA(1, 1, At, B1); PG8_BAR; PG8_SCHED;
            PG8_LDB(B0, 1, 0); PG8_LDB(B1, 1, 1); PG8_SCHED; PG8_LDA(At, 1, 0); PG8_STAGE(PG8_SA(0, 1), a2 + hstep, voffA);
            PG8_WAIT_V(8); PG8_WAIT_L(0); PG8_BAR; PG8_MMA(0, 0, At, B0); PG8_MMA(0, 1, At, B1); PG8_BAR; PG8_SCHED;
            PG8_LDA(At, 1, 1); PG8_STAGE(PG8_SB(1, 0), b3, voffB); PG8_STAGE(PG8_SB(1, 1), b3 + hstep, voffB); PG8_STAGE(PG8_SA(1, 0), a3, voffA);
            PG8_WAIT_V(8); PG8_WAIT_L(0); PG8_BAR; PG8_MMA(1, 0, At, B0); PG8_MMA(1, 1, At, B1); PG8_BAR; PG8_SCHED;
        }
        if (wr == 0) PG8_BAR;
#if defined(PROBE4)
        unsigned long long pe0_ = __builtin_amdgcn_s_memtime();
#endif
        E(acc, cur, wr, wc, fr, fq);
#if defined(PROBE4)
        if (PROBE4 == 1) { asm volatile("s_waitcnt vmcnt(0)" ::: "memory"); }
        g_pacc += __builtin_amdgcn_s_memtime() - pe0_;
#endif
        if (!has_next) break;
#pragma unroll
        for (int a = 0; a < 2; ++a)
#pragma unroll
            for (int b = 0; b < 2; ++b)
#pragma unroll
                for (int m = 0; m < 4; ++m)
#pragma unroll
                    for (int n = 0; n < 2; ++n) acc[a][b][m][n] = (f32x4){0.f, 0.f, 0.f, 0.f};
        cur = nxt; cA = nA; cB = nB; ++ui;
        if (wr == 1) PG8_BAR;
    }
    PG8_WAIT_V(0);
    PG8_BAR;
#if defined(PROBE4)
    if (blockIdx.x == 0 && tid == 0 && K == 1024 && S.nN == 22) { volatile LAS unsigned* MI = (volatile LAS unsigned*)(lds + LDS_MISC); const unsigned long long v = (((unsigned long long)MI[21] << 32) | MI[20]) + g_pacc; MI[20] = (unsigned)v; MI[21] = (unsigned)(v >> 32); }
#endif
#undef PG8_SA
#undef PG8_SB
#undef PG8_STAGE
#undef PG8_LDA
#undef PG8_LDB
#undef PG8_MMA
#undef PG8_WAIT_V
#undef PG8_WAIT_L
#undef PG8_BAR
#undef PG8_SCHED
}
}
struct Frame {
    LAS unsigned char* lds;
    int tid, lane, wave, vcu, G, vb;
    unsigned char* ws;
    const float* in[18];
    float* out;
};
#define WSP(T, off) ((T*)(F.ws + (off)))

__device__ __forceinline__ void conv_item(const float* W, int ldn, int srccol0, int k0, const float* gain, bf16_t* WT, int K, int dstrow0, LAS float* scr, int lane) {
    float v[32];
    const float* wp = W + (size_t)(k0 + (lane >> 5)) * ldn + srccol0 + (lane & 31);
#pragma unroll
    for (int i = 0; i < 32; ++i) v[i] = wp[(size_t)(2 * i) * ldn];
    const int c = lane & 7;
    float gn[8];
#pragma unroll
    for (int e = 0; e < 8; ++e) gn[e] = gain ? gain[k0 + 8 * c + e] : 1.0f;
#pragma unroll
    for (int i = 0; i < 32; ++i) scr[(2 * i + (lane >> 5)) * 33 + (lane & 31)] = v[i];
    LDS_WAIT(); asm volatile("" ::: "memory");
#pragma unroll
    for (int j = 0; j < 4; ++j) { const int n = (lane >> 3) + 8 * j; const LAS float* s = scr + (8 * c) * 33 + n;
        u32x4 o; o.x = cvt_pk_bf16(s[0 * 33] * gn[0], s[1 * 33] * gn[1]); o.y = cvt_pk_bf16(s[2 * 33] * gn[2], s[3 * 33] * gn[3]);
        o.z = cvt_pk_bf16(s[4 * 33] * gn[4], s[5 * 33] * gn[5]); o.w = cvt_pk_bf16(s[6 * 33] * gn[6], s[7 * 33] * gn[7]);
        *(u32x4*)(WT + (size_t)(dstrow0 + n) * K + k0 + 8 * c) = o; }
    LDS_WAIT(); asm volatile("" ::: "memory");
}
struct ConvJob { const float* W; int ldn, K, N, col0, kind; const float* gain; bf16_t* WT; };
__device__ __forceinline__ int conv_items(const ConvJob& J) { return (J.K / 64) * (J.N / 32); }
__device__ __forceinline__ void conv_run(const ConvJob& J, int item, LAS float* scr, int lane) {
    const int nblk = J.N / 32, kb = item / nblk, nb = item % nblk; const int n0 = 32 * nb;
    int src;
    if (J.kind == 0) src = J.col0 + n0; else { const int u = n0 >> 8, j = n0 & 255; src = (j < 128) ? u * 128 + j : 2816 + u * 128 + (j - 128); }
    conv_item(J.W, J.ldn, src, 64 * kb, J.gain, J.WT, J.K, n0, scr, lane);
}
__device__ __forceinline__ int conv_job(Frame& F, const ConvJob& J, int base, int gw, int ngw) {
    LAS float* scr = (LAS float*)(F.lds + F.wave * 16384);
    const int n = conv_items(J);
    const int first = (gw - base % ngw + ngw) % ngw;
    for (int it = first; it < n; it += ngw) conv_run(J, it, scr, F.lane);
    return base + n;
}
__device__ __forceinline__ ConvJob job_ffn_in(Frame& F, int layer, int which  , size_t dst) {
    ConvJob J; J.W = F.in[which ? 7 : 3] + (size_t)layer * D * 2 * DFF; J.ldn = 2 * DFF; J.K = D; J.N = 2 * DFF; J.col0 = 0; J.kind = 1; J.gain = F.in[which ? 6 : 2] + layer * D; J.WT = WSP(bf16_t, dst); return J; }
__device__ __forceinline__ ConvJob job_ffn_out(Frame& F, int layer, int which, size_t dst) {
    ConvJob J; J.W = F.in[which ? 8 : 4] + (size_t)layer * DFF * D; J.ldn = D; J.K = DFF; J.N = D; J.col0 = 0; J.kind = 0; J.gain = nullptr; J.WT = WSP(bf16_t, dst); return J; }

__device__ __forceinline__ f32x2 pk_silu_mul(f32x2 g, f32x2 u, float c1, float rs2) {
    const f32x2 t = g * c1; f32x2 e; e.x = __builtin_amdgcn_exp2f(t.x); e.y = __builtin_amdgcn_exp2f(t.y);
    const f32x2 d = e + 1.0f; f32x2 r; r.x = __builtin_amdgcn_rcpf(d.x); r.y = __builtin_amdgcn_rcpf(d.y);
    return (g * u) * (r * rs2);
}
#define ROWS8_RSTD(SSp, rowbase, rsv) do { const float a_ = row_rstd(SSp, (rowbase) + fq * 16), b_ = row_rstd(SSp, (rowbase) + 128 + fq * 16); \
        _Pragma("unroll") for (int k_ = 0; k_ < 8; ++k_) rsv[k_] = __shfl(k_ < 4 ? a_ : b_, fr + 16 * (k_ & 3)); } while (0)

struct EpiSwiglu {
    const float* SS; bf16_t* ACT;
    __device__ __forceinline__ void operator()(const f32x4 (&acc)[2][2][4][2], const pg8::Unit& u, int wr, int wc, int fr, int fq) const {
        float rsv[8]; ROWS8_RSTD(SS, u.pm * 256 + wr * 64 + fr, rsv);
#pragma unroll
        for (int ai = 0; ai < 2; ++ai)
#pragma unroll
            for (int m = 0; m < 4; ++m) {
                const int row = u.pm * 256 + ai * 128 + wr * 64 + m * 16 + fr; const float rs = rsv[ai * 4 + m], c1 = rs * -1.4426950408889634f, rs2 = rs * rs;
                f32x2 v[4];
#pragma unroll
                for (int n = 0; n < 2; ++n) { const f32x4 g = acc[ai][0][m][n], up = acc[ai][1][m][n];
                    v[2 * n] = pk_silu_mul((f32x2){g[0], g[1]}, (f32x2){up[0], up[1]}, c1, rs2); v[2 * n + 1] = pk_silu_mul((f32x2){g[2], g[3]}, (f32x2){up[2], up[3]}, c1, rs2); }
                u32x4 w; w.x = cvt_pk_bf16(v[0].x, v[0].y); w.y = cvt_pk_bf16(v[1].x, v[1].y); w.z = cvt_pk_bf16(v[2].x, v[2].y); w.w = cvt_pk_bf16(v[3].x, v[3].y);
                *(u32x4*)(ACT + (size_t)row * DFF + u.pn * 128 + wc * 32 + 8 * fq) = w;
            }
    }
};
template <bool BASE_F32> struct EpiResid {
    const float* xbase; bf16_t* HB; float* SS; float alpha;
    __device__ __forceinline__ void operator()(const f32x4 (&acc)[2][2][4][2], const pg8::Unit& u, int wr, int wc, int fr, int fq) const {
#pragma unroll
        for (int ai = 0; ai < 2; ++ai)
#pragma unroll
            for (int m = 0; m < 4; ++m) {
                const int row = u.pm * 256 + ai * 128 + wr * 64 + m * 16 + fr; float ss = 0.f;
#pragma unroll
                for (int bj = 0; bj < 2; ++bj) {
                    const size_t off = (size_t)row * D + u.pn * 256 + bj * 128 + wc * 32 + 8 * fq;
                    f32x4 b0, b1;
                    if (BASE_F32) { b0 = *(const f32x4*)(xbase + off); b1 = *(const f32x4*)(xbase + off + 4); }
                    else { const u32x4 hv = *(const u32x4*)(HB + off); b0 = (f32x4){bf_lo(hv.x), bf_hi(hv.x), bf_lo(hv.y), bf_hi(hv.y)}; b1 = (f32x4){bf_lo(hv.z), bf_hi(hv.z), bf_lo(hv.w), bf_hi(hv.w)}; }
                    const f32x4 v0 = b0 + acc[ai][bj][m][0] * alpha, v1 = b1 + acc[ai][bj][m][1] * alpha;
                    u32x4 w; w.x = cvt_pk_bf16(v0[0], v0[1]); w.y = cvt_pk_bf16(v0[2], v0[3]); w.z = cvt_pk_bf16(v1[0], v1[1]); w.w = cvt_pk_bf16(v1[2], v1[3]);
                    *(u32x4*)(HB + off) = w;
                    ss += (v0[0] * v0[0] + v0[1] * v0[1]) + (v0[2] * v0[2] + v0[3] * v0[3]) + (v1[0] * v1[0] + v1[1] * v1[1]) + (v1[2] * v1[2] + v1[3] * v1[3]);
                }
                ss += __shfl_xor(ss, 16); ss += __shfl_xor(ss, 32);
                if (fq == 0) SS[(size_t)row * 16 + u.pn * 4 + wc] = ss;
            }
    }
};
struct EpiRetIn {
    const float* SS; bf16_t* QH; bf16_t* KH; bf16_t* VT;
    __device__ __forceinline__ void operator()(const f32x4 (&acc)[2][2][4][2], const pg8::Unit& u, int wr, int wc, int fr, int fq) const {
        if (u.pn < 8) {
            const bool isq = u.pn < 4; const int head = u.pn & 3; bf16_t* dst = isq ? QH : KH;
            const float l2g = isq ? L2G[head] : -L2G[head], sc = isq ? 1.0f : 0.0625f;
            float inv[8];
#pragma unroll
            for (int e = 0; e < 8; ++e) inv[e] = ROPE_INV[wc * 32 + 8 * fq + e];
            float rsv[8]; ROWS8_RSTD(SS, u.pm * 256 + wr * 64 + fr, rsv);
#pragma unroll
            for (int ai = 0; ai < 2; ++ai)
#pragma unroll
                for (int m = 0; m < 4; ++m) {
                    const int row = u.pm * 256 + ai * 128 + wr * 64 + m * 16 + fr; const float rs = rsv[ai * 4 + m];
                    const int b = row >> 13, t = row & 8191; const float pos = (float)(t + NMETA);
                    const float dec = __builtin_amdgcn_exp2f((float)((t & 31) + 1) * l2g) * sc * rs;
                    float o1[8], o2[8];
#pragma unroll
                    for (int n = 0; n < 2; ++n)
#pragma unroll
                        for (int j = 0; j < 4; ++j) { const int e = 4 * n + j;
                            const float rev = (pos * inv[e]) * 0.15915494309189535f; const float frc = rev - floorf(rev);
                            const float sn = __builtin_amdgcn_sinf(frc), cs = __builtin_amdgcn_cosf(frc);
                            const float t1 = acc[ai][0][m][n][j], t2 = acc[ai][1][m][n][j];
                            o1[e] = (t1 * cs - t2 * sn) * dec; o2[e] = (t1 * sn + t2 * cs) * dec; }
                    bf16_t* p = dst + ((size_t)(b * 4 + head) * SEQ + t) * 256 + wc * 32 + 8 * fq;
                    u32x4 w; w.x = cvt_pk_bf16(o1[0], o1[1]); w.y = cvt_pk_bf16(o1[2], o1[3]); w.z = cvt_pk_bf16(o1[4], o1[5]); w.w = cvt_pk_bf16(o1[6], o1[7]);
                    *(u32x4*)p = w;
                    w.x = cvt_pk_bf16(o2[0], o2[1]); w.y = cvt_pk_bf16(o2[2], o2[3]); w.z = cvt_pk_bf16(o2[4], o2[5]); w.w = cvt_pk_bf16(o2[6], o2[7]);
                    *(u32x4*)(p + 128) = w;
                }
        } else {
            float rs[2][8];
            { const float mine = row_rstd(SS, u.pm * 256 + (fr >> 3) * 128 + wc * 32 + 8 * fq + (fr & 7));
#pragma unroll
              for (int bj = 0; bj < 2; ++bj)
#pragma unroll
                  for (int e = 0; e < 8; ++e) rs[bj][e] = __shfl(mine, bj * 8 + e + 16 * fq); }
            const int b = u.pm >> 5, t0 = (u.pm & 31) * 256;
#pragma unroll
            for (int ai = 0; ai < 2; ++ai)
#pragma unroll
                for (int m = 0; m < 4; ++m) {
                    const int vc = (u.pn - 8) * 256 + ai * 128 + wr * 64 + m * 16 + fr; const int head = vc >> 9, dvi = vc & 511;
                    bf16_t* p = VT + ((size_t)(b * 4 + head) * 512 + dvi) * SEQ + t0 + wc * 32 + 8 * fq;
#pragma unroll
                    for (int bj = 0; bj < 2; ++bj) {
                        const f32x4 v0 = acc[ai][bj][m][0], v1 = acc[ai][bj][m][1];
                        u32x4 w; w.x = cvt_pk_bf16(v0[0] * rs[bj][0], v0[1] * rs[bj][1]); w.y = cvt_pk_bf16(v0[2] * rs[bj][2], v0[3] * rs[bj][3]);
                        w.z = cvt_pk_bf16(v1[0] * rs[bj][4], v1[1] * rs[bj][5]); w.w = cvt_pk_bf16(v1[2] * rs[bj][6], v1[3] * rs[bj][7]);
                        *(u32x4*)(p + bj * 128) = w;
                    }
                }
        }
    }
};
template <int DV, int LDO> struct EpiGate {
    const float* SS; const bf16_t* O; bf16_t* Y; LAS float* RO;
    __device__ __forceinline__ void operator()(const f32x4 (&acc)[2][2][4][2], const pg8::Unit& u, int wr, int wc, int fr, int fq) const {
        const int wid = wr * 4 + wc, lane = fq * 16 + fr; const int head = (u.pn * 256) / DV;
        {   const bf16_t* ob = O + (size_t)(u.pm * 256 + wid * 32) * LDO + head * DV;
#pragma unroll
            for (int i0 = 0; i0 < 32; i0 += 8) { float sv[8];
#pragma unroll
                for (int i = 0; i < 8; ++i) { float s;
                    if (DV == 512) { const u32x4 v = *(const u32x4*)(ob + (size_t)(i0 + i) * LDO + lane * 8);
                        const float a0 = bf_lo(v.x), a1 = bf_hi(v.x), a2 = bf_lo(v.y), a3 = bf_hi(v.y), a4 = bf_lo(v.z), a5 = bf_hi(v.z), a6 = bf_lo(v.w), a7 = bf_hi(v.w);
                        s = ((a0 * a0 + a1 * a1) + (a2 * a2 + a3 * a3)) + ((a4 * a4 + a5 * a5) + (a6 * a6 + a7 * a7)); }
                    else { const u32x2 v = *(const u32x2*)(ob + (size_t)(i0 + i) * LDO + lane * 4);
                        const float a0 = bf_lo(v.x), a1 = bf_hi(v.x), a2 = bf_lo(v.y), a3 = bf_hi(v.y); s = (a0 * a0 + a1 * a1) + (a2 * a2 + a3 * a3); }
                    sv[i] = s; }
#pragma unroll
                for (int i = 0; i < 8; ++i) { const float t = wave_sum(sv[i]); if (lane == 0) RO[wid * 32 + i0 + i] = 1.0f / sqrtf(t * (1.0f / (float)DV) + 1e-6f); } }
            LDS_WAIT(); __builtin_amdgcn_s_barrier(); asm volatile("" ::: "memory"); }
        float rsv[8]; ROWS8_RSTD(SS, u.pm * 256 + wr * 64 + fr, rsv);
#pragma unroll
        for (int ai = 0; ai < 2; ++ai)
#pragma unroll
            for (int m = 0; m < 4; ++m) {
                const int rl = ai * 128 + wr * 64 + m * 16 + fr, row = u.pm * 256 + rl; const float rs = rsv[ai * 4 + m]; const float ro = RO[rl]; const float c1 = rs * -1.4426950408889634f, rs2 = rs * ro;
#pragma unroll
                for (int bj = 0; bj < 2; ++bj) {
                    const int col = u.pn * 256 + bj * 128 + wc * 32 + 8 * fq;
                    const u32x4 ov = *(const u32x4*)(O + (size_t)row * LDO + col);
                    const f32x4 g0 = acc[ai][bj][m][0], g1 = acc[ai][bj][m][1];
                    const f32x2 y0 = pk_silu_mul((f32x2){g0[0], g0[1]}, (f32x2){bf_lo(ov.x), bf_hi(ov.x)}, c1, rs2), y1 = pk_silu_mul((f32x2){g0[2], g0[3]}, (f32x2){bf_lo(ov.y), bf_hi(ov.y)}, c1, rs2);
                    const f32x2 y2 = pk_silu_mul((f32x2){g1[0], g1[1]}, (f32x2){bf_lo(ov.z), bf_hi(ov.z)}, c1, rs2), y3 = pk_silu_mul((f32x2){g1[2], g1[3]}, (f32x2){bf_lo(ov.w), bf_hi(ov.w)}, c1, rs2);
                    u32x4 w; w.x = cvt_pk_bf16(y0.x, y0.y); w.y = cvt_pk_bf16(y1.x, y1.y); w.z = cvt_pk_bf16(y2.x, y2.y); w.w = cvt_pk_bf16(y3.x, y3.y);
                    *(u32x4*)(Y + (size_t)row * LDO + col) = w;
                }
            }
        asm volatile("" ::: "memory"); __builtin_amdgcn_s_barrier(); asm volatile("" ::: "memory");
    }
};

struct EpiSiluG {
    const float* SS; bf16_t* G; int ldg;
    __device__ __forceinline__ void operator()(const f32x4 (&acc)[2][2][4][2], const pg8::Unit& u, int wr, int wc, int fr, int fq) const {
        float rsv[8]; ROWS8_RSTD(SS, u.pm * 256 + wr * 64 + fr, rsv);
#pragma unroll
        for (int ai = 0; ai < 2; ++ai)
#pragma unroll
            for (int m = 0; m < 4; ++m) {
                const int row = u.pm * 256 + ai * 128 + wr * 64 + m * 16 + fr; const float rs = rsv[ai * 4 + m], c1 = rs * -1.4426950408889634f;
#pragma unroll
                for (int bj = 0; bj < 2; ++bj) { const f32x4 g0 = acc[ai][bj][m][0], g1 = acc[ai][bj][m][1]; const f32x2 one = (f32x2){1.f, 1.f};
                    const f32x2 y0 = pk_silu_mul((f32x2){g0[0], g0[1]}, one, c1, rs), y1 = pk_silu_mul((f32x2){g0[2], g0[3]}, one, c1, rs);
                    const f32x2 y2 = pk_silu_mul((f32x2){g1[0], g1[1]}, one, c1, rs), y3 = pk_silu_mul((f32x2){g1[2], g1[3]}, one, c1, rs);
                    u32x4 w; w.x = cvt_pk_bf16(y0.x, y0.y); w.y = cvt_pk_bf16(y1.x, y1.y); w.z = cvt_pk_bf16(y2.x, y2.y); w.w = cvt_pk_bf16(y3.x, y3.y);
                    *(u32x4*)(G + (size_t)row * ldg + u.pn * 256 + bj * 128 + wc * 32 + 8 * fq) = w; }
            }
    }
};
struct EpiGlaIn {
    const float* SS; const float* BC; bf16_t* QH; bf16_t* KH; bf16_t* VT;
    __device__ __forceinline__ void operator()(const f32x4 (&acc)[2][2][4][2], const pg8::Unit& u, int wr, int wc, int fr, int fq) const {
        if (u.pn < 4) {
            const bool isq = u.pn < 2; bf16_t* dst = isq ? QH : KH;
            float rsv[8]; ROWS8_RSTD(SS, u.pm * 256 + wr * 64 + fr, rsv);
#pragma unroll
            for (int ai = 0; ai < 2; ++ai)
#pragma unroll
                for (int m = 0; m < 4; ++m) {
                    const int row = u.pm * 256 + ai * 128 + wr * 64 + m * 16 + fr; const float rs = rsv[ai * 4 + m] * (isq ? 0.08838834764831845f : 1.0f);
                    const int b = row >> 13, t = row & 8191;
#pragma unroll
                    for (int bj = 0; bj < 2; ++bj) {
                        const int cq = (u.pn & 1) * 256 + bj * 128 + wc * 32 + 8 * fq; const int head = cq >> 7, d = cq & 127;
                        const f32x4 c0 = *(const f32x4*)(BC + (size_t)row * 512 + cq), c1 = *(const f32x4*)(BC + (size_t)row * 512 + cq + 4);
                        float v[8];
#pragma unroll
                        for (int j = 0; j < 4; ++j) { v[j] = acc[ai][bj][m][0][j] * rs * __expf(isq ? c0[j] : -c0[j]); v[4 + j] = acc[ai][bj][m][1][j] * rs * __expf(isq ? c1[j] : -c1[j]); }
                        u32x4 w; w.x = cvt_pk_bf16(v[0], v[1]); w.y = cvt_pk_bf16(v[2], v[3]); w.z = cvt_pk_bf16(v[4], v[5]); w.w = cvt_pk_bf16(v[6], v[7]);
                        *(u32x4*)(dst + ((size_t)(b * 4 + head) * SEQ + t) * 128 + d) = w;
                    }
                }
        } else {
            float rs[2][8];
            { const float mine = row_rstd(SS, u.pm * 256 + (fr >> 3) * 128 + wc * 32 + 8 * fq + (fr & 7));
#pragma unroll
              for (int bj = 0; bj < 2; ++bj)
#pragma unroll
                  for (int e = 0; e < 8; ++e) rs[bj][e] = __shfl(mine, bj * 8 + e + 16 * fq); }
            const int b = u.pm >> 5, t0 = (u.pm & 31) * 256; const int head = u.pn - 4;
#pragma unroll
            for (int ai = 0; ai < 2; ++ai)
#pragma unroll
                for (int m = 0; m < 4; ++m) {
                    const int dvi = ai * 128 + wr * 64 + m * 16 + fr;
                    bf16_t* p = VT + ((size_t)(b * 4 + head) * 256 + dvi) * SEQ + t0 + wc * 32 + 8 * fq;
#pragma unroll
                    for (int bj = 0; bj < 2; ++bj) {
                        const f32x4 v0 = acc[ai][bj][m][0], v1 = acc[ai][bj][m][1];
                        u32x4 w; w.x = cvt_pk_bf16(v0[0] * rs[bj][0], v0[1] * rs[bj][1]); w.y = cvt_pk_bf16(v0[2] * rs[bj][2], v0[3] * rs[bj][3]);
                        w.z = cvt_pk_bf16(v1[0] * rs[bj][4], v1[1] * rs[bj][5]); w.w = cvt_pk_bf16(v1[2] * rs[bj][6], v1[3] * rs[bj][7]);
                        *(u32x4*)(p + bj * 128) = w;
                    }
                }
        }
    }
};
struct PtrNormal { const char* A; const char* B; size_t tstep;
    __device__ __forceinline__ void ptrs(const pg8::Unit& u, const char*& cA, const char*& cB) const { cA = A + (size_t)u.pm * tstep; cB = B + (size_t)u.pn * tstep; } };
struct PtrSwapFrom { const char* A; const char* B; size_t tstep; int pn_swap;
    __device__ __forceinline__ void ptrs(const pg8::Unit& u, const char*& cA, const char*& cB) const {
        const char* a = A + (size_t)u.pm * tstep; const char* b = B + (size_t)u.pn * tstep;
        if (u.pn >= pn_swap) { cA = b; cB = a; } else { cA = a; cB = b; } } };

constexpr int MA_RS_OFF = 98304, MA_RED_OFF = 100352;
template <int MODE> __device__ __forceinline__ void meta_tiles(Frame& F, const bf16_t* Bt, int N, int K, float* out, int ldo, float alpha, int b0, int nb) {
    const int lane = F.lane, g = lane >> 4, r16 = lane & 15, pitch = K + 8;
    const LAS bf16_t* A = (const LAS bf16_t*)F.lds; const LAS float* rsA = (const LAS float*)(F.lds + MA_RS_OFF); LAS f32x4* red = (LAS f32x4*)(F.lds + MA_RED_OFF);
    const int ksteps = K / 32, per = ksteps / 8;
    for (int tile = F.vb - b0; tile < N / 16; tile += nb) {
        f32x4 acc = (f32x4){0.f, 0.f, 0.f, 0.f};
        const bf16_t* bp = Bt + (size_t)(tile * 16 + r16) * K + 8 * g;
        for (int ks = F.wave * per; ks < (F.wave + 1) * per; ++ks) {
            const bf16x8 a = *(const LAS bf16x8*)(A + r16 * pitch + ks * 32 + 8 * g);
            const bf16x8 b = *(const bf16x8*)(bp + ks * 32);
            acc = __builtin_amdgcn_mfma_f32_16x16x32_bf16(a, b, acc, 0, 0, 0);
        }
        red[F.wave * 64 + lane] = acc;
        __syncthreads();
        if (F.wave == 0) {
            f32x4 s = red[lane];
#pragma unroll
            for (int w = 1; w < 8; ++w) s += red[w * 64 + lane];
#pragma unroll
            for (int j = 0; j < 4; ++j) { const int r = 4 * g + j; float* o = out + (size_t)r * ldo + tile * 16 + r16;
                if (MODE == 0) *o = s[j] * rsA[r]; else *o = *o + alpha * s[j]; }
        }
        __syncthreads();
    }
}
__device__ __forceinline__ bool meta_has_tiles(Frame& F, int N, int b0, int nb) { const int r = F.vb - b0; return r >= 0 && r < nb && r < N / 16; }
__device__ __forceinline__ void meta_prep_h(Frame& F) {
    const float* HM = WSP(float, WS_META + META_HM); LAS bf16_t* A = (LAS bf16_t*)F.lds; LAS float* rsA = (LAS float*)(F.lds + MA_RS_OFF);
    for (int r = F.wave; r < 16; r += 8) { float s = 0.f;
        for (int k = F.lane; k < D; k += 64) { const float v = HM[r * D + k]; s += v * v; A[r * (D + 8) + k] = f2bf(v); }
        s = wave_sum(s); if (F.lane == 0) rsA[r] = 1.0f / sqrtf(s * (1.0f / 1024.0f) + 1e-6f); }
    __syncthreads();
}
__device__ __forceinline__ void meta_prep_act(Frame& F) {
    const float* RAW = WSP(float, WS_META + META_RAW); LAS bf16_t* A = (LAS bf16_t*)F.lds; LAS float* rsA = (LAS float*)(F.lds + MA_RS_OFF);
    for (int i = F.tid; i < 16 * DFF; i += NTHREADS) { const int r = i / DFF, k = i % DFF, u = k >> 7, j = k & 127;
        const float g = RAW[r * 5632 + u * 256 + j], up = RAW[r * 5632 + u * 256 + 128 + j]; A[r * (DFF + 8) + k] = f2bf(fsilu(g) * up); }
    if (F.tid < 16) rsA[F.tid] = 1.f;
    __syncthreads();
}
__device__ __forceinline__ void meta_prep_y(Frame& F) {
    const float* RAW = WSP(float, WS_META + META_RAW); const float* MO = WSP(float, WS_META + META_MO);
    LAS bf16_t* A = (LAS bf16_t*)F.lds; LAS float* rsA = (LAS float*)(F.lds + MA_RS_OFF); LAS float* mro = (LAS float*)(F.lds + MA_RED_OFF);
    for (int p = F.wave; p < 64; p += 8) { const int r = p >> 2, head = p & 3; float sacc = 0.f;
        for (int k = F.lane; k < 512; k += 64) { const float v = MO[r * 2048 + head * 512 + k]; sacc += v * v; }
        sacc = wave_sum(sacc); if (F.lane == 0) mro[p] = 1.0f / sqrtf(sacc * (1.0f / 512.0f) + 1e-6f); }
    __syncthreads();
    for (int i = F.tid; i < 16 * 2048; i += NTHREADS) { const int r = i >> 11, k = i & 2047, head = k >> 9;
        A[r * (2048 + 8) + k] = f2bf(MO[r * 2048 + k] * mro[r * 4 + head] * fsilu(RAW[r * 6144 + 4096 + k])); }
    if (F.tid < 16) rsA[F.tid] = 1.f;
    __syncthreads();
}

__device__ __forceinline__ void meta_tiles_ksplit(Frame& F, const bf16_t* Bt, int K, int KQ, float* out, float alpha) {
    const int lane = F.lane, g = lane >> 4, r16 = lane & 15, pitch = KQ + 8;
    const LAS bf16_t* A = (const LAS bf16_t*)F.lds; LAS f32x4* red = (LAS f32x4*)(F.lds + MA_RED_OFF);
    const int item = F.vb; if (item >= 256) return;
    const int tile = item >> 2, kq = item & 3, nks = KQ / 32;
    f32x4 acc = (f32x4){0.f, 0.f, 0.f, 0.f};
    const bf16_t* bp = Bt + (size_t)(tile * 16 + r16) * K + kq * KQ + 8 * g;
    for (int ks = F.wave; ks < nks; ks += 8) {
        const bf16x8 a = *(const LAS bf16x8*)(A + r16 * pitch + ks * 32 + 8 * g);
        const bf16x8 b = *(const bf16x8*)(bp + ks * 32);
        acc = __builtin_amdgcn_mfma_f32_16x16x32_bf16(a, b, acc, 0, 0, 0);
    }
    red[F.wave * 64 + lane] = acc;
    __syncthreads();
    if (F.wave == 0) { f32x4 sacc = red[lane];
#pragma unroll
        for (int w = 1; w < 8; ++w) sacc += red[w * 64 + lane];
#pragma unroll
        for (int j = 0; j < 4; ++j) atomicAdd(out + (size_t)(4 * g + j) * D + tile * 16 + r16, alpha * sacc[j]); }
    __syncthreads();
}
__device__ __forceinline__ void meta_prep_act_q(Frame& F) {
    const float* RAW = WSP(float, WS_META + META_RAW); LAS bf16_t* A = (LAS bf16_t*)F.lds; const int kq = F.vb & 3;
    for (int i = F.tid; i < 16 * 704; i += NTHREADS) { const int r = i / 704, kk = i % 704, k = kq * 704 + kk, u = k >> 7, j = k & 127;
        const float gt = RAW[r * 5632 + u * 256 + j], up = RAW[r * 5632 + u * 256 + 128 + j]; A[r * (704 + 8) + kk] = f2bf(fsilu(gt) * up); }
    __syncthreads();
}
__device__ __forceinline__ void meta_prep_y_q(Frame& F) {
    const float* RAW = WSP(float, WS_META + META_RAW); const float* MO = WSP(float, WS_META + META_MO);
    LAS bf16_t* A = (LAS bf16_t*)F.lds; LAS float* mro = (LAS float*)(F.lds + MA_RED_OFF); const int head = F.vb & 3;
    for (int r = F.wave; r < 16; r += 8) { float sacc = 0.f;
        for (int k = F.lane; k < 512; k += 64) { const float v = MO[r * 2048 + head * 512 + k]; sacc += v * v; }
        sacc = wave_sum(sacc); if (F.lane == 0) mro[r] = 1.0f / sqrtf(sacc * (1.0f / 512.0f) + 1e-6f); }
    __syncthreads();
    for (int i = F.tid; i < 16 * 512; i += NTHREADS) { const int r = i >> 9, kk = i & 511, k = head * 512 + kk;
        A[r * (512 + 8) + kk] = f2bf(MO[r * 2048 + k] * mro[r] * fsilu(RAW[r * 6144 + 4096 + k])); }
    __syncthreads();
}
__device__ __forceinline__ void z_phase(Frame& F, const bf16_t* HB, const float* SS, const bf16_t* WZ, const float* wg, const float* bg, float* BC) {
    LAS float* zpart = (LAS float*)F.lds;
    LAS float* zs = (LAS float*)(F.lds + 8192);
    const int lane = F.lane, g = lane >> 4, r16 = lane & 15;
    for (int cidx = blockIdx.x; cidx < M / 64; cidx += F.G) {
        const int row0 = cidx * 64;
        { const int tile = F.wave & 3, kh = F.wave >> 2; f32x4 acc = (f32x4){0.f, 0.f, 0.f, 0.f};
          const bf16_t* ap = HB + (size_t)(row0 + tile * 16 + r16) * D + 8 * g; const bf16_t* bp = WZ + (size_t)r16 * D + 8 * g;
#pragma unroll
          for (int ks = kh * 16; ks < kh * 16 + 16; ++ks) {
              const bf16x8 a = *(const bf16x8*)(ap + ks * 32), b = *(const bf16x8*)(bp + ks * 32);
              acc = __builtin_amdgcn_mfma_f32_16x16x32_bf16(a, b, acc, 0, 0, 0);
          }
#pragma unroll
          for (int j = 0; j < 4; ++j) zpart[(kh * 64 + tile * 16 + 4 * g + j) * 16 + r16] = acc[j]; }
        __syncthreads();
        for (int i = F.tid; i < 64 * 16; i += NTHREADS) { const int t = i >> 4; zs[i] = (zpart[i] + zpart[1024 + i]) * row_rstd(SS, row0 + t); }
        __syncthreads();
        { const int c = F.tid; float w[16];
#pragma unroll
          for (int r = 0; r < 16; ++r) w[r] = wg[r * 512 + c];
          const float bias = bg[c]; float cum = 0.f;
          for (int t = 0; t < 64; ++t) { float a = bias; if (t == 32) cum = 0.f;
              const f32x4 z0 = *(const LAS f32x4*)(zs + t * 16), z1 = *(const LAS f32x4*)(zs + t * 16 + 4), z2 = *(const LAS f32x4*)(zs + t * 16 + 8), z3 = *(const LAS f32x4*)(zs + t * 16 + 12);
#pragma unroll
              for (int r = 0; r < 4; ++r) a += z0[r] * w[r] + z1[r] * w[4 + r] + z2[r] * w[8 + r] + z3[r] * w[12 + r];
              const float ls = fminf(a, 0.f) - __logf(1.0f + __expf(-fabsf(a)));
              cum += ls * 0.0625f; BC[(size_t)(row0 + t) * 512 + c] = cum; } }
        __syncthreads();
    }
}

typedef short v4i16_t __attribute__((ext_vector_type(4)));
__device__ __forceinline__ s16x4 ds_tr_asm(unsigned addr) { s16x4 r; asm volatile("ds_read_b64_tr_b16 %0, %1" : "=v"(r) : "v"(addr) : "memory"); return r; }
__device__ __forceinline__ s16x4 ds_tr(const LAS unsigned char* p) { return __builtin_bit_cast(s16x4, __builtin_amdgcn_ds_read_tr16_b64_v4i16((LAS v4i16_t*)p)); }
template <int DK, int DV, bool GLA>
__device__ __forceinline__ void s2v6_phase(Frame& F, const int unit, const bf16_t* QH, const bf16_t* KH, const bf16_t* VT, bf16_t* O, const float* BC, int ldraw) {
    constexpr int NS = DV / 16, ROWB = DK * 2, TILEB = 32 * ROWB, NIL = TILEB / 1024 / 4, LDO = 4 * DV, KS = DK / 32, NSTEP = 257, NLO = DK / 128, NHI = DK / 32 - NLO;
    constexpr int LK = 0, LQ = 3 * TILEB, LV = 6 * TILEB, LDEC = LV + 3 * 1024, LP = LDEC + 3 * 1024, LS = LP + 2 * 2048, LEND = LS + 2 * 16 * ROWB;
    static_assert(LEND <= LDS_MISC, "S2 LDS map");
    if (unit >= 8 * NS) return;
    const int bh = unit & 7, s = unit >> 3, b = bh >> 2, h = bh & 3;
    const int lane = F.lane, g = lane >> 4, r16 = lane & 15, w = F.wave, li = w & 3, hf = w >> 2, qi = li >> 1, kj = li & 1;
    LAS unsigned char* L = F.lds; const unsigned Lb = (unsigned)(uintptr_t)L;
    const float* RAW = WSP(float, WS_META + META_RAW);
    const char* Qg = (const char*)(QH + (size_t)bh * SEQ * DK); const char* Kg = (const char*)(KH + (size_t)bh * SEQ * DK);
    const char* Vg = (const char*)(VT + ((size_t)bh * DV + 16 * s) * SEQ);
    u32x4 ra[2 * NIL + 1], rb[2 * NIL + 1], rc[2 * NIL + 1];
#pragma unroll
    for (int i = 0; i < 2 * NIL + 1; ++i) { ra[i] = (u32x4){0, 0, 0, 0}; rb[i] = ra[i]; rc[i] = ra[i]; }
#define S6_LOAD(c_, R) do { const int rc_ = ((c_) - 1 < 255) ? (c_) - 1 : 255; const char* kc_ = Kg + (size_t)rc_ * TILEB; const char* qc_ = Qg + (size_t)rc_ * TILEB; \
        _Pragma("unroll") for (int i_ = 0; i_ < NIL; ++i_) { const int piece_ = li * NIL + i_, off_ = piece_ * 1024 + lane * 16, row_ = off_ / ROWB, p_ = (off_ % ROWB) >> 4; const int so_ = row_ * ROWB + ((p_ ^ (row_ & 15)) << 4); \
            R[i_] = *(const u32x4*)(kc_ + so_); R[NIL + i_] = *(const u32x4*)(qc_ + so_); } \
        if (li == 0) { const int wv_ = lane >> 2, p_ = lane & 3; R[2 * NIL] = *(const u32x4*)(Vg + (size_t)wv_ * SEQ * 2 + (size_t)rc_ * 64 + ((p_ ^ ((wv_ >> 2) & 3)) << 4)); } \
        if (GLA && li == 1) R[2 * NIL] = *(const u32x4*)((const char*)(BC + (size_t)(b * SEQ + rc_ * 32 + 31) * 512 + h * 128) + lane * 16); } while (0)
#define S6_WRITE(st_, R) do { \
        _Pragma("unroll") for (int i_ = 0; i_ < NIL; ++i_) { const int piece_ = li * NIL + i_; \
            *(LAS u32x4*)(L + LK + (st_) * TILEB + piece_ * 1024 + lane * 16) = R[i_]; *(LAS u32x4*)(L + LQ + (st_) * TILEB + piece_ * 1024 + lane * 16) = R[NIL + i_]; } \
        if (li == 0) *(LAS u32x4*)(L + LV + (st_) * 1024 + lane * 16) = R[2 * NIL]; \
        if (GLA && li == 1) *(LAS u32x4*)(L + LDEC + (st_) * 1024 + lane * 16) = R[2 * NIL]; } while (0)
#define S6_PT(st_, pb_) do { f32x4 pa = (f32x4){0.f, 0.f, 0.f, 0.f}, pc = pa; \
        if (kj <= qi) { const LAS unsigned char* kb = L + LK + (st_) * TILEB + (16 * kj + r16) * ROWB; const LAS unsigned char* qb = L + LQ + (st_) * TILEB + (16 * qi + r16) * ROWB; \
            _Pragma("unroll") for (int ks = 0; ks < KS; ks += 2) { const int ch0 = ((4 * ks + g) ^ r16) << 4, ch1 = ((4 * (ks + 1) + g) ^ r16) << 4; \
                const bf16x8 k0 = *(const LAS bf16x8*)(kb + ch0), q0 = *(const LAS bf16x8*)(qb + ch0), k1 = *(const LAS bf16x8*)(kb + ch1), q1 = *(const LAS bf16x8*)(qb + ch1); \
                pa = __builtin_amdgcn_mfma_f32_16x16x32_bf16(k0, q0, pa, 0, 0, 0); pc = __builtin_amdgcn_mfma_f32_16x16x32_bf16(k1, q1, pc, 0, 0, 0); } } \
        const f32x4 pt = pa + pc; const int i = 16 * qi + r16, j0 = 16 * kj + 4 * g; \
        const float v0 = (j0 + 0 <= i) ? pt[0] : 0.f, v1 = (j0 + 1 <= i) ? pt[1] : 0.f, v2 = (j0 + 2 <= i) ? pt[2] : 0.f, v3 = (j0 + 3 <= i) ? pt[3] : 0.f; \
        u32x2 pk; pk.x = cvt_pk_bf16(v0, v1); pk.y = cvt_pk_bf16(v2, v3); \
        *(LAS u32x2*)(L + LP + (pb_) * 2048 + i * 64 + (((2 * kj + (g >> 1)) ^ ((i >> 2) & 3)) << 4) + (g & 1) * 8) = pk; } while (0)
    for (int i = F.tid * 16; i < TILEB; i += NTHREADS * 16) { *(LAS u32x4*)(L + LK + i) = (u32x4){0, 0, 0, 0}; *(LAS u32x4*)(L + LQ + i) = (u32x4){0, 0, 0, 0}; }
    for (int i = F.tid * 16; i < 1024; i += NTHREADS * 16) *(LAS u32x4*)(L + LV + i) = (u32x4){0, 0, 0, 0};
    for (int i = F.tid * 16; i < 16 * ROWB; i += NTHREADS * 16) *(LAS u32x4*)(L + LS + i) = (u32x4){0, 0, 0, 0};
    __syncthreads();
    if (!GLA) {
        for (int idx = F.tid; idx < 16 * 128; idx += NTHREADS) { const int j = idx >> 7, c = idx & 127, row = 16 + j;
            const float* rq = RAW + (size_t)j * ldraw + h * 256; const float* rk = rq + 1024;
            const float rev = ((float)j * ROPE_INV[c]) * 0.15915494309189535f; const float frc = rev - floorf(rev);
            const float sn = __builtin_amdgcn_sinf(frc), cs = __builtin_amdgcn_cosf(frc);
            const float dq = __builtin_amdgcn_exp2f((float)(row + 1) * L2G[h]), dk = 0.0625f * __builtin_amdgcn_exp2f(-(float)(row + 1) * L2G[h]);
            const float q1v = rq[c], q2v = rq[c + 128], k1 = rk[c], k2 = rk[c + 128];
            const int a1 = row * ROWB + ((((c >> 3)) ^ (row & 15)) << 4) + (c & 7) * 2, a2 = row * ROWB + ((((c + 128) >> 3) ^ (row & 15)) << 4) + (c & 7) * 2;
            *(LAS bf16_t*)(L + LQ + a1) = f2bf((q1v * cs - q2v * sn) * dq); *(LAS bf16_t*)(L + LQ + a2) = f2bf((q1v * sn + q2v * cs) * dq);
            *(LAS bf16_t*)(L + LK + a1) = f2bf((k1 * cs - k2 * sn) * dk); *(LAS bf16_t*)(L + LK + a2) = f2bf((k1 * sn + k2 * cs) * dk); }
        if (F.tid < 256) { const int j = F.tid >> 4, wv = F.tid & 15, tok = 16 + j;
            *(LAS bf16_t*)(L + LV + wv * 64 + (((tok >> 3) ^ ((wv >> 2) & 3)) << 4) + (tok & 7) * 2) = f2bf(RAW[(size_t)j * ldraw + 2048 + h * 512 + 16 * s + wv]); }
    } else {
        if (F.tid < 128) { const int d = F.tid; const float* wgp = F.in[13] + h * 128 + d; const float bias = F.in[14][h * 128 + d]; float cum = 0.f;
            for (int j = 0; j < 16; ++j) { float a = bias;
                for (int r = 0; r < 16; ++r) a += RAW[(size_t)j * ldraw + 3072 + r] * wgp[r * 512];
                cum += (fminf(a, 0.f) - __logf(1.0f + __expf(-fabsf(a)))) * 0.0625f;
                const int row = 16 + j;
                *(LAS bf16_t*)(L + LK + row * ROWB + (((d >> 3) ^ (row & 15)) << 4) + (d & 7) * 2) = f2bf(RAW[(size_t)j * ldraw + 512 + h * 128 + d] * __expf(-cum)); }
            *(LAS float*)(L + LDEC + d * 4) = cum; }
        if (F.tid >= 256) { const int j = (F.tid - 256) >> 4, wv = F.tid & 15, tok = 16 + j;
            *(LAS bf16_t*)(L + LV + wv * 64 + (((tok >> 3) ^ ((wv >> 2) & 3)) << 4) + (tok & 7) * 2) = f2bf(RAW[(size_t)j * ldraw + 1024 + h * 256 + 16 * s + wv]); }
    }
    const float g32 = GLA ? 1.0f : __builtin_amdgcn_exp2f(32.0f * L2G[h]);
    if (hf) { S6_LOAD(1, ra); S6_WRITE(1, ra); }
    __syncthreads();
    if (hf) { S6_PT(0, 0); S6_LOAD(2, rb); S6_LOAD(3, rc); }
    __syncthreads();
    if (hf) {
#define S6_ODD(t_, RL, RW) do { const int t = (t_); S6_LOAD(t + 4, RL); if (t + 1 < NSTEP) S6_PT(s1, (t + 1) & 1); S6_WRITE(s2, RW); \
            LDS_WAIT(); __builtin_amdgcn_s_barrier(); asm volatile("" ::: "memory"); { const int o_ = s0; s0 = s1; s1 = s2; s2 = o_; } } while (0)
        int s0 = 0, s1 = 1, s2 = 2;
        for (int t3 = 0; t3 < 255; t3 += 3) { S6_ODD(t3, ra, rb); S6_ODD(t3 + 1, rb, rc); S6_ODD(t3 + 2, rc, ra); }
        S6_ODD(255, ra, rb); S6_ODD(256, rb, rc);
#undef S6_ODD
    } else {
        f32x4 S[NHI];
#pragma unroll
        for (int tt = 0; tt < NHI; ++tt) S[tt] = (f32x4){0.f, 0.f, 0.f, 0.f};
        int s0 = 0;
        for (int t = 0; t < NSTEP; ++t) { const int sb = t & 1;
            { s16x4 klo[NHI], khi[NHI];
              const bf16x8 vb = *(const LAS bf16x8*)(L + LV + s0 * 1024 + r16 * 64 + ((g ^ ((r16 >> 2) & 3)) << 4));
#pragma unroll
              for (int tt = 0; tt < NHI; ++tt) if (li >= 2 || tt < NLO) { const int tile = (li < 2) ? li + 2 * tt : 2 * NLO + (li - 2) + 2 * tt, d0 = 16 * tile, dcol = d0 + 4 * (r16 & 3), chunk = dcol >> 3, sub = (dcol & 7) * 2;
                  const int r1 = 8 * g + (r16 >> 2), r2 = r1 + 4;
                  klo[tt] = ds_tr_asm(Lb + LK + s0 * TILEB + r1 * ROWB + ((chunk ^ (r1 & 15)) << 4) + sub);
                  khi[tt] = ds_tr_asm(Lb + LK + s0 * TILEB + r2 * ROWB + ((chunk ^ (r2 & 15)) << 4) + sub); }
              asm volatile("s_waitcnt lgkmcnt(0)" ::: "memory"); __builtin_amdgcn_sched_barrier(0);
#pragma unroll
              for (int tt = 0; tt < NHI; ++tt) if (li >= 2 || tt < NLO) {
                  const bf16x8 ka = (bf16x8){klo[tt][0], klo[tt][1], klo[tt][2], klo[tt][3], khi[tt][0], khi[tt][1], khi[tt][2], khi[tt][3]};
                  S[tt] = __builtin_amdgcn_mfma_f32_16x16x32_bf16(ka, vb, S[tt], 0, 0, 0); }
#pragma unroll
              for (int tt = 0; tt < NHI; ++tt) if (li >= 2 || tt < NLO) { const int tile = (li < 2) ? li + 2 * tt : 2 * NLO + (li - 2) + 2 * tt;
                  if (GLA) { const f32x4 dl = *(const LAS f32x4*)(L + LDEC + s0 * 1024 + (16 * tile + 4 * g) * 4);
                      S[tt][0] *= __expf(dl[0]); S[tt][1] *= __expf(dl[1]); S[tt][2] *= __expf(dl[2]); S[tt][3] *= __expf(dl[3]); } else S[tt] = S[tt] * g32;
                  u32x2 pk; pk.x = cvt_pk_bf16(S[tt][0], S[tt][1]); pk.y = cvt_pk_bf16(S[tt][2], S[tt][3]);
                  *(LAS u32x2*)(L + LS + (sb ^ 1) * 16 * ROWB + r16 * ROWB + (((2 * tile + (g >> 1)) ^ r16) << 4) + (g & 1) * 8) = pk; } }
            if (li < 2) { const int irow = 16 * li + r16;
                const bf16x8 va = *(const LAS bf16x8*)(L + LV + s0 * 1024 + r16 * 64 + ((g ^ ((r16 >> 2) & 3)) << 4));
                const bf16x8 pb = *(const LAS bf16x8*)(L + LP + sb * 2048 + irow * 64 + ((g ^ ((irow >> 2) & 3)) << 4));
                f32x4 oa = __builtin_amdgcn_mfma_f32_16x16x32_bf16(va, pb, (f32x4){0.f, 0.f, 0.f, 0.f}, 0, 0, 0), ob = (f32x4){0.f, 0.f, 0.f, 0.f};
                const LAS unsigned char* sp = L + LS + sb * 16 * ROWB + r16 * ROWB; const LAS unsigned char* qb = L + LQ + s0 * TILEB + irow * ROWB;
#pragma unroll
                for (int ks = 0; ks < KS; ks += 2) { const int ch0 = ((4 * ks + g) ^ r16) << 4, ch1 = ((4 * (ks + 1) + g) ^ r16) << 4;
                    const bf16x8 sv0 = *(const LAS bf16x8*)(sp + ch0), q0 = *(const LAS bf16x8*)(qb + ch0), sv1 = *(const LAS bf16x8*)(sp + ch1), q1 = *(const LAS bf16x8*)(qb + ch1);
                    oa = __builtin_amdgcn_mfma_f32_16x16x32_bf16(sv0, q0, oa, 0, 0, 0); ob = __builtin_amdgcn_mfma_f32_16x16x32_bf16(sv1, q1, ob, 0, 0, 0); }
                const f32x4 ot = oa + ob;
                if (t >= 1) { const size_t grow = (size_t)b * SEQ + (size_t)(t - 1) * 32 + irow; u32x2 pk; pk.x = cvt_pk_bf16(ot[0], ot[1]); pk.y = cvt_pk_bf16(ot[2], ot[3]);
                    *(u32x2*)(O + grow * LDO + h * DV + 16 * s + 4 * g) = pk; }
                else if (!GLA && b == 0 && irow >= 16) { float* MO = WSP(float, WS_META + META_MO); *(f32x4*)(MO + (size_t)(irow - 16) * 2048 + h * 512 + 16 * s + 4 * g) = ot; } }
            LDS_WAIT(); __builtin_amdgcn_s_barrier(); asm volatile("" ::: "memory");
            s0 = (s0 == 2) ? 0 : s0 + 1;
        }
    }
#undef S6_LOAD
#undef S6_WRITE
#undef S6_PT
}

__device__ __forceinline__ void gla_gate_phase(Frame& F, const bf16_t* O, const bf16_t* G, bf16_t* Y) {
    const int gw = F.vcu * NWAVES + F.wave, NGW = F.G * NWAVES; const int head = F.lane >> 4;
    for (int m = gw; m < M; m += NGW) {
        const u32x4 o0 = *(const u32x4*)(O + (size_t)m * 1024 + 16 * F.lane), o1 = *(const u32x4*)(O + (size_t)m * 1024 + 16 * F.lane + 8);
        const u32x4 g0 = *(const u32x4*)(G + (size_t)m * 1024 + 16 * F.lane), g1 = *(const u32x4*)(G + (size_t)m * 1024 + 16 * F.lane + 8);
        float ov[16] = {bf_lo(o0.x), bf_hi(o0.x), bf_lo(o0.y), bf_hi(o0.y), bf_lo(o0.z), bf_hi(o0.z), bf_lo(o0.w), bf_hi(o0.w), bf_lo(o1.x), bf_hi(o1.x), bf_lo(o1.y), bf_hi(o1.y), bf_lo(o1.z), bf_hi(o1.z), bf_lo(o1.w), bf_hi(o1.w)};
        const float gv[16] = {bf_lo(g0.x), bf_hi(g0.x), bf_lo(g0.y), bf_hi(g0.y), bf_lo(g0.z), bf_hi(g0.z), bf_lo(g0.w), bf_hi(g0.w), bf_lo(g1.x), bf_hi(g1.x), bf_lo(g1.y), bf_hi(g1.y), bf_lo(g1.z), bf_hi(g1.z), bf_lo(g1.w), bf_hi(g1.w)};
        float ssum = 0.f;
#pragma unroll
        for (int i = 0; i < 16; ++i) ssum += ov[i] * ov[i];
        ssum += __shfl_xor(ssum, 1); ssum += __shfl_xor(ssum, 2); ssum += __shfl_xor(ssum, 4); ssum += __shfl_xor(ssum, 8);
        const float ro = 1.0f / sqrtf(ssum * (1.0f / 256.0f) + 1e-6f);
        u32x4 y0, y1;
        y0.x = cvt_pk_bf16(ov[0] * ro * gv[0], ov[1] * ro * gv[1]); y0.y = cvt_pk_bf16(ov[2] * ro * gv[2], ov[3] * ro * gv[3]); y0.z = cvt_pk_bf16(ov[4] * ro * gv[4], ov[5] * ro * gv[5]); y0.w = cvt_pk_bf16(ov[6] * ro * gv[6], ov[7] * ro * gv[7]);
        y1.x = cvt_pk_bf16(ov[8] * ro * gv[8], ov[9] * ro * gv[9]); y1.y = cvt_pk_bf16(ov[10] * ro * gv[10], ov[11] * ro * gv[11]); y1.z = cvt_pk_bf16(ov[12] * ro * gv[12], ov[13] * ro * gv[13]); y1.w = cvt_pk_bf16(ov[14] * ro * gv[14], ov[15] * ro * gv[15]);
        *(u32x4*)(Y + (size_t)m * 1024 + 16 * F.lane) = y0; *(u32x4*)(Y + (size_t)m * 1024 + 16 * F.lane + 8) = y1;
        (void)head;
    }
}
__device__ __forceinline__ void final_phase(Frame& F, const float* SS, const float* gain) {
    const int gw = F.vcu * NWAVES + F.wave, NGW = F.G * NWAVES; const bf16_t* HB = WSP(bf16_t, WS_HB);
    f32x4 gv[4];
#pragma unroll
    for (int j = 0; j < 4; ++j) gv[j] = *(const f32x4*)(gain + 4 * F.lane + 256 * j);
    for (int m = gw; m < M; m += NGW) { float* row = F.out + (size_t)m * D; const float rs = row_rstd(SS, m);
#pragma unroll
        for (int j = 0; j < 4; ++j) { const u32x2 hv = *(const u32x2*)(HB + (size_t)m * D + 4 * F.lane + 256 * j);
            f32x4 v = (f32x4){bf_lo(hv.x), bf_hi(hv.x), bf_lo(hv.y), bf_hi(hv.y)}; v = v * rs * gv[j]; *(f32x4*)(row + 4 * F.lane + 256 * j) = v; } }
}
__device__ __forceinline__ void p0_rows(Frame& F) {
    const int gw = F.vcu * NWAVES + F.wave, NGW = F.G * NWAVES; const float* x = F.in[0]; bf16_t* HB = WSP(bf16_t, WS_HB); float* SS = WSP(float, WS_SS);
    for (int m = gw; m < M; m += 2 * NGW) { const int m2 = m + NGW;
        f32x4 va[4], vb[4];
#pragma unroll
        for (int j = 0; j < 4; ++j) { va[j] = *(const f32x4*)(x + (size_t)m * D + 4 * F.lane + 256 * j); vb[j] = *(const f32x4*)(x + (size_t)m2 * D + 4 * F.lane + 256 * j); }
        float s = 0.f, s2 = 0.f;
#pragma unroll
        for (int j = 0; j < 4; ++j) { const f32x4 v = va[j], u = vb[j]; s += (v[0] * v[0] + v[1] * v[1]) + (v[2] * v[2] + v[3] * v[3]); s2 += (u[0] * u[0] + u[1] * u[1]) + (u[2] * u[2] + u[3] * u[3]);
            u32x2 pk; pk.x = cvt_pk_bf16(v[0], v[1]); pk.y = cvt_pk_bf16(v[2], v[3]); *(u32x2*)(HB + (size_t)m * D + 4 * F.lane + 256 * j) = pk;
            pk.x = cvt_pk_bf16(u[0], u[1]); pk.y = cvt_pk_bf16(u[2], u[3]); *(u32x2*)(HB + (size_t)m2 * D + 4 * F.lane + 256 * j) = pk; }
        s = wave_sum(s); s2 = wave_sum(s2);
        if (F.lane < 16) { SS[(size_t)m * 16 + F.lane] = F.lane == 0 ? s : 0.f; SS[(size_t)m2 * 16 + F.lane] = F.lane == 0 ? s2 : 0.f; } }
    if (blockIdx.x == 0) { float* HM = WSP(float, WS_META + META_HM); for (int i = F.tid; i < 16 * D; i += NTHREADS) HM[i] = F.in[1][i]; }
}

#ifndef S2FN
#define S2FN s2v6_phase
#endif
struct Args { const float* in[18]; float* out; unsigned char* ws; int ph_lo, ph_hi; };
constexpr int N_PHASES = 19;
__global__ void __launch_bounds__(NTHREADS, 2) fwd(Args args) {
    extern __shared__ __attribute__((aligned(16))) unsigned char lds_raw[];
    Frame F;
    F.lds = (LAS unsigned char*)lds_raw;
    F.tid = threadIdx.x; F.lane = F.tid & 63; F.wave = __builtin_amdgcn_readfirstlane(F.tid >> 6);
    F.G = gridDim.x; { const int bx = blockIdx.x; F.vcu = (F.G % 8 == 0) ? (bx % 8) * (F.G / 8) + bx / 8 : bx; }
    F.ws = args.ws; F.out = args.out;
#pragma unroll
    for (int i = 0; i < 18; ++i) F.in[i] = args.in[i];
    volatile LAS unsigned* MISC = (volatile LAS unsigned*)(F.lds + LDS_MISC);
    if (F.tid < 64) MISC[F.tid] = 0u;
    __syncthreads();
    XcdBarrier bar = xcd_barrier_post(WSP(unsigned, WS_CTL) + CW_BAR, MISC + 8);
    const int lo = args.ph_lo, hi = args.ph_hi;
    __syncthreads();
    F.vb = (int)blockIdx.x;
    int vblk = (int)blockIdx.x;
#define IN(k) (lo <= (k) && (k) < hi)
#if defined(PROBE_PHASE)
    unsigned long long t_prev = __builtin_amdgcn_s_memrealtime(), t_probe = 0ull;
#define SEAM(k) do { if (IN(k) && IN((k) + 1)) xcd_barrier(bar); { const unsigned long long t_now = __builtin_amdgcn_s_memrealtime(); if ((k) == PROBE_PHASE) t_probe = t_now - t_prev; t_prev = t_now; } } while (0)
#else
#define SEAM(k) do { if (IN(k) && IN((k) + 1)) xcd_barrier(bar); } while (0)
#endif
    bf16_t* HB = WSP(bf16_t, WS_HB); float* SS = WSP(float, WS_SS); float* H = F.out;
    bf16_t* ACT = WSP(bf16_t, WS_ACT);
    const int gw = F.vcu * NWAVES + F.wave, NGW = F.G * NWAVES;
    float* RAW = WSP(float, WS_META + META_RAW); float* HM = WSP(float, WS_META + META_HM);

#define FFN_IN(win, do_meta) do { \
        if ((do_meta) && meta_has_tiles(F, 2 * DFF, 128, 128)) { meta_prep_h(F); meta_tiles<0>(F, WSP(bf16_t, (win)), 2 * DFF, D, RAW, 2 * DFF, 1.f, 128, 128); } \
        pg8::Order S_; S_.init(M / 256, 22, F.G, vblk); PtrNormal P_{(const char*)HB, (const char*)WSP(bf16_t, (win)), (size_t)256 * D * 2}; \
        EpiSwiglu E_{SS, ACT}; pg8::gemm_phase(F.lds, D, S_, P_, E_); } while (0)
#define FFN_OUT(woutp, do_meta, F32B) do { const bf16_t* wo_ = (woutp); \
        if (do_meta) { meta_prep_act_q(F); meta_tiles_ksplit(F, wo_, DFF, 704, HM, 0.5f); } \
        pg8::Order S_; S_.init(M / 256, 4, F.G, vblk); PtrNormal P_{(const char*)ACT, (const char*)wo_, (size_t)256 * DFF * 2}; \
        EpiResid<F32B> E_{F.in[0], HB, SS, 0.5f}; pg8::gemm_phase(F.lds, DFF, S_, P_, E_); } while (0)

#define slack (vblk >= 128)
#define sgw ((vblk - 128) * NWAVES + F.wave)
    const int SNGW = 128 * NWAVES;
    if (IN(0)) {
        int cb = conv_job(F, job_ffn_in(F, 0, 0, WS_WFFN_A + WF_IN), 0, gw, NGW); cb = conv_job(F, job_ffn_out(F, 0, 0, WS_WFFN_A + WF_OUT), cb, gw, NGW);
        p0_rows(F);
    }
    SEAM(0);
    if (lo == 0 && hi == N_PHASES && F.G == 256) {
        const unsigned* barw = WSP(unsigned, WS_CTL) + CW_BAR; bool ok = true;
#pragma unroll
        for (int j = 0; j < 8; ++j) ok = ok && (__hip_atomic_load(barw + XB_XCNT(j), __ATOMIC_RELAXED, __HIP_MEMORY_SCOPE_AGENT) == 32u);
        const unsigned rank = MISC[10], xcc = MISC[11];
        if (ok && rank < 32u && xcc < 8u) vblk = (int)(rank * 8u + xcc);
    }
    F.vb = vblk;
    if (IN(1)) {
        if (slack) { ConvJob J;
            J.W = F.in[9]; J.ldn = 6144; J.K = D; J.N = 6144; J.col0 = 0; J.kind = 0; J.gain = F.in[5]; J.WT = WSP(bf16_t, WS_WMIX + WM_RET_IN);
            int cb = conv_job(F, J, 0, sgw, SNGW);
            J.W = F.in[11]; J.ldn = D; J.K = 2048; J.N = D; J.col0 = 0; J.kind = 0; J.gain = F.in[10]; J.WT = WSP(bf16_t, WS_WMIX + WM_RET_OUT);
            cb = conv_job(F, J, cb, sgw, SNGW);
            cb = conv_job(F, job_ffn_in(F, 0, 1, WS_WFFN_C), cb, sgw, SNGW);
            { ConvJob J2 = job_ffn_out(F, 0, 1, 0); J2.WT = (bf16_t*)F.out; cb = conv_job(F, J2, cb, sgw, SNGW); }
            __syncthreads(); }
        FFN_IN(WS_WFFN_A + WF_IN, true);
    }
    SEAM(1);
    if (IN(2)) FFN_OUT(WSP(bf16_t, WS_WFFN_A + WF_OUT), true, false);
    SEAM(2);
    if (IN(3)) {
        if (meta_has_tiles(F, 6144, 0, 256)) { meta_prep_h(F); meta_tiles<0>(F, WSP(bf16_t, WS_WMIX + WM_RET_IN), 6144, D, RAW, 6144, 1.f, 0, 256); }
        pg8::Order S_; S_.init(M / 256, 16, F.G, vblk);
        PtrSwapFrom P_{(const char*)HB, (const char*)WSP(bf16_t, WS_WMIX + WM_RET_IN), (size_t)256 * D * 2, 8};
        EpiRetIn E_{SS, WSP(bf16_t, WS_QH), WSP(bf16_t, WS_KH), WSP(bf16_t, WS_VT)}; pg8::gemm_phase(F.lds, D, S_, P_, E_);
    }
    SEAM(3);
    if (IN(4)) S2FN<256, 512, false>(F, vblk, WSP(bf16_t, WS_QH), WSP(bf16_t, WS_KH), WSP(bf16_t, WS_VT), WSP(bf16_t, WS_O), nullptr, 6144);
    SEAM(4);
    if (IN(5)) {
        pg8::Order S_; S_.init(M / 256, 8, F.G, vblk); PtrNormal P_{(const char*)HB, (const char*)(WSP(bf16_t, WS_WMIX + WM_RET_IN) + (size_t)4096 * D), (size_t)256 * D * 2};
        EpiGate<512, 2048> E_{SS, WSP(bf16_t, WS_O), WSP(bf16_t, WS_VT), (LAS float*)(F.lds + 132096)}; pg8::gemm_phase(F.lds, D, S_, P_, E_);
    }
    SEAM(5);
    if (IN(6)) {
        { meta_prep_y_q(F); meta_tiles_ksplit(F, WSP(bf16_t, WS_WMIX + WM_RET_OUT), 2048, 512, HM, 1.0f); }
        pg8::Order S_; S_.init(M / 256, 4, F.G, vblk); PtrNormal P_{(const char*)WSP(bf16_t, WS_VT), (const char*)WSP(bf16_t, WS_WMIX + WM_RET_OUT), (size_t)256 * 2048 * 2};
        EpiResid<false> E_{nullptr, HB, SS, 1.0f}; pg8::gemm_phase(F.lds, 2048, S_, P_, E_);
    }
    SEAM(6);
    if (IN(7)) {
        if (slack) { int cb = conv_job(F, job_ffn_in(F, 1, 0, WS_WFFN_B + WF_IN), 0, sgw, SNGW); cb = conv_job(F, job_ffn_out(F, 1, 0, WS_WFFN_B + WF_OUT), cb, sgw, SNGW);
            ConvJob J;
            J.W = F.in[12]; J.ldn = 3088; J.K = D; J.N = 3072; J.col0 = 0; J.kind = 0; J.gain = F.in[5] + D; J.WT = WSP(bf16_t, WS_WMIX + WM_GLA_IN);
            cb = conv_job(F, J, cb, sgw, SNGW);
            J.W = F.in[16]; J.ldn = D; J.K = D; J.N = D; J.col0 = 0; J.kind = 0; J.gain = F.in[15]; J.WT = WSP(bf16_t, WS_WMIX + WM_GLA_OUT);
            cb = conv_job(F, J, cb, sgw, SNGW);
            if (vblk == F.G - 1) { bf16_t* WZ = WSP(bf16_t, WS_WMIX + WM_GLA_Z); const float* W = F.in[12]; const float* gn = F.in[5] + D;
                for (int i = F.tid; i < 16 * D; i += NTHREADS) { const int k = i >> 4, r = i & 15; WZ[r * D + k] = f2bf(W[(size_t)k * 3088 + 3072 + r] * gn[k]); } }
            __syncthreads(); }
        FFN_IN(WS_WFFN_C, true);
    }
    SEAM(7);
    if (IN(8)) FFN_OUT((const bf16_t*)F.out, true, false);
    SEAM(8);
    if (IN(9)) {
        if (slack) { int cb = conv_job(F, job_ffn_in(F, 1, 1, WS_WFFN_A + WF_IN), 0, sgw, SNGW); cb = conv_job(F, job_ffn_out(F, 1, 1, WS_WFFN_A + WF_OUT), cb, sgw, SNGW); __syncthreads(); }
        FFN_IN(WS_WFFN_B + WF_IN, true);
    }
    SEAM(9);
    if (IN(10)) FFN_OUT(WSP(bf16_t, WS_WFFN_B + WF_OUT), true, false);
    SEAM(10);
    if (IN(11)) {
        if (meta_has_tiles(F, 2048, 0, 256)) { meta_prep_h(F); meta_tiles<0>(F, WSP(bf16_t, WS_WMIX + WM_GLA_IN), 2048, D, RAW, 3088, 1.f, 0, 256); }
        if (F.vb == 0) meta_tiles<0>(F, WSP(bf16_t, WS_WMIX + WM_GLA_Z), 16, D, RAW + 3072, 3088, 1.f, 0, 256);
        __syncthreads();
        z_phase(F, HB, SS, WSP(bf16_t, WS_WMIX + WM_GLA_Z), F.in[13], F.in[14], WSP(float, WS_BC));
    }
    SEAM(11);
    if (IN(12)) {
        pg8::Order S_; S_.init(M / 256, 8, F.G, vblk);
        PtrSwapFrom P_{(const char*)HB, (const char*)WSP(bf16_t, WS_WMIX + WM_GLA_IN), (size_t)256 * D * 2, 4};
        EpiGlaIn E_{SS, WSP(float, WS_BC), WSP(bf16_t, WS_QH2), WSP(bf16_t, WS_KH2), WSP(bf16_t, WS_VT2)}; pg8::gemm_phase(F.lds, D, S_, P_, E_);
    }
    SEAM(12);
    if (IN(13)) {
        if (vblk < 128) S2FN<128, 256, true>(F, vblk, WSP(bf16_t, WS_QH2), WSP(bf16_t, WS_KH2), WSP(bf16_t, WS_VT2), WSP(bf16_t, WS_O2), WSP(float, WS_BC), 3088);
        else {
            pg8::Order S_; S_.init(M / 256, 4, 128, vblk - 128); PtrNormal P_{(const char*)HB, (const char*)WSP(bf16_t, WS_WMIX + WM_GLA_G), (size_t)256 * D * 2};
            EpiSiluG E_{SS, WSP(bf16_t, WS_G2), 1024}; pg8::gemm_phase(F.lds, D, S_, P_, E_);
        }
    }
    SEAM(13);
    if (IN(14)) gla_gate_phase(F, WSP(bf16_t, WS_O2), WSP(bf16_t, WS_G2), WSP(bf16_t, WS_VT2));
    SEAM(14);
    if (IN(15)) {
        pg8::Order S_; S_.init(M / 256, 4, F.G, vblk); PtrNormal P_{(const char*)WSP(bf16_t, WS_VT2), (const char*)WSP(bf16_t, WS_WMIX + WM_GLA_OUT), (size_t)256 * D * 2};
        EpiResid<false> E_{nullptr, HB, SS, 1.0f}; pg8::gemm_phase(F.lds, D, S_, P_, E_);
    }
    SEAM(15);
    if (IN(16)) FFN_IN(WS_WFFN_A + WF_IN, false);
    SEAM(16);
    if (IN(17)) FFN_OUT(WSP(bf16_t, WS_WFFN_A + WF_OUT), false, false);
    SEAM(17);
    if (IN(18)) final_phase(F, SS, F.in[17]);
#if defined(PROBE2) || defined(PROBE3) || defined(PROBE4)
    __syncthreads();
    if (blockIdx.x == 0 && F.tid == 0) { const unsigned long long cyc = ((unsigned long long)MISC[21] << 32) | MISC[20]; const unsigned long long t0 = __builtin_amdgcn_s_memtime(); while (__builtin_amdgcn_s_memtime() - t0 < 4ull * cyc) __builtin_amdgcn_s_sleep(16); }
#endif
#if defined(PROBE_PHASE)
    { const unsigned long long t_now = __builtin_amdgcn_s_memrealtime(); if (18 == PROBE_PHASE) t_probe = t_now - t_prev;
      if (blockIdx.x == 0 && F.tid == 0) { const unsigned long long t_end = t_now + (unsigned long long)PROBE_MULT * t_probe; while (__builtin_amdgcn_s_memrealtime() < t_end) __builtin_amdgcn_s_sleep(16); } }
#endif
#undef slack
#undef sgw
#undef IN
#undef SEAM
#undef FFN_IN
#undef FFN_OUT
}
}
#ifndef MK_MODE
#define MK_MODE 0
#endif
#if MK_MODE == 2
namespace dbg {
__global__ void adapt(const float* Hreal, const float* HMtmp, float* Hn) {
    const size_t i = (size_t)blockIdx.x * blockDim.x + threadIdx.x;
    if (i >= (size_t)nv::ROWS * nv::D) return;
    const int d = (int)(i % nv::D); const size_t row = i / nv::D; const int b = (int)(row / nv::TT), s = (int)(row % nv::TT);
    Hn[i] = s < nv::NMETA ? HMtmp[s * nv::D + d] : Hreal[((size_t)b * nv::SEQ + (s - nv::NMETA)) * nv::D + d];
}
}
#endif
extern "C" void kernel_launch(void* const* d_in, const int* in_sizes, int n_in, void* d_out, int out_size, void* d_ws, size_t ws_size, hipStream_t stream) {
    static int grid = 0;
    if (grid == 0) {
        if (n_in != 18 || out_size != mk::M * mk::D || ws_size < mk::WS_NEED) { fprintf(stderr, "kernel_launch: unexpected sizes n_in %d out %d ws %zu\n", n_in, out_size, ws_size); grid = -1; return; }
        int dev = 0, cus = 0, per_cu = 0;
        if (hipGetDevice(&dev) != hipSuccess || hipDeviceGetAttribute(&cus, hipDeviceAttributeMultiprocessorCount, dev) != hipSuccess) { grid = -1; return; }
        if (hipFuncSetAttribute((const void*)mk::fwd, hipFuncAttributeMaxDynamicSharedMemorySize, mk::LDS_BYTES) != hipSuccess) { fprintf(stderr, "kernel_launch: hipFuncSetAttribute failed\n"); grid = -1; return; }
        if (hipOccupancyMaxActiveBlocksPerMultiprocessor(&per_cu, (const void*)mk::fwd, mk::NTHREADS, mk::LDS_BYTES) != hipSuccess || per_cu < 1) { fprintf(stderr, "kernel_launch: occupancy query says %d\n", per_cu); per_cu = 1; }
        (void)hipGetLastError();
        grid = cus;
        if (grid != 256) fprintf(stderr, "kernel_launch: %d CUs (built for 256)\n", grid);
    }
    if (grid < 0) return;
    (void)hipMemsetAsync((char*)d_ws + mk::WS_CTL, 0, mk::CTL_ZERO_BYTES, stream);
    mk::Args a{};
    for (int i = 0; i < 18; ++i) a.in[i] = (const float*)d_in[i];
    a.out = (float*)d_out; a.ws = (unsigned char*)d_ws;
#if MK_MODE == 0
    a.ph_lo = 0; a.ph_hi = mk::N_PHASES;
    hipLaunchKernelGGL(mk::fwd, dim3(grid), dim3(mk::NTHREADS), mk::LDS_BYTES, stream, a);
#elif MK_MODE == 1
    for (int p = 0; p < mk::N_PHASES; ++p) { a.ph_lo = p; a.ph_hi = p + 1; hipLaunchKernelGGL(mk::fwd, dim3(grid), dim3(mk::NTHREADS), mk::LDS_BYTES, stream, a); }
#else
    for (int p = 0; p < MK_CUT; ++p) { a.ph_lo = p; a.ph_hi = p + 1; hipLaunchKernelGGL(mk::fwd, dim3(grid), dim3(mk::NTHREADS), mk::LDS_BYTES, stream, a); }
    {
        float* tmp = (float*)((char*)d_ws + 250 * mk::MiB);
        (void)hipMemcpyAsync(tmp, (char*)d_ws + mk::WS_META + mk::META_HM, 16 * 1024 * 4, hipMemcpyDeviceToDevice, stream);
        hipLaunchKernelGGL(dbg::adapt, dim3((unsigned)(((size_t)nv::ROWS * nv::D + 255) / 256)), dim3(256), 0, stream, (const float*)d_out, (const float*)tmp, (float*)d_ws);
        nv::forward(stream, d_in, (float*)d_out, (char*)d_ws, MK_STAGE);
    }
#endif
}
```

```cpp
#include <hip/hip_runtime.h>
#include <cstdint>
#include <cstdio>
#include <cmath>
#define MK_MODE 0
namespace mk {
#define LAS __attribute__((address_space(3)))
#define GAS __attribute__((address_space(1)))
typedef unsigned short bf16_t;
typedef short bf16x8 __attribute__((ext_vector_type(8)));
typedef short s16x4 __attribute__((ext_vector_type(4)));
typedef float f32x4 __attribute__((ext_vector_type(4)));
typedef float f32x2 __attribute__((ext_vector_type(2)));
typedef unsigned u32x4 __attribute__((ext_vector_type(4)));
typedef unsigned u32x2 __attribute__((ext_vector_type(2)));

constexpr int M = 16384, D = 1024, DFF = 2816, SEQ = 8192, NMETA = 16;
constexpr int NWAVES = 8, NTHREADS = 512;
constexpr size_t MiB = 1u << 20;
constexpr size_t WS_CTL = 0, CTL_ZERO_BYTES = 1 * MiB;
constexpr size_t CTL_OSS_RET = 256 * 1024, CTL_OSS_GLA = 512 * 1024, CTL_MOSS = 768 * 1024;
constexpr size_t WS_HB = 1 * MiB, WS_SS = 33 * MiB, WS_META = 34 * MiB, WS_WMIX = 35 * MiB;
constexpr size_t META_HM = 0, META_RAW = 64 * 1024, META_MO = 448 * 1024;
constexpr size_t WS_WFFN_A = 52 * MiB, WS_ACT = 69 * MiB, WS_WFFN_B = 157 * MiB, WS_WFFN_C = 244 * MiB;
constexpr size_t WS_QH = 52 * MiB, WS_KH = 84 * MiB, WS_VT = 116 * MiB, WS_O = 180 * MiB;
constexpr size_t WS_BC = 69 * MiB, WS_QH2 = 101 * MiB, WS_KH2 = 117 * MiB, WS_VT2 = 133 * MiB, WS_O2 = 174 * MiB;
constexpr size_t WS_BV = 52 * MiB, WS_KM = 180 * MiB, WS_KT = 212 * MiB;
constexpr size_t WS_G2 = 208 * MiB;
constexpr size_t WS_NEED = 256 * MiB;
constexpr size_t WM_RET_IN = 0, WM_RET_OUT = 12 * MiB;
constexpr size_t WM_GLA_IN = 0, WM_GLA_G = 4 * MiB, WM_GLA_OUT = 6 * MiB, WM_GLA_Z = 8 * MiB;
constexpr size_t WF_IN = 0, WF_OUT = 11 * MiB;
constexpr int CW_BAR = 4096;

constexpr int LDS_BYTES = 163840;
constexpr int LDS_MISC = LDS_BYTES - 256;

__constant__ float L2G[4] = {-0.04580368961312478f, -0.02272007650008353f, -0.011315313227834133f, -0.005646563141142062f};
__constant__ float ROPE_INV[128] = {
  1.000000000e+00f, 9.300450087e-01f, 8.649836779e-01f, 8.044736385e-01f,
  7.481966019e-01f, 6.958565116e-01f, 6.471778154e-01f, 6.019044518e-01f,
  5.597981811e-01f, 5.206375122e-01f, 4.842162728e-01f, 4.503428936e-01f,
  4.188391268e-01f, 3.895392120e-01f, 3.622889817e-01f, 3.369450271e-01f,
  3.133740425e-01f, 2.914519310e-01f, 2.710633874e-01f, 2.521011233e-01f,
  2.344653904e-01f, 2.180633694e-01f, 2.028087080e-01f, 1.886212230e-01f,
  1.754262149e-01f, 1.631542742e-01f, 1.517407894e-01f, 1.411257535e-01f,
  1.312533021e-01f, 1.220714748e-01f, 1.135319397e-01f, 1.055898219e-01f,
  9.820328653e-02f, 9.133346379e-02f, 8.494423330e-02f, 7.900195569e-02f,
  7.347535342e-02f, 6.833537668e-02f, 6.355497986e-02f, 5.910899118e-02f,
  5.497401953e-02f, 5.112830922e-02f, 4.755162448e-02f, 4.422515258e-02f,
  4.113136977e-02f, 3.825402260e-02f, 3.557796404e-02f, 3.308910504e-02f,
  3.077435680e-02f, 2.862153389e-02f, 2.661931701e-02f, 2.475716174e-02f,
  2.302526683e-02f, 2.141453326e-02f, 1.991648041e-02f, 1.852322184e-02f,
  1.722742990e-02f, 1.602228358e-02f, 1.490144618e-02f, 1.385901403e-02f,
  1.288950257e-02f, 1.198781747e-02f, 1.114920899e-02f, 1.036926545e-02f,
  9.643883444e-03f, 8.969245479e-03f, 8.341802284e-03f, 7.758250926e-03f,
  7.215522230e-03f, 6.710760761e-03f, 6.241309457e-03f, 5.804697983e-03f,
  5.398627371e-03f, 5.020966288e-03f, 4.669724498e-03f, 4.343053792e-03f,
  4.039235413e-03f, 3.756670747e-03f, 3.493872471e-03f, 3.249458736e-03f,
  3.022142686e-03f, 2.810728736e-03f, 2.614103956e-03f, 2.431234345e-03f,
  2.261157380e-03f, 2.102978062e-03f, 1.955864020e-03f, 1.819041790e-03f,
  1.691789716e-03f, 1.573440502e-03f, 1.463370281e-03f, 1.361000235e-03f,
  1.265791478e-03f, 1.177242957e-03f, 1.094888896e-03f, 1.018295996e-03f,
  9.470609948e-04f, 8.808093844e-04f, 8.191923262e-04f, 7.618857198e-04f,
  7.085879333e-04f, 6.590186385e-04f, 6.129170069e-04f, 5.700403708e-04f,
  5.301629426e-04f, 4.930753494e-04f, 4.585822753e-04f, 4.265021416e-04f,
  3.966661752e-04f, 3.689173318e-04f, 3.431097430e-04f, 3.191074939e-04f,
  2.967843320e-04f, 2.760227653e-04f, 2.567135962e-04f, 2.387551940e-04f,
  2.220530587e-04f, 2.065193403e-04f, 1.920722716e-04f, 1.786358480e-04f,
  1.661392889e-04f, 1.545170089e-04f, 1.437077590e-04f, 1.336546848e-04f,
  1.243048755e-04f, 1.156091312e-04f, 1.075216787e-04f, 9.999999747e-05f,
};

#define LDS_WAIT() asm volatile("s_waitcnt lgkmcnt(0)" ::: "memory")
__device__ __forceinline__ int lane_id_v() { int l; asm volatile("v_mbcnt_lo_u32_b32 %0, -1, 0\n\tv_mbcnt_hi_u32_b32 %0, -1, %0" : "=v"(l)); return l; }
#define VM_WAIT() asm volatile("s_waitcnt vmcnt(0)" ::: "memory")
#define RLX_AGENT __ATOMIC_RELAXED, __HIP_MEMORY_SCOPE_AGENT

__device__ __forceinline__ unsigned cvt_pk_bf16(float lo, float hi) { unsigned r; asm volatile("v_cvt_pk_bf16_f32 %0, %1, %2" : "=v"(r) : "v"(lo), "v"(hi)); return r; }
__device__ __forceinline__ float bf_lo(unsigned w) { return __uint_as_float(w << 16); }
__device__ __forceinline__ float bf_hi(unsigned w) { return __uint_as_float(w & 0xffff0000u); }
__device__ __forceinline__ unsigned short f2bf(float f) { return (unsigned short)(cvt_pk_bf16(f, 0.f) & 0xffffu); }
__device__ __forceinline__ float fsilu(float v) { return v * __builtin_amdgcn_rcpf(1.0f + __expf(-v)); }
__device__ __forceinline__ float wave_sum(float v) {
#pragma unroll
    for (int o = 1; o < 64; o <<= 1) v += __shfl_xor(v, o);
    return v;
}
__device__ __forceinline__ float row_rstd(const float* SS, int row) {
    const f32x4* p = (const f32x4*)(SS + (size_t)row * 16);
    const f32x4 a = p[0], b = p[1], c = p[2], d = p[3];
    const float s = ((a.x + a.y) + (a.z + a.w)) + ((b.x + b.y) + (b.z + b.w)) + ((c.x + c.y) + (c.z + c.w)) + ((d.x + d.y) + (d.z + d.w));
    return 1.0f / sqrtf(s * (1.0f / 1024.0f) + 1e-6f);
}

#define XB_TMO      128
#define XB_XCNT(j)  (256  + 64 * (j))
#define XB_XSUB(j)  (1280 + 64 * (j))
#define XB_XGEN(j)  (2304 + 64 * (j))
#define XB_TOP      3328
#define XB_TOPGEN   3392
#define XCD_BAR_WORDS 3456
#define XB_SPIN_CAP (1u << 18)
__device__ __forceinline__ unsigned xb_ld(unsigned* p)              { return __hip_atomic_load(p, __ATOMIC_RELAXED, __HIP_MEMORY_SCOPE_AGENT); }
__device__ __forceinline__ unsigned xb_add(unsigned* p, unsigned v) { return __hip_atomic_fetch_add(p, v, __ATOMIC_RELAXED, __HIP_MEMORY_SCOPE_AGENT); }
__device__ __forceinline__ unsigned xb_xcc_id() { return (unsigned)__builtin_amdgcn_s_getreg((3 << 11) | 20) & 0xFu; }
#define XB_SPIN(cond, bar) do { unsigned _sp = 0; while (cond) { __builtin_amdgcn_s_sleep(1); \
    if ((++_sp & 255u) == 0u) { if (xb_ld(&(bar)[XB_TMO])) break; if (_sp > XB_SPIN_CAP) { atomicAdd(&(bar)[XB_TMO], 1u); break; } } } } while (0)
struct XcdBarrier { unsigned* bar; unsigned x; volatile LAS unsigned* st; };
__device__ __forceinline__ XcdBarrier xcd_barrier_post(unsigned* bar, volatile LAS unsigned* st) {
    XcdBarrier b; b.bar = bar; b.x = xb_xcc_id(); b.st = st;
    if (threadIdx.x == 0) { const unsigned rank = xb_add(&bar[XB_XCNT(b.x)], 1u); st[2] = rank; st[3] = b.x; }
    return b;
}
__device__ __forceinline__ void xcd_barrier_complete(unsigned* bar, unsigned x, unsigned& nloc, unsigned& nx) {
    const unsigned G = gridDim.x * gridDim.y * gridDim.z;
    unsigned sum, cnt, mine, sp = 0u;
    for (;;) {
        sum = 0u; cnt = 0u; mine = 0u;
#pragma unroll
        for (unsigned j = 0; j < 16; ++j) { const unsigned c = xb_ld(&bar[XB_XCNT(j)]); sum += c; cnt += (c > 0u) ? 1u : 0u; mine = (j == x) ? c : mine; }
        if (sum == G) break;
        __builtin_amdgcn_s_sleep(1);
        if ((++sp & 255u) == 0u) { if (xb_ld(&bar[XB_TMO])) break; if (sp > XB_SPIN_CAP) { atomicAdd(&bar[XB_TMO], 1u); break; } }
    }
    nloc = mine > 0u ? mine : 1u; nx = cnt > 0u ? cnt : 1u;
}
__device__ __forceinline__ void xcd_barrier(const XcdBarrier& b) {
    asm volatile("s_waitcnt vmcnt(0)" ::: "memory");
    __syncthreads();
    if (threadIdx.x == 0) {
        unsigned* bar = b.bar;
        __builtin_amdgcn_s_waitcnt(0);
        unsigned nloc = b.st[0], nx = b.st[1];
        if (nloc == 0u) { xcd_barrier_complete(bar, b.x, nloc, nx); b.st[0] = nloc; b.st[1] = nx; }
        const unsigned old = xb_add(&bar[XB_XSUB(b.x)], 1u);
        const unsigned gen = old / nloc;
        if (old + 1u == (gen + 1u) * nloc) {
            __builtin_amdgcn_fence(__ATOMIC_RELEASE, "agent");
            asm volatile("s_waitcnt vmcnt(0)" ::: "memory");
            const unsigned og = xb_add(&bar[XB_TOP], 1u);
            const unsigned tg = og / nx;
            if (og + 1u == (tg + 1u) * nx) xb_add(&bar[XB_TOPGEN], 1u);
            else XB_SPIN(xb_ld(&bar[XB_TOPGEN]) == tg, bar);
            __builtin_amdgcn_fence(__ATOMIC_ACQUIRE, "agent");
            xb_add(&bar[XB_XGEN(b.x)], 1u);
            asm volatile("s_waitcnt vmcnt(0)" ::: "memory");
        } else {
            XB_SPIN(xb_ld(&bar[XB_XGEN(b.x)]) == gen, bar);
            __builtin_amdgcn_fence(__ATOMIC_ACQUIRE, "agent");
            asm volatile("s_waitcnt vmcnt(0)" ::: "memory");
        }
    }
    __syncthreads();
}

namespace pg8 {
constexpr int BM = 256, BK = 64, HALF = 128, HTB = HALF * BK * 2, STAGE_BYTES = 8 * HTB, NXCD = 8, WGM = 8;
__host__ __device__ __forceinline__ int lds_byte(int r, int c) { const int st = (r >> 4) * 2 + (c >> 5), rr = r & 15, cc = c & 31, ob = rr * 64 + cc * 2; return st * 1024 + (ob ^ (((ob >> 9) & 1) << 5)); }
__host__ __device__ __forceinline__ void stage_rc(int b, int& R, int& C) { const int st = b / 1024, sb = b % 1024, swz = sb ^ (((sb >> 9) & 1) << 5); R = (st >> 1) * 16 + swz / 64; C = (st & 1) * 32 + (swz % 64) / 2; }
__host__ __device__ __forceinline__ int perm32(int rho) { const int n = rho >> 4, i = rho & 15; return 8 * (i >> 2) + 4 * n + (i & 3); }
struct Unit { int pm, pn; };
struct Order {
    int nM, nN, nwg, G, c;
    __device__ void init(int nM_, int nN_, int G_, int c_) { nM = nM_; nN = nN_; nwg = nM * nN; G = G_; c = c_; }
    __device__ bool next(int i, Unit& u) const {
        const long L = (long)i * G + c; if (L >= nwg) return false;
        int wgid = (int)L; { const int q = nwg / NXCD, r = nwg % NXCD, xcd = wgid % NXCD, off = wgid / NXCD; wgid = (xcd < r ? xcd * (q + 1) : r * (q + 1) + (xcd - r) * q) + off; }
        const int nig = WGM * nN, gid = wgid / nig, fm = gid * WGM, gsz = (nM - fm) < WGM ? (nM - fm) : WGM;
        u.pm = fm + ((wgid % nig) % gsz); u.pn = (wgid % nig) / gsz; return true;
    }
};
struct OrderLin {
    int n, G, c;
    __device__ bool next(int i, Unit& u) const { const long L = (long)i * G + c; if (L >= n) return false; u.pm = (int)L; u.pn = 0; return true; }
};
#if defined(PROBE4)
__device__ unsigned long long g_dummy_;
#endif
template <class Epi, class Ptr, class Ord = Order>
__device__ __forceinline__ void gemm_phase(LAS unsigned char* lds, const int K, const Ord& S, const Ptr& P, const Epi& E, const int lda = 0, const int ldb = 0, const int wid_in = -1) {
    const int wid = wid_in >= 0 ? wid_in : __builtin_amdgcn_readfirstlane((int)threadIdx.x >> 6), lane = wid_in >= 0 ? lane_id_v() : (int)(threadIdx.x & 63), tid = wid * 64 + lane, wr = wid >> 2, wc = wid & 3, fr = lane & 15, fq = lane >> 4;
    const int nt = K / BK;
    unsigned voffA[2], voffB[2];
#pragma unroll
    for (int i = 0; i < 2; ++i) { int R, C; stage_rc(tid * 16 + i * 8192, R, C); const int Rb = (R & ~31) + perm32(R & 31);
        voffA[i] = (unsigned)(R * (lda ? lda : K) + C) * 2u; voffB[i] = (unsigned)(Rb * (ldb ? ldb : K) + C) * 2u; }
    const size_t kstep = (size_t)(BK * 2);
    const size_t hstepA = (size_t)HALF * (lda ? lda : K) * 2, hstepB = (size_t)HALF * (ldb ? ldb : K) * 2;
    const unsigned ldsw = (unsigned)wid * 1024u;
    const int aoff = lds_byte(wr * 64 + fr, fq * 8), boff = lds_byte(wc * 32 + fr, fq * 8);
#define PG8_SA(b, h) (((b) * 2 + (h)) * HTB)
#define PG8_SB(b, h) ((4 + (b) * 2 + (h)) * HTB)
#define PG8_STAGE(bufoff, gbase, voff) do { _Pragma("unroll") for (int _i = 0; _i < 2; ++_i) \
        __builtin_amdgcn_global_load_lds((const unsigned*)((const char*)(gbase) + (voff)[_i]), (LAS unsigned*)(lds + (bufoff) + ldsw + _i * 8192), 16, 0, 0); } while (0)
#define PG8_LDA(dst, b, h) do { _Pragma("unroll") for (int m = 0; m < 4; ++m) _Pragma("unroll") for (int k = 0; k < 2; ++k) dst[m][k] = *(const LAS bf16x8*)(lds + PG8_SA(b, h) + aoff + m * 2048 + k * 1024); } while (0)
#define PG8_LDB(dst, b, h) do { _Pragma("unroll") for (int n = 0; n < 2; ++n) _Pragma("unroll") for (int k = 0; k < 2; ++k) dst[n][k] = *(const LAS bf16x8*)(lds + PG8_SB(b, h) + boff + n * 2048 + k * 1024); } while (0)
#define PG8_MMA(ai, bj, At, Bt) do { __builtin_amdgcn_s_setprio(1); _Pragma("unroll") for (int m = 0; m < 4; ++m) _Pragma("unroll") for (int n = 0; n < 2; ++n) _Pragma("unroll") for (int k = 0; k < 2; ++k) \
        acc[ai][bj][m][n] = __builtin_amdgcn_mfma_f32_16x16x32_bf16(Bt[n][k], At[m][k], acc[ai][bj][m][n], 0, 0, 0); __builtin_amdgcn_s_setprio(0); } while (0)
#define PG8_WAIT_V(n) asm volatile("s_waitcnt vmcnt(" #n ")" ::: "memory")
#define PG8_WAIT_L(n) asm volatile("s_waitcnt lgkmcnt(" #n ")" ::: "memory")
#define PG8_BAR __builtin_amdgcn_s_barrier()
#define PG8_SCHED __builtin_amdgcn_sched_barrier(0)
#if defined(PROBE4)
    unsigned long long g_pacc = 0ull;
#endif
    Unit cur, nxt; int ui = 0;
    if (!S.next(0, cur)) return;
    f32x4 acc[2][2][4][2];
#pragma unroll
    for (int a = 0; a < 2; ++a)
#pragma unroll
        for (int b = 0; b < 2; ++b)
#pragma unroll
            for (int m = 0; m < 4; ++m)
#pragma unroll
                for (int n = 0; n < 2; ++n) acc[a][b][m][n] = (f32x4){0.f, 0.f, 0.f, 0.f};
    bf16x8 At[4][2], B0[2][2], B1[2][2];
    const char* cA; const char* cB; P.ptrs(cur, cA, cB);
    PG8_STAGE(PG8_SB(0, 0), cB, voffB); PG8_STAGE(PG8_SB(0, 1), cB + hstepB, voffB); PG8_STAGE(PG8_SA(0, 0), cA, voffA); PG8_STAGE(PG8_SA(0, 1), cA + hstepA, voffA);
    if (wr == 1) PG8_BAR;
    PG8_WAIT_V(2); PG8_BAR;
    PG8_STAGE(PG8_SB(1, 0), cB + kstep, voffB); PG8_STAGE(PG8_SA(1, 0), cA + kstep, voffA); PG8_STAGE(PG8_SB(1, 1), cB + hstepB + kstep, voffB);
    PG8_WAIT_V(6); PG8_BAR;
    for (;;) {
        const bool has_next = S.next(ui + 1, nxt);
        const char* nA = cA; const char* nB = cB; if (has_next) P.ptrs(nxt, nA, nB);
        for (int t = 0; t < nt; t += 2) {
            const bool last = (t == nt - 2);
            const char* a1 = cA + (size_t)(t + 1) * kstep;
            const char* a2 = last ? nA : cA + (size_t)(t + 2) * kstep; const char* b2 = last ? nB : cB + (size_t)(t + 2) * kstep;
            const char* a3 = a2 + kstep; const char* b3 = b2 + kstep;
            PG8_LDB(B0, 0, 0); PG8_LDB(B1, 0, 1); PG8_SCHED; PG8_LDA(At, 0, 0); PG8_STAGE(PG8_SA(1, 1), a1 + hstepA, voffA);
            PG8_WAIT_V(8); PG8_WAIT_L(0); PG8_BAR; PG8_MMA(0, 0, At, B0); PG8_MMA(0, 1, At, B1); PG8_BAR; PG8_SCHED;
            PG8_LDA(At, 0, 1); PG8_STAGE(PG8_SB(0, 0), b2, voffB); PG8_STAGE(PG8_SB(0, 1), b2 + hstepB, voffB); PG8_STAGE(PG8_SA(0, 0), a2, voffA);
            PG8_WAIT_V(8); PG8_WAIT_L(0); PG8_BAR; PG8_MMA(1, 0, At, B0); PG8_MMA(1, 1, At, B1); PG8_BAR; PG8_SCHED;
            PG8_LDB(B0, 1, 0); PG8_LDB(B1, 1, 1); PG8_SCHED; PG8_LDA(At, 1, 0); PG8_STAGE(PG8_SA(0, 1), a2 + hstepA, voffA);
            PG8_WAIT_V(8); PG8_WAIT_L(0); PG8_BAR; PG8_MMA(0, 0, At, B0); PG8_MMA(0, 1, At, B1); PG8_BAR; PG8_SCHED;
            PG8_LDA(At, 1, 1); PG8_STAGE(PG8_SB(1, 0), b3, voffB); PG8_STAGE(PG8_SB(1, 1), b3 + hstepB, voffB); PG8_STAGE(PG8_SA(1, 0), a3, voffA);
            PG8_WAIT_V(8); PG8_WAIT_L(0); PG8_BAR; PG8_MMA(1, 0, At, B0); PG8_MMA(1, 1, At, B1); PG8_BAR; PG8_SCHED;
        }
        if (wr == 0) PG8_BAR;
#if defined(PROBE4)
        unsigned long long pe0_ = __builtin_amdgcn_s_memtime();
#endif
        E(acc, cur, wr, wc, fr, fq);
#if defined(PROBE4)
        if (PROBE4 == 1) { asm volatile("s_waitcnt vmcnt(0)" ::: "memory"); }
        g_pacc += __builtin_amdgcn_s_memtime() - pe0_;
#endif
        if (!has_next) break;
#pragma unroll
        for (int a = 0; a < 2; ++a)
#pragma unroll
            for (int b = 0; b < 2; ++b)
#pragma unroll
                for (int m = 0; m < 4; ++m)
#pragma unroll
                    for (int n = 0; n < 2; ++n) acc[a][b][m][n] = (f32x4){0.f, 0.f, 0.f, 0.f};
        cur = nxt; cA = nA; cB = nB; ++ui;
        if (wr == 1) PG8_BAR;
    }
    PG8_WAIT_V(0);
    PG8_BAR;
#if defined(PROBE4)
    if (blockIdx.x == 0 && tid == 0 && K == 1024 && S.nN == 22) { volatile LAS unsigned* MI = (volatile LAS unsigned*)(lds + LDS_MISC); const unsigned long long v = (((unsigned long long)MI[21] << 32) | MI[20]) + g_pacc; MI[20] = (unsigned)v; MI[21] = (unsigned)(v >> 32); }
#endif
#undef PG8_SA
#undef PG8_SB
#undef PG8_STAGE
#undef PG8_LDA
#undef PG8_LDB
#undef PG8_MMA
#undef PG8_WAIT_V
#undef PG8_WAIT_L
#undef PG8_BAR
#undef PG8_SCHED
}
}
struct Frame {
    LAS unsigned char* lds;
    int tid, lane, wave, vcu, G, vb;
    unsigned char* ws;
    const float* in[18];
    float* out;
};
#define WSP(T, off) ((T*)(F.ws + (off)))

__device__ __forceinline__ void conv_item(const float* W, int ldn, int srccol0, int k0, const float* gain, bf16_t* WT, int K, int dstrow0, LAS float* scr, int lane) {
    float v[32];
    const float* wp = W + (size_t)(k0 + (lane >> 5)) * ldn + srccol0 + (lane & 31);
#pragma unroll
    for (int i = 0; i < 32; ++i) v[i] = wp[(size_t)(2 * i) * ldn];
    const int c = lane & 7;
    float gn[8];
#pragma unroll
    for (int e = 0; e < 8; ++e) gn[e] = gain ? gain[k0 + 8 * c + e] : 1.0f;
#pragma unroll
    for (int i = 0; i < 32; ++i) scr[(2 * i + (lane >> 5)) * 33 + (lane & 31)] = v[i];
    LDS_WAIT(); asm volatile("" ::: "memory");
#pragma unroll
    for (int j = 0; j < 4; ++j) { const int n = (lane >> 3) + 8 * j; const LAS float* s = scr + (8 * c) * 33 + n;
        u32x4 o; o.x = cvt_pk_bf16(s[0 * 33] * gn[0], s[1 * 33] * gn[1]); o.y = cvt_pk_bf16(s[2 * 33] * gn[2], s[3 * 33] * gn[3]);
        o.z = cvt_pk_bf16(s[4 * 33] * gn[4], s[5 * 33] * gn[5]); o.w = cvt_pk_bf16(s[6 * 33] * gn[6], s[7 * 33] * gn[7]);
        *(u32x4*)(WT + (size_t)(dstrow0 + n) * K + k0 + 8 * c) = o; }
    LDS_WAIT(); asm volatile("" ::: "memory");
}
struct ConvJob { const float* W; int ldn, K, N, col0, kind; const float* gain; bf16_t* WT; };
__device__ __forceinline__ int conv_items(const ConvJob& J) { return (J.K / 64) * (J.N / 32); }
__device__ __forceinline__ void conv_run(const ConvJob& J, int item, LAS float* scr, int lane) {
    const int nblk = J.N / 32, kb = item / nblk, nb = item % nblk; const int n0 = 32 * nb;
    int src;
    if (J.kind == 0) src = J.col0 + n0; else { const int u = n0 >> 8, j = n0 & 255; src = (j < 128) ? u * 128 + j : 2816 + u * 128 + (j - 128); }
    conv_item(J.W, J.ldn, src, 64 * kb, J.gain, J.WT, J.K, n0, scr, lane);
}
__device__ __forceinline__ int conv_job(Frame& F, const ConvJob& J, int base, int gw, int ngw) {
    LAS float* scr = (LAS float*)(F.lds + F.wave * 16384);
    const int n = conv_items(J);
    const int first = (gw - base % ngw + ngw) % ngw;
    for (int it = first; it < n; it += ngw) conv_run(J, it, scr, F.lane);
    return base + n;
}
__device__ __forceinline__ ConvJob job_ffn_in(Frame& F, int layer, int which  , size_t dst) {
    ConvJob J; J.W = F.in[which ? 7 : 3] + (size_t)layer * D * 2 * DFF; J.ldn = 2 * DFF; J.K = D; J.N = 2 * DFF; J.col0 = 0; J.kind = 1; J.gain = F.in[which ? 6 : 2] + layer * D; J.WT = WSP(bf16_t, dst); return J; }
__device__ __forceinline__ ConvJob job_ffn_out(Frame& F, int layer, int which, size_t dst) {
    ConvJob J; J.W = F.in[which ? 8 : 4] + (size_t)layer * DFF * D; J.ldn = D; J.K = DFF; J.N = D; J.col0 = 0; J.kind = 0; J.gain = nullptr; J.WT = WSP(bf16_t, dst); return J; }

__device__ __forceinline__ f32x2 pk_silu_mul(f32x2 g, f32x2 u, float c1, float rs2) {
    const f32x2 t = g * c1; f32x2 e; e.x = __builtin_amdgcn_exp2f(t.x); e.y = __builtin_amdgcn_exp2f(t.y);
    const f32x2 d = e + 1.0f; f32x2 r; r.x = __builtin_amdgcn_rcpf(d.x); r.y = __builtin_amdgcn_rcpf(d.y);
    return (g * u) * (r * rs2);
}
#define ROWS8_RSTD(SSp, rowbase, rsv) do { const float a_ = row_rstd(SSp, (rowbase) + fq * 16), b_ = row_rstd(SSp, (rowbase) + 128 + fq * 16); \
        _Pragma("unroll") for (int k_ = 0; k_ < 8; ++k_) rsv[k_] = __shfl(k_ < 4 ? a_ : b_, fr + 16 * (k_ & 3)); } while (0)

struct EpiSwiglu {
    const float* SS; bf16_t* ACT;
    __device__ __forceinline__ void operator()(const f32x4 (&acc)[2][2][4][2], const pg8::Unit& u, int wr, int wc, int fr, int fq) const {
        float rsv[8]; ROWS8_RSTD(SS, u.pm * 256 + wr * 64 + fr, rsv);
#pragma unroll
        for (int ai = 0; ai < 2; ++ai)
#pragma unroll
            for (int m = 0; m < 4; ++m) {
                const int row = u.pm * 256 + ai * 128 + wr * 64 + m * 16 + fr; const float rs = rsv[ai * 4 + m], c1 = rs * -1.4426950408889634f, rs2 = rs * rs;
                f32x2 v[4];
#pragma unroll
                for (int n = 0; n < 2; ++n) { const f32x4 g = acc[ai][0][m][n], up = acc[ai][1][m][n];
                    v[2 * n] = pk_silu_mul((f32x2){g[0], g[1]}, (f32x2){up[0], up[1]}, c1, rs2); v[2 * n + 1] = pk_silu_mul((f32x2){g[2], g[3]}, (f32x2){up[2], up[3]}, c1, rs2); }
                u32x4 w; w.x = cvt_pk_bf16(v[0].x, v[0].y); w.y = cvt_pk_bf16(v[1].x, v[1].y); w.z = cvt_pk_bf16(v[2].x, v[2].y); w.w = cvt_pk_bf16(v[3].x, v[3].y);
                *(u32x4*)(ACT + (size_t)row * DFF + u.pn * 128 + wc * 32 + 8 * fq) = w;
            }
    }
};
template <bool BASE_F32> struct EpiResid {
    const float* xbase; bf16_t* HB; float* SS; float alpha;
    __device__ __forceinline__ void operator()(const f32x4 (&acc)[2][2][4][2], const pg8::Unit& u, int wr, int wc, int fr, int fq) const {
#pragma unroll
        for (int ai = 0; ai < 2; ++ai)
#pragma unroll
            for (int m = 0; m < 4; ++m) {
                const int row = u.pm * 256 + ai * 128 + wr * 64 + m * 16 + fr; float ss = 0.f;
#pragma unroll
                for (int bj = 0; bj < 2; ++bj) {
                    const size_t off = (size_t)row * D + u.pn * 256 + bj * 128 + wc * 32 + 8 * fq;
                    f32x4 b0, b1;
                    if (BASE_F32) { b0 = *(const f32x4*)(xbase + off); b1 = *(const f32x4*)(xbase + off + 4); }
                    else { const u32x4 hv = *(const u32x4*)(HB + off); b0 = (f32x4){bf_lo(hv.x), bf_hi(hv.x), bf_lo(hv.y), bf_hi(hv.y)}; b1 = (f32x4){bf_lo(hv.z), bf_hi(hv.z), bf_lo(hv.w), bf_hi(hv.w)}; }
                    const f32x4 v0 = b0 + acc[ai][bj][m][0] * alpha, v1 = b1 + acc[ai][bj][m][1] * alpha;
                    u32x4 w; w.x = cvt_pk_bf16(v0[0], v0[1]); w.y = cvt_pk_bf16(v0[2], v0[3]); w.z = cvt_pk_bf16(v1[0], v1[1]); w.w = cvt_pk_bf16(v1[2], v1[3]);
                    *(u32x4*)(HB + off) = w;
                    ss += (v0[0] * v0[0] + v0[1] * v0[1]) + (v0[2] * v0[2] + v0[3] * v0[3]) + (v1[0] * v1[0] + v1[1] * v1[1]) + (v1[2] * v1[2] + v1[3] * v1[3]);
                }
                ss += __shfl_xor(ss, 16); ss += __shfl_xor(ss, 32);
                if (fq == 0) SS[(size_t)row * 16 + u.pn * 4 + wc] = ss;
            }
    }
};
struct EpiRetIn {
    const float* SS; bf16_t* QH; bf16_t* KH; bf16_t* VT;
    __device__ __forceinline__ void operator()(const f32x4 (&acc)[2][2][4][2], const pg8::Unit& u, int wr, int wc, int fr, int fq) const {
        if (u.pn < 8) {
            const bool isq = u.pn < 4; const int head = u.pn & 3; bf16_t* dst = isq ? QH : KH;
            const float l2g = isq ? L2G[head] : -L2G[head], sc = isq ? 1.0f : 0.0625f;
            float inv[8]; int ez_ = 0; asm volatile("" : "+v"(ez_));
#pragma unroll
            for (int e = 0; e < 8; ++e) inv[e] = ROPE_INV[wc * 32 + 8 * fq + e + ez_];
            float rsv[8]; ROWS8_RSTD(SS, u.pm * 256 + wr * 64 + fr, rsv);
#pragma unroll
            for (int ai = 0; ai < 2; ++ai)
#pragma unroll
                for (int m = 0; m < 4; ++m) {
                    const int row = u.pm * 256 + ai * 128 + wr * 64 + m * 16 + fr; const float rs = rsv[ai * 4 + m];
                    const int b = row >> 13, t = row & 8191; const float pos = (float)(t + NMETA);
                    const float dec = __builtin_amdgcn_exp2f((float)((t & 31) + 1) * l2g) * sc * rs;
                    float o1[8], o2[8];
#pragma unroll
                    for (int n = 0; n < 2; ++n)
#pragma unroll
                        for (int j = 0; j < 4; ++j) { const int e = 4 * n + j;
                            const float rev = (pos * inv[e]) * 0.15915494309189535f; const float frc = rev - floorf(rev);
                            const float sn = __builtin_amdgcn_sinf(frc), cs = __builtin_amdgcn_cosf(frc);
                            const float t1 = acc[ai][0][m][n][j], t2 = acc[ai][1][m][n][j];
                            o1[e] = (t1 * cs - t2 * sn) * dec; o2[e] = (t1 * sn + t2 * cs) * dec; }
                    bf16_t* p = dst + ((size_t)(b * 4 + head) * SEQ + t) * 256 + wc * 32 + 8 * fq;
                    u32x4 w; w.x = cvt_pk_bf16(o1[0], o1[1]); w.y = cvt_pk_bf16(o1[2], o1[3]); w.z = cvt_pk_bf16(o1[4], o1[5]); w.w = cvt_pk_bf16(o1[6], o1[7]);
                    *(u32x4*)p = w;
                    w.x = cvt_pk_bf16(o2[0], o2[1]); w.y = cvt_pk_bf16(o2[2], o2[3]); w.z = cvt_pk_bf16(o2[4], o2[5]); w.w = cvt_pk_bf16(o2[6], o2[7]);
                    *(u32x4*)(p + 128) = w;
                }
        } else {
            float rs[2][8];
            { const float mine = row_rstd(SS, u.pm * 256 + (fr >> 3) * 128 + wc * 32 + 8 * fq + (fr & 7));
#pragma unroll
              for (int bj = 0; bj < 2; ++bj)
#pragma unroll
                  for (int e = 0; e < 8; ++e) rs[bj][e] = __shfl(mine, bj * 8 + e + 16 * fq); }
            const int b = u.pm >> 5, t0 = (u.pm & 31) * 256;
#pragma unroll
            for (int ai = 0; ai < 2; ++ai)
#pragma unroll
                for (int m = 0; m < 4; ++m) {
                    const int vc = (u.pn - 8) * 256 + ai * 128 + wr * 64 + m * 16 + fr; const int head = vc >> 9, dvi = vc & 511;
                    bf16_t* p = VT + ((size_t)(b * 4 + head) * 512 + dvi) * SEQ + t0 + wc * 32 + 8 * fq;
#pragma unroll
                    for (int bj = 0; bj < 2; ++bj) {
                        const f32x4 v0 = acc[ai][bj][m][0], v1 = acc[ai][bj][m][1];
                        u32x4 w; w.x = cvt_pk_bf16(v0[0] * rs[bj][0], v0[1] * rs[bj][1]); w.y = cvt_pk_bf16(v0[2] * rs[bj][2], v0[3] * rs[bj][3]);
                        w.z = cvt_pk_bf16(v1[0] * rs[bj][4], v1[1] * rs[bj][5]); w.w = cvt_pk_bf16(v1[2] * rs[bj][6], v1[3] * rs[bj][7]);
                        *(u32x4*)(p + bj * 128) = w;
                    }
                }
        }
    }
};
template <int DV, int LDO> struct EpiGate {
    const float* SS; const bf16_t* O; bf16_t* Y; LAS float* RO;
    __device__ __forceinline__ void operator()(const f32x4 (&acc)[2][2][4][2], const pg8::Unit& u, int wr, int wc, int fr, int fq) const {
        const int wid = wr * 4 + wc, lane = fq * 16 + fr; const int head = (u.pn * 256) / DV;
        {   const bf16_t* ob = O + (size_t)(u.pm * 256 + wid * 32) * LDO + head * DV;
#pragma unroll
            for (int i0 = 0; i0 < 32; i0 += 8) { float sv[8];
#pragma unroll
                for (int i = 0; i < 8; ++i) { float s;
                    if (DV == 512) { const u32x4 v = *(const u32x4*)(ob + (size_t)(i0 + i) * LDO + lane * 8);
                        const float a0 = bf_lo(v.x), a1 = bf_hi(v.x), a2 = bf_lo(v.y), a3 = bf_hi(v.y), a4 = bf_lo(v.z), a5 = bf_hi(v.z), a6 = bf_lo(v.w), a7 = bf_hi(v.w);
                        s = ((a0 * a0 + a1 * a1) + (a2 * a2 + a3 * a3)) + ((a4 * a4 + a5 * a5) + (a6 * a6 + a7 * a7)); }
                    else { const u32x2 v = *(const u32x2*)(ob + (size_t)(i0 + i) * LDO + lane * 4);
                        const float a0 = bf_lo(v.x), a1 = bf_hi(v.x), a2 = bf_lo(v.y), a3 = bf_hi(v.y); s = (a0 * a0 + a1 * a1) + (a2 * a2 + a3 * a3); }
                    sv[i] = s; }
#pragma unroll
                for (int i = 0; i < 8; ++i) { const float t = wave_sum(sv[i]); if (lane == 0) RO[wid * 32 + i0 + i] = 1.0f / sqrtf(t * (1.0f / (float)DV) + 1e-6f); } }
            LDS_WAIT(); __builtin_amdgcn_s_barrier(); asm volatile("" ::: "memory"); }
        float rsv[8]; ROWS8_RSTD(SS, u.pm * 256 + wr * 64 + fr, rsv);
#pragma unroll
        for (int ai = 0; ai < 2; ++ai)
#pragma unroll
            for (int m = 0; m < 4; ++m) {
                const int rl = ai * 128 + wr * 64 + m * 16 + fr, row = u.pm * 256 + rl; const float rs = rsv[ai * 4 + m]; const float ro = RO[rl]; const float c1 = rs * -1.4426950408889634f, rs2 = rs * ro;
#pragma unroll
                for (int bj = 0; bj < 2; ++bj) {
                    const int col = u.pn * 256 + bj * 128 + wc * 32 + 8 * fq;
                    const u32x4 ov = *(const u32x4*)(O + (size_t)row * LDO + col);
                    const f32x4 g0 = acc[ai][bj][m][0], g1 = acc[ai][bj][m][1];
                    const f32x2 y0 = pk_silu_mul((f32x2){g0[0], g0[1]}, (f32x2){bf_lo(ov.x), bf_hi(ov.x)}, c1, rs2), y1 = pk_silu_mul((f32x2){g0[2], g0[3]}, (f32x2){bf_lo(ov.y), bf_hi(ov.y)}, c1, rs2);
                    const f32x2 y2 = pk_silu_mul((f32x2){g1[0], g1[1]}, (f32x2){bf_lo(ov.z), bf_hi(ov.z)}, c1, rs2), y3 = pk_silu_mul((f32x2){g1[2], g1[3]}, (f32x2){bf_lo(ov.w), bf_hi(ov.w)}, c1, rs2);
                    u32x4 w; w.x = cvt_pk_bf16(y0.x, y0.y); w.y = cvt_pk_bf16(y1.x, y1.y); w.z = cvt_pk_bf16(y2.x, y2.y); w.w = cvt_pk_bf16(y3.x, y3.y);
                    *(u32x4*)(Y + (size_t)row * LDO + col) = w;
                }
            }
        asm volatile("" ::: "memory"); __builtin_amdgcn_s_barrier(); asm volatile("" ::: "memory");
    }
};

struct EpiSiluG {
    const float* SS; bf16_t* G; int ldg;
    __device__ __forceinline__ void operator()(const f32x4 (&acc)[2][2][4][2], const pg8::Unit& u, int wr, int wc, int fr, int fq) const {
        float rsv[8]; ROWS8_RSTD(SS, u.pm * 256 + wr * 64 + fr, rsv);
#pragma unroll
        for (int ai = 0; ai < 2; ++ai)
#pragma unroll
            for (int m = 0; m < 4; ++m) {
                const int row = u.pm * 256 + ai * 128 + wr * 64 + m * 16 + fr; const float rs = rsv[ai * 4 + m], c1 = rs * -1.4426950408889634f;
#pragma unroll
                for (int bj = 0; bj < 2; ++bj) { const f32x4 g0 = acc[ai][bj][m][0], g1 = acc[ai][bj][m][1]; const f32x2 one = (f32x2){1.f, 1.f};
                    const f32x2 y0 = pk_silu_mul((f32x2){g0[0], g0[1]}, one, c1, rs), y1 = pk_silu_mul((f32x2){g0[2], g0[3]}, one, c1, rs);
                    const f32x2 y2 = pk_silu_mul((f32x2){g1[0], g1[1]}, one, c1, rs), y3 = pk_silu_mul((f32x2){g1[2], g1[3]}, one, c1, rs);
                    u32x4 w; w.x = cvt_pk_bf16(y0.x, y0.y); w.y = cvt_pk_bf16(y1.x, y1.y); w.z = cvt_pk_bf16(y2.x, y2.y); w.w = cvt_pk_bf16(y3.x, y3.y);
                    *(u32x4*)(G + (size_t)row * ldg + u.pn * 256 + bj * 128 + wc * 32 + 8 * fq) = w; }
            }
    }
};
struct EpiGlaIn {
    const float* SS; const float* BC; bf16_t* QH; bf16_t* KH; bf16_t* VT;
    __device__ __forceinline__ void operator()(const f32x4 (&acc)[2][2][4][2], const pg8::Unit& u, int wr, int wc, int fr, int fq) const {
        if (u.pn < 4) {
            const bool isq = u.pn < 2; bf16_t* dst = isq ? QH : KH;
            float rsv[8]; ROWS8_RSTD(SS, u.pm * 256 + wr * 64 + fr, rsv);
#pragma unroll
            for (int ai = 0; ai < 2; ++ai)
#pragma unroll
                for (int m = 0; m < 4; ++m) {
                    const int row = u.pm * 256 + ai * 128 + wr * 64 + m * 16 + fr; const float rs = rsv[ai * 4 + m] * (isq ? 0.08838834764831845f : 1.0f);
                    const int b = row >> 13, t = row & 8191;
#pragma unroll
                    for (int bj = 0; bj < 2; ++bj) {
                        const int cq = (u.pn & 1) * 256 + bj * 128 + wc * 32 + 8 * fq; const int head = cq >> 7, d = cq & 127;
                        const f32x4 c0 = *(const f32x4*)(BC + (size_t)row * 512 + cq), c1 = *(const f32x4*)(BC + (size_t)row * 512 + cq + 4);
                        float v[8];
#pragma unroll
                        for (int j = 0; j < 4; ++j) { v[j] = acc[ai][bj][m][0][j] * rs * __expf(isq ? c0[j] : -c0[j]); v[4 + j] = acc[ai][bj][m][1][j] * rs * __expf(isq ? c1[j] : -c1[j]); }
                        u32x4 w; w.x = cvt_pk_bf16(v[0], v[1]); w.y = cvt_pk_bf16(v[2], v[3]); w.z = cvt_pk_bf16(v[4], v[5]); w.w = cvt_pk_bf16(v[6], v[7]);
                        *(u32x4*)(dst + ((size_t)(b * 4 + head) * SEQ + t) * 128 + d) = w;
                    }
                }
        } else {
            float rs[2][8];
            { const float mine = row_rstd(SS, u.pm * 256 + (fr >> 3) * 128 + wc * 32 + 8 * fq + (fr & 7));
#pragma unroll
              for (int bj = 0; bj < 2; ++bj)
#pragma unroll
                  for (int e = 0; e < 8; ++e) rs[bj][e] = __shfl(mine, bj * 8 + e + 16 * fq); }
            const int b = u.pm >> 5, t0 = (u.pm & 31) * 256; const int head = u.pn - 4;
#pragma unroll
            for (int ai = 0; ai < 2; ++ai)
#pragma unroll
                for (int m = 0; m < 4; ++m) {
                    const int dvi = ai * 128 + wr * 64 + m * 16 + fr;
                    bf16_t* p = VT + ((size_t)(b * 4 + head) * 256 + dvi) * SEQ + t0 + wc * 32 + 8 * fq;
#pragma unroll
                    for (int bj = 0; bj < 2; ++bj) {
                        const f32x4 v0 = acc[ai][bj][m][0], v1 = acc[ai][bj][m][1];
                        u32x4 w; w.x = cvt_pk_bf16(v0[0] * rs[bj][0], v0[1] * rs[bj][1]); w.y = cvt_pk_bf16(v0[2] * rs[bj][2], v0[3] * rs[bj][3]);
                        w.z = cvt_pk_bf16(v1[0] * rs[bj][4], v1[1] * rs[bj][5]); w.w = cvt_pk_bf16(v1[2] * rs[bj][6], v1[3] * rs[bj][7]);
                        *(u32x4*)(p + bj * 128) = w;
                    }
                }
        }
    }
};

struct EpiRetInP {
    const float* SS; bf16_t* AQ; bf16_t* KM; bf16_t* KT; bf16_t* BV;
    __device__ __forceinline__ void operator()(const f32x4 (&acc)[2][2][4][2], const pg8::Unit& u, int wr, int wc, int fr, int fq) const {
        if (u.pn < 8) {
            const bool isq = u.pn < 4; const int head = u.pn & 3;
            const float l2g = isq ? L2G[head] : -L2G[head], sc = isq ? 1.0f : 0.0625f;
            float inv[8]; int ez_ = 0; asm volatile("" : "+v"(ez_));
#pragma unroll
            for (int e = 0; e < 8; ++e) inv[e] = ROPE_INV[wc * 32 + 8 * fq + e + ez_];
            float rsv[8]; ROWS8_RSTD(SS, u.pm * 256 + wr * 64 + fr, rsv);
#pragma unroll
            for (int ai = 0; ai < 2; ++ai)
#pragma unroll
                for (int m = 0; m < 4; ++m) {
                    const int row = u.pm * 256 + ai * 128 + wr * 64 + m * 16 + fr; const float rs = rsv[ai * 4 + m];
                    const int b = row >> 13, t = row & 8191, c = t >> 8, i = t & 255; const float pos = (float)(t + NMETA);
                    const float dec = __builtin_amdgcn_exp2f((float)(i + 1) * l2g) * sc * rs;
                    float o1[8], o2[8];
#pragma unroll
                    for (int n = 0; n < 2; ++n)
#pragma unroll
                        for (int j = 0; j < 4; ++j) { const int e = 4 * n + j;
                            const float rev = (pos * inv[e]) * 0.15915494309189535f; const float frc = rev - floorf(rev);
                            const float sn = __builtin_amdgcn_sinf(frc), cs = __builtin_amdgcn_cosf(frc);
                            const float t1 = acc[ai][0][m][n][j], t2 = acc[ai][1][m][n][j];
                            o1[e] = (t1 * cs - t2 * sn) * dec; o2[e] = (t1 * sn + t2 * cs) * dec; }
                    const size_t bhc = (size_t)((b * 4 + head) * 32 + c); const int d = wc * 32 + 8 * fq;
                    u32x4 w1, w2; w1.x = cvt_pk_bf16(o1[0], o1[1]); w1.y = cvt_pk_bf16(o1[2], o1[3]); w1.z = cvt_pk_bf16(o1[4], o1[5]); w1.w = cvt_pk_bf16(o1[6], o1[7]);
                    w2.x = cvt_pk_bf16(o2[0], o2[1]); w2.y = cvt_pk_bf16(o2[2], o2[3]); w2.z = cvt_pk_bf16(o2[4], o2[5]); w2.w = cvt_pk_bf16(o2[6], o2[7]);
                    if (isq) { bf16_t* p = AQ + (bhc * 256 + i) * 512 + 256 + d; *(u32x4*)p = w1; *(u32x4*)(p + 128) = w2; }
                    else { bf16_t* p = KM + (bhc * 256 + i) * 256 + d; *(u32x4*)p = w1; *(u32x4*)(p + 128) = w2;
                        int iz = i; asm volatile("" : "+v"(iz));
                        bf16_t* q = KT + (bhc * 256 + d) * 256 + iz; bf16_t* q2 = q + (size_t)128 * 256;
#pragma unroll
                        for (int e = 0; e < 8; ++e) { q[e * 256] = f2bf(o1[e]); q2[e * 256] = f2bf(o2[e]); } }
                }
        } else {
            float rs[2][8];
            { const float mine = row_rstd(SS, u.pm * 256 + (fr >> 3) * 128 + wc * 32 + 8 * fq + (fr & 7));
#pragma unroll
              for (int bj = 0; bj < 2; ++bj)
#pragma unroll
                  for (int e = 0; e < 8; ++e) rs[bj][e] = __shfl(mine, bj * 8 + e + 16 * fq); }
            const int b = u.pm >> 5, c = u.pm & 31;
#pragma unroll
            for (int ai = 0; ai < 2; ++ai)
#pragma unroll
                for (int m = 0; m < 4; ++m) {
                    const int vc = (u.pn - 8) * 256 + ai * 128 + wr * 64 + m * 16 + fr; const int head = vc >> 9, v = vc & 511;
                    bf16_t* p = BV + (((size_t)((b * 4 + head) * 32 + c)) * 512 + v) * 512 + wc * 32 + 8 * fq;
#pragma unroll
                    for (int bj = 0; bj < 2; ++bj) {
                        const f32x4 v0 = acc[ai][bj][m][0], v1 = acc[ai][bj][m][1];
                        u32x4 w; w.x = cvt_pk_bf16(v0[0] * rs[bj][0], v0[1] * rs[bj][1]); w.y = cvt_pk_bf16(v0[2] * rs[bj][2], v0[3] * rs[bj][3]);
                        w.z = cvt_pk_bf16(v1[0] * rs[bj][4], v1[1] * rs[bj][5]); w.w = cvt_pk_bf16(v1[2] * rs[bj][6], v1[3] * rs[bj][7]);
                        *(u32x4*)(p + bj * 128) = w;
                    }
                }
        }
    }
};
struct PtrPA { const char* AQ; const char* KM; const char* KT; const char* BV;
    __device__ __forceinline__ void ptrs(const pg8::Unit& u, const char*& cA, const char*& cB) const {
        if (u.pm < 256) { const size_t bhc = (size_t)u.pm; cA = AQ + (bhc * 256 * 512 + 256) * 2; cB = KM + bhc * 256 * 256 * 2; }
        else { const int l = u.pm - 256; const size_t bhc = (size_t)(l >> 1); cA = BV + (bhc * 512 + (size_t)(l & 1) * 256) * 512 * 2; cB = KT + bhc * 256 * 256 * 2; } } };
struct EpiPA {
    bf16_t* AQ; bf16_t* BV;
    __device__ __forceinline__ void operator()(const f32x4 (&acc)[2][2][4][2], const pg8::Unit& u, int wr, int wc, int fr, int fq) const {
        const bool isP = u.pm < 256; const int l = u.pm - 256; const size_t bhc = isP ? (size_t)u.pm : (size_t)(l >> 1); const int half = l & 1;
#pragma unroll
        for (int ai = 0; ai < 2; ++ai)
#pragma unroll
            for (int m = 0; m < 4; ++m) { const int r = ai * 128 + wr * 64 + m * 16 + fr; int rz = r; asm volatile("" : "+v"(rz));
#pragma unroll
                for (int bj = 0; bj < 2; ++bj) { const int c0 = bj * 128 + wc * 32 + 8 * fq; const f32x4 a0 = acc[ai][bj][m][0], a1 = acc[ai][bj][m][1];
                    float v[8] = {a0[0], a0[1], a0[2], a0[3], a1[0], a1[1], a1[2], a1[3]};
                    if (isP) {
#pragma unroll
                        for (int e = 0; e < 8; ++e) { const int keep = (c0 + e - rz - 1) >> 31; v[e] = __int_as_float(__float_as_int(v[e]) & keep); } }
                    u32x4 w; w.x = cvt_pk_bf16(v[0], v[1]); w.y = cvt_pk_bf16(v[2], v[3]); w.z = cvt_pk_bf16(v[4], v[5]); w.w = cvt_pk_bf16(v[6], v[7]);
                    if (isP) *(u32x4*)(AQ + (bhc * 256 + r) * 512 + c0) = w;
                    else *(u32x4*)(BV + (bhc * 512 + half * 256 + r) * 512 + 256 + c0) = w; } }
    }
};
struct Ptr3 { const char* AQ; const char* BV;
    __device__ __forceinline__ void ptrs(const pg8::Unit& u, const char*& cA, const char*& cB) const { const size_t bhc = (size_t)(u.pm >> 1);
        cA = AQ + bhc * 256 * 512 * 2; cB = BV + (bhc * 512 + (size_t)(u.pm & 1) * 256) * 512 * 2; } };
struct Epi3 {
    bf16_t* O;
    __device__ __forceinline__ void operator()(const f32x4 (&acc)[2][2][4][2], const pg8::Unit& u, int wr, int wc, int fr, int fq) const {
        const int bhc = u.pm >> 1, half = u.pm & 1, bh = bhc >> 5, c = bhc & 31, b = bh >> 2, h = bh & 3;
#pragma unroll
        for (int ai = 0; ai < 2; ++ai)
#pragma unroll
            for (int m = 0; m < 4; ++m) { const int i = ai * 128 + wr * 64 + m * 16 + fr; bf16_t* p = O + ((size_t)b * SEQ + c * 256 + i) * 2048 + h * 512 + half * 256 + wc * 32 + 8 * fq;
#pragma unroll
                for (int bj = 0; bj < 2; ++bj) { const f32x4 a0 = acc[ai][bj][m][0], a1 = acc[ai][bj][m][1];
                    u32x4 w; w.x = cvt_pk_bf16(a0[0], a0[1]); w.y = cvt_pk_bf16(a0[2], a0[3]); w.z = cvt_pk_bf16(a1[0], a1[1]); w.w = cvt_pk_bf16(a1[2], a1[3]);
                    *(u32x4*)(p + bj * 128) = w; } }
    }
};
struct PtrNormal { const char* A; const char* B; size_t tstep;
    __device__ __forceinline__ void ptrs(const pg8::Unit& u, const char*& cA, const char*& cB) const { cA = A + (size_t)u.pm * tstep; cB = B + (size_t)u.pn * tstep; } };
struct PtrSwapFrom { const char* A; const char* B; size_t tstep; int pn_swap;
    __device__ __forceinline__ void ptrs(const pg8::Unit& u, const char*& cA, const char*& cB) const {
        const char* a = A + (size_t)u.pm * tstep; const char* b = B + (size_t)u.pn * tstep;
        if (u.pn >= pn_swap) { cA = b; cB = a; } else { cA = a; cB = b; } } };

constexpr int MA_RS_OFF = 98304, MA_RED_OFF = 100352;
template <int MODE> __device__ __forceinline__ void meta_tiles(Frame& F, const bf16_t* Bt, int N, int K, float* out, int ldo, float alpha, int b0, int nb) {
    const int lane = F.lane, g = lane >> 4, r16 = lane & 15, pitch = K + 8;
    const LAS bf16_t* A = (const LAS bf16_t*)F.lds; const LAS float* rsA = (const LAS float*)(F.lds + MA_RS_OFF); LAS f32x4* red = (LAS f32x4*)(F.lds + MA_RED_OFF);
    const int ksteps = K / 32, per = ksteps / 8;
    for (int tile = F.vb - b0; tile < N / 16; tile += nb) {
        f32x4 acc = (f32x4){0.f, 0.f, 0.f, 0.f};
        const bf16_t* bp = Bt + (size_t)(tile * 16 + r16) * K + 8 * g;
        for (int ks = F.wave * per; ks < (F.wave + 1) * per; ++ks) {
            const bf16x8 a = *(const LAS bf16x8*)(A + r16 * pitch + ks * 32 + 8 * g);
            const bf16x8 b = *(const bf16x8*)(bp + ks * 32);
            acc = __builtin_amdgcn_mfma_f32_16x16x32_bf16(a, b, acc, 0, 0, 0);
        }
        red[F.wave * 64 + lane] = acc;
        __syncthreads();
        if (F.wave == 0) {
            f32x4 s = red[lane];
#pragma unroll
            for (int w = 1; w < 8; ++w) s += red[w * 64 + lane];
#pragma unroll
            for (int j = 0; j < 4; ++j) { const int r = 4 * g + j; float* o = out + (size_t)r * ldo + tile * 16 + r16;
                if (MODE == 0) *o = s[j] * rsA[r]; else *o = *o + alpha * s[j]; }
        }
        __syncthreads();
    }
}
__device__ __forceinline__ bool meta_has_tiles(Frame& F, int N, int b0, int nb) { const int r = F.vb - b0; return r >= 0 && r < nb && r < N / 16; }
__device__ __forceinline__ void meta_prep_h(Frame& F) {
    const float* HM = WSP(float, WS_META + META_HM); LAS bf16_t* A = (LAS bf16_t*)F.lds; LAS float* rsA = (LAS float*)(F.lds + MA_RS_OFF);
    for (int r = F.wave; r < 16; r += 8) { float s = 0.f;
        for (int k = F.lane; k < D; k += 64) { const float v = HM[r * D + k]; s += v * v; A[r * (D + 8) + k] = f2bf(v); }
        s = wave_sum(s); if (F.lane == 0) rsA[r] = 1.0f / sqrtf(s * (1.0f / 1024.0f) + 1e-6f); }
    __syncthreads();
}
__device__ __forceinline__ void meta_prep_act(Frame& F) {
    const float* RAW = WSP(float, WS_META + META_RAW); LAS bf16_t* A = (LAS bf16_t*)F.lds; LAS float* rsA = (LAS float*)(F.lds + MA_RS_OFF);
    for (int i = F.tid; i < 16 * DFF; i += NTHREADS) { const int r = i / DFF, k = i % DFF, u = k >> 7, j = k & 127;
        const float g = RAW[r * 5632 + u * 256 + j], up = RAW[r * 5632 + u * 256 + 128 + j]; A[r * (DFF + 8) + k] = f2bf(fsilu(g) * up); }
    if (F.tid < 16) rsA[F.tid] = 1.f;
    __syncthreads();
}
__device__ __forceinline__ void meta_prep_y(Frame& F) {
    const float* RAW = WSP(float, WS_META + META_RAW); const float* MO = WSP(float, WS_META + META_MO);
    LAS bf16_t* A = (LAS bf16_t*)F.lds; LAS float* rsA = (LAS float*)(F.lds + MA_RS_OFF); LAS float* mro = (LAS float*)(F.lds + MA_RED_OFF);
    for (int p = F.wave; p < 64; p += 8) { const int r = p >> 2, head = p & 3; float sacc = 0.f;
        for (int k = F.lane; k < 512; k += 64) { const float v = MO[r * 2048 + head * 512 + k]; sacc += v * v; }
        sacc = wave_sum(sacc); if (F.lane == 0) mro[p] = 1.0f / sqrtf(sacc * (1.0f / 512.0f) + 1e-6f); }
    __syncthreads();
    for (int i = F.tid; i < 16 * 2048; i += NTHREADS) { const int r = i >> 11, k = i & 2047, head = k >> 9;
        A[r * (2048 + 8) + k] = f2bf(MO[r * 2048 + k] * mro[r * 4 + head] * fsilu(RAW[r * 6144 + 4096 + k])); }
    if (F.tid < 16) rsA[F.tid] = 1.f;
    __syncthreads();
}

__device__ __forceinline__ void meta_tiles_ksplit(Frame& F, const bf16_t* Bt, int K, int KQ, float* out, float alpha) {
    const int lane = F.lane, g = lane >> 4, r16 = lane & 15, pitch = KQ + 8;
    const LAS bf16_t* A = (const LAS bf16_t*)F.lds; LAS f32x4* red = (LAS f32x4*)(F.lds + MA_RED_OFF);
    const int item = F.vb; if (item >= 256) return;
    const int tile = item >> 2, kq = item & 3, nks = KQ / 32;
    f32x4 acc = (f32x4){0.f, 0.f, 0.f, 0.f};
    const bf16_t* bp = Bt + (size_t)(tile * 16 + r16) * K + kq * KQ + 8 * g;
    for (int ks = F.wave; ks < nks; ks += 8) {
        const bf16x8 a = *(const LAS bf16x8*)(A + r16 * pitch + ks * 32 + 8 * g);
        const bf16x8 b = *(const bf16x8*)(bp + ks * 32);
        acc = __builtin_amdgcn_mfma_f32_16x16x32_bf16(a, b, acc, 0, 0, 0);
    }
    red[F.wave * 64 + lane] = acc;
    __syncthreads();
    if (F.wave == 0) { f32x4 sacc = red[lane];
#pragma unroll
        for (int w = 1; w < 8; ++w) sacc += red[w * 64 + lane];
#pragma unroll
        for (int j = 0; j < 4; ++j) atomicAdd(out + (size_t)(4 * g + j) * D + tile * 16 + r16, alpha * sacc[j]); }
    __syncthreads();
}
__device__ __forceinline__ void meta_prep_act_q(Frame& F) {
    const float* RAW = WSP(float, WS_META + META_RAW); LAS bf16_t* A = (LAS bf16_t*)F.lds; const int kq = F.vb & 3;
    for (int i = F.tid; i < 16 * 704; i += NTHREADS) { const int r = i / 704, kk = i % 704, k = kq * 704 + kk, u = k >> 7, j = k & 127;
        const float gt = RAW[r * 5632 + u * 256 + j], up = RAW[r * 5632 + u * 256 + 128 + j]; A[r * (704 + 8) + kk] = f2bf(fsilu(gt) * up); }
    __syncthreads();
}
__device__ __forceinline__ void meta_prep_y_q(Frame& F) {
    const float* RAW = WSP(float, WS_META + META_RAW); const float* MO = WSP(float, WS_META + META_MO);
    LAS bf16_t* A = (LAS bf16_t*)F.lds; LAS float* mro = (LAS float*)(F.lds + MA_RED_OFF); const int head = F.vb & 3;
    for (int r = F.wave; r < 16; r += 8) { float sacc = 0.f;
        for (int k = F.lane; k < 512; k += 64) { const float v = MO[r * 2048 + head * 512 + k]; sacc += v * v; }
        sacc = wave_sum(sacc); if (F.lane == 0) mro[r] = 1.0f / sqrtf(sacc * (1.0f / 512.0f) + 1e-6f); }
    __syncthreads();
    for (int i = F.tid; i < 16 * 512; i += NTHREADS) { const int r = i >> 9, kk = i & 511, k = head * 512 + kk;
        A[r * (512 + 8) + kk] = f2bf(MO[r * 2048 + k] * mro[r] * fsilu(RAW[r * 6144 + 4096 + k])); }
    __syncthreads();
}
__device__ __forceinline__ void z_phase(Frame& F, const bf16_t* HB, const float* SS, const bf16_t* WZ, const float* wg, const float* bg, float* BC) {
    LAS float* zpart = (LAS float*)F.lds;
    LAS float* zs = (LAS float*)(F.lds + 8192);
    const int lane = F.lane, g = lane >> 4, r16 = lane & 15;
    for (int cidx = blockIdx.x; cidx < M / 64; cidx += F.G) {
        const int row0 = cidx * 64;
        { const int tile = F.wave & 3, kh = F.wave >> 2; f32x4 acc = (f32x4){0.f, 0.f, 0.f, 0.f};
          const bf16_t* ap = HB + (size_t)(row0 + tile * 16 + r16) * D + 8 * g; const bf16_t* bp = WZ + (size_t)r16 * D + 8 * g;
#pragma unroll
          for (int ks = kh * 16; ks < kh * 16 + 16; ++ks) {
              const bf16x8 a = *(const bf16x8*)(ap + ks * 32), b = *(const bf16x8*)(bp + ks * 32);
              acc = __builtin_amdgcn_mfma_f32_16x16x32_bf16(a, b, acc, 0, 0, 0);
          }
#pragma unroll
          for (int j = 0; j < 4; ++j) zpart[(kh * 64 + tile * 16 + 4 * g + j) * 16 + r16] = acc[j]; }
        __syncthreads();
        for (int i = F.tid; i < 64 * 16; i += NTHREADS) { const int t = i >> 4; zs[i] = (zpart[i] + zpart[1024 + i]) * row_rstd(SS, row0 + t); }
        __syncthreads();
        { const int c = F.tid; float w[16];
#pragma unroll
          for (int r = 0; r < 16; ++r) w[r] = wg[r * 512 + c];
          const float bias = bg[c]; float cum = 0.f;
          for (int t = 0; t < 64; ++t) { float a = bias; if (t == 32) cum = 0.f;
              const f32x4 z0 = *(const LAS f32x4*)(zs + t * 16), z1 = *(const LAS f32x4*)(zs + t * 16 + 4), z2 = *(const LAS f32x4*)(zs + t * 16 + 8), z3 = *(const LAS f32x4*)(zs + t * 16 + 12);
#pragma unroll
              for (int r = 0; r < 4; ++r) a += z0[r] * w[r] + z1[r] * w[4 + r] + z2[r] * w[8 + r] + z3[r] * w[12 + r];
              const float ls = fminf(a, 0.f) - __logf(1.0f + __expf(-fabsf(a)));
              cum += ls * 0.0625f; BC[(size_t)(row0 + t) * 512 + c] = cum; } }
        __syncthreads();
    }
}

typedef short v4i16_t __attribute__((ext_vector_type(4)));
__device__ __forceinline__ s16x4 ds_tr_asm(unsigned addr) { s16x4 r; asm volatile("ds_read_b64_tr_b16 %0, %1" : "=v"(r) : "v"(addr) : "memory"); return r; }
__device__ __forceinline__ s16x4 ds_tr(const LAS unsigned char* p) { return __builtin_bit_cast(s16x4, __builtin_amdgcn_ds_read_tr16_b64_v4i16((LAS v4i16_t*)p)); }
template <int DK, int DV, bool GLA>
__device__ __forceinline__ void s2v6_phase(Frame& F, const int unit, const bf16_t* QH, const bf16_t* KH, const bf16_t* VT, bf16_t* O, const float* BC, int ldraw) {
    constexpr int NS = DV / 16, ROWB = DK * 2, TILEB = 32 * ROWB, NIL = TILEB / 1024 / 4, LDO = 4 * DV, KS = DK / 32, NSTEP = 257, NLO = DK / 128, NHI = DK / 32 - NLO;
    constexpr int LK = 0, LQ = 3 * TILEB, LV = 6 * TILEB, LDEC = LV + 3 * 1024, LP = LDEC + 3 * 1024, LS = LP + 2 * 2048, LEND = LS + 2 * 16 * ROWB;
    static_assert(LEND <= LDS_MISC, "S2 LDS map");
    if (unit >= 8 * NS) return;
    const int bh = unit & 7, s = unit >> 3, b = bh >> 2, h = bh & 3;
    const int lane = F.lane, g = lane >> 4, r16 = lane & 15, w = F.wave, li = w & 3, hf = w >> 2, qi = li >> 1, kj = li & 1;
    LAS unsigned char* L = F.lds; const unsigned Lb = (unsigned)(uintptr_t)L;
    const float* RAW = WSP(float, WS_META + META_RAW);
    const char* Qg = (const char*)(QH + (size_t)bh * SEQ * DK); const char* Kg = (const char*)(KH + (size_t)bh * SEQ * DK);
    const char* Vg = (const char*)(VT + ((size_t)bh * DV + 16 * s) * SEQ);
    u32x4 ra[2 * NIL + 1], rb[2 * NIL + 1], rc[2 * NIL + 1];
#pragma unroll
    for (int i = 0; i < 2 * NIL + 1; ++i) { ra[i] = (u32x4){0, 0, 0, 0}; rb[i] = ra[i]; rc[i] = ra[i]; }
#define S6_LOAD(c_, R) do { const int rc_ = ((c_) - 1 < 255) ? (c_) - 1 : 255; const char* kc_ = Kg + (size_t)rc_ * TILEB; const char* qc_ = Qg + (size_t)rc_ * TILEB; \
        _Pragma("unroll") for (int i_ = 0; i_ < NIL; ++i_) { const int piece_ = li * NIL + i_, off_ = piece_ * 1024 + lane * 16, row_ = off_ / ROWB, p_ = (off_ % ROWB) >> 4; const int so_ = row_ * ROWB + ((p_ ^ (row_ & 15)) << 4); \
            R[i_] = *(const u32x4*)(kc_ + so_); R[NIL + i_] = *(const u32x4*)(qc_ + so_); } \
        if (li == 0) { const int wv_ = lane >> 2, p_ = lane & 3; R[2 * NIL] = *(const u32x4*)(Vg + (size_t)wv_ * SEQ * 2 + (size_t)rc_ * 64 + ((p_ ^ ((wv_ >> 2) & 3)) << 4)); } \
        if (GLA && li == 1) R[2 * NIL] = *(const u32x4*)((const char*)(BC + (size_t)(b * SEQ + rc_ * 32 + 31) * 512 + h * 128) + lane * 16); } while (0)
#define S6_WRITE(st_, R) do { \
        _Pragma("unroll") for (int i_ = 0; i_ < NIL; ++i_) { const int piece_ = li * NIL + i_; \
            *(LAS u32x4*)(L + LK + (st_) * TILEB + piece_ * 1024 + lane * 16) = R[i_]; *(LAS u32x4*)(L + LQ + (st_) * TILEB + piece_ * 1024 + lane * 16) = R[NIL + i_]; } \
        if (li == 0) *(LAS u32x4*)(L + LV + (st_) * 1024 + lane * 16) = R[2 * NIL]; \
        if (GLA && li == 1) *(LAS u32x4*)(L + LDEC + (st_) * 1024 + lane * 16) = R[2 * NIL]; } while (0)
#define S6_PT(st_, pb_) do { f32x4 pa = (f32x4){0.f, 0.f, 0.f, 0.f}, pc = pa; \
        if (kj <= qi) { const LAS unsigned char* kb = L + LK + (st_) * TILEB + (16 * kj + r16) * ROWB; const LAS unsigned char* qb = L + LQ + (st_) * TILEB + (16 * qi + r16) * ROWB; \
            _Pragma("unroll") for (int ks = 0; ks < KS; ks += 2) { const int ch0 = ((4 * ks + g) ^ r16) << 4, ch1 = ((4 * (ks + 1) + g) ^ r16) << 4; \
                const bf16x8 k0 = *(const LAS bf16x8*)(kb + ch0), q0 = *(const LAS bf16x8*)(qb + ch0), k1 = *(const LAS bf16x8*)(kb + ch1), q1 = *(const LAS bf16x8*)(qb + ch1); \
                pa = __builtin_amdgcn_mfma_f32_16x16x32_bf16(k0, q0, pa, 0, 0, 0); pc = __builtin_amdgcn_mfma_f32_16x16x32_bf16(k1, q1, pc, 0, 0, 0); } } \
        const f32x4 pt = pa + pc; const int i = 16 * qi + r16, j0 = 16 * kj + 4 * g; \
        const float v0 = (j0 + 0 <= i) ? pt[0] : 0.f, v1 = (j0 + 1 <= i) ? pt[1] : 0.f, v2 = (j0 + 2 <= i) ? pt[2] : 0.f, v3 = (j0 + 3 <= i) ? pt[3] : 0.f; \
        u32x2 pk; pk.x = cvt_pk_bf16(v0, v1); pk.y = cvt_pk_bf16(v2, v3); \
        *(LAS u32x2*)(L + LP + (pb_) * 2048 + i * 64 + (((2 * kj + (g >> 1)) ^ ((i >> 2) & 3)) << 4) + (g & 1) * 8) = pk; } while (0)
    for (int i = F.tid * 16; i < TILEB; i += NTHREADS * 16) { *(LAS u32x4*)(L + LK + i) = (u32x4){0, 0, 0, 0}; *(LAS u32x4*)(L + LQ + i) = (u32x4){0, 0, 0, 0}; }
    for (int i = F.tid * 16; i < 1024; i += NTHREADS * 16) *(LAS u32x4*)(L + LV + i) = (u32x4){0, 0, 0, 0};
    for (int i = F.tid * 16; i < 16 * ROWB; i += NTHREADS * 16) *(LAS u32x4*)(L + LS + i) = (u32x4){0, 0, 0, 0};
    __syncthreads();
    if (!GLA) {
        for (int idx = F.tid; idx < 16 * 128; idx += NTHREADS) { const int j = idx >> 7, c = idx & 127, row = 16 + j;
            const float* rq = RAW + (size_t)j * ldraw + h * 256; const float* rk = rq + 1024;
            const float rev = ((float)j * ROPE_INV[c]) * 0.15915494309189535f; const float frc = rev - floorf(rev);
            const float sn = __builtin_amdgcn_sinf(frc), cs = __builtin_amdgcn_cosf(frc);
            const float dq = __builtin_amdgcn_exp2f((float)(row + 1) * L2G[h]), dk = 0.0625f * __builtin_amdgcn_exp2f(-(float)(row + 1) * L2G[h]);
            const float q1v = rq[c], q2v = rq[c + 128], k1 = rk[c], k2 = rk[c + 128];
            const int a1 = row * ROWB + ((((c >> 3)) ^ (row & 15)) << 4) + (c & 7) * 2, a2 = row * ROWB + ((((c + 128) >> 3) ^ (row & 15)) << 4) + (c & 7) * 2;
            *(LAS bf16_t*)(L + LQ + a1) = f2bf((q1v * cs - q2v * sn) * dq); *(LAS bf16_t*)(L + LQ + a2) = f2bf((q1v * sn + q2v * cs) * dq);
            *(LAS bf16_t*)(L + LK + a1) = f2bf((k1 * cs - k2 * sn) * dk); *(LAS bf16_t*)(L + LK + a2) = f2bf((k1 * sn + k2 * cs) * dk); }
        if (F.tid < 256) { const int j = F.tid >> 4, wv = F.tid & 15, tok = 16 + j;
            *(LAS bf16_t*)(L + LV + wv * 64 + (((tok >> 3) ^ ((wv >> 2) & 3)) << 4) + (tok & 7) * 2) = f2bf(RAW[(size_t)j * ldraw + 2048 + h * 512 + 16 * s + wv]); }
    } else {
        if (F.tid < 128) { const int d = F.tid; const float* wgp = F.in[13] + h * 128 + d; const float bias = F.in[14][h * 128 + d]; float cum = 0.f;
            for (int j = 0; j < 16; ++j) { float a = bias;
                for (int r = 0; r < 16; ++r) a += RAW[(size_t)j * ldraw + 3072 + r] * wgp[r * 512];
                cum += (fminf(a, 0.f) - __logf(1.0f + __expf(-fabsf(a)))) * 0.0625f;
                const int row = 16 + j;
                *(LAS bf16_t*)(L + LK + row * ROWB + (((d >> 3) ^ (row & 15)) << 4) + (d & 7) * 2) = f2bf(RAW[(size_t)j * ldraw + 512 + h * 128 + d] * __expf(-cum)); }
            *(LAS float*)(L + LDEC + d * 4) = cum; }
        if (F.tid >= 256) { const int j = (F.tid - 256) >> 4, wv = F.tid & 15, tok = 16 + j;
            *(LAS bf16_t*)(L + LV + wv * 64 + (((tok >> 3) ^ ((wv >> 2) & 3)) << 4) + (tok & 7) * 2) = f2bf(RAW[(size_t)j * ldraw + 1024 + h * 256 + 16 * s + wv]); }
    }
    const float g32 = GLA ? 1.0f : __builtin_amdgcn_exp2f(32.0f * L2G[h]);
    if (hf) { S6_LOAD(1, ra); S6_WRITE(1, ra); }
    __syncthreads();
    if (hf) { S6_PT(0, 0); S6_LOAD(2, rb); S6_LOAD(3, rc); }
    __syncthreads();
    if (hf) {
#define S6_ODD(t_, RL, RW) do { const int t = (t_); S6_LOAD(t + 4, RL); if (t + 1 < NSTEP) S6_PT(s1, (t + 1) & 1); S6_WRITE(s2, RW); \
            LDS_WAIT(); __builtin_amdgcn_s_barrier(); asm volatile("" ::: "memory"); { const int o_ = s0; s0 = s1; s1 = s2; s2 = o_; } } while (0)
        int s0 = 0, s1 = 1, s2 = 2;
        for (int t3 = 0; t3 < 255; t3 += 3) { S6_ODD(t3, ra, rb); S6_ODD(t3 + 1, rb, rc); S6_ODD(t3 + 2, rc, ra); }
        S6_ODD(255, ra, rb); S6_ODD(256, rb, rc);
#undef S6_ODD
    } else {
        f32x4 S[NHI];
#pragma unroll
        for (int tt = 0; tt < NHI; ++tt) S[tt] = (f32x4){0.f, 0.f, 0.f, 0.f};
        int s0 = 0;
        for (int t = 0; t < NSTEP; ++t) { const int sb = t & 1;
            { s16x4 klo[NHI], khi[NHI];
              const bf16x8 vb = *(const LAS bf16x8*)(L + LV + s0 * 1024 + r16 * 64 + ((g ^ ((r16 >> 2) & 3)) << 4));
#pragma unroll
              for (int tt = 0; tt < NHI; ++tt) if (li >= 2 || tt < NLO) { const int tile = (li < 2) ? li + 2 * tt : 2 * NLO + (li - 2) + 2 * tt, d0 = 16 * tile, dcol = d0 + 4 * (r16 & 3), chunk = dcol >> 3, sub = (dcol & 7) * 2;
                  const int r1 = 8 * g + (r16 >> 2), r2 = r1 + 4;
                  klo[tt] = ds_tr_asm(Lb + LK + s0 * TILEB + r1 * ROWB + ((chunk ^ (r1 & 15)) << 4) + sub);
                  khi[tt] = ds_tr_asm(Lb + LK + s0 * TILEB + r2 * ROWB + ((chunk ^ (r2 & 15)) << 4) + sub); }
              asm volatile("s_waitcnt lgkmcnt(0)" ::: "memory"); __builtin_amdgcn_sched_barrier(0);
#pragma unroll
              for (int tt = 0; tt < NHI; ++tt) if (li >= 2 || tt < NLO) {
                  const bf16x8 ka = (bf16x8){klo[tt][0], klo[tt][1], klo[tt][2], klo[tt][3], khi[tt][0], khi[tt][1], khi[tt][2], khi[tt][3]};
                  S[tt] = __builtin_amdgcn_mfma_f32_16x16x32_bf16(ka, vb, S[tt], 0, 0, 0); }
#pragma unroll
              for (int tt = 0; tt < NHI; ++tt) if (li >= 2 || tt < NLO) { const int tile = (li < 2) ? li + 2 * tt : 2 * NLO + (li - 2) + 2 * tt;
                  if (GLA) { const f32x4 dl = *(const LAS f32x4*)(L + LDEC + s0 * 1024 + (16 * tile + 4 * g) * 4);
                      S[tt][0] *= __expf(dl[0]); S[tt][1] *= __expf(dl[1]); S[tt][2] *= __expf(dl[2]); S[tt][3] *= __expf(dl[3]); } else S[tt] = S[tt] * g32;
                  u32x2 pk; pk.x = cvt_pk_bf16(S[tt][0], S[tt][1]); pk.y = cvt_pk_bf16(S[tt][2], S[tt][3]);
                  *(LAS u32x2*)(L + LS + (sb ^ 1) * 16 * ROWB + r16 * ROWB + (((2 * tile + (g >> 1)) ^ r16) << 4) + (g & 1) * 8) = pk; } }
            if (li < 2) { const int irow = 16 * li + r16;
                const bf16x8 va = *(const LAS bf16x8*)(L + LV + s0 * 1024 + r16 * 64 + ((g ^ ((r16 >> 2) & 3)) << 4));
                const bf16x8 pb = *(const LAS bf16x8*)(L + LP + sb * 2048 + irow * 64 + ((g ^ ((irow >> 2) & 3)) << 4));
                f32x4 oa = __builtin_amdgcn_mfma_f32_16x16x32_bf16(va, pb, (f32x4){0.f, 0.f, 0.f, 0.f}, 0, 0, 0), ob = (f32x4){0.f, 0.f, 0.f, 0.f};
                const LAS unsigned char* sp = L + LS + sb * 16 * ROWB + r16 * ROWB; const LAS unsigned char* qb = L + LQ + s0 * TILEB + irow * ROWB;
#pragma unroll
                for (int ks = 0; ks < KS; ks += 2) { const int ch0 = ((4 * ks + g) ^ r16) << 4, ch1 = ((4 * (ks + 1) + g) ^ r16) << 4;
                    const bf16x8 sv0 = *(const LAS bf16x8*)(sp + ch0), q0 = *(const LAS bf16x8*)(qb + ch0), sv1 = *(const LAS bf16x8*)(sp + ch1), q1 = *(const LAS bf16x8*)(qb + ch1);
                    oa = __builtin_amdgcn_mfma_f32_16x16x32_bf16(sv0, q0, oa, 0, 0, 0); ob = __builtin_amdgcn_mfma_f32_16x16x32_bf16(sv1, q1, ob, 0, 0, 0); }
                const f32x4 ot = oa + ob;
                if (t >= 1) { const size_t grow = (size_t)b * SEQ + (size_t)(t - 1) * 32 + irow; u32x2 pk; pk.x = cvt_pk_bf16(ot[0], ot[1]); pk.y = cvt_pk_bf16(ot[2], ot[3]);
                    *(u32x2*)(O + grow * LDO + h * DV + 16 * s + 4 * g) = pk; }
                else if (!GLA && b == 0 && irow >= 16) { float* MO = WSP(float, WS_META + META_MO); *(f32x4*)(MO + (size_t)(irow - 16) * 2048 + h * 512 + 16 * s + 4 * g) = ot; } }
            LDS_WAIT(); __builtin_amdgcn_s_barrier(); asm volatile("" ::: "memory");
            s0 = (s0 == 2) ? 0 : s0 + 1;
        }
    }
#undef S6_LOAD
#undef S6_WRITE
#undef S6_PT
}

__device__ __forceinline__ void ret_scan_phase(Frame& F, const int blk, bf16_t* BV) {
    const int bh = blk >> 5, vgrp = blk & 31, b = bh >> 2, h = bh & 3; if (blk >= 256) return;
    LAS float* KMt = (LAS float*)F.lds; LAS float* QMt = KMt + 16 * 256; LAS float* VMt = QMt + 16 * 256; LAS float* SC = VMt + 256;
    const float* RAW = WSP(float, WS_META + META_RAW);
    for (int idx = F.tid; idx < 16 * 128; idx += NTHREADS) { const int j = idx >> 7, c = idx & 127;
        const float* rq = RAW + (size_t)j * 6144 + h * 256; const float* rk = rq + 1024;
        const float rev = ((float)j * ROPE_INV[c]) * 0.15915494309189535f; const float frc = rev - floorf(rev);
        const float sn = __builtin_amdgcn_sinf(frc), cs = __builtin_amdgcn_cosf(frc);
        const float dq = __builtin_amdgcn_exp2f((float)j * L2G[h]), dk = 0.0625f * __builtin_amdgcn_exp2f(-(float)j * L2G[h]);
        const float q1 = rq[c], q2 = rq[c + 128], k1 = rk[c], k2 = rk[c + 128];
        QMt[j * 256 + c] = (q1 * cs - q2 * sn) * dq; QMt[j * 256 + c + 128] = (q1 * sn + q2 * cs) * dq;
        KMt[j * 256 + c] = (k1 * cs - k2 * sn) * dk; KMt[j * 256 + c + 128] = (k1 * sn + k2 * cs) * dk; }
    if (F.tid < 256) VMt[F.tid] = RAW[(size_t)(F.tid >> 4) * 6144 + 2048 + h * 512 + 16 * vgrp + (F.tid & 15)];
    __syncthreads();
    if (b == 0) {
        if (F.tid < 256) { const int j = F.tid >> 4, jp = F.tid & 15; float a = 0.f;
            for (int d = 0; d < 256; ++d) a += QMt[j * 256 + d] * KMt[jp * 256 + d];
            SC[F.tid] = (jp <= j) ? a : 0.f; }
        __syncthreads();
        if (F.tid < 256) { const int j = F.tid >> 4, vv = F.tid & 15; float o = 0.f;
#pragma unroll
            for (int jp = 0; jp < 16; ++jp) o += SC[j * 16 + jp] * VMt[jp * 16 + vv];
            WSP(float, WS_META + META_MO)[(size_t)j * 2048 + h * 512 + 16 * vgrp + vv] = o; }
    }
    const int vloc = F.tid >> 5, d8 = (F.tid & 31) * 8, v = 16 * vgrp + vloc;
    float sacc[8];
    { const float g15 = __builtin_amdgcn_exp2f(15.0f * L2G[h]);
#pragma unroll
      for (int e = 0; e < 8; ++e) sacc[e] = 0.f;
      for (int j = 0; j < 16; ++j) { const float vm = VMt[j * 16 + vloc];
#pragma unroll
          for (int e = 0; e < 8; ++e) sacc[e] += vm * KMt[j * 256 + d8 + e]; }
#pragma unroll
      for (int e = 0; e < 8; ++e) sacc[e] *= g15; }
    const float g256 = __builtin_amdgcn_exp2f(256.0f * L2G[h]);
    bf16_t* slot = BV + (((size_t)bh * 32) * 512 + v) * 512 + 256 + d8;
#pragma unroll 4
    for (int c = 0; c < 32; ++c) { bf16_t* p = slot + (size_t)c * 512 * 512; const u32x4 uv = *(const u32x4*)p;
        u32x4 w; w.x = cvt_pk_bf16(sacc[0], sacc[1]); w.y = cvt_pk_bf16(sacc[2], sacc[3]); w.z = cvt_pk_bf16(sacc[4], sacc[5]); w.w = cvt_pk_bf16(sacc[6], sacc[7]);
        *(u32x4*)p = w;
        sacc[0] = g256 * (sacc[0] + bf_lo(uv.x)); sacc[1] = g256 * (sacc[1] + bf_hi(uv.x)); sacc[2] = g256 * (sacc[2] + bf_lo(uv.y)); sacc[3] = g256 * (sacc[3] + bf_hi(uv.y));
        sacc[4] = g256 * (sacc[4] + bf_lo(uv.z)); sacc[5] = g256 * (sacc[5] + bf_hi(uv.z)); sacc[6] = g256 * (sacc[6] + bf_lo(uv.w)); sacc[7] = g256 * (sacc[7] + bf_hi(uv.w)); }
    __syncthreads();
}

__device__ __forceinline__ void gla_gate_phase(Frame& F, const bf16_t* O, const bf16_t* G, bf16_t* Y) {
    const int gw = F.vcu * NWAVES + F.wave, NGW = F.G * NWAVES; const int head = F.lane >> 4;
    for (int m = gw; m < M; m += NGW) {
        const u32x4 o0 = *(const u32x4*)(O + (size_t)m * 1024 + 16 * F.lane), o1 = *(const u32x4*)(O + (size_t)m * 1024 + 16 * F.lane + 8);
        const u32x4 g0 = *(const u32x4*)(G + (size_t)m * 1024 + 16 * F.lane), g1 = *(const u32x4*)(G + (size_t)m * 1024 + 16 * F.lane + 8);
        float ov[16] = {bf_lo(o0.x), bf_hi(o0.x), bf_lo(o0.y), bf_hi(o0.y), bf_lo(o0.z), bf_hi(o0.z), bf_lo(o0.w), bf_hi(o0.w), bf_lo(o1.x), bf_hi(o1.x), bf_lo(o1.y), bf_hi(o1.y), bf_lo(o1.z), bf_hi(o1.z), bf_lo(o1.w), bf_hi(o1.w)};
        const float gv[16] = {bf_lo(g0.x), bf_hi(g0.x), bf_lo(g0.y), bf_hi(g0.y), bf_lo(g0.z), bf_hi(g0.z), bf_lo(g0.w), bf_hi(g0.w), bf_lo(g1.x), bf_hi(g1.x), bf_lo(g1.y), bf_hi(g1.y), bf_lo(g1.z), bf_hi(g1.z), bf_lo(g1.w), bf_hi(g1.w)};
        float ssum = 0.f;
#pragma unroll
        for (int i = 0; i < 16; ++i) ssum += ov[i] * ov[i];
        ssum += __shfl_xor(ssum, 1); ssum += __shfl_xor(ssum, 2); ssum += __shfl_xor(ssum, 4); ssum += __shfl_xor(ssum, 8);
        const float ro = 1.0f / sqrtf(ssum * (1.0f / 256.0f) + 1e-6f);
        u32x4 y0, y1;
        y0.x = cvt_pk_bf16(ov[0] * ro * gv[0], ov[1] * ro * gv[1]); y0.y = cvt_pk_bf16(ov[2] * ro * gv[2], ov[3] * ro * gv[3]); y0.z = cvt_pk_bf16(ov[4] * ro * gv[4], ov[5] * ro * gv[5]); y0.w = cvt_pk_bf16(ov[6] * ro * gv[6], ov[7] * ro * gv[7]);
        y1.x = cvt_pk_bf16(ov[8] * ro * gv[8], ov[9] * ro * gv[9]); y1.y = cvt_pk_bf16(ov[10] * ro * gv[10], ov[11] * ro * gv[11]); y1.z = cvt_pk_bf16(ov[12] * ro * gv[12], ov[13] * ro * gv[13]); y1.w = cvt_pk_bf16(ov[14] * ro * gv[14], ov[15] * ro * gv[15]);
        *(u32x4*)(Y + (size_t)m * 1024 + 16 * F.lane) = y0; *(u32x4*)(Y + (size_t)m * 1024 + 16 * F.lane + 8) = y1;
        (void)head;
    }
}
__device__ __forceinline__ void final_phase(Frame& F, const float* SS, const float* gain) {
    const int gw = F.vcu * NWAVES + F.wave, NGW = F.G * NWAVES; const bf16_t* HB = WSP(bf16_t, WS_HB);
    f32x4 gv[4];
#pragma unroll
    for (int j = 0; j < 4; ++j) gv[j] = *(const f32x4*)(gain + 4 * F.lane + 256 * j);
    for (int m = gw; m < M; m += NGW) { float* row = F.out + (size_t)m * D; const float rs = row_rstd(SS, m);
#pragma unroll
        for (int j = 0; j < 4; ++j) { const u32x2 hv = *(const u32x2*)(HB + (size_t)m * D + 4 * F.lane + 256 * j);
            f32x4 v = (f32x4){bf_lo(hv.x), bf_hi(hv.x), bf_lo(hv.y), bf_hi(hv.y)}; v = v * rs * gv[j]; *(f32x4*)(row + 4 * F.lane + 256 * j) = v; } }
}
__device__ __forceinline__ void p0_rows(Frame& F) {
    const int gw = F.vcu * NWAVES + F.wave, NGW = F.G * NWAVES; const float* x = F.in[0]; bf16_t* HB = WSP(bf16_t, WS_HB); float* SS = WSP(float, WS_SS);
    for (int m = gw; m < M; m += 2 * NGW) { const int m2 = m + NGW;
        f32x4 va[4], vb[4];
#pragma unroll
        for (int j = 0; j < 4; ++j) { va[j] = *(const f32x4*)(x + (size_t)m * D + 4 * F.lane + 256 * j); vb[j] = *(const f32x4*)(x + (size_t)m2 * D + 4 * F.lane + 256 * j); }
        float s = 0.f, s2 = 0.f;
#pragma unroll
        for (int j = 0; j < 4; ++j) { const f32x4 v = va[j], u = vb[j]; s += (v[0] * v[0] + v[1] * v[1]) + (v[2] * v[2] + v[3] * v[3]); s2 += (u[0] * u[0] + u[1] * u[1]) + (u[2] * u[2] + u[3] * u[3]);
            u32x2 pk; pk.x = cvt_pk_bf16(v[0], v[1]); pk.y = cvt_pk_bf16(v[2], v[3]); *(u32x2*)(HB + (size_t)m * D + 4 * F.lane + 256 * j) = pk;
            pk.x = cvt_pk_bf16(u[0], u[1]); pk.y = cvt_pk_bf16(u[2], u[3]); *(u32x2*)(HB + (size_t)m2 * D + 4 * F.lane + 256 * j) = pk; }
        s = wave_sum(s); s2 = wave_sum(s2);
        if (F.lane < 16) { SS[(size_t)m * 16 + F.lane] = F.lane == 0 ? s : 0.f; SS[(size_t)m2 * 16 + F.lane] = F.lane == 0 ? s2 : 0.f; } }
    if (blockIdx.x == 0) { float* HM = WSP(float, WS_META + META_HM); for (int i = F.tid; i < 16 * D; i += NTHREADS) HM[i] = F.in[1][i]; }
}

#ifndef S2FN
#define S2FN s2v6_phase
#endif
__device__ __forceinline__ unsigned char* opaque_ptr(unsigned char* p) { const unsigned long long v = (unsigned long long)p; int lo = __builtin_amdgcn_readfirstlane((int)(unsigned)v), hi = __builtin_amdgcn_readfirstlane((int)(unsigned)(v >> 32)); asm volatile("" : "+s"(lo), "+s"(hi)); return (unsigned char*)(((unsigned long long)(unsigned)hi << 32) | (unsigned)lo); }
struct Args { const float* in[18]; float* out; unsigned char* ws; int ph_lo, ph_hi; };
constexpr int N_PHASES = 19;
__global__ void __launch_bounds__(NTHREADS, 2) fwd(Args args) {
    extern __shared__ __attribute__((aligned(16))) unsigned char lds_raw[];
    Frame F;
    F.lds = (LAS unsigned char*)lds_raw;
    F.tid = threadIdx.x; F.lane = F.tid & 63; F.wave = __builtin_amdgcn_readfirstlane(F.tid >> 6);
    F.G = gridDim.x; { const int bx = blockIdx.x; F.vcu = (F.G % 8 == 0) ? (bx % 8) * (F.G / 8) + bx / 8 : bx; }
    F.ws = args.ws; F.out = args.out;
#pragma unroll
    for (int i = 0; i < 18; ++i) F.in[i] = args.in[i];
    volatile LAS unsigned* MISC = (volatile LAS unsigned*)(F.lds + LDS_MISC);
    if (F.tid < 64) MISC[F.tid] = 0u;
    __syncthreads();
    XcdBarrier bar = xcd_barrier_post(WSP(unsigned, WS_CTL) + CW_BAR, MISC + 8);
    const int lo = args.ph_lo, hi = args.ph_hi;
    __syncthreads();
    F.vb = (int)blockIdx.x;
    int vblk = (int)blockIdx.x;
#define INR(k) (lo <= (k) && (k) < hi)
#define IN(k) (lo <= (k) && (k) < hi && ((F.lane = lane_id_v()), (F.tid = F.wave * 64 + F.lane), true))
#if defined(PROBE_PHASE)
    unsigned long long t_prev = __builtin_amdgcn_s_memrealtime(), t_probe = 0ull;
#define SEAM(k) do { if (INR(k) && INR((k) + 1)) xcd_barrier(bar); { const unsigned long long t_now = __builtin_amdgcn_s_memrealtime(); if ((k) == PROBE_PHASE) t_probe = t_now - t_prev; t_prev = t_now; } } while (0)
#else
#define SEAM(k) do { if (INR(k) && INR((k) + 1)) xcd_barrier(bar); } while (0)
#endif
#define HB WSP(bf16_t, WS_HB)
#define SS WSP(float, WS_SS)
#define ACT WSP(bf16_t, WS_ACT)
    const int gw = F.vcu * NWAVES + F.wave, NGW = F.G * NWAVES;
#define RAW WSP(float, WS_META + META_RAW)
#define HM WSP(float, WS_META + META_HM)

#define FFN_IN(win, do_meta) do { \
        if ((do_meta) && meta_has_tiles(F, 2 * DFF, 128, 128)) { meta_prep_h(F); meta_tiles<0>(F, WSP(bf16_t, (win)), 2 * DFF, D, RAW, 2 * DFF, 1.f, 128, 128); } \
        pg8::Order S_; S_.init(M / 256, 22, F.G, vblk); PtrNormal P_{(const char*)HB, (const char*)WSP(bf16_t, (win)), (size_t)256 * D * 2}; \
        EpiSwiglu E_{SS, ACT}; pg8::gemm_phase(F.lds, D, S_, P_, E_, 0, 0, F.wave); } while (0)
#define FFN_OUT(woutp, do_meta, F32B) do { const bf16_t* wo_ = (woutp); \
        if (do_meta) { meta_prep_act_q(F); meta_tiles_ksplit(F, wo_, DFF, 704, HM, 0.5f); } \
        pg8::Order S_; S_.init(M / 256, 4, F.G, vblk); PtrNormal P_{(const char*)ACT, (const char*)wo_, (size_t)256 * DFF * 2}; \
        EpiResid<F32B> E_{F.in[0], HB, SS, 0.5f}; pg8::gemm_phase(F.lds, DFF, S_, P_, E_, 0, 0, F.wave); } while (0)

#define slack (vblk >= 128)
#define sgw ((vblk - 128) * NWAVES + F.wave)
    const int SNGW = 128 * NWAVES;
    if (IN(0)) {
        int cb = conv_job(F, job_ffn_in(F, 0, 0, WS_WFFN_A + WF_IN), 0, gw, NGW); cb = conv_job(F, job_ffn_out(F, 0, 0, WS_WFFN_A + WF_OUT), cb, gw, NGW);
        p0_rows(F);
    }
    SEAM(0);
    if (lo == 0 && hi == N_PHASES && F.G == 256) {
        const unsigned* barw = WSP(unsigned, WS_CTL) + CW_BAR; bool ok = true;
#pragma unroll
        for (int j = 0; j < 8; ++j) ok = ok && (__hip_atomic_load(barw + XB_XCNT(j), __ATOMIC_RELAXED, __HIP_MEMORY_SCOPE_AGENT) == 32u);
        const unsigned rank = MISC[10], xcc = MISC[11];
        if (ok && rank < 32u && xcc < 8u) vblk = (int)(rank * 8u + xcc);
    }
    F.vb = vblk;
    if (IN(1)) {
        if (slack) { ConvJob J;
            J.W = F.in[9]; J.ldn = 6144; J.K = D; J.N = 6144; J.col0 = 0; J.kind = 0; J.gain = F.in[5]; J.WT = WSP(bf16_t, WS_WMIX + WM_RET_IN);
            int cb = conv_job(F, J, 0, sgw, SNGW);
            J.W = F.in[11]; J.ldn = D; J.K = 2048; J.N = D; J.col0 = 0; J.kind = 0; J.gain = F.in[10]; J.WT = WSP(bf16_t, WS_WMIX + WM_RET_OUT);
            cb = conv_job(F, J, cb, sgw, SNGW);
            cb = conv_job(F, job_ffn_in(F, 0, 1, WS_WFFN_C), cb, sgw, SNGW);
            __syncthreads(); }
        FFN_IN(WS_WFFN_A + WF_IN, true);
    }
    SEAM(1);
    if (IN(2)) FFN_OUT(WSP(bf16_t, WS_WFFN_A + WF_OUT), true, false);
    SEAM(2);
    if (IN(3)) {
        if (meta_has_tiles(F, 6144, 0, 256)) { meta_prep_h(F); meta_tiles<0>(F, WSP(bf16_t, WS_WMIX + WM_RET_IN), 6144, D, RAW, 6144, 1.f, 0, 256); }
        pg8::Order S_; S_.init(M / 256, 16, F.G, vblk);
        PtrSwapFrom P_{(const char*)HB, (const char*)WSP(bf16_t, WS_WMIX + WM_RET_IN), (size_t)256 * D * 2, 8};
        EpiRetInP E_{SS, (bf16_t*)F.out, WSP(bf16_t, WS_KM), WSP(bf16_t, WS_KT), WSP(bf16_t, WS_BV)}; pg8::gemm_phase(F.lds, D, S_, P_, E_, 0, 0, F.wave);
    }
    SEAM(3);
    if (IN(4)) {
        { pg8::OrderLin S_{768, F.G, vblk}; PtrPA P_{(const char*)F.out, (const char*)WSP(bf16_t, WS_KM), (const char*)WSP(bf16_t, WS_KT), (const char*)WSP(bf16_t, WS_BV)};
          EpiPA E_{(bf16_t*)F.out, WSP(bf16_t, WS_BV)}; int Kz = 256; asm volatile("" : "+s"(Kz));
          pg8::gemm_phase<EpiPA, PtrPA, pg8::OrderLin>(F.lds, Kz, S_, P_, E_, 512, 256, F.wave); }
        xcd_barrier(bar);
        ret_scan_phase(F, vblk, WSP(bf16_t, WS_BV));
        xcd_barrier(bar);
        { pg8::OrderLin S_{512, F.G, vblk}; Ptr3 P_{(const char*)F.out, (const char*)WSP(bf16_t, WS_BV)};
          Epi3 E_{WSP(bf16_t, WS_O)}; int Kz = 512; asm volatile("" : "+s"(Kz));
          pg8::gemm_phase<Epi3, Ptr3, pg8::OrderLin>(F.lds, Kz, S_, P_, E_, 512, 512, F.wave); }
    }
    SEAM(4);
    if (IN(5)) {
        (void)conv_job(F, job_ffn_out(F, 0, 1, WS_WFFN_A + WF_OUT), 0, gw, NGW);
        __syncthreads();
        pg8::Order S_; S_.init(M / 256, 8, F.G, vblk); PtrNormal P_{(const char*)HB, (const char*)(WSP(bf16_t, WS_WMIX + WM_RET_IN) + (size_t)4096 * D), (size_t)256 * D * 2};
        EpiGate<512, 2048> E_{SS, WSP(bf16_t, WS_O), WSP(bf16_t, WS_VT), (LAS float*)(F.lds + 132096)}; pg8::gemm_phase(F.lds, D, S_, P_, E_, 0, 0, F.wave);
    }
    SEAM(5);
    if (IN(6)) {
        { meta_prep_y_q(F); meta_tiles_ksplit(F, WSP(bf16_t, WS_WMIX + WM_RET_OUT), 2048, 512, HM, 1.0f); }
        pg8::Order S_; S_.init(M / 256, 4, F.G, vblk); PtrNormal P_{(const char*)WSP(bf16_t, WS_VT), (const char*)WSP(bf16_t, WS_WMIX + WM_RET_OUT), (size_t)256 * 2048 * 2};
        EpiResid<false> E_{nullptr, HB, SS, 1.0f}; pg8::gemm_phase(F.lds, 2048, S_, P_, E_, 0, 0, F.wave);
    }
    SEAM(6);
    if (IN(7)) {
        if (slack) { int cb = conv_job(F, job_ffn_in(F, 1, 0, WS_WFFN_B + WF_IN), 0, sgw, SNGW); cb = conv_job(F, job_ffn_out(F, 1, 0, WS_WFFN_B + WF_OUT), cb, sgw, SNGW);
            ConvJob J;
            J.W = F.in[12]; J.ldn = 3088; J.K = D; J.N = 3072; J.col0 = 0; J.kind = 0; J.gain = F.in[5] + D; J.WT = WSP(bf16_t, WS_WMIX + WM_GLA_IN);
            cb = conv_job(F, J, cb, sgw, SNGW);
            J.W = F.in[16]; J.ldn = D; J.K = D; J.N = D; J.col0 = 0; J.kind = 0; J.gain = F.in[15]; J.WT = WSP(bf16_t, WS_WMIX + WM_GLA_OUT);
            cb = conv_job(F, J, cb, sgw, SNGW);
            if (vblk == F.G - 1) { bf16_t* WZ = WSP(bf16_t, WS_WMIX + WM_GLA_Z); const float* W = F.in[12]; const float* gn = F.in[5] + D;
                for (int i = F.tid; i < 16 * D; i += NTHREADS) { const int k = i >> 4, r = i & 15; WZ[r * D + k] = f2bf(W[(size_t)k * 3088 + 3072 + r] * gn[k]); } }
            __syncthreads(); }
        FFN_IN(WS_WFFN_C, true);
    }
    SEAM(7);
    if (IN(8)) FFN_OUT(WSP(bf16_t, WS_WFFN_A + WF_OUT), true, false);
    SEAM(8);
    if (IN(9)) {
        if (slack) { int cb = conv_job(F, job_ffn_in(F, 1, 1, WS_WFFN_A + WF_IN), 0, sgw, SNGW); cb = conv_job(F, job_ffn_out(F, 1, 1, WS_WFFN_A + WF_OUT), cb, sgw, SNGW); __syncthreads(); }
        FFN_IN(WS_WFFN_B + WF_IN, true);
    }
    SEAM(9);
    if (IN(10)) FFN_OUT(WSP(bf16_t, WS_WFFN_B + WF_OUT), true, false);
    SEAM(10);
    if (IN(11)) {
        if (meta_has_tiles(F, 2048, 0, 256)) { meta_prep_h(F); meta_tiles<0>(F, WSP(bf16_t, WS_WMIX + WM_GLA_IN), 2048, D, RAW, 3088, 1.f, 0, 256); }
        if (F.vb == 128) { meta_prep_h(F); meta_tiles<0>(F, WSP(bf16_t, WS_WMIX + WM_GLA_Z), 16, D, RAW + 3072, 3088, 1.f, 128, 128); }
        __syncthreads();
        z_phase(F, HB, SS, WSP(bf16_t, WS_WMIX + WM_GLA_Z), F.in[13], F.in[14], WSP(float, WS_BC));
    }
    SEAM(11);
    if (IN(12)) {
        pg8::Order S_; S_.init(M / 256, 8, F.G, vblk);
        PtrSwapFrom P_{(const char*)HB, (const char*)WSP(bf16_t, WS_WMIX + WM_GLA_IN), (size_t)256 * D * 2, 4};
        EpiGlaIn E_{SS, WSP(float, WS_BC), WSP(bf16_t, WS_QH2), WSP(bf16_t, WS_KH2), WSP(bf16_t, WS_VT2)}; pg8::gemm_phase(F.lds, D, S_, P_, E_, 0, 0, F.wave);
    }
    SEAM(12);
    if (IN(13)) {
        if (vblk < 128) S2FN<128, 256, true>(F, vblk, WSP(bf16_t, WS_QH2), WSP(bf16_t, WS_KH2), WSP(bf16_t, WS_VT2), WSP(bf16_t, WS_O2), WSP(float, WS_BC), 3088);
        else {
            pg8::Order S_; S_.init(M / 256, 4, 128, vblk - 128); PtrNormal P_{(const char*)HB, (const char*)WSP(bf16_t, WS_WMIX + WM_GLA_G), (size_t)256 * D * 2};
            EpiSiluG E_{SS, WSP(bf16_t, WS_G2), 1024}; pg8::gemm_phase(F.lds, D, S_, P_, E_, 0, 0, F.wave);
        }
    }
    SEAM(13);
    if (IN(14)) gla_gate_phase(F, WSP(bf16_t, WS_O2), WSP(bf16_t, WS_G2), WSP(bf16_t, WS_VT2));
    SEAM(14);
    if (IN(15)) {
        pg8::Order S_; S_.init(M / 256, 4, F.G, vblk); PtrNormal P_{(const char*)WSP(bf16_t, WS_VT2), (const char*)WSP(bf16_t, WS_WMIX + WM_GLA_OUT), (size_t)256 * D * 2};
        EpiResid<false> E_{nullptr, HB, SS, 1.0f}; pg8::gemm_phase(F.lds, D, S_, P_, E_, 0, 0, F.wave);
    }
    SEAM(15);
    if (IN(16)) FFN_IN(WS_WFFN_A + WF_IN, false);
    SEAM(16);
    if (IN(17)) FFN_OUT(WSP(bf16_t, WS_WFFN_A + WF_OUT), false, false);
    SEAM(17);
    if (IN(18)) final_phase(F, SS, F.in[17]);
#if defined(PROBE2) || defined(PROBE3) || defined(PROBE4)
    __syncthreads();
    if (blockIdx.x == 0 && F.tid == 0) { const unsigned long long cyc = ((unsigned long long)MISC[21] << 32) | MISC[20]; const unsigned long long t0 = __builtin_amdgcn_s_memtime(); while (__builtin_amdgcn_s_memtime() - t0 < 4ull * cyc) __builtin_amdgcn_s_sleep(16); }
#endif
#if defined(PROBE_PHASE)
    { const unsigned long long t_now = __builtin_amdgcn_s_memrealtime(); if (18 == PROBE_PHASE) t_probe = t_now - t_prev;
      if (blockIdx.x == 0 && F.tid == 0) { const unsigned long long t_end = t_now + (unsigned long long)PROBE_MULT * t_probe; while (__builtin_amdgcn_s_memrealtime() < t_end) __builtin_amdgcn_s_sleep(16); } }
#endif
#undef HB
#undef SS
#undef ACT
#undef RAW
#undef HM
#undef slack
#undef sgw
#undef IN
#undef SEAM
#undef FFN_IN
#undef FFN_OUT
}
}
#ifndef MK_MODE
#define MK_MODE 0
#endif
#if MK_MODE == 2
namespace dbg {
__global__ void adapt(const unsigned short* HBtmp, const float* HMtmp, float* Hn) {
    const size_t i = (size_t)blockIdx.x * blockDim.x + threadIdx.x;
    if (i >= (size_t)nv::ROWS * nv::D) return;
    const int d = (int)(i % nv::D); const size_t row = i / nv::D; const int b = (int)(row / nv::TT), s = (int)(row % nv::TT);
    Hn[i] = s < nv::NMETA ? HMtmp[s * nv::D + d] : __uint_as_float((unsigned)HBtmp[((size_t)b * nv::SEQ + (s - nv::NMETA)) * nv::D + d] << 16);
}
}
#endif
extern "C" void kernel_launch(void* const* d_in, const int* in_sizes, int n_in, void* d_out, int out_size, void* d_ws, size_t ws_size, hipStream_t stream) {
    static int grid = 0;
    if (grid == 0) {
        if (n_in != 18 || out_size != mk::M * mk::D || ws_size < mk::WS_NEED) { fprintf(stderr, "kernel_launch: unexpected sizes n_in %d out %d ws %zu\n", n_in, out_size, ws_size); grid = -1; return; }
        int dev = 0, cus = 0, per_cu = 0;
        if (hipGetDevice(&dev) != hipSuccess || hipDeviceGetAttribute(&cus, hipDeviceAttributeMultiprocessorCount, dev) != hipSuccess) { grid = -1; return; }
        if (hipFuncSetAttribute((const void*)mk::fwd, hipFuncAttributeMaxDynamicSharedMemorySize, mk::LDS_BYTES) != hipSuccess) { fprintf(stderr, "kernel_launch: hipFuncSetAttribute failed\n"); grid = -1; return; }
        if (hipOccupancyMaxActiveBlocksPerMultiprocessor(&per_cu, (const void*)mk::fwd, mk::NTHREADS, mk::LDS_BYTES) != hipSuccess || per_cu < 1) { fprintf(stderr, "kernel_launch: occupancy query says %d\n", per_cu); per_cu = 1; }
        (void)hipGetLastError();
        grid = cus;
        if (grid != 256) fprintf(stderr, "kernel_launch: %d CUs (built for 256)\n", grid);
    }
    if (grid < 0) return;
    (void)hipMemsetAsync((char*)d_ws + mk::WS_CTL, 0, mk::CTL_ZERO_BYTES, stream);
    mk::Args a{};
    for (int i = 0; i < 18; ++i) a.in[i] = (const float*)d_in[i];
    a.out = (float*)d_out; a.ws = (unsigned char*)d_ws;
#if MK_MODE == 0
    a.ph_lo = 0; a.ph_hi = mk::N_PHASES;
    hipLaunchKernelGGL(mk::fwd, dim3(grid), dim3(mk::NTHREADS), mk::LDS_BYTES, stream, a);
#elif MK_MODE == 1
    for (int p = 0; p < mk::N_PHASES; ++p) { a.ph_lo = p; a.ph_hi = p + 1; hipLaunchKernelGGL(mk::fwd, dim3(grid), dim3(mk::NTHREADS), mk::LDS_BYTES, stream, a); }
#else
    a.ph_lo = 0; a.ph_hi = MK_CUT; hipLaunchKernelGGL(mk::fwd, dim3(grid), dim3(mk::NTHREADS), mk::LDS_BYTES, stream, a);
    {
        float* tmp = (float*)((char*)d_ws + 250 * mk::MiB); unsigned short* hbt = (unsigned short*)((char*)d_ws + 210 * mk::MiB);
        (void)hipMemcpyAsync(tmp, (char*)d_ws + mk::WS_META + mk::META_HM, 16 * 1024 * 4, hipMemcpyDeviceToDevice, stream);
        (void)hipMemcpyAsync(hbt, (char*)d_ws + mk::WS_HB, (size_t)mk::M * mk::D * 2, hipMemcpyDeviceToDevice, stream);
        hipLaunchKernelGGL(dbg::adapt, dim3((unsigned)(((size_t)nv::ROWS * nv::D + 255) / 256)), dim3(256), 0, stream, (const unsigned short*)hbt, (const float*)tmp, (float*)d_ws);
        nv::forward(stream, d_in, (float*)d_out, (char*)d_ws, MK_STAGE);
    }
#endif
}
```

```cpp
#include <hip/hip_runtime.h>
#include <cstdint>
#include <cstdio>
#include <cmath>
#define MK_MODE 0
namespace mk {
#define LAS __attribute__((address_space(3)))
#define GAS __attribute__((address_space(1)))
typedef unsigned short bf16_t;
typedef short bf16x8 __attribute__((ext_vector_type(8)));
typedef short s16x4 __attribute__((ext_vector_type(4)));
typedef float f32x4 __attribute__((ext_vector_type(4)));
typedef float f32x2 __attribute__((ext_vector_type(2)));
typedef unsigned u32x4 __attribute__((ext_vector_type(4)));
typedef unsigned u32x2 __attribute__((ext_vector_type(2)));

constexpr int M = 16384, D = 1024, DFF = 2816, SEQ = 8192, NMETA = 16;
constexpr int NWAVES = 8, NTHREADS = 512;
constexpr size_t MiB = 1u << 20;
constexpr size_t WS_CTL = 0, CTL_ZERO_BYTES = 1 * MiB;
constexpr size_t CTL_OSS_RET = 256 * 1024, CTL_OSS_GLA = 512 * 1024, CTL_MOSS = 768 * 1024;
constexpr size_t WS_HB = 1 * MiB, WS_SS = 33 * MiB, WS_META = 34 * MiB, WS_WMIX = 35 * MiB;
constexpr size_t META_HM = 0, META_RAW = 64 * 1024, META_MO = 448 * 1024;
constexpr size_t WS_WFFN_A = 52 * MiB, WS_ACT = 69 * MiB, WS_WFFN_B = 157 * MiB, WS_WFFN_C = 244 * MiB;
constexpr size_t WS_QH = 52 * MiB, WS_KH = 84 * MiB, WS_VT = 116 * MiB, WS_O = 180 * MiB;
constexpr size_t WS_BC = 69 * MiB, WS_QH2 = 101 * MiB, WS_KH2 = 117 * MiB, WS_VT2 = 133 * MiB, WS_O2 = 174 * MiB;
constexpr size_t WS_BV = 52 * MiB, WS_KM = 180 * MiB, WS_KT = 212 * MiB;
constexpr size_t WS_G2 = 208 * MiB;
constexpr size_t WS_NEED = 256 * MiB;
constexpr size_t WM_RET_IN = 0, WM_RET_OUT = 12 * MiB;
constexpr size_t WM_GLA_IN = 0, WM_GLA_G = 4 * MiB, WM_GLA_OUT = 6 * MiB, WM_GLA_Z = 8 * MiB;
constexpr size_t WF_IN = 0, WF_OUT = 11 * MiB;
constexpr int CW_BAR = 4096;

constexpr int LDS_BYTES = 163840;
constexpr int LDS_UL = 139264;
constexpr int LDS_RS = 133120;
constexpr int LDS_MISC = LDS_BYTES - 256;

__constant__ float L2G[4] = {-0.04580368961312478f, -0.02272007650008353f, -0.011315313227834133f, -0.005646563141142062f};
__constant__ float ROPE_INV[128] = {
  1.000000000e+00f, 9.300450087e-01f, 8.649836779e-01f, 8.044736385e-01f,
  7.481966019e-01f, 6.958565116e-01f, 6.471778154e-01f, 6.019044518e-01f,
  5.597981811e-01f, 5.206375122e-01f, 4.842162728e-01f, 4.503428936e-01f,
  4.188391268e-01f, 3.895392120e-01f, 3.622889817e-01f, 3.369450271e-01f,
  3.133740425e-01f, 2.914519310e-01f, 2.710633874e-01f, 2.521011233e-01f,
  2.344653904e-01f, 2.180633694e-01f, 2.028087080e-01f, 1.886212230e-01f,
  1.754262149e-01f, 1.631542742e-01f, 1.517407894e-01f, 1.411257535e-01f,
  1.312533021e-01f, 1.220714748e-01f, 1.135319397e-01f, 1.055898219e-01f,
  9.820328653e-02f, 9.133346379e-02f, 8.494423330e-02f, 7.900195569e-02f,
  7.347535342e-02f, 6.833537668e-02f, 6.355497986e-02f, 5.910899118e-02f,
  5.497401953e-02f, 5.112830922e-02f, 4.755162448e-02f, 4.422515258e-02f,
  4.113136977e-02f, 3.825402260e-02f, 3.557796404e-02f, 3.308910504e-02f,
  3.077435680e-02f, 2.862153389e-02f, 2.661931701e-02f, 2.475716174e-02f,
  2.302526683e-02f, 2.141453326e-02f, 1.991648041e-02f, 1.852322184e-02f,
  1.722742990e-02f, 1.602228358e-02f, 1.490144618e-02f, 1.385901403e-02f,
  1.288950257e-02f, 1.198781747e-02f, 1.114920899e-02f, 1.036926545e-02f,
  9.643883444e-03f, 8.969245479e-03f, 8.341802284e-03f, 7.758250926e-03f,
  7.215522230e-03f, 6.710760761e-03f, 6.241309457e-03f, 5.804697983e-03f,
  5.398627371e-03f, 5.020966288e-03f, 4.669724498e-03f, 4.343053792e-03f,
  4.039235413e-03f, 3.756670747e-03f, 3.493872471e-03f, 3.249458736e-03f,
  3.022142686e-03f, 2.810728736e-03f, 2.614103956e-03f, 2.431234345e-03f,
  2.261157380e-03f, 2.102978062e-03f, 1.955864020e-03f, 1.819041790e-03f,
  1.691789716e-03f, 1.573440502e-03f, 1.463370281e-03f, 1.361000235e-03f,
  1.265791478e-03f, 1.177242957e-03f, 1.094888896e-03f, 1.018295996e-03f,
  9.470609948e-04f, 8.808093844e-04f, 8.191923262e-04f, 7.618857198e-04f,
  7.085879333e-04f, 6.590186385e-04f, 6.129170069e-04f, 5.700403708e-04f,
  5.301629426e-04f, 4.930753494e-04f, 4.585822753e-04f, 4.265021416e-04f,
  3.966661752e-04f, 3.689173318e-04f, 3.431097430e-04f, 3.191074939e-04f,
  2.967843320e-04f, 2.760227653e-04f, 2.567135962e-04f, 2.387551940e-04f,
  2.220530587e-04f, 2.065193403e-04f, 1.920722716e-04f, 1.786358480e-04f,
  1.661392889e-04f, 1.545170089e-04f, 1.437077590e-04f, 1.336546848e-04f,
  1.243048755e-04f, 1.156091312e-04f, 1.075216787e-04f, 9.999999747e-05f,
};

#define LDS_WAIT() asm volatile("s_waitcnt lgkmcnt(0)" ::: "memory")
__device__ __forceinline__ int lane_id_v() { int l; asm volatile("v_mbcnt_lo_u32_b32 %0, -1, 0\n\tv_mbcnt_hi_u32_b32 %0, -1, %0" : "=v"(l)); return l; }
#define VM_WAIT() asm volatile("s_waitcnt vmcnt(0)" ::: "memory")
#define RLX_AGENT __ATOMIC_RELAXED, __HIP_MEMORY_SCOPE_AGENT

__device__ __forceinline__ unsigned cvt_pk_bf16(float lo, float hi) { unsigned r; asm volatile("v_cvt_pk_bf16_f32 %0, %1, %2" : "=v"(r) : "v"(lo), "v"(hi)); return r; }
__device__ __forceinline__ float bf_lo(unsigned w) { return __uint_as_float(w << 16); }
__device__ __forceinline__ float bf_hi(unsigned w) { return __uint_as_float(w & 0xffff0000u); }
__device__ __forceinline__ unsigned short f2bf(float f) { return (unsigned short)(cvt_pk_bf16(f, 0.f) & 0xffffu); }
__device__ __forceinline__ float fsilu(float v) { return v * __builtin_amdgcn_rcpf(1.0f + __expf(-v)); }
__device__ __forceinline__ float wave_sum(float v) {
#pragma unroll
    for (int o = 1; o < 64; o <<= 1) v += __shfl_xor(v, o);
    return v;
}
__device__ __forceinline__ float row_rstd(const float* SS, int row) {
    const f32x4* p = (const f32x4*)(SS + (size_t)row * 16);
    const f32x4 a = p[0], b = p[1], c = p[2], d = p[3];
    const float s = ((a.x + a.y) + (a.z + a.w)) + ((b.x + b.y) + (b.z + b.w)) + ((c.x + c.y) + (c.z + c.w)) + ((d.x + d.y) + (d.z + d.w));
    return 1.0f / sqrtf(s * (1.0f / 1024.0f) + 1e-6f);
}

#define XB_TMO      128
#define XB_XCNT(j)  (256  + 64 * (j))
#define XB_XSUB(j)  (1280 + 64 * (j))
#define XB_XGEN(j)  (2304 + 64 * (j))
#define XB_TOP      3328
#define XB_TOPGEN   3392
#define XCD_BAR_WORDS 3456
#define XB_SPIN_CAP (1u << 18)
__device__ __forceinline__ unsigned xb_ld(unsigned* p)              { return __hip_atomic_load(p, __ATOMIC_RELAXED, __HIP_MEMORY_SCOPE_AGENT); }
__device__ __forceinline__ unsigned xb_add(unsigned* p, unsigned v) { return __hip_atomic_fetch_add(p, v, __ATOMIC_RELAXED, __HIP_MEMORY_SCOPE_AGENT); }
__device__ __forceinline__ unsigned xb_xcc_id() { return (unsigned)__builtin_amdgcn_s_getreg((3 << 11) | 20) & 0xFu; }
#define XB_SPIN(cond, bar) do { unsigned _sp = 0; while (cond) { __builtin_amdgcn_s_sleep(1); \
    if ((++_sp & 255u) == 0u) { if (xb_ld(&(bar)[XB_TMO])) break; if (_sp > XB_SPIN_CAP) { atomicAdd(&(bar)[XB_TMO], 1u); break; } } } } while (0)
struct XcdBarrier { unsigned* bar; unsigned x; volatile LAS unsigned* st; };
__device__ __forceinline__ XcdBarrier xcd_barrier_post(unsigned* bar, volatile LAS unsigned* st) {
    XcdBarrier b; b.bar = bar; b.x = xb_xcc_id(); b.st = st;
    if (threadIdx.x == 0) { const unsigned rank = xb_add(&bar[XB_XCNT(b.x)], 1u); st[2] = rank; st[3] = b.x; }
    return b;
}
__device__ __forceinline__ void xcd_barrier_complete(unsigned* bar, unsigned x, unsigned& nloc, unsigned& nx) {
    const unsigned G = gridDim.x * gridDim.y * gridDim.z;
    unsigned sum, cnt, mine, sp = 0u;
    for (;;) {
        sum = 0u; cnt = 0u; mine = 0u;
#pragma unroll
        for (unsigned j = 0; j < 16; ++j) { const unsigned c = xb_ld(&bar[XB_XCNT(j)]); sum += c; cnt += (c > 0u) ? 1u : 0u; mine = (j == x) ? c : mine; }
        if (sum == G) break;
        __builtin_amdgcn_s_sleep(1);
        if ((++sp & 255u) == 0u) { if (xb_ld(&bar[XB_TMO])) break; if (sp > XB_SPIN_CAP) { atomicAdd(&bar[XB_TMO], 1u); break; } }
    }
    nloc = mine > 0u ? mine : 1u; nx = cnt > 0u ? cnt : 1u;
}
__device__ __forceinline__ void xcd_barrier(const XcdBarrier& b) {
    asm volatile("s_waitcnt vmcnt(0)" ::: "memory");
    __syncthreads();
    if (threadIdx.x == 0) {
        unsigned* bar = b.bar;
        __builtin_amdgcn_s_waitcnt(0);
        unsigned nloc = b.st[0], nx = b.st[1];
        if (nloc == 0u) { xcd_barrier_complete(bar, b.x, nloc, nx); b.st[0] = nloc; b.st[1] = nx; }
        const unsigned old = xb_add(&bar[XB_XSUB(b.x)], 1u);
        const unsigned gen = old / nloc;
        if (old + 1u == (gen + 1u) * nloc) {
            __builtin_amdgcn_fence(__ATOMIC_RELEASE, "agent");
            asm volatile("s_waitcnt vmcnt(0)" ::: "memory");
            const unsigned og = xb_add(&bar[XB_TOP], 1u);
            const unsigned tg = og / nx;
            if (og + 1u == (tg + 1u) * nx) xb_add(&bar[XB_TOPGEN], 1u);
            else XB_SPIN(xb_ld(&bar[XB_TOPGEN]) == tg, bar);
            __builtin_amdgcn_fence(__ATOMIC_ACQUIRE, "agent");
            xb_add(&bar[XB_XGEN(b.x)], 1u);
            asm volatile("s_waitcnt vmcnt(0)" ::: "memory");
        } else {
            XB_SPIN(xb_ld(&bar[XB_XGEN(b.x)]) == gen, bar);
            __builtin_amdgcn_fence(__ATOMIC_ACQUIRE, "agent");
            asm volatile("s_waitcnt vmcnt(0)" ::: "memory");
        }
    }
    __syncthreads();
}

namespace pg8 {
constexpr int BM = 256, BK = 64, HALF = 128, HTB = HALF * BK * 2, STAGE_BYTES = 8 * HTB, NXCD = 8, WGM = 8;
__host__ __device__ __forceinline__ int lds_byte(int r, int c) { const int st = (r >> 4) * 2 + (c >> 5), rr = r & 15, cc = c & 31, ob = rr * 64 + cc * 2; return st * 1024 + (ob ^ (((ob >> 9) & 1) << 5)); }
__host__ __device__ __forceinline__ void stage_rc(int b, int& R, int& C) { const int st = b / 1024, sb = b % 1024, swz = sb ^ (((sb >> 9) & 1) << 5); R = (st >> 1) * 16 + swz / 64; C = (st & 1) * 32 + (swz % 64) / 2; }
__host__ __device__ __forceinline__ int perm32(int rho) { const int n = rho >> 4, i = rho & 15; return 8 * (i >> 2) + 4 * n + (i & 3); }
struct Unit { int pm, pn, ui; };
struct Order {
    int nM, nN, nwg, G, c;
    __device__ void init(int nM_, int nN_, int G_, int c_) { nM = nM_; nN = nN_; nwg = nM * nN; G = G_; c = c_; }
    __device__ bool next(int i, Unit& u) const {
        const long L = (long)i * G + c; if (L >= nwg) return false;
        int wgid = (int)L; { const int q = nwg / NXCD, r = nwg % NXCD, xcd = wgid % NXCD, off = wgid / NXCD; wgid = (xcd < r ? xcd * (q + 1) : r * (q + 1) + (xcd - r) * q) + off; }
        const int nig = WGM * nN, gid = wgid / nig, fm = gid * WGM, gsz = (nM - fm) < WGM ? (nM - fm) : WGM;
        u.pm = fm + ((wgid % nig) % gsz); u.pn = (wgid % nig) / gsz; return true;
    }
};
struct OrderLin {
    int n, G, c, nN = 0;
    __device__ bool next(int i, Unit& u) const { const long L = (long)i * G + c; if (L >= n) return false; u.pm = (int)L; u.pn = 0; return true; }
};
#if defined(PROBE4)
__device__ unsigned long long g_dummy_;
#endif
template <class Epi, class Ptr, class Ord = Order>
__device__ __forceinline__ void gemm_phase(LAS unsigned char* lds, const int K, const Ord& S, const Ptr& P, const Epi& E, const int lda = 0, const int ldb = 0, const int wid_in = -1, const float* SSrs = nullptr) {
    const int wid = wid_in >= 0 ? wid_in : __builtin_amdgcn_readfirstlane((int)threadIdx.x >> 6), lane = wid_in >= 0 ? lane_id_v() : (int)(threadIdx.x & 63), tid = wid * 64 + lane, wr = wid >> 2, wc = wid & 3, fr = lane & 15, fq = lane >> 4;
    const int nt = K / BK;
    unsigned voffA[2], voffB[2];
#pragma unroll
    for (int i = 0; i < 2; ++i) { int R, C; stage_rc(tid * 16 + i * 8192, R, C); const int Rb = (R & ~31) + perm32(R & 31);
        voffA[i] = (unsigned)(R * (lda ? lda : K) + C) * 2u; voffB[i] = (unsigned)(Rb * (ldb ? ldb : K) + C) * 2u; }
    const size_t kstep = (size_t)(BK * 2);
    const size_t hstepA = (size_t)HALF * (lda ? lda : K) * 2, hstepB = (size_t)HALF * (ldb ? ldb : K) * 2;
    const unsigned ldsw = (unsigned)wid * 1024u;
    const int aoff = lds_byte(wr * 64 + fr, fq * 8), boff = lds_byte(wc * 32 + fr, fq * 8);
#define PG8_SA(b, h) (((b) * 2 + (h)) * HTB)
#define PG8_SB(b, h) ((4 + (b) * 2 + (h)) * HTB)
#define PG8_STAGE(bufoff, gbase, voff) do { _Pragma("unroll") for (int _i = 0; _i < 2; ++_i) \
        __builtin_amdgcn_global_load_lds((const unsigned*)((const char*)(gbase) + (voff)[_i]), (LAS unsigned*)(lds + (bufoff) + ldsw + _i * 8192), 16, 0, 0); } while (0)
#define PG8_LDA(dst, b, h) do { _Pragma("unroll") for (int m = 0; m < 4; ++m) _Pragma("unroll") for (int k = 0; k < 2; ++k) dst[m][k] = *(const LAS bf16x8*)(lds + PG8_SA(b, h) + aoff + m * 2048 + k * 1024); } while (0)
#define PG8_LDB(dst, b, h) do { _Pragma("unroll") for (int n = 0; n < 2; ++n) _Pragma("unroll") for (int k = 0; k < 2; ++k) dst[n][k] = *(const LAS bf16x8*)(lds + PG8_SB(b, h) + boff + n * 2048 + k * 1024); } while (0)
#define PG8_MMA(ai, bj, At, Bt) do { __builtin_amdgcn_s_setprio(1); _Pragma("unroll") for (int m = 0; m < 4; ++m) _Pragma("unroll") for (int n = 0; n < 2; ++n) _Pragma("unroll") for (int k = 0; k < 2; ++k) \
        acc[ai][bj][m][n] = __builtin_amdgcn_mfma_f32_16x16x32_bf16(Bt[n][k], At[m][k], acc[ai][bj][m][n], 0, 0, 0); __builtin_amdgcn_s_setprio(0); } while (0)
#define PG8_WAIT_V(n) asm volatile("s_waitcnt vmcnt(" #n ")" ::: "memory")
#define PG8_WAIT_L(n) asm volatile("s_waitcnt lgkmcnt(" #n ")" ::: "memory")
#define PG8_BAR __builtin_amdgcn_s_barrier()
#define PG8_SCHED __builtin_amdgcn_sched_barrier(0)
#if defined(PROBE4)
    unsigned long long g_pacc = 0ull;
#endif
    Unit cur, nxt; int ui = 0;
    LAS int* UL = (LAS int*)(lds + LDS_UL);
    int codev; { Unit uv; const bool okv = S.next(lane & 7, uv); codev = okv ? (uv.pm | (uv.pn << 16)) : -1; }
    if (tid < 8) UL[tid] = codev;
    { const int c0 = __builtin_amdgcn_readlane(codev, 0); if (c0 < 0) return; cur.pm = c0 & 0xffff; cur.pn = c0 >> 16; cur.ui = 0; }
    float sv[6];
    if (SSrs) {
#pragma unroll
        for (int i = 0; i < 6; ++i) { const int ci = __builtin_amdgcn_readlane(codev, i); const int pm = (ci < 0 ? cur.pm : (ci & 0xffff));
            const f32x4* p = (const f32x4*)(SSrs + (size_t)(pm * 256 + (tid >> 1)) * 16 + (tid & 1) * 8); const f32x4 a = p[0], b = p[1];
            sv[i] = ((a.x + a.y) + (a.z + a.w)) + ((b.x + b.y) + (b.z + b.w)); }
    }
    f32x4 acc[2][2][4][2];
#pragma unroll
    for (int a = 0; a < 2; ++a)
#pragma unroll
        for (int b = 0; b < 2; ++b)
#pragma unroll
            for (int m = 0; m < 4; ++m)
#pragma unroll
                for (int n = 0; n < 2; ++n) acc[a][b][m][n] = (f32x4){0.f, 0.f, 0.f, 0.f};
    bf16x8 At[4][2], B0[2][2], B1[2][2];
    const char* cA; const char* cB; P.ptrs(cur, cA, cB);
    PG8_STAGE(PG8_SB(0, 0), cB, voffB); PG8_STAGE(PG8_SB(0, 1), cB + hstepB, voffB); PG8_STAGE(PG8_SA(0, 0), cA, voffA); PG8_STAGE(PG8_SA(0, 1), cA + hstepA, voffA);
    if (SSrs) { LAS float* RS = (LAS float*)(lds + LDS_RS);
#pragma unroll
        for (int i = 0; i < 6; ++i) { const float s = sv[i] + __shfl_xor(sv[i], 1); if (!(tid & 1)) RS[i * 256 + (tid >> 1)] = 1.0f / sqrtf(s * (1.0f / 1024.0f) + 1e-6f); } }
    PG8_WAIT_L(0);
    if (wr == 1) PG8_BAR;
    PG8_WAIT_V(2); PG8_BAR;
    PG8_STAGE(PG8_SB(1, 0), cB + kstep, voffB); PG8_STAGE(PG8_SA(1, 0), cA + kstep, voffA); PG8_STAGE(PG8_SB(1, 1), cB + hstepB + kstep, voffB);
    PG8_WAIT_V(6); PG8_BAR;
    for (;;) {
        bool has_next;
        if (ui + 1 < 8) { const int cn = __builtin_amdgcn_readfirstlane(UL[ui + 1]); has_next = cn >= 0; nxt.pm = cn & 0xffff; nxt.pn = cn >> 16; }
        else has_next = S.next(ui + 1, nxt);
        nxt.ui = ui + 1;
        const char* nA = cA; const char* nB = cB; if (has_next) P.ptrs(nxt, nA, nB);
        for (int t = 0; t < nt; t += 2) {
            const bool last = (t == nt - 2);
            const char* a1 = cA + (size_t)(t + 1) * kstep;
            const char* a2 = last ? nA : cA + (size_t)(t + 2) * kstep; const char* b2 = last ? nB : cB + (size_t)(t + 2) * kstep;
            const char* a3 = a2 + kstep; const char* b3 = b2 + kstep;
            PG8_LDB(B0, 0, 0); PG8_LDB(B1, 0, 1); PG8_SCHED; PG8_LDA(At, 0, 0); PG8_STAGE(PG8_SA(1, 1), a1 + hstepA, voffA);
            PG8_WAIT_V(8); PG8_WAIT_L(0); PG8_BAR; PG8_MMA(0, 0, At, B0); PG8_MMA(0, 1, At, B1); PG8_BAR; PG8_SCHED;
            PG8_LDA(At, 0, 1); PG8_STAGE(PG8_SB(0, 0), b2, voffB); PG8_STAGE(PG8_SB(0, 1), b2 + hstepB, voffB); PG8_STAGE(PG8_SA(0, 0), a2, voffA);
            PG8_WAIT_V(8); PG8_WAIT_L(0); PG8_BAR; PG8_MMA(1, 0, At, B0); PG8_MMA(1, 1, At, B1); PG8_BAR; PG8_SCHED;
            PG8_LDB(B0, 1, 0); PG8_LDB(B1, 1, 1); PG8_SCHED; PG8_LDA(At, 1, 0); PG8_STAGE(PG8_SA(0, 1), a2 + hstepA, voffA);
            PG8_WAIT_V(8); PG8_WAIT_L(0); PG8_BAR; PG8_MMA(0, 0, At, B0); PG8_MMA(0, 1, At, B1); PG8_BAR; PG8_SCHED;
            PG8_LDA(At, 1, 1); PG8_STAGE(PG8_SB(1, 0), b3, voffB); PG8_STAGE(PG8_SB(1, 1), b3 + hstepB, voffB); PG8_STAGE(PG8_SA(1, 0), a3, voffA);
            PG8_WAIT_V(8); PG8_WAIT_L(0); PG8_BAR; PG8_MMA(1, 0, At, B0); PG8_MMA(1, 1, At, B1); PG8_BAR; PG8_SCHED;
        }
        if (wr == 0) PG8_BAR;
#if defined(PROBE4)
        unsigned long long pe0_ = __builtin_amdgcn_s_memtime();
#endif
        E(acc, cur, wr, wc, fr, fq);
#if defined(PROBE4)
        if (PROBE4 == 1) { asm volatile("s_waitcnt vmcnt(0)" ::: "memory"); }
        g_pacc += __builtin_amdgcn_s_memtime() - pe0_;
#endif
        if (!has_next) break;
#pragma unroll
        for (int a = 0; a < 2; ++a)
#pragma unroll
            for (int b = 0; b < 2; ++b)
#pragma unroll
                for (int m = 0; m < 4; ++m)
#pragma unroll
                    for (int n = 0; n < 2; ++n) acc[a][b][m][n] = (f32x4){0.f, 0.f, 0.f, 0.f};
        cur = nxt; cA = nA; cB = nB; ++ui;
        if (wr == 1) PG8_BAR;
    }
    PG8_WAIT_V(0);
    PG8_BAR;
#if defined(PROBE4)
    if (blockIdx.x == 0 && tid == 0 && K == 1024 && S.nN == PROBE4_NN) { volatile LAS unsigned* MI = (volatile LAS unsigned*)(lds + LDS_MISC); const unsigned long long v = (((unsigned long long)MI[21] << 32) | MI[20]) + g_pacc; MI[20] = (unsigned)v; MI[21] = (unsigned)(v >> 32); }
#endif
#undef PG8_SA
#undef PG8_SB
#undef PG8_STAGE
#undef PG8_LDA
#undef PG8_LDB
#undef PG8_MMA
#undef PG8_WAIT_V
#undef PG8_WAIT_L
#undef PG8_BAR
#undef PG8_SCHED
}
}
struct Frame {
    LAS unsigned char* lds;
    int tid, lane, wave, vcu, G, vb;
    unsigned char* ws;
    const float* in[18];
    float* out;
};
#define WSP(T, off) ((T*)(F.ws + (off)))

__device__ __forceinline__ void conv_item(const float* W, int ldn, int srccol0, int k0, const float* gain, bf16_t* WT, int K, int dstrow0, LAS float* scr, int lane) {
    float v[32];
    const float* wp = W + (size_t)(k0 + (lane >> 5)) * ldn + srccol0 + (lane & 31);
#pragma unroll
    for (int i = 0; i < 32; ++i) v[i] = wp[(size_t)(2 * i) * ldn];
    const int c = lane & 7;
    float gn[8];
#pragma unroll
    for (int e = 0; e < 8; ++e) gn[e] = gain ? gain[k0 + 8 * c + e] : 1.0f;
#pragma unroll
    for (int i = 0; i < 32; ++i) scr[(2 * i + (lane >> 5)) * 33 + (lane & 31)] = v[i];
    LDS_WAIT(); asm volatile("" ::: "memory");
#pragma unroll
    for (int j = 0; j < 4; ++j) { const int n = (lane >> 3) + 8 * j; const LAS float* s = scr + (8 * c) * 33 + n;
        u32x4 o; o.x = cvt_pk_bf16(s[0 * 33] * gn[0], s[1 * 33] * gn[1]); o.y = cvt_pk_bf16(s[2 * 33] * gn[2], s[3 * 33] * gn[3]);
        o.z = cvt_pk_bf16(s[4 * 33] * gn[4], s[5 * 33] * gn[5]); o.w = cvt_pk_bf16(s[6 * 33] * gn[6], s[7 * 33] * gn[7]);
        *(u32x4*)(WT + (size_t)(dstrow0 + n) * K + k0 + 8 * c) = o; }
    LDS_WAIT(); asm volatile("" ::: "memory");
}
struct ConvJob { const float* W; int ldn, K, N, col0, kind; const float* gain; bf16_t* WT; };
__device__ __forceinline__ int conv_items(const ConvJob& J) { return (J.K / 64) * (J.N / 32); }
__device__ __forceinline__ void conv_run(const ConvJob& J, int item, LAS float* scr, int lane) {
    const int nblk = J.N / 32, kb = item / nblk, nb = item % nblk; const int n0 = 32 * nb;
    int src;
    if (J.kind == 0) src = J.col0 + n0; else { const int u = n0 >> 8, j = n0 & 255; src = (j < 128) ? u * 128 + j : 2816 + u * 128 + (j - 128); }
    conv_item(J.W, J.ldn, src, 64 * kb, J.gain, J.WT, J.K, n0, scr, lane);
}
__device__ __forceinline__ int conv_job(Frame& F, const ConvJob& J, int base, int gw, int ngw) {
    LAS float* scr = (LAS float*)(F.lds + F.wave * 16384);
    const int n = conv_items(J);
    const int first = (gw - base % ngw + ngw) % ngw;
    for (int it = first; it < n; it += ngw) conv_run(J, it, scr, F.lane);
    return base + n;
}
__device__ __forceinline__ ConvJob job_ffn_in(Frame& F, int layer, int which  , size_t dst) {
    ConvJob J; J.W = F.in[which ? 7 : 3] + (size_t)layer * D * 2 * DFF; J.ldn = 2 * DFF; J.K = D; J.N = 2 * DFF; J.col0 = 0; J.kind = 1; J.gain = F.in[which ? 6 : 2] + layer * D; J.WT = WSP(bf16_t, dst); return J; }
__device__ __forceinline__ ConvJob job_ffn_out(Frame& F, int layer, int which, size_t dst) {
    ConvJob J; J.W = F.in[which ? 8 : 4] + (size_t)layer * DFF * D; J.ldn = D; J.K = DFF; J.N = D; J.col0 = 0; J.kind = 0; J.gain = nullptr; J.WT = WSP(bf16_t, dst); return J; }

__device__ __forceinline__ f32x2 pk_silu_mul(f32x2 g, f32x2 u, float c1, float rs2) {
    const f32x2 t = g * c1; f32x2 e; e.x = __builtin_amdgcn_exp2f(t.x); e.y = __builtin_amdgcn_exp2f(t.y);
    const f32x2 d = e + 1.0f; f32x2 r; r.x = __builtin_amdgcn_rcpf(d.x); r.y = __builtin_amdgcn_rcpf(d.y);
    return (g * u) * (r * rs2);
}
#define RSTAB ((const LAS float*)(RSL) + u.ui * 256)
#define ROWS8_RS(rsv) do { const LAS float* rs_ = RSTAB + wr * 64 + fr; _Pragma("unroll") for (int k_ = 0; k_ < 8; ++k_) rsv[k_] = rs_[(k_ >> 2) * 128 + (k_ & 3) * 16]; } while (0)
#define COLS16_RS(rs) do { const LAS float* rs_ = RSTAB + wc * 32 + 8 * fq; _Pragma("unroll") for (int bj_ = 0; bj_ < 2; ++bj_) { const f32x4 a_ = *(const LAS f32x4*)(rs_ + bj_ * 128), b_ = *(const LAS f32x4*)(rs_ + bj_ * 128 + 4); \
        rs[bj_][0] = a_.x; rs[bj_][1] = a_.y; rs[bj_][2] = a_.z; rs[bj_][3] = a_.w; rs[bj_][4] = b_.x; rs[bj_][5] = b_.y; rs[bj_][6] = b_.z; rs[bj_][7] = b_.w; } } while (0)
#define ROWS8_RSTD(SSp, rowbase, rsv) do { const float a_ = row_rstd(SSp, (rowbase) + fq * 16), b_ = row_rstd(SSp, (rowbase) + 128 + fq * 16); \
        _Pragma("unroll") for (int k_ = 0; k_ < 8; ++k_) rsv[k_] = __shfl(k_ < 4 ? a_ : b_, fr + 16 * (k_ & 3)); } while (0)

struct EpiSwiglu {
    const LAS float* RSL; bf16_t* ACT;
    __device__ __forceinline__ void operator()(const f32x4 (&acc)[2][2][4][2], const pg8::Unit& u, int wr, int wc, int fr, int fq) const {
        float rsv[8]; ROWS8_RS(rsv);
#pragma unroll
        for (int ai = 0; ai < 2; ++ai)
#pragma unroll
            for (int m = 0; m < 4; ++m) {
                const int row = u.pm * 256 + ai * 128 + wr * 64 + m * 16 + fr; const float rs = rsv[ai * 4 + m], c1 = rs * -1.4426950408889634f, rs2 = rs * rs;
                f32x2 v[4];
#pragma unroll
                for (int n = 0; n < 2; ++n) { const f32x4 g = acc[ai][0][m][n], up = acc[ai][1][m][n];
                    v[2 * n] = pk_silu_mul((f32x2){g[0], g[1]}, (f32x2){up[0], up[1]}, c1, rs2); v[2 * n + 1] = pk_silu_mul((f32x2){g[2], g[3]}, (f32x2){up[2], up[3]}, c1, rs2); }
                u32x4 w; w.x = cvt_pk_bf16(v[0].x, v[0].y); w.y = cvt_pk_bf16(v[1].x, v[1].y); w.z = cvt_pk_bf16(v[2].x, v[2].y); w.w = cvt_pk_bf16(v[3].x, v[3].y);
                *(u32x4*)(ACT + (size_t)row * DFF + u.pn * 128 + wc * 32 + 8 * fq) = w;
            }
    }
};
template <bool BASE_F32> struct EpiResid {
    const float* xbase; bf16_t* HB; float* SS; float alpha;
    __device__ __forceinline__ void operator()(const f32x4 (&acc)[2][2][4][2], const pg8::Unit& u, int wr, int wc, int fr, int fq) const {
#pragma unroll
        for (int ai = 0; ai < 2; ++ai)
#pragma unroll
            for (int m = 0; m < 4; ++m) {
                const int row = u.pm * 256 + ai * 128 + wr * 64 + m * 16 + fr; float ss = 0.f;
#pragma unroll
                for (int bj = 0; bj < 2; ++bj) {
                    const size_t off = (size_t)row * D + u.pn * 256 + bj * 128 + wc * 32 + 8 * fq;
                    f32x4 b0, b1;
                    if (BASE_F32) { b0 = *(const f32x4*)(xbase + off); b1 = *(const f32x4*)(xbase + off + 4); }
                    else { const u32x4 hv = *(const u32x4*)(HB + off); b0 = (f32x4){bf_lo(hv.x), bf_hi(hv.x), bf_lo(hv.y), bf_hi(hv.y)}; b1 = (f32x4){bf_lo(hv.z), bf_hi(hv.z), bf_lo(hv.w), bf_hi(hv.w)}; }
                    const f32x4 v0 = b0 + acc[ai][bj][m][0] * alpha, v1 = b1 + acc[ai][bj][m][1] * alpha;
                    u32x4 w; w.x = cvt_pk_bf16(v0[0], v0[1]); w.y = cvt_pk_bf16(v0[2], v0[3]); w.z = cvt_pk_bf16(v1[0], v1[1]); w.w = cvt_pk_bf16(v1[2], v1[3]);
                    *(u32x4*)(HB + off) = w;
                    ss += (v0[0] * v0[0] + v0[1] * v0[1]) + (v0[2] * v0[2] + v0[3] * v0[3]) + (v1[0] * v1[0] + v1[1] * v1[1]) + (v1[2] * v1[2] + v1[3] * v1[3]);
                }
                ss += __shfl_xor(ss, 16); ss += __shfl_xor(ss, 32);
                if (fq == 0) SS[(size_t)row * 16 + u.pn * 4 + wc] = ss;
            }
    }
};
struct EpiRetIn {
    const float* SS; bf16_t* QH; bf16_t* KH; bf16_t* VT;
    __device__ __forceinline__ void operator()(const f32x4 (&acc)[2][2][4][2], const pg8::Unit& u, int wr, int wc, int fr, int fq) const {
        if (u.pn < 8) {
            const bool isq = u.pn < 4; const int head = u.pn & 3; bf16_t* dst = isq ? QH : KH;
            const float l2g = isq ? L2G[head] : -L2G[head], sc = isq ? 1.0f : 0.0625f;
            float inv[8]; int ez_ = 0; asm volatile("" : "+v"(ez_));
#pragma unroll
            for (int e = 0; e < 8; ++e) inv[e] = ROPE_INV[wc * 32 + 8 * fq + e + ez_];
            float rsv[8]; ROWS8_RSTD(SS, u.pm * 256 + wr * 64 + fr, rsv);
#pragma unroll
            for (int ai = 0; ai < 2; ++ai)
#pragma unroll
                for (int m = 0; m < 4; ++m) {
                    const int row = u.pm * 256 + ai * 128 + wr * 64 + m * 16 + fr; const float rs = rsv[ai * 4 + m];
                    const int b = row >> 13, t = row & 8191; const float pos = (float)(t + NMETA);
                    const float dec = __builtin_amdgcn_exp2f((float)((t & 31) + 1) * l2g) * sc * rs;
                    float o1[8], o2[8];
#pragma unroll
                    for (int n = 0; n < 2; ++n)
#pragma unroll
                        for (int j = 0; j < 4; ++j) { const int e = 4 * n + j;
                            const float rev = (pos * inv[e]) * 0.15915494309189535f; const float frc = rev - floorf(rev);
                            const float sn = __builtin_amdgcn_sinf(frc), cs = __builtin_amdgcn_cosf(frc);
                            const float t1 = acc[ai][0][m][n][j], t2 = acc[ai][1][m][n][j];
                            o1[e] = (t1 * cs - t2 * sn) * dec; o2[e] = (t1 * sn + t2 * cs) * dec; }
                    bf16_t* p = dst + ((size_t)(b * 4 + head) * SEQ + t) * 256 + wc * 32 + 8 * fq;
                    u32x4 w; w.x = cvt_pk_bf16(o1[0], o1[1]); w.y = cvt_pk_bf16(o1[2], o1[3]); w.z = cvt_pk_bf16(o1[4], o1[5]); w.w = cvt_pk_bf16(o1[6], o1[7]);
                    *(u32x4*)p = w;
                    w.x = cvt_pk_bf16(o2[0], o2[1]); w.y = cvt_pk_bf16(o2[2], o2[3]); w.z = cvt_pk_bf16(o2[4], o2[5]); w.w = cvt_pk_bf16(o2[6], o2[7]);
                    *(u32x4*)(p + 128) = w;
                }
        } else {
            float rs[2][8];
            { const float mine = row_rstd(SS, u.pm * 256 + (fr >> 3) * 128 + wc * 32 + 8 * fq + (fr & 7));
#pragma unroll
              for (int bj = 0; bj < 2; ++bj)
#pragma unroll
                  for (int e = 0; e < 8; ++e) rs[bj][e] = __shfl(mine, bj * 8 + e + 16 * fq); }
            const int b = u.pm >> 5, t0 = (u.pm & 31) * 256;
#pragma unroll
            for (int ai = 0; ai < 2; ++ai)
#pragma unroll
                for (int m = 0; m < 4; ++m) {
                    const int vc = (u.pn - 8) * 256 + ai * 128 + wr * 64 + m * 16 + fr; const int head = vc >> 9, dvi = vc & 511;
                    bf16_t* p = VT + ((size_t)(b * 4 + head) * 512 + dvi) * SEQ + t0 + wc * 32 + 8 * fq;
#pragma unroll
                    for (int bj = 0; bj < 2; ++bj) {
                        const f32x4 v0 = acc[ai][bj][m][0], v1 = acc[ai][bj][m][1];
                        u32x4 w; w.x = cvt_pk_bf16(v0[0] * rs[bj][0], v0[1] * rs[bj][1]); w.y = cvt_pk_bf16(v0[2] * rs[bj][2], v0[3] * rs[bj][3]);
                        w.z = cvt_pk_bf16(v1[0] * rs[bj][4], v1[1] * rs[bj][5]); w.w = cvt_pk_bf16(v1[2] * rs[bj][6], v1[3] * rs[bj][7]);
                        *(u32x4*)(p + bj * 128) = w;
                    }
                }
        }
    }
};
template <int DV, int LDO> struct EpiGate {
    const LAS float* RSL; const bf16_t* O; bf16_t* Y; LAS float* RO;
    __device__ __forceinline__ void operator()(const f32x4 (&acc)[2][2][4][2], const pg8::Unit& u, int wr, int wc, int fr, int fq) const {
        const int wid = wr * 4 + wc, lane = fq * 16 + fr; const int head = (u.pn * 256) / DV;
        {   const bf16_t* ob = O + (size_t)(u.pm * 256 + wid * 32) * LDO + head * DV;
#pragma unroll
            for (int i0 = 0; i0 < 32; i0 += 8) { float sv[8];
#pragma unroll
                for (int i = 0; i < 8; ++i) { float s;
                    if (DV == 512) { const u32x4 v = *(const u32x4*)(ob + (size_t)(i0 + i) * LDO + lane * 8);
                        const float a0 = bf_lo(v.x), a1 = bf_hi(v.x), a2 = bf_lo(v.y), a3 = bf_hi(v.y), a4 = bf_lo(v.z), a5 = bf_hi(v.z), a6 = bf_lo(v.w), a7 = bf_hi(v.w);
                        s = ((a0 * a0 + a1 * a1) + (a2 * a2 + a3 * a3)) + ((a4 * a4 + a5 * a5) + (a6 * a6 + a7 * a7)); }
                    else { const u32x2 v = *(const u32x2*)(ob + (size_t)(i0 + i) * LDO + lane * 4);
                        const float a0 = bf_lo(v.x), a1 = bf_hi(v.x), a2 = bf_lo(v.y), a3 = bf_hi(v.y); s = (a0 * a0 + a1 * a1) + (a2 * a2 + a3 * a3); }
                    sv[i] = s; }
#pragma unroll
                for (int i = 0; i < 8; ++i) { const float t = wave_sum(sv[i]); if (lane == 0) RO[wid * 32 + i0 + i] = 1.0f / sqrtf(t * (1.0f / (float)DV) + 1e-6f); } }
            LDS_WAIT(); __builtin_amdgcn_s_barrier(); asm volatile("" ::: "memory"); }
        float rsv[8]; ROWS8_RS(rsv);
#pragma unroll
        for (int ai = 0; ai < 2; ++ai)
#pragma unroll
            for (int m = 0; m < 4; ++m) {
                const int rl = ai * 128 + wr * 64 + m * 16 + fr, row = u.pm * 256 + rl; const float rs = rsv[ai * 4 + m]; const float ro = RO[rl]; const float c1 = rs * -1.4426950408889634f, rs2 = rs * ro;
#pragma unroll
                for (int bj = 0; bj < 2; ++bj) {
                    const int col = u.pn * 256 + bj * 128 + wc * 32 + 8 * fq;
                    const u32x4 ov = *(const u32x4*)(O + (size_t)row * LDO + col);
                    const f32x4 g0 = acc[ai][bj][m][0], g1 = acc[ai][bj][m][1];
                    const f32x2 y0 = pk_silu_mul((f32x2){g0[0], g0[1]}, (f32x2){bf_lo(ov.x), bf_hi(ov.x)}, c1, rs2), y1 = pk_silu_mul((f32x2){g0[2], g0[3]}, (f32x2){bf_lo(ov.y), bf_hi(ov.y)}, c1, rs2);
                    const f32x2 y2 = pk_silu_mul((f32x2){g1[0], g1[1]}, (f32x2){bf_lo(ov.z), bf_hi(ov.z)}, c1, rs2), y3 = pk_silu_mul((f32x2){g1[2], g1[3]}, (f32x2){bf_lo(ov.w), bf_hi(ov.w)}, c1, rs2);
                    u32x4 w; w.x = cvt_pk_bf16(y0.x, y0.y); w.y = cvt_pk_bf16(y1.x, y1.y); w.z = cvt_pk_bf16(y2.x, y2.y); w.w = cvt_pk_bf16(y3.x, y3.y);
                    *(u32x4*)(Y + (size_t)row * LDO + col) = w;
                }
            }
        asm volatile("" ::: "memory"); __builtin_amdgcn_s_barrier(); asm volatile("" ::: "memory");
    }
};

struct EpiSiluG {
    const LAS float* RSL; bf16_t* G; int ldg;
    __device__ __forceinline__ void operator()(const f32x4 (&acc)[2][2][4][2], const pg8::Unit& u, int wr, int wc, int fr, int fq) const {
        float rsv[8]; ROWS8_RS(rsv);
#pragma unroll
        for (int ai = 0; ai < 2; ++ai)
#pragma unroll
            for (int m = 0; m < 4; ++m) {
                const int row = u.pm * 256 + ai * 128 + wr * 64 + m * 16 + fr; const float rs = rsv[ai * 4 + m], c1 = rs * -1.4426950408889634f;
#pragma unroll
                for (int bj = 0; bj < 2; ++bj) { const f32x4 g0 = acc[ai][bj][m][0], g1 = acc[ai][bj][m][1]; const f32x2 one = (f32x2){1.f, 1.f};
                    const f32x2 y0 = pk_silu_mul((f32x2){g0[0], g0[1]}, one, c1, rs), y1 = pk_silu_mul((f32x2){g0[2], g0[3]}, one, c1, rs);
                    const f32x2 y2 = pk_silu_mul((f32x2){g1[0], g1[1]}, one, c1, rs), y3 = pk_silu_mul((f32x2){g1[2], g1[3]}, one, c1, rs);
                    u32x4 w; w.x = cvt_pk_bf16(y0.x, y0.y); w.y = cvt_pk_bf16(y1.x, y1.y); w.z = cvt_pk_bf16(y2.x, y2.y); w.w = cvt_pk_bf16(y3.x, y3.y);
                    *(u32x4*)(G + (size_t)row * ldg + u.pn * 256 + bj * 128 + wc * 32 + 8 * fq) = w; }
            }
    }
};
struct EpiGlaIn {
    const LAS float* RSL; const float* BC; bf16_t* QH; bf16_t* KH; bf16_t* VT;
    __device__ __forceinline__ void operator()(const f32x4 (&acc)[2][2][4][2], const pg8::Unit& u, int wr, int wc, int fr, int fq) const {
        if (u.pn < 4) {
            const bool isq = u.pn < 2; bf16_t* dst = isq ? QH : KH;
            float rsv[8]; ROWS8_RS(rsv);
#pragma unroll
            for (int ai = 0; ai < 2; ++ai)
#pragma unroll
                for (int m = 0; m < 4; ++m) {
                    const int row = u.pm * 256 + ai * 128 + wr * 64 + m * 16 + fr; const float rs = rsv[ai * 4 + m] * (isq ? 0.08838834764831845f : 1.0f);
                    const int b = row >> 13, t = row & 8191;
#pragma unroll
                    for (int bj = 0; bj < 2; ++bj) {
                        const int cq = (u.pn & 1) * 256 + bj * 128 + wc * 32 + 8 * fq; const int head = cq >> 7, d = cq & 127;
                        const f32x4 c0 = *(const f32x4*)(BC + (size_t)row * 512 + cq), c1 = *(const f32x4*)(BC + (size_t)row * 512 + cq + 4);
                        float v[8];
#pragma unroll
                        for (int j = 0; j < 4; ++j) { v[j] = acc[ai][bj][m][0][j] * rs * __expf(isq ? c0[j] : -c0[j]); v[4 + j] = acc[ai][bj][m][1][j] * rs * __expf(isq ? c1[j] : -c1[j]); }
                        u32x4 w; w.x = cvt_pk_bf16(v[0], v[1]); w.y = cvt_pk_bf16(v[2], v[3]); w.z = cvt_pk_bf16(v[4], v[5]); w.w = cvt_pk_bf16(v[6], v[7]);
                        *(u32x4*)(dst + ((size_t)(b * 4 + head) * SEQ + t) * 128 + d) = w;
                    }
                }
        } else {
            float rs[2][8];
            COLS16_RS(rs);
            const int b = u.pm >> 5, t0 = (u.pm & 31) * 256; const int head = u.pn - 4;
#pragma unroll
            for (int ai = 0; ai < 2; ++ai)
#pragma unroll
                for (int m = 0; m < 4; ++m) {
                    const int dvi = ai * 128 + wr * 64 + m * 16 + fr;
                    bf16_t* p = VT + ((size_t)(b * 4 + head) * 256 + dvi) * SEQ + t0 + wc * 32 + 8 * fq;
#pragma unroll
                    for (int bj = 0; bj < 2; ++bj) {
                        const f32x4 v0 = acc[ai][bj][m][0], v1 = acc[ai][bj][m][1];
                        u32x4 w; w.x = cvt_pk_bf16(v0[0] * rs[bj][0], v0[1] * rs[bj][1]); w.y = cvt_pk_bf16(v0[2] * rs[bj][2], v0[3] * rs[bj][3]);
                        w.z = cvt_pk_bf16(v1[0] * rs[bj][4], v1[1] * rs[bj][5]); w.w = cvt_pk_bf16(v1[2] * rs[bj][6], v1[3] * rs[bj][7]);
                        *(u32x4*)(p + bj * 128) = w;
                    }
                }
        }
    }
};

struct EpiRetInP {
    const LAS float* RSL; bf16_t* AQ; bf16_t* KM; bf16_t* KT; bf16_t* BV;
    __device__ __forceinline__ void operator()(const f32x4 (&acc)[2][2][4][2], const pg8::Unit& u, int wr, int wc, int fr, int fq) const {
        if (u.pn < 8) {
            const bool isq = u.pn < 4; const int head = u.pn & 3;
            const float l2g = isq ? L2G[head] : -L2G[head], sc = isq ? 1.0f : 0.0625f;
            float inv[8]; int ez_ = 0; asm volatile("" : "+v"(ez_));
#pragma unroll
            for (int e = 0; e < 8; ++e) inv[e] = ROPE_INV[wc * 32 + 8 * fq + e + ez_];
            float rsv[8]; ROWS8_RS(rsv);
#pragma unroll
            for (int ai = 0; ai < 2; ++ai)
#pragma unroll
                for (int m = 0; m < 4; ++m) {
                    const int row = u.pm * 256 + ai * 128 + wr * 64 + m * 16 + fr; const float rs = rsv[ai * 4 + m];
                    const int b = row >> 13, t = row & 8191, c = t >> 8, i = t & 255; const float pos = (float)(t + NMETA);
                    const float dec = __builtin_amdgcn_exp2f((float)(i + 1) * l2g) * sc * rs;
                    float o1[8], o2[8];
#pragma unroll
                    for (int n = 0; n < 2; ++n)
#pragma unroll
                        for (int j = 0; j < 4; ++j) { const int e = 4 * n + j;
                            const float rev = (pos * inv[e]) * 0.15915494309189535f; const float frc = rev - floorf(rev);
                            const float sn = __builtin_amdgcn_sinf(frc), cs = __builtin_amdgcn_cosf(frc);
                            const float t1 = acc[ai][0][m][n][j], t2 = acc[ai][1][m][n][j];
                            o1[e] = (t1 * cs - t2 * sn) * dec; o2[e] = (t1 * sn + t2 * cs) * dec; }
                    const size_t bhc = (size_t)((b * 4 + head) * 32 + c); const int d = wc * 32 + 8 * fq;
                    u32x4 w1, w2; w1.x = cvt_pk_bf16(o1[0], o1[1]); w1.y = cvt_pk_bf16(o1[2], o1[3]); w1.z = cvt_pk_bf16(o1[4], o1[5]); w1.w = cvt_pk_bf16(o1[6], o1[7]);
                    w2.x = cvt_pk_bf16(o2[0], o2[1]); w2.y = cvt_pk_bf16(o2[2], o2[3]); w2.z = cvt_pk_bf16(o2[4], o2[5]); w2.w = cvt_pk_bf16(o2[6], o2[7]);
                    if (isq) { bf16_t* p = AQ + (bhc * 256 + i) * 512 + 256 + d; *(u32x4*)p = w1; *(u32x4*)(p + 128) = w2; }
                    else { bf16_t* p = KM + (bhc * 256 + i) * 256 + d; *(u32x4*)p = w1; *(u32x4*)(p + 128) = w2;
                        int iz = i; asm volatile("" : "+v"(iz));
                        bf16_t* q = KT + (bhc * 256 + d) * 256 + iz; bf16_t* q2 = q + (size_t)128 * 256;
#pragma unroll
                        for (int e = 0; e < 8; ++e) { q[e * 256] = f2bf(o1[e]); q2[e * 256] = f2bf(o2[e]); } }
                }
        } else {
            float rs[2][8];
            COLS16_RS(rs);
            const int b = u.pm >> 5, c = u.pm & 31;
#pragma unroll
            for (int ai = 0; ai < 2; ++ai)
#pragma unroll
                for (int m = 0; m < 4; ++m) {
                    const int vc = (u.pn - 8) * 256 + ai * 128 + wr * 64 + m * 16 + fr; const int head = vc >> 9, v = vc & 511;
                    bf16_t* p = BV + (((size_t)((b * 4 + head) * 32 + c)) * 512 + v) * 512 + wc * 32 + 8 * fq;
#pragma unroll
                    for (int bj = 0; bj < 2; ++bj) {
                        const f32x4 v0 = acc[ai][bj][m][0], v1 = acc[ai][bj][m][1];
                        u32x4 w; w.x = cvt_pk_bf16(v0[0] * rs[bj][0], v0[1] * rs[bj][1]); w.y = cvt_pk_bf16(v0[2] * rs[bj][2], v0[3] * rs[bj][3]);
                        w.z = cvt_pk_bf16(v1[0] * rs[bj][4], v1[1] * rs[bj][5]); w.w = cvt_pk_bf16(v1[2] * rs[bj][6], v1[3] * rs[bj][7]);
                        *(u32x4*)(p + bj * 128) = w;
                    }
                }
        }
    }
};
struct PtrPA { const char* AQ; const char* KM; const char* KT; const char* BV;
    __device__ __forceinline__ void ptrs(const pg8::Unit& u, const char*& cA, const char*& cB) const {
        if (u.pm < 256) { const size_t bhc = (size_t)u.pm; cA = AQ + (bhc * 256 * 512 + 256) * 2; cB = KM + bhc * 256 * 256 * 2; }
        else { const int l = u.pm - 256; const size_t bhc = (size_t)(l >> 1); cA = BV + (bhc * 512 + (size_t)(l & 1) * 256) * 512 * 2; cB = KT + bhc * 256 * 256 * 2; } } };
struct EpiPA {
    bf16_t* AQ; bf16_t* BV;
    __device__ __forceinline__ void operator()(const f32x4 (&acc)[2][2][4][2], const pg8::Unit& u, int wr, int wc, int fr, int fq) const {
        const bool isP = u.pm < 256; const int l = u.pm - 256; const size_t bhc = isP ? (size_t)u.pm : (size_t)(l >> 1); const int half = l & 1;
#pragma unroll
        for (int ai = 0; ai < 2; ++ai)
#pragma unroll
            for (int m = 0; m < 4; ++m) { const int r = ai * 128 + wr * 64 + m * 16 + fr; int rz = r; asm volatile("" : "+v"(rz));
#pragma unroll
                for (int bj = 0; bj < 2; ++bj) { const int c0 = bj * 128 + wc * 32 + 8 * fq; const f32x4 a0 = acc[ai][bj][m][0], a1 = acc[ai][bj][m][1];
                    float v[8] = {a0[0], a0[1], a0[2], a0[3], a1[0], a1[1], a1[2], a1[3]};
                    if (isP) {
#pragma unroll
                        for (int e = 0; e < 8; ++e) { const int keep = (c0 + e - rz - 1) >> 31; v[e] = __int_as_float(__float_as_int(v[e]) & keep); } }
                    u32x4 w; w.x = cvt_pk_bf16(v[0], v[1]); w.y = cvt_pk_bf16(v[2], v[3]); w.z = cvt_pk_bf16(v[4], v[5]); w.w = cvt_pk_bf16(v[6], v[7]);
                    if (isP) *(u32x4*)(AQ + (bhc * 256 + r) * 512 + c0) = w;
                    else *(u32x4*)(BV + (bhc * 512 + half * 256 + r) * 512 + 256 + c0) = w; } }
    }
};
struct Ptr3 { const char* AQ; const char* BV;
    __device__ __forceinline__ void ptrs(const pg8::Unit& u, const char*& cA, const char*& cB) const { const size_t bhc = (size_t)(u.pm >> 1);
        cA = AQ + bhc * 256 * 512 * 2; cB = BV + (bhc * 512 + (size_t)(u.pm & 1) * 256) * 512 * 2; } };
struct Epi3 {
    bf16_t* O;
    __device__ __forceinline__ void operator()(const f32x4 (&acc)[2][2][4][2], const pg8::Unit& u, int wr, int wc, int fr, int fq) const {
        const int bhc = u.pm >> 1, half = u.pm & 1, bh = bhc >> 5, c = bhc & 31, b = bh >> 2, h = bh & 3;
#pragma unroll
        for (int ai = 0; ai < 2; ++ai)
#pragma unroll
            for (int m = 0; m < 4; ++m) { const int i = ai * 128 + wr * 64 + m * 16 + fr; bf16_t* p = O + ((size_t)b * SEQ + c * 256 + i) * 2048 + h * 512 + half * 256 + wc * 32 + 8 * fq;
#pragma unroll
                for (int bj = 0; bj < 2; ++bj) { const f32x4 a0 = acc[ai][bj][m][0], a1 = acc[ai][bj][m][1];
                    u32x4 w; w.x = cvt_pk_bf16(a0[0], a0[1]); w.y = cvt_pk_bf16(a0[2], a0[3]); w.z = cvt_pk_bf16(a1[0], a1[1]); w.w = cvt_pk_bf16(a1[2], a1[3]);
                    *(u32x4*)(p + bj * 128) = w; } }
    }
};
struct PtrNormal { const char* A; const char* B; size_t tstep;
    __device__ __forceinline__ void ptrs(const pg8::Unit& u, const char*& cA, const char*& cB) const { cA = A + (size_t)u.pm * tstep; cB = B + (size_t)u.pn * tstep; } };
struct PtrSwapFrom { const char* A; const char* B; size_t tstep; int pn_swap;
    __device__ __forceinline__ void ptrs(const pg8::Unit& u, const char*& cA, const char*& cB) const {
        const char* a = A + (size_t)u.pm * tstep; const char* b = B + (size_t)u.pn * tstep;
        if (u.pn >= pn_swap) { cA = b; cB = a; } else { cA = a; cB = b; } } };

constexpr int MA_RS_OFF = 98304, MA_RED_OFF = 100352;
template <int MODE> __device__ __forceinline__ void meta_tiles(Frame& F, const bf16_t* Bt, int N, int K, float* out, int ldo, float alpha, int b0, int nb) {
    const int lane = F.lane, g = lane >> 4, r16 = lane & 15, pitch = K + 8;
    const LAS bf16_t* A = (const LAS bf16_t*)F.lds; const LAS float* rsA = (const LAS float*)(F.lds + MA_RS_OFF); LAS f32x4* red = (LAS f32x4*)(F.lds + MA_RED_OFF);
    const int ksteps = K / 32, per = ksteps / 8;
    for (int tile = F.vb - b0; tile < N / 16; tile += nb) {
        f32x4 acc = (f32x4){0.f, 0.f, 0.f, 0.f};
        const bf16_t* bp = Bt + (size_t)(tile * 16 + r16) * K + 8 * g;
        for (int ks = F.wave * per; ks < (F.wave + 1) * per; ++ks) {
            const bf16x8 a = *(const LAS bf16x8*)(A + r16 * pitch + ks * 32 + 8 * g);
            const bf16x8 b = *(const bf16x8*)(bp + ks * 32);
            acc = __builtin_amdgcn_mfma_f32_16x16x32_bf16(a, b, acc, 0, 0, 0);
        }
        red[F.wave * 64 + lane] = acc;
        __syncthreads();
        if (F.wave == 0) {
            f32x4 s = red[lane];
#pragma unroll
            for (int w = 1; w < 8; ++w) s += red[w * 64 + lane];
#pragma unroll
            for (int j = 0; j < 4; ++j) { const int r = 4 * g + j; float* o = out + (size_t)r * ldo + tile * 16 + r16;
                if (MODE == 0) *o = s[j] * rsA[r]; else *o = *o + alpha * s[j]; }
        }
        __syncthreads();
    }
}
__device__ __forceinline__ bool meta_has_tiles(Frame& F, int N, int b0, int nb) { const int r = F.vb - b0; return r >= 0 && r < nb && r < N / 16; }
__device__ __forceinline__ void meta_prep_h(Frame& F) {
    const float* HM = WSP(float, WS_META + META_HM); LAS bf16_t* A = (LAS bf16_t*)F.lds; LAS float* rsA = (LAS float*)(F.lds + MA_RS_OFF);
    for (int r = F.wave; r < 16; r += 8) { float s = 0.f;
        for (int k = F.lane; k < D; k += 64) { const float v = HM[r * D + k]; s += v * v; A[r * (D + 8) + k] = f2bf(v); }
        s = wave_sum(s); if (F.lane == 0) rsA[r] = 1.0f / sqrtf(s * (1.0f / 1024.0f) + 1e-6f); }
    __syncthreads();
}
__device__ __forceinline__ void meta_prep_act(Frame& F) {
    const float* RAW = WSP(float, WS_META + META_RAW); LAS bf16_t* A = (LAS bf16_t*)F.lds; LAS float* rsA = (LAS float*)(F.lds + MA_RS_OFF);
    for (int i = F.tid; i < 16 * DFF; i += NTHREADS) { const int r = i / DFF, k = i % DFF, u = k >> 7, j = k & 127;
        const float g = RAW[r * 5632 + u * 256 + j], up = RAW[r * 5632 + u * 256 + 128 + j]; A[r * (DFF + 8) + k] = f2bf(fsilu(g) * up); }
    if (F.tid < 16) rsA[F.tid] = 1.f;
    __syncthreads();
}
__device__ __forceinline__ void meta_prep_y(Frame& F) {
    const float* RAW = WSP(float, WS_META + META_RAW); const float* MO = WSP(float, WS_META + META_MO);
    LAS bf16_t* A = (LAS bf16_t*)F.lds; LAS float* rsA = (LAS float*)(F.lds + MA_RS_OFF); LAS float* mro = (LAS float*)(F.lds + MA_RED_OFF);
    for (int p = F.wave; p < 64; p += 8) { const int r = p >> 2, head = p & 3; float sacc = 0.f;
        for (int k = F.lane; k < 512; k += 64) { const float v = MO[r * 2048 + head * 512 + k]; sacc += v * v; }
        sacc = wave_sum(sacc); if (F.lane == 0) mro[p] = 1.0f / sqrtf(sacc * (1.0f / 512.0f) + 1e-6f); }
    __syncthreads();
    for (int i = F.tid; i < 16 * 2048; i += NTHREADS) { const int r = i >> 11, k = i & 2047, head = k >> 9;
        A[r * (2048 + 8) + k] = f2bf(MO[r * 2048 + k] * mro[r * 4 + head] * fsilu(RAW[r * 6144 + 4096 + k])); }
    if (F.tid < 16) rsA[F.tid] = 1.f;
    __syncthreads();
}

__device__ __forceinline__ void meta_tiles_ksplit(Frame& F, const bf16_t* Bt, int K, int KQ, float* out, float alpha) {
    const int lane = F.lane, g = lane >> 4, r16 = lane & 15, pitch = KQ + 8;
    const LAS bf16_t* A = (const LAS bf16_t*)F.lds; LAS f32x4* red = (LAS f32x4*)(F.lds + MA_RED_OFF);
    const int item = F.vb; if (item >= 256) return;
    const int tile = item >> 2, kq = item & 3, nks = KQ / 32;
    f32x4 acc = (f32x4){0.f, 0.f, 0.f, 0.f};
    const bf16_t* bp = Bt + (size_t)(tile * 16 + r16) * K + kq * KQ + 8 * g;
    for (int ks = F.wave; ks < nks; ks += 8) {
        const bf16x8 a = *(const LAS bf16x8*)(A + r16 * pitch + ks * 32 + 8 * g);
        const bf16x8 b = *(const bf16x8*)(bp + ks * 32);
        acc = __builtin_amdgcn_mfma_f32_16x16x32_bf16(a, b, acc, 0, 0, 0);
    }
    red[F.wave * 64 + lane] = acc;
    __syncthreads();
    if (F.wave == 0) { f32x4 sacc = red[lane];
#pragma unroll
        for (int w = 1; w < 8; ++w) sacc += red[w * 64 + lane];
#pragma unroll
        for (int j = 0; j < 4; ++j) atomicAdd(out + (size_t)(4 * g + j) * D + tile * 16 + r16, alpha * sacc[j]); }
    __syncthreads();
}
__device__ __forceinline__ void meta_prep_act_q(Frame& F) {
    const float* RAW = WSP(float, WS_META + META_RAW); LAS bf16_t* A = (LAS bf16_t*)F.lds; const int kq = F.vb & 3;
    for (int i = F.tid; i < 16 * 704; i += NTHREADS) { const int r = i / 704, kk = i % 704, k = kq * 704 + kk, u = k >> 7, j = k & 127;
        const float gt = RAW[r * 5632 + u * 256 + j], up = RAW[r * 5632 + u * 256 + 128 + j]; A[r * (704 + 8) + kk] = f2bf(fsilu(gt) * up); }
    __syncthreads();
}
__device__ __forceinline__ void meta_prep_y_q(Frame& F) {
    const float* RAW = WSP(float, WS_META + META_RAW); const float* MO = WSP(float, WS_META + META_MO);
    LAS bf16_t* A = (LAS bf16_t*)F.lds; LAS float* mro = (LAS float*)(F.lds + MA_RED_OFF); const int head = F.vb & 3;
    for (int r = F.wave; r < 16; r += 8) { float sacc = 0.f;
        for (int k = F.lane; k < 512; k += 64) { const float v = MO[r * 2048 + head * 512 + k]; sacc += v * v; }
        sacc = wave_sum(sacc); if (F.lane == 0) mro[r] = 1.0f / sqrtf(sacc * (1.0f / 512.0f) + 1e-6f); }
    __syncthreads();
    for (int i = F.tid; i < 16 * 512; i += NTHREADS) { const int r = i >> 9, kk = i & 511, k = head * 512 + kk;
        A[r * (512 + 8) + kk] = f2bf(MO[r * 2048 + k] * mro[r] * fsilu(RAW[r * 6144 + 4096 + k])); }
    __syncthreads();
}
__device__ __forceinline__ void z_phase(Frame& F, const bf16_t* HB, const float* SS, const bf16_t* WZ, const float* wg, const float* bg, float* BC) {
    LAS float* zpart = (LAS float*)F.lds;
    LAS float* zs = (LAS float*)(F.lds + 8192);
    const int lane = F.lane, g = lane >> 4, r16 = lane & 15;
    for (int cidx = blockIdx.x; cidx < M / 64; cidx += F.G) {
        const int row0 = cidx * 64;
        { const int tile = F.wave & 3, kh = F.wave >> 2; f32x4 acc = (f32x4){0.f, 0.f, 0.f, 0.f};
          const bf16_t* ap = HB + (size_t)(row0 + tile * 16 + r16) * D + 8 * g; const bf16_t* bp = WZ + (size_t)r16 * D + 8 * g;
#pragma unroll
          for (int ks = kh * 16; ks < kh * 16 + 16; ++ks) {
              const bf16x8 a = *(const bf16x8*)(ap + ks * 32), b = *(const bf16x8*)(bp + ks * 32);
              acc = __builtin_amdgcn_mfma_f32_16x16x32_bf16(a, b, acc, 0, 0, 0);
          }
#pragma unroll
          for (int j = 0; j < 4; ++j) zpart[(kh * 64 + tile * 16 + 4 * g + j) * 16 + r16] = acc[j]; }
        __syncthreads();
        for (int i = F.tid; i < 64 * 16; i += NTHREADS) { const int t = i >> 4; zs[i] = (zpart[i] + zpart[1024 + i]) * row_rstd(SS, row0 + t); }
        __syncthreads();
        { const int c = F.tid; float w[16];
#pragma unroll
          for (int r = 0; r < 16; ++r) w[r] = wg[r * 512 + c];
          const float bias = bg[c]; float cum = 0.f;
          for (int t = 0; t < 64; ++t) { float a = bias; if (t == 32) cum = 0.f;
              const f32x4 z0 = *(const LAS f32x4*)(zs + t * 16), z1 = *(const LAS f32x4*)(zs + t * 16 + 4), z2 = *(const LAS f32x4*)(zs + t * 16 + 8), z3 = *(const LAS f32x4*)(zs + t * 16 + 12);
#pragma unroll
              for (int r = 0; r < 4; ++r) a += z0[r] * w[r] + z1[r] * w[4 + r] + z2[r] * w[8 + r] + z3[r] * w[12 + r];
              const float ls = fminf(a, 0.f) - __logf(1.0f + __expf(-fabsf(a)));
              cum += ls * 0.0625f; BC[(size_t)(row0 + t) * 512 + c] = cum; } }
        __syncthreads();
    }
}

typedef short v4i16_t __attribute__((ext_vector_type(4)));
__device__ __forceinline__ s16x4 ds_tr_asm(unsigned addr) { s16x4 r; asm volatile("ds_read_b64_tr_b16 %0, %1" : "=v"(r) : "v"(addr) : "memory"); return r; }
__device__ __forceinline__ s16x4 ds_tr(const LAS unsigned char* p) { return __builtin_bit_cast(s16x4, __builtin_amdgcn_ds_read_tr16_b64_v4i16((LAS v4i16_t*)p)); }
template <int DK, int DV, bool GLA>
__device__ __forceinline__ void s2v6_phase(Frame& F, const int unit, const bf16_t* QH, const bf16_t* KH, const bf16_t* VT, bf16_t* O, const float* BC, int ldraw) {
    constexpr int NS = DV / 16, ROWB = DK * 2, TILEB = 32 * ROWB, NIL = TILEB / 1024 / 4, LDO = 4 * DV, KS = DK / 32, NSTEP = 257, NLO = DK / 128, NHI = DK / 32 - NLO;
    constexpr int LK = 0, LQ = 3 * TILEB, LV = 6 * TILEB, LDEC = LV + 3 * 1024, LP = LDEC + 3 * 1024, LS = LP + 2 * 2048, LEND = LS + 2 * 16 * ROWB;
    static_assert(LEND <= LDS_MISC, "S2 LDS map");
    if (unit >= 8 * NS) return;
    const int bh = unit & 7, s = unit >> 3, b = bh >> 2, h = bh & 3;
    const int lane = F.lane, g = lane >> 4, r16 = lane & 15, w = F.wave, li = w & 3, hf = w >> 2, qi = li >> 1, kj = li & 1;
    LAS unsigned char* L = F.lds; const unsigned Lb = (unsigned)(uintptr_t)L;
    const float* RAW = WSP(float, WS_META + META_RAW);
    const char* Qg = (const char*)(QH + (size_t)bh * SEQ * DK); const char* Kg = (const char*)(KH + (size_t)bh * SEQ * DK);
    const char* Vg = (const char*)(VT + ((size_t)bh * DV + 16 * s) * SEQ);
    u32x4 ra[2 * NIL + 1], rb[2 * NIL + 1], rc[2 * NIL + 1];
#pragma unroll
    for (int i = 0; i < 2 * NIL + 1; ++i) { ra[i] = (u32x4){0, 0, 0, 0}; rb[i] = ra[i]; rc[i] = ra[i]; }
#define S6_LOAD(c_, R) do { const int rc_ = ((c_) - 1 < 255) ? (c_) - 1 : 255; const char* kc_ = Kg + (size_t)rc_ * TILEB; const char* qc_ = Qg + (size_t)rc_ * TILEB; \
        _Pragma("unroll") for (int i_ = 0; i_ < NIL; ++i_) { const int piece_ = li * NIL + i_, off_ = piece_ * 1024 + lane * 16, row_ = off_ / ROWB, p_ = (off_ % ROWB) >> 4; const int so_ = row_ * ROWB + ((p_ ^ (row_ & 15)) << 4); \
            R[i_] = *(const u32x4*)(kc_ + so_); R[NIL + i_] = *(const u32x4*)(qc_ + so_); } \
        if (li == 0) { const int wv_ = lane >> 2, p_ = lane & 3; R[2 * NIL] = *(const u32x4*)(Vg + (size_t)wv_ * SEQ * 2 + (size_t)rc_ * 64 + ((p_ ^ ((wv_ >> 2) & 3)) << 4)); } \
        if (GLA && li == 1) R[2 * NIL] = *(const u32x4*)((const char*)(BC + (size_t)(b * SEQ + rc_ * 32 + 31) * 512 + h * 128) + lane * 16); } while (0)
#define S6_WRITE(st_, R) do { \
        _Pragma("unroll") for (int i_ = 0; i_ < NIL; ++i_) { const int piece_ = li * NIL + i_; \
            *(LAS u32x4*)(L + LK + (st_) * TILEB + piece_ * 1024 + lane * 16) = R[i_]; *(LAS u32x4*)(L + LQ + (st_) * TILEB + piece_ * 1024 + lane * 16) = R[NIL + i_]; } \
        if (li == 0) *(LAS u32x4*)(L + LV + (st_) * 1024 + lane * 16) = R[2 * NIL]; \
        if (GLA && li == 1) *(LAS u32x4*)(L + LDEC + (st_) * 1024 + lane * 16) = R[2 * NIL]; } while (0)
#define S6_PT(st_, pb_) do { f32x4 pa = (f32x4){0.f, 0.f, 0.f, 0.f}, pc = pa; \
        if (kj <= qi) { const LAS unsigned char* kb = L + LK + (st_) * TILEB + (16 * kj + r16) * ROWB; const LAS unsigned char* qb = L + LQ + (st_) * TILEB + (16 * qi + r16) * ROWB; \
            _Pragma("unroll") for (int ks = 0; ks < KS; ks += 2) { const int ch0 = ((4 * ks + g) ^ r16) << 4, ch1 = ((4 * (ks + 1) + g) ^ r16) << 4; \
                const bf16x8 k0 = *(const LAS bf16x8*)(kb + ch0), q0 = *(const LAS bf16x8*)(qb + ch0), k1 = *(const LAS bf16x8*)(kb + ch1), q1 = *(const LAS bf16x8*)(qb + ch1); \
                pa = __builtin_amdgcn_mfma_f32_16x16x32_bf16(k0, q0, pa, 0, 0, 0); pc = __builtin_amdgcn_mfma_f32_16x16x32_bf16(k1, q1, pc, 0, 0, 0); } } \
        const f32x4 pt = pa + pc; const int i = 16 * qi + r16, j0 = 16 * kj + 4 * g; \
        const float v0 = (j0 + 0 <= i) ? pt[0] : 0.f, v1 = (j0 + 1 <= i) ? pt[1] : 0.f, v2 = (j0 + 2 <= i) ? pt[2] : 0.f, v3 = (j0 + 3 <= i) ? pt[3] : 0.f; \
        u32x2 pk; pk.x = cvt_pk_bf16(v0, v1); pk.y = cvt_pk_bf16(v2, v3); \
        *(LAS u32x2*)(L + LP + (pb_) * 2048 + i * 64 + (((2 * kj + (g >> 1)) ^ ((i >> 2) & 3)) << 4) + (g & 1) * 8) = pk; } while (0)
    for (int i = F.tid * 16; i < TILEB; i += NTHREADS * 16) { *(LAS u32x4*)(L + LK + i) = (u32x4){0, 0, 0, 0}; *(LAS u32x4*)(L + LQ + i) = (u32x4){0, 0, 0, 0}; }
    for (int i = F.tid * 16; i < 1024; i += NTHREADS * 16) *(LAS u32x4*)(L + LV + i) = (u32x4){0, 0, 0, 0};
    for (int i = F.tid * 16; i < 16 * ROWB; i += NTHREADS * 16) *(LAS u32x4*)(L + LS + i) = (u32x4){0, 0, 0, 0};
    __syncthreads();
    if (!GLA) {
        for (int idx = F.tid; idx < 16 * 128; idx += NTHREADS) { const int j = idx >> 7, c = idx & 127, row = 16 + j;
            const float* rq = RAW + (size_t)j * ldraw + h * 256; const float* rk = rq + 1024;
            const float rev = ((float)j * ROPE_INV[c]) * 0.15915494309189535f; const float frc = rev - floorf(rev);
            const float sn = __builtin_amdgcn_sinf(frc), cs = __builtin_amdgcn_cosf(frc);
            const float dq = __builtin_amdgcn_exp2f((float)(row + 1) * L2G[h]), dk = 0.0625f * __builtin_amdgcn_exp2f(-(float)(row + 1) * L2G[h]);
            const float q1v = rq[c], q2v = rq[c + 128], k1 = rk[c], k2 = rk[c + 128];
            const int a1 = row * ROWB + ((((c >> 3)) ^ (row & 15)) << 4) + (c & 7) * 2, a2 = row * ROWB + ((((c + 128) >> 3) ^ (row & 15)) << 4) + (c & 7) * 2;
            *(LAS bf16_t*)(L + LQ + a1) = f2bf((q1v * cs - q2v * sn) * dq); *(LAS bf16_t*)(L + LQ + a2) = f2bf((q1v * sn + q2v * cs) * dq);
            *(LAS bf16_t*)(L + LK + a1) = f2bf((k1 * cs - k2 * sn) * dk); *(LAS bf16_t*)(L + LK + a2) = f2bf((k1 * sn + k2 * cs) * dk); }
        if (F.tid < 256) { const int j = F.tid >> 4, wv = F.tid & 15, tok = 16 + j;
            *(LAS bf16_t*)(L + LV + wv * 64 + (((tok >> 3) ^ ((wv >> 2) & 3)) << 4) + (tok & 7) * 2) = f2bf(RAW[(size_t)j * ldraw + 2048 + h * 512 + 16 * s + wv]); }
    } else {
        if (F.tid < 128) { const int d = F.tid; const float* wgp = F.in[13] + h * 128 + d; const float bias = F.in[14][h * 128 + d]; float cum = 0.f;
            for (int j = 0; j < 16; ++j) { float a = bias;
                for (int r = 0; r < 16; ++r) a += RAW[(size_t)j * ldraw + 3072 + r] * wgp[r * 512];
                cum += (fminf(a, 0.f) - __logf(1.0f + __expf(-fabsf(a)))) * 0.0625f;
                const int row = 16 + j;
                *(LAS bf16_t*)(L + LK + row * ROWB + (((d >> 3) ^ (row & 15)) << 4) + (d & 7) * 2) = f2bf(RAW[(size_t)j * ldraw + 512 + h * 128 + d] * __expf(-cum)); }
            *(LAS float*)(L + LDEC + d * 4) = cum; }
        if (F.tid >= 256) { const int j = (F.tid - 256) >> 4, wv = F.tid & 15, tok = 16 + j;
            *(LAS bf16_t*)(L + LV + wv * 64 + (((tok >> 3) ^ ((wv >> 2) & 3)) << 4) + (tok & 7) * 2) = f2bf(RAW[(size_t)j * ldraw + 1024 + h * 256 + 16 * s + wv]); }
    }
    const float g32 = GLA ? 1.0f : __builtin_amdgcn_exp2f(32.0f * L2G[h]);
    if (hf) { S6_LOAD(1, ra); S6_WRITE(1, ra); }
    __syncthreads();
    if (hf) { S6_PT(0, 0); S6_LOAD(2, rb); S6_LOAD(3, rc); }
    __syncthreads();
    if (hf) {
#define S6_ODD(t_, RL, RW) do { const int t = (t_); S6_LOAD(t + 4, RL); if (t + 1 < NSTEP) S6_PT(s1, (t + 1) & 1); S6_WRITE(s2, RW); \
            LDS_WAIT(); __builtin_amdgcn_s_barrier(); asm volatile("" ::: "memory"); { const int o_ = s0; s0 = s1; s1 = s2; s2 = o_; } } while (0)
        int s0 = 0, s1 = 1, s2 = 2;
        for (int t3 = 0; t3 < 255; t3 += 3) { S6_ODD(t3, ra, rb); S6_ODD(t3 + 1, rb, rc); S6_ODD(t3 + 2, rc, ra); }
        S6_ODD(255, ra, rb); S6_ODD(256, rb, rc);
#undef S6_ODD
    } else {
        f32x4 S[NHI];
#pragma unroll
        for (int tt = 0; tt < NHI; ++tt) S[tt] = (f32x4){0.f, 0.f, 0.f, 0.f};
        int s0 = 0;
        for (int t = 0; t < NSTEP; ++t) { const int sb = t & 1;
            { s16x4 klo[NHI], khi[NHI];
              const bf16x8 vb = *(const LAS bf16x8*)(L + LV + s0 * 1024 + r16 * 64 + ((g ^ ((r16 >> 2) & 3)) << 4));
#pragma unroll
              for (int tt = 0; tt < NHI; ++tt) if (li >= 2 || tt < NLO) { const int tile = (li < 2) ? li + 2 * tt : 2 * NLO + (li - 2) + 2 * tt, d0 = 16 * tile, dcol = d0 + 4 * (r16 & 3), chunk = dcol >> 3, sub = (dcol & 7) * 2;
                  const int r1 = 8 * g + (r16 >> 2), r2 = r1 + 4;
                  klo[tt] = ds_tr_asm(Lb + LK + s0 * TILEB + r1 * ROWB + ((chunk ^ (r1 & 15)) << 4) + sub);
                  khi[tt] = ds_tr_asm(Lb + LK + s0 * TILEB + r2 * ROWB + ((chunk ^ (r2 & 15)) << 4) + sub); }
              asm volatile("s_waitcnt lgkmcnt(0)" ::: "memory"); __builtin_amdgcn_sched_barrier(0);
#pragma unroll
              for (int tt = 0; tt < NHI; ++tt) if (li >= 2 || tt < NLO) {
                  const bf16x8 ka = (bf16x8){klo[tt][0], klo[tt][1], klo[tt][2], klo[tt][3], khi[tt][0], khi[tt][1], khi[tt][2], khi[tt][3]};
                  S[tt] = __builtin_amdgcn_mfma_f32_16x16x32_bf16(ka, vb, S[tt], 0, 0, 0); }
#pragma unroll
              for (int tt = 0; tt < NHI; ++tt) if (li >= 2 || tt < NLO) { const int tile = (li < 2) ? li + 2 * tt : 2 * NLO + (li - 2) + 2 * tt;
                  if (GLA) { const f32x4 dl = *(const LAS f32x4*)(L + LDEC + s0 * 1024 + (16 * tile + 4 * g) * 4);
                      S[tt][0] *= __expf(dl[0]); S[tt][1] *= __expf(dl[1]); S[tt][2] *= __expf(dl[2]); S[tt][3] *= __expf(dl[3]); } else S[tt] = S[tt] * g32;
                  u32x2 pk; pk.x = cvt_pk_bf16(S[tt][0], S[tt][1]); pk.y = cvt_pk_bf16(S[tt][2], S[tt][3]);
                  *(LAS u32x2*)(L + LS + (sb ^ 1) * 16 * ROWB + r16 * ROWB + (((2 * tile + (g >> 1)) ^ r16) << 4) + (g & 1) * 8) = pk; } }
            if (li < 2) { const int irow = 16 * li + r16;
                const bf16x8 va = *(const LAS bf16x8*)(L + LV + s0 * 1024 + r16 * 64 + ((g ^ ((r16 >> 2) & 3)) << 4));
                const bf16x8 pb = *(const LAS bf16x8*)(L + LP + sb * 2048 + irow * 64 + ((g ^ ((irow >> 2) & 3)) << 4));
                f32x4 oa = __builtin_amdgcn_mfma_f32_16x16x32_bf16(va, pb, (f32x4){0.f, 0.f, 0.f, 0.f}, 0, 0, 0), ob = (f32x4){0.f, 0.f, 0.f, 0.f};
                const LAS unsigned char* sp = L + LS + sb * 16 * ROWB + r16 * ROWB; const LAS unsigned char* qb = L + LQ + s0 * TILEB + irow * ROWB;
#pragma unroll
                for (int ks = 0; ks < KS; ks += 2) { const int ch0 = ((4 * ks + g) ^ r16) << 4, ch1 = ((4 * (ks + 1) + g) ^ r16) << 4;
                    const bf16x8 sv0 = *(const LAS bf16x8*)(sp + ch0), q0 = *(const LAS bf16x8*)(qb + ch0), sv1 = *(const LAS bf16x8*)(sp + ch1), q1 = *(const LAS bf16x8*)(qb + ch1);
                    oa = __builtin_amdgcn_mfma_f32_16x16x32_bf16(sv0, q0, oa, 0, 0, 0); ob = __builtin_amdgcn_mfma_f32_16x16x32_bf16(sv1, q1, ob, 0, 0, 0); }
                const f32x4 ot = oa + ob;
                if (t >= 1) { const size_t grow = (size_t)b * SEQ + (size_t)(t - 1) * 32 + irow; u32x2 pk; pk.x = cvt_pk_bf16(ot[0], ot[1]); pk.y = cvt_pk_bf16(ot[2], ot[3]);
                    *(u32x2*)(O + grow * LDO + h * DV + 16 * s + 4 * g) = pk; }
                else if (!GLA && b == 0 && irow >= 16) { float* MO = WSP(float, WS_META + META_MO); *(f32x4*)(MO + (size_t)(irow - 16) * 2048 + h * 512 + 16 * s + 4 * g) = ot; } }
            LDS_WAIT(); __builtin_amdgcn_s_barrier(); asm volatile("" ::: "memory");
            s0 = (s0 == 2) ? 0 : s0 + 1;
        }
    }
#undef S6_LOAD
#undef S6_WRITE
#undef S6_PT
}

__device__ __forceinline__ void ret_scan_phase(Frame& F, const int blk, bf16_t* BV) {
    const int bh = blk >> 5, vgrp = blk & 31, b = bh >> 2, h = bh & 3; if (blk >= 256) return;
    LAS float* KMt = (LAS float*)F.lds; LAS float* QMt = KMt + 16 * 256; LAS float* VMt = QMt + 16 * 256; LAS float* SC = VMt + 256;
    const float* RAW = WSP(float, WS_META + META_RAW);
    for (int idx = F.tid; idx < 16 * 128; idx += NTHREADS) { const int j = idx >> 7, c = idx & 127;
        const float* rq = RAW + (size_t)j * 6144 + h * 256; const float* rk = rq + 1024;
        const float rev = ((float)j * ROPE_INV[c]) * 0.15915494309189535f; const float frc = rev - floorf(rev);
        const float sn = __builtin_amdgcn_sinf(frc), cs = __builtin_amdgcn_cosf(frc);
        const float dq = __builtin_amdgcn_exp2f((float)j * L2G[h]), dk = 0.0625f * __builtin_amdgcn_exp2f(-(float)j * L2G[h]);
        const float q1 = rq[c], q2 = rq[c + 128], k1 = rk[c], k2 = rk[c + 128];
        QMt[j * 256 + c] = (q1 * cs - q2 * sn) * dq; QMt[j * 256 + c + 128] = (q1 * sn + q2 * cs) * dq;
        KMt[j * 256 + c] = (k1 * cs - k2 * sn) * dk; KMt[j * 256 + c + 128] = (k1 * sn + k2 * cs) * dk; }
    if (F.tid < 256) VMt[F.tid] = RAW[(size_t)(F.tid >> 4) * 6144 + 2048 + h * 512 + 16 * vgrp + (F.tid & 15)];
    __syncthreads();
    if (b == 0) {
        if (F.tid < 256) { const int j = F.tid >> 4, jp = F.tid & 15; float a = 0.f;
            for (int d = 0; d < 256; ++d) a += QMt[j * 256 + d] * KMt[jp * 256 + d];
            SC[F.tid] = (jp <= j) ? a : 0.f; }
        __syncthreads();
        if (F.tid < 256) { const int j = F.tid >> 4, vv = F.tid & 15; float o = 0.f;
#pragma unroll
            for (int jp = 0; jp < 16; ++jp) o += SC[j * 16 + jp] * VMt[jp * 16 + vv];
            WSP(float, WS_META + META_MO)[(size_t)j * 2048 + h * 512 + 16 * vgrp + vv] = o; }
    }
    const int vloc = F.tid >> 5, d8 = (F.tid & 31) * 8, v = 16 * vgrp + vloc;
    float sacc[8];
    { const float g15 = __builtin_amdgcn_exp2f(15.0f * L2G[h]);
#pragma unroll
      for (int e = 0; e < 8; ++e) sacc[e] = 0.f;
      for (int j = 0; j < 16; ++j) { const float vm = VMt[j * 16 + vloc];
#pragma unroll
          for (int e = 0; e < 8; ++e) sacc[e] += vm * KMt[j * 256 + d8 + e]; }
#pragma unroll
      for (int e = 0; e < 8; ++e) sacc[e] *= g15; }
    const float g256 = __builtin_amdgcn_exp2f(256.0f * L2G[h]);
    bf16_t* slot = BV + (((size_t)bh * 32) * 512 + v) * 512 + 256 + d8;
#pragma unroll 8
    for (int c = 0; c < 32; ++c) { bf16_t* p = slot + (size_t)c * 512 * 512; const u32x4 uv = *(const u32x4*)p;
        u32x4 w; w.x = cvt_pk_bf16(sacc[0], sacc[1]); w.y = cvt_pk_bf16(sacc[2], sacc[3]); w.z = cvt_pk_bf16(sacc[4], sacc[5]); w.w = cvt_pk_bf16(sacc[6], sacc[7]);
        *(u32x4*)p = w;
        sacc[0] = g256 * (sacc[0] + bf_lo(uv.x)); sacc[1] = g256 * (sacc[1] + bf_hi(uv.x)); sacc[2] = g256 * (sacc[2] + bf_lo(uv.y)); sacc[3] = g256 * (sacc[3] + bf_hi(uv.y));
        sacc[4] = g256 * (sacc[4] + bf_lo(uv.z)); sacc[5] = g256 * (sacc[5] + bf_hi(uv.z)); sacc[6] = g256 * (sacc[6] + bf_lo(uv.w)); sacc[7] = g256 * (sacc[7] + bf_hi(uv.w)); }
    __syncthreads();
}

__device__ __forceinline__ void gla_gate_phase(Frame& F, const bf16_t* O, const bf16_t* G, bf16_t* Y) {
    const int gw = F.vcu * NWAVES + F.wave, NGW = F.G * NWAVES; const int head = F.lane >> 4;
    for (int m = gw; m < M; m += NGW) {
        const u32x4 o0 = *(const u32x4*)(O + (size_t)m * 1024 + 16 * F.lane), o1 = *(const u32x4*)(O + (size_t)m * 1024 + 16 * F.lane + 8);
        const u32x4 g0 = *(const u32x4*)(G + (size_t)m * 1024 + 16 * F.lane), g1 = *(const u32x4*)(G + (size_t)m * 1024 + 16 * F.lane + 8);
        float ov[16] = {bf_lo(o0.x), bf_hi(o0.x), bf_lo(o0.y), bf_hi(o0.y), bf_lo(o0.z), bf_hi(o0.z), bf_lo(o0.w), bf_hi(o0.w), bf_lo(o1.x), bf_hi(o1.x), bf_lo(o1.y), bf_hi(o1.y), bf_lo(o1.z), bf_hi(o1.z), bf_lo(o1.w), bf_hi(o1.w)};
        const float gv[16] = {bf_lo(g0.x), bf_hi(g0.x), bf_lo(g0.y), bf_hi(g0.y), bf_lo(g0.z), bf_hi(g0.z), bf_lo(g0.w), bf_hi(g0.w), bf_lo(g1.x), bf_hi(g1.x), bf_lo(g1.y), bf_hi(g1.y), bf_lo(g1.z), bf_hi(g1.z), bf_lo(g1.w), bf_hi(g1.w)};
        float ssum = 0.f;
#pragma unroll
        for (int i = 0; i < 16; ++i) ssum += ov[i] * ov[i];
        ssum += __shfl_xor(ssum, 1); ssum += __shfl_xor(ssum, 2); ssum += __shfl_xor(ssum, 4); ssum += __shfl_xor(ssum, 8);
        const float ro = 1.0f / sqrtf(ssum * (1.0f / 256.0f) + 1e-6f);
        u32x4 y0, y1;
        y0.x = cvt_pk_bf16(ov[0] * ro * gv[0], ov[1] * ro * gv[1]); y0.y = cvt_pk_bf16(ov[2] * ro * gv[2], ov[3] * ro * gv[3]); y0.z = cvt_pk_bf16(ov[4] * ro * gv[4], ov[5] * ro * gv[5]); y0.w = cvt_pk_bf16(ov[6] * ro * gv[6], ov[7] * ro * gv[7]);
        y1.x = cvt_pk_bf16(ov[8] * ro * gv[8], ov[9] * ro * gv[9]); y1.y = cvt_pk_bf16(ov[10] * ro * gv[10], ov[11] * ro * gv[11]); y1.z = cvt_pk_bf16(ov[12] * ro * gv[12], ov[13] * ro * gv[13]); y1.w = cvt_pk_bf16(ov[14] * ro * gv[14], ov[15] * ro * gv[15]);
        *(u32x4*)(Y + (size_t)m * 1024 + 16 * F.lane) = y0; *(u32x4*)(Y + (size_t)m * 1024 + 16 * F.lane + 8) = y1;
        (void)head;
    }
}
__device__ __forceinline__ void final_phase(Frame& F, const float* SS, const float* gain) {
    const int gw = F.vcu * NWAVES + F.wave, NGW = F.G * NWAVES; const bf16_t* HB = WSP(bf16_t, WS_HB);
    f32x4 gv[4];
#pragma unroll
    for (int j = 0; j < 4; ++j) gv[j] = *(const f32x4*)(gain + 4 * F.lane + 256 * j);
    for (int m = gw; m < M; m += NGW) { float* row = F.out + (size_t)m * D; const float rs = row_rstd(SS, m);
#pragma unroll
        for (int j = 0; j < 4; ++j) { const u32x2 hv = *(const u32x2*)(HB + (size_t)m * D + 4 * F.lane + 256 * j);
            f32x4 v = (f32x4){bf_lo(hv.x), bf_hi(hv.x), bf_lo(hv.y), bf_hi(hv.y)}; v = v * rs * gv[j]; *(f32x4*)(row + 4 * F.lane + 256 * j) = v; } }
}
__device__ __forceinline__ void p0_rows(Frame& F) {
    const int gw = F.vcu * NWAVES + F.wave, NGW = F.G * NWAVES; const float* x = F.in[0]; bf16_t* HB = WSP(bf16_t, WS_HB); float* SS = WSP(float, WS_SS);
    for (int m = gw; m < M; m += 2 * NGW) { const int m2 = m + NGW;
        f32x4 va[4], vb[4];
#pragma unroll
        for (int j = 0; j < 4; ++j) { va[j] = *(const f32x4*)(x + (size_t)m * D + 4 * F.lane + 256 * j); vb[j] = *(const f32x4*)(x + (size_t)m2 * D + 4 * F.lane + 256 * j); }
        float s = 0.f, s2 = 0.f;
#pragma unroll
        for (int j = 0; j < 4; ++j) { const f32x4 v = va[j], u = vb[j]; s += (v[0] * v[0] + v[1] * v[1]) + (v[2] * v[2] + v[3] * v[3]); s2 += (u[0] * u[0] + u[1] * u[1]) + (u[2] * u[2] + u[3] * u[3]);
            u32x2 pk; pk.x = cvt_pk_bf16(v[0], v[1]); pk.y = cvt_pk_bf16(v[2], v[3]); *(u32x2*)(HB + (size_t)m * D + 4 * F.lane + 256 * j) = pk;
            pk.x = cvt_pk_bf16(u[0], u[1]); pk.y = cvt_pk_bf16(u[2], u[3]); *(u32x2*)(HB + (size_t)m2 * D + 4 * F.lane + 256 * j) = pk; }
        s = wave_sum(s); s2 = wave_sum(s2);
        if (F.lane < 16) { SS[(size_t)m * 16 + F.lane] = F.lane == 0 ? s : 0.f; SS[(size_t)m2 * 16 + F.lane] = F.lane == 0 ? s2 : 0.f; } }
    if (blockIdx.x == 0) { float* HM = WSP(float, WS_META + META_HM); for (int i = F.tid; i < 16 * D; i += NTHREADS) HM[i] = F.in[1][i]; }
}

#ifndef S2FN
#define S2FN s2v6_phase
#endif
__device__ __forceinline__ unsigned char* opaque_ptr(unsigned char* p) { const unsigned long long v = (unsigned long long)p; int lo = __builtin_amdgcn_readfirstlane((int)(unsigned)v), hi = __builtin_amdgcn_readfirstlane((int)(unsigned)(v >> 32)); asm volatile("" : "+s"(lo), "+s"(hi)); return (unsigned char*)(((unsigned long long)(unsigned)hi << 32) | (unsigned)lo); }
struct Args { const float* in[18]; float* out; unsigned char* ws; int ph_lo, ph_hi; };
constexpr int N_PHASES = 19;
__global__ void __launch_bounds__(NTHREADS, 2) fwd(Args args) {
    extern __shared__ __attribute__((aligned(16))) unsigned char lds_raw[];
    Frame F;
    F.lds = (LAS unsigned char*)lds_raw;
    F.tid = threadIdx.x; F.lane = F.tid & 63; F.wave = __builtin_amdgcn_readfirstlane(F.tid >> 6);
    F.G = gridDim.x; { const int bx = blockIdx.x; F.vcu = (F.G % 8 == 0) ? (bx % 8) * (F.G / 8) + bx / 8 : bx; }
    F.ws = args.ws; F.out = args.out;
#pragma unroll
    for (int i = 0; i < 18; ++i) F.in[i] = args.in[i];
    volatile LAS unsigned* MISC = (volatile LAS unsigned*)(F.lds + LDS_MISC);
    if (F.tid < 64) MISC[F.tid] = 0u;
    __syncthreads();
    XcdBarrier bar = xcd_barrier_post(WSP(unsigned, WS_CTL) + CW_BAR, MISC + 8);
    const int lo = args.ph_lo, hi = args.ph_hi;
    __syncthreads();
    F.vb = (int)blockIdx.x;
    int vblk = (int)blockIdx.x;
#define INR(k) (lo <= (k) && (k) < hi)
#define IN(k) (lo <= (k) && (k) < hi && ((F.lane = lane_id_v()), (F.tid = F.wave * 64 + F.lane), true))
#if defined(PROBE_PHASE)
    unsigned long long t_prev = __builtin_amdgcn_s_memrealtime(), t_probe = 0ull;
#define SEAM(k) do { if (INR(k) && INR((k) + 1)) xcd_barrier(bar); { const unsigned long long t_now = __builtin_amdgcn_s_memrealtime(); if ((k) == PROBE_PHASE) t_probe = t_now - t_prev; t_prev = t_now; } } while (0)
#else
#define SEAM(k) do { if (INR(k) && INR((k) + 1)) xcd_barrier(bar); } while (0)
#endif
#define HB WSP(bf16_t, WS_HB)
#define SS WSP(float, WS_SS)
#define ACT WSP(bf16_t, WS_ACT)
    const int gw = F.vcu * NWAVES + F.wave, NGW = F.G * NWAVES;
#define RAW WSP(float, WS_META + META_RAW)
#define HM WSP(float, WS_META + META_HM)

#define FFN_IN(win, do_meta) do { \
        if ((do_meta) && meta_has_tiles(F, 2 * DFF, 128, 128)) { meta_prep_h(F); meta_tiles<0>(F, WSP(bf16_t, (win)), 2 * DFF, D, RAW, 2 * DFF, 1.f, 128, 128); } \
        pg8::Order S_; S_.init(M / 256, 22, F.G, vblk); PtrNormal P_{(const char*)HB, (const char*)WSP(bf16_t, (win)), (size_t)256 * D * 2}; \
        EpiSwiglu E_{(const LAS float*)(F.lds + LDS_RS), ACT}; pg8::gemm_phase(F.lds, D, S_, P_, E_, 0, 0, F.wave, SS); } while (0)
#define FFN_OUT(woutp, do_meta, F32B) do { const bf16_t* wo_ = (woutp); \
        if (do_meta) { meta_prep_act_q(F); meta_tiles_ksplit(F, wo_, DFF, 704, HM, 0.5f); } \
        pg8::Order S_; S_.init(M / 256, 4, F.G, vblk); PtrNormal P_{(const char*)ACT, (const char*)wo_, (size_t)256 * DFF * 2}; \
        EpiResid<F32B> E_{F.in[0], HB, SS, 0.5f}; pg8::gemm_phase(F.lds, DFF, S_, P_, E_, 0, 0, F.wave); } while (0)

#define slack (vblk >= 128)
#define sgw ((vblk - 128) * NWAVES + F.wave)
    const int SNGW = 128 * NWAVES;
    if (IN(0)) {
        int cb = conv_job(F, job_ffn_in(F, 0, 0, WS_WFFN_A + WF_IN), 0, gw, NGW); cb = conv_job(F, job_ffn_out(F, 0, 0, WS_WFFN_A + WF_OUT), cb, gw, NGW);
        p0_rows(F);
    }
    SEAM(0);
    if (lo == 0 && hi == N_PHASES && F.G == 256) {
        const unsigned* barw = WSP(unsigned, WS_CTL) + CW_BAR; bool ok = true;
#pragma unroll
        for (int j = 0; j < 8; ++j) ok = ok && (__hip_atomic_load(barw + XB_XCNT(j), __ATOMIC_RELAXED, __HIP_MEMORY_SCOPE_AGENT) == 32u);
        const unsigned rank = MISC[10], xcc = MISC[11];
        if (ok && rank < 32u && xcc < 8u) vblk = (int)(rank * 8u + xcc);
    }
    F.vb = vblk;
    if (IN(1)) {
        if (slack) { ConvJob J;
            J.W = F.in[9]; J.ldn = 6144; J.K = D; J.N = 6144; J.col0 = 0; J.kind = 0; J.gain = F.in[5]; J.WT = WSP(bf16_t, WS_WMIX + WM_RET_IN);
            int cb = conv_job(F, J, 0, sgw, SNGW);
            J.W = F.in[11]; J.ldn = D; J.K = 2048; J.N = D; J.col0 = 0; J.kind = 0; J.gain = F.in[10]; J.WT = WSP(bf16_t, WS_WMIX + WM_RET_OUT);
            cb = conv_job(F, J, cb, sgw, SNGW);
            cb = conv_job(F, job_ffn_in(F, 0, 1, WS_WFFN_C), cb, sgw, SNGW);
            __syncthreads(); }
        FFN_IN(WS_WFFN_A + WF_IN, true);
    }
    SEAM(1);
    if (IN(2)) FFN_OUT(WSP(bf16_t, WS_WFFN_A + WF_OUT), true, false);
    SEAM(2);
    if (IN(3)) {
        if (meta_has_tiles(F, 6144, 0, 256)) { meta_prep_h(F); meta_tiles<0>(F, WSP(bf16_t, WS_WMIX + WM_RET_IN), 6144, D, RAW, 6144, 1.f, 0, 256); }
        pg8::Order S_; S_.init(M / 256, 16, F.G, vblk);
        PtrSwapFrom P_{(const char*)HB, (const char*)WSP(bf16_t, WS_WMIX + WM_RET_IN), (size_t)256 * D * 2, 8};
        EpiRetInP E_{(const LAS float*)(F.lds + LDS_RS), (bf16_t*)F.out, WSP(bf16_t, WS_KM), WSP(bf16_t, WS_KT), WSP(bf16_t, WS_BV)}; pg8::gemm_phase(F.lds, D, S_, P_, E_, 0, 0, F.wave, SS);
    }
    SEAM(3);
    if (IN(4)) {
        { pg8::OrderLin S_{768, F.G, vblk}; PtrPA P_{(const char*)F.out, (const char*)WSP(bf16_t, WS_KM), (const char*)WSP(bf16_t, WS_KT), (const char*)WSP(bf16_t, WS_BV)};
          EpiPA E_{(bf16_t*)F.out, WSP(bf16_t, WS_BV)}; int Kz = 256; asm volatile("" : "+s"(Kz));
          pg8::gemm_phase<EpiPA, PtrPA, pg8::OrderLin>(F.lds, Kz, S_, P_, E_, 512, 256, F.wave); }
        xcd_barrier(bar);
        ret_scan_phase(F, vblk, WSP(bf16_t, WS_BV));
        xcd_barrier(bar);
        { pg8::OrderLin S_{512, F.G, vblk}; Ptr3 P_{(const char*)F.out, (const char*)WSP(bf16_t, WS_BV)};
          Epi3 E_{WSP(bf16_t, WS_O)}; int Kz = 512; asm volatile("" : "+s"(Kz));
          pg8::gemm_phase<Epi3, Ptr3, pg8::OrderLin>(F.lds, Kz, S_, P_, E_, 512, 512, F.wave); }
    }
    SEAM(4);
    if (IN(5)) {
        pg8::Order S_; S_.init(M / 256, 8, F.G, vblk); PtrNormal P_{(const char*)HB, (const char*)(WSP(bf16_t, WS_WMIX + WM_RET_IN) + (size_t)4096 * D), (size_t)256 * D * 2};
        EpiGate<512, 2048> E_{(const LAS float*)(F.lds + LDS_RS), WSP(bf16_t, WS_O), WSP(bf16_t, WS_VT), (LAS float*)(F.lds + 132096)}; pg8::gemm_phase(F.lds, D, S_, P_, E_, 0, 0, F.wave, SS);
    }
    SEAM(5);
    if (IN(6)) {
        { meta_prep_y_q(F); meta_tiles_ksplit(F, WSP(bf16_t, WS_WMIX + WM_RET_OUT), 2048, 512, HM, 1.0f); }
        pg8::Order S_; S_.init(M / 256, 4, F.G, vblk); PtrNormal P_{(const char*)WSP(bf16_t, WS_VT), (const char*)WSP(bf16_t, WS_WMIX + WM_RET_OUT), (size_t)256 * 2048 * 2};
        EpiResid<false> E_{nullptr, HB, SS, 1.0f}; pg8::gemm_phase(F.lds, 2048, S_, P_, E_, 0, 0, F.wave);
    }
    SEAM(6);
    if (IN(7)) {
        if (slack) { int cb = conv_job(F, job_ffn_out(F, 0, 1, WS_WFFN_A + WF_OUT), 0, sgw, SNGW);
            cb = conv_job(F, job_ffn_in(F, 1, 0, WS_WFFN_B + WF_IN), cb, sgw, SNGW); cb = conv_job(F, job_ffn_out(F, 1, 0, WS_WFFN_B + WF_OUT), cb, sgw, SNGW);
            ConvJob J;
            J.W = F.in[12]; J.ldn = 3088; J.K = D; J.N = 3072; J.col0 = 0; J.kind = 0; J.gain = F.in[5] + D; J.WT = WSP(bf16_t, WS_WMIX + WM_GLA_IN);
            cb = conv_job(F, J, cb, sgw, SNGW);
            J.W = F.in[16]; J.ldn = D; J.K = D; J.N = D; J.col0 = 0; J.kind = 0; J.gain = F.in[15]; J.WT = WSP(bf16_t, WS_WMIX + WM_GLA_OUT);
            cb = conv_job(F, J, cb, sgw, SNGW);
            if (vblk == F.G - 1) { bf16_t* WZ = WSP(bf16_t, WS_WMIX + WM_GLA_Z); const float* W = F.in[12]; const float* gn = F.in[5] + D;
                for (int i = F.tid; i < 16 * D; i += NTHREADS) { const int k = i >> 4, r = i & 15; WZ[r * D + k] = f2bf(W[(size_t)k * 3088 + 3072 + r] * gn[k]); } }
            __syncthreads(); }
        FFN_IN(WS_WFFN_C, true);
    }
    SEAM(7);
    if (IN(8)) FFN_OUT(WSP(bf16_t, WS_WFFN_A + WF_OUT), true, false);
    SEAM(8);
    if (IN(9)) {
        if (slack) { int cb = conv_job(F, job_ffn_in(F, 1, 1, WS_WFFN_A + WF_IN), 0, sgw, SNGW); cb = conv_job(F, job_ffn_out(F, 1, 1, WS_WFFN_A + WF_OUT), cb, sgw, SNGW); __syncthreads(); }
        FFN_IN(WS_WFFN_B + WF_IN, true);
    }
    SEAM(9);
    if (IN(10)) FFN_OUT(WSP(bf16_t, WS_WFFN_B + WF_OUT), true, false);
    SEAM(10);
    if (IN(11)) {
        if (meta_has_tiles(F, 2048, 0, 256)) { meta_prep_h(F); meta_tiles<0>(F, WSP(bf16_t, WS_WMIX + WM_GLA_IN), 2048, D, RAW, 3088, 1.f, 0, 256); }
        if (F.vb == 128) { meta_prep_h(F); meta_tiles<0>(F, WSP(bf16_t, WS_WMIX + WM_GLA_Z), 16, D, RAW + 3072, 3088, 1.f, 128, 128); }
        __syncthreads();
        z_phase(F, HB, SS, WSP(bf16_t, WS_WMIX + WM_GLA_Z), F.in[13], F.in[14], WSP(float, WS_BC));
    }
    SEAM(11);
    if (IN(12)) {
        pg8::Order S_; S_.init(M / 256, 8, F.G, vblk);
        PtrSwapFrom P_{(const char*)HB, (const char*)WSP(bf16_t, WS_WMIX + WM_GLA_IN), (size_t)256 * D * 2, 4};
        EpiGlaIn E_{(const LAS float*)(F.lds + LDS_RS), WSP(float, WS_BC), WSP(bf16_t, WS_QH2), WSP(bf16_t, WS_KH2), WSP(bf16_t, WS_VT2)}; pg8::gemm_phase(F.lds, D, S_, P_, E_, 0, 0, F.wave, SS);
    }
    SEAM(12);
    if (IN(13)) {
        if (vblk < 128) S2FN<128, 256, true>(F, vblk, WSP(bf16_t, WS_QH2), WSP(bf16_t, WS_KH2), WSP(bf16_t, WS_VT2), WSP(bf16_t, WS_O2), WSP(float, WS_BC), 3088);
        else {
            pg8::Order S_; S_.init(M / 256, 4, 128, vblk - 128); PtrNormal P_{(const char*)HB, (const char*)WSP(bf16_t, WS_WMIX + WM_GLA_G), (size_t)256 * D * 2};
            EpiSiluG E_{(const LAS float*)(F.lds + LDS_RS), WSP(bf16_t, WS_G2), 1024}; pg8::gemm_phase(F.lds, D, S_, P_, E_, 0, 0, F.wave, SS);
        }
    }
    SEAM(13);
    if (IN(14)) gla_gate_phase(F, WSP(bf16_t, WS_O2), WSP(bf16_t, WS_G2), WSP(bf16_t, WS_VT2));
    SEAM(14);
    if (IN(15)) {
        pg8::Order S_; S_.init(M / 256, 4, F.G, vblk); PtrNormal P_{(const char*)WSP(bf16_t, WS_VT2), (const char*)WSP(bf16_t, WS_WMIX + WM_GLA_OUT), (size_t)256 * D * 2};
        EpiResid<false> E_{nullptr, HB, SS, 1.0f}; pg8::gemm_phase(F.lds, D, S_, P_, E_, 0, 0, F.wave);
    }
    SEAM(15);
    if (IN(16)) FFN_IN(WS_WFFN_A + WF_IN, false);
    SEAM(16);
    if (IN(17)) FFN_OUT(WSP(bf16_t, WS_WFFN_A + WF_OUT), false, false);
    SEAM(17);
    if (IN(18)) final_phase(F, SS, F.in[17]);
#if defined(PROBE2) || defined(PROBE3) || defined(PROBE4)
    __syncthreads();
    if (blockIdx.x == 0 && F.tid == 0) { const unsigned long long cyc = ((unsigned long long)MISC[21] << 32) | MISC[20]; const unsigned long long t0 = __builtin_amdgcn_s_memtime(); while (__builtin_amdgcn_s_memtime() - t0 < 4ull * cyc) __builtin_amdgcn_s_sleep(16); }
#endif
#if defined(PROBE_PHASE)
    { const unsigned long long t_now = __builtin_amdgcn_s_memrealtime(); if (18 == PROBE_PHASE) t_probe = t_now - t_prev;
      if (blockIdx.x == 0 && F.tid == 0) { const unsigned long long t_end = t_now + (unsigned long long)PROBE_MULT * t_probe; while (__builtin_amdgcn_s_memrealtime() < t_end) __builtin_amdgcn_s_sleep(16); } }
#endif
#undef HB
#undef SS
#undef ACT
#undef RAW
#undef HM
#undef slack
#undef sgw
#undef IN
#undef SEAM
#undef FFN_IN
#undef FFN_OUT
}
}
#ifndef MK_MODE
#define MK_MODE 0
#endif
#if MK_MODE == 2
namespace dbg {
__global__ void adapt(const unsigned short* HBtmp, const float* HMtmp, float* Hn) {
    const size_t i = (size_t)blockIdx.x * blockDim.x + threadIdx.x;
    if (i >= (size_t)nv::ROWS * nv::D) return;
    const int d = (int)(i % nv::D); const size_t row = i / nv::D; const int b = (int)(row / nv::TT), s = (int)(row % nv::TT);
    Hn[i] = s < nv::NMETA ? HMtmp[s * nv::D + d] : __uint_as_float((unsigned)HBtmp[((size_t)b * nv::SEQ + (s - nv::NMETA)) * nv::D + d] << 16);
}
}
#endif
extern "C" void kernel_launch(void* const* d_in, const int* in_sizes, int n_in, void* d_out, int out_size, void* d_ws, size_t ws_size, hipStream_t stream) {
    static int grid = 0;
    if (grid == 0) {
        if (n_in != 18 || out_size != mk::M * mk::D || ws_size < mk::WS_NEED) { fprintf(stderr, "kernel_launch: unexpected sizes n_in %d out %d ws %zu\n", n_in, out_size, ws_size); grid = -1; return; }
        int dev = 0, cus = 0, per_cu = 0;
        if (hipGetDevice(&dev) != hipSuccess || hipDeviceGetAttribute(&cus, hipDeviceAttributeMultiprocessorCount, dev) != hipSuccess) { grid = -1; return; }
        if (hipFuncSetAttribute((const void*)mk::fwd, hipFuncAttributeMaxDynamicSharedMemorySize, mk::LDS_BYTES) != hipSuccess) { fprintf(stderr, "kernel_launch: hipFuncSetAttribute failed\n"); grid = -1; return; }
        if (hipOccupancyMaxActiveBlocksPerMultiprocessor(&per_cu, (const void*)mk::fwd, mk::NTHREADS, mk::LDS_BYTES) != hipSuccess || per_cu < 1) { fprintf(stderr, "kernel_launch: occupancy query says %d\n", per_cu); per_cu = 1; }
        (void)hipGetLastError();
        grid = cus;
        if (grid != 256) fprintf(stderr, "kernel_launch: %d CUs (built for 256)\n", grid);
    }
    if (grid < 0) return;
    (void)hipMemsetAsync((char*)d_ws + mk::WS_CTL, 0, mk::CTL_ZERO_BYTES, stream);
    mk::Args a{};
    for (int i = 0; i < 18; ++i) a.in[i] = (const float*)d_in[i];
    a.out = (float*)d_out; a.ws = (unsigned char*)d_ws;
#if MK_MODE == 0
    a.ph_lo = 0; a.ph_hi = mk::N_PHASES;
    hipLaunchKernelGGL(mk::fwd, dim3(grid), dim3(mk::NTHREADS), mk::LDS_BYTES, stream, a);
#elif MK_MODE == 1
    for (int p = 0; p < mk::N_PHASES; ++p) { a.ph_lo = p; a.ph_hi = p + 1; hipLaunchKernelGGL(mk::fwd, dim3(grid), dim3(mk::NTHREADS), mk::LDS_BYTES, stream, a); }
#else
    a.ph_lo = 0; a.ph_hi = MK_CUT; hipLaunchKernelGGL(mk::fwd, dim3(grid), dim3(mk::NTHREADS), mk::LDS_BYTES, stream, a);
    {
        float* tmp = (float*)((char*)d_ws + 250 * mk::MiB); unsigned short* hbt = (unsigned short*)((char*)d_ws + 210 * mk::MiB);
        (void)hipMemcpyAsync(tmp, (char*)d_ws + mk::WS_META + mk::META_HM, 16 * 1024 * 4, hipMemcpyDeviceToDevice, stream);
        (void)hipMemcpyAsync(hbt, (char*)d_ws + mk::WS_HB, (size_t)mk::M * mk::D * 2, hipMemcpyDeviceToDevice, stream);
        hipLaunchKernelGGL(dbg::adapt, dim3((unsigned)(((size_t)nv::ROWS * nv::D + 255) / 256)), dim3(256), 0, stream, (const unsigned short*)hbt, (const float*)tmp, (float*)d_ws);
        nv::forward(stream, d_in, (float*)d_out, (char*)d_ws, MK_STAGE);
    }
#endif
}
```
